# Optimizing an MI355X kernel written in HIP

```python
import jax, jax.numpy as jnp
from jax import lax
import numpy as np

D_MODEL = 1024
BATCH = 2
SEQ = 8192
DEPTH = 2

D_MIX = D_MODEL
NORM_EPS = 1e-6

GLA_HEADS = 4
GLA_DK = 64
GLA_DV = 128
GLA_KW = GLA_HEADS * GLA_DK
GLA_VW = GLA_HEADS * GLA_DV
GLA_GATE_RANK = 16
GLA_TAU = 16.0
GLA_CHUNK = 64

RWKV_HEAD = 64
RWKV_W = D_MIX - GLA_VW
RWKV_HEADS = RWKV_W // RWKV_HEAD
RWKV_DECAY_RANK = 64
RWKV_A_RANK = 64
RWKV_GN_EPS = 64e-5

GLA_SPLITS = (GLA_KW, GLA_KW, GLA_VW, GLA_GATE_RANK, GLA_VW)
RWKV_SHIFT_SPLITS = (RWKV_W, RWKV_W, RWKV_W, RWKV_DECAY_RANK, RWKV_A_RANK)
GLA_IN = sum(GLA_SPLITS)
RWKV_SHIFT_W = sum(RWKV_SHIFT_SPLITS)
RWKV_IN = RWKV_SHIFT_W + RWKV_W
IN_WIDTH = GLA_IN + RWKV_IN

kernel_name = "hymba_gla_rwkv7_hybrid"


def _split(t, sizes):
    idx = np.cumsum(np.array(sizes))[:-1].tolist()
    return jnp.split(t, idx, axis=-1)


def _rmsnorm(x, w):
    xf = x.astype(jnp.float32)
    y = xf * lax.rsqrt(jnp.mean(xf * xf, axis=-1, keepdims=True) + NORM_EPS)
    return (y * w.astype(jnp.float32)).astype(x.dtype)


def _gla_chunked(q, k, v, log_a):
    B, T, H, DK = q.shape
    DV = v.shape[-1]
    C = GLA_CHUNK
    N = T // C

    def to_chunks(t):
        return t.reshape(B, N, C, H, t.shape[-1]).transpose(1, 0, 3, 2, 4)

    qc, kc, vc, gc = to_chunks(q), to_chunks(k), to_chunks(v), to_chunks(log_a)
    b = jnp.cumsum(gc, axis=3)
    b_last = b[:, :, :, -1:, :]
    q_in = qc * jnp.exp(b)
    k_in = kc * jnp.exp(-b)
    k_st = kc * jnp.exp(b_last - b)
    causal = jnp.tril(jnp.ones((C, C), dtype=bool))
    scores = jnp.einsum('nbhid,nbhjd->nbhij', q_in, k_in)
    scores = jnp.where(causal, scores, 0.0)
    o_intra = jnp.einsum('nbhij,nbhjv->nbhiv', scores, vc)
    d_state = jnp.einsum('nbhjd,nbhjv->nbhdv', k_st, vc)
    chunk_decay = jnp.exp(b_last[:, :, :, 0, :])

    def step(S, inp):
        dS, dec = inp
        return S * dec[..., None] + dS, S

    S0 = jnp.zeros((B, H, DK, DV), jnp.float32)
    _, S_prev = lax.scan(step, S0, (d_state, chunk_decay))
    o_inter = jnp.einsum('nbhid,nbhdv->nbhiv', q_in, S_prev)
    o = o_intra + o_inter
    return o.transpose(1, 0, 3, 2, 4).reshape(B, T, H, DV)


def _rwkv7_scan(r, decay, k, v, kk, a):
    B, T, H, N = r.shape

    def step(S, inp):
        r_t, w_t, k_t, v_t, kk_t, a_t = inp
        sa = jnp.einsum('bhvk,bhk->bhv', S, -kk_t)
        S = (S * w_t[:, :, None, :]
             + sa[..., None] * (kk_t * a_t)[:, :, None, :]
             + v_t[..., None] * k_t[:, :, None, :])
        y = jnp.einsum('bhvk,bhk->bhv', S, r_t)
        return S, y

    xs = tuple(t.transpose(1, 0, 2, 3) for t in (r, decay, k, v, kk, a))
    S0 = jnp.zeros((B, H, N, N), jnp.float32)
    _, y = lax.scan(step, S0, xs)
    return y.transpose(1, 0, 2, 3)


def _hybrid_layer(x, norm_w, w_in, gla_gate_up, gla_gate_bias, gla_norm_w,
                  rwkv_mu, rwkv_w0, rwkv_w_up, rwkv_a0, rwkv_a_up, rwkv_k_k,
                  rwkv_k_a, rwkv_r_k, rwkv_ln_w, rwkv_ln_b, w_out):
    B, T, _ = x.shape
    f32 = jnp.float32
    h = _rmsnorm(x, norm_w)
    u = (h @ w_in).astype(f32)
    gla_u, rwkv_u = u[..., :GLA_IN], u[..., GLA_IN:]

    gq, gk, gv, glr, gg = _split(gla_u, GLA_SPLITS)
    log_a = jax.nn.log_sigmoid(glr @ gla_gate_up.astype(f32) + gla_gate_bias.astype(f32)) / GLA_TAU
    q = gq.reshape(B, T, GLA_HEADS, GLA_DK) * (GLA_DK ** -0.5)
    k = gk.reshape(B, T, GLA_HEADS, GLA_DK)
    v = gv.reshape(B, T, GLA_HEADS, GLA_DV)
    o = _gla_chunked(q, k, v, log_a.reshape(B, T, GLA_HEADS, GLA_DK))
    o = o * lax.rsqrt(jnp.mean(o * o, axis=-1, keepdims=True) + NORM_EPS) * gla_norm_w.astype(f32)
    gla_out = o.reshape(B, T, GLA_VW) * jax.nn.silu(gg)

    shifted_cols = rwkv_u[..., :RWKV_SHIFT_W]
    rg = rwkv_u[..., RWKV_SHIFT_W:]
    prev = jnp.pad(shifted_cols, ((0, 0), (1, 0), (0, 0)))[:, :-1]
    mixed = shifted_cols + (prev - shifted_cols) * rwkv_mu.astype(f32)
    r, rk, rv, wl, al = _split(mixed, RWKV_SHIFT_SPLITS)
    w = -jax.nn.softplus(-(rwkv_w0.astype(f32) + jnp.tanh(wl) @ rwkv_w_up.astype(f32))) - 0.5
    decay = jnp.exp(-jnp.exp(w))
    a = jax.nn.sigmoid(rwkv_a0.astype(f32) + al @ rwkv_a_up.astype(f32))
    kk = (rk * rwkv_k_k.astype(f32)).reshape(B, T, RWKV_HEADS, RWKV_HEAD)
    kk = kk / jnp.maximum(jnp.linalg.norm(kk, axis=-1, keepdims=True), 1e-12)
    rk = rk * (1.0 + (a - 1.0) * rwkv_k_a.astype(f32))
    hs = (B, T, RWKV_HEADS, RWKV_HEAD)
    r_h, k_h, v_h = r.reshape(hs), rk.reshape(hs), rv.reshape(hs)
    y = _rwkv7_scan(r_h, decay.reshape(hs), k_h, v_h, kk, a.reshape(hs))
    mu = jnp.mean(y, axis=-1, keepdims=True)
    var = jnp.mean(jnp.square(y - mu), axis=-1, keepdims=True)
    y = ((y - mu) * lax.rsqrt(var + RWKV_GN_EPS)).reshape(B, T, RWKV_W)
    y = y * rwkv_ln_w.astype(f32) + rwkv_ln_b.astype(f32)
    bonus = jnp.sum(r_h * k_h * rwkv_r_k.astype(f32), axis=-1, keepdims=True) * v_h
    rwkv_out = (y + bonus.reshape(B, T, RWKV_W)) * jax.nn.silu(rg)

    merged = jnp.concatenate([gla_out, rwkv_out], axis=-1).astype(x.dtype)
    return x + merged @ w_out


def setup_inputs(seed: int = 0) -> dict:
    key = jax.random.key(seed)
    ks = jax.random.split(key, 20)
    n = jax.random.normal
    L = DEPTH
    return {
        "x": n(ks[0], (BATCH, SEQ, D_MODEL), jnp.float32),
        "norm_w": 1.0 + 0.05 * n(ks[1], (L, D_MODEL), jnp.float32),
        "w_in": n(ks[2], (L, D_MODEL, IN_WIDTH), jnp.float32) * D_MODEL ** -0.5,
        "gla_gate_up": n(ks[3], (L, GLA_GATE_RANK, GLA_KW), jnp.float32) * GLA_GATE_RANK ** -0.5,
        "gla_gate_bias": 0.1 * n(ks[4], (L, GLA_KW), jnp.float32),
        "gla_norm_w": 1.0 + 0.05 * n(ks[5], (L, GLA_DV), jnp.float32),
        "rwkv_mu": jax.random.uniform(ks[6], (L, RWKV_SHIFT_W), jnp.float32),
        "rwkv_w0": jax.random.uniform(ks[7], (L, RWKV_W), jnp.float32, -6.0, -1.0),
        "rwkv_w_up": 0.1 * n(ks[8], (L, RWKV_DECAY_RANK, RWKV_W), jnp.float32),
        "rwkv_a0": 0.1 * n(ks[9], (L, RWKV_W), jnp.float32),
        "rwkv_a_up": 0.1 * n(ks[10], (L, RWKV_A_RANK, RWKV_W), jnp.float32),
        "rwkv_k_k": 0.85 + 0.05 * n(ks[11], (L, RWKV_W), jnp.float32),
        "rwkv_k_a": 1.0 + 0.05 * n(ks[12], (L, RWKV_W), jnp.float32),
        "rwkv_r_k": 0.1 * n(ks[13], (L, RWKV_HEADS, RWKV_HEAD), jnp.float32),
        "rwkv_ln_w": 1.0 + 0.05 * n(ks[14], (L, RWKV_W), jnp.float32),
        "rwkv_ln_b": 0.02 * n(ks[15], (L, RWKV_W), jnp.float32),
        "w_out": n(ks[16], (L, D_MIX, D_MODEL), jnp.float32) * D_MIX ** -0.5,
        "final_norm_w": 1.0 + 0.05 * n(ks[17], (D_MODEL,), jnp.float32),
    }


def reference(x, norm_w, w_in, gla_gate_up, gla_gate_bias, gla_norm_w, rwkv_mu,
              rwkv_w0, rwkv_w_up, rwkv_a0, rwkv_a_up, rwkv_k_k, rwkv_k_a,
              rwkv_r_k, rwkv_ln_w, rwkv_ln_b, w_out, final_norm_w):
    for l in range(DEPTH):
        x = _hybrid_layer(x, norm_w[l], w_in[l], gla_gate_up[l], gla_gate_bias[l],
                          gla_norm_w[l], rwkv_mu[l], rwkv_w0[l], rwkv_w_up[l],
                          rwkv_a0[l], rwkv_a_up[l], rwkv_k_k[l], rwkv_k_a[l],
                          rwkv_r_k[l], rwkv_ln_w[l], rwkv_ln_b[l], w_out[l])
    return _rmsnorm(x, final_norm_w)
```

```cpp
#include <hip/hip_runtime.h>
#include <hip/hip_cooperative_groups.h>
#include <cstdio>
#include <cstdint>
namespace cg = cooperative_groups;
namespace pg8 {
#define PG8_LAS __attribute__((address_space(3)))
typedef unsigned short bf16_t;
typedef short bf16x8 __attribute__((ext_vector_type(8)));
typedef float f32x4 __attribute__((ext_vector_type(4)));
typedef unsigned u32x4 __attribute__((ext_vector_type(4)));
constexpr int BM = 256, BK = 64, HALF = 128, HTB = HALF * BK * 2  , STAGE_BYTES = 8 * HTB, NXCD = 8, WGM = 8;

__host__ __device__ __forceinline__ int lds_byte(int r, int c) { const int st = (r >> 4) * 2 + (c >> 5), rr = r & 15, cc = c & 31, ob = rr * 64 + cc * 2; return st * 1024 + (ob ^ (((ob >> 9) & 1) << 5)); }
__host__ __device__ __forceinline__ void stage_rc(int b, int& R, int& C) { const int st = b / 1024, sb = b % 1024, swz = sb ^ (((sb >> 9) & 1) << 5); R = (st >> 1) * 16 + swz / 64; C = (st & 1) * 32 + (swz % 64) / 2; }
__host__ __device__ __forceinline__ int perm32(int rho) { const int n = rho >> 4, i = rho & 15; return 8 * (i >> 2) + 4 * n + (i & 3); }

struct Unit { int pm, pn; };
struct Gemm { const bf16_t* A; const bf16_t* Bt; int M, N, K; };

struct StaticOrder {
    int nM, nN, nwg, G, c;
    __host__ __device__ void init(int M, int N, int G_, int c_) { nM = M / BM; nN = N / BM; nwg = nM * nN; G = G_; c = c_; }
    __host__ __device__ bool next(int i, Unit& u) const {
        const long L = (long)i * G + c; if (L >= nwg) return false;
        int wgid = (int)L; { const int q = nwg / NXCD, r = nwg % NXCD, xcd = wgid % NXCD, off = wgid / NXCD; wgid = (xcd < r ? xcd * (q + 1) : r * (q + 1) + (xcd - r) * q) + off; }
        const int nig = WGM * nN, gid = wgid / nig, fm = gid * WGM, gsz = (nM - fm) < WGM ? (nM - fm) : WGM;
        u.pm = fm + ((wgid % nig) % gsz); u.pn = (wgid % nig) / gsz; return true;
    }
    __device__ __forceinline__ void a_ready(const Unit&) const {}
    __device__ __forceinline__ void done(const Unit&) const {}
};

__device__ __forceinline__ unsigned cvt_pk_bf16(float lo, float hi) { unsigned r; asm volatile("v_cvt_pk_bf16_f32 %0, %1, %2" : "=v"(r) : "v"(lo), "v"(hi)); return r; }
typedef float f32x2 __attribute__((ext_vector_type(2)));
__device__ __forceinline__ f32x2 gelu_pk(f32x2 v) {
    const f32x2 av = __builtin_elementwise_abs(v), d = av * 0.2316418882f + 1.0f;
    f32x2 t; t.x = __builtin_amdgcn_rcpf(d.x); t.y = __builtin_amdgcn_rcpf(d.y);
    f32x2 q = t * 0.5307027145f + (-0.7265760135f); q = q * t + 0.7107068705f; q = q * t + (-0.142248368f); q = q * t + 0.127414796f; q = q * t;
    const f32x2 s = (v * v) * (-0.72134752044f);
    f32x2 e; e.x = __builtin_amdgcn_exp2f(s.x); e.y = __builtin_amdgcn_exp2f(s.y);
    const f32x2 m = v * (q * e), r = v - m;
    f32x2 o; o.x = v.x < 0.f ? m.x : r.x; o.y = v.y < 0.f ? m.y : r.y; return o;
}

template <int ACT  > struct EpiBf16 {
    static constexpr bool PERM = true, AFTER_DRAIN = false; static_assert(ACT == 0 || ACT == 1, "EpiBf16: ACT is 0 (none) or 1 (gelu_pk)");
    bf16_t* O; int ldc; const float* bias; int split_cols; size_t split_stride; float scale0;
    __device__ __forceinline__ void operator()(const f32x4 (&acc)[2][2][4][2], const Unit& u, int wr, int wc, int fr, int fq) const {
        const int row0 = u.pm * BM + wr * 64 + fr; int colt = u.pn * BM; bf16_t* base = O;
        float sc = 1.f; if (split_cols) { const int t = colt / split_cols; base += (size_t)t * split_stride; colt -= t * split_cols; if (t == 0) sc = scale0; }
        const int col0 = colt + wc * 32 + 8 * fq, bcol0 = u.pn * BM + wc * 32 + 8 * fq;
        f32x4 bv[2][2];
#pragma unroll
        for (int bj = 0; bj < 2; ++bj)
#pragma unroll
            for (int n = 0; n < 2; ++n) bv[bj][n] = bias ? *(const f32x4*)(bias + bcol0 + bj * HALF + 4 * n) : (f32x4){0.f, 0.f, 0.f, 0.f};
#pragma unroll
        for (int ai = 0; ai < 2; ++ai)
#pragma unroll
            for (int m = 0; m < 4; ++m) { bf16_t* rowp = base + (size_t)(row0 + ai * HALF + m * 16) * ldc + col0;
#pragma unroll
                for (int bj = 0; bj < 2; ++bj) { f32x4 v0 = acc[ai][bj][m][0] + bv[bj][0], v1 = acc[ai][bj][m][1] + bv[bj][1];
                    if (ACT == 1) { f32x2 a = gelu_pk((f32x2){v0[0], v0[1]}), b = gelu_pk((f32x2){v0[2], v0[3]}), c = gelu_pk((f32x2){v1[0], v1[1]}), d = gelu_pk((f32x2){v1[2], v1[3]});
                        v0 = (f32x4){a.x, a.y, b.x, b.y}; v1 = (f32x4){c.x, c.y, d.x, d.y}; }
                    v0 = v0 * sc; v1 = v1 * sc; u32x4 w; w.x = cvt_pk_bf16(v0[0], v0[1]); w.y = cvt_pk_bf16(v0[2], v0[3]); w.z = cvt_pk_bf16(v1[0], v1[1]); w.w = cvt_pk_bf16(v1[2], v1[3]);
                    *(u32x4*)(rowp + bj * HALF) = w; } }
    }
};

template <class Epi, class Sched, bool ALIGN_EPI = false, bool SP2 = false>
__device__ __forceinline__ void gemm_phase(PG8_LAS unsigned char* lds, const Gemm g, const Sched& S, const Epi& E) {
    int tid_ = threadIdx.x; asm volatile("" : "+v"(tid_));
    const int tid = tid_, wid = __builtin_amdgcn_readfirstlane(tid >> 6), lane = tid & 63, wr = wid >> 2, wc = wid & 3, fr = lane & 15, fq = lane >> 4;
    const int K = g.K, nt = K / BK;
    unsigned voffA[2], voffB[2];
#pragma unroll
    for (int i = 0; i < 2; ++i) { int R, C; stage_rc(tid * 16 + i * 8192, R, C); const int Rb = Epi::PERM ? ((R & ~31) + perm32(R & 31)) : R;
        voffA[i] = (unsigned)(R * K + C) * 2u; voffB[i] = (unsigned)(Rb * K + C) * 2u; }
    const size_t kstep = (size_t)(BK * 2);
    const size_t hstep = (size_t)HALF * K * 2;
    const size_t tstep = 2 * hstep;
    const unsigned ldsw = (unsigned)wid * 1024u;
    const int aoff = lds_byte(wr * 64 + fr, fq * 8), boff = lds_byte(wc * 32 + fr, fq * 8);
#define PG8_SA(b, h) (((b) * 2 + (h)) * HTB)
#define PG8_SB(b, h) ((4 + (b) * 2 + (h)) * HTB)
#define PG8_STAGE(bufoff, gbase, voff) do { _Pragma("unroll") for (int _i = 0; _i < 2; ++_i) \
        __builtin_amdgcn_global_load_lds((const unsigned*)((const char*)(gbase) + (voff)[_i]), (PG8_LAS unsigned*)(lds + (bufoff) + ldsw + _i * 8192), 16, 0, 0); } while (0)
#define PG8_LDA(dst, b, h) do { _Pragma("unroll") for (int m = 0; m < 4; ++m) _Pragma("unroll") for (int k = 0; k < 2; ++k) dst[m][k] = *(const PG8_LAS bf16x8*)(lds + PG8_SA(b, h) + aoff + m * 2048 + k * 1024); } while (0)
#define PG8_LDB(dst, b, h) do { _Pragma("unroll") for (int n = 0; n < 2; ++n) _Pragma("unroll") for (int k = 0; k < 2; ++k) dst[n][k] = *(const PG8_LAS bf16x8*)(lds + PG8_SB(b, h) + boff + n * 2048 + k * 1024); } while (0)
#define PG8_MMA(ai, bj, At, Bt) do { __builtin_amdgcn_s_setprio(1); _Pragma("unroll") for (int m = 0; m < 4; ++m) _Pragma("unroll") for (int n = 0; n < 2; ++n) _Pragma("unroll") for (int k = 0; k < 2; ++k) \
        acc[ai][bj][m][n] = __builtin_amdgcn_mfma_f32_16x16x32_bf16(Bt[n][k], At[m][k], acc[ai][bj][m][n], 0, 0, 0); __builtin_amdgcn_s_setprio(0); } while (0)
#define PG8_WAIT_V(n) asm volatile("s_waitcnt vmcnt(" #n ")" ::: "memory")
#define PG8_WAIT_L(n) asm volatile("s_waitcnt lgkmcnt(" #n ")" ::: "memory")
#define PG8_BAR __builtin_amdgcn_s_barrier()
#define PG8_SCHED __builtin_amdgcn_sched_barrier(0)
    Unit cur, nxt; int ui = 0;
    if (!S.next(0, cur)) return;
    f32x4 acc[2][2][4][2];
#pragma unroll
    for (int a = 0; a < 2; ++a)
#pragma unroll
        for (int b = 0; b < 2; ++b)
#pragma unroll
            for (int m = 0; m < 4; ++m)
#pragma unroll
                for (int n = 0; n < 2; ++n) acc[a][b][m][n] = (f32x4){0.f, 0.f, 0.f, 0.f};
    bf16x8 At[4][2], B0[2][2], B1[2][2];
    const char* cA = (const char*)g.A + (size_t)cur.pm * tstep; const char* cB = (const char*)g.Bt + (size_t)cur.pn * tstep;
    S.a_ready(cur);
    if constexpr (SP2) {
        PG8_STAGE(PG8_SB(0, 0), cB, voffB); PG8_STAGE(PG8_SB(0, 1), cB + hstep, voffB); PG8_STAGE(PG8_SA(0, 0), cA, voffA); PG8_STAGE(PG8_SA(0, 1), cA + hstep, voffA);
        if (wr == 1) PG8_BAR;
        PG8_WAIT_V(2); PG8_BAR;
        PG8_STAGE(PG8_SB(1, 0), cB + kstep, voffB); PG8_STAGE(PG8_SA(1, 0), cA + kstep, voffA); PG8_STAGE(PG8_SB(1, 1), cB + hstep + kstep, voffB);
        PG8_WAIT_V(6); PG8_BAR;
    } else {
        PG8_STAGE(PG8_SB(0, 0), cB, voffB); PG8_STAGE(PG8_SA(0, 0), cA, voffA); PG8_STAGE(PG8_SB(0, 1), cB + hstep, voffB); PG8_STAGE(PG8_SA(0, 1), cA + hstep, voffA);
        if (wr == 1) PG8_BAR;
        PG8_WAIT_V(4); PG8_BAR;
        PG8_STAGE(PG8_SB(1, 0), cB + kstep, voffB); PG8_STAGE(PG8_SA(1, 0), cA + kstep, voffA); PG8_STAGE(PG8_SB(1, 1), cB + hstep + kstep, voffB);
        PG8_WAIT_V(6); PG8_BAR;
    }
    for (;;) {
        const bool has_next = S.next(ui + 1, nxt);
        const char* nA = has_next ? (const char*)g.A + (size_t)nxt.pm * tstep : cA; const char* nB = has_next ? (const char*)g.Bt + (size_t)nxt.pn * tstep : cB;
        for (int t = 0; t < nt; t += 2) {
            const bool last = (t == nt - 2);
            const char* a1 = cA + (size_t)(t + 1) * kstep;
            const char* a2 = last ? nA : cA + (size_t)(t + 2) * kstep; const char* b2 = last ? nB : cB + (size_t)(t + 2) * kstep;
            const char* a3 = a2 + kstep; const char* b3 = b2 + kstep;
            if (last && has_next) S.a_ready(nxt);
            if constexpr (SP2) {
            PG8_LDB(B0, 0, 0); PG8_LDB(B1, 0, 1); PG8_SCHED; PG8_LDA(At, 0, 0); PG8_STAGE(PG8_SA(1, 1), a1 + hstep, voffA);
            PG8_WAIT_V(8); PG8_WAIT_L(0); PG8_BAR; PG8_MMA(0, 0, At, B0); PG8_MMA(0, 1, At, B1); PG8_BAR; PG8_SCHED;
            PG8_LDA(At, 0, 1); PG8_STAGE(PG8_SB(0, 0), b2, voffB); PG8_STAGE(PG8_SB(0, 1), b2 + hstep, voffB); PG8_STAGE(PG8_SA(0, 0), a2, voffA);
            PG8_WAIT_V(8); PG8_WAIT_L(0); PG8_BAR; PG8_MMA(1, 0, At, B0); PG8_MMA(1, 1, At, B1); PG8_BAR; PG8_SCHED;
            PG8_LDB(B0, 1, 0); PG8_LDB(B1, 1, 1); PG8_SCHED; PG8_LDA(At, 1, 0); PG8_STAGE(PG8_SA(0, 1), a2 + hstep, voffA);
            PG8_WAIT_V(8); PG8_WAIT_L(0); PG8_BAR; PG8_MMA(0, 0, At, B0); PG8_MMA(0, 1, At, B1); PG8_BAR; PG8_SCHED;
            PG8_LDA(At, 1, 1); PG8_STAGE(PG8_SB(1, 0), b3, voffB); PG8_STAGE(PG8_SB(1, 1), b3 + hstep, voffB); PG8_STAGE(PG8_SA(1, 0), a3, voffA);
            PG8_WAIT_V(8); PG8_WAIT_L(0); PG8_BAR; PG8_MMA(1, 0, At, B0); PG8_MMA(1, 1, At, B1); PG8_BAR; PG8_SCHED;
            } else {
            PG8_LDB(B0, 0, 0); PG8_SCHED; PG8_LDA(At, 0, 0); PG8_STAGE(PG8_SA(1, 1), a1 + hstep, voffA);
            PG8_WAIT_L(8); PG8_BAR; PG8_WAIT_L(0); PG8_MMA(0, 0, At, B0); PG8_BAR; PG8_SCHED;
            PG8_LDB(B1, 0, 1); PG8_STAGE(PG8_SB(0, 0), b2, voffB);
            PG8_BAR; PG8_WAIT_L(0); PG8_MMA(0, 1, At, B1); PG8_BAR;
            PG8_LDA(At, 0, 1); PG8_STAGE(PG8_SA(0, 0), a2, voffA);
            PG8_BAR; PG8_WAIT_L(0); PG8_MMA(1, 0, At, B0); PG8_BAR; PG8_SCHED;
            PG8_STAGE(PG8_SB(0, 1), b2 + hstep, voffB);
            PG8_WAIT_V(6); PG8_BAR; PG8_MMA(1, 1, At, B1); PG8_BAR;
            PG8_LDB(B0, 1, 0); PG8_SCHED; PG8_LDA(At, 1, 0); PG8_STAGE(PG8_SA(0, 1), a2 + hstep, voffA);
            PG8_WAIT_L(8); PG8_BAR; PG8_WAIT_L(0); PG8_MMA(0, 0, At, B0); PG8_BAR; PG8_SCHED;
            PG8_LDB(B1, 1, 1); PG8_STAGE(PG8_SB(1, 0), b3, voffB);
            PG8_BAR; PG8_WAIT_L(0); PG8_MMA(0, 1, At, B1); PG8_BAR;
            PG8_LDA(At, 1, 1); PG8_STAGE(PG8_SA(1, 0), a3, voffA);
            PG8_BAR; PG8_WAIT_L(0); PG8_MMA(1, 0, At, B0); PG8_BAR; PG8_SCHED;
            PG8_STAGE(PG8_SB(1, 1), b3 + hstep, voffB);
            PG8_WAIT_V(6); PG8_BAR; PG8_MMA(1, 1, At, B1); PG8_BAR;
            }
        }
        if constexpr (ALIGN_EPI) { if (wr == 0) PG8_BAR; }
        if constexpr (!Epi::AFTER_DRAIN) { E(acc, cur, wr, wc, fr, fq); S.done(cur); }
        if (!has_next) break;
#pragma unroll
        for (int a = 0; a < 2; ++a)
#pragma unroll
            for (int b = 0; b < 2; ++b)
#pragma unroll
                for (int m = 0; m < 4; ++m)
#pragma unroll
                    for (int n = 0; n < 2; ++n) acc[a][b][m][n] = (f32x4){0.f, 0.f, 0.f, 0.f};
        cur = nxt; cA = nA; cB = nB; ++ui;
        if constexpr (ALIGN_EPI) { if (wr == 1) PG8_BAR; }
    }
    PG8_WAIT_V(0);
    if constexpr (!ALIGN_EPI) { if (wr == 0) PG8_BAR; }
    PG8_BAR;
    if constexpr (Epi::AFTER_DRAIN) { E.fused(acc, cur, wr, wc, fr, fq, lds, wid, lane); S.done(cur); }
#undef PG8_SA
#undef PG8_SB
#undef PG8_STAGE
#undef PG8_LDA
#undef PG8_LDB
#undef PG8_MMA
#undef PG8_WAIT_V
#undef PG8_WAIT_L
#undef PG8_BAR
#undef PG8_SCHED
}
}
namespace pg8 {
struct EpiResid {
    static constexpr bool PERM = false, AFTER_DRAIN = false;
    const float* base; float* out; int ldc;
    __device__ __forceinline__ void operator()(const f32x4 (&acc)[2][2][4][2], const Unit& u, int wr, int wc, int fr, int fq) const {
        const int col0 = u.pn * BM + wc * 32 + 4 * fq;
#pragma unroll
        for (int ai = 0; ai < 2; ++ai)
#pragma unroll
            for (int m = 0; m < 4; ++m) { const size_t off = (size_t)(u.pm * BM + ai * HALF + wr * 64 + m * 16 + fr) * ldc + col0;
#pragma unroll
                for (int bj = 0; bj < 2; ++bj)
#pragma unroll
                    for (int n = 0; n < 2; ++n) { const f32x4 b = *(const f32x4*)(base + off + bj * HALF + n * 16); *(f32x4*)(out + off + bj * HALF + n * 16) = b + acc[ai][bj][m][n]; } }
    }
};
}
constexpr int NWAVES = 8, NTHR = 512;
constexpr int BATCH = 2, T = 8192, D = 1024, M = BATCH * T, MH = T;
constexpr int NIN = 3728, NPAD = 3840;
constexpr int C_GQ = 0, C_GK = 256, C_GV = 512, C_GLR = 1024, C_GG = 1040, C_R = 1552, C_K = 2064, C_V = 2576, C_WL = 3088, C_AL = 3152, C_RG = 3216;
constexpr size_t MiB = 1u << 20;
constexpr size_t WS_WIN = 1 * MiB, WIN_BYTES = (size_t)NPAD * D * 2;
constexpr size_t WS_WOUT = 16 * MiB, WOUT_BYTES = (size_t)D * D * 2;
constexpr size_t WS_XN = 20 * MiB;
constexpr size_t WS_U = 52 * MiB;
constexpr size_t WS_PR = 112 * MiB, PR_BYTES = (size_t)MH * 512 * 4;
constexpr size_t WS_Y = 208 * MiB, WS_LA = 224 * MiB, WS_O = 232 * MiB, WS_BON = 248 * MiB, WS_END = 249 * MiB;
constexpr int LDS_BYTES = 147456;

typedef unsigned short bf16;
typedef unsigned v4u __attribute__((ext_vector_type(4)));
typedef float f32x4 __attribute__((ext_vector_type(4)));
#define LDS_WAIT() asm volatile("s_waitcnt lgkmcnt(0)" ::: "memory")
__device__ __forceinline__ float bf2f(unsigned h) { return __uint_as_float(h << 16); }
__device__ __forceinline__ unsigned f2bf(float f) { unsigned u = __float_as_uint(f); return (u + 0x7fffu + ((u >> 16) & 1u)) >> 16; }
__device__ __forceinline__ unsigned pk2(float lo, float hi) { return f2bf(lo) | (f2bf(hi) << 16); }
__device__ __forceinline__ float wave_sum(float v) {
#pragma unroll
    for (int o = 1; o < 64; o <<= 1) v += __shfl_xor(v, o);
    return v;
}
__device__ __forceinline__ float sigm(float x) { return 1.f / (1.f + __expf(-x)); }
__device__ __forceinline__ float rl(float v, int l) { return __int_as_float(__builtin_amdgcn_readlane(__float_as_int(v), l)); }

struct Args { const float* in[18]; float* out; unsigned char* ws; };

__device__ __forceinline__ void transpose_item(const float* W, int K, int N, int Npad, bf16* WT, float* scr, int item, int lane) {
    const int nblk = Npad / 32, kb = item / nblk, nb = item % nblk, k0 = 64 * kb, n0 = 32 * nb;
    const int n = n0 + (lane & 31);
#pragma unroll 8
    for (int i = 0; i < 32; ++i) { const int kk = 2 * i + (lane >> 5); scr[kk * 33 + (lane & 31)] = (n < N) ? W[(size_t)(k0 + kk) * N + n] : 0.f; }
    LDS_WAIT();
    const int c = lane & 7;
#pragma unroll
    for (int j = 0; j < 4; ++j) { const int nn = (lane >> 3) + 8 * j; const float* s = scr + (8 * c) * 33 + nn;
        v4u o; o.x = pk2(s[0 * 33], s[1 * 33]); o.y = pk2(s[2 * 33], s[3 * 33]); o.z = pk2(s[4 * 33], s[5 * 33]); o.w = pk2(s[6 * 33], s[7 * 33]);
        *(v4u*)(WT + (size_t)(n0 + nn) * K + k0 + 8 * c) = o; }
    LDS_WAIT();
}
__device__ __forceinline__ void rms_row(const float* xrow, const float* w, bf16* obf, float* of32, int lane) {
    const f32x4* xr = (const f32x4*)xrow + lane; const f32x4* wr = (const f32x4*)w + lane;
    f32x4 v[4]; float s = 0.f;
#pragma unroll
    for (int j = 0; j < 4; ++j) { v[j] = xr[64 * j]; s += (v[j].x * v[j].x + v[j].y * v[j].y) + (v[j].z * v[j].z + v[j].w * v[j].w); }
    const float rs = rsqrtf(wave_sum(s) * (1.f / D) + 1e-6f);
#pragma unroll
    for (int j = 0; j < 4; ++j) { const f32x4 ww = wr[64 * j]; f32x4 o = v[j] * rs * ww;
        if (of32) ((f32x4*)of32 + lane)[64 * j] = o;
        else ((unsigned long long*)obf + lane)[64 * j] = (unsigned long long)pk2(o.x, o.y) | ((unsigned long long)pk2(o.z, o.w) << 32); }
}

__device__ __forceinline__ void prep_phase(const Args& a, int l, unsigned char* ldsb, int tid, int wave, int lane) {
    asm volatile("" : "+v"(lane), "+v"(tid));
    const bf16* U = (const bf16*)(a.ws + WS_U);
    float* PR = (float*)(a.ws + WS_PR); float* R_ = PR, *K_ = PR + (size_t)MH * 512, *V_ = PR + (size_t)MH * 1024, *KK_ = PR + (size_t)MH * 1536, *A_ = PR + (size_t)MH * 2048, *LW_ = PR + (size_t)MH * 2560;
    float* LA = (float*)(a.ws + WS_LA); float* BON = (float*)(a.ws + WS_BON);
    const float* mu = a.in[6] + l * 1664; const float* w_up = a.in[8] + l * 64 * 512; const float* a_up = a.in[10] + l * 64 * 512;
    const int c = tid;
    float* sh = (float*)ldsb;
    float* xwb = (float*)(ldsb + 16384);
    {
        const int j = tid & 127; const float mu_l = mu[1536 + j];
#pragma unroll 1
        for (int i4 = 0; i4 < 8; ++i4) { const int i = i4 * 4 + (tid >> 7); const int lr = blockIdx.x * 32 + i;
            const bf16* urow = U + (size_t)lr * NPAD; const int col = C_WL + j; const float cur = bf2f(urow[col]); const float prev = lr > 0 ? bf2f(urow[col - NPAD]) : 0.f;
            float mv = cur + (prev - cur) * mu_l; if (j < 64) mv = tanhf(mv); sh[i * 128 + j] = mv; }
    }
    __syncthreads();
    {
        float wup[64];
#pragma unroll
        for (int r = 0; r < 64; ++r) wup[r] = w_up[r * 512 + c];
        const float w0c = a.in[7][l * 512 + c];
#pragma unroll 1
        for (int i = 0; i < 32; ++i) { const float* s = sh + i * 128; float xw = w0c;
#pragma unroll
            for (int r0 = 0; r0 < 64; r0 += 4) { const f32x4 s0 = *(const f32x4*)(s + r0); xw += s0.x * wup[r0] + s0.y * wup[r0 + 1] + s0.z * wup[r0 + 2] + s0.w * wup[r0 + 3]; }
            xwb[i * 512 + c] = xw; }
    }
    asm volatile("" ::: "memory");
    float aup[64];
#pragma unroll
    for (int r = 0; r < 64; ++r) aup[r] = a_up[r * 512 + c];
    const float mu_r = mu[c], mu_k = mu[512 + c], mu_v = mu[1024 + c];
    const float a0c = a.in[9][l * 512 + c], kkc = a.in[11][l * 512 + c], kac = a.in[12][l * 512 + c], rkc = a.in[13][l * 512 + c];
#pragma unroll 1
    for (int i = 0; i < 32; ++i) {
        const int lr = blockIdx.x * 32 + i;
        const bf16* urow = U + (size_t)lr * NPAD; const bf16* prow = urow - NPAD;
        const float* s = sh + i * 128 + 64;
        float xa = a0c;
#pragma unroll
        for (int r0 = 0; r0 < 64; r0 += 4) { const f32x4 s0 = *(const f32x4*)(s + r0); xa += s0.x * aup[r0] + s0.y * aup[r0 + 1] + s0.z * aup[r0 + 2] + s0.w * aup[r0 + 3]; }
        const float xw = xwb[i * 512 + c];
        const float lw = -0.60653065971f * sigm(xw), av = sigm(xa);
        const float rc = bf2f(urow[C_R + c]), kc = bf2f(urow[C_K + c]), vc = bf2f(urow[C_V + c]);
        const float rp = lr > 0 ? bf2f(prow[C_R + c]) : 0.f, kp = lr > 0 ? bf2f(prow[C_K + c]) : 0.f, vp = lr > 0 ? bf2f(prow[C_V + c]) : 0.f;
        const float r = rc + (rp - rc) * mu_r, k = kc + (kp - kc) * mu_k, v = vc + (vp - vc) * mu_v;
        float kk = k * kkc; const float nn = wave_sum(kk * kk); kk = kk / fmaxf(sqrtf(nn), 1e-12f);
        const float k2 = k * (1.f + (av - 1.f) * kac);
        const float bon = wave_sum(r * k2 * rkc);
        const size_t o = (size_t)lr * 512 + c;
        R_[o] = r; K_[o] = k2; V_[o] = v; KK_[o] = kk; A_[o] = av; LW_[o] = lw;
        if (lane == 0) BON[lr * 8 + wave] = bon;
    }
    asm volatile("" ::: "memory");
    if (tid < 256) {
        float gup[16]; const float gb = a.in[4][l * 256 + tid];
#pragma unroll
        for (int r = 0; r < 16; ++r) gup[r] = a.in[3][l * 16 * 256 + r * 256 + tid];
#pragma unroll 1
        for (int i = 0; i < 32; ++i) { const int lr = blockIdx.x * 32 + i; const bf16* urow = U + (size_t)lr * NPAD;
            const v4u g0 = *(const v4u*)(urow + C_GLR), g1 = *(const v4u*)(urow + C_GLR + 8);
            const unsigned gw[8] = {g0.x, g0.y, g0.z, g0.w, g1.x, g1.y, g1.z, g1.w};
            float x = gb;
#pragma unroll
            for (int r2 = 0; r2 < 8; ++r2) { x += bf2f(gw[r2] & 0xffffu) * gup[2 * r2] + bf2f(gw[r2] >> 16) * gup[2 * r2 + 1]; }
            const float ls = fminf(x, 0.f) - log1pf(__expf(-fabsf(x)));
            LA[(size_t)lr * 256 + tid] = ls * (1.f / 16.f); }
    }
    __syncthreads();
}

__device__ __forceinline__ void rwkv_scan_simple(const Args& a, int h, int lane) {
    asm volatile("" : "+v"(lane));
    const float* PR = (const float*)(a.ws + WS_PR); const float* R_ = PR, *K_ = PR + (size_t)MH * 512, *V_ = PR + (size_t)MH * 1024, *KK_ = PR + (size_t)MH * 1536, *A_ = PR + (size_t)MH * 2048, *LW_ = PR + (size_t)MH * 2560;
    float* Y = (float*)(a.ws + WS_Y);
    float S[64];
#pragma unroll
    for (int d = 0; d < 64; ++d) S[d] = 0.f;
    size_t o = (size_t)h * 64 + lane;
    float kkn = KK_[o], lwn = LW_[o], an = A_[o], kn = K_[o], rn = R_[o], vn = V_[o];
    for (int t = 0; t < T; ++t) {
        const float kkl = kkn, wl = __expf(lwn), kal = kkn * an, kl = kn, rl_ = rn, ve = vn;
        const size_t oc = o;
        if (t + 1 < T) { o += 512; kkn = KK_[o]; lwn = LW_[o]; an = A_[o]; kn = K_[o]; rn = R_[o]; vn = V_[o]; }
        float sa = 0.f;
#pragma unroll
        for (int d = 0; d < 64; ++d) sa += S[d] * rl(kkl, d);
        const float nsa = -sa; float y = 0.f;
#pragma unroll
        for (int d = 0; d < 64; ++d) { S[d] = S[d] * rl(wl, d) + nsa * rl(kal, d) + ve * rl(kl, d); y += S[d] * rl(rl_, d); }
        Y[oc] = y;
    }
}
__device__ __forceinline__ void gla_scan_simple(const Args& a, int h, int e, int lane) {
    asm volatile("" : "+v"(lane), "+v"(e));
    const bf16* U = (const bf16*)(a.ws + WS_U); const float* LA = (const float*)(a.ws + WS_LA); float* O = (float*)(a.ws + WS_O);
    float S[64];
#pragma unroll
    for (int d = 0; d < 64; ++d) S[d] = 0.f;
    float lan = LA[h * 64 + lane]; unsigned kn = U[C_GK + h * 64 + lane], qn = U[C_GQ + h * 64 + lane], vn = U[C_GV + h * 128 + e];
    for (int t = 0; t < T; ++t) {
        const float al = __expf(lan), kl = bf2f(kn), ql = 0.125f * bf2f(qn), ve = bf2f(vn);
        if (t + 1 < T) { const bf16* ur = U + (size_t)(t + 1) * NPAD; lan = LA[(size_t)(t + 1) * 256 + h * 64 + lane]; kn = ur[C_GK + h * 64 + lane]; qn = ur[C_GQ + h * 64 + lane]; vn = ur[C_GV + h * 128 + e]; }
        float ov = 0.f;
#pragma unroll
        for (int d = 0; d < 64; ++d) { S[d] = S[d] * rl(al, d) + rl(kl, d) * ve; ov += rl(ql, d) * S[d]; }
        O[(size_t)t * 512 + h * 128 + e] = ov;
    }
}

__device__ __forceinline__ void merge_phase(const Args& a, int l, int hb, unsigned char* ldsb, int tid, int wave, int lane) {
    const bf16* U = (const bf16*)(a.ws + WS_U); const float* V_ = (const float*)(a.ws + WS_PR) + (size_t)MH * 1024;
    const float* Y = (const float*)(a.ws + WS_Y); const float* O = (const float*)(a.ws + WS_O); const float* BON = (const float*)(a.ws + WS_BON);
    bf16* MG = (bf16*)(a.ws + WS_XN) + (size_t)hb * MH * D;
    int c_ = tid; asm volatile("" : "+v"(c_), "+v"(lane)); const int c = c_;
    const float lnw = a.in[14][l * 512 + c], lnb = a.in[15][l * 512 + c], gnw = a.in[5][l * 128 + (c & 127)];
    float* sh = (float*)ldsb;
    for (int i = 0; i < 32; ++i) {
        const int lr = blockIdx.x * 32 + i; const bf16* urow = U + (size_t)lr * NPAD; const size_t o = (size_t)lr * 512 + c;
        const float y = Y[o]; const float mean = wave_sum(y) * (1.f / 64.f); const float dd = y - mean; const float var = wave_sum(dd * dd) * (1.f / 64.f);
        const float yn = dd * rsqrtf(var + 64e-5f) * lnw + lnb;
        const float rg = bf2f(urow[C_RG + c]);
        const float ro = (yn + BON[lr * 8 + wave] * V_[o]) * rg * sigm(rg);
        const float ov = O[o]; const float ss = wave_sum(ov * ov);
        if (lane == 0) sh[(i & 1) * 8 + wave] = ss;
        __syncthreads();
        const float tot = sh[(i & 1) * 8 + (wave & ~1)] + sh[(i & 1) * 8 + (wave | 1)];
        const float gg = bf2f(urow[C_GG + c]);
        const float go = ov * rsqrtf(tot * (1.f / 128.f) + 1e-6f) * gnw * gg * sigm(gg);
        MG[(size_t)lr * D + c] = (bf16)f2bf(go); MG[(size_t)lr * D + 512 + c] = (bf16)f2bf(ro);
    }
}

__global__ void __launch_bounds__(NTHR, 2) hymba_fwd(Args a) {
    extern __shared__ __attribute__((aligned(16))) unsigned char lds[];
    cg::grid_group grid = cg::this_grid();
    const int tid = threadIdx.x, lane = tid & 63, wave = __builtin_amdgcn_readfirstlane(tid >> 6);
    const int G = gridDim.x, gw = blockIdx.x * NWAVES + wave, NGW = G * NWAVES;
    bf16* XN = (bf16*)(a.ws + WS_XN); bf16* U = (bf16*)(a.ws + WS_U);
    {
        float* scr = (float*)lds + wave * (64 * 33);
        constexpr int I_IN = (D / 64) * (NPAD / 32), I_OUT = (D / 64) * (D / 32);
        for (int it = gw; it < 2 * (I_IN + I_OUT); it += NGW) {
            int r = it; const int l = r / (I_IN + I_OUT); r -= l * (I_IN + I_OUT);
            if (r < I_IN) transpose_item(a.in[2] + (size_t)l * D * NIN, D, NIN, NPAD, (bf16*)(a.ws + WS_WIN + l * WIN_BYTES), scr, r, lane);
            else transpose_item(a.in[16] + (size_t)l * D * D, D, D, D, (bf16*)(a.ws + WS_WOUT + l * WOUT_BYTES), scr, r - I_IN, lane);
        }
        for (int m = gw; m < M; m += NGW) rms_row(a.in[0] + (size_t)m * D, a.in[1], XN + (size_t)m * D, nullptr, lane);
    }
    grid.sync();
    for (int l = 0; l < 2; ++l) {
        for (int hb = 0; hb < 2; ++hb) {
            {
                pg8::Gemm g{XN + (size_t)hb * MH * D, (const bf16*)(a.ws + WS_WIN + l * WIN_BYTES), MH, NPAD, D}; pg8::StaticOrder S; S.init(MH, NPAD, G, (int)blockIdx.x);
                pg8::EpiBf16<0> E{U, NPAD, nullptr, 0, 0, 1.f};
                pg8::gemm_phase<pg8::EpiBf16<0>, pg8::StaticOrder, true, true>((PG8_LAS unsigned char*)lds, g, S, E);
            }
            grid.sync();
            prep_phase(a, l, lds, tid, wave, lane);
            grid.sync();
            if (blockIdx.x < 8) { if (wave == 0) rwkv_scan_simple(a, blockIdx.x, lane); }
            else if (blockIdx.x < 12) { if (wave < 2) gla_scan_simple(a, blockIdx.x - 8, tid, lane); }
            grid.sync();
            merge_phase(a, l, hb, lds, tid, wave, lane);
            grid.sync();
        }
        {
            pg8::Gemm g{XN, (const bf16*)(a.ws + WS_WOUT + l * WOUT_BYTES), M, D, D}; pg8::StaticOrder S; S.init(M, D, G, (int)blockIdx.x);
            pg8::EpiResid E{l == 0 ? a.in[0] : a.out, a.out, D};
            pg8::gemm_phase<pg8::EpiResid, pg8::StaticOrder, true, true>((PG8_LAS unsigned char*)lds, g, S, E);
        }
        grid.sync();
        if (l == 0) { for (int m = gw; m < M; m += NGW) rms_row(a.out + (size_t)m * D, a.in[1] + D, XN + (size_t)m * D, nullptr, lane); grid.sync(); }
        else { for (int m = gw; m < M; m += NGW) rms_row(a.out + (size_t)m * D, a.in[17], nullptr, a.out + (size_t)m * D, lane); }
    }
}

extern "C" void kernel_launch(void* const* d_in, const int* in_sizes, int n_in, void* d_out, int out_size, void* d_ws, size_t ws_size, hipStream_t stream) {
    static int grid = 0;
    if (grid == 0) {
        if (n_in != 18 || out_size != M * D || ws_size < WS_END) { fprintf(stderr, "kernel_launch: unexpected shapes n_in %d out %d ws %zu\n", n_in, out_size, ws_size); grid = -1; return; }
        int dev = 0, cus = 0, per_cu = 0;
        hipGetDevice(&dev); hipDeviceGetAttribute(&cus, hipDeviceAttributeMultiprocessorCount, dev);
        if (hipFuncSetAttribute((const void*)hymba_fwd, hipFuncAttributeMaxDynamicSharedMemorySize, LDS_BYTES) != hipSuccess) { fprintf(stderr, "kernel_launch: hipFuncSetAttribute failed\n"); grid = -1; return; }
        if (hipOccupancyMaxActiveBlocksPerMultiprocessor(&per_cu, (const void*)hymba_fwd, NTHR, LDS_BYTES) != hipSuccess || per_cu < 1) { fprintf(stderr, "kernel_launch: occupancy query failed (%d)\n", per_cu); grid = -1; return; }
        grid = cus * 1;
        fprintf(stderr, "kernel_launch: cus %d per_cu %d grid %d\n", cus, per_cu, grid);
    }
    if (grid < 0) return;
    Args a{};
    for (int i = 0; i < 18; ++i) a.in[i] = (const float*)d_in[i];
    a.out = (float*)d_out; a.ws = (unsigned char*)d_ws;
    void* args[] = {&a};
    hipError_t e = hipLaunchCooperativeKernel((const void*)hymba_fwd, dim3(grid), dim3(NTHR), args, LDS_BYTES, stream);
    if (e != hipSuccess) fprintf(stderr, "cooperative launch failed: %s (grid %d)\n", hipGetErrorString(e), grid);
}
```

```cpp
#include <hip/hip_runtime.h>
#include <hip/hip_cooperative_groups.h>
#include <cstdio>
#include <cstdint>
namespace cg = cooperative_groups;
namespace pg8 {
#define PG8_LAS __attribute__((address_space(3)))
typedef unsigned short bf16_t;
typedef short bf16x8 __attribute__((ext_vector_type(8)));
typedef float f32x4 __attribute__((ext_vector_type(4)));
typedef unsigned u32x4 __attribute__((ext_vector_type(4)));
constexpr int BM = 256, BK = 64, HALF = 128, HTB = HALF * BK * 2  , STAGE_BYTES = 8 * HTB, NXCD = 8, WGM = 8;

__host__ __device__ __forceinline__ int lds_byte(int r, int c) { const int st = (r >> 4) * 2 + (c >> 5), rr = r & 15, cc = c & 31, ob = rr * 64 + cc * 2; return st * 1024 + (ob ^ (((ob >> 9) & 1) << 5)); }
__host__ __device__ __forceinline__ void stage_rc(int b, int& R, int& C) { const int st = b / 1024, sb = b % 1024, swz = sb ^ (((sb >> 9) & 1) << 5); R = (st >> 1) * 16 + swz / 64; C = (st & 1) * 32 + (swz % 64) / 2; }
__host__ __device__ __forceinline__ int perm32(int rho) { const int n = rho >> 4, i = rho & 15; return 8 * (i >> 2) + 4 * n + (i & 3); }

struct Unit { int pm, pn; };
struct Gemm { const bf16_t* A; const bf16_t* Bt; int M, N, K; };

struct StaticOrder {
    int nM, nN, nwg, G, c;
    __host__ __device__ void init(int M, int N, int G_, int c_) { nM = M / BM; nN = N / BM; nwg = nM * nN; G = G_; c = c_; }
    __host__ __device__ bool next(int i, Unit& u) const {
        const long L = (long)i * G + c; if (L >= nwg) return false;
        int wgid = (int)L; { const int q = nwg / NXCD, r = nwg % NXCD, xcd = wgid % NXCD, off = wgid / NXCD; wgid = (xcd < r ? xcd * (q + 1) : r * (q + 1) + (xcd - r) * q) + off; }
        const int nig = WGM * nN, gid = wgid / nig, fm = gid * WGM, gsz = (nM - fm) < WGM ? (nM - fm) : WGM;
        u.pm = fm + ((wgid % nig) % gsz); u.pn = (wgid % nig) / gsz; return true;
    }
    __device__ __forceinline__ void a_ready(const Unit&) const {}
    __device__ __forceinline__ void done(const Unit&) const {}
};

__device__ __forceinline__ unsigned cvt_pk_bf16(float lo, float hi) { unsigned r; asm volatile("v_cvt_pk_bf16_f32 %0, %1, %2" : "=v"(r) : "v"(lo), "v"(hi)); return r; }
typedef float f32x2 __attribute__((ext_vector_type(2)));
__device__ __forceinline__ f32x2 gelu_pk(f32x2 v) {
    const f32x2 av = __builtin_elementwise_abs(v), d = av * 0.2316418882f + 1.0f;
    f32x2 t; t.x = __builtin_amdgcn_rcpf(d.x); t.y = __builtin_amdgcn_rcpf(d.y);
    f32x2 q = t * 0.5307027145f + (-0.7265760135f); q = q * t + 0.7107068705f; q = q * t + (-0.142248368f); q = q * t + 0.127414796f; q = q * t;
    const f32x2 s = (v * v) * (-0.72134752044f);
    f32x2 e; e.x = __builtin_amdgcn_exp2f(s.x); e.y = __builtin_amdgcn_exp2f(s.y);
    const f32x2 m = v * (q * e), r = v - m;
    f32x2 o; o.x = v.x < 0.f ? m.x : r.x; o.y = v.y < 0.f ? m.y : r.y; return o;
}

template <int ACT  > struct EpiBf16 {
    static constexpr bool PERM = true, AFTER_DRAIN = false; static_assert(ACT == 0 || ACT == 1, "EpiBf16: ACT is 0 (none) or 1 (gelu_pk)");
    bf16_t* O; int ldc; const float* bias; int split_cols; size_t split_stride; float scale0;
    __device__ __forceinline__ void operator()(const f32x4 (&acc)[2][2][4][2], const Unit& u, int wr, int wc, int fr, int fq) const {
        const int row0 = u.pm * BM + wr * 64 + fr; int colt = u.pn * BM; bf16_t* base = O;
        float sc = 1.f; if (split_cols) { const int t = colt / split_cols; base += (size_t)t * split_stride; colt -= t * split_cols; if (t == 0) sc = scale0; }
        const int col0 = colt + wc * 32 + 8 * fq, bcol0 = u.pn * BM + wc * 32 + 8 * fq;
        f32x4 bv[2][2];
#pragma unroll
        for (int bj = 0; bj < 2; ++bj)
#pragma unroll
            for (int n = 0; n < 2; ++n) bv[bj][n] = bias ? *(const f32x4*)(bias + bcol0 + bj * HALF + 4 * n) : (f32x4){0.f, 0.f, 0.f, 0.f};
#pragma unroll
        for (int ai = 0; ai < 2; ++ai)
#pragma unroll
            for (int m = 0; m < 4; ++m) { bf16_t* rowp = base + (size_t)(row0 + ai * HALF + m * 16) * ldc + col0;
#pragma unroll
                for (int bj = 0; bj < 2; ++bj) { f32x4 v0 = acc[ai][bj][m][0] + bv[bj][0], v1 = acc[ai][bj][m][1] + bv[bj][1];
                    if (ACT == 1) { f32x2 a = gelu_pk((f32x2){v0[0], v0[1]}), b = gelu_pk((f32x2){v0[2], v0[3]}), c = gelu_pk((f32x2){v1[0], v1[1]}), d = gelu_pk((f32x2){v1[2], v1[3]});
                        v0 = (f32x4){a.x, a.y, b.x, b.y}; v1 = (f32x4){c.x, c.y, d.x, d.y}; }
                    v0 = v0 * sc; v1 = v1 * sc; u32x4 w; w.x = cvt_pk_bf16(v0[0], v0[1]); w.y = cvt_pk_bf16(v0[2], v0[3]); w.z = cvt_pk_bf16(v1[0], v1[1]); w.w = cvt_pk_bf16(v1[2], v1[3]);
                    *(u32x4*)(rowp + bj * HALF) = w; } }
    }
};

template <class Epi, class Sched, bool ALIGN_EPI = false, bool SP2 = false>
__device__ __forceinline__ void gemm_phase(PG8_LAS unsigned char* lds, const Gemm g, const Sched& S, const Epi& E) {
    int tid_ = threadIdx.x; asm volatile("" : "+v"(tid_));
    const int tid = tid_, wid = __builtin_amdgcn_readfirstlane(tid >> 6), lane = tid & 63, wr = wid >> 2, wc = wid & 3, fr = lane & 15, fq = lane >> 4;
    const int K = g.K, nt = K / BK;
    unsigned voffA[2], voffB[2];
#pragma unroll
    for (int i = 0; i < 2; ++i) { int R, C; stage_rc(tid * 16 + i * 8192, R, C); const int Rb = Epi::PERM ? ((R & ~31) + perm32(R & 31)) : R;
        voffA[i] = (unsigned)(R * K + C) * 2u; voffB[i] = (unsigned)(Rb * K + C) * 2u; }
    const size_t kstep = (size_t)(BK * 2);
    const size_t hstep = (size_t)HALF * K * 2;
    const size_t tstep = 2 * hstep;
    const unsigned ldsw = (unsigned)wid * 1024u;
    const int aoff = lds_byte(wr * 64 + fr, fq * 8), boff = lds_byte(wc * 32 + fr, fq * 8);
#define PG8_SA(b, h) (((b) * 2 + (h)) * HTB)
#define PG8_SB(b, h) ((4 + (b) * 2 + (h)) * HTB)
#define PG8_STAGE(bufoff, gbase, voff) do { _Pragma("unroll") for (int _i = 0; _i < 2; ++_i) \
        __builtin_amdgcn_global_load_lds((const unsigned*)((const char*)(gbase) + (voff)[_i]), (PG8_LAS unsigned*)(lds + (bufoff) + ldsw + _i * 8192), 16, 0, 0); } while (0)
#define PG8_LDA(dst, b, h) do { _Pragma("unroll") for (int m = 0; m < 4; ++m) _Pragma("unroll") for (int k = 0; k < 2; ++k) dst[m][k] = *(const PG8_LAS bf16x8*)(lds + PG8_SA(b, h) + aoff + m * 2048 + k * 1024); } while (0)
#define PG8_LDB(dst, b, h) do { _Pragma("unroll") for (int n = 0; n < 2; ++n) _Pragma("unroll") for (int k = 0; k < 2; ++k) dst[n][k] = *(const PG8_LAS bf16x8*)(lds + PG8_SB(b, h) + boff + n * 2048 + k * 1024); } while (0)
#define PG8_MMA(ai, bj, At, Bt) do { __builtin_amdgcn_s_setprio(1); _Pragma("unroll") for (int m = 0; m < 4; ++m) _Pragma("unroll") for (int n = 0; n < 2; ++n) _Pragma("unroll") for (int k = 0; k < 2; ++k) \
        acc[ai][bj][m][n] = __builtin_amdgcn_mfma_f32_16x16x32_bf16(Bt[n][k], At[m][k], acc[ai][bj][m][n], 0, 0, 0); __builtin_amdgcn_s_setprio(0); } while (0)
#define PG8_WAIT_V(n) asm volatile("s_waitcnt vmcnt(" #n ")" ::: "memory")
#define PG8_WAIT_L(n) asm volatile("s_waitcnt lgkmcnt(" #n ")" ::: "memory")
#define PG8_BAR __builtin_amdgcn_s_barrier()
#define PG8_SCHED __builtin_amdgcn_sched_barrier(0)
    Unit cur, nxt; int ui = 0;
    if (!S.next(0, cur)) return;
    f32x4 acc[2][2][4][2];
#pragma unroll
    for (int a = 0; a < 2; ++a)
#pragma unroll
        for (int b = 0; b < 2; ++b)
#pragma unroll
            for (int m = 0; m < 4; ++m)
#pragma unroll
                for (int n = 0; n < 2; ++n) acc[a][b][m][n] = (f32x4){0.f, 0.f, 0.f, 0.f};
    bf16x8 At[4][2], B0[2][2], B1[2][2];
    const char* cA = (const char*)g.A + (size_t)cur.pm * tstep; const char* cB = (const char*)g.Bt + (size_t)cur.pn * tstep;
    S.a_ready(cur);
    if constexpr (SP2) {
        PG8_STAGE(PG8_SB(0, 0), cB, voffB); PG8_STAGE(PG8_SB(0, 1), cB + hstep, voffB); PG8_STAGE(PG8_SA(0, 0), cA, voffA); PG8_STAGE(PG8_SA(0, 1), cA + hstep, voffA);
        if (wr == 1) PG8_BAR;
        PG8_WAIT_V(2); PG8_BAR;
        PG8_STAGE(PG8_SB(1, 0), cB + kstep, voffB); PG8_STAGE(PG8_SA(1, 0), cA + kstep, voffA); PG8_STAGE(PG8_SB(1, 1), cB + hstep + kstep, voffB);
        PG8_WAIT_V(6); PG8_BAR;
    } else {
        PG8_STAGE(PG8_SB(0, 0), cB, voffB); PG8_STAGE(PG8_SA(0, 0), cA, voffA); PG8_STAGE(PG8_SB(0, 1), cB + hstep, voffB); PG8_STAGE(PG8_SA(0, 1), cA + hstep, voffA);
        if (wr == 1) PG8_BAR;
        PG8_WAIT_V(4); PG8_BAR;
        PG8_STAGE(PG8_SB(1, 0), cB + kstep, voffB); PG8_STAGE(PG8_SA(1, 0), cA + kstep, voffA); PG8_STAGE(PG8_SB(1, 1), cB + hstep + kstep, voffB);
        PG8_WAIT_V(6); PG8_BAR;
    }
    for (;;) {
        const bool has_next = S.next(ui + 1, nxt);
        const char* nA = has_next ? (const char*)g.A + (size_t)nxt.pm * tstep : cA; const char* nB = has_next ? (const char*)g.Bt + (size_t)nxt.pn * tstep : cB;
        for (int t = 0; t < nt; t += 2) {
            const bool last = (t == nt - 2);
            const char* a1 = cA + (size_t)(t + 1) * kstep;
            const char* a2 = last ? nA : cA + (size_t)(t + 2) * kstep; const char* b2 = last ? nB : cB + (size_t)(t + 2) * kstep;
            const char* a3 = a2 + kstep; const char* b3 = b2 + kstep;
            if (last && has_next) S.a_ready(nxt);
            if constexpr (SP2) {
            PG8_LDB(B0, 0, 0); PG8_LDB(B1, 0, 1); PG8_SCHED; PG8_LDA(At, 0, 0); PG8_STAGE(PG8_SA(1, 1), a1 + hstep, voffA);
            PG8_WAIT_V(8); PG8_WAIT_L(0); PG8_BAR; PG8_MMA(0, 0, At, B0); PG8_MMA(0, 1, At, B1); PG8_BAR; PG8_SCHED;
            PG8_LDA(At, 0, 1); PG8_STAGE(PG8_SB(0, 0), b2, voffB); PG8_STAGE(PG8_SB(0, 1), b2 + hstep, voffB); PG8_STAGE(PG8_SA(0, 0), a2, voffA);
            PG8_WAIT_V(8); PG8_WAIT_L(0); PG8_BAR; PG8_MMA(1, 0, At, B0); PG8_MMA(1, 1, At, B1); PG8_BAR; PG8_SCHED;
            PG8_LDB(B0, 1, 0); PG8_LDB(B1, 1, 1); PG8_SCHED; PG8_LDA(At, 1, 0); PG8_STAGE(PG8_SA(0, 1), a2 + hstep, voffA);
            PG8_WAIT_V(8); PG8_WAIT_L(0); PG8_BAR; PG8_MMA(0, 0, At, B0); PG8_MMA(0, 1, At, B1); PG8_BAR; PG8_SCHED;
            PG8_LDA(At, 1, 1); PG8_STAGE(PG8_SB(1, 0), b3, voffB); PG8_STAGE(PG8_SB(1, 1), b3 + hstep, voffB); PG8_STAGE(PG8_SA(1, 0), a3, voffA);
            PG8_WAIT_V(8); PG8_WAIT_L(0); PG8_BAR; PG8_MMA(1, 0, At, B0); PG8_MMA(1, 1, At, B1); PG8_BAR; PG8_SCHED;
            } else {
            PG8_LDB(B0, 0, 0); PG8_SCHED; PG8_LDA(At, 0, 0); PG8_STAGE(PG8_SA(1, 1), a1 + hstep, voffA);
            PG8_WAIT_L(8); PG8_BAR; PG8_WAIT_L(0); PG8_MMA(0, 0, At, B0); PG8_BAR; PG8_SCHED;
            PG8_LDB(B1, 0, 1); PG8_STAGE(PG8_SB(0, 0), b2, voffB);
            PG8_BAR; PG8_WAIT_L(0); PG8_MMA(0, 1, At, B1); PG8_BAR;
            PG8_LDA(At, 0, 1); PG8_STAGE(PG8_SA(0, 0), a2, voffA);
            PG8_BAR; PG8_WAIT_L(0); PG8_MMA(1, 0, At, B0); PG8_BAR; PG8_SCHED;
            PG8_STAGE(PG8_SB(0, 1), b2 + hstep, voffB);
            PG8_WAIT_V(6); PG8_BAR; PG8_MMA(1, 1, At, B1); PG8_BAR;
            PG8_LDB(B0, 1, 0); PG8_SCHED; PG8_LDA(At, 1, 0); PG8_STAGE(PG8_SA(0, 1), a2 + hstep, voffA);
            PG8_WAIT_L(8); PG8_BAR; PG8_WAIT_L(0); PG8_MMA(0, 0, At, B0); PG8_BAR; PG8_SCHED;
            PG8_LDB(B1, 1, 1); PG8_STAGE(PG8_SB(1, 0), b3, voffB);
            PG8_BAR; PG8_WAIT_L(0); PG8_MMA(0, 1, At, B1); PG8_BAR;
            PG8_LDA(At, 1, 1); PG8_STAGE(PG8_SA(1, 0), a3, voffA);
            PG8_BAR; PG8_WAIT_L(0); PG8_MMA(1, 0, At, B0); PG8_BAR; PG8_SCHED;
            PG8_STAGE(PG8_SB(1, 1), b3 + hstep, voffB);
            PG8_WAIT_V(6); PG8_BAR; PG8_MMA(1, 1, At, B1); PG8_BAR;
            }
        }
        if constexpr (ALIGN_EPI) { if (wr == 0) PG8_BAR; }
        if constexpr (!Epi::AFTER_DRAIN) { E(acc, cur, wr, wc, fr, fq); S.done(cur); }
        if (!has_next) break;
#pragma unroll
        for (int a = 0; a < 2; ++a)
#pragma unroll
            for (int b = 0; b < 2; ++b)
#pragma unroll
                for (int m = 0; m < 4; ++m)
#pragma unroll
                    for (int n = 0; n < 2; ++n) acc[a][b][m][n] = (f32x4){0.f, 0.f, 0.f, 0.f};
        cur = nxt; cA = nA; cB = nB; ++ui;
        if constexpr (ALIGN_EPI) { if (wr == 1) PG8_BAR; }
    }
    PG8_WAIT_V(0);
    if constexpr (!ALIGN_EPI) { if (wr == 0) PG8_BAR; }
    PG8_BAR;
    if constexpr (Epi::AFTER_DRAIN) { E.fused(acc, cur, wr, wc, fr, fq, lds, wid, lane); S.done(cur); }
#undef PG8_SA
#undef PG8_SB
#undef PG8_STAGE
#undef PG8_LDA
#undef PG8_LDB
#undef PG8_MMA
#undef PG8_WAIT_V
#undef PG8_WAIT_L
#undef PG8_BAR
#undef PG8_SCHED
}
}
namespace pg8 {
struct EpiResid {
    static constexpr bool PERM = false, AFTER_DRAIN = false;
    const float* base; float* out; int ldc;
    __device__ __forceinline__ void operator()(const f32x4 (&acc)[2][2][4][2], const Unit& u, int wr, int wc, int fr, int fq) const {
        const int col0 = u.pn * BM + wc * 32 + 4 * fq;
#pragma unroll
        for (int ai = 0; ai < 2; ++ai)
#pragma unroll
            for (int m = 0; m < 4; ++m) { const size_t off = (size_t)(u.pm * BM + ai * HALF + wr * 64 + m * 16 + fr) * ldc + col0;
#pragma unroll
                for (int bj = 0; bj < 2; ++bj)
#pragma unroll
                    for (int n = 0; n < 2; ++n) { const f32x4 b = *(const f32x4*)(base + off + bj * HALF + n * 16); *(f32x4*)(out + off + bj * HALF + n * 16) = b + acc[ai][bj][m][n]; } }
    }
};
}
constexpr int NWAVES = 8, NTHR = 512;
constexpr int BATCH = 2, T = 8192, D = 1024, M = BATCH * T, MH = T;
constexpr int NIN = 3728, NPAD = 3840;
constexpr int C_GQ = 0, C_GK = 256, C_GV = 512, C_GLR = 1024, C_GG = 1040, C_R = 1552, C_K = 2064, C_V = 2576, C_WL = 3088, C_AL = 3152, C_RG = 3216;
constexpr size_t MiB = 1u << 20;
constexpr size_t WS_WIN = 1 * MiB, WIN_BYTES = (size_t)NPAD * D * 2;
constexpr size_t WS_WOUT = 16 * MiB, WOUT_BYTES = (size_t)D * D * 2;
constexpr size_t WS_XN = 20 * MiB;
constexpr size_t WS_U = 52 * MiB;
constexpr size_t WS_END = 256 * MiB;
constexpr int LDS_BYTES = 147456;

typedef unsigned short bf16;
typedef unsigned v4u __attribute__((ext_vector_type(4)));
typedef float f32x4 __attribute__((ext_vector_type(4)));
#define LDS_WAIT() asm volatile("s_waitcnt lgkmcnt(0)" ::: "memory")
__device__ __forceinline__ float bf2f(unsigned h) { return __uint_as_float(h << 16); }
__device__ __forceinline__ unsigned f2bf(float f) { unsigned u = __float_as_uint(f); return (u + 0x7fffu + ((u >> 16) & 1u)) >> 16; }
__device__ __forceinline__ unsigned pk2(float lo, float hi) { return f2bf(lo) | (f2bf(hi) << 16); }
__device__ __forceinline__ float wave_sum(float v) {
#pragma unroll
    for (int o = 1; o < 64; o <<= 1) v += __shfl_xor(v, o);
    return v;
}
__device__ __forceinline__ float sigm(float x) { return 1.f / (1.f + __expf(-x)); }
__device__ __forceinline__ float rl(float v, int l) { return __int_as_float(__builtin_amdgcn_readlane(__float_as_int(v), l)); }

struct Args { const float* in[18]; float* out; unsigned char* ws; };

__device__ __forceinline__ void transpose_item(const float* W, int K, int N, int Npad, bf16* WT, float* scr, int item, int lane) {
    const int nblk = Npad / 32, kb = item / nblk, nb = item % nblk, k0 = 64 * kb, n0 = 32 * nb;
    const int n = n0 + (lane & 31);
#pragma unroll 8
    for (int i = 0; i < 32; ++i) { const int kk = 2 * i + (lane >> 5); scr[kk * 33 + (lane & 31)] = (n < N) ? W[(size_t)(k0 + kk) * N + n] : 0.f; }
    LDS_WAIT();
    const int c = lane & 7;
#pragma unroll
    for (int j = 0; j < 4; ++j) { const int nn = (lane >> 3) + 8 * j; const float* s = scr + (8 * c) * 33 + nn;
        v4u o; o.x = pk2(s[0 * 33], s[1 * 33]); o.y = pk2(s[2 * 33], s[3 * 33]); o.z = pk2(s[4 * 33], s[5 * 33]); o.w = pk2(s[6 * 33], s[7 * 33]);
        *(v4u*)(WT + (size_t)(n0 + nn) * K + k0 + 8 * c) = o; }
    LDS_WAIT();
}
__device__ __forceinline__ void rms_row(const float* xrow, const float* w, bf16* obf, float* of32, int lane) {
    const f32x4* xr = (const f32x4*)xrow + lane; const f32x4* wr = (const f32x4*)w + lane;
    f32x4 v[4]; float s = 0.f;
#pragma unroll
    for (int j = 0; j < 4; ++j) { v[j] = xr[64 * j]; s += (v[j].x * v[j].x + v[j].y * v[j].y) + (v[j].z * v[j].z + v[j].w * v[j].w); }
    const float rs = rsqrtf(wave_sum(s) * (1.f / D) + 1e-6f);
#pragma unroll
    for (int j = 0; j < 4; ++j) { const f32x4 ww = wr[64 * j]; f32x4 o = v[j] * rs * ww;
        if (of32) ((f32x4*)of32 + lane)[64 * j] = o;
        else ((unsigned long long*)obf + lane)[64 * j] = (unsigned long long)pk2(o.x, o.y) | ((unsigned long long)pk2(o.z, o.w) << 32); }
}

typedef short bf16x8 __attribute__((ext_vector_type(8)));
typedef unsigned v2u __attribute__((ext_vector_type(2)));
constexpr int PITCH = 72, FP = 68, TP = 20;
constexpr int OFF_TW = 0, OFF_AL = 9216, OFF_ARK = 18432, OFF_XA = 27648, OFF_XW = 45056, OFF_AT = 63488, OFF_RT = 72704, OFF_BH = 81920, OFF_KH = 91136,
              OFF_BBT = 100352, OFF_KBT = 109568, OFF_VT = 118784, OFF_TII = 128000, OFF_TOT = 133120, OFF_BC = 135168;
constexpr int OFF_AAK = OFF_TW, OFF_ARB = OFF_AL, OFF_AAB = OFF_XA, OFF_XT = OFF_XW;
constexpr size_t WS_MC = 112 * MiB, WS_NC = 120 * MiB, WS_PP = 136 * MiB, WS_Y0 = 144 * MiB, WS_S0 = 160 * MiB, WS_DEC = 168 * MiB, WS_BON2 = 169 * MiB, WS_UPT = 170 * MiB;
constexpr int NUNIT = 1024;

__device__ __forceinline__ f32x4 mma2(const bf16* Arow, const bf16* Brow, f32x4 acc) {
    acc = __builtin_amdgcn_mfma_f32_16x16x32_bf16(*(const bf16x8*)(Arow), *(const bf16x8*)(Brow), acc, 0, 0, 0);
    acc = __builtin_amdgcn_mfma_f32_16x16x32_bf16(*(const bf16x8*)(Arow + 32), *(const bf16x8*)(Brow + 32), acc, 0, 0, 0);
    return acc;
}
__device__ __forceinline__ v2u pack4(f32x4 v) { v2u r; r.x = pk2(v.x, v.y); r.y = pk2(v.z, v.w); return r; }
__device__ __forceinline__ void unpack8(v4u w, float* o) { o[0] = bf2f(w.x & 0xffffu); o[1] = bf2f(w.x >> 16); o[2] = bf2f(w.y & 0xffffu); o[3] = bf2f(w.y >> 16);
    o[4] = bf2f(w.z & 0xffffu); o[5] = bf2f(w.z >> 16); o[6] = bf2f(w.w & 0xffffu); o[7] = bf2f(w.w >> 16); }
__device__ __forceinline__ v4u pack8(const float* v) { v4u r; r.x = pk2(v[0], v[1]); r.y = pk2(v[2], v[3]); r.z = pk2(v[4], v[5]); r.w = pk2(v[6], v[7]); return r; }

__device__ __forceinline__ void r1_phase(const Args& a, int l, unsigned char* L, int tid) {
    asm volatile("" : "+v"(tid));
    const int lane = tid & 63, wave = __builtin_amdgcn_readfirstlane(tid >> 6), g = lane >> 4, c16 = lane & 15;
    const bf16* U = (const bf16*)(a.ws + WS_U);
    bf16* TW = (bf16*)(L + OFF_TW); bf16* ALm = (bf16*)(L + OFF_AL); bf16* ARK = (bf16*)(L + OFF_ARK); bf16* AAK = (bf16*)(L + OFF_AAK); bf16* ARB = (bf16*)(L + OFF_ARB);
    float* XA = (float*)(L + OFF_XA); float* XW = (float*)(L + OFF_XW); float* AAB = (float*)(L + OFF_AAB); bf16* XT = (bf16*)(L + OFF_XT);
    bf16* AT = (bf16*)(L + OFF_AT); bf16* RT = (bf16*)(L + OFF_RT); bf16* BH = (bf16*)(L + OFF_BH); bf16* KH = (bf16*)(L + OFF_KH);
    bf16* BBT = (bf16*)(L + OFF_BBT); bf16* KBT = (bf16*)(L + OFF_KBT); bf16* VT = (bf16*)(L + OFF_VT);
    float* TII = (float*)(L + OFF_TII); float* TOT = (float*)(L + OFF_TOT); float* BC = (float*)(L + OFF_BC);
    const bf16* UPT = (const bf16*)(a.ws + WS_UPT) + (size_t)l * 2 * 512 * 64;
    const float* mu = a.in[6] + l * 1664;
#pragma unroll 1
    for (int unit = blockIdx.x; unit < NUNIT; unit += gridDim.x) {
        const int ch = unit >> 3, h = unit & 7;
        {
            const int t = tid >> 3, cg = tid & 7, lr = 64 * ch + t;
            const bf16* up = U + (size_t)lr * NPAD + C_WL + 16 * cg;
            const v4u c0 = *(const v4u*)up, c1 = *(const v4u*)(up + 8);
            v4u p0 = {0u, 0u, 0u, 0u}, p1 = {0u, 0u, 0u, 0u};
            if (lr > 0) { p0 = *(const v4u*)(up - NPAD); p1 = *(const v4u*)(up - NPAD + 8); }
            float cu[16], pr[16], o[16]; unpack8(c0, cu); unpack8(c1, cu + 8); unpack8(p0, pr); unpack8(p1, pr + 8);
            const float* mp = mu + 1536 + 16 * cg;
#pragma unroll
            for (int i = 0; i < 16; ++i) { float mv = cu[i] + (pr[i] - cu[i]) * mp[i]; if (cg < 4) mv = tanhf(mv); o[i] = mv; }
            bf16* dst = (cg < 4 ? TW : ALm) + t * PITCH + 16 * (cg & 3);
            *(v4u*)dst = pack8(o); *(v4u*)(dst + 8) = pack8(o + 8);
        }
        __syncthreads();
        {
            const int q = wave >> 2, dt = wave & 3;
            const bf16* WT = UPT + (size_t)q * 512 * 64 + (size_t)(64 * h + 16 * dt + c16) * 64 + 8 * g;
            const bf16x8 a0 = *(const bf16x8*)WT, a1 = *(const bf16x8*)(WT + 32);
            const bf16* Bm = q ? ALm : TW; float* X = q ? XA : XW;
#pragma unroll
            for (int tt = 0; tt < 4; ++tt) { const bf16* br = Bm + (16 * tt + c16) * PITCH + 8 * g; f32x4 acc = {0.f, 0.f, 0.f, 0.f};
                acc = __builtin_amdgcn_mfma_f32_16x16x32_bf16(a0, *(const bf16x8*)br, acc, 0, 0, 0);
                acc = __builtin_amdgcn_mfma_f32_16x16x32_bf16(a1, *(const bf16x8*)(br + 32), acc, 0, 0, 0);
                *(f32x4*)(X + (16 * tt + c16) * FP + 16 * dt + 4 * g) = acc; }
        }
        __syncthreads();
        const int t = tid >> 3, dg = tid & 7, d0 = 8 * dg, lr = 64 * ch + t, hc = 64 * h + d0;
        float r[8], kq[8], v[8], al[8], be[8], lw[8];
        {
            const bf16* up = U + (size_t)lr * NPAD + hc;
            float rc[8], rp[8], kc[8], kp[8], vc[8], vp[8];
            unpack8(*(const v4u*)(up + C_R), rc); unpack8(*(const v4u*)(up + C_K), kc); unpack8(*(const v4u*)(up + C_V), vc);
            if (lr > 0) { unpack8(*(const v4u*)(up + C_R - NPAD), rp); unpack8(*(const v4u*)(up + C_K - NPAD), kp); unpack8(*(const v4u*)(up + C_V - NPAD), vp); }
            else {
#pragma unroll
                for (int i = 0; i < 8; ++i) { rp[i] = 0.f; kp[i] = 0.f; vp[i] = 0.f; } }
            const float* w0p = a.in[7] + l * 512 + hc; const float* a0p = a.in[9] + l * 512 + hc; const float* kkp = a.in[11] + l * 512 + hc;
            const float* kap = a.in[12] + l * 512 + hc; const float* rkp = a.in[13] + l * 512 + hc;
            float nn = 0.f, bon = 0.f, kk[8], av[8];
#pragma unroll
            for (int i = 0; i < 8; ++i) {
                const float xw = XW[t * FP + d0 + i] + w0p[i], xa = XA[t * FP + d0 + i] + a0p[i];
                lw[i] = -0.60653065971f * sigm(xw); av[i] = sigm(xa);
                r[i] = rc[i] + (rp[i] - rc[i]) * mu[hc + i]; const float k = kc[i] + (kp[i] - kc[i]) * mu[512 + hc + i]; v[i] = vc[i] + (vp[i] - vc[i]) * mu[1024 + hc + i];
                kk[i] = k * kkp[i]; nn += kk[i] * kk[i];
                kq[i] = k * (1.f + (av[i] - 1.f) * kap[i]); bon += r[i] * kq[i] * rkp[i];
            }
            nn += __shfl_xor(nn, 1); nn += __shfl_xor(nn, 2); nn += __shfl_xor(nn, 4);
            bon += __shfl_xor(bon, 1); bon += __shfl_xor(bon, 2); bon += __shfl_xor(bon, 4);
            const float inv = 1.f / fmaxf(sqrtf(nn), 1e-12f);
#pragma unroll
            for (int i = 0; i < 8; ++i) { const float kn = kk[i] * inv; al[i] = -kn; be[i] = av[i] * kn; XW[t * FP + d0 + i] = lw[i]; }
            if (dg == 0) ((float*)(a.ws + WS_BON2))[lr * 8 + h] = bon;
        }
        __syncthreads();
        {
            const int d = tid & 63, tb = tid >> 6; float p[8]; float run = 0.f;
#pragma unroll
            for (int i = 0; i < 8; ++i) { run += XW[(8 * tb + i) * FP + d]; p[i] = run; }
            TOT[tb * 64 + d] = run;
            __syncthreads();
            float off = 0.f;
#pragma unroll
            for (int j = 0; j < 8; ++j) off += (j < tb) ? TOT[j * 64 + d] : 0.f;
#pragma unroll
            for (int i = 0; i < 8; ++i) XW[(8 * tb + i) * FP + d] = off + p[i];
            if (tb == 7) BC[d] = off + run;
        }
        __syncthreads();
        {
            float at[8], rt[8], bh[8], kh[8];
#pragma unroll
            for (int i = 0; i < 8; ++i) { const float b = XW[t * FP + d0 + i], bc = BC[d0 + i];
                const float eb = __expf(b), enb = __expf(-b), ebp = __expf(b - lw[i]), ebc = __expf(bc - b);
                at[i] = al[i] * ebp; rt[i] = r[i] * eb; bh[i] = be[i] * enb; kh[i] = kq[i] * enb;
                BBT[(d0 + i) * PITCH + t] = (bf16)f2bf(be[i] * ebc); KBT[(d0 + i) * PITCH + t] = (bf16)f2bf(kq[i] * ebc); VT[(d0 + i) * PITCH + t] = (bf16)f2bf(v[i]); }
            *(v4u*)(AT + t * PITCH + d0) = pack8(at); *(v4u*)(RT + t * PITCH + d0) = pack8(rt); *(v4u*)(BH + t * PITCH + d0) = pack8(bh); *(v4u*)(KH + t * PITCH + d0) = pack8(kh);
        }
        __syncthreads();
        {
            const int q = wave >> 1, mh = wave & 1;
            const bf16* As = (q < 2) ? AT : RT; const bf16* Bs = (q & 1) ? KH : BH;
#pragma unroll
            for (int t2 = 0; t2 < 2; ++t2) { const int tt = 2 * mh + t2; const int tcol = 16 * tt + c16;
#pragma unroll
                for (int jt = 0; jt < 4; ++jt) {
                    f32x4 acc = {0.f, 0.f, 0.f, 0.f};
                    if (jt <= tt) { acc = mma2(Bs + (16 * jt + c16) * PITCH + 8 * g, As + tcol * PITCH + 8 * g, acc);
#pragma unroll
                        for (int j = 0; j < 4; ++j) { const int jj = 16 * jt + 4 * g + j; const bool keep = (q < 2) ? (jj < tcol) : (jj <= tcol); if (!keep) acc[j] = 0.f; } }
                    if (q == 0) *(f32x4*)(AAB + tcol * FP + 16 * jt + 4 * g) = acc;
                    else { bf16* dst = (q == 1 ? AAK : (q == 2 ? ARB : ARK)); *(v2u*)(dst + tcol * PITCH + 16 * jt + 4 * g) = pack4(acc); }
                } }
        }
        __syncthreads();
        f32x4 Z[4];
        {
            if (wave == 0) { const int i = g; float Tc[16];
#pragma unroll
                for (int tr = 0; tr < 16; ++tr) { float s = (c16 == tr) ? 1.f : 0.f; const float* ar = AAB + (16 * i + tr) * FP + 16 * i;
#pragma unroll
                    for (int j = 0; j < 16; ++j) if (j < tr) s += ar[j] * Tc[j];
                    Tc[tr] = s; TII[(i * 16 + tr) * TP + c16] = s; } }
            if (wave < 4) {
#pragma unroll
                for (int i = 0; i < 4; ++i)
#pragma unroll
                    for (int j = 0; j < 4; ++j) Z[i][j] = bf2f(AT[(16 * i + 4 * g + j) * PITCH + 16 * wave + c16]);
            } else {
#pragma unroll
                for (int i = 0; i < 4; ++i) { f32x4 acc = {0.f, 0.f, 0.f, 0.f}; Z[i] = mma2(AAK + (16 * i + c16) * PITCH + 8 * g, VT + (16 * (wave - 4) + c16) * PITCH + 8 * g, acc); }
            }
        }
        __syncthreads();
        {
            f32x4 X[4];
#pragma unroll
            for (int i = 0; i < 4; ++i) { f32x4 z = Z[i];
#pragma unroll
                for (int kb = 0; kb < 4; ++kb) if (kb < i) { const f32x4 av = *(const f32x4*)(AAB + (16 * i + c16) * FP + 16 * kb + 4 * g);
#pragma unroll
                    for (int s = 0; s < 4; ++s) z = __builtin_amdgcn_mfma_f32_16x16x4f32(av[s], X[kb][s], z, 0, 0, 0); }
                const f32x4 tv = *(const f32x4*)(TII + (i * 16 + c16) * TP + 4 * g); f32x4 x = {0.f, 0.f, 0.f, 0.f};
#pragma unroll
                for (int s = 0; s < 4; ++s) x = __builtin_amdgcn_mfma_f32_16x16x4f32(tv[s], z[s], x, 0, 0, 0);
                X[i] = x; }
#pragma unroll
            for (int i = 0; i < 4; ++i) *(v2u*)(XT + (16 * wave + c16) * PITCH + 16 * i + 4 * g) = pack4(X[i]);
        }
        __syncthreads();
        {
            const int q = wave >> 1, hh = wave & 1;
            bf16* MCg = (bf16*)(a.ws + WS_MC) + (size_t)unit * 4096; float* NCg = (float*)(a.ws + WS_NC) + (size_t)unit * 4096;
            bf16* PPg = (bf16*)(a.ws + WS_PP) + (size_t)unit * 4096; float* Y0g = (float*)(a.ws + WS_Y0) + (size_t)unit * 4096;
#pragma unroll
            for (int t2 = 0; t2 < 2; ++t2) { const int ti = 2 * hh + t2;
#pragma unroll
                for (int tj = 0; tj < 4; ++tj) { f32x4 acc = {0.f, 0.f, 0.f, 0.f}; const int cc = 16 * tj + c16, rr = 16 * ti + 4 * g;
                    if (q == 0) { acc = mma2(XT + (16 * ti + c16) * PITCH + 8 * g, BBT + cc * PITCH + 8 * g, acc); *(v2u*)(MCg + cc * 64 + rr) = pack4(acc); }
                    else if (q == 1) { acc = mma2(BBT + (16 * ti + c16) * PITCH + 8 * g, XT + (64 + cc) * PITCH + 8 * g, acc); acc = mma2(KBT + (16 * ti + c16) * PITCH + 8 * g, VT + cc * PITCH + 8 * g, acc);
                        *(f32x4*)(NCg + cc * 64 + rr) = acc; }
                    else if (q == 2) { acc = mma2(XT + (16 * ti + c16) * PITCH + 8 * g, ARB + cc * PITCH + 8 * g, acc);
                        const v2u rv = *(const v2u*)(RT + cc * PITCH + rr); acc[0] += bf2f(rv.x & 0xffffu); acc[1] += bf2f(rv.x >> 16); acc[2] += bf2f(rv.y & 0xffffu); acc[3] += bf2f(rv.y >> 16);
                        *(v2u*)(PPg + cc * 64 + rr) = pack4(acc); }
                    else { acc = mma2(ARB + (16 * ti + c16) * PITCH + 8 * g, XT + (64 + cc) * PITCH + 8 * g, acc); acc = mma2(ARK + (16 * ti + c16) * PITCH + 8 * g, VT + cc * PITCH + 8 * g, acc);
                        *(f32x4*)(Y0g + cc * 64 + rr) = acc; }
                } }
            if (tid < 64) ((float*)(a.ws + WS_DEC))[unit * 64 + tid] = __expf(BC[tid]);
        }
        __syncthreads();
    }
}

__device__ __forceinline__ void r2_scan(const Args& a, int chain, int lane) {
    asm volatile("" : "+v"(lane));
    const int h = chain >> 2, e0 = 16 * (chain & 3), g = lane >> 4, c16 = lane & 15;
    const bf16* MC = (const bf16*)(a.ws + WS_MC); const float* NC = (const float*)(a.ws + WS_NC); const float* DEC = (const float*)(a.ws + WS_DEC); bf16* S0 = (bf16*)(a.ws + WS_S0);
    f32x4 S[4];
#pragma unroll
    for (int m = 0; m < 4; ++m) S[m] = (f32x4){0.f, 0.f, 0.f, 0.f};
    v2u An[4][4]; f32x4 Nn[4], Dn[4];
    {
        const size_t ub = (size_t)h * 4096;
#pragma unroll
        for (int mt = 0; mt < 4; ++mt) {
#pragma unroll
            for (int p = 0; p < 4; ++p) An[mt][p] = *(const v2u*)(MC + ub + (16 * mt + c16) * 64 + 16 * p + 4 * g);
            Nn[mt] = *(const f32x4*)(NC + ub + (e0 + c16) * 64 + 16 * mt + 4 * g); Dn[mt] = *(const f32x4*)(DEC + (size_t)h * 64 + 16 * mt + 4 * g); }
    }
#pragma unroll 1
    for (int c = 0; c < 128; ++c) {
        const size_t ub = (size_t)(c * 8 + h) * 4096;
        v2u Ac[4][4]; f32x4 Ncur[4], Dc[4];
#pragma unroll
        for (int mt = 0; mt < 4; ++mt) { Ncur[mt] = Nn[mt]; Dc[mt] = Dn[mt];
#pragma unroll
            for (int p = 0; p < 4; ++p) Ac[mt][p] = An[mt][p]; }
        if (c + 1 < 128) { const size_t un = (size_t)((c + 1) * 8 + h);
#pragma unroll
            for (int mt = 0; mt < 4; ++mt) {
#pragma unroll
                for (int p = 0; p < 4; ++p) An[mt][p] = *(const v2u*)(MC + un * 4096 + (16 * mt + c16) * 64 + 16 * p + 4 * g);
                Nn[mt] = *(const f32x4*)(NC + un * 4096 + (e0 + c16) * 64 + 16 * mt + 4 * g); Dn[mt] = *(const f32x4*)(DEC + un * 64 + 16 * mt + 4 * g); } }
        v2u sb[4];
#pragma unroll
        for (int m = 0; m < 4; ++m) { sb[m] = pack4(S[m]); *(v2u*)(S0 + ub + (e0 + c16) * 64 + 16 * m + 4 * g) = sb[m]; }
        v4u b0 = {sb[0].x, sb[0].y, sb[1].x, sb[1].y}, b1 = {sb[2].x, sb[2].y, sb[3].x, sb[3].y};
        const bf16x8 B0 = __builtin_bit_cast(bf16x8, b0), B1 = __builtin_bit_cast(bf16x8, b1);
#pragma unroll
        for (int mt = 0; mt < 4; ++mt) { f32x4 acc = Ncur[mt] + S[mt] * Dc[mt];
            v4u a0 = {Ac[mt][0].x, Ac[mt][0].y, Ac[mt][1].x, Ac[mt][1].y}, a1 = {Ac[mt][2].x, Ac[mt][2].y, Ac[mt][3].x, Ac[mt][3].y};
            acc = __builtin_amdgcn_mfma_f32_16x16x32_bf16(__builtin_bit_cast(bf16x8, a0), B0, acc, 0, 0, 0);
            acc = __builtin_amdgcn_mfma_f32_16x16x32_bf16(__builtin_bit_cast(bf16x8, a1), B1, acc, 0, 0, 0);
            S[mt] = acc; }
    }
}

__device__ __forceinline__ void r3_phase(const Args& a, int l, int hb, int gw, int NGW, int lane) {
    asm volatile("" : "+v"(lane));
    const int g = lane >> 4, c16 = lane & 15;
    const bf16* U = (const bf16*)(a.ws + WS_U); const bf16* PP = (const bf16*)(a.ws + WS_PP); const bf16* S0 = (const bf16*)(a.ws + WS_S0); const float* Y0 = (const float*)(a.ws + WS_Y0);
    const float* BON = (const float*)(a.ws + WS_BON2); bf16* MG = (bf16*)(a.ws + WS_XN) + (size_t)hb * MH * D;
    const float* mu_v = a.in[6] + l * 1664 + 1024;
#pragma unroll 1
    for (int task = gw; task < NUNIT * 4; task += NGW) {
        const int unit = task >> 2, mt = task & 3, ch = unit >> 3, h = unit & 7; const size_t ub = (size_t)unit * 4096;
        const bf16x8 A0 = *(const bf16x8*)(PP + ub + (16 * mt + c16) * 64 + 8 * g), A1 = *(const bf16x8*)(PP + ub + (16 * mt + c16) * 64 + 32 + 8 * g);
        f32x4 Y[4];
#pragma unroll
        for (int nt = 0; nt < 4; ++nt) { const bf16* sr = S0 + ub + (16 * nt + c16) * 64 + 8 * g; f32x4 acc = *(const f32x4*)(Y0 + ub + (16 * nt + c16) * 64 + 16 * mt + 4 * g);
            acc = __builtin_amdgcn_mfma_f32_16x16x32_bf16(A0, *(const bf16x8*)sr, acc, 0, 0, 0);
            acc = __builtin_amdgcn_mfma_f32_16x16x32_bf16(A1, *(const bf16x8*)(sr + 32), acc, 0, 0, 0);
            Y[nt] = acc; }
        f32x4 mean = (Y[0] + Y[1]) + (Y[2] + Y[3]);
#pragma unroll
        for (int j = 0; j < 4; ++j) { float s = mean[j]; s += __shfl_xor(s, 1); s += __shfl_xor(s, 2); s += __shfl_xor(s, 4); s += __shfl_xor(s, 8); mean[j] = s * (1.f / 64.f); }
        f32x4 var = {0.f, 0.f, 0.f, 0.f};
#pragma unroll
        for (int nt = 0; nt < 4; ++nt) { const f32x4 dd = Y[nt] - mean; var += dd * dd; }
#pragma unroll
        for (int j = 0; j < 4; ++j) { float s = var[j]; s += __shfl_xor(s, 1); s += __shfl_xor(s, 2); s += __shfl_xor(s, 4); s += __shfl_xor(s, 8); var[j] = rsqrtf(s * (1.f / 64.f) + 64e-5f); }
#pragma unroll
        for (int j = 0; j < 4; ++j) { const int lr = 64 * ch + 16 * mt + 4 * g + j; const bf16* urow = U + (size_t)lr * NPAD; const float bon = BON[lr * 8 + h];
#pragma unroll
            for (int nt = 0; nt < 4; ++nt) { const int cc = 64 * h + 16 * nt + c16;
                const float yn = (Y[nt][j] - mean[j]) * var[j] * a.in[14][l * 512 + cc] + a.in[15][l * 512 + cc];
                const float vc = bf2f(urow[C_V + cc]), vp = lr > 0 ? bf2f(urow[C_V + cc - NPAD]) : 0.f; const float v = vc + (vp - vc) * mu_v[cc];
                const float rg = bf2f(urow[C_RG + cc]);
                MG[(size_t)lr * D + 512 + cc] = (bf16)f2bf((yn + bon * v) * rg * sigm(rg)); } }
    }
}

constexpr int OFF_GQI = 17408, OFF_GKI = 26624, OFF_GKST = 35840, OFF_GVT = 45056, OFF_GSC = 63488, OFF_GTOT = 72704, OFF_GBC = 74752;
constexpr size_t WS_QI = 171 * MiB, WS_OI = 175 * MiB, WS_DS = 191 * MiB, WS_GDEC = 207 * MiB, WS_SP = 208 * MiB;
constexpr int NGUNIT = 512;

__device__ __forceinline__ void g1_phase(const Args& a, int l, unsigned char* L, int tid) {
    asm volatile("" : "+v"(tid));
    const int lane = tid & 63, wave = __builtin_amdgcn_readfirstlane(tid >> 6), g = lane >> 4, c16 = lane & 15;
    const bf16* U = (const bf16*)(a.ws + WS_U);
    float* XW = (float*)L; bf16* QI = (bf16*)(L + OFF_GQI); bf16* KI = (bf16*)(L + OFF_GKI); bf16* KST = (bf16*)(L + OFF_GKST); bf16* VT = (bf16*)(L + OFF_GVT); bf16* SC = (bf16*)(L + OFF_GSC);
    float* TOT = (float*)(L + OFF_GTOT); float* BC = (float*)(L + OFF_GBC);
#pragma unroll 1
    for (int unit = blockIdx.x; unit < NGUNIT; unit += gridDim.x) {
        const int ch = unit >> 2, h = unit & 3;
        const int t = tid >> 3, dg = tid & 7, d0 = 8 * dg, lr = 64 * ch + t, hc = 64 * h + d0;
        const bf16* urow = U + (size_t)lr * NPAD;
        float q[8], k[8];
        {
            float glr[16]; unpack8(*(const v4u*)(urow + C_GLR), glr); unpack8(*(const v4u*)(urow + C_GLR + 8), glr + 8);
            float x[8]; const float* gb = a.in[4] + l * 256 + hc; const float* gu = a.in[3] + l * 16 * 256 + hc;
#pragma unroll
            for (int i = 0; i < 8; ++i) x[i] = gb[i];
#pragma unroll
            for (int r = 0; r < 16; ++r) { const f32x4 u0 = *(const f32x4*)(gu + r * 256), u1 = *(const f32x4*)(gu + r * 256 + 4);
                x[0] += glr[r] * u0.x; x[1] += glr[r] * u0.y; x[2] += glr[r] * u0.z; x[3] += glr[r] * u0.w; x[4] += glr[r] * u1.x; x[5] += glr[r] * u1.y; x[6] += glr[r] * u1.z; x[7] += glr[r] * u1.w; }
#pragma unroll
            for (int i = 0; i < 8; ++i) XW[t * FP + d0 + i] = (fminf(x[i], 0.f) - log1pf(__expf(-fabsf(x[i])))) * (1.f / 16.f);
            unpack8(*(const v4u*)(urow + C_GQ + hc), q); unpack8(*(const v4u*)(urow + C_GK + hc), k);
            float vv[16]; const int e0 = 16 * dg; unpack8(*(const v4u*)(urow + C_GV + 128 * h + e0), vv); unpack8(*(const v4u*)(urow + C_GV + 128 * h + e0 + 8), vv + 8);
#pragma unroll
            for (int i = 0; i < 16; ++i) VT[(e0 + i) * PITCH + t] = (bf16)f2bf(vv[i]);
        }
        __syncthreads();
        {
            const int d = tid & 63, tb = tid >> 6; float p[8]; float run = 0.f;
#pragma unroll
            for (int i = 0; i < 8; ++i) { run += XW[(8 * tb + i) * FP + d]; p[i] = run; }
            TOT[tb * 64 + d] = run;
            __syncthreads();
            float off = 0.f;
#pragma unroll
            for (int j = 0; j < 8; ++j) off += (j < tb) ? TOT[j * 64 + d] : 0.f;
#pragma unroll
            for (int i = 0; i < 8; ++i) XW[(8 * tb + i) * FP + d] = off + p[i];
            if (tb == 7) BC[d] = off + run;
        }
        __syncthreads();
        {
            float qi[8], ki[8];
#pragma unroll
            for (int i = 0; i < 8; ++i) { const float b = XW[t * FP + d0 + i], bc = BC[d0 + i];
                qi[i] = q[i] * 0.125f * __expf(b); ki[i] = k[i] * __expf(-b); KST[(d0 + i) * PITCH + t] = (bf16)f2bf(k[i] * __expf(bc - b)); }
            const v4u qp = pack8(qi);
            *(v4u*)(QI + t * PITCH + d0) = qp; *(v4u*)(KI + t * PITCH + d0) = pack8(ki);
            *(v4u*)((bf16*)(a.ws + WS_QI) + (size_t)unit * 4096 + t * 64 + d0) = qp;
        }
        __syncthreads();
        {
            const int tt = wave >> 1; const int tcol = 16 * tt + c16;
#pragma unroll
            for (int j2 = 0; j2 < 2; ++j2) { const int jt = 2 * (wave & 1) + j2; f32x4 acc = {0.f, 0.f, 0.f, 0.f};
                if (jt <= tt) { acc = mma2(KI + (16 * jt + c16) * PITCH + 8 * g, QI + tcol * PITCH + 8 * g, acc);
#pragma unroll
                    for (int j = 0; j < 4; ++j) if (16 * jt + 4 * g + j > tcol) acc[j] = 0.f; }
                *(v2u*)(SC + tcol * PITCH + 16 * jt + 4 * g) = pack4(acc); }
            float* DSg = (float*)(a.ws + WS_DS) + (size_t)unit * 8192;
#pragma unroll
            for (int i = 0; i < 4; ++i) { const int tile = wave * 4 + i, dt = tile & 3, et = tile >> 2; f32x4 acc = {0.f, 0.f, 0.f, 0.f};
                acc = mma2(KST + (16 * dt + c16) * PITCH + 8 * g, VT + (16 * et + c16) * PITCH + 8 * g, acc);
                *(f32x4*)(DSg + (16 * et + c16) * 64 + 16 * dt + 4 * g) = acc; }
            if (tid < 64) ((float*)(a.ws + WS_GDEC))[unit * 64 + tid] = __expf(BC[tid]);
        }
        __syncthreads();
        {
            float* OIg = (float*)(a.ws + WS_OI) + (size_t)unit * 8192;
#pragma unroll
            for (int i = 0; i < 4; ++i) { const int tile = wave * 4 + i, tt = tile & 3, et = tile >> 2; f32x4 acc = {0.f, 0.f, 0.f, 0.f};
                acc = mma2(SC + (16 * tt + c16) * PITCH + 8 * g, VT + (16 * et + c16) * PITCH + 8 * g, acc);
                *(f32x4*)(OIg + (16 * et + c16) * 64 + 16 * tt + 4 * g) = acc; }
        }
        __syncthreads();
    }
}

__device__ __forceinline__ void g2_scan(const Args& a, int gid) {
    asm volatile("" : "+v"(gid));
    const int h = gid >> 13, ed = gid & 8191, d = gid & 63;
    const float* DS = (const float*)(a.ws + WS_DS); const float* GD = (const float*)(a.ws + WS_GDEC); bf16* SP = (bf16*)(a.ws + WS_SP);
    float S = 0.f;
#pragma unroll 1
    for (int cb = 0; cb < 128; cb += 16) {
        float ds[16], dc[16];
#pragma unroll
        for (int i = 0; i < 16; ++i) { const size_t unit = (size_t)(cb + i) * 4 + h; ds[i] = DS[unit * 8192 + ed]; dc[i] = GD[unit * 64 + d]; }
#pragma unroll
        for (int i = 0; i < 16; ++i) { const size_t unit = (size_t)(cb + i) * 4 + h; SP[unit * 8192 + ed] = (bf16)f2bf(S); S = S * dc[i] + ds[i]; }
    }
}

__device__ __forceinline__ void g3_phase(const Args& a, int l, int hb, int gw, int NGW, int lane) {
    asm volatile("" : "+v"(lane));
    const int g = lane >> 4, c16 = lane & 15;
    const bf16* U = (const bf16*)(a.ws + WS_U); const bf16* QI = (const bf16*)(a.ws + WS_QI); const bf16* SP = (const bf16*)(a.ws + WS_SP); const float* OI = (const float*)(a.ws + WS_OI);
    bf16* MG = (bf16*)(a.ws + WS_XN) + (size_t)hb * MH * D;
#pragma unroll 1
    for (int task = gw; task < NGUNIT * 4; task += NGW) {
        const int unit = task >> 2, mt = task & 3, ch = unit >> 2, h = unit & 3;
        const bf16* qr = QI + (size_t)unit * 4096 + (16 * mt + c16) * 64 + 8 * g;
        const bf16x8 A0 = *(const bf16x8*)qr, A1 = *(const bf16x8*)(qr + 32);
        f32x4 O[8]; f32x4 ss = {0.f, 0.f, 0.f, 0.f};
#pragma unroll
        for (int nt = 0; nt < 8; ++nt) { const bf16* sr = SP + (size_t)unit * 8192 + (16 * nt + c16) * 64 + 8 * g; f32x4 acc = *(const f32x4*)(OI + (size_t)unit * 8192 + (16 * nt + c16) * 64 + 16 * mt + 4 * g);
            acc = __builtin_amdgcn_mfma_f32_16x16x32_bf16(A0, *(const bf16x8*)sr, acc, 0, 0, 0);
            acc = __builtin_amdgcn_mfma_f32_16x16x32_bf16(A1, *(const bf16x8*)(sr + 32), acc, 0, 0, 0);
            O[nt] = acc; ss += acc * acc; }
#pragma unroll
        for (int j = 0; j < 4; ++j) { float s = ss[j]; s += __shfl_xor(s, 1); s += __shfl_xor(s, 2); s += __shfl_xor(s, 4); s += __shfl_xor(s, 8); ss[j] = rsqrtf(s * (1.f / 128.f) + 1e-6f); }
#pragma unroll
        for (int j = 0; j < 4; ++j) { const int lr = 64 * ch + 16 * mt + 4 * g + j; const bf16* urow = U + (size_t)lr * NPAD + C_GG + 128 * h;
#pragma unroll
            for (int nt = 0; nt < 8; ++nt) { const int e = 16 * nt + c16; const float gg = bf2f(urow[e]);
                MG[(size_t)lr * D + 128 * h + e] = (bf16)f2bf(O[nt][j] * ss[j] * a.in[5][l * 128 + e] * gg * sigm(gg)); } }
    }
}

__global__ void __launch_bounds__(NTHR, 2) hymba_fwd(Args a) {
    extern __shared__ __attribute__((aligned(16))) unsigned char lds[];
    cg::grid_group grid = cg::this_grid();
    const int tid = threadIdx.x, lane = tid & 63, wave = __builtin_amdgcn_readfirstlane(tid >> 6);
    const int G = gridDim.x, gw = blockIdx.x * NWAVES + wave, NGW = G * NWAVES;
    bf16* XN = (bf16*)(a.ws + WS_XN); bf16* U = (bf16*)(a.ws + WS_U);
    {
        float* scr = (float*)lds + wave * (64 * 33);
        constexpr int I_IN = (D / 64) * (NPAD / 32), I_OUT = (D / 64) * (D / 32);
        for (int it = gw; it < 2 * (I_IN + I_OUT); it += NGW) {
            int r = it; const int l = r / (I_IN + I_OUT); r -= l * (I_IN + I_OUT);
            if (r < I_IN) transpose_item(a.in[2] + (size_t)l * D * NIN, D, NIN, NPAD, (bf16*)(a.ws + WS_WIN + l * WIN_BYTES), scr, r, lane);
            else transpose_item(a.in[16] + (size_t)l * D * D, D, D, D, (bf16*)(a.ws + WS_WOUT + l * WOUT_BYTES), scr, r - I_IN, lane);
        }
        for (int m = gw; m < M; m += NGW) rms_row(a.in[0] + (size_t)m * D, a.in[1], XN + (size_t)m * D, nullptr, lane);
        {
            bf16* UPT = (bf16*)(a.ws + WS_UPT);
            for (int e = blockIdx.x * NTHR + tid; e < 2 * 2 * 512 * 64; e += G * NTHR) { const int r = e & 63, c = (e >> 6) & 511, q = (e >> 15) & 1, ll = e >> 16;
                UPT[e] = (bf16)f2bf((q ? a.in[10] : a.in[8])[(size_t)ll * 64 * 512 + r * 512 + c]); }
        }
    }
    grid.sync();
    for (int l = 0; l < 2; ++l) {
        for (int hb = 0; hb < 2; ++hb) {
            {
                pg8::Gemm g{XN + (size_t)hb * MH * D, (const bf16*)(a.ws + WS_WIN + l * WIN_BYTES), MH, NPAD, D}; pg8::StaticOrder S; S.init(MH, NPAD, G, (int)blockIdx.x);
                pg8::EpiBf16<0> E{U, NPAD, nullptr, 0, 0, 1.f};
                pg8::gemm_phase<pg8::EpiBf16<0>, pg8::StaticOrder, true, true>((PG8_LAS unsigned char*)lds, g, S, E);
            }
            grid.sync();
            r1_phase(a, l, lds, tid);
            g1_phase(a, l, lds, tid);
            grid.sync();
            if (blockIdx.x < 32) { if (wave == 0) r2_scan(a, blockIdx.x, lane); }
            else if (blockIdx.x < 96) g2_scan(a, (blockIdx.x - 32) * NTHR + tid);
            grid.sync();
            r3_phase(a, l, hb, gw, NGW, lane);
            g3_phase(a, l, hb, gw, NGW, lane);
            grid.sync();
        }
        {
            pg8::Gemm g{XN, (const bf16*)(a.ws + WS_WOUT + l * WOUT_BYTES), M, D, D}; pg8::StaticOrder S; S.init(M, D, G, (int)blockIdx.x);
            pg8::EpiResid E{l == 0 ? a.in[0] : a.out, a.out, D};
            pg8::gemm_phase<pg8::EpiResid, pg8::StaticOrder, true, true>((PG8_LAS unsigned char*)lds, g, S, E);
        }
        grid.sync();
        { int ln = lane; asm volatile("" : "+v"(ln));
        if (l == 0) { for (int m = gw; m < M; m += NGW) rms_row(a.out + (size_t)m * D, a.in[1] + D, XN + (size_t)m * D, nullptr, ln); grid.sync(); }
        else { for (int m = gw; m < M; m += NGW) rms_row(a.out + (size_t)m * D, a.in[17], nullptr, a.out + (size_t)m * D, ln); } }
    }
}

extern "C" void kernel_launch(void* const* d_in, const int* in_sizes, int n_in, void* d_out, int out_size, void* d_ws, size_t ws_size, hipStream_t stream) {
    static int grid = 0;
    if (grid == 0) {
        if (n_in != 18 || out_size != M * D || ws_size < WS_END) { fprintf(stderr, "kernel_launch: unexpected shapes n_in %d out %d ws %zu\n", n_in, out_size, ws_size); grid = -1; return; }
        int dev = 0, cus = 0, per_cu = 0;
        hipGetDevice(&dev); hipDeviceGetAttribute(&cus, hipDeviceAttributeMultiprocessorCount, dev);
        if (hipFuncSetAttribute((const void*)hymba_fwd, hipFuncAttributeMaxDynamicSharedMemorySize, LDS_BYTES) != hipSuccess) { fprintf(stderr, "kernel_launch: hipFuncSetAttribute failed\n"); grid = -1; return; }
        if (hipOccupancyMaxActiveBlocksPerMultiprocessor(&per_cu, (const void*)hymba_fwd, NTHR, LDS_BYTES) != hipSuccess || per_cu < 1) { fprintf(stderr, "kernel_launch: occupancy query failed (%d)\n", per_cu); grid = -1; return; }
        grid = cus * 1;
        fprintf(stderr, "kernel_launch: cus %d per_cu %d grid %d\n", cus, per_cu, grid);
    }
    if (grid < 0) return;
    Args a{};
    for (int i = 0; i < 18; ++i) a.in[i] = (const float*)d_in[i];
    a.out = (float*)d_out; a.ws = (unsigned char*)d_ws;
    void* args[] = {&a};
    hipError_t e = hipLaunchCooperativeKernel((const void*)hymba_fwd, dim3(grid), dim3(NTHR), args, LDS_BYTES, stream);
    if (e != hipSuccess) fprintf(stderr, "cooperative launch failed: %s (grid %d)\n", hipGetErrorString(e), grid);
}
```

```cpp
#include <hip/hip_runtime.h>
#include <hip/hip_cooperative_groups.h>
#include <cstdio>
#include <cstdint>
namespace cg = cooperative_groups;
namespace pg8 {
#define PG8_LAS __attribute__((address_space(3)))
typedef unsigned short bf16_t;
typedef short bf16x8 __attribute__((ext_vector_type(8)));
typedef float f32x4 __attribute__((ext_vector_type(4)));
typedef unsigned u32x4 __attribute__((ext_vector_type(4)));
constexpr int BM = 256, BK = 64, HALF = 128, HTB = HALF * BK * 2  , STAGE_BYTES = 8 * HTB, NXCD = 8, WGM = 8;

__host__ __device__ __forceinline__ int lds_byte(int r, int c) { const int st = (r >> 4) * 2 + (c >> 5), rr = r & 15, cc = c & 31, ob = rr * 64 + cc * 2; return st * 1024 + (ob ^ (((ob >> 9) & 1) << 5)); }
__host__ __device__ __forceinline__ void stage_rc(int b, int& R, int& C) { const int st = b / 1024, sb = b % 1024, swz = sb ^ (((sb >> 9) & 1) << 5); R = (st >> 1) * 16 + swz / 64; C = (st & 1) * 32 + (swz % 64) / 2; }
__host__ __device__ __forceinline__ int perm32(int rho) { const int n = rho >> 4, i = rho & 15; return 8 * (i >> 2) + 4 * n + (i & 3); }

struct Unit { int pm, pn; };
struct Gemm { const bf16_t* A; const bf16_t* Bt; int M, N, K; };

struct StaticOrder {
    int nM, nN, nwg, G, c;
    __host__ __device__ void init(int M, int N, int G_, int c_) { nM = M / BM; nN = N / BM; nwg = nM * nN; G = G_; c = c_; }
    __host__ __device__ bool next(int i, Unit& u) const {
        const long L = (long)i * G + c; if (L >= nwg) return false;
        int wgid = (int)L; { const int q = nwg / NXCD, r = nwg % NXCD, xcd = wgid % NXCD, off = wgid / NXCD; wgid = (xcd < r ? xcd * (q + 1) : r * (q + 1) + (xcd - r) * q) + off; }
        const int nig = WGM * nN, gid = wgid / nig, fm = gid * WGM, gsz = (nM - fm) < WGM ? (nM - fm) : WGM;
        u.pm = fm + ((wgid % nig) % gsz); u.pn = (wgid % nig) / gsz; return true;
    }
    __device__ __forceinline__ void a_ready(const Unit&) const {}
    __device__ __forceinline__ void done(const Unit&) const {}
};

__device__ __forceinline__ unsigned cvt_pk_bf16(float lo, float hi) { unsigned r; asm volatile("v_cvt_pk_bf16_f32 %0, %1, %2" : "=v"(r) : "v"(lo), "v"(hi)); return r; }
typedef float f32x2 __attribute__((ext_vector_type(2)));
__device__ __forceinline__ f32x2 gelu_pk(f32x2 v) {
    const f32x2 av = __builtin_elementwise_abs(v), d = av * 0.2316418882f + 1.0f;
    f32x2 t; t.x = __builtin_amdgcn_rcpf(d.x); t.y = __builtin_amdgcn_rcpf(d.y);
    f32x2 q = t * 0.5307027145f + (-0.7265760135f); q = q * t + 0.7107068705f; q = q * t + (-0.142248368f); q = q * t + 0.127414796f; q = q * t;
    const f32x2 s = (v * v) * (-0.72134752044f);
    f32x2 e; e.x = __builtin_amdgcn_exp2f(s.x); e.y = __builtin_amdgcn_exp2f(s.y);
    const f32x2 m = v * (q * e), r = v - m;
    f32x2 o; o.x = v.x < 0.f ? m.x : r.x; o.y = v.y < 0.f ? m.y : r.y; return o;
}

template <int ACT  > struct EpiBf16 {
    static constexpr bool PERM = true, AFTER_DRAIN = false; static_assert(ACT == 0 || ACT == 1, "EpiBf16: ACT is 0 (none) or 1 (gelu_pk)");
    bf16_t* O; int ldc; const float* bias; int split_cols; size_t split_stride; float scale0;
    __device__ __forceinline__ void operator()(const f32x4 (&acc)[2][2][4][2], const Unit& u, int wr, int wc, int fr, int fq) const {
        const int row0 = u.pm * BM + wr * 64 + fr; int colt = u.pn * BM; bf16_t* base = O;
        float sc = 1.f; if (split_cols) { const int t = colt / split_cols; base += (size_t)t * split_stride; colt -= t * split_cols; if (t == 0) sc = scale0; }
        const int col0 = colt + wc * 32 + 8 * fq, bcol0 = u.pn * BM + wc * 32 + 8 * fq;
        f32x4 bv[2][2];
#pragma unroll
        for (int bj = 0; bj < 2; ++bj)
#pragma unroll
            for (int n = 0; n < 2; ++n) bv[bj][n] = bias ? *(const f32x4*)(bias + bcol0 + bj * HALF + 4 * n) : (f32x4){0.f, 0.f, 0.f, 0.f};
#pragma unroll
        for (int ai = 0; ai < 2; ++ai)
#pragma unroll
            for (int m = 0; m < 4; ++m) { bf16_t* rowp = base + (size_t)(row0 + ai * HALF + m * 16) * ldc + col0;
#pragma unroll
                for (int bj = 0; bj < 2; ++bj) { f32x4 v0 = acc[ai][bj][m][0] + bv[bj][0], v1 = acc[ai][bj][m][1] + bv[bj][1];
                    if (ACT == 1) { f32x2 a = gelu_pk((f32x2){v0[0], v0[1]}), b = gelu_pk((f32x2){v0[2], v0[3]}), c = gelu_pk((f32x2){v1[0], v1[1]}), d = gelu_pk((f32x2){v1[2], v1[3]});
                        v0 = (f32x4){a.x, a.y, b.x, b.y}; v1 = (f32x4){c.x, c.y, d.x, d.y}; }
                    v0 = v0 * sc; v1 = v1 * sc; u32x4 w; w.x = cvt_pk_bf16(v0[0], v0[1]); w.y = cvt_pk_bf16(v0[2], v0[3]); w.z = cvt_pk_bf16(v1[0], v1[1]); w.w = cvt_pk_bf16(v1[2], v1[3]);
                    *(u32x4*)(rowp + bj * HALF) = w; } }
    }
};

template <class Epi, class Sched, bool ALIGN_EPI = false, bool SP2 = false>
__device__ __forceinline__ void gemm_phase(PG8_LAS unsigned char* lds, const Gemm g, const Sched& S, const Epi& E) {
    int tid_ = threadIdx.x; asm volatile("" : "+v"(tid_));
    const int tid = tid_, wid = __builtin_amdgcn_readfirstlane(tid >> 6), lane = tid & 63, wr = wid >> 2, wc = wid & 3, fr = lane & 15, fq = lane >> 4;
    const int K = g.K, nt = K / BK;
    unsigned voffA[2], voffB[2];
#pragma unroll
    for (int i = 0; i < 2; ++i) { int R, C; stage_rc(tid * 16 + i * 8192, R, C); const int Rb = Epi::PERM ? ((R & ~31) + perm32(R & 31)) : R;
        voffA[i] = (unsigned)(R * K + C) * 2u; voffB[i] = (unsigned)(Rb * K + C) * 2u; }
    const size_t kstep = (size_t)(BK * 2);
    const size_t hstep = (size_t)HALF * K * 2;
    const size_t tstep = 2 * hstep;
    const unsigned ldsw = (unsigned)wid * 1024u;
    const int aoff = lds_byte(wr * 64 + fr, fq * 8), boff = lds_byte(wc * 32 + fr, fq * 8);
#define PG8_SA(b, h) (((b) * 2 + (h)) * HTB)
#define PG8_SB(b, h) ((4 + (b) * 2 + (h)) * HTB)
#define PG8_STAGE(bufoff, gbase, voff) do { _Pragma("unroll") for (int _i = 0; _i < 2; ++_i) \
        __builtin_amdgcn_global_load_lds((const unsigned*)((const char*)(gbase) + (voff)[_i]), (PG8_LAS unsigned*)(lds + (bufoff) + ldsw + _i * 8192), 16, 0, 0); } while (0)
#define PG8_LDA(dst, b, h) do { _Pragma("unroll") for (int m = 0; m < 4; ++m) _Pragma("unroll") for (int k = 0; k < 2; ++k) dst[m][k] = *(const PG8_LAS bf16x8*)(lds + PG8_SA(b, h) + aoff + m * 2048 + k * 1024); } while (0)
#define PG8_LDB(dst, b, h) do { _Pragma("unroll") for (int n = 0; n < 2; ++n) _Pragma("unroll") for (int k = 0; k < 2; ++k) dst[n][k] = *(const PG8_LAS bf16x8*)(lds + PG8_SB(b, h) + boff + n * 2048 + k * 1024); } while (0)
#define PG8_MMA(ai, bj, At, Bt) do { __builtin_amdgcn_s_setprio(1); _Pragma("unroll") for (int m = 0; m < 4; ++m) _Pragma("unroll") for (int n = 0; n < 2; ++n) _Pragma("unroll") for (int k = 0; k < 2; ++k) \
        acc[ai][bj][m][n] = __builtin_amdgcn_mfma_f32_16x16x32_bf16(Bt[n][k], At[m][k], acc[ai][bj][m][n], 0, 0, 0); __builtin_amdgcn_s_setprio(0); } while (0)
#define PG8_WAIT_V(n) asm volatile("s_waitcnt vmcnt(" #n ")" ::: "memory")
#define PG8_WAIT_L(n) asm volatile("s_waitcnt lgkmcnt(" #n ")" ::: "memory")
#define PG8_BAR __builtin_amdgcn_s_barrier()
#define PG8_SCHED __builtin_amdgcn_sched_barrier(0)
    Unit cur, nxt; int ui = 0;
    if (!S.next(0, cur)) return;
    f32x4 acc[2][2][4][2];
#pragma unroll
    for (int a = 0; a < 2; ++a)
#pragma unroll
        for (int b = 0; b < 2; ++b)
#pragma unroll
            for (int m = 0; m < 4; ++m)
#pragma unroll
                for (int n = 0; n < 2; ++n) acc[a][b][m][n] = (f32x4){0.f, 0.f, 0.f, 0.f};
    bf16x8 At[4][2], B0[2][2], B1[2][2];
    const char* cA = (const char*)g.A + (size_t)cur.pm * tstep; const char* cB = (const char*)g.Bt + (size_t)cur.pn * tstep;
    S.a_ready(cur);
    if constexpr (SP2) {
        PG8_STAGE(PG8_SB(0, 0), cB, voffB); PG8_STAGE(PG8_SB(0, 1), cB + hstep, voffB); PG8_STAGE(PG8_SA(0, 0), cA, voffA); PG8_STAGE(PG8_SA(0, 1), cA + hstep, voffA);
        if (wr == 1) PG8_BAR;
        PG8_WAIT_V(2); PG8_BAR;
        PG8_STAGE(PG8_SB(1, 0), cB + kstep, voffB); PG8_STAGE(PG8_SA(1, 0), cA + kstep, voffA); PG8_STAGE(PG8_SB(1, 1), cB + hstep + kstep, voffB);
        PG8_WAIT_V(6); PG8_BAR;
    } else {
        PG8_STAGE(PG8_SB(0, 0), cB, voffB); PG8_STAGE(PG8_SA(0, 0), cA, voffA); PG8_STAGE(PG8_SB(0, 1), cB + hstep, voffB); PG8_STAGE(PG8_SA(0, 1), cA + hstep, voffA);
        if (wr == 1) PG8_BAR;
        PG8_WAIT_V(4); PG8_BAR;
        PG8_STAGE(PG8_SB(1, 0), cB + kstep, voffB); PG8_STAGE(PG8_SA(1, 0), cA + kstep, voffA); PG8_STAGE(PG8_SB(1, 1), cB + hstep + kstep, voffB);
        PG8_WAIT_V(6); PG8_BAR;
    }
    for (;;) {
        const bool has_next = S.next(ui + 1, nxt);
        const char* nA = has_next ? (const char*)g.A + (size_t)nxt.pm * tstep : cA; const char* nB = has_next ? (const char*)g.Bt + (size_t)nxt.pn * tstep : cB;
        for (int t = 0; t < nt; t += 2) {
            const bool last = (t == nt - 2);
            const char* a1 = cA + (size_t)(t + 1) * kstep;
            const char* a2 = last ? nA : cA + (size_t)(t + 2) * kstep; const char* b2 = last ? nB : cB + (size_t)(t + 2) * kstep;
            const char* a3 = a2 + kstep; const char* b3 = b2 + kstep;
            if (last && has_next) S.a_ready(nxt);
            if constexpr (SP2) {
            PG8_LDB(B0, 0, 0); PG8_LDB(B1, 0, 1); PG8_SCHED; PG8_LDA(At, 0, 0); PG8_STAGE(PG8_SA(1, 1), a1 + hstep, voffA);
            PG8_WAIT_V(8); PG8_WAIT_L(0); PG8_BAR; PG8_MMA(0, 0, At, B0); PG8_MMA(0, 1, At, B1); PG8_BAR; PG8_SCHED;
            PG8_LDA(At, 0, 1); PG8_STAGE(PG8_SB(0, 0), b2, voffB); PG8_STAGE(PG8_SB(0, 1), b2 + hstep, voffB); PG8_STAGE(PG8_SA(0, 0), a2, voffA);
            PG8_WAIT_V(8); PG8_WAIT_L(0); PG8_BAR; PG8_MMA(1, 0, At, B0); PG8_MMA(1, 1, At, B1); PG8_BAR; PG8_SCHED;
            PG8_LDB(B0, 1, 0); PG8_LDB(B1, 1, 1); PG8_SCHED; PG8_LDA(At, 1, 0); PG8_STAGE(PG8_SA(0, 1), a2 + hstep, voffA);
            PG8_WAIT_V(8); PG8_WAIT_L(0); PG8_BAR; PG8_MMA(0, 0, At, B0); PG8_MMA(0, 1, At, B1); PG8_BAR; PG8_SCHED;
            PG8_LDA(At, 1, 1); PG8_STAGE(PG8_SB(1, 0), b3, voffB); PG8_STAGE(PG8_SB(1, 1), b3 + hstep, voffB); PG8_STAGE(PG8_SA(1, 0), a3, voffA);
            PG8_WAIT_V(8); PG8_WAIT_L(0); PG8_BAR; PG8_MMA(1, 0, At, B0); PG8_MMA(1, 1, At, B1); PG8_BAR; PG8_SCHED;
            } else {
            PG8_LDB(B0, 0, 0); PG8_SCHED; PG8_LDA(At, 0, 0); PG8_STAGE(PG8_SA(1, 1), a1 + hstep, voffA);
            PG8_WAIT_L(8); PG8_BAR; PG8_WAIT_L(0); PG8_MMA(0, 0, At, B0); PG8_BAR; PG8_SCHED;
            PG8_LDB(B1, 0, 1); PG8_STAGE(PG8_SB(0, 0), b2, voffB);
            PG8_BAR; PG8_WAIT_L(0); PG8_MMA(0, 1, At, B1); PG8_BAR;
            PG8_LDA(At, 0, 1); PG8_STAGE(PG8_SA(0, 0), a2, voffA);
            PG8_BAR; PG8_WAIT_L(0); PG8_MMA(1, 0, At, B0); PG8_BAR; PG8_SCHED;
            PG8_STAGE(PG8_SB(0, 1), b2 + hstep, voffB);
            PG8_WAIT_V(6); PG8_BAR; PG8_MMA(1, 1, At, B1); PG8_BAR;
            PG8_LDB(B0, 1, 0); PG8_SCHED; PG8_LDA(At, 1, 0); PG8_STAGE(PG8_SA(0, 1), a2 + hstep, voffA);
            PG8_WAIT_L(8); PG8_BAR; PG8_WAIT_L(0); PG8_MMA(0, 0, At, B0); PG8_BAR; PG8_SCHED;
            PG8_LDB(B1, 1, 1); PG8_STAGE(PG8_SB(1, 0), b3, voffB);
            PG8_BAR; PG8_WAIT_L(0); PG8_MMA(0, 1, At, B1); PG8_BAR;
            PG8_LDA(At, 1, 1); PG8_STAGE(PG8_SA(1, 0), a3, voffA);
            PG8_BAR; PG8_WAIT_L(0); PG8_MMA(1, 0, At, B0); PG8_BAR; PG8_SCHED;
            PG8_STAGE(PG8_SB(1, 1), b3 + hstep, voffB);
            PG8_WAIT_V(6); PG8_BAR; PG8_MMA(1, 1, At, B1); PG8_BAR;
            }
        }
        if constexpr (ALIGN_EPI) { if (wr == 0) PG8_BAR; }
        if constexpr (!Epi::AFTER_DRAIN) { E(acc, cur, wr, wc, fr, fq); S.done(cur); }
        if (!has_next) break;
#pragma unroll
        for (int a = 0; a < 2; ++a)
#pragma unroll
            for (int b = 0; b < 2; ++b)
#pragma unroll
                for (int m = 0; m < 4; ++m)
#pragma unroll
                    for (int n = 0; n < 2; ++n) acc[a][b][m][n] = (f32x4){0.f, 0.f, 0.f, 0.f};
        cur = nxt; cA = nA; cB = nB; ++ui;
        if constexpr (ALIGN_EPI) { if (wr == 1) PG8_BAR; }
    }
    PG8_WAIT_V(0);
    if constexpr (!ALIGN_EPI) { if (wr == 0) PG8_BAR; }
    PG8_BAR;
    if constexpr (Epi::AFTER_DRAIN) { E.fused(acc, cur, wr, wc, fr, fq, lds, wid, lane); S.done(cur); }
#undef PG8_SA
#undef PG8_SB
#undef PG8_STAGE
#undef PG8_LDA
#undef PG8_LDB
#undef PG8_MMA
#undef PG8_WAIT_V
#undef PG8_WAIT_L
#undef PG8_BAR
#undef PG8_SCHED
}
}
namespace pg8 {
struct EpiResid {
    static constexpr bool PERM = false, AFTER_DRAIN = false;
    const float* base; float* out; int ldc;
    __device__ __forceinline__ void operator()(const f32x4 (&acc)[2][2][4][2], const Unit& u, int wr, int wc, int fr, int fq) const {
        const int col0 = u.pn * BM + wc * 32 + 4 * fq;
#pragma unroll
        for (int ai = 0; ai < 2; ++ai)
#pragma unroll
            for (int m = 0; m < 4; ++m) { const size_t off = (size_t)(u.pm * BM + ai * HALF + wr * 64 + m * 16 + fr) * ldc + col0;
#pragma unroll
                for (int bj = 0; bj < 2; ++bj)
#pragma unroll
                    for (int n = 0; n < 2; ++n) { const f32x4 b = *(const f32x4*)(base + off + bj * HALF + n * 16); *(f32x4*)(out + off + bj * HALF + n * 16) = b + acc[ai][bj][m][n]; } }
    }
};
}
constexpr int NWAVES = 8, NTHR = 512;
constexpr int BATCH = 2, T = 8192, D = 1024, M = BATCH * T, MH = T;
constexpr int NIN = 3728, NPAD = 3840;
constexpr int C_GQ = 0, C_GK = 256, C_GV = 512, C_GLR = 1024, C_GG = 1040, C_R = 1552, C_K = 2064, C_V = 2576, C_WL = 3088, C_AL = 3152, C_RG = 3216;
constexpr size_t MiB = 1u << 20;
constexpr size_t WS_WIN = 1 * MiB, WIN_BYTES = (size_t)NPAD * D * 2;
constexpr size_t WS_WOUT = 16 * MiB, WOUT_BYTES = (size_t)D * D * 2;
constexpr size_t WS_XN = 20 * MiB;
constexpr size_t WS_U = 52 * MiB;
constexpr size_t WS_END = 256 * MiB;
constexpr int LDS_BYTES = 147456;

typedef unsigned short bf16;
typedef unsigned v4u __attribute__((ext_vector_type(4)));
typedef float f32x4 __attribute__((ext_vector_type(4)));
#define LDS_WAIT() asm volatile("s_waitcnt lgkmcnt(0)" ::: "memory")
__device__ __forceinline__ float bf2f(unsigned h) { return __uint_as_float(h << 16); }
__device__ __forceinline__ unsigned f2bf(float f) { unsigned u = __float_as_uint(f); return (u + 0x7fffu + ((u >> 16) & 1u)) >> 16; }
__device__ __forceinline__ unsigned pk2(float lo, float hi) { return f2bf(lo) | (f2bf(hi) << 16); }
__device__ __forceinline__ float wave_sum(float v) {
#pragma unroll
    for (int o = 1; o < 64; o <<= 1) v += __shfl_xor(v, o);
    return v;
}
__device__ __forceinline__ float sigm(float x) { return 1.f / (1.f + __expf(-x)); }
__device__ __forceinline__ float rl(float v, int l) { return __int_as_float(__builtin_amdgcn_readlane(__float_as_int(v), l)); }

struct Args { const float* in[18]; float* out; unsigned char* ws; };

__device__ __forceinline__ void transpose_item(const float* W, int K, int N, int Npad, bf16* WT, float* scr, int item, int lane) {
    const int nblk = Npad / 32, kb = item / nblk, nb = item % nblk, k0 = 64 * kb, n0 = 32 * nb;
    const int n = n0 + (lane & 31);
#pragma unroll 8
    for (int i = 0; i < 32; ++i) { const int kk = 2 * i + (lane >> 5); scr[kk * 33 + (lane & 31)] = (n < N) ? W[(size_t)(k0 + kk) * N + n] : 0.f; }
    LDS_WAIT();
    const int c = lane & 7;
#pragma unroll
    for (int j = 0; j < 4; ++j) { const int nn = (lane >> 3) + 8 * j; const float* s = scr + (8 * c) * 33 + nn;
        v4u o; o.x = pk2(s[0 * 33], s[1 * 33]); o.y = pk2(s[2 * 33], s[3 * 33]); o.z = pk2(s[4 * 33], s[5 * 33]); o.w = pk2(s[6 * 33], s[7 * 33]);
        *(v4u*)(WT + (size_t)(n0 + nn) * K + k0 + 8 * c) = o; }
    LDS_WAIT();
}
__device__ __forceinline__ void rms_row(const float* xrow, const float* w, bf16* obf, float* of32, int lane) {
    const f32x4* xr = (const f32x4*)xrow + lane; const f32x4* wr = (const f32x4*)w + lane;
    f32x4 v[4]; float s = 0.f;
#pragma unroll
    for (int j = 0; j < 4; ++j) { v[j] = xr[64 * j]; s += (v[j].x * v[j].x + v[j].y * v[j].y) + (v[j].z * v[j].z + v[j].w * v[j].w); }
    const float rs = rsqrtf(wave_sum(s) * (1.f / D) + 1e-6f);
#pragma unroll
    for (int j = 0; j < 4; ++j) { const f32x4 ww = wr[64 * j]; f32x4 o = v[j] * rs * ww;
        if (of32) ((f32x4*)of32 + lane)[64 * j] = o;
        else ((unsigned long long*)obf + lane)[64 * j] = (unsigned long long)pk2(o.x, o.y) | ((unsigned long long)pk2(o.z, o.w) << 32); }
}

typedef short bf16x8 __attribute__((ext_vector_type(8)));
typedef unsigned v2u __attribute__((ext_vector_type(2)));
constexpr int PITCH = 72, FP = 68, TP = 20;
constexpr int OFF_TW = 0, OFF_AL = 9216, OFF_ARK = 18432, OFF_XA = 27648, OFF_XW = 45056, OFF_AT = 63488, OFF_RT = 72704, OFF_BH = 81920, OFF_KH = 91136,
              OFF_BBT = 100352, OFF_KBT = 109568, OFF_VT = 118784, OFF_TII = 128000, OFF_TOT = 133120, OFF_BC = 135168;
constexpr int OFF_AAK = OFF_TW, OFF_ARB = OFF_AL, OFF_AAB = OFF_XA, OFF_XT = OFF_XW;
constexpr size_t WS_MC = 112 * MiB, WS_NC = 120 * MiB, WS_PP = 136 * MiB, WS_Y0 = 144 * MiB, WS_S0 = 160 * MiB, WS_DEC = 168 * MiB, WS_BON2 = 169 * MiB, WS_UPT = 170 * MiB;
constexpr int NUNIT = 1024;

__device__ __forceinline__ f32x4 mma2(const bf16* Arow, const bf16* Brow, f32x4 acc) {
    acc = __builtin_amdgcn_mfma_f32_16x16x32_bf16(*(const bf16x8*)(Arow), *(const bf16x8*)(Brow), acc, 0, 0, 0);
    acc = __builtin_amdgcn_mfma_f32_16x16x32_bf16(*(const bf16x8*)(Arow + 32), *(const bf16x8*)(Brow + 32), acc, 0, 0, 0);
    return acc;
}
__device__ __forceinline__ v2u pack4(f32x4 v) { v2u r; r.x = pk2(v.x, v.y); r.y = pk2(v.z, v.w); return r; }
__device__ __forceinline__ void unpack8(v4u w, float* o) { o[0] = bf2f(w.x & 0xffffu); o[1] = bf2f(w.x >> 16); o[2] = bf2f(w.y & 0xffffu); o[3] = bf2f(w.y >> 16);
    o[4] = bf2f(w.z & 0xffffu); o[5] = bf2f(w.z >> 16); o[6] = bf2f(w.w & 0xffffu); o[7] = bf2f(w.w >> 16); }
__device__ __forceinline__ v4u pack8(const float* v) { v4u r; r.x = pk2(v[0], v[1]); r.y = pk2(v[2], v[3]); r.z = pk2(v[4], v[5]); r.w = pk2(v[6], v[7]); return r; }

__device__ __forceinline__ void r1_phase(const Args& a, int l, unsigned char* L, int tid) {
    asm volatile("" : "+v"(tid));
    const int lane = tid & 63, wave = __builtin_amdgcn_readfirstlane(tid >> 6), g = lane >> 4, c16 = lane & 15;
    const bf16* U = (const bf16*)(a.ws + WS_U);
    bf16* TW = (bf16*)(L + OFF_TW); bf16* ALm = (bf16*)(L + OFF_AL); bf16* ARK = (bf16*)(L + OFF_ARK); bf16* AAK = (bf16*)(L + OFF_AAK); bf16* ARB = (bf16*)(L + OFF_ARB);
    float* XA = (float*)(L + OFF_XA); float* XW = (float*)(L + OFF_XW); float* AAB = (float*)(L + OFF_AAB); bf16* XT = (bf16*)(L + OFF_XT);
    bf16* AT = (bf16*)(L + OFF_AT); bf16* RT = (bf16*)(L + OFF_RT); bf16* BH = (bf16*)(L + OFF_BH); bf16* KH = (bf16*)(L + OFF_KH);
    bf16* BBT = (bf16*)(L + OFF_BBT); bf16* KBT = (bf16*)(L + OFF_KBT); bf16* VT = (bf16*)(L + OFF_VT);
    float* TII = (float*)(L + OFF_TII); float* TOT = (float*)(L + OFF_TOT); float* BC = (float*)(L + OFF_BC);
    const bf16* UPT = (const bf16*)(a.ws + WS_UPT) + (size_t)l * 2 * 512 * 64;
    const float* mu = a.in[6] + l * 1664;
#pragma unroll 1
    for (int unit = blockIdx.x; unit < NUNIT; unit += gridDim.x) {
        const int ch = unit >> 3, h = unit & 7;
        {
            const int t = tid >> 3, cg = tid & 7, lr = 64 * ch + t;
            const bf16* up = U + (size_t)lr * NPAD + C_WL + 16 * cg;
            const v4u c0 = *(const v4u*)up, c1 = *(const v4u*)(up + 8);
            v4u p0 = {0u, 0u, 0u, 0u}, p1 = {0u, 0u, 0u, 0u};
            if (lr > 0) { p0 = *(const v4u*)(up - NPAD); p1 = *(const v4u*)(up - NPAD + 8); }
            float cu[16], pr[16], o[16]; unpack8(c0, cu); unpack8(c1, cu + 8); unpack8(p0, pr); unpack8(p1, pr + 8);
            const float* mp = mu + 1536 + 16 * cg;
#pragma unroll
            for (int i = 0; i < 16; ++i) { float mv = cu[i] + (pr[i] - cu[i]) * mp[i]; if (cg < 4) mv = tanhf(mv); o[i] = mv; }
            bf16* dst = (cg < 4 ? TW : ALm) + t * PITCH + 16 * (cg & 3);
            *(v4u*)dst = pack8(o); *(v4u*)(dst + 8) = pack8(o + 8);
        }
        __syncthreads();
        {
            const int q = wave >> 2, dt = wave & 3;
            const bf16* WT = UPT + (size_t)q * 512 * 64 + (size_t)(64 * h + 16 * dt + c16) * 64 + 8 * g;
            const bf16x8 a0 = *(const bf16x8*)WT, a1 = *(const bf16x8*)(WT + 32);
            const bf16* Bm = q ? ALm : TW; float* X = q ? XA : XW;
#pragma unroll
            for (int tt = 0; tt < 4; ++tt) { const bf16* br = Bm + (16 * tt + c16) * PITCH + 8 * g; f32x4 acc = {0.f, 0.f, 0.f, 0.f};
                acc = __builtin_amdgcn_mfma_f32_16x16x32_bf16(a0, *(const bf16x8*)br, acc, 0, 0, 0);
                acc = __builtin_amdgcn_mfma_f32_16x16x32_bf16(a1, *(const bf16x8*)(br + 32), acc, 0, 0, 0);
                *(f32x4*)(X + (16 * tt + c16) * FP + 16 * dt + 4 * g) = acc; }
        }
        __syncthreads();
        const int t = tid >> 3, dg = tid & 7, d0 = 8 * dg, lr = 64 * ch + t, hc = 64 * h + d0;
        float r[8], kq[8], v[8], al[8], be[8], lw[8];
        {
            const bf16* up = U + (size_t)lr * NPAD + hc;
            float rc[8], rp[8], kc[8], kp[8], vc[8], vp[8];
            unpack8(*(const v4u*)(up + C_R), rc); unpack8(*(const v4u*)(up + C_K), kc); unpack8(*(const v4u*)(up + C_V), vc);
            if (lr > 0) { unpack8(*(const v4u*)(up + C_R - NPAD), rp); unpack8(*(const v4u*)(up + C_K - NPAD), kp); unpack8(*(const v4u*)(up + C_V - NPAD), vp); }
            else {
#pragma unroll
                for (int i = 0; i < 8; ++i) { rp[i] = 0.f; kp[i] = 0.f; vp[i] = 0.f; } }
            const float* w0p = a.in[7] + l * 512 + hc; const float* a0p = a.in[9] + l * 512 + hc; const float* kkp = a.in[11] + l * 512 + hc;
            const float* kap = a.in[12] + l * 512 + hc; const float* rkp = a.in[13] + l * 512 + hc;
            float nn = 0.f, bon = 0.f, kk[8], av[8];
#pragma unroll
            for (int i = 0; i < 8; ++i) {
                const float xw = XW[t * FP + d0 + i] + w0p[i], xa = XA[t * FP + d0 + i] + a0p[i];
                lw[i] = -0.60653065971f * sigm(xw); av[i] = sigm(xa);
                r[i] = rc[i] + (rp[i] - rc[i]) * mu[hc + i]; const float k = kc[i] + (kp[i] - kc[i]) * mu[512 + hc + i]; v[i] = vc[i] + (vp[i] - vc[i]) * mu[1024 + hc + i];
                kk[i] = k * kkp[i]; nn += kk[i] * kk[i];
                kq[i] = k * (1.f + (av[i] - 1.f) * kap[i]); bon += r[i] * kq[i] * rkp[i];
            }
            nn += __shfl_xor(nn, 1); nn += __shfl_xor(nn, 2); nn += __shfl_xor(nn, 4);
            bon += __shfl_xor(bon, 1); bon += __shfl_xor(bon, 2); bon += __shfl_xor(bon, 4);
            const float inv = 1.f / fmaxf(sqrtf(nn), 1e-12f);
#pragma unroll
            for (int i = 0; i < 8; ++i) { const float kn = kk[i] * inv; al[i] = -kn; be[i] = av[i] * kn; XW[t * FP + d0 + i] = lw[i]; }
            if (dg == 0) ((float*)(a.ws + WS_BON2))[lr * 8 + h] = bon;
        }
        __syncthreads();
        {
            const int d = tid & 63, tb = tid >> 6; float p[8]; float run = 0.f;
#pragma unroll
            for (int i = 0; i < 8; ++i) { run += XW[(8 * tb + i) * FP + d]; p[i] = run; }
            TOT[tb * 64 + d] = run;
            __syncthreads();
            float off = 0.f;
#pragma unroll
            for (int j = 0; j < 8; ++j) off += (j < tb) ? TOT[j * 64 + d] : 0.f;
#pragma unroll
            for (int i = 0; i < 8; ++i) XW[(8 * tb + i) * FP + d] = off + p[i];
            if (tb == 7) BC[d] = off + run;
        }
        __syncthreads();
        {
            float at[8], rt[8], bh[8], kh[8];
#pragma unroll
            for (int i = 0; i < 8; ++i) { const float b = XW[t * FP + d0 + i], bc = BC[d0 + i];
                const float eb = __expf(b), enb = __expf(-b), ebp = __expf(b - lw[i]), ebc = __expf(bc - b);
                at[i] = al[i] * ebp; rt[i] = r[i] * eb; bh[i] = be[i] * enb; kh[i] = kq[i] * enb;
                BBT[(d0 + i) * PITCH + t] = (bf16)f2bf(be[i] * ebc); KBT[(d0 + i) * PITCH + t] = (bf16)f2bf(kq[i] * ebc); VT[(d0 + i) * PITCH + t] = (bf16)f2bf(v[i]); }
            *(v4u*)(AT + t * PITCH + d0) = pack8(at); *(v4u*)(RT + t * PITCH + d0) = pack8(rt); *(v4u*)(BH + t * PITCH + d0) = pack8(bh); *(v4u*)(KH + t * PITCH + d0) = pack8(kh);
        }
        __syncthreads();
        {
            const int q = wave >> 1, mh = wave & 1;
            const bf16* As = (q < 2) ? AT : RT; const bf16* Bs = (q & 1) ? KH : BH;
#pragma unroll
            for (int t2 = 0; t2 < 2; ++t2) { const int tt = 2 * mh + t2; const int tcol = 16 * tt + c16;
#pragma unroll
                for (int jt = 0; jt < 4; ++jt) {
                    f32x4 acc = {0.f, 0.f, 0.f, 0.f};
                    if (jt <= tt) { acc = mma2(Bs + (16 * jt + c16) * PITCH + 8 * g, As + tcol * PITCH + 8 * g, acc);
#pragma unroll
                        for (int j = 0; j < 4; ++j) { const int jj = 16 * jt + 4 * g + j; const bool keep = (q < 2) ? (jj < tcol) : (jj <= tcol); if (!keep) acc[j] = 0.f; } }
                    if (q == 0) *(f32x4*)(AAB + tcol * FP + 16 * jt + 4 * g) = acc;
                    else { bf16* dst = (q == 1 ? AAK : (q == 2 ? ARB : ARK)); *(v2u*)(dst + tcol * PITCH + 16 * jt + 4 * g) = pack4(acc); }
                } }
        }
        __syncthreads();
        f32x4 Z[4];
        {
            if (wave == 0) { const int i = g; float Tc[16];
#pragma unroll
                for (int tr = 0; tr < 16; ++tr) { float s = (c16 == tr) ? 1.f : 0.f; const float* ar = AAB + (16 * i + tr) * FP + 16 * i;
#pragma unroll
                    for (int j = 0; j < 16; ++j) if (j < tr) s += ar[j] * Tc[j];
                    Tc[tr] = s; TII[(i * 16 + tr) * TP + c16] = s; } }
            if (wave < 4) {
#pragma unroll
                for (int i = 0; i < 4; ++i)
#pragma unroll
                    for (int j = 0; j < 4; ++j) Z[i][j] = bf2f(AT[(16 * i + 4 * g + j) * PITCH + 16 * wave + c16]);
            } else {
#pragma unroll
                for (int i = 0; i < 4; ++i) { f32x4 acc = {0.f, 0.f, 0.f, 0.f}; Z[i] = mma2(AAK + (16 * i + c16) * PITCH + 8 * g, VT + (16 * (wave - 4) + c16) * PITCH + 8 * g, acc); }
            }
        }
        __syncthreads();
        {
            f32x4 X[4];
#pragma unroll
            for (int i = 0; i < 4; ++i) { f32x4 z = Z[i];
#pragma unroll
                for (int kb = 0; kb < 4; ++kb) if (kb < i) { const f32x4 av = *(const f32x4*)(AAB + (16 * i + c16) * FP + 16 * kb + 4 * g);
#pragma unroll
                    for (int s = 0; s < 4; ++s) z = __builtin_amdgcn_mfma_f32_16x16x4f32(av[s], X[kb][s], z, 0, 0, 0); }
                const f32x4 tv = *(const f32x4*)(TII + (i * 16 + c16) * TP + 4 * g); f32x4 x = {0.f, 0.f, 0.f, 0.f};
#pragma unroll
                for (int s = 0; s < 4; ++s) x = __builtin_amdgcn_mfma_f32_16x16x4f32(tv[s], z[s], x, 0, 0, 0);
                X[i] = x; }
#pragma unroll
            for (int i = 0; i < 4; ++i) *(v2u*)(XT + (16 * wave + c16) * PITCH + 16 * i + 4 * g) = pack4(X[i]);
        }
        __syncthreads();
        {
            const int q = wave >> 1, hh = wave & 1;
            bf16* MCg = (bf16*)(a.ws + WS_MC) + (size_t)unit * 4096; float* NCg = (float*)(a.ws + WS_NC) + (size_t)unit * 4096;
            bf16* PPg = (bf16*)(a.ws + WS_PP) + (size_t)unit * 4096; float* Y0g = (float*)(a.ws + WS_Y0) + (size_t)unit * 4096;
#pragma unroll
            for (int t2 = 0; t2 < 2; ++t2) { const int ti = 2 * hh + t2;
#pragma unroll
                for (int tj = 0; tj < 4; ++tj) { f32x4 acc = {0.f, 0.f, 0.f, 0.f}; const int cc = 16 * tj + c16, rr = 16 * ti + 4 * g;
                    if (q == 0) { acc = mma2(XT + (16 * ti + c16) * PITCH + 8 * g, BBT + cc * PITCH + 8 * g, acc); *(v2u*)(MCg + cc * 64 + rr) = pack4(acc); }
                    else if (q == 1) { acc = mma2(BBT + (16 * ti + c16) * PITCH + 8 * g, XT + (64 + cc) * PITCH + 8 * g, acc); acc = mma2(KBT + (16 * ti + c16) * PITCH + 8 * g, VT + cc * PITCH + 8 * g, acc);
                        *(f32x4*)(NCg + cc * 64 + rr) = acc; }
                    else if (q == 2) { acc = mma2(XT + (16 * ti + c16) * PITCH + 8 * g, ARB + cc * PITCH + 8 * g, acc);
                        const v2u rv = *(const v2u*)(RT + cc * PITCH + rr); acc[0] += bf2f(rv.x & 0xffffu); acc[1] += bf2f(rv.x >> 16); acc[2] += bf2f(rv.y & 0xffffu); acc[3] += bf2f(rv.y >> 16);
                        *(v2u*)(PPg + cc * 64 + rr) = pack4(acc); }
                    else { acc = mma2(ARB + (16 * ti + c16) * PITCH + 8 * g, XT + (64 + cc) * PITCH + 8 * g, acc); acc = mma2(ARK + (16 * ti + c16) * PITCH + 8 * g, VT + cc * PITCH + 8 * g, acc);
                        *(f32x4*)(Y0g + cc * 64 + rr) = acc; }
                } }
            if (tid < 64) ((float*)(a.ws + WS_DEC))[unit * 64 + tid] = __expf(BC[tid]);
        }
        __syncthreads();
    }
}

#define LAS3 __attribute__((address_space(3)))
constexpr int R2_SLOT = 12544, R2_NS = 10, R2_FLAGS = R2_SLOT * R2_NS;
__device__ __forceinline__ void r2_scan(const Args& a, int chain, unsigned char* L, int tid) {
    asm volatile("" : "+v"(tid));
    const int lane = tid & 63, wave = __builtin_amdgcn_readfirstlane(tid >> 6);
    const int h = chain >> 2, e0 = 16 * (chain & 3), g = lane >> 4, c16 = lane & 15;
    volatile LAS3 unsigned* flg = (volatile LAS3 unsigned*)(LAS3 unsigned char*)(L + R2_FLAGS);
    if (tid < 32) flg[tid] = 0u;
    __syncthreads();
    const bf16* MC = (const bf16*)(a.ws + WS_MC); const float* NC = (const float*)(a.ws + WS_NC); const float* DEC = (const float*)(a.ws + WS_DEC);
    if (wave != 0) {
        int mco[8], nco[4];
#pragma unroll
        for (int q = 0; q < 8; ++q) { const int pos = 64 * q + lane, row = pos >> 3, kc = (pos & 7) ^ (row & 7); mco[q] = row * 64 + kc * 8; }
#pragma unroll
        for (int q = 0; q < 4; ++q) { const int pos = 64 * q + lane, e = pos >> 4, dc = (pos & 15) ^ e; nco[q] = (e0 + e) * 64 + dc * 4; }
        int prev = -1;
#pragma unroll 1
        for (int c = wave - 1; c < 128; c += 7) {
            while ((int)flg[16] < c - (R2_NS - 1)) __builtin_amdgcn_s_sleep(1);
            LAS3 unsigned char* slot = (LAS3 unsigned char*)(L + (c % R2_NS) * R2_SLOT);
            const size_t unit = (size_t)c * 8 + h;
#pragma unroll
            for (int q = 0; q < 8; ++q) __builtin_amdgcn_global_load_lds((const unsigned*)(MC + unit * 4096 + mco[q]), (LAS3 unsigned*)(slot + q * 1024), 16, 0, 0);
#pragma unroll
            for (int q = 0; q < 4; ++q) __builtin_amdgcn_global_load_lds((const unsigned*)(NC + unit * 4096 + nco[q]), (LAS3 unsigned*)(slot + 8192 + q * 1024), 16, 0, 0);
            __builtin_amdgcn_global_load_lds((const unsigned*)(DEC + unit * 64 + lane), (LAS3 unsigned*)(slot + 12288), 4, 0, 0);
            if (prev >= 0) { asm volatile("s_waitcnt vmcnt(13)" ::: "memory"); if (lane == 0) flg[prev % R2_NS] = (unsigned)(prev + 1); }
            prev = c;
        }
        asm volatile("s_waitcnt vmcnt(0)" ::: "memory");
        if (prev >= 0 && lane == 0) flg[prev % R2_NS] = (unsigned)(prev + 1);
    } else {
        bf16* S0 = (bf16*)(a.ws + WS_S0);
        f32x4 S[4];
#pragma unroll
        for (int m = 0; m < 4; ++m) S[m] = (f32x4){0.f, 0.f, 0.f, 0.f};
#pragma unroll 1
        for (int c = 0; c < 128; ++c) {
            const int s = c % R2_NS;
            while (flg[s] != (unsigned)(c + 1)) __builtin_amdgcn_s_sleep(0);
            asm volatile("" ::: "memory");
            const LAS3 unsigned char* slot = (const LAS3 unsigned char*)(L + s * R2_SLOT);
            v2u Ac[4][4]; f32x4 Nc[4], Dc[4];
#pragma unroll
            for (int mt = 0; mt < 4; ++mt) { const int row = 16 * mt + c16;
#pragma unroll
                for (int p = 0; p < 4; ++p) { const int kc = 2 * p + (g >> 1); Ac[mt][p] = *(const LAS3 v2u*)(slot + (row * 8 + (kc ^ (row & 7))) * 16 + (g & 1) * 8); }
                Nc[mt] = *(const LAS3 f32x4*)(slot + 8192 + (c16 * 16 + ((4 * mt + g) ^ c16)) * 16);
                Dc[mt] = *(const LAS3 f32x4*)(slot + 12288 + (16 * mt + 4 * g) * 4); }
            const size_t ub = ((size_t)c * 8 + h) * 4096;
            v2u sb[4];
#pragma unroll
            for (int m = 0; m < 4; ++m) { sb[m] = pack4(S[m]); *(v2u*)(S0 + ub + (e0 + c16) * 64 + 16 * m + 4 * g) = sb[m]; }
            v4u b0 = {sb[0].x, sb[0].y, sb[1].x, sb[1].y}, b1 = {sb[2].x, sb[2].y, sb[3].x, sb[3].y};
            const bf16x8 B0 = __builtin_bit_cast(bf16x8, b0), B1 = __builtin_bit_cast(bf16x8, b1);
#pragma unroll
            for (int mt = 0; mt < 4; ++mt) { f32x4 acc = Nc[mt] + S[mt] * Dc[mt];
                v4u a0 = {Ac[mt][0].x, Ac[mt][0].y, Ac[mt][1].x, Ac[mt][1].y}, a1 = {Ac[mt][2].x, Ac[mt][2].y, Ac[mt][3].x, Ac[mt][3].y};
                acc = __builtin_amdgcn_mfma_f32_16x16x32_bf16(__builtin_bit_cast(bf16x8, a0), B0, acc, 0, 0, 0);
                acc = __builtin_amdgcn_mfma_f32_16x16x32_bf16(__builtin_bit_cast(bf16x8, a1), B1, acc, 0, 0, 0);
                S[mt] = acc; }
            asm volatile("s_waitcnt lgkmcnt(0)" ::: "memory");
            if (lane == 0) flg[16] = (unsigned)(c + 1);
        }
    }
    __syncthreads();
}

__device__ __forceinline__ void r3_phase(const Args& a, int l, int hb, int gw, int NGW, int lane) {
    asm volatile("" : "+v"(lane));
    const int g = lane >> 4, c16 = lane & 15;
    const bf16* U = (const bf16*)(a.ws + WS_U); const bf16* PP = (const bf16*)(a.ws + WS_PP); const bf16* S0 = (const bf16*)(a.ws + WS_S0); const float* Y0 = (const float*)(a.ws + WS_Y0);
    const float* BON = (const float*)(a.ws + WS_BON2); bf16* MG = (bf16*)(a.ws + WS_XN) + (size_t)hb * MH * D;
    const float* mu_v = a.in[6] + l * 1664 + 1024;
#pragma unroll 1
    for (int task = gw; task < NUNIT * 4; task += NGW) {
        const int unit = task >> 2, mt = task & 3, ch = unit >> 3, h = unit & 7; const size_t ub = (size_t)unit * 4096;
        const bf16x8 A0 = *(const bf16x8*)(PP + ub + (16 * mt + c16) * 64 + 8 * g), A1 = *(const bf16x8*)(PP + ub + (16 * mt + c16) * 64 + 32 + 8 * g);
        f32x4 Y[4];
#pragma unroll
        for (int nt = 0; nt < 4; ++nt) { const bf16* sr = S0 + ub + (16 * nt + c16) * 64 + 8 * g; f32x4 acc = *(const f32x4*)(Y0 + ub + (16 * nt + c16) * 64 + 16 * mt + 4 * g);
            acc = __builtin_amdgcn_mfma_f32_16x16x32_bf16(A0, *(const bf16x8*)sr, acc, 0, 0, 0);
            acc = __builtin_amdgcn_mfma_f32_16x16x32_bf16(A1, *(const bf16x8*)(sr + 32), acc, 0, 0, 0);
            Y[nt] = acc; }
        f32x4 mean = (Y[0] + Y[1]) + (Y[2] + Y[3]);
#pragma unroll
        for (int j = 0; j < 4; ++j) { float s = mean[j]; s += __shfl_xor(s, 1); s += __shfl_xor(s, 2); s += __shfl_xor(s, 4); s += __shfl_xor(s, 8); mean[j] = s * (1.f / 64.f); }
        f32x4 var = {0.f, 0.f, 0.f, 0.f};
#pragma unroll
        for (int nt = 0; nt < 4; ++nt) { const f32x4 dd = Y[nt] - mean; var += dd * dd; }
#pragma unroll
        for (int j = 0; j < 4; ++j) { float s = var[j]; s += __shfl_xor(s, 1); s += __shfl_xor(s, 2); s += __shfl_xor(s, 4); s += __shfl_xor(s, 8); var[j] = rsqrtf(s * (1.f / 64.f) + 64e-5f); }
#pragma unroll
        for (int j = 0; j < 4; ++j) { const int lr = 64 * ch + 16 * mt + 4 * g + j; const bf16* urow = U + (size_t)lr * NPAD; const float bon = BON[lr * 8 + h];
#pragma unroll
            for (int nt = 0; nt < 4; ++nt) { const int cc = 64 * h + 16 * nt + c16;
                const float yn = (Y[nt][j] - mean[j]) * var[j] * a.in[14][l * 512 + cc] + a.in[15][l * 512 + cc];
                const float vc = bf2f(urow[C_V + cc]), vp = lr > 0 ? bf2f(urow[C_V + cc - NPAD]) : 0.f; const float v = vc + (vp - vc) * mu_v[cc];
                const float rg = bf2f(urow[C_RG + cc]);
                MG[(size_t)lr * D + 512 + cc] = (bf16)f2bf((yn + bon * v) * rg * sigm(rg)); } }
    }
}

constexpr int OFF_GQI = 17408, OFF_GKI = 26624, OFF_GKST = 35840, OFF_GVT = 45056, OFF_GSC = 63488, OFF_GTOT = 72704, OFF_GBC = 74752;
constexpr size_t WS_QI = 171 * MiB, WS_OI = 175 * MiB, WS_DS = 191 * MiB, WS_GDEC = 207 * MiB, WS_SP = 208 * MiB;
constexpr int NGUNIT = 512;

__device__ __forceinline__ void g1_phase(const Args& a, int l, unsigned char* L, int tid) {
    asm volatile("" : "+v"(tid));
    const int lane = tid & 63, wave = __builtin_amdgcn_readfirstlane(tid >> 6), g = lane >> 4, c16 = lane & 15;
    const bf16* U = (const bf16*)(a.ws + WS_U);
    float* XW = (float*)L; bf16* QI = (bf16*)(L + OFF_GQI); bf16* KI = (bf16*)(L + OFF_GKI); bf16* KST = (bf16*)(L + OFF_GKST); bf16* VT = (bf16*)(L + OFF_GVT); bf16* SC = (bf16*)(L + OFF_GSC);
    float* TOT = (float*)(L + OFF_GTOT); float* BC = (float*)(L + OFF_GBC);
#pragma unroll 1
    for (int unit = blockIdx.x; unit < NGUNIT; unit += gridDim.x) {
        const int ch = unit >> 2, h = unit & 3;
        const int t = tid >> 3, dg = tid & 7, d0 = 8 * dg, lr = 64 * ch + t, hc = 64 * h + d0;
        const bf16* urow = U + (size_t)lr * NPAD;
        float q[8], k[8];
        {
            float glr[16]; unpack8(*(const v4u*)(urow + C_GLR), glr); unpack8(*(const v4u*)(urow + C_GLR + 8), glr + 8);
            float x[8]; const float* gb = a.in[4] + l * 256 + hc; const float* gu = a.in[3] + l * 16 * 256 + hc;
#pragma unroll
            for (int i = 0; i < 8; ++i) x[i] = gb[i];
#pragma unroll
            for (int r = 0; r < 16; ++r) { const f32x4 u0 = *(const f32x4*)(gu + r * 256), u1 = *(const f32x4*)(gu + r * 256 + 4);
                x[0] += glr[r] * u0.x; x[1] += glr[r] * u0.y; x[2] += glr[r] * u0.z; x[3] += glr[r] * u0.w; x[4] += glr[r] * u1.x; x[5] += glr[r] * u1.y; x[6] += glr[r] * u1.z; x[7] += glr[r] * u1.w; }
#pragma unroll
            for (int i = 0; i < 8; ++i) XW[t * FP + d0 + i] = (fminf(x[i], 0.f) - log1pf(__expf(-fabsf(x[i])))) * (1.f / 16.f);
            unpack8(*(const v4u*)(urow + C_GQ + hc), q); unpack8(*(const v4u*)(urow + C_GK + hc), k);
            float vv[16]; const int e0 = 16 * dg; unpack8(*(const v4u*)(urow + C_GV + 128 * h + e0), vv); unpack8(*(const v4u*)(urow + C_GV + 128 * h + e0 + 8), vv + 8);
#pragma unroll
            for (int i = 0; i < 16; ++i) VT[(e0 + i) * PITCH + t] = (bf16)f2bf(vv[i]);
        }
        __syncthreads();
        {
            const int d = tid & 63, tb = tid >> 6; float p[8]; float run = 0.f;
#pragma unroll
            for (int i = 0; i < 8; ++i) { run += XW[(8 * tb + i) * FP + d]; p[i] = run; }
            TOT[tb * 64 + d] = run;
            __syncthreads();
            float off = 0.f;
#pragma unroll
            for (int j = 0; j < 8; ++j) off += (j < tb) ? TOT[j * 64 + d] : 0.f;
#pragma unroll
            for (int i = 0; i < 8; ++i) XW[(8 * tb + i) * FP + d] = off + p[i];
            if (tb == 7) BC[d] = off + run;
        }
        __syncthreads();
        {
            float qi[8], ki[8];
#pragma unroll
            for (int i = 0; i < 8; ++i) { const float b = XW[t * FP + d0 + i], bc = BC[d0 + i];
                qi[i] = q[i] * 0.125f * __expf(b); ki[i] = k[i] * __expf(-b); KST[(d0 + i) * PITCH + t] = (bf16)f2bf(k[i] * __expf(bc - b)); }
            const v4u qp = pack8(qi);
            *(v4u*)(QI + t * PITCH + d0) = qp; *(v4u*)(KI + t * PITCH + d0) = pack8(ki);
            *(v4u*)((bf16*)(a.ws + WS_QI) + (size_t)unit * 4096 + t * 64 + d0) = qp;
        }
        __syncthreads();
        {
            const int tt = wave >> 1; const int tcol = 16 * tt + c16;
#pragma unroll
            for (int j2 = 0; j2 < 2; ++j2) { const int jt = 2 * (wave & 1) + j2; f32x4 acc = {0.f, 0.f, 0.f, 0.f};
                if (jt <= tt) { acc = mma2(KI + (16 * jt + c16) * PITCH + 8 * g, QI + tcol * PITCH + 8 * g, acc);
#pragma unroll
                    for (int j = 0; j < 4; ++j) if (16 * jt + 4 * g + j > tcol) acc[j] = 0.f; }
                *(v2u*)(SC + tcol * PITCH + 16 * jt + 4 * g) = pack4(acc); }
            float* DSg = (float*)(a.ws + WS_DS) + (size_t)unit * 8192;
#pragma unroll
            for (int i = 0; i < 4; ++i) { const int tile = wave * 4 + i, dt = tile & 3, et = tile >> 2; f32x4 acc = {0.f, 0.f, 0.f, 0.f};
                acc = mma2(KST + (16 * dt + c16) * PITCH + 8 * g, VT + (16 * et + c16) * PITCH + 8 * g, acc);
                *(f32x4*)(DSg + (16 * et + c16) * 64 + 16 * dt + 4 * g) = acc; }
            if (tid < 64) ((float*)(a.ws + WS_GDEC))[unit * 64 + tid] = __expf(BC[tid]);
        }
        __syncthreads();
        {
            float* OIg = (float*)(a.ws + WS_OI) + (size_t)unit * 8192;
#pragma unroll
            for (int i = 0; i < 4; ++i) { const int tile = wave * 4 + i, tt = tile & 3, et = tile >> 2; f32x4 acc = {0.f, 0.f, 0.f, 0.f};
                acc = mma2(SC + (16 * tt + c16) * PITCH + 8 * g, VT + (16 * et + c16) * PITCH + 8 * g, acc);
                *(f32x4*)(OIg + (16 * et + c16) * 64 + 16 * tt + 4 * g) = acc; }
        }
        __syncthreads();
    }
}

__device__ __forceinline__ void g2_scan(const Args& a, int gid) {
    asm volatile("" : "+v"(gid));
    const int h = gid >> 13, ed = gid & 8191, d = gid & 63;
    const float* DS = (const float*)(a.ws + WS_DS); const float* GD = (const float*)(a.ws + WS_GDEC); bf16* SP = (bf16*)(a.ws + WS_SP);
    float S = 0.f;
#pragma unroll 1
    for (int cb = 0; cb < 128; cb += 16) {
        float ds[16], dc[16];
#pragma unroll
        for (int i = 0; i < 16; ++i) { const size_t unit = (size_t)(cb + i) * 4 + h; ds[i] = DS[unit * 8192 + ed]; dc[i] = GD[unit * 64 + d]; }
#pragma unroll
        for (int i = 0; i < 16; ++i) { const size_t unit = (size_t)(cb + i) * 4 + h; SP[unit * 8192 + ed] = (bf16)f2bf(S); S = S * dc[i] + ds[i]; }
    }
}

__device__ __forceinline__ void g3_phase(const Args& a, int l, int hb, int gw, int NGW, int lane) {
    asm volatile("" : "+v"(lane));
    const int g = lane >> 4, c16 = lane & 15;
    const bf16* U = (const bf16*)(a.ws + WS_U); const bf16* QI = (const bf16*)(a.ws + WS_QI); const bf16* SP = (const bf16*)(a.ws + WS_SP); const float* OI = (const float*)(a.ws + WS_OI);
    bf16* MG = (bf16*)(a.ws + WS_XN) + (size_t)hb * MH * D;
#pragma unroll 1
    for (int task = gw; task < NGUNIT * 4; task += NGW) {
        const int unit = task >> 2, mt = task & 3, ch = unit >> 2, h = unit & 3;
        const bf16* qr = QI + (size_t)unit * 4096 + (16 * mt + c16) * 64 + 8 * g;
        const bf16x8 A0 = *(const bf16x8*)qr, A1 = *(const bf16x8*)(qr + 32);
        f32x4 O[8]; f32x4 ss = {0.f, 0.f, 0.f, 0.f};
#pragma unroll
        for (int nt = 0; nt < 8; ++nt) { const bf16* sr = SP + (size_t)unit * 8192 + (16 * nt + c16) * 64 + 8 * g; f32x4 acc = *(const f32x4*)(OI + (size_t)unit * 8192 + (16 * nt + c16) * 64 + 16 * mt + 4 * g);
            acc = __builtin_amdgcn_mfma_f32_16x16x32_bf16(A0, *(const bf16x8*)sr, acc, 0, 0, 0);
            acc = __builtin_amdgcn_mfma_f32_16x16x32_bf16(A1, *(const bf16x8*)(sr + 32), acc, 0, 0, 0);
            O[nt] = acc; ss += acc * acc; }
#pragma unroll
        for (int j = 0; j < 4; ++j) { float s = ss[j]; s += __shfl_xor(s, 1); s += __shfl_xor(s, 2); s += __shfl_xor(s, 4); s += __shfl_xor(s, 8); ss[j] = rsqrtf(s * (1.f / 128.f) + 1e-6f); }
#pragma unroll
        for (int j = 0; j < 4; ++j) { const int lr = 64 * ch + 16 * mt + 4 * g + j; const bf16* urow = U + (size_t)lr * NPAD + C_GG + 128 * h;
#pragma unroll
            for (int nt = 0; nt < 8; ++nt) { const int e = 16 * nt + c16; const float gg = bf2f(urow[e]);
                MG[(size_t)lr * D + 128 * h + e] = (bf16)f2bf(O[nt][j] * ss[j] * a.in[5][l * 128 + e] * gg * sigm(gg)); } }
    }
}

#define LAS __attribute__((address_space(3)))
#define XB_TMO      128
#define XB_XCNT(j)  (256  + 64 * (j))
#define XB_XSUB(j)  (1280 + 64 * (j))
#define XB_XGEN(j)  (2304 + 64 * (j))
#define XB_TOP      3328
#define XB_TOPGEN   3392
#define XCD_BAR_WORDS 3456
#define XB_SPIN_CAP (1u << 18)

__device__ __forceinline__ unsigned xb_ld(unsigned* p)              { return __hip_atomic_load(p, __ATOMIC_RELAXED, __HIP_MEMORY_SCOPE_AGENT); }
__device__ __forceinline__ unsigned xb_add(unsigned* p, unsigned v) { return __hip_atomic_fetch_add(p, v, __ATOMIC_RELAXED, __HIP_MEMORY_SCOPE_AGENT); }
__device__ __forceinline__ unsigned xb_xcc_id() { return (unsigned)__builtin_amdgcn_s_getreg((3 << 11) | 20) & 0xFu; }
#define XB_SPIN(cond, bar) do { unsigned _sp = 0; while (cond) { __builtin_amdgcn_s_sleep(1); \
    if ((++_sp & 255u) == 0u) { if (xb_ld(&(bar)[XB_TMO])) break; if (_sp > XB_SPIN_CAP) { atomicAdd(&(bar)[XB_TMO], 1u); break; } } } } while (0)

struct XcdBarrier {
    unsigned* bar; unsigned x;
    volatile LAS unsigned* st;
};

__device__ __forceinline__ XcdBarrier xcd_barrier_post(unsigned* bar, volatile LAS unsigned* st) {
    XcdBarrier b; b.bar = bar; b.x = xb_xcc_id(); b.st = st;
    if (threadIdx.x == 0) (void)xb_add(&bar[XB_XCNT(b.x)], 1u);
    return b;
}
__device__ __forceinline__ void xcd_barrier_complete(unsigned* bar, unsigned x, unsigned& nloc, unsigned& nx) {
    const unsigned G = gridDim.x * gridDim.y * gridDim.z;
    unsigned sum, cnt, mine, sp = 0u;
    for (;;) {
        sum = 0u; cnt = 0u; mine = 0u;
#pragma unroll
        for (unsigned j = 0; j < 16; ++j) { const unsigned c = xb_ld(&bar[XB_XCNT(j)]); sum += c; cnt += (c > 0u) ? 1u : 0u; mine = (j == x) ? c : mine; }
        if (sum == G) break;
        __builtin_amdgcn_s_sleep(1);
        if ((++sp & 255u) == 0u) { if (xb_ld(&bar[XB_TMO])) break; if (sp > XB_SPIN_CAP) { atomicAdd(&bar[XB_TMO], 1u); break; } }
    }
    nloc = mine > 0u ? mine : 1u; nx = cnt > 0u ? cnt : 1u;
}

__device__ __forceinline__ void xcd_barrier(const XcdBarrier& b) {
    asm volatile("s_waitcnt vmcnt(0)" ::: "memory");
    __syncthreads();
    if (threadIdx.x == 0) {
        unsigned* bar = b.bar;
        __builtin_amdgcn_s_waitcnt(0);
        unsigned nloc = b.st[0], nx = b.st[1];
        if (nloc == 0u) { xcd_barrier_complete(bar, b.x, nloc, nx); b.st[0] = nloc; b.st[1] = nx; }
        const unsigned old = xb_add(&bar[XB_XSUB(b.x)], 1u);
        const unsigned gen = old / nloc;
        if (old + 1u == (gen + 1u) * nloc) {
            __builtin_amdgcn_fence(__ATOMIC_RELEASE, "agent");
            asm volatile("s_waitcnt vmcnt(0)" ::: "memory");
            const unsigned og = xb_add(&bar[XB_TOP], 1u);
            const unsigned tg = og / nx;
            if (og + 1u == (tg + 1u) * nx) xb_add(&bar[XB_TOPGEN], 1u);
            else XB_SPIN(xb_ld(&bar[XB_TOPGEN]) == tg, bar);
            __builtin_amdgcn_fence(__ATOMIC_ACQUIRE, "agent");
            xb_add(&bar[XB_XGEN(b.x)], 1u);
            asm volatile("s_waitcnt vmcnt(0)" ::: "memory");
        } else {
            XB_SPIN(xb_ld(&bar[XB_XGEN(b.x)]) == gen, bar);
            __builtin_amdgcn_fence(__ATOMIC_ACQUIRE, "agent");
            asm volatile("s_waitcnt vmcnt(0)" ::: "memory");
        }
    }
    __syncthreads();
}


__global__ void __launch_bounds__(NTHR, 2) hymba_fwd(Args a) {
    extern __shared__ __attribute__((aligned(16))) unsigned char lds[];
    cg::grid_group grid = cg::this_grid();
    const int tid = threadIdx.x, lane = tid & 63, wave = __builtin_amdgcn_readfirstlane(tid >> 6);
    const int G = gridDim.x, gw = blockIdx.x * NWAVES + wave, NGW = G * NWAVES;
    bf16* XN = (bf16*)(a.ws + WS_XN); bf16* U = (bf16*)(a.ws + WS_U);
    volatile LAS unsigned* xst = (volatile LAS unsigned*)(LAS unsigned char*)(lds + LDS_BYTES - 64);
    if (tid < 2) xst[tid] = 0u;
    __syncthreads();
    const XcdBarrier xbar = xcd_barrier_post((unsigned*)a.ws, xst);
    {
        float* scr = (float*)lds + wave * (64 * 33);
        constexpr int I_IN = (D / 64) * (NPAD / 32), I_OUT = (D / 64) * (D / 32);
        for (int it = gw; it < 2 * (I_IN + I_OUT); it += NGW) {
            int r = it; const int l = r / (I_IN + I_OUT); r -= l * (I_IN + I_OUT);
            if (r < I_IN) transpose_item(a.in[2] + (size_t)l * D * NIN, D, NIN, NPAD, (bf16*)(a.ws + WS_WIN + l * WIN_BYTES), scr, r, lane);
            else transpose_item(a.in[16] + (size_t)l * D * D, D, D, D, (bf16*)(a.ws + WS_WOUT + l * WOUT_BYTES), scr, r - I_IN, lane);
        }
        for (int m = gw; m < M; m += NGW) rms_row(a.in[0] + (size_t)m * D, a.in[1], XN + (size_t)m * D, nullptr, lane);
        {
            bf16* UPT = (bf16*)(a.ws + WS_UPT);
            for (int e = blockIdx.x * NTHR + tid; e < 2 * 2 * 512 * 64; e += G * NTHR) { const int r = e & 63, c = (e >> 6) & 511, q = (e >> 15) & 1, ll = e >> 16;
                UPT[e] = (bf16)f2bf((q ? a.in[10] : a.in[8])[(size_t)ll * 64 * 512 + r * 512 + c]); }
        }
    }
    grid.sync();
    for (int l = 0; l < 2; ++l) {
        for (int hb = 0; hb < 2; ++hb) {
            {
                pg8::Gemm g{XN + (size_t)hb * MH * D, (const bf16*)(a.ws + WS_WIN + l * WIN_BYTES), MH, NPAD, D}; pg8::StaticOrder S; S.init(MH, NPAD, G, (int)blockIdx.x);
                pg8::EpiBf16<0> E{U, NPAD, nullptr, 0, 0, 1.f};
                pg8::gemm_phase<pg8::EpiBf16<0>, pg8::StaticOrder, true, true>((PG8_LAS unsigned char*)lds, g, S, E);
            }
            xcd_barrier(xbar);
            r1_phase(a, l, lds, tid);
            g1_phase(a, l, lds, tid);
            xcd_barrier(xbar);
            if (blockIdx.x < 32) r2_scan(a, blockIdx.x, lds, tid);
            else if (blockIdx.x < 96) g2_scan(a, (blockIdx.x - 32) * NTHR + tid);
            xcd_barrier(xbar);
            r3_phase(a, l, hb, gw, NGW, lane);
            g3_phase(a, l, hb, gw, NGW, lane);
            xcd_barrier(xbar);
        }
        {
            pg8::Gemm g{XN, (const bf16*)(a.ws + WS_WOUT + l * WOUT_BYTES), M, D, D}; pg8::StaticOrder S; S.init(M, D, G, (int)blockIdx.x);
            pg8::EpiResid E{l == 0 ? a.in[0] : a.out, a.out, D};
            pg8::gemm_phase<pg8::EpiResid, pg8::StaticOrder, true, true>((PG8_LAS unsigned char*)lds, g, S, E);
        }
        xcd_barrier(xbar);
        { int ln = lane; asm volatile("" : "+v"(ln));
        if (l == 0) { for (int m = gw; m < M; m += NGW) rms_row(a.out + (size_t)m * D, a.in[1] + D, XN + (size_t)m * D, nullptr, ln); xcd_barrier(xbar); }
        else { for (int m = gw; m < M; m += NGW) rms_row(a.out + (size_t)m * D, a.in[17], nullptr, a.out + (size_t)m * D, ln); } }
    }
}

extern "C" void kernel_launch(void* const* d_in, const int* in_sizes, int n_in, void* d_out, int out_size, void* d_ws, size_t ws_size, hipStream_t stream) {
    static int grid = 0;
    if (grid == 0) {
        if (n_in != 18 || out_size != M * D || ws_size < WS_END) { fprintf(stderr, "kernel_launch: unexpected shapes n_in %d out %d ws %zu\n", n_in, out_size, ws_size); grid = -1; return; }
        int dev = 0, cus = 0, per_cu = 0;
        hipGetDevice(&dev); hipDeviceGetAttribute(&cus, hipDeviceAttributeMultiprocessorCount, dev);
        if (hipFuncSetAttribute((const void*)hymba_fwd, hipFuncAttributeMaxDynamicSharedMemorySize, LDS_BYTES) != hipSuccess) { fprintf(stderr, "kernel_launch: hipFuncSetAttribute failed\n"); grid = -1; return; }
        if (hipOccupancyMaxActiveBlocksPerMultiprocessor(&per_cu, (const void*)hymba_fwd, NTHR, LDS_BYTES) != hipSuccess || per_cu < 1) { fprintf(stderr, "kernel_launch: occupancy query failed (%d)\n", per_cu); grid = -1; return; }
        grid = cus * 1;
        fprintf(stderr, "kernel_launch: cus %d per_cu %d grid %d\n", cus, per_cu, grid);
    }
    if (grid < 0) return;
    if (hipMemsetAsync(d_ws, 0, 16384, stream) != hipSuccess) { fprintf(stderr, "kernel_launch: memset failed\n"); return; }
    Args a{};
    for (int i = 0; i < 18; ++i) a.in[i] = (const float*)d_in[i];
    a.out = (float*)d_out; a.ws = (unsigned char*)d_ws;
    void* args[] = {&a};
    hipError_t e = hipLaunchCooperativeKernel((const void*)hymba_fwd, dim3(grid), dim3(NTHR), args, LDS_BYTES, stream);
    if (e != hipSuccess) fprintf(stderr, "cooperative launch failed: %s (grid %d)\n", hipGetErrorString(e), grid);
}
```

```cpp
#include <hip/hip_runtime.h>
#include <hip/hip_cooperative_groups.h>
#include <cstdio>
#include <cstdint>
namespace cg = cooperative_groups;
namespace pg8 {
#define PG8_LAS __attribute__((address_space(3)))
typedef unsigned short bf16_t;
typedef short bf16x8 __attribute__((ext_vector_type(8)));
typedef float f32x4 __attribute__((ext_vector_type(4)));
typedef unsigned u32x4 __attribute__((ext_vector_type(4)));
constexpr int BM = 256, BK = 64, HALF = 128, HTB = HALF * BK * 2  , STAGE_BYTES = 8 * HTB, NXCD = 8, WGM = 8;

__host__ __device__ __forceinline__ int lds_byte(int r, int c) { const int st = (r >> 4) * 2 + (c >> 5), rr = r & 15, cc = c & 31, ob = rr * 64 + cc * 2; return st * 1024 + (ob ^ (((ob >> 9) & 1) << 5)); }
__host__ __device__ __forceinline__ void stage_rc(int b, int& R, int& C) { const int st = b / 1024, sb = b % 1024, swz = sb ^ (((sb >> 9) & 1) << 5); R = (st >> 1) * 16 + swz / 64; C = (st & 1) * 32 + (swz % 64) / 2; }
__host__ __device__ __forceinline__ int perm32(int rho) { const int n = rho >> 4, i = rho & 15; return 8 * (i >> 2) + 4 * n + (i & 3); }

struct Unit { int pm, pn; };
struct Gemm { const bf16_t* A; const bf16_t* Bt; int M, N, K; };

struct StaticOrder {
    int nM, nN, nwg, G, c;
    __host__ __device__ void init(int M, int N, int G_, int c_) { nM = M / BM; nN = N / BM; nwg = nM * nN; G = G_; c = c_; }
    __host__ __device__ bool next(int i, Unit& u) const {
        const long L = (long)i * G + c; if (L >= nwg) return false;
        int wgid = (int)L; { const int q = nwg / NXCD, r = nwg % NXCD, xcd = wgid % NXCD, off = wgid / NXCD; wgid = (xcd < r ? xcd * (q + 1) : r * (q + 1) + (xcd - r) * q) + off; }
        const int nig = WGM * nN, gid = wgid / nig, fm = gid * WGM, gsz = (nM - fm) < WGM ? (nM - fm) : WGM;
        u.pm = fm + ((wgid % nig) % gsz); u.pn = (wgid % nig) / gsz; return true;
    }
    __device__ __forceinline__ void a_ready(const Unit&) const {}
    __device__ __forceinline__ void done(const Unit&) const {}
};

__device__ __forceinline__ unsigned cvt_pk_bf16(float lo, float hi) { unsigned r; asm volatile("v_cvt_pk_bf16_f32 %0, %1, %2" : "=v"(r) : "v"(lo), "v"(hi)); return r; }
typedef float f32x2 __attribute__((ext_vector_type(2)));
__device__ __forceinline__ f32x2 gelu_pk(f32x2 v) {
    const f32x2 av = __builtin_elementwise_abs(v), d = av * 0.2316418882f + 1.0f;
    f32x2 t; t.x = __builtin_amdgcn_rcpf(d.x); t.y = __builtin_amdgcn_rcpf(d.y);
    f32x2 q = t * 0.5307027145f + (-0.7265760135f); q = q * t + 0.7107068705f; q = q * t + (-0.142248368f); q = q * t + 0.127414796f; q = q * t;
    const f32x2 s = (v * v) * (-0.72134752044f);
    f32x2 e; e.x = __builtin_amdgcn_exp2f(s.x); e.y = __builtin_amdgcn_exp2f(s.y);
    const f32x2 m = v * (q * e), r = v - m;
    f32x2 o; o.x = v.x < 0.f ? m.x : r.x; o.y = v.y < 0.f ? m.y : r.y; return o;
}

template <int ACT  > struct EpiBf16 {
    static constexpr bool PERM = true, AFTER_DRAIN = false; static_assert(ACT == 0 || ACT == 1, "EpiBf16: ACT is 0 (none) or 1 (gelu_pk)");
    bf16_t* O; int ldc; const float* bias; int split_cols; size_t split_stride; float scale0;
    __device__ __forceinline__ void operator()(const f32x4 (&acc)[2][2][4][2], const Unit& u, int wr, int wc, int fr, int fq) const {
        const int row0 = u.pm * BM + wr * 64 + fr; int colt = u.pn * BM; bf16_t* base = O;
        float sc = 1.f; if (split_cols) { const int t = colt / split_cols; base += (size_t)t * split_stride; colt -= t * split_cols; if (t == 0) sc = scale0; }
        const int col0 = colt + wc * 32 + 8 * fq, bcol0 = u.pn * BM + wc * 32 + 8 * fq;
        f32x4 bv[2][2];
#pragma unroll
        for (int bj = 0; bj < 2; ++bj)
#pragma unroll
            for (int n = 0; n < 2; ++n) bv[bj][n] = bias ? *(const f32x4*)(bias + bcol0 + bj * HALF + 4 * n) : (f32x4){0.f, 0.f, 0.f, 0.f};
#pragma unroll
        for (int ai = 0; ai < 2; ++ai)
#pragma unroll
            for (int m = 0; m < 4; ++m) { bf16_t* rowp = base + (size_t)(row0 + ai * HALF + m * 16) * ldc + col0;
#pragma unroll
                for (int bj = 0; bj < 2; ++bj) { f32x4 v0 = acc[ai][bj][m][0] + bv[bj][0], v1 = acc[ai][bj][m][1] + bv[bj][1];
                    if (ACT == 1) { f32x2 a = gelu_pk((f32x2){v0[0], v0[1]}), b = gelu_pk((f32x2){v0[2], v0[3]}), c = gelu_pk((f32x2){v1[0], v1[1]}), d = gelu_pk((f32x2){v1[2], v1[3]});
                        v0 = (f32x4){a.x, a.y, b.x, b.y}; v1 = (f32x4){c.x, c.y, d.x, d.y}; }
                    v0 = v0 * sc; v1 = v1 * sc; u32x4 w; w.x = cvt_pk_bf16(v0[0], v0[1]); w.y = cvt_pk_bf16(v0[2], v0[3]); w.z = cvt_pk_bf16(v1[0], v1[1]); w.w = cvt_pk_bf16(v1[2], v1[3]);
                    *(u32x4*)(rowp + bj * HALF) = w; } }
    }
};

template <class Epi, class Sched, bool ALIGN_EPI = false, bool SP2 = false>
__device__ __forceinline__ void gemm_phase(PG8_LAS unsigned char* lds, const Gemm g, const Sched& S, const Epi& E) {
    int tid_ = threadIdx.x; asm volatile("" : "+v"(tid_));
    const int tid = tid_, wid = __builtin_amdgcn_readfirstlane(tid >> 6), lane = tid & 63, wr = wid >> 2, wc = wid & 3, fr = lane & 15, fq = lane >> 4;
    const int K = g.K, nt = K / BK;
    unsigned voffA[2], voffB[2];
#pragma unroll
    for (int i = 0; i < 2; ++i) { int R, C; stage_rc(tid * 16 + i * 8192, R, C); const int Rb = Epi::PERM ? ((R & ~31) + perm32(R & 31)) : R;
        voffA[i] = (unsigned)(R * K + C) * 2u; voffB[i] = (unsigned)(Rb * K + C) * 2u; }
    const size_t kstep = (size_t)(BK * 2);
    const size_t hstep = (size_t)HALF * K * 2;
    const size_t tstep = 2 * hstep;
    const unsigned ldsw = (unsigned)wid * 1024u;
    const int aoff = lds_byte(wr * 64 + fr, fq * 8), boff = lds_byte(wc * 32 + fr, fq * 8);
#define PG8_SA(b, h) (((b) * 2 + (h)) * HTB)
#define PG8_SB(b, h) ((4 + (b) * 2 + (h)) * HTB)
#define PG8_STAGE(bufoff, gbase, voff) do { _Pragma("unroll") for (int _i = 0; _i < 2; ++_i) \
        __builtin_amdgcn_global_load_lds((const unsigned*)((const char*)(gbase) + (voff)[_i]), (PG8_LAS unsigned*)(lds + (bufoff) + ldsw + _i * 8192), 16, 0, 0); } while (0)
#define PG8_LDA(dst, b, h) do { _Pragma("unroll") for (int m = 0; m < 4; ++m) _Pragma("unroll") for (int k = 0; k < 2; ++k) dst[m][k] = *(const PG8_LAS bf16x8*)(lds + PG8_SA(b, h) + aoff + m * 2048 + k * 1024); } while (0)
#define PG8_LDB(dst, b, h) do { _Pragma("unroll") for (int n = 0; n < 2; ++n) _Pragma("unroll") for (int k = 0; k < 2; ++k) dst[n][k] = *(const PG8_LAS bf16x8*)(lds + PG8_SB(b, h) + boff + n * 2048 + k * 1024); } while (0)
#define PG8_MMA(ai, bj, At, Bt) do { __builtin_amdgcn_s_setprio(1); _Pragma("unroll") for (int m = 0; m < 4; ++m) _Pragma("unroll") for (int n = 0; n < 2; ++n) _Pragma("unroll") for (int k = 0; k < 2; ++k) \
        acc[ai][bj][m][n] = __builtin_amdgcn_mfma_f32_16x16x32_bf16(Bt[n][k], At[m][k], acc[ai][bj][m][n], 0, 0, 0); __builtin_amdgcn_s_setprio(0); } while (0)
#define PG8_WAIT_V(n) asm volatile("s_waitcnt vmcnt(" #n ")" ::: "memory")
#define PG8_WAIT_L(n) asm volatile("s_waitcnt lgkmcnt(" #n ")" ::: "memory")
#define PG8_BAR __builtin_amdgcn_s_barrier()
#define PG8_SCHED __builtin_amdgcn_sched_barrier(0)
    Unit cur, nxt; int ui = 0;
    if (!S.next(0, cur)) return;
    f32x4 acc[2][2][4][2];
#pragma unroll
    for (int a = 0; a < 2; ++a)
#pragma unroll
        for (int b = 0; b < 2; ++b)
#pragma unroll
            for (int m = 0; m < 4; ++m)
#pragma unroll
                for (int n = 0; n < 2; ++n) acc[a][b][m][n] = (f32x4){0.f, 0.f, 0.f, 0.f};
    bf16x8 At[4][2], B0[2][2], B1[2][2];
    const char* cA = (const char*)g.A + (size_t)cur.pm * tstep; const char* cB = (const char*)g.Bt + (size_t)cur.pn * tstep;
    S.a_ready(cur);
    if constexpr (SP2) {
        PG8_STAGE(PG8_SB(0, 0), cB, voffB); PG8_STAGE(PG8_SB(0, 1), cB + hstep, voffB); PG8_STAGE(PG8_SA(0, 0), cA, voffA); PG8_STAGE(PG8_SA(0, 1), cA + hstep, voffA);
        if (wr == 1) PG8_BAR;
        PG8_WAIT_V(2); PG8_BAR;
        PG8_STAGE(PG8_SB(1, 0), cB + kstep, voffB); PG8_STAGE(PG8_SA(1, 0), cA + kstep, voffA); PG8_STAGE(PG8_SB(1, 1), cB + hstep + kstep, voffB);
        PG8_WAIT_V(6); PG8_BAR;
    } else {
        PG8_STAGE(PG8_SB(0, 0), cB, voffB); PG8_STAGE(PG8_SA(0, 0), cA, voffA); PG8_STAGE(PG8_SB(0, 1), cB + hstep, voffB); PG8_STAGE(PG8_SA(0, 1), cA + hstep, voffA);
        if (wr == 1) PG8_BAR;
        PG8_WAIT_V(4); PG8_BAR;
        PG8_STAGE(PG8_SB(1, 0), cB + kstep, voffB); PG8_STAGE(PG8_SA(1, 0), cA + kstep, voffA); PG8_STAGE(PG8_SB(1, 1), cB + hstep + kstep, voffB);
        PG8_WAIT_V(6); PG8_BAR;
    }
    for (;;) {
        const bool has_next = S.next(ui + 1, nxt);
        const char* nA = has_next ? (const char*)g.A + (size_t)nxt.pm * tstep : cA; const char* nB = has_next ? (const char*)g.Bt + (size_t)nxt.pn * tstep : cB;
        for (int t = 0; t < nt; t += 2) {
            const bool last = (t == nt - 2);
            const char* a1 = cA + (size_t)(t + 1) * kstep;
            const char* a2 = last ? nA : cA + (size_t)(t + 2) * kstep; const char* b2 = last ? nB : cB + (size_t)(t + 2) * kstep;
            const char* a3 = a2 + kstep; const char* b3 = b2 + kstep;
            if (last && has_next) S.a_ready(nxt);
            if constexpr (SP2) {
            PG8_LDB(B0, 0, 0); PG8_LDB(B1, 0, 1); PG8_SCHED; PG8_LDA(At, 0, 0); PG8_STAGE(PG8_SA(1, 1), a1 + hstep, voffA);
            PG8_WAIT_V(8); PG8_WAIT_L(0); PG8_BAR; PG8_MMA(0, 0, At, B0); PG8_MMA(0, 1, At, B1); PG8_BAR; PG8_SCHED;
            PG8_LDA(At, 0, 1); PG8_STAGE(PG8_SB(0, 0), b2, voffB); PG8_STAGE(PG8_SB(0, 1), b2 + hstep, voffB); PG8_STAGE(PG8_SA(0, 0), a2, voffA);
            PG8_WAIT_V(8); PG8_WAIT_L(0); PG8_BAR; PG8_MMA(1, 0, At, B0); PG8_MMA(1, 1, At, B1); PG8_BAR; PG8_SCHED;
            PG8_LDB(B0, 1, 0); PG8_LDB(B1, 1, 1); PG8_SCHED; PG8_LDA(At, 1, 0); PG8_STAGE(PG8_SA(0, 1), a2 + hstep, voffA);
            PG8_WAIT_V(8); PG8_WAIT_L(0); PG8_BAR; PG8_MMA(0, 0, At, B0); PG8_MMA(0, 1, At, B1); PG8_BAR; PG8_SCHED;
            PG8_LDA(At, 1, 1); PG8_STAGE(PG8_SB(1, 0), b3, voffB); PG8_STAGE(PG8_SB(1, 1), b3 + hstep, voffB); PG8_STAGE(PG8_SA(1, 0), a3, voffA);
            PG8_WAIT_V(8); PG8_WAIT_L(0); PG8_BAR; PG8_MMA(1, 0, At, B0); PG8_MMA(1, 1, At, B1); PG8_BAR; PG8_SCHED;
            } else {
            PG8_LDB(B0, 0, 0); PG8_SCHED; PG8_LDA(At, 0, 0); PG8_STAGE(PG8_SA(1, 1), a1 + hstep, voffA);
            PG8_WAIT_L(8); PG8_BAR; PG8_WAIT_L(0); PG8_MMA(0, 0, At, B0); PG8_BAR; PG8_SCHED;
            PG8_LDB(B1, 0, 1); PG8_STAGE(PG8_SB(0, 0), b2, voffB);
            PG8_BAR; PG8_WAIT_L(0); PG8_MMA(0, 1, At, B1); PG8_BAR;
            PG8_LDA(At, 0, 1); PG8_STAGE(PG8_SA(0, 0), a2, voffA);
            PG8_BAR; PG8_WAIT_L(0); PG8_MMA(1, 0, At, B0); PG8_BAR; PG8_SCHED;
            PG8_STAGE(PG8_SB(0, 1), b2 + hstep, voffB);
            PG8_WAIT_V(6); PG8_BAR; PG8_MMA(1, 1, At, B1); PG8_BAR;
            PG8_LDB(B0, 1, 0); PG8_SCHED; PG8_LDA(At, 1, 0); PG8_STAGE(PG8_SA(0, 1), a2 + hstep, voffA);
            PG8_WAIT_L(8); PG8_BAR; PG8_WAIT_L(0); PG8_MMA(0, 0, At, B0); PG8_BAR; PG8_SCHED;
            PG8_LDB(B1, 1, 1); PG8_STAGE(PG8_SB(1, 0), b3, voffB);
            PG8_BAR; PG8_WAIT_L(0); PG8_MMA(0, 1, At, B1); PG8_BAR;
            PG8_LDA(At, 1, 1); PG8_STAGE(PG8_SA(1, 0), a3, voffA);
            PG8_BAR; PG8_WAIT_L(0); PG8_MMA(1, 0, At, B0); PG8_BAR; PG8_SCHED;
            PG8_STAGE(PG8_SB(1, 1), b3 + hstep, voffB);
            PG8_WAIT_V(6); PG8_BAR; PG8_MMA(1, 1, At, B1); PG8_BAR;
            }
        }
        if constexpr (ALIGN_EPI) { if (wr == 0) PG8_BAR; }
        if constexpr (!Epi::AFTER_DRAIN) { E(acc, cur, wr, wc, fr, fq); S.done(cur); }
        if (!has_next) break;
#pragma unroll
        for (int a = 0; a < 2; ++a)
#pragma unroll
            for (int b = 0; b < 2; ++b)
#pragma unroll
                for (int m = 0; m < 4; ++m)
#pragma unroll
                    for (int n = 0; n < 2; ++n) acc[a][b][m][n] = (f32x4){0.f, 0.f, 0.f, 0.f};
        cur = nxt; cA = nA; cB = nB; ++ui;
        if constexpr (ALIGN_EPI) { if (wr == 1) PG8_BAR; }
    }
    PG8_WAIT_V(0);
    if constexpr (!ALIGN_EPI) { if (wr == 0) PG8_BAR; }
    PG8_BAR;
    if constexpr (Epi::AFTER_DRAIN) { E.fused(acc, cur, wr, wc, fr, fq, lds, wid, lane); S.done(cur); }
#undef PG8_SA
#undef PG8_SB
#undef PG8_STAGE
#undef PG8_LDA
#undef PG8_LDB
#undef PG8_MMA
#undef PG8_WAIT_V
#undef PG8_WAIT_L
#undef PG8_BAR
#undef PG8_SCHED
}
}
namespace pg8 {
struct EpiResid {
    static constexpr bool PERM = false, AFTER_DRAIN = false;
    const float* base; float* out; int ldc;
    __device__ __forceinline__ void operator()(const f32x4 (&acc)[2][2][4][2], const Unit& u, int wr, int wc, int fr, int fq) const {
        const int col0 = u.pn * BM + wc * 32 + 4 * fq;
#pragma unroll
        for (int ai = 0; ai < 2; ++ai)
#pragma unroll
            for (int m = 0; m < 4; ++m) { const size_t off = (size_t)(u.pm * BM + ai * HALF + wr * 64 + m * 16 + fr) * ldc + col0;
#pragma unroll
                for (int bj = 0; bj < 2; ++bj)
#pragma unroll
                    for (int n = 0; n < 2; ++n) { const f32x4 b = *(const f32x4*)(base + off + bj * HALF + n * 16); *(f32x4*)(out + off + bj * HALF + n * 16) = b + acc[ai][bj][m][n]; } }
    }
};
}
constexpr int NWAVES = 8, NTHR = 512;
constexpr int BATCH = 2, T = 8192, D = 1024, M = BATCH * T, MH = T;
constexpr int NIN = 3728, NPAD = 3840;
constexpr int C_GQ = 0, C_GK = 256, C_GV = 512, C_GLR = 1024, C_GG = 1040, C_R = 1552, C_K = 2064, C_V = 2576, C_WL = 3088, C_AL = 3152, C_RG = 3216;
constexpr size_t MiB = 1u << 20;
constexpr size_t WS_WIN = 1 * MiB, WIN_BYTES = (size_t)NPAD * D * 2;
constexpr size_t WS_WOUT = 16 * MiB, WOUT_BYTES = (size_t)D * D * 2;
constexpr size_t WS_XN = 20 * MiB;
constexpr size_t WS_U = 52 * MiB;
constexpr size_t WS_END = 256 * MiB;
constexpr int LDS_BYTES = 147456;

typedef unsigned short bf16;
typedef unsigned v4u __attribute__((ext_vector_type(4)));
typedef float f32x4 __attribute__((ext_vector_type(4)));
#define LDS_WAIT() asm volatile("s_waitcnt lgkmcnt(0)" ::: "memory")
__device__ __forceinline__ float bf2f(unsigned h) { return __uint_as_float(h << 16); }
__device__ __forceinline__ unsigned f2bf(float f) { unsigned u = __float_as_uint(f); return (u + 0x7fffu + ((u >> 16) & 1u)) >> 16; }
typedef __bf16 bf16x2_t __attribute__((ext_vector_type(2)));
typedef float f32x2_t __attribute__((ext_vector_type(2)));
__device__ __forceinline__ unsigned pk2(float lo, float hi) { const f32x2_t v = {lo, hi}; const bf16x2_t b = __builtin_convertvector(v, bf16x2_t); return __builtin_bit_cast(unsigned, b); }
__device__ __forceinline__ float wave_sum(float v) {
#pragma unroll
    for (int o = 1; o < 64; o <<= 1) v += __shfl_xor(v, o);
    return v;
}
__device__ __forceinline__ float sigm(float x) { return 1.f / (1.f + __expf(-x)); }
__device__ __forceinline__ float rl(float v, int l) { return __int_as_float(__builtin_amdgcn_readlane(__float_as_int(v), l)); }

struct Args { const float* in[18]; float* out; unsigned char* ws; };
typedef const Args __attribute__((address_space(4))) CArgs;
__device__ __forceinline__ CArgs* opaque_args() { CArgs* p = (CArgs*)__builtin_amdgcn_kernarg_segment_ptr(); asm volatile("" : "+s"(p)); return p; }
#define AA (*opaque_args())

__device__ __forceinline__ void transpose_item(const float* W, int K, int N, int Npad, bf16* WT, float* scr, int item, int lane) {
    const int nblk = Npad / 32, kb = item / nblk, nb = item % nblk, k0 = 64 * kb, n0 = 32 * nb;
    const int n = n0 + (lane & 31);
#pragma unroll 8
    for (int i = 0; i < 32; ++i) { const int kk = 2 * i + (lane >> 5); scr[kk * 33 + (lane & 31)] = (n < N) ? W[(size_t)(k0 + kk) * N + n] : 0.f; }
    LDS_WAIT();
    const int c = lane & 7;
#pragma unroll
    for (int j = 0; j < 4; ++j) { const int nn = (lane >> 3) + 8 * j; const float* s = scr + (8 * c) * 33 + nn;
        v4u o; o.x = pk2(s[0 * 33], s[1 * 33]); o.y = pk2(s[2 * 33], s[3 * 33]); o.z = pk2(s[4 * 33], s[5 * 33]); o.w = pk2(s[6 * 33], s[7 * 33]);
        *(v4u*)(WT + (size_t)(n0 + nn) * K + k0 + 8 * c) = o; }
    LDS_WAIT();
}
__device__ __forceinline__ void rms_row(const float* xrow, const float* w, bf16* obf, float* of32, int lane) {
    const f32x4* xr = (const f32x4*)xrow + lane; const f32x4* wr = (const f32x4*)w + lane;
    f32x4 v[4]; float s = 0.f;
#pragma unroll
    for (int j = 0; j < 4; ++j) { v[j] = xr[64 * j]; s += (v[j].x * v[j].x + v[j].y * v[j].y) + (v[j].z * v[j].z + v[j].w * v[j].w); }
    const float rs = rsqrtf(wave_sum(s) * (1.f / D) + 1e-6f);
#pragma unroll
    for (int j = 0; j < 4; ++j) { const f32x4 ww = wr[64 * j]; f32x4 o = v[j] * rs * ww;
        if (of32) ((f32x4*)of32 + lane)[64 * j] = o;
        else ((unsigned long long*)obf + lane)[64 * j] = (unsigned long long)pk2(o.x, o.y) | ((unsigned long long)pk2(o.z, o.w) << 32); }
}

typedef short bf16x8 __attribute__((ext_vector_type(8)));
typedef unsigned v2u __attribute__((ext_vector_type(2)));
constexpr int PITCH = 72, FP = 68, TP = 20;
constexpr int OFF_TW = 0, OFF_AL = 9216, OFF_ARK = 18432, OFF_XA = 27648, OFF_XW = 45056, OFF_AT = 63488, OFF_RT = 72704, OFF_BH = 81920, OFF_KH = 91136,
              OFF_BBT = 100352, OFF_KBT = 109568, OFF_VT = 118784, OFF_TII = 128000, OFF_TOT = 133120, OFF_BC = 135168;
constexpr int OFF_AAK = OFF_TW, OFF_ARB = OFF_AL, OFF_AAB = OFF_XA, OFF_XT = OFF_XW;
constexpr size_t WS_MC = 112 * MiB, WS_NC = 120 * MiB, WS_PP = 136 * MiB, WS_Y0 = 144 * MiB, WS_S0 = 160 * MiB, WS_DEC = 168 * MiB, WS_BON2 = 169 * MiB, WS_UPT = 170 * MiB;
constexpr int NUNIT = 1024;

__device__ __forceinline__ f32x4 mma2(const bf16* Arow, const bf16* Brow, f32x4 acc) {
    acc = __builtin_amdgcn_mfma_f32_16x16x32_bf16(*(const bf16x8*)(Arow), *(const bf16x8*)(Brow), acc, 0, 0, 0);
    acc = __builtin_amdgcn_mfma_f32_16x16x32_bf16(*(const bf16x8*)(Arow + 32), *(const bf16x8*)(Brow + 32), acc, 0, 0, 0);
    return acc;
}
__device__ __forceinline__ v2u pack4(f32x4 v) { v2u r; r.x = pk2(v.x, v.y); r.y = pk2(v.z, v.w); return r; }
__device__ __forceinline__ void unpack8(v4u w, float* o) { o[0] = bf2f(w.x & 0xffffu); o[1] = bf2f(w.x >> 16); o[2] = bf2f(w.y & 0xffffu); o[3] = bf2f(w.y >> 16);
    o[4] = bf2f(w.z & 0xffffu); o[5] = bf2f(w.z >> 16); o[6] = bf2f(w.w & 0xffffu); o[7] = bf2f(w.w >> 16); }
__device__ __forceinline__ v4u pack8(const float* v) { v4u r; r.x = pk2(v[0], v[1]); r.y = pk2(v[2], v[3]); r.z = pk2(v[4], v[5]); r.w = pk2(v[6], v[7]); return r; }

__device__ __forceinline__ void r1_phase(CArgs& a, int l, unsigned char* L, int tid) {
    asm volatile("" : "+v"(tid));
    const int lane = tid & 63, wave = __builtin_amdgcn_readfirstlane(tid >> 6), g = lane >> 4, c16 = lane & 15;
    const bf16* U = (const bf16*)(a.ws + WS_U);
    bf16* TW = (bf16*)(L + OFF_TW); bf16* ALm = (bf16*)(L + OFF_AL); bf16* ARK = (bf16*)(L + OFF_ARK); bf16* AAK = (bf16*)(L + OFF_AAK); bf16* ARB = (bf16*)(L + OFF_ARB);
    float* XA = (float*)(L + OFF_XA); float* XW = (float*)(L + OFF_XW); float* AAB = (float*)(L + OFF_AAB); bf16* XT = (bf16*)(L + OFF_XT);
    bf16* AT = (bf16*)(L + OFF_AT); bf16* RT = (bf16*)(L + OFF_RT); bf16* BH = (bf16*)(L + OFF_BH); bf16* KH = (bf16*)(L + OFF_KH);
    bf16* BBT = (bf16*)(L + OFF_BBT); bf16* KBT = (bf16*)(L + OFF_KBT); bf16* VT = (bf16*)(L + OFF_VT);
    float* TII = (float*)(L + OFF_TII); float* TOT = (float*)(L + OFF_TOT); float* BC = (float*)(L + OFF_BC);
    const bf16* UPT = (const bf16*)(a.ws + WS_UPT) + (size_t)l * 2 * 512 * 64;
    const float* mu = a.in[6] + l * 1664;
#pragma unroll 1
    for (int unit = blockIdx.x; unit < NUNIT; unit += gridDim.x) {
        const int ch = unit >> 3, h = unit & 7;
        {
            const int t = tid >> 3, cg = tid & 7, lr = 64 * ch + t;
            const bf16* up = U + (size_t)lr * NPAD + C_WL + 16 * cg;
            const v4u c0 = *(const v4u*)up, c1 = *(const v4u*)(up + 8);
            v4u p0 = {0u, 0u, 0u, 0u}, p1 = {0u, 0u, 0u, 0u};
            if (lr > 0) { p0 = *(const v4u*)(up - NPAD); p1 = *(const v4u*)(up - NPAD + 8); }
            float cu[16], pr[16], o[16]; unpack8(c0, cu); unpack8(c1, cu + 8); unpack8(p0, pr); unpack8(p1, pr + 8);
            const float* mp = mu + 1536 + 16 * cg;
#pragma unroll
            for (int i = 0; i < 16; ++i) { float mv = cu[i] + (pr[i] - cu[i]) * mp[i]; if (cg < 4) mv = tanhf(mv); o[i] = mv; }
            bf16* dst = (cg < 4 ? TW : ALm) + t * PITCH + 16 * (cg & 3);
            *(v4u*)dst = pack8(o); *(v4u*)(dst + 8) = pack8(o + 8);
        }
        __syncthreads();
        {
            const int q = wave >> 2, dt = wave & 3;
            const bf16* WT = UPT + (size_t)q * 512 * 64 + (size_t)(64 * h + 16 * dt + c16) * 64 + 8 * g;
            const bf16x8 a0 = *(const bf16x8*)WT, a1 = *(const bf16x8*)(WT + 32);
            const bf16* Bm = q ? ALm : TW; float* X = q ? XA : XW;
#pragma unroll
            for (int tt = 0; tt < 4; ++tt) { const bf16* br = Bm + (16 * tt + c16) * PITCH + 8 * g; f32x4 acc = {0.f, 0.f, 0.f, 0.f};
                acc = __builtin_amdgcn_mfma_f32_16x16x32_bf16(a0, *(const bf16x8*)br, acc, 0, 0, 0);
                acc = __builtin_amdgcn_mfma_f32_16x16x32_bf16(a1, *(const bf16x8*)(br + 32), acc, 0, 0, 0);
                *(f32x4*)(X + (16 * tt + c16) * FP + 16 * dt + 4 * g) = acc; }
        }
        __syncthreads();
        const int t = tid >> 3, dg = tid & 7, d0 = 8 * dg, lr = 64 * ch + t, hc = 64 * h + d0;
        float r[8], kq[8], v[8], al[8], be[8], lw[8];
        {
            const bf16* up = U + (size_t)lr * NPAD + hc;
            float rc[8], rp[8], kc[8], kp[8], vc[8], vp[8];
            unpack8(*(const v4u*)(up + C_R), rc); unpack8(*(const v4u*)(up + C_K), kc); unpack8(*(const v4u*)(up + C_V), vc);
            if (lr > 0) { unpack8(*(const v4u*)(up + C_R - NPAD), rp); unpack8(*(const v4u*)(up + C_K - NPAD), kp); unpack8(*(const v4u*)(up + C_V - NPAD), vp); }
            else {
#pragma unroll
                for (int i = 0; i < 8; ++i) { rp[i] = 0.f; kp[i] = 0.f; vp[i] = 0.f; } }
            const float* w0p = a.in[7] + l * 512 + hc; const float* a0p = a.in[9] + l * 512 + hc; const float* kkp = a.in[11] + l * 512 + hc;
            const float* kap = a.in[12] + l * 512 + hc; const float* rkp = a.in[13] + l * 512 + hc;
            float nn = 0.f, bon = 0.f, kk[8], av[8];
#pragma unroll
            for (int i = 0; i < 8; ++i) {
                const float xw = XW[t * FP + d0 + i] + w0p[i], xa = XA[t * FP + d0 + i] + a0p[i];
                lw[i] = -0.60653065971f * sigm(xw); av[i] = sigm(xa);
                r[i] = rc[i] + (rp[i] - rc[i]) * mu[hc + i]; const float k = kc[i] + (kp[i] - kc[i]) * mu[512 + hc + i]; v[i] = vc[i] + (vp[i] - vc[i]) * mu[1024 + hc + i];
                kk[i] = k * kkp[i]; nn += kk[i] * kk[i];
                kq[i] = k * (1.f + (av[i] - 1.f) * kap[i]); bon += r[i] * kq[i] * rkp[i];
            }
            nn += __shfl_xor(nn, 1); nn += __shfl_xor(nn, 2); nn += __shfl_xor(nn, 4);
            bon += __shfl_xor(bon, 1); bon += __shfl_xor(bon, 2); bon += __shfl_xor(bon, 4);
            const float inv = 1.f / fmaxf(sqrtf(nn), 1e-12f);
#pragma unroll
            for (int i = 0; i < 8; ++i) { const float kn = kk[i] * inv; al[i] = -kn; be[i] = av[i] * kn; XW[t * FP + d0 + i] = lw[i]; }
            if (dg == 0) ((float*)(a.ws + WS_BON2))[lr * 8 + h] = bon;
        }
        __syncthreads();
        {
            const int d = tid & 63, tb = tid >> 6; float p[8]; float run = 0.f;
#pragma unroll
            for (int i = 0; i < 8; ++i) { run += XW[(8 * tb + i) * FP + d]; p[i] = run; }
            TOT[tb * 64 + d] = run;
            __syncthreads();
            float off = 0.f;
#pragma unroll
            for (int j = 0; j < 8; ++j) off += (j < tb) ? TOT[j * 64 + d] : 0.f;
#pragma unroll
            for (int i = 0; i < 8; ++i) XW[(8 * tb + i) * FP + d] = off + p[i];
            if (tb == 7) BC[d] = off + run;
        }
        __syncthreads();
        {
            float at[8], rt[8], bh[8], kh[8];
#pragma unroll
            for (int i = 0; i < 8; ++i) { const float b = XW[t * FP + d0 + i], bc = BC[d0 + i];
                const float eb = __expf(b), enb = __expf(-b), ebp = __expf(b - lw[i]), ebc = __expf(bc - b);
                at[i] = al[i] * ebp; rt[i] = r[i] * eb; bh[i] = be[i] * enb; kh[i] = kq[i] * enb;
                BBT[(d0 + i) * PITCH + t] = (bf16)f2bf(be[i] * ebc); KBT[(d0 + i) * PITCH + t] = (bf16)f2bf(kq[i] * ebc); VT[(d0 + i) * PITCH + t] = (bf16)f2bf(v[i]); }
            *(v4u*)(AT + t * PITCH + d0) = pack8(at); *(v4u*)(RT + t * PITCH + d0) = pack8(rt); *(v4u*)(BH + t * PITCH + d0) = pack8(bh); *(v4u*)(KH + t * PITCH + d0) = pack8(kh);
        }
        __syncthreads();
        {
            const int q = wave >> 1, mh = wave & 1;
            const bf16* As = (q < 2) ? AT : RT; const bf16* Bs = (q & 1) ? KH : BH;
#pragma unroll
            for (int t2 = 0; t2 < 2; ++t2) { const int tt = 2 * mh + t2; const int tcol = 16 * tt + c16;
#pragma unroll
                for (int jt = 0; jt < 4; ++jt) {
                    f32x4 acc = {0.f, 0.f, 0.f, 0.f};
                    if (jt <= tt) { acc = mma2(Bs + (16 * jt + c16) * PITCH + 8 * g, As + tcol * PITCH + 8 * g, acc);
#pragma unroll
                        for (int j = 0; j < 4; ++j) { const int jj = 16 * jt + 4 * g + j; const bool keep = (q < 2) ? (jj < tcol) : (jj <= tcol); if (!keep) acc[j] = 0.f; } }
                    if (q == 0) *(f32x4*)(AAB + tcol * FP + 16 * jt + 4 * g) = acc;
                    else { bf16* dst = (q == 1 ? AAK : (q == 2 ? ARB : ARK)); *(v2u*)(dst + tcol * PITCH + 16 * jt + 4 * g) = pack4(acc); }
                } }
        }
        __syncthreads();
        f32x4 Z[4];
        {
            if (wave == 0) { const int i = g; float Tc[16];
#pragma unroll
                for (int tr = 0; tr < 16; ++tr) { float s = (c16 == tr) ? 1.f : 0.f; const float* ar = AAB + (16 * i + tr) * FP + 16 * i;
#pragma unroll
                    for (int j = 0; j < 16; ++j) if (j < tr) s += ar[j] * Tc[j];
                    Tc[tr] = s; TII[(i * 16 + tr) * TP + c16] = s; } }
            if (wave < 4) {
#pragma unroll
                for (int i = 0; i < 4; ++i)
#pragma unroll
                    for (int j = 0; j < 4; ++j) Z[i][j] = bf2f(AT[(16 * i + 4 * g + j) * PITCH + 16 * wave + c16]);
            } else {
#pragma unroll
                for (int i = 0; i < 4; ++i) { f32x4 acc = {0.f, 0.f, 0.f, 0.f}; Z[i] = mma2(AAK + (16 * i + c16) * PITCH + 8 * g, VT + (16 * (wave - 4) + c16) * PITCH + 8 * g, acc); }
            }
        }
        __syncthreads();
        {
            f32x4 X[4];
#pragma unroll
            for (int i = 0; i < 4; ++i) { f32x4 z = Z[i];
#pragma unroll
                for (int kb = 0; kb < 4; ++kb) if (kb < i) { const f32x4 av = *(const f32x4*)(AAB + (16 * i + c16) * FP + 16 * kb + 4 * g);
#pragma unroll
                    for (int s = 0; s < 4; ++s) z = __builtin_amdgcn_mfma_f32_16x16x4f32(av[s], X[kb][s], z, 0, 0, 0); }
                const f32x4 tv = *(const f32x4*)(TII + (i * 16 + c16) * TP + 4 * g); f32x4 x = {0.f, 0.f, 0.f, 0.f};
#pragma unroll
                for (int s = 0; s < 4; ++s) x = __builtin_amdgcn_mfma_f32_16x16x4f32(tv[s], z[s], x, 0, 0, 0);
                X[i] = x; }
#pragma unroll
            for (int i = 0; i < 4; ++i) *(v2u*)(XT + (16 * wave + c16) * PITCH + 16 * i + 4 * g) = pack4(X[i]);
        }
        __syncthreads();
        {
            const int q = wave >> 1, hh = wave & 1;
            bf16* MCg = (bf16*)(a.ws + WS_MC) + (size_t)unit * 4096; bf16* NCg = (bf16*)(a.ws + WS_NC) + (size_t)unit * 4096;
            bf16* PPg = (bf16*)(a.ws + WS_PP) + (size_t)unit * 4096; float* Y0g = (float*)(a.ws + WS_Y0) + (size_t)unit * 4096;
#pragma unroll
            for (int t2 = 0; t2 < 2; ++t2) { const int ti = 2 * hh + t2;
#pragma unroll
                for (int tj = 0; tj < 4; ++tj) { f32x4 acc = {0.f, 0.f, 0.f, 0.f}; const int cc = 16 * tj + c16, rr = 16 * ti + 4 * g;
                    if (q == 0) { acc = mma2(XT + (16 * ti + c16) * PITCH + 8 * g, BBT + cc * PITCH + 8 * g, acc); *(v2u*)(MCg + cc * 64 + (ti >> 1) * 32 + g * 8 + (ti & 1) * 4) = pack4(acc); }
                    else if (q == 1) { acc = mma2(BBT + (16 * ti + c16) * PITCH + 8 * g, XT + (64 + cc) * PITCH + 8 * g, acc); acc = mma2(KBT + (16 * ti + c16) * PITCH + 8 * g, VT + cc * PITCH + 8 * g, acc);
                        *(v2u*)(NCg + cc * 64 + rr) = pack4(acc); }
                    else if (q == 2) { acc = mma2(XT + (16 * ti + c16) * PITCH + 8 * g, ARB + cc * PITCH + 8 * g, acc);
                        const v2u rv = *(const v2u*)(RT + cc * PITCH + rr); acc[0] += bf2f(rv.x & 0xffffu); acc[1] += bf2f(rv.x >> 16); acc[2] += bf2f(rv.y & 0xffffu); acc[3] += bf2f(rv.y >> 16);
                        *(v2u*)(PPg + cc * 64 + rr) = pack4(acc); }
                    else { acc = mma2(ARB + (16 * ti + c16) * PITCH + 8 * g, XT + (64 + cc) * PITCH + 8 * g, acc); acc = mma2(ARK + (16 * ti + c16) * PITCH + 8 * g, VT + cc * PITCH + 8 * g, acc);
                        *(f32x4*)(Y0g + cc * 64 + rr) = acc; }
                } }
            if (tid < 64) ((float*)(a.ws + WS_DEC))[unit * 64 + tid] = __expf(BC[tid]);
        }
        __syncthreads();
    }
}

#define LAS3 __attribute__((address_space(3)))
constexpr int R2_SLOT = 10496, R2_NS = 13, R2_FLAGS = R2_SLOT * R2_NS;
__device__ __forceinline__ void r2_scan(CArgs& a, int chain, unsigned char* L, int tid) {
    asm volatile("" : "+v"(tid));
    const int lane = tid & 63, wave = __builtin_amdgcn_readfirstlane(tid >> 6);
    const int h = chain >> 2, e0 = 16 * (chain & 3), g = lane >> 4, c16 = lane & 15;
    volatile LAS3 unsigned* flg = (volatile LAS3 unsigned*)(LAS3 unsigned char*)(L + R2_FLAGS);
    if (tid < 32) flg[tid] = 0u;
    __syncthreads();
    const bf16* MC = (const bf16*)(a.ws + WS_MC); const bf16* NC = (const bf16*)(a.ws + WS_NC); const float* DEC = (const float*)(a.ws + WS_DEC);
    if (wave != 0) {
        int mco[8], nco[2];
#pragma unroll
        for (int q = 0; q < 8; ++q) { const int pos = 64 * q + lane, row = pos >> 3, kc = (pos & 7) ^ (row & 7); mco[q] = row * 64 + kc * 8; }
#pragma unroll
        for (int q = 0; q < 2; ++q) { const int pos = 64 * q + lane, e = pos >> 3, dc = (pos & 7) ^ (e & 7); nco[q] = (e0 + e) * 64 + dc * 8; }
        int prev = -1;
#pragma unroll 1
        for (int c = wave - 1; c < 128; c += 7) {
            while ((int)flg[16] < c - (R2_NS - 1)) __builtin_amdgcn_s_sleep(1);
            LAS3 unsigned char* slot = (LAS3 unsigned char*)(L + (c % R2_NS) * R2_SLOT);
            const size_t unit = (size_t)c * 8 + h;
#pragma unroll
            for (int q = 0; q < 8; ++q) __builtin_amdgcn_global_load_lds((const unsigned*)(MC + unit * 4096 + mco[q]), (LAS3 unsigned*)(slot + q * 1024), 16, 0, 0);
#pragma unroll
            for (int q = 0; q < 2; ++q) __builtin_amdgcn_global_load_lds((const unsigned*)(NC + unit * 4096 + nco[q]), (LAS3 unsigned*)(slot + 8192 + q * 1024), 16, 0, 0);
            __builtin_amdgcn_global_load_lds((const unsigned*)(DEC + unit * 64 + lane), (LAS3 unsigned*)(slot + 10240), 4, 0, 0);
            if (prev >= 0) { asm volatile("s_waitcnt vmcnt(11)" ::: "memory"); if (lane == 0) flg[prev % R2_NS] = (unsigned)(prev + 1); }
            prev = c;
        }
        asm volatile("s_waitcnt vmcnt(0)" ::: "memory");
        if (prev >= 0 && lane == 0) flg[prev % R2_NS] = (unsigned)(prev + 1);
    } else {
        bf16* S0 = (bf16*)(a.ws + WS_S0);
        f32x4 S[4];
#pragma unroll
        for (int m = 0; m < 4; ++m) S[m] = (f32x4){0.f, 0.f, 0.f, 0.f};
        int avail = 0;
#define R2_WAIT(c_) do { while (avail <= (c_)) { const unsigned f0_ = flg[(c_) % R2_NS], f1_ = flg[((c_) + 1) % R2_NS], f2_ = flg[((c_) + 2) % R2_NS], f3_ = flg[((c_) + 3) % R2_NS]; \
            if (f0_ == (unsigned)((c_) + 1)) { avail = (c_) + 1; if (f1_ == (unsigned)((c_) + 2)) { avail = (c_) + 2; if (f2_ == (unsigned)((c_) + 3)) { avail = (c_) + 3; if (f3_ == (unsigned)((c_) + 4)) avail = (c_) + 4; } } } \
            else __builtin_amdgcn_s_sleep(0); } asm volatile("" ::: "memory"); } while (0)
#define R2_READ(c_, A_, N_, D_) do { const LAS3 unsigned char* slot_ = (const LAS3 unsigned char*)(L + ((c_) % R2_NS) * R2_SLOT); \
            _Pragma("unroll") for (int mt = 0; mt < 4; ++mt) { const int row = 16 * mt + c16; \
                A_[mt][0] = *(const LAS3 v4u*)(slot_ + (row * 8 + (g ^ (row & 7))) * 16); A_[mt][1] = *(const LAS3 v4u*)(slot_ + (row * 8 + ((4 + g) ^ (row & 7))) * 16); \
                N_[mt] = *(const LAS3 v2u*)(slot_ + 8192 + (c16 * 8 + ((2 * mt + (g >> 1)) ^ (c16 & 7))) * 16 + (g & 1) * 8); \
                D_[mt] = *(const LAS3 f32x4*)(slot_ + 10240 + (16 * mt + 4 * g) * 4); } } while (0)
#define R2_STEP(c_, A_, N_, D_) do { const size_t ub_ = ((size_t)(c_) * 8 + h) * 4096; v2u sb_[4]; \
            _Pragma("unroll") for (int m = 0; m < 4; ++m) { sb_[m] = pack4(S[m]); *(v2u*)(S0 + ub_ + (e0 + c16) * 64 + 16 * m + 4 * g) = sb_[m]; } \
            const v4u b0_ = {sb_[0].x, sb_[0].y, sb_[1].x, sb_[1].y}, b1_ = {sb_[2].x, sb_[2].y, sb_[3].x, sb_[3].y}; \
            const bf16x8 B0_ = __builtin_bit_cast(bf16x8, b0_), B1_ = __builtin_bit_cast(bf16x8, b1_); \
            _Pragma("unroll") for (int mt = 0; mt < 4; ++mt) { const f32x4 nv_ = {bf2f(N_[mt].x & 0xffffu), bf2f(N_[mt].x >> 16), bf2f(N_[mt].y & 0xffffu), bf2f(N_[mt].y >> 16)}; \
                f32x4 acc_ = nv_ + S[mt] * D_[mt]; \
                acc_ = __builtin_amdgcn_mfma_f32_16x16x32_bf16(__builtin_bit_cast(bf16x8, A_[mt][0]), B0_, acc_, 0, 0, 0); \
                acc_ = __builtin_amdgcn_mfma_f32_16x16x32_bf16(__builtin_bit_cast(bf16x8, A_[mt][1]), B1_, acc_, 0, 0, 0); \
                S[mt] = acc_; } } while (0)
        v4u Aa[4][2], Ab[4][2]; v2u Na[4], Nb[4]; f32x4 Da[4], Db[4];
        R2_WAIT(0); R2_READ(0, Aa, Na, Da);
        asm volatile("s_waitcnt lgkmcnt(0)" ::: "memory");
#pragma unroll 1
        for (int c = 0; c < 128; c += 2) {
            if (lane == 0) flg[16] = (unsigned)(c + 1);
            R2_WAIT(c + 1); R2_READ(c + 1, Ab, Nb, Db);
            R2_STEP(c, Aa, Na, Da);
            asm volatile("s_waitcnt lgkmcnt(0)" ::: "memory");
            if (lane == 0) flg[16] = (unsigned)(c + 2);
            if (c + 2 < 128) { R2_WAIT(c + 2); R2_READ(c + 2, Aa, Na, Da); }
            R2_STEP(c + 1, Ab, Nb, Db);
            asm volatile("s_waitcnt lgkmcnt(0)" ::: "memory");
        }
#undef R2_WAIT
#undef R2_STEP
#undef R2_READ
    }
    __syncthreads();
}

__device__ __forceinline__ void r3_phase(CArgs& a, int l, int hb, int gw, int NGW, int lane) {
    asm volatile("" : "+v"(lane));
    const int g = lane >> 4, c16 = lane & 15;
    const bf16* U = (const bf16*)(a.ws + WS_U); const bf16* PP = (const bf16*)(a.ws + WS_PP); const bf16* S0 = (const bf16*)(a.ws + WS_S0); const float* Y0 = (const float*)(a.ws + WS_Y0);
    const float* BON = (const float*)(a.ws + WS_BON2); bf16* MG = (bf16*)(a.ws + WS_XN) + (size_t)hb * MH * D;
    const float* mu_v = a.in[6] + l * 1664 + 1024;
#pragma unroll 1
    for (int task = gw; task < NUNIT * 4; task += NGW) {
        const int unit = task >> 2, mt = task & 3, ch = unit >> 3, h = unit & 7; const size_t ub = (size_t)unit * 4096;
        const bf16x8 A0 = *(const bf16x8*)(PP + ub + (16 * mt + c16) * 64 + 8 * g), A1 = *(const bf16x8*)(PP + ub + (16 * mt + c16) * 64 + 32 + 8 * g);
        f32x4 Y[4];
#pragma unroll
        for (int nt = 0; nt < 4; ++nt) { const bf16* sr = S0 + ub + (16 * nt + c16) * 64 + 8 * g; f32x4 acc = *(const f32x4*)(Y0 + ub + (16 * nt + c16) * 64 + 16 * mt + 4 * g);
            acc = __builtin_amdgcn_mfma_f32_16x16x32_bf16(A0, *(const bf16x8*)sr, acc, 0, 0, 0);
            acc = __builtin_amdgcn_mfma_f32_16x16x32_bf16(A1, *(const bf16x8*)(sr + 32), acc, 0, 0, 0);
            Y[nt] = acc; }
        f32x4 mean = (Y[0] + Y[1]) + (Y[2] + Y[3]);
#pragma unroll
        for (int j = 0; j < 4; ++j) { float s = mean[j]; s += __shfl_xor(s, 1); s += __shfl_xor(s, 2); s += __shfl_xor(s, 4); s += __shfl_xor(s, 8); mean[j] = s * (1.f / 64.f); }
        f32x4 var = {0.f, 0.f, 0.f, 0.f};
#pragma unroll
        for (int nt = 0; nt < 4; ++nt) { const f32x4 dd = Y[nt] - mean; var += dd * dd; }
#pragma unroll
        for (int j = 0; j < 4; ++j) { float s = var[j]; s += __shfl_xor(s, 1); s += __shfl_xor(s, 2); s += __shfl_xor(s, 4); s += __shfl_xor(s, 8); var[j] = rsqrtf(s * (1.f / 64.f) + 64e-5f); }
#pragma unroll
        for (int j = 0; j < 4; ++j) { const int lr = 64 * ch + 16 * mt + 4 * g + j; const bf16* urow = U + (size_t)lr * NPAD; const float bon = BON[lr * 8 + h];
#pragma unroll
            for (int nt = 0; nt < 4; ++nt) { const int cc = 64 * h + 16 * nt + c16;
                const float yn = (Y[nt][j] - mean[j]) * var[j] * a.in[14][l * 512 + cc] + a.in[15][l * 512 + cc];
                const float vc = bf2f(urow[C_V + cc]), vp = lr > 0 ? bf2f(urow[C_V + cc - NPAD]) : 0.f; const float v = vc + (vp - vc) * mu_v[cc];
                const float rg = bf2f(urow[C_RG + cc]);
                MG[(size_t)lr * D + 512 + cc] = (bf16)f2bf((yn + bon * v) * rg * sigm(rg)); } }
    }
}

constexpr int OFF_GQI = 17408, OFF_GKI = 26624, OFF_GKST = 35840, OFF_GVT = 45056, OFF_GSC = 63488, OFF_GTOT = 72704, OFF_GBC = 74752;
constexpr size_t WS_QI = 171 * MiB, WS_OI = 175 * MiB, WS_DS = 191 * MiB, WS_GDEC = 207 * MiB, WS_SP = 208 * MiB;
constexpr int NGUNIT = 512;

__device__ __forceinline__ void g1_phase(CArgs& a, int l, unsigned char* L, int tid) {
    asm volatile("" : "+v"(tid));
    const int lane = tid & 63, wave = __builtin_amdgcn_readfirstlane(tid >> 6), g = lane >> 4, c16 = lane & 15;
    const bf16* U = (const bf16*)(a.ws + WS_U);
    float* XW = (float*)L; bf16* QI = (bf16*)(L + OFF_GQI); bf16* KI = (bf16*)(L + OFF_GKI); bf16* KST = (bf16*)(L + OFF_GKST); bf16* VT = (bf16*)(L + OFF_GVT); bf16* SC = (bf16*)(L + OFF_GSC);
    float* TOT = (float*)(L + OFF_GTOT); float* BC = (float*)(L + OFF_GBC);
#pragma unroll 1
    for (int unit = blockIdx.x; unit < NGUNIT; unit += gridDim.x) {
        const int ch = unit >> 2, h = unit & 3;
        const int t = tid >> 3, dg = tid & 7, d0 = 8 * dg, lr = 64 * ch + t, hc = 64 * h + d0;
        const bf16* urow = U + (size_t)lr * NPAD;
        float q[8], k[8];
        {
            float glr[16]; unpack8(*(const v4u*)(urow + C_GLR), glr); unpack8(*(const v4u*)(urow + C_GLR + 8), glr + 8);
            float x[8]; const float* gb = a.in[4] + l * 256 + hc; const float* gu = a.in[3] + l * 16 * 256 + hc;
#pragma unroll
            for (int i = 0; i < 8; ++i) x[i] = gb[i];
#pragma unroll
            for (int r = 0; r < 16; ++r) { const f32x4 u0 = *(const f32x4*)(gu + r * 256), u1 = *(const f32x4*)(gu + r * 256 + 4);
                x[0] += glr[r] * u0.x; x[1] += glr[r] * u0.y; x[2] += glr[r] * u0.z; x[3] += glr[r] * u0.w; x[4] += glr[r] * u1.x; x[5] += glr[r] * u1.y; x[6] += glr[r] * u1.z; x[7] += glr[r] * u1.w; }
#pragma unroll
            for (int i = 0; i < 8; ++i) XW[t * FP + d0 + i] = (fminf(x[i], 0.f) - log1pf(__expf(-fabsf(x[i])))) * (1.f / 16.f);
            unpack8(*(const v4u*)(urow + C_GQ + hc), q); unpack8(*(const v4u*)(urow + C_GK + hc), k);
            float vv[16]; const int e0 = 16 * dg; unpack8(*(const v4u*)(urow + C_GV + 128 * h + e0), vv); unpack8(*(const v4u*)(urow + C_GV + 128 * h + e0 + 8), vv + 8);
#pragma unroll
            for (int i = 0; i < 16; ++i) VT[(e0 + i) * PITCH + t] = (bf16)f2bf(vv[i]);
        }
        __syncthreads();
        {
            const int d = tid & 63, tb = tid >> 6; float p[8]; float run = 0.f;
#pragma unroll
            for (int i = 0; i < 8; ++i) { run += XW[(8 * tb + i) * FP + d]; p[i] = run; }
            TOT[tb * 64 + d] = run;
            __syncthreads();
            float off = 0.f;
#pragma unroll
            for (int j = 0; j < 8; ++j) off += (j < tb) ? TOT[j * 64 + d] : 0.f;
#pragma unroll
            for (int i = 0; i < 8; ++i) XW[(8 * tb + i) * FP + d] = off + p[i];
            if (tb == 7) BC[d] = off + run;
        }
        __syncthreads();
        {
            float qi[8], ki[8];
#pragma unroll
            for (int i = 0; i < 8; ++i) { const float b = XW[t * FP + d0 + i], bc = BC[d0 + i];
                qi[i] = q[i] * 0.125f * __expf(b); ki[i] = k[i] * __expf(-b); KST[(d0 + i) * PITCH + t] = (bf16)f2bf(k[i] * __expf(bc - b)); }
            const v4u qp = pack8(qi);
            *(v4u*)(QI + t * PITCH + d0) = qp; *(v4u*)(KI + t * PITCH + d0) = pack8(ki);
            *(v4u*)((bf16*)(a.ws + WS_QI) + (size_t)unit * 4096 + t * 64 + d0) = qp;
        }
        __syncthreads();
        {
            const int tt = wave >> 1; const int tcol = 16 * tt + c16;
#pragma unroll
            for (int j2 = 0; j2 < 2; ++j2) { const int jt = 2 * (wave & 1) + j2; f32x4 acc = {0.f, 0.f, 0.f, 0.f};
                if (jt <= tt) { acc = mma2(KI + (16 * jt + c16) * PITCH + 8 * g, QI + tcol * PITCH + 8 * g, acc);
#pragma unroll
                    for (int j = 0; j < 4; ++j) if (16 * jt + 4 * g + j > tcol) acc[j] = 0.f; }
                *(v2u*)(SC + tcol * PITCH + 16 * jt + 4 * g) = pack4(acc); }
            float* DSg = (float*)(a.ws + WS_DS) + (size_t)unit * 8192;
#pragma unroll
            for (int i = 0; i < 4; ++i) { const int tile = wave * 4 + i, dt = tile & 3, et = tile >> 2; f32x4 acc = {0.f, 0.f, 0.f, 0.f};
                acc = mma2(KST + (16 * dt + c16) * PITCH + 8 * g, VT + (16 * et + c16) * PITCH + 8 * g, acc);
                *(f32x4*)(DSg + (16 * et + c16) * 64 + 16 * dt + 4 * g) = acc; }
            if (tid < 64) ((float*)(a.ws + WS_GDEC))[unit * 64 + tid] = __expf(BC[tid]);
        }
        __syncthreads();
        {
            float* OIg = (float*)(a.ws + WS_OI) + (size_t)unit * 8192;
#pragma unroll
            for (int i = 0; i < 4; ++i) { const int tile = wave * 4 + i, tt = tile & 3, et = tile >> 2; f32x4 acc = {0.f, 0.f, 0.f, 0.f};
                acc = mma2(SC + (16 * tt + c16) * PITCH + 8 * g, VT + (16 * et + c16) * PITCH + 8 * g, acc);
                *(f32x4*)(OIg + (16 * et + c16) * 64 + 16 * tt + 4 * g) = acc; }
        }
        __syncthreads();
    }
}

__device__ __forceinline__ void g2_scan(CArgs& a, int gid) {
    asm volatile("" : "+v"(gid));
    const int h = gid >> 13, ed = gid & 8191, d = gid & 63;
    const float* DS = (const float*)(a.ws + WS_DS); const float* GD = (const float*)(a.ws + WS_GDEC); bf16* SP = (bf16*)(a.ws + WS_SP);
    float S = 0.f;
#pragma unroll 1
    for (int cb = 0; cb < 128; cb += 16) {
        float ds[16], dc[16];
#pragma unroll
        for (int i = 0; i < 16; ++i) { const size_t unit = (size_t)(cb + i) * 4 + h; ds[i] = DS[unit * 8192 + ed]; dc[i] = GD[unit * 64 + d]; }
#pragma unroll
        for (int i = 0; i < 16; ++i) { const size_t unit = (size_t)(cb + i) * 4 + h; SP[unit * 8192 + ed] = (bf16)f2bf(S); S = S * dc[i] + ds[i]; }
    }
}

__device__ __forceinline__ void g3_phase(CArgs& a, int l, int hb, int gw, int NGW, int lane) {
    asm volatile("" : "+v"(lane));
    const int g = lane >> 4, c16 = lane & 15;
    const bf16* U = (const bf16*)(a.ws + WS_U); const bf16* QI = (const bf16*)(a.ws + WS_QI); const bf16* SP = (const bf16*)(a.ws + WS_SP); const float* OI = (const float*)(a.ws + WS_OI);
    bf16* MG = (bf16*)(a.ws + WS_XN) + (size_t)hb * MH * D;
#pragma unroll 1
    for (int task = gw; task < NGUNIT * 4; task += NGW) {
        const int unit = task >> 2, mt = task & 3, ch = unit >> 2, h = unit & 3;
        const bf16* qr = QI + (size_t)unit * 4096 + (16 * mt + c16) * 64 + 8 * g;
        const bf16x8 A0 = *(const bf16x8*)qr, A1 = *(const bf16x8*)(qr + 32);
        f32x4 O[8]; f32x4 ss = {0.f, 0.f, 0.f, 0.f};
#pragma unroll
        for (int nt = 0; nt < 8; ++nt) { const bf16* sr = SP + (size_t)unit * 8192 + (16 * nt + c16) * 64 + 8 * g; f32x4 acc = *(const f32x4*)(OI + (size_t)unit * 8192 + (16 * nt + c16) * 64 + 16 * mt + 4 * g);
            acc = __builtin_amdgcn_mfma_f32_16x16x32_bf16(A0, *(const bf16x8*)sr, acc, 0, 0, 0);
            acc = __builtin_amdgcn_mfma_f32_16x16x32_bf16(A1, *(const bf16x8*)(sr + 32), acc, 0, 0, 0);
            O[nt] = acc; ss += acc * acc; }
#pragma unroll
        for (int j = 0; j < 4; ++j) { float s = ss[j]; s += __shfl_xor(s, 1); s += __shfl_xor(s, 2); s += __shfl_xor(s, 4); s += __shfl_xor(s, 8); ss[j] = rsqrtf(s * (1.f / 128.f) + 1e-6f); }
#pragma unroll
        for (int j = 0; j < 4; ++j) { const int lr = 64 * ch + 16 * mt + 4 * g + j; const bf16* urow = U + (size_t)lr * NPAD + C_GG + 128 * h;
#pragma unroll
            for (int nt = 0; nt < 8; ++nt) { const int e = 16 * nt + c16; const float gg = bf2f(urow[e]);
                MG[(size_t)lr * D + 128 * h + e] = (bf16)f2bf(O[nt][j] * ss[j] * a.in[5][l * 128 + e] * gg * sigm(gg)); } }
    }
}

#define LAS __attribute__((address_space(3)))
#define XB_TMO      128
#define XB_XCNT(j)  (256  + 64 * (j))
#define XB_XSUB(j)  (1280 + 64 * (j))
#define XB_XGEN(j)  (2304 + 64 * (j))
#define XB_TOP      3328
#define XB_TOPGEN   3392
#define XCD_BAR_WORDS 3456
#define XB_SPIN_CAP (1u << 18)

__device__ __forceinline__ unsigned xb_ld(unsigned* p)              { return __hip_atomic_load(p, __ATOMIC_RELAXED, __HIP_MEMORY_SCOPE_AGENT); }
__device__ __forceinline__ unsigned xb_add(unsigned* p, unsigned v) { return __hip_atomic_fetch_add(p, v, __ATOMIC_RELAXED, __HIP_MEMORY_SCOPE_AGENT); }
__device__ __forceinline__ unsigned xb_xcc_id() { return (unsigned)__builtin_amdgcn_s_getreg((3 << 11) | 20) & 0xFu; }
#define XB_SPIN(cond, bar) do { unsigned _sp = 0; while (cond) { __builtin_amdgcn_s_sleep(1); \
    if ((++_sp & 255u) == 0u) { if (xb_ld(&(bar)[XB_TMO])) break; if (_sp > XB_SPIN_CAP) { atomicAdd(&(bar)[XB_TMO], 1u); break; } } } } while (0)

struct XcdBarrier {
    unsigned* bar; unsigned x;
    volatile LAS unsigned* st;
};

__device__ __forceinline__ XcdBarrier xcd_barrier_post(unsigned* bar, volatile LAS unsigned* st) {
    XcdBarrier b; b.bar = bar; b.x = xb_xcc_id(); b.st = st;
    if (threadIdx.x == 0) (void)xb_add(&bar[XB_XCNT(b.x)], 1u);
    return b;
}
__device__ __forceinline__ void xcd_barrier_complete(unsigned* bar, unsigned x, unsigned& nloc, unsigned& nx) {
    const unsigned G = gridDim.x * gridDim.y * gridDim.z;
    unsigned sum, cnt, mine, sp = 0u;
    for (;;) {
        sum = 0u; cnt = 0u; mine = 0u;
#pragma unroll
        for (unsigned j = 0; j < 16; ++j) { const unsigned c = xb_ld(&bar[XB_XCNT(j)]); sum += c; cnt += (c > 0u) ? 1u : 0u; mine = (j == x) ? c : mine; }
        if (sum == G) break;
        __builtin_amdgcn_s_sleep(1);
        if ((++sp & 255u) == 0u) { if (xb_ld(&bar[XB_TMO])) break; if (sp > XB_SPIN_CAP) { atomicAdd(&bar[XB_TMO], 1u); break; } }
    }
    nloc = mine > 0u ? mine : 1u; nx = cnt > 0u ? cnt : 1u;
}

__device__ __forceinline__ void xcd_barrier(const XcdBarrier& b) {
    asm volatile("s_waitcnt vmcnt(0)" ::: "memory");
    __syncthreads();
    if (threadIdx.x == 0) {
        unsigned* bar = b.bar;
        __builtin_amdgcn_s_waitcnt(0);
        unsigned nloc = b.st[0], nx = b.st[1];
        if (nloc == 0u) { xcd_barrier_complete(bar, b.x, nloc, nx); b.st[0] = nloc; b.st[1] = nx; }
        const unsigned old = xb_add(&bar[XB_XSUB(b.x)], 1u);
        const unsigned gen = old / nloc;
        if (old + 1u == (gen + 1u) * nloc) {
            __builtin_amdgcn_fence(__ATOMIC_RELEASE, "agent");
            asm volatile("s_waitcnt vmcnt(0)" ::: "memory");
            const unsigned og = xb_add(&bar[XB_TOP], 1u);
            const unsigned tg = og / nx;
            if (og + 1u == (tg + 1u) * nx) xb_add(&bar[XB_TOPGEN], 1u);
            else XB_SPIN(xb_ld(&bar[XB_TOPGEN]) == tg, bar);
            __builtin_amdgcn_fence(__ATOMIC_ACQUIRE, "agent");
            xb_add(&bar[XB_XGEN(b.x)], 1u);
            asm volatile("s_waitcnt vmcnt(0)" ::: "memory");
        } else {
            XB_SPIN(xb_ld(&bar[XB_XGEN(b.x)]) == gen, bar);
            __builtin_amdgcn_fence(__ATOMIC_ACQUIRE, "agent");
            asm volatile("s_waitcnt vmcnt(0)" ::: "memory");
        }
    }
    __syncthreads();
}


__global__ void __launch_bounds__(NTHR, 2) hymba_fwd(Args a_kernarg) {
    extern __shared__ __attribute__((aligned(16))) unsigned char lds[];
    cg::grid_group grid = cg::this_grid();
    const int tid = threadIdx.x, lane = tid & 63, wave = __builtin_amdgcn_readfirstlane(tid >> 6);
    const int G = gridDim.x, gw = blockIdx.x * NWAVES + wave, NGW = G * NWAVES;
    volatile LAS unsigned* xst = (volatile LAS unsigned*)(LAS unsigned char*)(lds + LDS_BYTES - 64);
    if (tid < 2) xst[tid] = 0u;
    __syncthreads();
    const XcdBarrier xbar = xcd_barrier_post((unsigned*)AA.ws, xst);
    {
        CArgs& a = AA; bf16* XN = (bf16*)(a.ws + WS_XN);
        float* scr = (float*)lds + wave * (64 * 33);
        constexpr int I_IN = (D / 64) * (NPAD / 32), I_OUT = (D / 64) * (D / 32);
        for (int it = gw; it < 2 * (I_IN + I_OUT); it += NGW) {
            int r = it; const int l = r / (I_IN + I_OUT); r -= l * (I_IN + I_OUT);
            if (r < I_IN) transpose_item(a.in[2] + (size_t)l * D * NIN, D, NIN, NPAD, (bf16*)(a.ws + WS_WIN + l * WIN_BYTES), scr, r, lane);
            else transpose_item(a.in[16] + (size_t)l * D * D, D, D, D, (bf16*)(a.ws + WS_WOUT + l * WOUT_BYTES), scr, r - I_IN, lane);
        }
        for (int m = gw; m < M; m += NGW) rms_row(a.in[0] + (size_t)m * D, a.in[1], XN + (size_t)m * D, nullptr, lane);
        {
            bf16* UPT = (bf16*)(a.ws + WS_UPT);
            for (int e = blockIdx.x * NTHR + tid; e < 2 * 2 * 512 * 64; e += G * NTHR) { const int r = e & 63, c = (e >> 6) & 511, q = (e >> 15) & 1, ll = e >> 16;
                UPT[e] = (bf16)f2bf((q ? a.in[10] : a.in[8])[(size_t)ll * 64 * 512 + r * 512 + c]); }
        }
    }
    grid.sync();
    for (int l = 0; l < 2; ++l) {
        for (int hb = 0; hb < 2; ++hb) {
            {
                CArgs& a = AA; bf16* XN = (bf16*)(a.ws + WS_XN); bf16* U = (bf16*)(a.ws + WS_U);
                pg8::Gemm g{XN + (size_t)hb * MH * D, (const bf16*)(a.ws + WS_WIN + l * WIN_BYTES), MH, NPAD, D}; pg8::StaticOrder S; S.init(MH, NPAD, G, (int)blockIdx.x);
                pg8::EpiBf16<0> E{U, NPAD, nullptr, 0, 0, 1.f};
                pg8::gemm_phase<pg8::EpiBf16<0>, pg8::StaticOrder, true, true>((PG8_LAS unsigned char*)lds, g, S, E);
            }
            xcd_barrier(xbar);
            r1_phase(AA, l, lds, tid);
            g1_phase(AA, l, lds, tid);
            xcd_barrier(xbar);
            if (blockIdx.x < 32) r2_scan(AA, blockIdx.x, lds, tid);
            else if (blockIdx.x < 96) g2_scan(AA, (blockIdx.x - 32) * NTHR + tid);
            xcd_barrier(xbar);
            r3_phase(AA, l, hb, gw, NGW, lane);
            g3_phase(AA, l, hb, gw, NGW, lane);
            xcd_barrier(xbar);
        }
        {
            CArgs& a = AA; bf16* XN = (bf16*)(a.ws + WS_XN);
            pg8::Gemm g{XN, (const bf16*)(a.ws + WS_WOUT + l * WOUT_BYTES), M, D, D}; pg8::StaticOrder S; S.init(M, D, G, (int)blockIdx.x);
            pg8::EpiResid E{l == 0 ? a.in[0] : a.out, a.out, D};
            pg8::gemm_phase<pg8::EpiResid, pg8::StaticOrder, true, true>((PG8_LAS unsigned char*)lds, g, S, E);
        }
        xcd_barrier(xbar);
        { int ln = lane; asm volatile("" : "+v"(ln)); CArgs& a = AA; bf16* XN = (bf16*)(a.ws + WS_XN);
        if (l == 0) { for (int m = gw; m < M; m += NGW) rms_row(a.out + (size_t)m * D, a.in[1] + D, XN + (size_t)m * D, nullptr, ln); xcd_barrier(xbar); }
        else { for (int m = gw; m < M; m += NGW) rms_row(a.out + (size_t)m * D, a.in[17], nullptr, a.out + (size_t)m * D, ln); } }
    }
}

extern "C" void kernel_launch(void* const* d_in, const int* in_sizes, int n_in, void* d_out, int out_size, void* d_ws, size_t ws_size, hipStream_t stream) {
    static int grid = 0;
    if (grid == 0) {
        if (n_in != 18 || out_size != M * D || ws_size < WS_END) { fprintf(stderr, "kernel_launch: unexpected shapes n_in %d out %d ws %zu\n", n_in, out_size, ws_size); grid = -1; return; }
        int dev = 0, cus = 0, per_cu = 0;
        hipGetDevice(&dev); hipDeviceGetAttribute(&cus, hipDeviceAttributeMultiprocessorCount, dev);
        if (hipFuncSetAttribute((const void*)hymba_fwd, hipFuncAttributeMaxDynamicSharedMemorySize, LDS_BYTES) != hipSuccess) { fprintf(stderr, "kernel_launch: hipFuncSetAttribute failed\n"); grid = -1; return; }
        if (hipOccupancyMaxActiveBlocksPerMultiprocessor(&per_cu, (const void*)hymba_fwd, NTHR, LDS_BYTES) != hipSuccess || per_cu < 1) { fprintf(stderr, "kernel_launch: occupancy query failed (%d)\n", per_cu); grid = -1; return; }
        grid = cus * 1;
        fprintf(stderr, "kernel_launch: cus %d per_cu %d grid %d\n", cus, per_cu, grid);
    }
    if (grid < 0) return;
    if (hipMemsetAsync(d_ws, 0, 16384, stream) != hipSuccess) { fprintf(stderr, "kernel_launch: memset failed\n"); return; }
    Args a{};
    for (int i = 0; i < 18; ++i) a.in[i] = (const float*)d_in[i];
    a.out = (float*)d_out; a.ws = (unsigned char*)d_ws;
    void* args[] = {&a};
    hipError_t e = hipLaunchCooperativeKernel((const void*)hymba_fwd, dim3(grid), dim3(NTHR), args, LDS_BYTES, stream);
    if (e != hipSuccess) fprintf(stderr, "cooperative launch failed: %s (grid %d)\n", hipGetErrorString(e), grid);
}
```

```cpp
#include <hip/hip_runtime.h>
#include <hip/hip_cooperative_groups.h>
#include <cstdio>
#include <cstdint>
namespace cg = cooperative_groups;
namespace pg8 {
#define PG8_LAS __attribute__((address_space(3)))
typedef unsigned short bf16_t;
typedef short bf16x8 __attribute__((ext_vector_type(8)));
typedef float f32x4 __attribute__((ext_vector_type(4)));
typedef unsigned u32x4 __attribute__((ext_vector_type(4)));
constexpr int BM = 256, BK = 64, HALF = 128, HTB = HALF * BK * 2  , STAGE_BYTES = 8 * HTB, NXCD = 8, WGM = 8;

__host__ __device__ __forceinline__ int lds_byte(int r, int c) { const int st = (r >> 4) * 2 + (c >> 5), rr = r & 15, cc = c & 31, ob = rr * 64 + cc * 2; return st * 1024 + (ob ^ (((ob >> 9) & 1) << 5)); }
__host__ __device__ __forceinline__ void stage_rc(int b, int& R, int& C) { const int st = b / 1024, sb = b % 1024, swz = sb ^ (((sb >> 9) & 1) << 5); R = (st >> 1) * 16 + swz / 64; C = (st & 1) * 32 + (swz % 64) / 2; }
__host__ __device__ __forceinline__ int perm32(int rho) { const int n = rho >> 4, i = rho & 15; return 8 * (i >> 2) + 4 * n + (i & 3); }

struct Unit { int pm, pn; };
struct Gemm { const bf16_t* A; const bf16_t* Bt; int M, N, K; };

struct StaticOrder {
    int nM, nN, nwg, G, c;
    __host__ __device__ void init(int M, int N, int G_, int c_) { nM = M / BM; nN = N / BM; nwg = nM * nN; G = G_; c = c_; }
    __host__ __device__ bool next(int i, Unit& u) const {
        const long L = (long)i * G + c; if (L >= nwg) return false;
        int wgid = (int)L; { const int q = nwg / NXCD, r = nwg % NXCD, xcd = wgid % NXCD, off = wgid / NXCD; wgid = (xcd < r ? xcd * (q + 1) : r * (q + 1) + (xcd - r) * q) + off; }
        const int nig = WGM * nN, gid = wgid / nig, fm = gid * WGM, gsz = (nM - fm) < WGM ? (nM - fm) : WGM;
        u.pm = fm + ((wgid % nig) % gsz); u.pn = (wgid % nig) / gsz; return true;
    }
    __device__ __forceinline__ void a_ready(const Unit&) const {}
    __device__ __forceinline__ void done(const Unit&) const {}
};

__device__ __forceinline__ unsigned cvt_pk_bf16(float lo, float hi) { unsigned r; asm volatile("v_cvt_pk_bf16_f32 %0, %1, %2" : "=v"(r) : "v"(lo), "v"(hi)); return r; }
typedef float f32x2 __attribute__((ext_vector_type(2)));
__device__ __forceinline__ f32x2 gelu_pk(f32x2 v) {
    const f32x2 av = __builtin_elementwise_abs(v), d = av * 0.2316418882f + 1.0f;
    f32x2 t; t.x = __builtin_amdgcn_rcpf(d.x); t.y = __builtin_amdgcn_rcpf(d.y);
    f32x2 q = t * 0.5307027145f + (-0.7265760135f); q = q * t + 0.7107068705f; q = q * t + (-0.142248368f); q = q * t + 0.127414796f; q = q * t;
    const f32x2 s = (v * v) * (-0.72134752044f);
    f32x2 e; e.x = __builtin_amdgcn_exp2f(s.x); e.y = __builtin_amdgcn_exp2f(s.y);
    const f32x2 m = v * (q * e), r = v - m;
    f32x2 o; o.x = v.x < 0.f ? m.x : r.x; o.y = v.y < 0.f ? m.y : r.y; return o;
}

template <int ACT  > struct EpiBf16 {
    static constexpr bool PERM = true, AFTER_DRAIN = false; static_assert(ACT == 0 || ACT == 1, "EpiBf16: ACT is 0 (none) or 1 (gelu_pk)");
    bf16_t* O; int ldc; const float* bias; int split_cols; size_t split_stride; float scale0;
    __device__ __forceinline__ void operator()(const f32x4 (&acc)[2][2][4][2], const Unit& u, int wr, int wc, int fr, int fq) const {
        const int row0 = u.pm * BM + wr * 64 + fr; int colt = u.pn * BM; bf16_t* base = O;
        float sc = 1.f; if (split_cols) { const int t = colt / split_cols; base += (size_t)t * split_stride; colt -= t * split_cols; if (t == 0) sc = scale0; }
        const int col0 = colt + wc * 32 + 8 * fq, bcol0 = u.pn * BM + wc * 32 + 8 * fq;
        f32x4 bv[2][2];
#pragma unroll
        for (int bj = 0; bj < 2; ++bj)
#pragma unroll
            for (int n = 0; n < 2; ++n) bv[bj][n] = bias ? *(const f32x4*)(bias + bcol0 + bj * HALF + 4 * n) : (f32x4){0.f, 0.f, 0.f, 0.f};
#pragma unroll
        for (int ai = 0; ai < 2; ++ai)
#pragma unroll
            for (int m = 0; m < 4; ++m) { bf16_t* rowp = base + (size_t)(row0 + ai * HALF + m * 16) * ldc + col0;
#pragma unroll
                for (int bj = 0; bj < 2; ++bj) { f32x4 v0 = acc[ai][bj][m][0] + bv[bj][0], v1 = acc[ai][bj][m][1] + bv[bj][1];
                    if (ACT == 1) { f32x2 a = gelu_pk((f32x2){v0[0], v0[1]}), b = gelu_pk((f32x2){v0[2], v0[3]}), c = gelu_pk((f32x2){v1[0], v1[1]}), d = gelu_pk((f32x2){v1[2], v1[3]});
                        v0 = (f32x4){a.x, a.y, b.x, b.y}; v1 = (f32x4){c.x, c.y, d.x, d.y}; }
                    v0 = v0 * sc; v1 = v1 * sc; u32x4 w; w.x = cvt_pk_bf16(v0[0], v0[1]); w.y = cvt_pk_bf16(v0[2], v0[3]); w.z = cvt_pk_bf16(v1[0], v1[1]); w.w = cvt_pk_bf16(v1[2], v1[3]);
                    *(u32x4*)(rowp + bj * HALF) = w; } }
    }
};

template <class Epi, class Sched, bool ALIGN_EPI = false, bool SP2 = false>
__device__ __forceinline__ void gemm_phase(PG8_LAS unsigned char* lds, const Gemm g, const Sched& S, const Epi& E) {
    int tid_ = threadIdx.x; asm volatile("" : "+v"(tid_));
    const int tid = tid_, wid = __builtin_amdgcn_readfirstlane(tid >> 6), lane = tid & 63, wr = wid >> 2, wc = wid & 3, fr = lane & 15, fq = lane >> 4;
    const int K = g.K, nt = K / BK;
    unsigned voffA[2], voffB[2];
#pragma unroll
    for (int i = 0; i < 2; ++i) { int R, C; stage_rc(tid * 16 + i * 8192, R, C); const int Rb = Epi::PERM ? ((R & ~31) + perm32(R & 31)) : R;
        voffA[i] = (unsigned)(R * K + C) * 2u; voffB[i] = (unsigned)(Rb * K + C) * 2u; }
    const size_t kstep = (size_t)(BK * 2);
    const size_t hstep = (size_t)HALF * K * 2;
    const size_t tstep = 2 * hstep;
    const unsigned ldsw = (unsigned)wid * 1024u;
    const int aoff = lds_byte(wr * 64 + fr, fq * 8), boff = lds_byte(wc * 32 + fr, fq * 8);
#define PG8_SA(b, h) (((b) * 2 + (h)) * HTB)
#define PG8_SB(b, h) ((4 + (b) * 2 + (h)) * HTB)
#define PG8_STAGE(bufoff, gbase, voff) do { _Pragma("unroll") for (int _i = 0; _i < 2; ++_i) \
        __builtin_amdgcn_global_load_lds((const unsigned*)((const char*)(gbase) + (voff)[_i]), (PG8_LAS unsigned*)(lds + (bufoff) + ldsw + _i * 8192), 16, 0, 0); } while (0)
#define PG8_LDA(dst, b, h) do { _Pragma("unroll") for (int m = 0; m < 4; ++m) _Pragma("unroll") for (int k = 0; k < 2; ++k) dst[m][k] = *(const PG8_LAS bf16x8*)(lds + PG8_SA(b, h) + aoff + m * 2048 + k * 1024); } while (0)
#define PG8_LDB(dst, b, h) do { _Pragma("unroll") for (int n = 0; n < 2; ++n) _Pragma("unroll") for (int k = 0; k < 2; ++k) dst[n][k] = *(const PG8_LAS bf16x8*)(lds + PG8_SB(b, h) + boff + n * 2048 + k * 1024); } while (0)
#define PG8_MMA(ai, bj, At, Bt) do { __builtin_amdgcn_s_setprio(1); _Pragma("unroll") for (int m = 0; m < 4; ++m) _Pragma("unroll") for (int n = 0; n < 2; ++n) _Pragma("unroll") for (int k = 0; k < 2; ++k) \
        acc[ai][bj][m][n] = __builtin_amdgcn_mfma_f32_16x16x32_bf16(Bt[n][k], At[m][k], acc[ai][bj][m][n], 0, 0, 0); __builtin_amdgcn_s_setprio(0); } while (0)
#define PG8_WAIT_V(n) asm volatile("s_waitcnt vmcnt(" #n ")" ::: "memory")
#define PG8_WAIT_L(n) asm volatile("s_waitcnt lgkmcnt(" #n ")" ::: "memory")
#define PG8_BAR __builtin_amdgcn_s_barrier()
#define PG8_SCHED __builtin_amdgcn_sched_barrier(0)
    Unit cur, nxt; int ui = 0;
    if (!S.next(0, cur)) return;
    f32x4 acc[2][2][4][2];
#pragma unroll
    for (int a = 0; a < 2; ++a)
#pragma unroll
        for (int b = 0; b < 2; ++b)
#pragma unroll
            for (int m = 0; m < 4; ++m)
#pragma unroll
                for (int n = 0; n < 2; ++n) acc[a][b][m][n] = (f32x4){0.f, 0.f, 0.f, 0.f};
    bf16x8 At[4][2], B0[2][2], B1[2][2];
    const char* cA = (const char*)g.A + (size_t)cur.pm * tstep; const char* cB = (const char*)g.Bt + (size_t)cur.pn * tstep;
    S.a_ready(cur);
    if constexpr (SP2) {
        PG8_STAGE(PG8_SB(0, 0), cB, voffB); PG8_STAGE(PG8_SB(0, 1), cB + hstep, voffB); PG8_STAGE(PG8_SA(0, 0), cA, voffA); PG8_STAGE(PG8_SA(0, 1), cA + hstep, voffA);
        if (wr == 1) PG8_BAR;
        PG8_WAIT_V(2); PG8_BAR;
        PG8_STAGE(PG8_SB(1, 0), cB + kstep, voffB); PG8_STAGE(PG8_SA(1, 0), cA + kstep, voffA); PG8_STAGE(PG8_SB(1, 1), cB + hstep + kstep, voffB);
        PG8_WAIT_V(6); PG8_BAR;
    } else {
        PG8_STAGE(PG8_SB(0, 0), cB, voffB); PG8_STAGE(PG8_SA(0, 0), cA, voffA); PG8_STAGE(PG8_SB(0, 1), cB + hstep, voffB); PG8_STAGE(PG8_SA(0, 1), cA + hstep, voffA);
        if (wr == 1) PG8_BAR;
        PG8_WAIT_V(4); PG8_BAR;
        PG8_STAGE(PG8_SB(1, 0), cB + kstep, voffB); PG8_STAGE(PG8_SA(1, 0), cA + kstep, voffA); PG8_STAGE(PG8_SB(1, 1), cB + hstep + kstep, voffB);
        PG8_WAIT_V(6); PG8_BAR;
    }
    for (;;) {
        const bool has_next = S.next(ui + 1, nxt);
        const char* nA = has_next ? (const char*)g.A + (size_t)nxt.pm * tstep : cA; const char* nB = has_next ? (const char*)g.Bt + (size_t)nxt.pn * tstep : cB;
        for (int t = 0; t < nt; t += 2) {
            const bool last = (t == nt - 2);
            const char* a1 = cA + (size_t)(t + 1) * kstep;
            const char* a2 = last ? nA : cA + (size_t)(t + 2) * kstep; const char* b2 = last ? nB : cB + (size_t)(t + 2) * kstep;
            const char* a3 = a2 + kstep; const char* b3 = b2 + kstep;
            if (last && has_next) S.a_ready(nxt);
            if constexpr (SP2) {
            PG8_LDB(B0, 0, 0); PG8_LDB(B1, 0, 1); PG8_SCHED; PG8_LDA(At, 0, 0); PG8_STAGE(PG8_SA(1, 1), a1 + hstep, voffA);
            PG8_WAIT_V(8); PG8_WAIT_L(0); PG8_BAR; PG8_MMA(0, 0, At, B0); PG8_MMA(0, 1, At, B1); PG8_BAR; PG8_SCHED;
            PG8_LDA(At, 0, 1); PG8_STAGE(PG8_SB(0, 0), b2, voffB); PG8_STAGE(PG8_SB(0, 1), b2 + hstep, voffB); PG8_STAGE(PG8_SA(0, 0), a2, voffA);
            PG8_WAIT_V(8); PG8_WAIT_L(0); PG8_BAR; PG8_MMA(1, 0, At, B0); PG8_MMA(1, 1, At, B1); PG8_BAR; PG8_SCHED;
            PG8_LDB(B0, 1, 0); PG8_LDB(B1, 1, 1); PG8_SCHED; PG8_LDA(At, 1, 0); PG8_STAGE(PG8_SA(0, 1), a2 + hstep, voffA);
            PG8_WAIT_V(8); PG8_WAIT_L(0); PG8_BAR; PG8_MMA(0, 0, At, B0); PG8_MMA(0, 1, At, B1); PG8_BAR; PG8_SCHED;
            PG8_LDA(At, 1, 1); PG8_STAGE(PG8_SB(1, 0), b3, voffB); PG8_STAGE(PG8_SB(1, 1), b3 + hstep, voffB); PG8_STAGE(PG8_SA(1, 0), a3, voffA);
            PG8_WAIT_V(8); PG8_WAIT_L(0); PG8_BAR; PG8_MMA(1, 0, At, B0); PG8_MMA(1, 1, At, B1); PG8_BAR; PG8_SCHED;
            } else {
            PG8_LDB(B0, 0, 0); PG8_SCHED; PG8_LDA(At, 0, 0); PG8_STAGE(PG8_SA(1, 1), a1 + hstep, voffA);
            PG8_WAIT_L(8); PG8_BAR; PG8_WAIT_L(0); PG8_MMA(0, 0, At, B0); PG8_BAR; PG8_SCHED;
            PG8_LDB(B1, 0, 1); PG8_STAGE(PG8_SB(0, 0), b2, voffB);
            PG8_BAR; PG8_WAIT_L(0); PG8_MMA(0, 1, At, B1); PG8_BAR;
            PG8_LDA(At, 0, 1); PG8_STAGE(PG8_SA(0, 0), a2, voffA);
            PG8_BAR; PG8_WAIT_L(0); PG8_MMA(1, 0, At, B0); PG8_BAR; PG8_SCHED;
            PG8_STAGE(PG8_SB(0, 1), b2 + hstep, voffB);
            PG8_WAIT_V(6); PG8_BAR; PG8_MMA(1, 1, At, B1); PG8_BAR;
            PG8_LDB(B0, 1, 0); PG8_SCHED; PG8_LDA(At, 1, 0); PG8_STAGE(PG8_SA(0, 1), a2 + hstep, voffA);
            PG8_WAIT_L(8); PG8_BAR; PG8_WAIT_L(0); PG8_MMA(0, 0, At, B0); PG8_BAR; PG8_SCHED;
            PG8_LDB(B1, 1, 1); PG8_STAGE(PG8_SB(1, 0), b3, voffB);
            PG8_BAR; PG8_WAIT_L(0); PG8_MMA(0, 1, At, B1); PG8_BAR;
            PG8_LDA(At, 1, 1); PG8_STAGE(PG8_SA(1, 0), a3, voffA);
            PG8_BAR; PG8_WAIT_L(0); PG8_MMA(1, 0, At, B0); PG8_BAR; PG8_SCHED;
            PG8_STAGE(PG8_SB(1, 1), b3 + hstep, voffB);
            PG8_WAIT_V(6); PG8_BAR; PG8_MMA(1, 1, At, B1); PG8_BAR;
            }
        }
        if constexpr (ALIGN_EPI) { if (wr == 0) PG8_BAR; }
        if constexpr (!Epi::AFTER_DRAIN) { E(acc, cur, wr, wc, fr, fq); S.done(cur); }
        if (!has_next) break;
#pragma unroll
        for (int a = 0; a < 2; ++a)
#pragma unroll
            for (int b = 0; b < 2; ++b)
#pragma unroll
                for (int m = 0; m < 4; ++m)
#pragma unroll
                    for (int n = 0; n < 2; ++n) acc[a][b][m][n] = (f32x4){0.f, 0.f, 0.f, 0.f};
        cur = nxt; cA = nA; cB = nB; ++ui;
        if constexpr (ALIGN_EPI) { if (wr == 1) PG8_BAR; }
    }
    PG8_WAIT_V(0);
    if constexpr (!ALIGN_EPI) { if (wr == 0) PG8_BAR; }
    PG8_BAR;
    if constexpr (Epi::AFTER_DRAIN) { E.fused(acc, cur, wr, wc, fr, fq, lds, wid, lane); S.done(cur); }
#undef PG8_SA
#undef PG8_SB
#undef PG8_STAGE
#undef PG8_LDA
#undef PG8_LDB
#undef PG8_MMA
#undef PG8_WAIT_V
#undef PG8_WAIT_L
#undef PG8_BAR
#undef PG8_SCHED
}
}
namespace pg8 {
struct EpiResid {
    static constexpr bool PERM = false, AFTER_DRAIN = false;
    const float* base; float* out; int ldc;
    __device__ __forceinline__ void operator()(const f32x4 (&acc)[2][2][4][2], const Unit& u, int wr, int wc, int fr, int fq) const {
        const int col0 = u.pn * BM + wc * 32 + 4 * fq;
#pragma unroll
        for (int ai = 0; ai < 2; ++ai)
#pragma unroll
            for (int m = 0; m < 4; ++m) { const size_t off = (size_t)(u.pm * BM + ai * HALF + wr * 64 + m * 16 + fr) * ldc + col0;
#pragma unroll
                for (int bj = 0; bj < 2; ++bj)
#pragma unroll
                    for (int n = 0; n < 2; ++n) { const f32x4 b = *(const f32x4*)(base + off + bj * HALF + n * 16); *(f32x4*)(out + off + bj * HALF + n * 16) = b + acc[ai][bj][m][n]; } }
    }
};
}
constexpr int NWAVES = 8, NTHR = 512;
constexpr int BATCH = 2, T = 8192, D = 1024, M = BATCH * T, MH = T;
constexpr int NIN = 3728, NPAD = 3840;
constexpr int C_GQ = 0, C_GK = 256, C_GV = 512, C_GLR = 1024, C_GG = 1040, C_R = 1552, C_K = 2064, C_V = 2576, C_WL = 3088, C_AL = 3152, C_RG = 3216;
constexpr size_t MiB = 1u << 20;
constexpr size_t WS_WIN = 1 * MiB, WIN_BYTES = (size_t)NPAD * D * 2;
constexpr size_t WS_WOUT = 16 * MiB, WOUT_BYTES = (size_t)D * D * 2;
constexpr size_t WS_XN = 20 * MiB;
constexpr size_t WS_U = 52 * MiB;
constexpr size_t WS_END = 256 * MiB;
constexpr int LDS_BYTES = 147456;

typedef unsigned short bf16;
typedef unsigned v4u __attribute__((ext_vector_type(4)));
typedef float f32x4 __attribute__((ext_vector_type(4)));
#define LDS_WAIT() asm volatile("s_waitcnt lgkmcnt(0)" ::: "memory")
__device__ __forceinline__ float bf2f(unsigned h) { return __uint_as_float(h << 16); }
__device__ __forceinline__ unsigned f2bf(float f) { unsigned u = __float_as_uint(f); return (u + 0x7fffu + ((u >> 16) & 1u)) >> 16; }
typedef __bf16 bf16x2_t __attribute__((ext_vector_type(2)));
typedef float f32x2_t __attribute__((ext_vector_type(2)));
__device__ __forceinline__ unsigned pk2(float lo, float hi) { const f32x2_t v = {lo, hi}; const bf16x2_t b = __builtin_convertvector(v, bf16x2_t); return __builtin_bit_cast(unsigned, b); }
__device__ __forceinline__ float wave_sum(float v) {
#pragma unroll
    for (int o = 1; o < 64; o <<= 1) v += __shfl_xor(v, o);
    return v;
}
__device__ __forceinline__ float sigm(float x) { return __builtin_amdgcn_rcpf(1.f + __expf(-x)); }
__device__ __forceinline__ float tanh_fast(float x) { return 1.f - 2.f * __builtin_amdgcn_rcpf(1.f + __expf(2.f * x)); }
__device__ __forceinline__ float rl(float v, int l) { return __int_as_float(__builtin_amdgcn_readlane(__float_as_int(v), l)); }

struct Args { const float* in[18]; float* out; unsigned char* ws; };
typedef const Args __attribute__((address_space(4))) CArgs;
__device__ __forceinline__ CArgs* opaque_args() { CArgs* p = (CArgs*)__builtin_amdgcn_kernarg_segment_ptr(); asm volatile("" : "+s"(p)); return p; }
#define AA (*opaque_args())

__device__ __forceinline__ void transpose_item(const float* W, int K, int N, int Npad, bf16* WT, float* scr, int item, int lane) {
    const int nblk = Npad / 32, kb = item / nblk, nb = item % nblk, k0 = 64 * kb, n0 = 32 * nb;
    const int n = n0 + (lane & 31);
#pragma unroll 8
    for (int i = 0; i < 32; ++i) { const int kk = 2 * i + (lane >> 5); scr[kk * 33 + (lane & 31)] = (n < N) ? W[(size_t)(k0 + kk) * N + n] : 0.f; }
    LDS_WAIT();
    const int c = lane & 7;
#pragma unroll
    for (int j = 0; j < 4; ++j) { const int nn = (lane >> 3) + 8 * j; const float* s = scr + (8 * c) * 33 + nn;
        v4u o; o.x = pk2(s[0 * 33], s[1 * 33]); o.y = pk2(s[2 * 33], s[3 * 33]); o.z = pk2(s[4 * 33], s[5 * 33]); o.w = pk2(s[6 * 33], s[7 * 33]);
        *(v4u*)(WT + (size_t)(n0 + nn) * K + k0 + 8 * c) = o; }
    LDS_WAIT();
}
__device__ __forceinline__ void rms_row(const float* xrow, const float* w, bf16* obf, float* of32, int lane) {
    const f32x4* xr = (const f32x4*)xrow + lane; const f32x4* wr = (const f32x4*)w + lane;
    f32x4 v[4]; float s = 0.f;
#pragma unroll
    for (int j = 0; j < 4; ++j) { v[j] = xr[64 * j]; s += (v[j].x * v[j].x + v[j].y * v[j].y) + (v[j].z * v[j].z + v[j].w * v[j].w); }
    const float rs = rsqrtf(wave_sum(s) * (1.f / D) + 1e-6f);
#pragma unroll
    for (int j = 0; j < 4; ++j) { const f32x4 ww = wr[64 * j]; f32x4 o = v[j] * rs * ww;
        if (of32) ((f32x4*)of32 + lane)[64 * j] = o;
        else ((unsigned long long*)obf + lane)[64 * j] = (unsigned long long)pk2(o.x, o.y) | ((unsigned long long)pk2(o.z, o.w) << 32); }
}

typedef short bf16x8 __attribute__((ext_vector_type(8)));
typedef unsigned v2u __attribute__((ext_vector_type(2)));
constexpr int PITCH = 72, FP = 68, TP = 20;
constexpr int OFF_TW = 0, OFF_AL = 9216, OFF_ARK = 18432, OFF_XA = 27648, OFF_XW = 45056, OFF_AT = 63488, OFF_RT = 72704, OFF_BH = 81920, OFF_KH = 91136,
              OFF_BBT = 100352, OFF_KBT = 109568, OFF_VT = 118784, OFF_TII = 128000, OFF_TOT = 133120, OFF_BC = 135168;
constexpr int OFF_AAK = OFF_TW, OFF_ARB = OFF_AL, OFF_AAB = OFF_XA, OFF_XT = OFF_XW;
constexpr size_t WS_MC = 112 * MiB, WS_NC = 120 * MiB, WS_PP = 136 * MiB, WS_Y0 = 144 * MiB, WS_S0 = 160 * MiB, WS_DEC = 168 * MiB, WS_BON2 = 169 * MiB, WS_UPT = 170 * MiB;
constexpr int NUNIT = 1024;

__device__ __forceinline__ f32x4 mma2(const bf16* Arow, const bf16* Brow, f32x4 acc) {
    acc = __builtin_amdgcn_mfma_f32_16x16x32_bf16(*(const bf16x8*)(Arow), *(const bf16x8*)(Brow), acc, 0, 0, 0);
    acc = __builtin_amdgcn_mfma_f32_16x16x32_bf16(*(const bf16x8*)(Arow + 32), *(const bf16x8*)(Brow + 32), acc, 0, 0, 0);
    return acc;
}
__device__ __forceinline__ v2u pack4(f32x4 v) { v2u r; r.x = pk2(v.x, v.y); r.y = pk2(v.z, v.w); return r; }
__device__ __forceinline__ void unpack8(v4u w, float* o) { o[0] = bf2f(w.x & 0xffffu); o[1] = bf2f(w.x >> 16); o[2] = bf2f(w.y & 0xffffu); o[3] = bf2f(w.y >> 16);
    o[4] = bf2f(w.z & 0xffffu); o[5] = bf2f(w.z >> 16); o[6] = bf2f(w.w & 0xffffu); o[7] = bf2f(w.w >> 16); }
__device__ __forceinline__ v4u pack8(const float* v) { v4u r; r.x = pk2(v[0], v[1]); r.y = pk2(v[2], v[3]); r.z = pk2(v[4], v[5]); r.w = pk2(v[6], v[7]); return r; }

__device__ __forceinline__ void r1_phase(CArgs& a, int l, unsigned char* L, int tid) {
    asm volatile("" : "+v"(tid));
    const int lane = tid & 63, wave = __builtin_amdgcn_readfirstlane(tid >> 6), g = lane >> 4, c16 = lane & 15;
    const bf16* U = (const bf16*)(a.ws + WS_U);
    bf16* TW = (bf16*)(L + OFF_TW); bf16* ALm = (bf16*)(L + OFF_AL); bf16* ARK = (bf16*)(L + OFF_ARK); bf16* AAK = (bf16*)(L + OFF_AAK); bf16* ARB = (bf16*)(L + OFF_ARB);
    float* XA = (float*)(L + OFF_XA); float* XW = (float*)(L + OFF_XW); float* AAB = (float*)(L + OFF_AAB); bf16* XT = (bf16*)(L + OFF_XT);
    bf16* AT = (bf16*)(L + OFF_AT); bf16* RT = (bf16*)(L + OFF_RT); bf16* BH = (bf16*)(L + OFF_BH); bf16* KH = (bf16*)(L + OFF_KH);
    bf16* BBT = (bf16*)(L + OFF_BBT); bf16* KBT = (bf16*)(L + OFF_KBT); bf16* VT = (bf16*)(L + OFF_VT);
    float* TII = (float*)(L + OFF_TII); float* TOT = (float*)(L + OFF_TOT); float* BC = (float*)(L + OFF_BC);
    const bf16* UPT = (const bf16*)(a.ws + WS_UPT) + (size_t)l * 2 * 512 * 64;
    const float* mu = a.in[6] + l * 1664;
    float* WTS = (float*)(L + 135424);
    int hl = -1;
#pragma unroll 1
    for (int unit = blockIdx.x; unit < NUNIT; unit += gridDim.x) {
        const int ch = unit >> 3, h = unit & 7;
        if (h != hl) { hl = h; __syncthreads();
            if (tid < 64) { const int c = l * 512 + 64 * h + tid; WTS[tid] = a.in[7][c]; WTS[64 + tid] = a.in[9][c]; WTS[128 + tid] = a.in[11][c]; WTS[192 + tid] = a.in[12][c]; WTS[256 + tid] = a.in[13][c];
                WTS[320 + tid] = mu[64 * h + tid]; WTS[384 + tid] = mu[512 + 64 * h + tid]; WTS[448 + tid] = mu[1024 + 64 * h + tid]; }
            else if (tid < 192) WTS[512 + tid - 64] = mu[1536 + tid - 64];
            __syncthreads(); }
        const int t = tid >> 3, dg = tid & 7, d0 = 8 * dg, lr = 64 * ch + t, hc = 64 * h + d0;
        v4u Lrc, Lkc, Lvc, Lrp = {0u, 0u, 0u, 0u}, Lkp = {0u, 0u, 0u, 0u}, Lvp = {0u, 0u, 0u, 0u};
        { const bf16* up = U + (size_t)lr * NPAD + hc; Lrc = *(const v4u*)(up + C_R); Lkc = *(const v4u*)(up + C_K); Lvc = *(const v4u*)(up + C_V);
          if (lr > 0) { Lrp = *(const v4u*)(up + C_R - NPAD); Lkp = *(const v4u*)(up + C_K - NPAD); Lvp = *(const v4u*)(up + C_V - NPAD); } }
        {
            const int t = tid >> 3, cg = tid & 7, lr = 64 * ch + t;
            const bf16* up = U + (size_t)lr * NPAD + C_WL + 16 * cg;
            const v4u c0 = *(const v4u*)up, c1 = *(const v4u*)(up + 8);
            v4u p0 = {0u, 0u, 0u, 0u}, p1 = {0u, 0u, 0u, 0u};
            if (lr > 0) { p0 = *(const v4u*)(up - NPAD); p1 = *(const v4u*)(up - NPAD + 8); }
            float cu[16], pr[16], o[16]; unpack8(c0, cu); unpack8(c1, cu + 8); unpack8(p0, pr); unpack8(p1, pr + 8);
            const float* mp = WTS + 512 + 16 * cg;
#pragma unroll
            for (int i = 0; i < 16; ++i) { float mv = cu[i] + (pr[i] - cu[i]) * mp[i]; if (cg < 4) mv = tanh_fast(mv); o[i] = mv; }
            bf16* dst = (cg < 4 ? TW : ALm) + t * PITCH + 16 * (cg & 3);
            *(v4u*)dst = pack8(o); *(v4u*)(dst + 8) = pack8(o + 8);
        }
        __syncthreads();
        {
            const int q = wave >> 2, dt = wave & 3;
            const bf16* WT = UPT + (size_t)q * 512 * 64 + (size_t)(64 * h + 16 * dt + c16) * 64 + 8 * g;
            const bf16x8 a0 = *(const bf16x8*)WT, a1 = *(const bf16x8*)(WT + 32);
            const bf16* Bm = q ? ALm : TW; float* X = q ? XA : XW;
#pragma unroll
            for (int tt = 0; tt < 4; ++tt) { const bf16* br = Bm + (16 * tt + c16) * PITCH + 8 * g; f32x4 acc = {0.f, 0.f, 0.f, 0.f};
                acc = __builtin_amdgcn_mfma_f32_16x16x32_bf16(a0, *(const bf16x8*)br, acc, 0, 0, 0);
                acc = __builtin_amdgcn_mfma_f32_16x16x32_bf16(a1, *(const bf16x8*)(br + 32), acc, 0, 0, 0);
                *(f32x4*)(X + (16 * tt + c16) * FP + 16 * dt + 4 * g) = acc; }
        }
        __syncthreads();
        float r[8], kq[8], v[8], al[8], be[8], lw[8];
        {
            float rc[8], rp[8], kc[8], kp[8], vc[8], vp[8];
            unpack8(Lrc, rc); unpack8(Lkc, kc); unpack8(Lvc, vc); unpack8(Lrp, rp); unpack8(Lkp, kp); unpack8(Lvp, vp);
            const float* w0p = WTS + d0; const float* a0p = WTS + 64 + d0; const float* kkp = WTS + 128 + d0;
            const float* kap = WTS + 192 + d0; const float* rkp = WTS + 256 + d0;
            float nn = 0.f, bon = 0.f, kk[8], av[8];
#pragma unroll
            for (int i = 0; i < 8; ++i) {
                const float xw = XW[t * FP + d0 + i] + w0p[i], xa = XA[t * FP + d0 + i] + a0p[i];
                lw[i] = -0.60653065971f * sigm(xw); av[i] = sigm(xa);
                r[i] = rc[i] + (rp[i] - rc[i]) * WTS[320 + d0 + i]; const float k = kc[i] + (kp[i] - kc[i]) * WTS[384 + d0 + i]; v[i] = vc[i] + (vp[i] - vc[i]) * WTS[448 + d0 + i];
                kk[i] = k * kkp[i]; nn += kk[i] * kk[i];
                kq[i] = k * (1.f + (av[i] - 1.f) * kap[i]); bon += r[i] * kq[i] * rkp[i];
            }
            nn += __shfl_xor(nn, 1); nn += __shfl_xor(nn, 2); nn += __shfl_xor(nn, 4);
            bon += __shfl_xor(bon, 1); bon += __shfl_xor(bon, 2); bon += __shfl_xor(bon, 4);
            const float inv = __builtin_amdgcn_rsqf(fmaxf(nn, 1e-24f));
#pragma unroll
            for (int i = 0; i < 8; ++i) { const float kn = kk[i] * inv; al[i] = -kn; be[i] = av[i] * kn; XW[t * FP + d0 + i] = lw[i]; }
            if (dg == 0) ((float*)(a.ws + WS_BON2))[lr * 8 + h] = bon;
        }
        __syncthreads();
        {
            const int d = tid & 63, tb = tid >> 6; float p[8]; float run = 0.f;
#pragma unroll
            for (int i = 0; i < 8; ++i) { run += XW[(8 * tb + i) * FP + d]; p[i] = run; }
            TOT[tb * 64 + d] = run;
            __syncthreads();
            float off = 0.f;
#pragma unroll
            for (int j = 0; j < 8; ++j) off += (j < tb) ? TOT[j * 64 + d] : 0.f;
#pragma unroll
            for (int i = 0; i < 8; ++i) XW[(8 * tb + i) * FP + d] = off + p[i];
            if (tb == 7) BC[d] = off + run;
        }
        __syncthreads();
        {
            float at[8], rt[8], bh[8], kh[8];
#pragma unroll
            for (int i = 0; i < 8; ++i) { const float b = XW[t * FP + d0 + i], bc = BC[d0 + i];
                const float eb = __expf(b), enb = __expf(-b), ebp = __expf(b - lw[i]), ebc = __expf(bc - b);
                at[i] = al[i] * ebp; rt[i] = r[i] * eb; bh[i] = be[i] * enb; kh[i] = kq[i] * enb;
                BBT[(d0 + i) * PITCH + t] = (bf16)f2bf(be[i] * ebc); KBT[(d0 + i) * PITCH + t] = (bf16)f2bf(kq[i] * ebc); VT[(d0 + i) * PITCH + t] = (bf16)f2bf(v[i]); }
            *(v4u*)(AT + t * PITCH + d0) = pack8(at); *(v4u*)(RT + t * PITCH + d0) = pack8(rt); *(v4u*)(BH + t * PITCH + d0) = pack8(bh); *(v4u*)(KH + t * PITCH + d0) = pack8(kh);
        }
        __syncthreads();
        {
            const int q = wave >> 1, mh = wave & 1;
            const bf16* As = (q < 2) ? AT : RT; const bf16* Bs = (q & 1) ? KH : BH;
#pragma unroll
            for (int t2 = 0; t2 < 2; ++t2) { const int tt = 2 * mh + t2; const int tcol = 16 * tt + c16;
#pragma unroll
                for (int jt = 0; jt < 4; ++jt) {
                    f32x4 acc = {0.f, 0.f, 0.f, 0.f};
                    if (jt <= tt) { acc = mma2(Bs + (16 * jt + c16) * PITCH + 8 * g, As + tcol * PITCH + 8 * g, acc);
#pragma unroll
                        for (int j = 0; j < 4; ++j) { const int jj = 16 * jt + 4 * g + j; const bool keep = (q < 2) ? (jj < tcol) : (jj <= tcol); if (!keep) acc[j] = 0.f; } }
                    if (q == 0) *(f32x4*)(AAB + tcol * FP + 16 * jt + 4 * g) = acc;
                    else { bf16* dst = (q == 1 ? AAK : (q == 2 ? ARB : ARK)); *(v2u*)(dst + tcol * PITCH + 16 * jt + 4 * g) = pack4(acc); }
                } }
        }
        __syncthreads();
        f32x4 Z[4];
        {
            if (wave == 0) { const int i = g; float Tc[16];
#pragma unroll
                for (int tr = 0; tr < 16; ++tr) { float s0 = (c16 == tr) ? 1.f : 0.f, s1 = 0.f, s2 = 0.f, s3 = 0.f; const float* ar = AAB + (16 * i + tr) * FP + 16 * i;
#pragma unroll
                    for (int j = 0; j < 16; j += 4) { if (j < tr) s0 += ar[j] * Tc[j]; if (j + 1 < tr) s1 += ar[j + 1] * Tc[j + 1]; if (j + 2 < tr) s2 += ar[j + 2] * Tc[j + 2]; if (j + 3 < tr) s3 += ar[j + 3] * Tc[j + 3]; }
                    const float sv = (s0 + s1) + (s2 + s3); Tc[tr] = sv; TII[(i * 16 + tr) * TP + c16] = sv; } }
            if (wave < 4) {
#pragma unroll
                for (int i = 0; i < 4; ++i)
#pragma unroll
                    for (int j = 0; j < 4; ++j) Z[i][j] = bf2f(AT[(16 * i + 4 * g + j) * PITCH + 16 * wave + c16]);
            } else {
#pragma unroll
                for (int i = 0; i < 4; ++i) { f32x4 acc = {0.f, 0.f, 0.f, 0.f}; Z[i] = mma2(AAK + (16 * i + c16) * PITCH + 8 * g, VT + (16 * (wave - 4) + c16) * PITCH + 8 * g, acc); }
            }
        }
        __syncthreads();
        {
            f32x4 X[4];
#pragma unroll
            for (int i = 0; i < 4; ++i) { f32x4 z = Z[i];
#pragma unroll
                for (int kb = 0; kb < 4; ++kb) if (kb < i) { const f32x4 av = *(const f32x4*)(AAB + (16 * i + c16) * FP + 16 * kb + 4 * g);
#pragma unroll
                    for (int s = 0; s < 4; ++s) z = __builtin_amdgcn_mfma_f32_16x16x4f32(av[s], X[kb][s], z, 0, 0, 0); }
                const f32x4 tv = *(const f32x4*)(TII + (i * 16 + c16) * TP + 4 * g); f32x4 x = {0.f, 0.f, 0.f, 0.f};
#pragma unroll
                for (int s = 0; s < 4; ++s) x = __builtin_amdgcn_mfma_f32_16x16x4f32(tv[s], z[s], x, 0, 0, 0);
                X[i] = x; }
#pragma unroll
            for (int i = 0; i < 4; ++i) *(v2u*)(XT + (16 * wave + c16) * PITCH + 16 * i + 4 * g) = pack4(X[i]);
        }
        __syncthreads();
        {
            const int q = wave >> 1, hh = wave & 1;
            bf16* MCg = (bf16*)(a.ws + WS_MC) + (size_t)unit * 4096; float* NCg = (float*)(a.ws + WS_NC) + (size_t)unit * 4096;
            bf16* PPg = (bf16*)(a.ws + WS_PP) + (size_t)unit * 4096; float* Y0g = (float*)(a.ws + WS_Y0) + (size_t)unit * 4096;
#pragma unroll
            for (int t2 = 0; t2 < 2; ++t2) { const int ti = 2 * hh + t2;
#pragma unroll
                for (int tj = 0; tj < 4; ++tj) { f32x4 acc = {0.f, 0.f, 0.f, 0.f}; const int cc = 16 * tj + c16, rr = 16 * ti + 4 * g;
                    if (q == 0) { acc = mma2(XT + (16 * ti + c16) * PITCH + 8 * g, BBT + cc * PITCH + 8 * g, acc); *(v2u*)(MCg + cc * 64 + (ti >> 1) * 32 + g * 8 + (ti & 1) * 4) = pack4(acc); }
                    else if (q == 1) { acc = mma2(BBT + (16 * ti + c16) * PITCH + 8 * g, XT + (64 + cc) * PITCH + 8 * g, acc); acc = mma2(KBT + (16 * ti + c16) * PITCH + 8 * g, VT + cc * PITCH + 8 * g, acc);
                        *(f32x4*)(NCg + cc * 64 + rr) = acc; }
                    else if (q == 2) { acc = mma2(XT + (16 * ti + c16) * PITCH + 8 * g, ARB + cc * PITCH + 8 * g, acc);
                        const v2u rv = *(const v2u*)(RT + cc * PITCH + rr); acc[0] += bf2f(rv.x & 0xffffu); acc[1] += bf2f(rv.x >> 16); acc[2] += bf2f(rv.y & 0xffffu); acc[3] += bf2f(rv.y >> 16);
                        *(v2u*)(PPg + cc * 64 + rr) = pack4(acc); }
                    else { acc = mma2(XT + (64 + 16 * ti + c16) * PITCH + 8 * g, ARB + cc * PITCH + 8 * g, acc); acc = mma2(VT + (16 * ti + c16) * PITCH + 8 * g, ARK + cc * PITCH + 8 * g, acc);
                        *(f32x4*)(Y0g + cc * 64 + rr) = acc; }
                } }
            if (tid < 64) ((float*)(a.ws + WS_DEC))[unit * 64 + tid] = __expf(BC[tid]);
        }
        __syncthreads();
    }
}

#define LAS3 __attribute__((address_space(3)))
constexpr int R2_SLOT = 12544, R2_NS = 11, R2_FLAGS = R2_SLOT * R2_NS;
__device__ __forceinline__ void r2_scan(CArgs& a, int chain, unsigned char* L, int tid) {
    asm volatile("" : "+v"(tid));
    const int lane = tid & 63, wave = __builtin_amdgcn_readfirstlane(tid >> 6);
    const int h = chain >> 2, e0 = 16 * (chain & 3), g = lane >> 4, c16 = lane & 15;
    volatile LAS3 unsigned* flg = (volatile LAS3 unsigned*)(LAS3 unsigned char*)(L + R2_FLAGS);
    if (tid < 32) flg[tid] = 0u;
    __syncthreads();
    const bf16* MC = (const bf16*)(a.ws + WS_MC); const float* NC = (const float*)(a.ws + WS_NC); const float* DEC = (const float*)(a.ws + WS_DEC);
    if (wave != 0) {
        int mco[8], nco[4];
#pragma unroll
        for (int q = 0; q < 8; ++q) { const int pos = 64 * q + lane, row = pos >> 3, kc = (pos & 7) ^ (row & 7); mco[q] = row * 64 + kc * 8; }
#pragma unroll
        for (int q = 0; q < 4; ++q) { const int pos = 64 * q + lane, e = pos >> 4, dc = (pos & 15) ^ e; nco[q] = (e0 + e) * 64 + dc * 4; }
        int prev = -1;
#pragma unroll 1
        for (int c = wave - 1; c < 128; c += 7) {
            while ((int)flg[16] < c - (R2_NS - 1)) __builtin_amdgcn_s_sleep(1);
            LAS3 unsigned char* slot = (LAS3 unsigned char*)(L + (c % R2_NS) * R2_SLOT);
            const size_t unit = (size_t)c * 8 + h;
#pragma unroll
            for (int q = 0; q < 8; ++q) __builtin_amdgcn_global_load_lds((const unsigned*)(MC + unit * 4096 + mco[q]), (LAS3 unsigned*)(slot + q * 1024), 16, 0, 0);
#pragma unroll
            for (int q = 0; q < 4; ++q) __builtin_amdgcn_global_load_lds((const unsigned*)(NC + unit * 4096 + nco[q]), (LAS3 unsigned*)(slot + 8192 + q * 1024), 16, 0, 0);
            __builtin_amdgcn_global_load_lds((const unsigned*)(DEC + unit * 64 + lane), (LAS3 unsigned*)(slot + 12288), 4, 0, 0);
            if (prev >= 0) { asm volatile("s_waitcnt vmcnt(13)" ::: "memory"); if (lane == 0) flg[prev % R2_NS] = (unsigned)(prev + 1); }
            prev = c;
        }
        asm volatile("s_waitcnt vmcnt(0)" ::: "memory");
        if (prev >= 0 && lane == 0) flg[prev % R2_NS] = (unsigned)(prev + 1);
    } else {
        bf16* S0 = (bf16*)(a.ws + WS_S0);
        f32x4 S[4];
#pragma unroll
        for (int m = 0; m < 4; ++m) S[m] = (f32x4){0.f, 0.f, 0.f, 0.f};
        int avail = 0;
#define R2_WAIT(c_) do { while (avail <= (c_)) { const unsigned f0_ = flg[(c_) % R2_NS], f1_ = flg[((c_) + 1) % R2_NS], f2_ = flg[((c_) + 2) % R2_NS], f3_ = flg[((c_) + 3) % R2_NS]; \
            if (f0_ == (unsigned)((c_) + 1)) { avail = (c_) + 1; if (f1_ == (unsigned)((c_) + 2)) { avail = (c_) + 2; if (f2_ == (unsigned)((c_) + 3)) { avail = (c_) + 3; if (f3_ == (unsigned)((c_) + 4)) avail = (c_) + 4; } } } \
            else __builtin_amdgcn_s_sleep(0); } asm volatile("" ::: "memory"); } while (0)
#define R2_READ(c_, A_, N_, D_) do { const LAS3 unsigned char* slot_ = (const LAS3 unsigned char*)(L + ((c_) % R2_NS) * R2_SLOT); \
            _Pragma("unroll") for (int mt = 0; mt < 4; ++mt) { const int row = 16 * mt + c16; \
                A_[mt][0] = *(const LAS3 v4u*)(slot_ + (row * 8 + (g ^ (row & 7))) * 16); A_[mt][1] = *(const LAS3 v4u*)(slot_ + (row * 8 + ((4 + g) ^ (row & 7))) * 16); \
                N_[mt] = *(const LAS3 f32x4*)(slot_ + 8192 + (c16 * 16 + ((4 * mt + g) ^ c16)) * 16); \
                D_[mt] = *(const LAS3 f32x4*)(slot_ + 12288 + (16 * mt + 4 * g) * 4); } } while (0)
#define R2_STEP(c_, A_, N_, D_) do { const size_t ub_ = ((size_t)(c_) * 8 + h) * 4096; v2u sb_[4]; \
            _Pragma("unroll") for (int m = 0; m < 4; ++m) { sb_[m] = pack4(S[m]); *(v2u*)(S0 + ub_ + (e0 + c16) * 64 + 16 * m + 4 * g) = sb_[m]; } \
            const v4u b0_ = {sb_[0].x, sb_[0].y, sb_[1].x, sb_[1].y}, b1_ = {sb_[2].x, sb_[2].y, sb_[3].x, sb_[3].y}; \
            const bf16x8 B0_ = __builtin_bit_cast(bf16x8, b0_), B1_ = __builtin_bit_cast(bf16x8, b1_); \
            f32x4 acc_[4]; \
            _Pragma("unroll") for (int mt = 0; mt < 4; ++mt) acc_[mt] = __builtin_amdgcn_mfma_f32_16x16x32_bf16(__builtin_bit_cast(bf16x8, A_[mt][0]), B0_, N_[mt] + S[mt] * D_[mt], 0, 0, 0); \
            _Pragma("unroll") for (int mt = 0; mt < 4; ++mt) S[mt] = __builtin_amdgcn_mfma_f32_16x16x32_bf16(__builtin_bit_cast(bf16x8, A_[mt][1]), B1_, acc_[mt], 0, 0, 0); } while (0)
        v4u Aa[4][2], Ab[4][2]; f32x4 Na[4], Nb[4]; f32x4 Da[4], Db[4];
        R2_WAIT(0); R2_READ(0, Aa, Na, Da);
        asm volatile("s_waitcnt lgkmcnt(0)" ::: "memory");
#pragma unroll 1
        for (int c = 0; c < 128; c += 2) {
            if (lane == 0) flg[16] = (unsigned)(c + 1);
            R2_WAIT(c + 1); R2_READ(c + 1, Ab, Nb, Db);
            R2_STEP(c, Aa, Na, Da);
            asm volatile("s_waitcnt lgkmcnt(0)" ::: "memory");
            if (lane == 0) flg[16] = (unsigned)(c + 2);
            if (c + 2 < 128) { R2_WAIT(c + 2); R2_READ(c + 2, Aa, Na, Da); }
            R2_STEP(c + 1, Ab, Nb, Db);
            asm volatile("s_waitcnt lgkmcnt(0)" ::: "memory");
        }
#undef R2_WAIT
#undef R2_STEP
#undef R2_READ
    }
    __syncthreads();
}

__device__ __forceinline__ void r3_phase(CArgs& a, int l, int hb, int gw, int NGW, int lane) {
    asm volatile("" : "+v"(lane));
    const int g = lane >> 4, c16 = lane & 15;
    const bf16* U = (const bf16*)(a.ws + WS_U); const bf16* PP = (const bf16*)(a.ws + WS_PP); const bf16* S0 = (const bf16*)(a.ws + WS_S0); const float* Y0 = (const float*)(a.ws + WS_Y0);
    const float* BON = (const float*)(a.ws + WS_BON2); bf16* MG = (bf16*)(a.ws + WS_XN) + (size_t)hb * MH * D;
    const float* mu_v = a.in[6] + l * 1664 + 1024; const float* lnw = a.in[14] + l * 512; const float* lnb = a.in[15] + l * 512;
#pragma unroll 1
    for (int task = gw; task < NUNIT * 4; task += NGW) {
        const int unit = task >> 2, mt = task & 3, ch = unit >> 3, h = unit & 7; const size_t ub = (size_t)unit * 4096;
        const int lr = 64 * ch + 16 * mt + c16; const bf16* urow = U + (size_t)lr * NPAD + 64 * h + 4 * g;
        v2u vc[4], vp[4], rgv[4];
#pragma unroll
        for (int et = 0; et < 4; ++et) { vc[et] = *(const v2u*)(urow + C_V + 16 * et); rgv[et] = *(const v2u*)(urow + C_RG + 16 * et); vp[et] = (v2u){0u, 0u}; if (lr > 0) vp[et] = *(const v2u*)(urow + C_V + 16 * et - NPAD); }
        const float bon = BON[lr * 8 + h];
        const bf16* pr = PP + ub + (16 * mt + c16) * 64 + 8 * g;
        const bf16x8 B0 = *(const bf16x8*)pr, B1 = *(const bf16x8*)(pr + 32);
        f32x4 Y[4];
#pragma unroll
        for (int et = 0; et < 4; ++et) { const bf16* sr = S0 + ub + (16 * et + c16) * 64 + 8 * g; f32x4 acc = *(const f32x4*)(Y0 + ub + (16 * mt + c16) * 64 + 16 * et + 4 * g);
            acc = __builtin_amdgcn_mfma_f32_16x16x32_bf16(*(const bf16x8*)sr, B0, acc, 0, 0, 0);
            acc = __builtin_amdgcn_mfma_f32_16x16x32_bf16(*(const bf16x8*)(sr + 32), B1, acc, 0, 0, 0);
            Y[et] = acc; }
        const f32x4 sv = (Y[0] + Y[1]) + (Y[2] + Y[3]); float sm = (sv.x + sv.y) + (sv.z + sv.w); sm += __shfl_xor(sm, 16); sm += __shfl_xor(sm, 32);
        const float mean = sm * (1.f / 64.f); float q = 0.f;
#pragma unroll
        for (int et = 0; et < 4; ++et) { const f32x4 dd = Y[et] - mean; q += (dd.x * dd.x + dd.y * dd.y) + (dd.z * dd.z + dd.w * dd.w); }
        q += __shfl_xor(q, 16); q += __shfl_xor(q, 32);
        const float rstd = rsqrtf(q * (1.f / 64.f) + 64e-5f);
#pragma unroll
        for (int et = 0; et < 4; ++et) { const int cc = 64 * h + 16 * et + 4 * g;
            const f32x4 w4 = *(const f32x4*)(lnw + cc), b4 = *(const f32x4*)(lnb + cc), m4 = *(const f32x4*)(mu_v + cc);
            const f32x4 vcf = {bf2f(vc[et].x & 0xffffu), bf2f(vc[et].x >> 16), bf2f(vc[et].y & 0xffffu), bf2f(vc[et].y >> 16)};
            const f32x4 vpf = {bf2f(vp[et].x & 0xffffu), bf2f(vp[et].x >> 16), bf2f(vp[et].y & 0xffffu), bf2f(vp[et].y >> 16)};
            const f32x4 rgf = {bf2f(rgv[et].x & 0xffffu), bf2f(rgv[et].x >> 16), bf2f(rgv[et].y & 0xffffu), bf2f(rgv[et].y >> 16)};
            const f32x4 vv = vcf + (vpf - vcf) * m4; const f32x4 yn = (Y[et] - mean) * rstd * w4 + b4;
            f32x4 o;
#pragma unroll
            for (int j = 0; j < 4; ++j) o[j] = (yn[j] + bon * vv[j]) * rgf[j] * sigm(rgf[j]);
            *(v2u*)(MG + (size_t)lr * D + 512 + cc) = pack4(o); }
    }
}

constexpr int OFF_GQI = 17408, OFF_GKI = 26624, OFF_GKST = 35840, OFF_GVT = 45056, OFF_GSC = 63488, OFF_GTOT = 72704, OFF_GBC = 74752;
constexpr size_t WS_QI = 171 * MiB, WS_OI = 175 * MiB, WS_DS = 191 * MiB, WS_GDEC = 207 * MiB, WS_SP = 208 * MiB;
constexpr int NGUNIT = 512;

__device__ __forceinline__ void g1_phase(CArgs& a, int l, unsigned char* L, int tid) {
    asm volatile("" : "+v"(tid));
    const int lane = tid & 63, wave = __builtin_amdgcn_readfirstlane(tid >> 6), g = lane >> 4, c16 = lane & 15;
    const bf16* U = (const bf16*)(a.ws + WS_U);
    float* XW = (float*)L; bf16* QI = (bf16*)(L + OFF_GQI); bf16* KI = (bf16*)(L + OFF_GKI); bf16* KST = (bf16*)(L + OFF_GKST); bf16* VT = (bf16*)(L + OFF_GVT); bf16* SC = (bf16*)(L + OFF_GSC);
    float* TOT = (float*)(L + OFF_GTOT); float* BC = (float*)(L + OFF_GBC);
#pragma unroll 1
    for (int unit = blockIdx.x; unit < NGUNIT; unit += gridDim.x) {
        const int ch = unit >> 2, h = unit & 3;
        const int t = tid >> 3, dg = tid & 7, d0 = 8 * dg, lr = 64 * ch + t, hc = 64 * h + d0;
        const bf16* urow = U + (size_t)lr * NPAD;
        float q[8], k[8];
        {
            float glr[16]; unpack8(*(const v4u*)(urow + C_GLR), glr); unpack8(*(const v4u*)(urow + C_GLR + 8), glr + 8);
            float x[8]; const float* gb = a.in[4] + l * 256 + hc; const float* gu = a.in[3] + l * 16 * 256 + hc;
#pragma unroll
            for (int i = 0; i < 8; ++i) x[i] = gb[i];
#pragma unroll
            for (int r = 0; r < 16; ++r) { const f32x4 u0 = *(const f32x4*)(gu + r * 256), u1 = *(const f32x4*)(gu + r * 256 + 4);
                x[0] += glr[r] * u0.x; x[1] += glr[r] * u0.y; x[2] += glr[r] * u0.z; x[3] += glr[r] * u0.w; x[4] += glr[r] * u1.x; x[5] += glr[r] * u1.y; x[6] += glr[r] * u1.z; x[7] += glr[r] * u1.w; }
#pragma unroll
            for (int i = 0; i < 8; ++i) XW[t * FP + d0 + i] = (fminf(x[i], 0.f) - log1pf(__expf(-fabsf(x[i])))) * (1.f / 16.f);
            unpack8(*(const v4u*)(urow + C_GQ + hc), q); unpack8(*(const v4u*)(urow + C_GK + hc), k);
            float vv[16]; const int e0 = 16 * dg; unpack8(*(const v4u*)(urow + C_GV + 128 * h + e0), vv); unpack8(*(const v4u*)(urow + C_GV + 128 * h + e0 + 8), vv + 8);
#pragma unroll
            for (int i = 0; i < 16; ++i) VT[(e0 + i) * PITCH + t] = (bf16)f2bf(vv[i]);
        }
        __syncthreads();
        {
            const int d = tid & 63, tb = tid >> 6; float p[8]; float run = 0.f;
#pragma unroll
            for (int i = 0; i < 8; ++i) { run += XW[(8 * tb + i) * FP + d]; p[i] = run; }
            TOT[tb * 64 + d] = run;
            __syncthreads();
            float off = 0.f;
#pragma unroll
            for (int j = 0; j < 8; ++j) off += (j < tb) ? TOT[j * 64 + d] : 0.f;
#pragma unroll
            for (int i = 0; i < 8; ++i) XW[(8 * tb + i) * FP + d] = off + p[i];
            if (tb == 7) BC[d] = off + run;
        }
        __syncthreads();
        {
            float qi[8], ki[8];
#pragma unroll
            for (int i = 0; i < 8; ++i) { const float b = XW[t * FP + d0 + i], bc = BC[d0 + i];
                qi[i] = q[i] * 0.125f * __expf(b); ki[i] = k[i] * __expf(-b); KST[(d0 + i) * PITCH + t] = (bf16)f2bf(k[i] * __expf(bc - b)); }
            const v4u qp = pack8(qi);
            *(v4u*)(QI + t * PITCH + d0) = qp; *(v4u*)(KI + t * PITCH + d0) = pack8(ki);
            *(v4u*)((bf16*)(a.ws + WS_QI) + (size_t)unit * 4096 + t * 64 + d0) = qp;
        }
        __syncthreads();
        {
            const int tt = wave >> 1; const int tcol = 16 * tt + c16;
#pragma unroll
            for (int j2 = 0; j2 < 2; ++j2) { const int jt = 2 * (wave & 1) + j2; f32x4 acc = {0.f, 0.f, 0.f, 0.f};
                if (jt <= tt) { acc = mma2(KI + (16 * jt + c16) * PITCH + 8 * g, QI + tcol * PITCH + 8 * g, acc);
#pragma unroll
                    for (int j = 0; j < 4; ++j) if (16 * jt + 4 * g + j > tcol) acc[j] = 0.f; }
                *(v2u*)(SC + tcol * PITCH + 16 * jt + 4 * g) = pack4(acc); }
            float* DSg = (float*)(a.ws + WS_DS) + (size_t)unit * 8192;
#pragma unroll
            for (int i = 0; i < 4; ++i) { const int tile = wave * 4 + i, dt = tile & 3, et = tile >> 2; f32x4 acc = {0.f, 0.f, 0.f, 0.f};
                acc = mma2(KST + (16 * dt + c16) * PITCH + 8 * g, VT + (16 * et + c16) * PITCH + 8 * g, acc);
                *(f32x4*)(DSg + (16 * et + c16) * 64 + 16 * dt + 4 * g) = acc; }
            if (tid < 64) ((float*)(a.ws + WS_GDEC))[unit * 64 + tid] = __expf(BC[tid]);
        }
        __syncthreads();
        {
            float* OIg = (float*)(a.ws + WS_OI) + (size_t)unit * 8192;
#pragma unroll
            for (int i = 0; i < 4; ++i) { const int tile = wave * 4 + i, tt = tile & 3, et = tile >> 2; f32x4 acc = {0.f, 0.f, 0.f, 0.f};
                acc = mma2(VT + (16 * et + c16) * PITCH + 8 * g, SC + (16 * tt + c16) * PITCH + 8 * g, acc);
                *(f32x4*)(OIg + (16 * tt + c16) * 128 + 16 * et + 4 * g) = acc; }
        }
        __syncthreads();
    }
}

__device__ __forceinline__ void g2_scan(CArgs& a, int gid) {
    asm volatile("" : "+v"(gid));
    const int h = gid >> 13, ed = gid & 8191, d = gid & 63;
    const float* DS = (const float*)(a.ws + WS_DS); const float* GD = (const float*)(a.ws + WS_GDEC); bf16* SP = (bf16*)(a.ws + WS_SP);
    float S = 0.f;
#pragma unroll 1
    for (int cb = 0; cb < 128; cb += 16) {
        float ds[16], dc[16];
#pragma unroll
        for (int i = 0; i < 16; ++i) { const size_t unit = (size_t)(cb + i) * 4 + h; ds[i] = DS[unit * 8192 + ed]; dc[i] = GD[unit * 64 + d]; }
#pragma unroll
        for (int i = 0; i < 16; ++i) { const size_t unit = (size_t)(cb + i) * 4 + h; SP[unit * 8192 + ed] = (bf16)f2bf(S); S = S * dc[i] + ds[i]; }
    }
}

__device__ __forceinline__ void g3_phase(CArgs& a, int l, int hb, int gw, int NGW, int lane) {
    asm volatile("" : "+v"(lane));
    const int g = lane >> 4, c16 = lane & 15;
    const bf16* U = (const bf16*)(a.ws + WS_U); const bf16* QI = (const bf16*)(a.ws + WS_QI); const bf16* SP = (const bf16*)(a.ws + WS_SP); const float* OI = (const float*)(a.ws + WS_OI);
    bf16* MG = (bf16*)(a.ws + WS_XN) + (size_t)hb * MH * D; const float* gnw = a.in[5] + l * 128;
#pragma unroll 1
    for (int task = gw; task < NGUNIT * 4; task += NGW) {
        const int unit = task >> 2, mt = task & 3, ch = unit >> 2, h = unit & 3;
        const int lr = 64 * ch + 16 * mt + c16; const bf16* urow = U + (size_t)lr * NPAD + C_GG + 128 * h + 4 * g;
        v2u ggv[8];
#pragma unroll
        for (int et = 0; et < 8; ++et) ggv[et] = *(const v2u*)(urow + 16 * et);
        const bf16* qr = QI + (size_t)unit * 4096 + (16 * mt + c16) * 64 + 8 * g;
        const bf16x8 B0 = *(const bf16x8*)qr, B1 = *(const bf16x8*)(qr + 32);
        f32x4 O[8]; float ss = 0.f;
#pragma unroll
        for (int et = 0; et < 8; ++et) { const bf16* sr = SP + (size_t)unit * 8192 + (16 * et + c16) * 64 + 8 * g; f32x4 acc = *(const f32x4*)(OI + (size_t)unit * 8192 + (16 * mt + c16) * 128 + 16 * et + 4 * g);
            acc = __builtin_amdgcn_mfma_f32_16x16x32_bf16(*(const bf16x8*)sr, B0, acc, 0, 0, 0);
            acc = __builtin_amdgcn_mfma_f32_16x16x32_bf16(*(const bf16x8*)(sr + 32), B1, acc, 0, 0, 0);
            O[et] = acc; ss += (acc.x * acc.x + acc.y * acc.y) + (acc.z * acc.z + acc.w * acc.w); }
        ss += __shfl_xor(ss, 16); ss += __shfl_xor(ss, 32);
        const float rstd = rsqrtf(ss * (1.f / 128.f) + 1e-6f);
#pragma unroll
        for (int et = 0; et < 8; ++et) { const int e = 16 * et + 4 * g; const f32x4 w4 = *(const f32x4*)(gnw + e);
            const f32x4 gf = {bf2f(ggv[et].x & 0xffffu), bf2f(ggv[et].x >> 16), bf2f(ggv[et].y & 0xffffu), bf2f(ggv[et].y >> 16)};
            f32x4 o;
#pragma unroll
            for (int j = 0; j < 4; ++j) o[j] = O[et][j] * rstd * w4[j] * gf[j] * sigm(gf[j]);
            *(v2u*)(MG + (size_t)lr * D + 128 * h + e) = pack4(o); }
    }
}

#define LAS __attribute__((address_space(3)))
#define XB_TMO      128
#define XB_XCNT(j)  (256  + 64 * (j))
#define XB_XSUB(j)  (1280 + 64 * (j))
#define XB_XGEN(j)  (2304 + 64 * (j))
#define XB_TOP      3328
#define XB_TOPGEN   3392
#define XCD_BAR_WORDS 3456
#define XB_SPIN_CAP (1u << 18)

__device__ __forceinline__ unsigned xb_ld(unsigned* p)              { return __hip_atomic_load(p, __ATOMIC_RELAXED, __HIP_MEMORY_SCOPE_AGENT); }
__device__ __forceinline__ unsigned xb_add(unsigned* p, unsigned v) { return __hip_atomic_fetch_add(p, v, __ATOMIC_RELAXED, __HIP_MEMORY_SCOPE_AGENT); }
__device__ __forceinline__ unsigned xb_xcc_id() { return (unsigned)__builtin_amdgcn_s_getreg((3 << 11) | 20) & 0xFu; }
#define XB_SPIN(cond, bar) do { unsigned _sp = 0; while (cond) { __builtin_amdgcn_s_sleep(1); \
    if ((++_sp & 255u) == 0u) { if (xb_ld(&(bar)[XB_TMO])) break; if (_sp > XB_SPIN_CAP) { atomicAdd(&(bar)[XB_TMO], 1u); break; } } } } while (0)

struct XcdBarrier {
    unsigned* bar; unsigned x;
    volatile LAS unsigned* st;
};

__device__ __forceinline__ XcdBarrier xcd_barrier_post(unsigned* bar, volatile LAS unsigned* st) {
    XcdBarrier b; b.bar = bar; b.x = xb_xcc_id(); b.st = st;
    if (threadIdx.x == 0) (void)xb_add(&bar[XB_XCNT(b.x)], 1u);
    return b;
}
__device__ __forceinline__ void xcd_barrier_complete(unsigned* bar, unsigned x, unsigned& nloc, unsigned& nx) {
    const unsigned G = gridDim.x * gridDim.y * gridDim.z;
    unsigned sum, cnt, mine, sp = 0u;
    for (;;) {
        sum = 0u; cnt = 0u; mine = 0u;
#pragma unroll
        for (unsigned j = 0; j < 16; ++j) { const unsigned c = xb_ld(&bar[XB_XCNT(j)]); sum += c; cnt += (c > 0u) ? 1u : 0u; mine = (j == x) ? c : mine; }
        if (sum == G) break;
        __builtin_amdgcn_s_sleep(1);
        if ((++sp & 255u) == 0u) { if (xb_ld(&bar[XB_TMO])) break; if (sp > XB_SPIN_CAP) { atomicAdd(&bar[XB_TMO], 1u); break; } }
    }
    nloc = mine > 0u ? mine : 1u; nx = cnt > 0u ? cnt : 1u;
}

__device__ __forceinline__ void xcd_barrier(const XcdBarrier& b) {
    asm volatile("s_waitcnt vmcnt(0)" ::: "memory");
    __syncthreads();
    if (threadIdx.x == 0) {
        unsigned* bar = b.bar;
        __builtin_amdgcn_s_waitcnt(0);
        unsigned nloc = b.st[0], nx = b.st[1];
        if (nloc == 0u) { xcd_barrier_complete(bar, b.x, nloc, nx); b.st[0] = nloc; b.st[1] = nx; }
        const unsigned old = xb_add(&bar[XB_XSUB(b.x)], 1u);
        const unsigned gen = old / nloc;
        if (old + 1u == (gen + 1u) * nloc) {
            __builtin_amdgcn_fence(__ATOMIC_RELEASE, "agent");
            asm volatile("s_waitcnt vmcnt(0)" ::: "memory");
            const unsigned og = xb_add(&bar[XB_TOP], 1u);
            const unsigned tg = og / nx;
            if (og + 1u == (tg + 1u) * nx) xb_add(&bar[XB_TOPGEN], 1u);
            else XB_SPIN(xb_ld(&bar[XB_TOPGEN]) == tg, bar);
            __builtin_amdgcn_fence(__ATOMIC_ACQUIRE, "agent");
            xb_add(&bar[XB_XGEN(b.x)], 1u);
            asm volatile("s_waitcnt vmcnt(0)" ::: "memory");
        } else {
            XB_SPIN(xb_ld(&bar[XB_XGEN(b.x)]) == gen, bar);
            __builtin_amdgcn_fence(__ATOMIC_ACQUIRE, "agent");
            asm volatile("s_waitcnt vmcnt(0)" ::: "memory");
        }
    }
    __syncthreads();
}


__global__ void __launch_bounds__(NTHR, 2) hymba_fwd(Args a_kernarg) {
    extern __shared__ __attribute__((aligned(16))) unsigned char lds[];
    cg::grid_group grid = cg::this_grid();
    const int tid = threadIdx.x, lane = tid & 63, wave = __builtin_amdgcn_readfirstlane(tid >> 6);
    const int G = gridDim.x, gw = blockIdx.x * NWAVES + wave, NGW = G * NWAVES;
    volatile LAS unsigned* xst = (volatile LAS unsigned*)(LAS unsigned char*)(lds + LDS_BYTES - 64);
    if (tid < 2) xst[tid] = 0u;
    __syncthreads();
    const XcdBarrier xbar = xcd_barrier_post((unsigned*)AA.ws, xst);
    {
        CArgs& a = AA; bf16* XN = (bf16*)(a.ws + WS_XN);
        float* scr = (float*)lds + wave * (64 * 33);
        constexpr int I_IN = (D / 64) * (NPAD / 32), I_OUT = (D / 64) * (D / 32);
        for (int it = gw; it < 2 * (I_IN + I_OUT); it += NGW) {
            int r = it; const int l = r / (I_IN + I_OUT); r -= l * (I_IN + I_OUT);
            if (r < I_IN) transpose_item(a.in[2] + (size_t)l * D * NIN, D, NIN, NPAD, (bf16*)(a.ws + WS_WIN + l * WIN_BYTES), scr, r, lane);
            else transpose_item(a.in[16] + (size_t)l * D * D, D, D, D, (bf16*)(a.ws + WS_WOUT + l * WOUT_BYTES), scr, r - I_IN, lane);
        }
        for (int m = gw; m < M; m += NGW) rms_row(a.in[0] + (size_t)m * D, a.in[1], XN + (size_t)m * D, nullptr, lane);
        {
            bf16* UPT = (bf16*)(a.ws + WS_UPT);
            for (int e = blockIdx.x * NTHR + tid; e < 2 * 2 * 512 * 64; e += G * NTHR) { const int r = e & 63, c = (e >> 6) & 511, q = (e >> 15) & 1, ll = e >> 16;
                UPT[e] = (bf16)f2bf((q ? a.in[10] : a.in[8])[(size_t)ll * 64 * 512 + r * 512 + c]); }
        }
    }
    grid.sync();
    for (int l = 0; l < 2; ++l) {
        for (int hb = 0; hb < 2; ++hb) {
            {
                CArgs& a = AA; bf16* XN = (bf16*)(a.ws + WS_XN); bf16* U = (bf16*)(a.ws + WS_U);
                pg8::Gemm g{XN + (size_t)hb * MH * D, (const bf16*)(a.ws + WS_WIN + l * WIN_BYTES), MH, NPAD, D}; pg8::StaticOrder S; S.init(MH, NPAD, G, (int)blockIdx.x);
                pg8::EpiBf16<0> E{U, NPAD, nullptr, 0, 0, 1.f};
                pg8::gemm_phase<pg8::EpiBf16<0>, pg8::StaticOrder, true, true>((PG8_LAS unsigned char*)lds, g, S, E);
            }
            xcd_barrier(xbar);
            r1_phase(AA, l, lds, tid);
            g1_phase(AA, l, lds, tid);
            xcd_barrier(xbar);
            if (blockIdx.x < 32) r2_scan(AA, blockIdx.x, lds, tid);
            else if (blockIdx.x < 96) g2_scan(AA, (blockIdx.x - 32) * NTHR + tid);
            xcd_barrier(xbar);
            r3_phase(AA, l, hb, gw, NGW, lane);
            g3_phase(AA, l, hb, gw, NGW, lane);
            xcd_barrier(xbar);
        }
        {
            CArgs& a = AA; bf16* XN = (bf16*)(a.ws + WS_XN);
            pg8::Gemm g{XN, (const bf16*)(a.ws + WS_WOUT + l * WOUT_BYTES), M, D, D}; pg8::StaticOrder S; S.init(M, D, G, (int)blockIdx.x);
            pg8::EpiResid E{l == 0 ? a.in[0] : a.out, a.out, D};
            pg8::gemm_phase<pg8::EpiResid, pg8::StaticOrder, true, true>((PG8_LAS unsigned char*)lds, g, S, E);
        }
        xcd_barrier(xbar);
        { int ln = lane; asm volatile("" : "+v"(ln)); CArgs& a = AA; bf16* XN = (bf16*)(a.ws + WS_XN);
        if (l == 0) { for (int m = gw; m < M; m += NGW) rms_row(a.out + (size_t)m * D, a.in[1] + D, XN + (size_t)m * D, nullptr, ln); xcd_barrier(xbar); }
        else { for (int m = gw; m < M; m += NGW) rms_row(a.out + (size_t)m * D, a.in[17], nullptr, a.out + (size_t)m * D, ln); } }
    }
}

extern "C" void kernel_launch(void* const* d_in, const int* in_sizes, int n_in, void* d_out, int out_size, void* d_ws, size_t ws_size, hipStream_t stream) {
    static int grid = 0;
    if (grid == 0) {
        if (n_in != 18 || out_size != M * D || ws_size < WS_END) { fprintf(stderr, "kernel_launch: unexpected shapes n_in %d out %d ws %zu\n", n_in, out_size, ws_size); grid = -1; return; }
        int dev = 0, cus = 0, per_cu = 0;
        hipGetDevice(&dev); hipDeviceGetAttribute(&cus, hipDeviceAttributeMultiprocessorCount, dev);
        if (hipFuncSetAttribute((const void*)hymba_fwd, hipFuncAttributeMaxDynamicSharedMemorySize, LDS_BYTES) != hipSuccess) { fprintf(stderr, "kernel_launch: hipFuncSetAttribute failed\n"); grid = -1; return; }
        if (hipOccupancyMaxActiveBlocksPerMultiprocessor(&per_cu, (const void*)hymba_fwd, NTHR, LDS_BYTES) != hipSuccess || per_cu < 1) { fprintf(stderr, "kernel_launch: occupancy query failed (%d)\n", per_cu); grid = -1; return; }
        grid = cus * 1;
        fprintf(stderr, "kernel_launch: cus %d per_cu %d grid %d\n", cus, per_cu, grid);
    }
    if (grid < 0) return;
    if (hipMemsetAsync(d_ws, 0, 16384, stream) != hipSuccess) { fprintf(stderr, "kernel_launch: memset failed\n"); return; }
    Args a{};
    for (int i = 0; i < 18; ++i) a.in[i] = (const float*)d_in[i];
    a.out = (float*)d_out; a.ws = (unsigned char*)d_ws;
    void* args[] = {&a};
    hipError_t e = hipLaunchCooperativeKernel((const void*)hymba_fwd, dim3(grid), dim3(NTHR), args, LDS_BYTES, stream);
    if (e != hipSuccess) fprintf(stderr, "cooperative launch failed: %s (grid %d)\n", hipGetErrorString(e), grid);
}
```

```cpp
#include <hip/hip_runtime.h>
#include <hip/hip_cooperative_groups.h>
#include <cstdio>
#include <cstdint>
namespace cg = cooperative_groups;
namespace pg8 {
#define PG8_LAS __attribute__((address_space(3)))
typedef unsigned short bf16_t;
typedef short bf16x8 __attribute__((ext_vector_type(8)));
typedef float f32x4 __attribute__((ext_vector_type(4)));
typedef unsigned u32x4 __attribute__((ext_vector_type(4)));
constexpr int BM = 256, BK = 64, HALF = 128, HTB = HALF * BK * 2  , STAGE_BYTES = 8 * HTB, NXCD = 8, WGM = 8;

__host__ __device__ __forceinline__ int lds_byte(int r, int c) { const int st = (r >> 4) * 2 + (c >> 5), rr = r & 15, cc = c & 31, ob = rr * 64 + cc * 2; return st * 1024 + (ob ^ (((ob >> 9) & 1) << 5)); }
__host__ __device__ __forceinline__ void stage_rc(int b, int& R, int& C) { const int st = b / 1024, sb = b % 1024, swz = sb ^ (((sb >> 9) & 1) << 5); R = (st >> 1) * 16 + swz / 64; C = (st & 1) * 32 + (swz % 64) / 2; }
__host__ __device__ __forceinline__ int perm32(int rho) { const int n = rho >> 4, i = rho & 15; return 8 * (i >> 2) + 4 * n + (i & 3); }

struct Unit { int pm, pn; };
struct Gemm { const bf16_t* A; const bf16_t* Bt; int M, N, K; };

struct StaticOrder {
    int nM, nN, nwg, G, c;
    __host__ __device__ void init(int M, int N, int G_, int c_) { nM = M / BM; nN = N / BM; nwg = nM * nN; G = G_; c = c_; }
    __host__ __device__ bool next(int i, Unit& u) const {
        const long L = (long)i * G + c; if (L >= nwg) return false;
        int wgid = (int)L; { const int q = nwg / NXCD, r = nwg % NXCD, xcd = wgid % NXCD, off = wgid / NXCD; wgid = (xcd < r ? xcd * (q + 1) : r * (q + 1) + (xcd - r) * q) + off; }
        const int nig = WGM * nN, gid = wgid / nig, fm = gid * WGM, gsz = (nM - fm) < WGM ? (nM - fm) : WGM;
        u.pm = fm + ((wgid % nig) % gsz); u.pn = (wgid % nig) / gsz; return true;
    }
    __device__ __forceinline__ void a_ready(const Unit&) const {}
    __device__ __forceinline__ void done(const Unit&) const {}
};

__device__ __forceinline__ unsigned cvt_pk_bf16(float lo, float hi) { unsigned r; asm volatile("v_cvt_pk_bf16_f32 %0, %1, %2" : "=v"(r) : "v"(lo), "v"(hi)); return r; }
typedef float f32x2 __attribute__((ext_vector_type(2)));
__device__ __forceinline__ f32x2 gelu_pk(f32x2 v) {
    const f32x2 av = __builtin_elementwise_abs(v), d = av * 0.2316418882f + 1.0f;
    f32x2 t; t.x = __builtin_amdgcn_rcpf(d.x); t.y = __builtin_amdgcn_rcpf(d.y);
    f32x2 q = t * 0.5307027145f + (-0.7265760135f); q = q * t + 0.7107068705f; q = q * t + (-0.142248368f); q = q * t + 0.127414796f; q = q * t;
    const f32x2 s = (v * v) * (-0.72134752044f);
    f32x2 e; e.x = __builtin_amdgcn_exp2f(s.x); e.y = __builtin_amdgcn_exp2f(s.y);
    const f32x2 m = v * (q * e), r = v - m;
    f32x2 o; o.x = v.x < 0.f ? m.x : r.x; o.y = v.y < 0.f ? m.y : r.y; return o;
}

template <int ACT  > struct EpiBf16 {
    static constexpr bool PERM = true, AFTER_DRAIN = false; static_assert(ACT == 0 || ACT == 1, "EpiBf16: ACT is 0 (none) or 1 (gelu_pk)");
    bf16_t* O; int ldc; const float* bias; int split_cols; size_t split_stride; float scale0;
    __device__ __forceinline__ void operator()(const f32x4 (&acc)[2][2][4][2], const Unit& u, int wr, int wc, int fr, int fq) const {
        const int row0 = u.pm * BM + wr * 64 + fr; int colt = u.pn * BM; bf16_t* base = O;
        float sc = 1.f; if (split_cols) { const int t = colt / split_cols; base += (size_t)t * split_stride; colt -= t * split_cols; if (t == 0) sc = scale0; }
        const int col0 = colt + wc * 32 + 8 * fq, bcol0 = u.pn * BM + wc * 32 + 8 * fq;
        f32x4 bv[2][2];
#pragma unroll
        for (int bj = 0; bj < 2; ++bj)
#pragma unroll
            for (int n = 0; n < 2; ++n) bv[bj][n] = bias ? *(const f32x4*)(bias + bcol0 + bj * HALF + 4 * n) : (f32x4){0.f, 0.f, 0.f, 0.f};
#pragma unroll
        for (int ai = 0; ai < 2; ++ai)
#pragma unroll
            for (int m = 0; m < 4; ++m) { bf16_t* rowp = base + (size_t)(row0 + ai * HALF + m * 16) * ldc + col0;
#pragma unroll
                for (int bj = 0; bj < 2; ++bj) { f32x4 v0 = acc[ai][bj][m][0] + bv[bj][0], v1 = acc[ai][bj][m][1] + bv[bj][1];
                    if (ACT == 1) { f32x2 a = gelu_pk((f32x2){v0[0], v0[1]}), b = gelu_pk((f32x2){v0[2], v0[3]}), c = gelu_pk((f32x2){v1[0], v1[1]}), d = gelu_pk((f32x2){v1[2], v1[3]});
                        v0 = (f32x4){a.x, a.y, b.x, b.y}; v1 = (f32x4){c.x, c.y, d.x, d.y}; }
                    v0 = v0 * sc; v1 = v1 * sc; u32x4 w; w.x = cvt_pk_bf16(v0[0], v0[1]); w.y = cvt_pk_bf16(v0[2], v0[3]); w.z = cvt_pk_bf16(v1[0], v1[1]); w.w = cvt_pk_bf16(v1[2], v1[3]);
                    *(u32x4*)(rowp + bj * HALF) = w; } }
    }
};

template <class Epi, class Sched, bool ALIGN_EPI = false, bool SP2 = false>
__device__ __forceinline__ void gemm_phase(PG8_LAS unsigned char* lds, const Gemm g, const Sched& S, const Epi& E) {
    int tid_ = threadIdx.x; asm volatile("" : "+v"(tid_));
    const int tid = tid_, wid = __builtin_amdgcn_readfirstlane(tid >> 6), lane = tid & 63, wr = wid >> 2, wc = wid & 3, fr = lane & 15, fq = lane >> 4;
    const int K = g.K, nt = K / BK;
    unsigned voffA[2], voffB[2];
#pragma unroll
    for (int i = 0; i < 2; ++i) { int R, C; stage_rc(tid * 16 + i * 8192, R, C); const int Rb = Epi::PERM ? ((R & ~31) + perm32(R & 31)) : R;
        voffA[i] = (unsigned)(R * K + C) * 2u; voffB[i] = (unsigned)(Rb * K + C) * 2u; }
    const size_t kstep = (size_t)(BK * 2);
    const size_t hstep = (size_t)HALF * K * 2;
    const size_t tstep = 2 * hstep;
    const unsigned ldsw = (unsigned)wid * 1024u;
    const int aoff = lds_byte(wr * 64 + fr, fq * 8), boff = lds_byte(wc * 32 + fr, fq * 8);
#define PG8_SA(b, h) (((b) * 2 + (h)) * HTB)
#define PG8_SB(b, h) ((4 + (b) * 2 + (h)) * HTB)
#define PG8_STAGE(bufoff, gbase, voff) do { _Pragma("unroll") for (int _i = 0; _i < 2; ++_i) \
        __builtin_amdgcn_global_load_lds((const unsigned*)((const char*)(gbase) + (voff)[_i]), (PG8_LAS unsigned*)(lds + (bufoff) + ldsw + _i * 8192), 16, 0, 0); } while (0)
#define PG8_LDA(dst, b, h) do { _Pragma("unroll") for (int m = 0; m < 4; ++m) _Pragma("unroll") for (int k = 0; k < 2; ++k) dst[m][k] = *(const PG8_LAS bf16x8*)(lds + PG8_SA(b, h) + aoff + m * 2048 + k * 1024); } while (0)
#define PG8_LDB(dst, b, h) do { _Pragma("unroll") for (int n = 0; n < 2; ++n) _Pragma("unroll") for (int k = 0; k < 2; ++k) dst[n][k] = *(const PG8_LAS bf16x8*)(lds + PG8_SB(b, h) + boff + n * 2048 + k * 1024); } while (0)
#define PG8_MMA(ai, bj, At, Bt) do { __builtin_amdgcn_s_setprio(1); _Pragma("unroll") for (int m = 0; m < 4; ++m) _Pragma("unroll") for (int n = 0; n < 2; ++n) _Pragma("unroll") for (int k = 0; k < 2; ++k) \
        acc[ai][bj][m][n] = __builtin_amdgcn_mfma_f32_16x16x32_bf16(Bt[n][k], At[m][k], acc[ai][bj][m][n], 0, 0, 0); __builtin_amdgcn_s_setprio(0); } while (0)
#define PG8_WAIT_V(n) asm volatile("s_waitcnt vmcnt(" #n ")" ::: "memory")
#define PG8_WAIT_L(n) asm volatile("s_waitcnt lgkmcnt(" #n ")" ::: "memory")
#define PG8_BAR __builtin_amdgcn_s_barrier()
#define PG8_SCHED __builtin_amdgcn_sched_barrier(0)
    Unit cur, nxt; int ui = 0;
    if (!S.next(0, cur)) return;
    f32x4 acc[2][2][4][2];
#pragma unroll
    for (int a = 0; a < 2; ++a)
#pragma unroll
        for (int b = 0; b < 2; ++b)
#pragma unroll
            for (int m = 0; m < 4; ++m)
#pragma unroll
                for (int n = 0; n < 2; ++n) acc[a][b][m][n] = (f32x4){0.f, 0.f, 0.f, 0.f};
    bf16x8 At[4][2], B0[2][2], B1[2][2];
    const char* cA = (const char*)g.A + (size_t)cur.pm * tstep; const char* cB = (const char*)g.Bt + (size_t)cur.pn * tstep;
    S.a_ready(cur);
    if constexpr (SP2) {
        PG8_STAGE(PG8_SB(0, 0), cB, voffB); PG8_STAGE(PG8_SB(0, 1), cB + hstep, voffB); PG8_STAGE(PG8_SA(0, 0), cA, voffA); PG8_STAGE(PG8_SA(0, 1), cA + hstep, voffA);
        if (wr == 1) PG8_BAR;
        PG8_WAIT_V(2); PG8_BAR;
        PG8_STAGE(PG8_SB(1, 0), cB + kstep, voffB); PG8_STAGE(PG8_SA(1, 0), cA + kstep, voffA); PG8_STAGE(PG8_SB(1, 1), cB + hstep + kstep, voffB);
        PG8_WAIT_V(6); PG8_BAR;
    } else {
        PG8_STAGE(PG8_SB(0, 0), cB, voffB); PG8_STAGE(PG8_SA(0, 0), cA, voffA); PG8_STAGE(PG8_SB(0, 1), cB + hstep, voffB); PG8_STAGE(PG8_SA(0, 1), cA + hstep, voffA);
        if (wr == 1) PG8_BAR;
        PG8_WAIT_V(4); PG8_BAR;
        PG8_STAGE(PG8_SB(1, 0), cB + kstep, voffB); PG8_STAGE(PG8_SA(1, 0), cA + kstep, voffA); PG8_STAGE(PG8_SB(1, 1), cB + hstep + kstep, voffB);
        PG8_WAIT_V(6); PG8_BAR;
    }
    for (;;) {
        const bool has_next = S.next(ui + 1, nxt);
        const char* nA = has_next ? (const char*)g.A + (size_t)nxt.pm * tstep : cA; const char* nB = has_next ? (const char*)g.Bt + (size_t)nxt.pn * tstep : cB;
        for (int t = 0; t < nt; t += 2) {
            const bool last = (t == nt - 2);
            const char* a1 = cA + (size_t)(t + 1) * kstep;
            const char* a2 = last ? nA : cA + (size_t)(t + 2) * kstep; const char* b2 = last ? nB : cB + (size_t)(t + 2) * kstep;
            const char* a3 = a2 + kstep; const char* b3 = b2 + kstep;
            if (last && has_next) S.a_ready(nxt);
            if constexpr (SP2) {
            PG8_LDB(B0, 0, 0); PG8_LDB(B1, 0, 1); PG8_SCHED; PG8_LDA(At, 0, 0); PG8_STAGE(PG8_SA(1, 1), a1 + hstep, voffA);
            PG8_WAIT_V(8); PG8_WAIT_L(0); PG8_BAR; PG8_MMA(0, 0, At, B0); PG8_MMA(0, 1, At, B1); PG8_BAR; PG8_SCHED;
            PG8_LDA(At, 0, 1); PG8_STAGE(PG8_SB(0, 0), b2, voffB); PG8_STAGE(PG8_SB(0, 1), b2 + hstep, voffB); PG8_STAGE(PG8_SA(0, 0), a2, voffA);
            PG8_WAIT_V(8); PG8_WAIT_L(0); PG8_BAR; PG8_MMA(1, 0, At, B0); PG8_MMA(1, 1, At, B1); PG8_BAR; PG8_SCHED;
            PG8_LDB(B0, 1, 0); PG8_LDB(B1, 1, 1); PG8_SCHED; PG8_LDA(At, 1, 0); PG8_STAGE(PG8_SA(0, 1), a2 + hstep, voffA);
            PG8_WAIT_V(8); PG8_WAIT_L(0); PG8_BAR; PG8_MMA(0, 0, At, B0); PG8_MMA(0, 1, At, B1); PG8_BAR; PG8_SCHED;
            PG8_LDA(At, 1, 1); PG8_STAGE(PG8_SB(1, 0), b3, voffB); PG8_STAGE(PG8_SB(1, 1), b3 + hstep, voffB); PG8_STAGE(PG8_SA(1, 0), a3, voffA);
            PG8_WAIT_V(8); PG8_WAIT_L(0); PG8_BAR; PG8_MMA(1, 0, At, B0); PG8_MMA(1, 1, At, B1); PG8_BAR; PG8_SCHED;
            } else {
            PG8_LDB(B0, 0, 0); PG8_SCHED; PG8_LDA(At, 0, 0); PG8_STAGE(PG8_SA(1, 1), a1 + hstep, voffA);
            PG8_WAIT_L(8); PG8_BAR; PG8_WAIT_L(0); PG8_MMA(0, 0, At, B0); PG8_BAR; PG8_SCHED;
            PG8_LDB(B1, 0, 1); PG8_STAGE(PG8_SB(0, 0), b2, voffB);
            PG8_BAR; PG8_WAIT_L(0); PG8_MMA(0, 1, At, B1); PG8_BAR;
            PG8_LDA(At, 0, 1); PG8_STAGE(PG8_SA(0, 0), a2, voffA);
            PG8_BAR; PG8_WAIT_L(0); PG8_MMA(1, 0, At, B0); PG8_BAR; PG8_SCHED;
            PG8_STAGE(PG8_SB(0, 1), b2 + hstep, voffB);
            PG8_WAIT_V(6); PG8_BAR; PG8_MMA(1, 1, At, B1); PG8_BAR;
            PG8_LDB(B0, 1, 0); PG8_SCHED; PG8_LDA(At, 1, 0); PG8_STAGE(PG8_SA(0, 1), a2 + hstep, voffA);
            PG8_WAIT_L(8); PG8_BAR; PG8_WAIT_L(0); PG8_MMA(0, 0, At, B0); PG8_BAR; PG8_SCHED;
            PG8_LDB(B1, 1, 1); PG8_STAGE(PG8_SB(1, 0), b3, voffB);
            PG8_BAR; PG8_WAIT_L(0); PG8_MMA(0, 1, At, B1); PG8_BAR;
            PG8_LDA(At, 1, 1); PG8_STAGE(PG8_SA(1, 0), a3, voffA);
            PG8_BAR; PG8_WAIT_L(0); PG8_MMA(1, 0, At, B0); PG8_BAR; PG8_SCHED;
            PG8_STAGE(PG8_SB(1, 1), b3 + hstep, voffB);
            PG8_WAIT_V(6); PG8_BAR; PG8_MMA(1, 1, At, B1); PG8_BAR;
            }
        }
        if constexpr (ALIGN_EPI) { if (wr == 0) PG8_BAR; }
        if constexpr (!Epi::AFTER_DRAIN) { E(acc, cur, wr, wc, fr, fq); S.done(cur); }
        if (!has_next) break;
#pragma unroll
        for (int a = 0; a < 2; ++a)
#pragma unroll
            for (int b = 0; b < 2; ++b)
#pragma unroll
                for (int m = 0; m < 4; ++m)
#pragma unroll
                    for (int n = 0; n < 2; ++n) acc[a][b][m][n] = (f32x4){0.f, 0.f, 0.f, 0.f};
        cur = nxt; cA = nA; cB = nB; ++ui;
        if constexpr (ALIGN_EPI) { if (wr == 1) PG8_BAR; }
    }
    PG8_WAIT_V(0);
    if constexpr (!ALIGN_EPI) { if (wr == 0) PG8_BAR; }
    PG8_BAR;
    if constexpr (Epi::AFTER_DRAIN) { E.fused(acc, cur, wr, wc, fr, fq, lds, wid, lane); S.done(cur); }
#undef PG8_SA
#undef PG8_SB
#undef PG8_STAGE
#undef PG8_LDA
#undef PG8_LDB
#undef PG8_MMA
#undef PG8_WAIT_V
#undef PG8_WAIT_L
#undef PG8_BAR
#undef PG8_SCHED
}
}
namespace pg8 {
struct EpiResid {
    static constexpr bool PERM = false, AFTER_DRAIN = false;
    const float* base; float* out; int ldc;
    __device__ __forceinline__ void operator()(const f32x4 (&acc)[2][2][4][2], const Unit& u, int wr, int wc, int fr, int fq) const {
        const int col0 = u.pn * BM + wc * 32 + 4 * fq;
#pragma unroll
        for (int ai = 0; ai < 2; ++ai)
#pragma unroll
            for (int m = 0; m < 4; ++m) { const size_t off = (size_t)(u.pm * BM + ai * HALF + wr * 64 + m * 16 + fr) * ldc + col0;
#pragma unroll
                for (int bj = 0; bj < 2; ++bj)
#pragma unroll
                    for (int n = 0; n < 2; ++n) { const f32x4 b = *(const f32x4*)(base + off + bj * HALF + n * 16); *(f32x4*)(out + off + bj * HALF + n * 16) = b + acc[ai][bj][m][n]; } }
    }
};
}
constexpr int NWAVES = 8, NTHR = 512;
constexpr int BATCH = 2, T = 8192, D = 1024, M = BATCH * T, MH = T;
constexpr int NIN = 3728, NPAD = 3840;
constexpr int C_GQ = 0, C_GK = 256, C_GV = 512, C_GLR = 1024, C_GG = 1040, C_R = 1552, C_K = 2064, C_V = 2576, C_WL = 3088, C_AL = 3152, C_RG = 3216;
constexpr size_t MiB = 1u << 20;
constexpr size_t WS_WIN = 1 * MiB, WIN_BYTES = (size_t)NPAD * D * 2;
constexpr size_t WS_WOUT = 16 * MiB, WOUT_BYTES = (size_t)D * D * 2;
constexpr size_t WS_XN = 20 * MiB;
constexpr size_t WS_U = 52 * MiB;
constexpr size_t WS_END = 256 * MiB;
constexpr int LDS_BYTES = 147456;

typedef unsigned short bf16;
typedef unsigned v4u __attribute__((ext_vector_type(4)));
typedef float f32x4 __attribute__((ext_vector_type(4)));
#define LDS_WAIT() asm volatile("s_waitcnt lgkmcnt(0)" ::: "memory")
__device__ __forceinline__ float bf2f(unsigned h) { return __uint_as_float(h << 16); }
__device__ __forceinline__ unsigned f2bf(float f) { unsigned u = __float_as_uint(f); return (u + 0x7fffu + ((u >> 16) & 1u)) >> 16; }
typedef __bf16 bf16x2_t __attribute__((ext_vector_type(2)));
typedef float f32x2_t __attribute__((ext_vector_type(2)));
__device__ __forceinline__ unsigned pk2(float lo, float hi) { const f32x2_t v = {lo, hi}; const bf16x2_t b = __builtin_convertvector(v, bf16x2_t); return __builtin_bit_cast(unsigned, b); }
__device__ __forceinline__ float wave_sum(float v) {
#pragma unroll
    for (int o = 1; o < 64; o <<= 1) v += __shfl_xor(v, o);
    return v;
}
__device__ __forceinline__ float sigm(float x) { return __builtin_amdgcn_rcpf(1.f + __expf(-x)); }
__device__ __forceinline__ float tanh_fast(float x) { return 1.f - 2.f * __builtin_amdgcn_rcpf(1.f + __expf(2.f * x)); }
__device__ __forceinline__ float rl(float v, int l) { return __int_as_float(__builtin_amdgcn_readlane(__float_as_int(v), l)); }

struct Args { const float* in[18]; float* out; unsigned char* ws; };
typedef const Args __attribute__((address_space(4))) CArgs;
__device__ __forceinline__ CArgs* opaque_args() { CArgs* p = (CArgs*)__builtin_amdgcn_kernarg_segment_ptr(); asm volatile("" : "+s"(p)); return p; }
#define AA (*opaque_args())

__device__ __forceinline__ void transpose_item(const float* W, int K, int N, int Npad, bf16* WT, float* scr, int item, int lane) {
    const int nblk = Npad / 32, kb = item / nblk, nb = item % nblk, k0 = 64 * kb, n0 = 32 * nb;
    const int n = n0 + (lane & 31);
#pragma unroll 8
    for (int i = 0; i < 32; ++i) { const int kk = 2 * i + (lane >> 5); scr[kk * 33 + (lane & 31)] = (n < N) ? W[(size_t)(k0 + kk) * N + n] : 0.f; }
    LDS_WAIT();
    const int c = lane & 7;
#pragma unroll
    for (int j = 0; j < 4; ++j) { const int nn = (lane >> 3) + 8 * j; const float* s = scr + (8 * c) * 33 + nn;
        v4u o; o.x = pk2(s[0 * 33], s[1 * 33]); o.y = pk2(s[2 * 33], s[3 * 33]); o.z = pk2(s[4 * 33], s[5 * 33]); o.w = pk2(s[6 * 33], s[7 * 33]);
        *(v4u*)(WT + (size_t)(n0 + nn) * K + k0 + 8 * c) = o; }
    LDS_WAIT();
}
__device__ __forceinline__ void rms_row(const float* xrow, const float* w, bf16* obf, float* of32, int lane) {
    const f32x4* xr = (const f32x4*)xrow + lane; const f32x4* wr = (const f32x4*)w + lane;
    f32x4 v[4]; float s = 0.f;
#pragma unroll
    for (int j = 0; j < 4; ++j) { v[j] = xr[64 * j]; s += (v[j].x * v[j].x + v[j].y * v[j].y) + (v[j].z * v[j].z + v[j].w * v[j].w); }
    const float rs = rsqrtf(wave_sum(s) * (1.f / D) + 1e-6f);
#pragma unroll
    for (int j = 0; j < 4; ++j) { const f32x4 ww = wr[64 * j]; f32x4 o = v[j] * rs * ww;
        if (of32) ((f32x4*)of32 + lane)[64 * j] = o;
        else ((unsigned long long*)obf + lane)[64 * j] = (unsigned long long)pk2(o.x, o.y) | ((unsigned long long)pk2(o.z, o.w) << 32); }
}

typedef short bf16x8 __attribute__((ext_vector_type(8)));
typedef unsigned v2u __attribute__((ext_vector_type(2)));
constexpr int PITCH = 72, FP = 68, TP = 20;
constexpr int OFF_TW = 0, OFF_AL = 9216, OFF_ARK = 18432, OFF_XA = 27648, OFF_XW = 45056, OFF_AT = 63488, OFF_RT = 72704, OFF_BH = 81920, OFF_KH = 91136,
              OFF_BBT = 100352, OFF_KBT = 109568, OFF_VT = 118784, OFF_TII = 128000, OFF_TOT = 133120, OFF_BC = 135168;
constexpr int OFF_AAK = OFF_TW, OFF_ARB = OFF_AL, OFF_AAB = OFF_XA, OFF_XT = OFF_XW;
constexpr size_t WS_MC = 112 * MiB, WS_NC = 120 * MiB, WS_PP = 136 * MiB, WS_Y0 = 144 * MiB, WS_S0 = 160 * MiB, WS_DEC = 168 * MiB, WS_BON2 = 169 * MiB, WS_UPT = 170 * MiB;
constexpr int NUNIT = 1024;

__device__ __forceinline__ f32x4 mma2(const bf16* Arow, const bf16* Brow, f32x4 acc) {
    acc = __builtin_amdgcn_mfma_f32_16x16x32_bf16(*(const bf16x8*)(Arow), *(const bf16x8*)(Brow), acc, 0, 0, 0);
    acc = __builtin_amdgcn_mfma_f32_16x16x32_bf16(*(const bf16x8*)(Arow + 32), *(const bf16x8*)(Brow + 32), acc, 0, 0, 0);
    return acc;
}
__device__ __forceinline__ v2u pack4(f32x4 v) { v2u r; r.x = pk2(v.x, v.y); r.y = pk2(v.z, v.w); return r; }
__device__ __forceinline__ void unpack8(v4u w, float* o) { o[0] = bf2f(w.x & 0xffffu); o[1] = bf2f(w.x >> 16); o[2] = bf2f(w.y & 0xffffu); o[3] = bf2f(w.y >> 16);
    o[4] = bf2f(w.z & 0xffffu); o[5] = bf2f(w.z >> 16); o[6] = bf2f(w.w & 0xffffu); o[7] = bf2f(w.w >> 16); }
__device__ __forceinline__ v4u pack8(const float* v) { v4u r; r.x = pk2(v[0], v[1]); r.y = pk2(v[2], v[3]); r.z = pk2(v[4], v[5]); r.w = pk2(v[6], v[7]); return r; }

__device__ __forceinline__ void r1_phase(CArgs& a, int l, unsigned char* L, int tid0) {
    asm volatile("" : "+v"(tid0));
    const int wave = __builtin_amdgcn_readfirstlane(tid0 >> 6);
    const bf16* U = (const bf16*)(a.ws + WS_U);
    bf16* TW = (bf16*)(L + OFF_TW); bf16* ALm = (bf16*)(L + OFF_AL); bf16* ARK = (bf16*)(L + OFF_ARK); bf16* AAK = (bf16*)(L + OFF_AAK); bf16* ARB = (bf16*)(L + OFF_ARB);
    float* XA = (float*)(L + OFF_XA); float* XW = (float*)(L + OFF_XW); float* AAB = (float*)(L + OFF_AAB); bf16* XT = (bf16*)(L + OFF_XT);
    bf16* AT = (bf16*)(L + OFF_AT); bf16* RT = (bf16*)(L + OFF_RT); bf16* BH = (bf16*)(L + OFF_BH); bf16* KH = (bf16*)(L + OFF_KH);
    bf16* BBT = (bf16*)(L + OFF_BBT); bf16* KBT = (bf16*)(L + OFF_KBT); bf16* VT = (bf16*)(L + OFF_VT);
    float* TII = (float*)(L + OFF_TII); float* TOT = (float*)(L + OFF_TOT); float* BC = (float*)(L + OFF_BC);
    const bf16* UPT = (const bf16*)(a.ws + WS_UPT) + (size_t)l * 2 * 512 * 64;
    const float* mu = a.in[6] + l * 1664;
    float* WTS = (float*)(L + 135424);
    int hl = -1;
    v4u Pc0, Pc1, Pp0, Pp1, Lrc, Lkc, Lvc, Lrp, Lkp, Lvp; bf16x8 wfa0, wfa1;
#define R1_ISSUE(u_) do { const int lr_ = 64 * ((u_) >> 3) + (tid >> 3); const bf16* ub_ = U + (size_t)lr_ * NPAD; const bf16* up_ = ub_ + C_WL + 16 * (tid & 7); const bf16* uq_ = ub_ + 64 * ((u_) & 7) + 8 * (tid & 7); \
        Pc0 = *(const v4u*)up_; Pc1 = *(const v4u*)(up_ + 8); Lrc = *(const v4u*)(uq_ + C_R); Lkc = *(const v4u*)(uq_ + C_K); Lvc = *(const v4u*)(uq_ + C_V); \
        Pp0 = (v4u){0u, 0u, 0u, 0u}; Pp1 = Pp0; Lrp = Pp0; Lkp = Pp0; Lvp = Pp0; \
        if (lr_ > 0) { Pp0 = *(const v4u*)(up_ - NPAD); Pp1 = *(const v4u*)(up_ - NPAD + 8); Lrp = *(const v4u*)(uq_ + C_R - NPAD); Lkp = *(const v4u*)(uq_ + C_K - NPAD); Lvp = *(const v4u*)(uq_ + C_V - NPAD); } } while (0)
#pragma unroll 1
    for (int unit = blockIdx.x; unit < NUNIT; unit += gridDim.x) {
        int tid = tid0; asm volatile("" : "+v"(tid));
        const int lane = tid & 63, g = lane >> 4, c16 = lane & 15;
        const int ch = unit >> 3, h = unit & 7;
        if (h != hl) { hl = h; __syncthreads();
            if (tid < 64) { const int c = l * 512 + 64 * h + tid; WTS[tid] = a.in[7][c]; WTS[64 + tid] = a.in[9][c]; WTS[128 + tid] = a.in[11][c]; WTS[192 + tid] = a.in[12][c]; WTS[256 + tid] = a.in[13][c];
                WTS[320 + tid] = mu[64 * h + tid]; WTS[384 + tid] = mu[512 + 64 * h + tid]; WTS[448 + tid] = mu[1024 + 64 * h + tid]; }
            else if (tid < 192) WTS[512 + tid - 64] = mu[1536 + tid - 64];
            { const bf16* WT = UPT + (size_t)(wave >> 2) * 512 * 64 + (size_t)(64 * h + 16 * (wave & 3) + c16) * 64 + 8 * g; wfa0 = *(const bf16x8*)WT; wfa1 = *(const bf16x8*)(WT + 32); }
            __syncthreads(); }
        const int t = tid >> 3, dg = tid & 7, d0 = 8 * dg, lr = 64 * ch + t, hc = 64 * h + d0;
        if (unit == (int)blockIdx.x) R1_ISSUE(unit);
        {
            const int cg = tid & 7;
            float cu[16], pr[16], o[16]; unpack8(Pc0, cu); unpack8(Pc1, cu + 8); unpack8(Pp0, pr); unpack8(Pp1, pr + 8);
            const float* mp = WTS + 512 + 16 * cg;
#pragma unroll
            for (int i = 0; i < 16; ++i) { float mv = cu[i] + (pr[i] - cu[i]) * mp[i]; if (cg < 4) mv = tanh_fast(mv); o[i] = mv; }
            bf16* dst = (cg < 4 ? TW : ALm) + t * PITCH + 16 * (cg & 3);
            *(v4u*)dst = pack8(o); *(v4u*)(dst + 8) = pack8(o + 8);
        }
        __syncthreads();
        {
            const int q = wave >> 2, dt = wave & 3;
            const bf16x8 a0 = wfa0, a1 = wfa1;
            const bf16* Bm = q ? ALm : TW; float* X = q ? XA : XW;
#pragma unroll
            for (int tt = 0; tt < 4; ++tt) { const bf16* br = Bm + (16 * tt + c16) * PITCH + 8 * g; f32x4 acc = {0.f, 0.f, 0.f, 0.f};
                acc = __builtin_amdgcn_mfma_f32_16x16x32_bf16(a0, *(const bf16x8*)br, acc, 0, 0, 0);
                acc = __builtin_amdgcn_mfma_f32_16x16x32_bf16(a1, *(const bf16x8*)(br + 32), acc, 0, 0, 0);
                *(f32x4*)(X + (16 * tt + c16) * FP + 16 * dt + 4 * g) = acc; }
        }
        __syncthreads();
        float r[8], kq[8], v[8], al[8], be[8], lw[8];
        {
            float rc[8], rp[8], kc[8], kp[8], vc[8], vp[8];
            unpack8(Lrc, rc); unpack8(Lkc, kc); unpack8(Lvc, vc); unpack8(Lrp, rp); unpack8(Lkp, kp); unpack8(Lvp, vp);
            const float* w0p = WTS + d0; const float* a0p = WTS + 64 + d0; const float* kkp = WTS + 128 + d0;
            const float* kap = WTS + 192 + d0; const float* rkp = WTS + 256 + d0;
            float nn = 0.f, bon = 0.f, kk[8], av[8];
#pragma unroll
            for (int i = 0; i < 8; ++i) {
                const float xw = XW[t * FP + d0 + i] + w0p[i], xa = XA[t * FP + d0 + i] + a0p[i];
                lw[i] = -0.60653065971f * sigm(xw); av[i] = sigm(xa);
                r[i] = rc[i] + (rp[i] - rc[i]) * WTS[320 + d0 + i]; const float k = kc[i] + (kp[i] - kc[i]) * WTS[384 + d0 + i]; v[i] = vc[i] + (vp[i] - vc[i]) * WTS[448 + d0 + i];
                kk[i] = k * kkp[i]; nn += kk[i] * kk[i];
                kq[i] = k * (1.f + (av[i] - 1.f) * kap[i]); bon += r[i] * kq[i] * rkp[i];
            }
            nn += __shfl_xor(nn, 1); nn += __shfl_xor(nn, 2); nn += __shfl_xor(nn, 4);
            bon += __shfl_xor(bon, 1); bon += __shfl_xor(bon, 2); bon += __shfl_xor(bon, 4);
            const float inv = __builtin_amdgcn_rsqf(fmaxf(nn, 1e-24f));
#pragma unroll
            for (int i = 0; i < 8; ++i) { const float kn = kk[i] * inv; al[i] = -kn; be[i] = av[i] * kn; XW[t * FP + d0 + i] = lw[i]; }
            if (dg == 0) ((float*)(a.ws + WS_BON2))[lr * 8 + h] = bon;
        }
        __syncthreads();
        {
            const int d = tid & 63, tb = tid >> 6; float p[8]; float run = 0.f;
#pragma unroll
            for (int i = 0; i < 8; ++i) { run += XW[(8 * tb + i) * FP + d]; p[i] = run; }
            TOT[tb * 64 + d] = run;
            __syncthreads();
            float off = 0.f;
#pragma unroll
            for (int j = 0; j < 8; ++j) off += (j < tb) ? TOT[j * 64 + d] : 0.f;
#pragma unroll
            for (int i = 0; i < 8; ++i) XW[(8 * tb + i) * FP + d] = off + p[i];
            if (tb == 7) BC[d] = off + run;
        }
        __syncthreads();
        {
            float at[8], rt[8], bh[8], kh[8];
#pragma unroll
            for (int i = 0; i < 8; ++i) { const float b = XW[t * FP + d0 + i], bc = BC[d0 + i];
                const float eb = __expf(b), enb = __expf(-b), ebp = __expf(b - lw[i]), ebc = __expf(bc - b);
                at[i] = al[i] * ebp; rt[i] = r[i] * eb; bh[i] = be[i] * enb; kh[i] = kq[i] * enb;
                BBT[(d0 + i) * PITCH + t] = (bf16)f2bf(be[i] * ebc); KBT[(d0 + i) * PITCH + t] = (bf16)f2bf(kq[i] * ebc); VT[(d0 + i) * PITCH + t] = (bf16)f2bf(v[i]); }
            *(v4u*)(AT + t * PITCH + d0) = pack8(at); *(v4u*)(RT + t * PITCH + d0) = pack8(rt); *(v4u*)(BH + t * PITCH + d0) = pack8(bh); *(v4u*)(KH + t * PITCH + d0) = pack8(kh);
        }
        asm volatile("" ::: "memory");
        if (unit + (int)gridDim.x < NUNIT) R1_ISSUE(unit + (int)gridDim.x);
        __syncthreads();
        {
            const int q = wave >> 1, mh = wave & 1;
            const bf16* As = (q < 2) ? AT : RT; const bf16* Bs = (q & 1) ? KH : BH;
#pragma unroll
            for (int t2 = 0; t2 < 2; ++t2) { const int tt = 2 * mh + t2; const int tcol = 16 * tt + c16;
#pragma unroll
                for (int jt = 0; jt < 4; ++jt) {
                    f32x4 acc = {0.f, 0.f, 0.f, 0.f};
                    if (jt <= tt) { acc = mma2(Bs + (16 * jt + c16) * PITCH + 8 * g, As + tcol * PITCH + 8 * g, acc);
#pragma unroll
                        for (int j = 0; j < 4; ++j) { const int jj = 16 * jt + 4 * g + j; const bool keep = (q < 2) ? (jj < tcol) : (jj <= tcol); if (!keep) acc[j] = 0.f; } }
                    if (q == 0) *(f32x4*)(AAB + tcol * FP + 16 * jt + 4 * g) = acc;
                    else { bf16* dst = (q == 1 ? AAK : (q == 2 ? ARB : ARK)); *(v2u*)(dst + tcol * PITCH + 16 * jt + 4 * g) = pack4(acc); }
                } }
        }
        __syncthreads();
        f32x4 Z[4];
        {
            if (wave == 0) { const int i = g; float Tc[16];
#pragma unroll
                for (int tr = 0; tr < 16; ++tr) { float s0 = (c16 == tr) ? 1.f : 0.f, s1 = 0.f, s2 = 0.f, s3 = 0.f; const float* ar = AAB + (16 * i + tr) * FP + 16 * i;
#pragma unroll
                    for (int j = 0; j < 16; j += 4) { if (j < tr) s0 += ar[j] * Tc[j]; if (j + 1 < tr) s1 += ar[j + 1] * Tc[j + 1]; if (j + 2 < tr) s2 += ar[j + 2] * Tc[j + 2]; if (j + 3 < tr) s3 += ar[j + 3] * Tc[j + 3]; }
                    const float sv = (s0 + s1) + (s2 + s3); Tc[tr] = sv; TII[(i * 16 + tr) * TP + c16] = sv; } }
            if (wave < 4) {
#pragma unroll
                for (int i = 0; i < 4; ++i)
#pragma unroll
                    for (int j = 0; j < 4; ++j) Z[i][j] = bf2f(AT[(16 * i + 4 * g + j) * PITCH + 16 * wave + c16]);
            } else {
#pragma unroll
                for (int i = 0; i < 4; ++i) { f32x4 acc = {0.f, 0.f, 0.f, 0.f}; Z[i] = mma2(AAK + (16 * i + c16) * PITCH + 8 * g, VT + (16 * (wave - 4) + c16) * PITCH + 8 * g, acc); }
            }
        }
        __syncthreads();
        {
            f32x4 X[4];
#pragma unroll
            for (int i = 0; i < 4; ++i) { f32x4 z = Z[i];
#pragma unroll
                for (int kb = 0; kb < 4; ++kb) if (kb < i) { const f32x4 av = *(const f32x4*)(AAB + (16 * i + c16) * FP + 16 * kb + 4 * g);
#pragma unroll
                    for (int s = 0; s < 4; ++s) z = __builtin_amdgcn_mfma_f32_16x16x4f32(av[s], X[kb][s], z, 0, 0, 0); }
                const f32x4 tv = *(const f32x4*)(TII + (i * 16 + c16) * TP + 4 * g); f32x4 x = {0.f, 0.f, 0.f, 0.f};
#pragma unroll
                for (int s = 0; s < 4; ++s) x = __builtin_amdgcn_mfma_f32_16x16x4f32(tv[s], z[s], x, 0, 0, 0);
                X[i] = x; }
#pragma unroll
            for (int i = 0; i < 4; ++i) *(v2u*)(XT + (16 * wave + c16) * PITCH + 16 * i + 4 * g) = pack4(X[i]);
        }
        __syncthreads();
        {
            const int q = wave >> 1, hh = wave & 1;
            bf16* MCg = (bf16*)(a.ws + WS_MC) + (size_t)unit * 4096; float* NCg = (float*)(a.ws + WS_NC) + (size_t)unit * 4096;
            bf16* PPg = (bf16*)(a.ws + WS_PP) + (size_t)unit * 4096; bf16* Y0g = (bf16*)(a.ws + WS_Y0) + (size_t)unit * 4096;
#pragma unroll
            for (int t2 = 0; t2 < 2; ++t2) { const int ti = 2 * hh + t2;
#pragma unroll
                for (int tj = 0; tj < 4; ++tj) { f32x4 acc = {0.f, 0.f, 0.f, 0.f}; const int cc = 16 * tj + c16, rr = 16 * ti + 4 * g;
                    if (q == 0) { acc = mma2(XT + (16 * ti + c16) * PITCH + 8 * g, BBT + cc * PITCH + 8 * g, acc); *(v2u*)(MCg + cc * 64 + (ti >> 1) * 32 + g * 8 + (ti & 1) * 4) = pack4(acc); }
                    else if (q == 1) { acc = mma2(BBT + (16 * ti + c16) * PITCH + 8 * g, XT + (64 + cc) * PITCH + 8 * g, acc); acc = mma2(KBT + (16 * ti + c16) * PITCH + 8 * g, VT + cc * PITCH + 8 * g, acc);
                        *(f32x4*)(NCg + cc * 64 + rr) = acc; }
                    else if (q == 2) { acc = mma2(XT + (16 * ti + c16) * PITCH + 8 * g, ARB + cc * PITCH + 8 * g, acc);
                        const v2u rv = *(const v2u*)(RT + cc * PITCH + rr); acc[0] += bf2f(rv.x & 0xffffu); acc[1] += bf2f(rv.x >> 16); acc[2] += bf2f(rv.y & 0xffffu); acc[3] += bf2f(rv.y >> 16);
                        *(v2u*)(PPg + cc * 64 + rr) = pack4(acc); }
                    else { acc = mma2(XT + (64 + 16 * ti + c16) * PITCH + 8 * g, ARB + cc * PITCH + 8 * g, acc); acc = mma2(VT + (16 * ti + c16) * PITCH + 8 * g, ARK + cc * PITCH + 8 * g, acc);
                        *(v2u*)(Y0g + cc * 64 + rr) = pack4(acc); }
                } }
            if (tid < 64) ((float*)(a.ws + WS_DEC))[unit * 64 + tid] = __expf(BC[tid]);
        }
        __syncthreads();
    }
}

#define LAS3 __attribute__((address_space(3)))
constexpr int R2_SLOT = 12544, R2_NS = 11, R2_FLAGS = R2_SLOT * R2_NS;
__device__ __forceinline__ void r2_scan(CArgs& a, int chain, unsigned char* L, int tid) {
    asm volatile("" : "+v"(tid));
    const int lane = tid & 63, wave = __builtin_amdgcn_readfirstlane(tid >> 6);
    const int h = chain >> 2, e0 = 16 * (chain & 3), g = lane >> 4, c16 = lane & 15;
    volatile LAS3 unsigned* flg = (volatile LAS3 unsigned*)(LAS3 unsigned char*)(L + R2_FLAGS);
    if (tid < 32) flg[tid] = 0u;
    if (tid >= 64 && tid < 64 + R2_NS) *(volatile LAS3 unsigned*)(LAS3 unsigned char*)(L + (tid - 64) * R2_SLOT + 12288 + 252) = 0xffffffffu;
    __syncthreads();
    const bf16* MC = (const bf16*)(a.ws + WS_MC); const float* NC = (const float*)(a.ws + WS_NC); const float* DEC = (const float*)(a.ws + WS_DEC);
    if (wave != 0) {
        int mco[8], nco[4];
#pragma unroll
        for (int q = 0; q < 8; ++q) { const int pos = 64 * q + lane, row = pos >> 3, kc = (pos & 7) ^ (row & 7); mco[q] = row * 64 + kc * 8; }
#pragma unroll
        for (int q = 0; q < 4; ++q) { const int pos = 64 * q + lane, e = pos >> 4, dc = (pos & 15) ^ e; nco[q] = (e0 + e) * 64 + dc * 4; }
#pragma unroll 1
        for (int c = wave - 1; c < 128; c += 7) {
            while ((int)flg[16] < c - (R2_NS - 1)) __builtin_amdgcn_s_sleep(1);
            LAS3 unsigned char* slot = (LAS3 unsigned char*)(L + (c % R2_NS) * R2_SLOT);
            const size_t unit = (size_t)c * 8 + h;
#pragma unroll
            for (int q = 0; q < 8; ++q) __builtin_amdgcn_global_load_lds((const unsigned*)(MC + unit * 4096 + mco[q]), (LAS3 unsigned*)(slot + q * 1024), 16, 0, 0);
#pragma unroll
            for (int q = 0; q < 4; ++q) __builtin_amdgcn_global_load_lds((const unsigned*)(NC + unit * 4096 + nco[q]), (LAS3 unsigned*)(slot + 8192 + q * 1024), 16, 0, 0);
            __builtin_amdgcn_global_load_lds((const unsigned*)(DEC + unit * 64 + lane), (LAS3 unsigned*)(slot + 12288), 4, 0, 0);
        }
        asm volatile("s_waitcnt vmcnt(0)" ::: "memory");
    } else {
        bf16* S0 = (bf16*)(a.ws + WS_S0);
        f32x4 S[4];
#pragma unroll
        for (int m = 0; m < 4; ++m) S[m] = (f32x4){0.f, 0.f, 0.f, 0.f};
        int avail = 0;
#define R2_MARK(c_) (*(volatile LAS3 unsigned*)(LAS3 unsigned char*)(L + ((c_) % R2_NS) * R2_SLOT + 12288 + 252))
#define R2_WAIT(c_) do { while (avail <= (c_)) { const unsigned f0_ = R2_MARK(c_), f1_ = R2_MARK((c_) + 1), f2_ = R2_MARK((c_) + 2); \
            if (f0_ != 0xffffffffu) { avail = (c_) + 1; if (f1_ != 0xffffffffu) { avail = (c_) + 2; if (f2_ != 0xffffffffu) avail = (c_) + 3; } } \
            else __builtin_amdgcn_s_sleep(0); } asm volatile("" ::: "memory"); } while (0)
#define R2_FREE(c_) do { if (lane == 0) { R2_MARK(c_) = 0xffffffffu; flg[16] = (unsigned)((c_) + 1); } } while (0)
#define R2_READ(c_, A_, N_, D_) do { const LAS3 unsigned char* slot_ = (const LAS3 unsigned char*)(L + ((c_) % R2_NS) * R2_SLOT); \
            _Pragma("unroll") for (int mt = 0; mt < 4; ++mt) { const int row = 16 * mt + c16; \
                A_[mt][0] = *(const LAS3 v4u*)(slot_ + (row * 8 + (g ^ (row & 7))) * 16); A_[mt][1] = *(const LAS3 v4u*)(slot_ + (row * 8 + ((4 + g) ^ (row & 7))) * 16); \
                N_[mt] = *(const LAS3 f32x4*)(slot_ + 8192 + (c16 * 16 + ((4 * mt + g) ^ c16)) * 16); \
                D_[mt] = *(const LAS3 f32x4*)(slot_ + 12288 + (16 * mt + 4 * g) * 4); } } while (0)
#define R2_STEP(c_, A_, N_, D_) do { const size_t ub_ = ((size_t)(c_) * 8 + h) * 4096; v2u sb_[4]; \
            _Pragma("unroll") for (int m = 0; m < 4; ++m) { sb_[m] = pack4(S[m]); *(v2u*)(S0 + ub_ + (e0 + c16) * 64 + 16 * m + 4 * g) = sb_[m]; } \
            const v4u b0_ = {sb_[0].x, sb_[0].y, sb_[1].x, sb_[1].y}, b1_ = {sb_[2].x, sb_[2].y, sb_[3].x, sb_[3].y}; \
            const bf16x8 B0_ = __builtin_bit_cast(bf16x8, b0_), B1_ = __builtin_bit_cast(bf16x8, b1_); \
            f32x4 acc_[4]; \
            _Pragma("unroll") for (int mt = 0; mt < 4; ++mt) acc_[mt] = __builtin_amdgcn_mfma_f32_16x16x32_bf16(__builtin_bit_cast(bf16x8, A_[mt][0]), B0_, N_[mt] + S[mt] * D_[mt], 0, 0, 0); \
            _Pragma("unroll") for (int mt = 0; mt < 4; ++mt) S[mt] = __builtin_amdgcn_mfma_f32_16x16x32_bf16(__builtin_bit_cast(bf16x8, A_[mt][1]), B1_, acc_[mt], 0, 0, 0); } while (0)
        v4u Aa[4][2], Ab[4][2]; f32x4 Na[4], Nb[4]; f32x4 Da[4], Db[4];
        R2_WAIT(0); R2_READ(0, Aa, Na, Da);
        asm volatile("s_waitcnt lgkmcnt(0)" ::: "memory");
#pragma unroll 1
        for (int c = 0; c < 128; c += 2) {
            R2_FREE(c);
            R2_WAIT(c + 1); R2_READ(c + 1, Ab, Nb, Db);
            R2_STEP(c, Aa, Na, Da);
            asm volatile("s_waitcnt lgkmcnt(0)" ::: "memory");
            R2_FREE(c + 1);
            if (c + 2 < 128) { R2_WAIT(c + 2); R2_READ(c + 2, Aa, Na, Da); }
            R2_STEP(c + 1, Ab, Nb, Db);
            asm volatile("s_waitcnt lgkmcnt(0)" ::: "memory");
        }
#undef R2_WAIT
#undef R2_MARK
#undef R2_FREE
#undef R2_STEP
#undef R2_READ
    }
    __syncthreads();
}

__device__ __forceinline__ void r3_phase(CArgs& a, int l, int hb, int gw, int NGW, int lane) {
    asm volatile("" : "+v"(lane));
    const int g = lane >> 4, c16 = lane & 15;
    const bf16* U = (const bf16*)(a.ws + WS_U); const bf16* PP = (const bf16*)(a.ws + WS_PP); const bf16* S0 = (const bf16*)(a.ws + WS_S0); const bf16* Y0 = (const bf16*)(a.ws + WS_Y0);
    const float* BON = (const float*)(a.ws + WS_BON2); bf16* MG = (bf16*)(a.ws + WS_XN) + (size_t)hb * MH * D;
    const float* mu_v = a.in[6] + l * 1664 + 1024; const float* lnw = a.in[14] + l * 512; const float* lnb = a.in[15] + l * 512;
    const int erow = 16 * (c16 >> 2) + (c16 & 3);
#pragma unroll 1
    for (int task = gw; task < NUNIT * 4; task += NGW) {
        const int unit = task >> 2, mt = task & 3, ch = unit >> 3, h = unit & 7; const size_t ub = (size_t)unit * 4096;
        const int lr = 64 * ch + 16 * mt + c16; const bf16* urow = U + (size_t)lr * NPAD + 64 * h + 16 * g;
        float vc[16], vp[16], rgf[16];
        unpack8(*(const v4u*)(urow + C_V), vc); unpack8(*(const v4u*)(urow + C_V + 8), vc + 8); unpack8(*(const v4u*)(urow + C_RG), rgf); unpack8(*(const v4u*)(urow + C_RG + 8), rgf + 8);
        if (lr > 0) { unpack8(*(const v4u*)(urow + C_V - NPAD), vp); unpack8(*(const v4u*)(urow + C_V + 8 - NPAD), vp + 8); }
        else {
#pragma unroll
            for (int i = 0; i < 16; ++i) vp[i] = 0.f; }
        const float bon = BON[lr * 8 + h];
        const bf16* pr = PP + ub + (16 * mt + c16) * 64 + 8 * g;
        const bf16x8 B0 = *(const bf16x8*)pr, B1 = *(const bf16x8*)(pr + 32);
        f32x4 Y[4]; bf16x8 SA[4][2];
#pragma unroll
        for (int et = 0; et < 4; ++et) { const bf16* sr = S0 + ub + (erow + 4 * et) * 64 + 8 * g; SA[et][0] = *(const bf16x8*)sr; SA[et][1] = *(const bf16x8*)(sr + 32); }
        const bf16* y0p = Y0 + ub + (16 * mt + c16) * 64 + 16 * g; const v4u y0a = *(const v4u*)y0p, y0b = *(const v4u*)(y0p + 8);
        asm volatile("" ::: "memory");
        { float yf[16]; unpack8(y0a, yf); unpack8(y0b, yf + 8);
#pragma unroll
          for (int et = 0; et < 4; ++et) Y[et] = (f32x4){yf[4 * et], yf[4 * et + 1], yf[4 * et + 2], yf[4 * et + 3]}; }
#pragma unroll
        for (int et = 0; et < 4; ++et) { f32x4 acc = __builtin_amdgcn_mfma_f32_16x16x32_bf16(SA[et][0], B0, Y[et], 0, 0, 0);
            Y[et] = __builtin_amdgcn_mfma_f32_16x16x32_bf16(SA[et][1], B1, acc, 0, 0, 0); }
        const f32x4 sv = (Y[0] + Y[1]) + (Y[2] + Y[3]); float sm = (sv.x + sv.y) + (sv.z + sv.w); sm += __shfl_xor(sm, 16); sm += __shfl_xor(sm, 32);
        const float mean = sm * (1.f / 64.f); float q = 0.f;
#pragma unroll
        for (int et = 0; et < 4; ++et) { const f32x4 dd = Y[et] - mean; q += (dd.x * dd.x + dd.y * dd.y) + (dd.z * dd.z + dd.w * dd.w); }
        q += __shfl_xor(q, 16); q += __shfl_xor(q, 32);
        const float rstd = rsqrtf(q * (1.f / 64.f) + 64e-5f);
        const int cc = 64 * h + 16 * g; float o[16];
#pragma unroll
        for (int et = 0; et < 4; ++et) {
            const f32x4 w4 = *(const f32x4*)(lnw + cc + 4 * et), b4 = *(const f32x4*)(lnb + cc + 4 * et), m4 = *(const f32x4*)(mu_v + cc + 4 * et);
#pragma unroll
            for (int j = 0; j < 4; ++j) { const int i = 4 * et + j; const float vv = vc[i] + (vp[i] - vc[i]) * m4[j]; const float yn = (Y[et][j] - mean) * rstd * w4[j] + b4[j];
                o[i] = (yn + bon * vv) * rgf[i] * sigm(rgf[i]); } }
        bf16* op = MG + (size_t)lr * D + 512 + cc; *(v4u*)op = pack8(o); *(v4u*)(op + 8) = pack8(o + 8);
    }
}

constexpr int OFF_GQI = 17408, OFF_GKI = 26624, OFF_GKST = 35840, OFF_GVT = 45056, OFF_GSC = 63488, OFF_GTOT = 72704, OFF_GBC = 74752;
constexpr size_t WS_QI = 171 * MiB, WS_OI = 175 * MiB, WS_DS = 191 * MiB, WS_GDEC = 207 * MiB, WS_SP = 208 * MiB;
constexpr int NGUNIT = 512;

__device__ __forceinline__ void g1_phase(CArgs& a, int l, unsigned char* L, int tid0) {
    asm volatile("" : "+v"(tid0));
    const int wave = __builtin_amdgcn_readfirstlane(tid0 >> 6);
    const bf16* U = (const bf16*)(a.ws + WS_U);
    float* XW = (float*)L; bf16* QI = (bf16*)(L + OFF_GQI); bf16* KI = (bf16*)(L + OFF_GKI); bf16* KST = (bf16*)(L + OFF_GKST); bf16* VT = (bf16*)(L + OFF_GVT); bf16* SC = (bf16*)(L + OFF_GSC);
    float* TOT = (float*)(L + OFF_GTOT); float* BC = (float*)(L + OFF_GBC);
    float* GW = (float*)(L + OFF_GBC + 256);
    int hl = -1;
    v4u Gl0, Gl1, Gq, Gk, Gv0, Gv1;
#define G1_ISSUE(u_) do { const int lr_ = 64 * ((u_) >> 2) + (tid >> 3), h_ = (u_) & 3, dg_ = tid & 7; const bf16* ur_ = U + (size_t)lr_ * NPAD; \
        Gl0 = *(const v4u*)(ur_ + C_GLR); Gl1 = *(const v4u*)(ur_ + C_GLR + 8); Gq = *(const v4u*)(ur_ + C_GQ + 64 * h_ + 8 * dg_); Gk = *(const v4u*)(ur_ + C_GK + 64 * h_ + 8 * dg_); \
        Gv0 = *(const v4u*)(ur_ + C_GV + 128 * h_ + 16 * dg_); Gv1 = *(const v4u*)(ur_ + C_GV + 128 * h_ + 16 * dg_ + 8); } while (0)
#pragma unroll 1
    for (int unit = blockIdx.x; unit < NGUNIT; unit += gridDim.x) {
        int tid = tid0; asm volatile("" : "+v"(tid));
        const int lane = tid & 63, g = lane >> 4, c16 = lane & 15;
        const int ch = unit >> 2, h = unit & 3;
        if (h != hl) { hl = h; __syncthreads();
            for (int i = tid; i < 16 * 64; i += NTHR) GW[i] = a.in[3][l * 16 * 256 + (i >> 6) * 256 + 64 * h + (i & 63)];
            if (tid < 64) GW[1024 + tid] = a.in[4][l * 256 + 64 * h + tid];
            __syncthreads(); }
        const int t = tid >> 3, dg = tid & 7, d0 = 8 * dg, lr = 64 * ch + t, hc = 64 * h + d0;
        if (unit == (int)blockIdx.x) G1_ISSUE(unit);
        float q[8], k[8];
        {
            float glr[16]; unpack8(Gl0, glr); unpack8(Gl1, glr + 8);
            float x[8]; const float* gb = GW + 1024 + d0; const float* gu = GW + d0;
#pragma unroll
            for (int i = 0; i < 8; ++i) x[i] = gb[i];
#pragma unroll
            for (int r = 0; r < 16; ++r) { const f32x4 u0 = *(const f32x4*)(gu + r * 64), u1 = *(const f32x4*)(gu + r * 64 + 4);
                x[0] += glr[r] * u0.x; x[1] += glr[r] * u0.y; x[2] += glr[r] * u0.z; x[3] += glr[r] * u0.w; x[4] += glr[r] * u1.x; x[5] += glr[r] * u1.y; x[6] += glr[r] * u1.z; x[7] += glr[r] * u1.w; }
#pragma unroll
            for (int i = 0; i < 8; ++i) XW[t * FP + d0 + i] = (fminf(x[i], 0.f) - log1pf(__expf(-fabsf(x[i])))) * (1.f / 16.f);
            unpack8(Gq, q); unpack8(Gk, k);
            float vv[16]; const int e0 = 16 * dg; unpack8(Gv0, vv); unpack8(Gv1, vv + 8);
            asm volatile("" ::: "memory");
            if (unit + (int)gridDim.x < NGUNIT) G1_ISSUE(unit + (int)gridDim.x);
#pragma unroll
            for (int i = 0; i < 16; ++i) VT[(e0 + i) * PITCH + t] = (bf16)f2bf(vv[i]);
        }
        __syncthreads();
        {
            const int d = tid & 63, tb = tid >> 6; float p[8]; float run = 0.f;
#pragma unroll
            for (int i = 0; i < 8; ++i) { run += XW[(8 * tb + i) * FP + d]; p[i] = run; }
            TOT[tb * 64 + d] = run;
            __syncthreads();
            float off = 0.f;
#pragma unroll
            for (int j = 0; j < 8; ++j) off += (j < tb) ? TOT[j * 64 + d] : 0.f;
#pragma unroll
            for (int i = 0; i < 8; ++i) XW[(8 * tb + i) * FP + d] = off + p[i];
            if (tb == 7) BC[d] = off + run;
        }
        __syncthreads();
        {
            float qi[8], ki[8];
#pragma unroll
            for (int i = 0; i < 8; ++i) { const float b = XW[t * FP + d0 + i], bc = BC[d0 + i];
                qi[i] = q[i] * 0.125f * __expf(b); ki[i] = k[i] * __expf(-b); KST[(d0 + i) * PITCH + t] = (bf16)f2bf(k[i] * __expf(bc - b)); }
            const v4u qp = pack8(qi);
            *(v4u*)(QI + t * PITCH + d0) = qp; *(v4u*)(KI + t * PITCH + d0) = pack8(ki);
            *(v4u*)((bf16*)(a.ws + WS_QI) + (size_t)unit * 4096 + t * 64 + d0) = qp;
        }
        __syncthreads();
        {
            const int tt = wave >> 1; const int tcol = 16 * tt + c16;
#pragma unroll
            for (int j2 = 0; j2 < 2; ++j2) { const int jt = 2 * (wave & 1) + j2; f32x4 acc = {0.f, 0.f, 0.f, 0.f};
                if (jt <= tt) { acc = mma2(KI + (16 * jt + c16) * PITCH + 8 * g, QI + tcol * PITCH + 8 * g, acc);
#pragma unroll
                    for (int j = 0; j < 4; ++j) if (16 * jt + 4 * g + j > tcol) acc[j] = 0.f; }
                *(v2u*)(SC + tcol * PITCH + 16 * jt + 4 * g) = pack4(acc); }
            bf16* DSg = (bf16*)(a.ws + WS_DS) + (size_t)unit * 8192;
#pragma unroll
            for (int i = 0; i < 4; ++i) { const int tile = wave * 4 + i, dt = tile & 3, et = tile >> 2; f32x4 acc = {0.f, 0.f, 0.f, 0.f};
                acc = mma2(KST + (16 * dt + c16) * PITCH + 8 * g, VT + (16 * et + c16) * PITCH + 8 * g, acc);
                *(v2u*)(DSg + (16 * et + c16) * 64 + 16 * dt + 4 * g) = pack4(acc); }
            if (tid < 64) ((float*)(a.ws + WS_GDEC))[unit * 64 + tid] = __expf(BC[tid]);
        }
        __syncthreads();
        {
            bf16* OIg = (bf16*)(a.ws + WS_OI) + (size_t)unit * 8192;
#pragma unroll
            for (int i = 0; i < 4; ++i) { const int tile = wave * 4 + i, tt = tile & 3, et = tile >> 2; f32x4 acc = {0.f, 0.f, 0.f, 0.f};
                acc = mma2(VT + (16 * et + c16) * PITCH + 8 * g, SC + (16 * tt + c16) * PITCH + 8 * g, acc);
                *(v2u*)(OIg + (16 * tt + c16) * 128 + 16 * et + 4 * g) = pack4(acc); }
        }
        __syncthreads();
    }
}

__device__ __forceinline__ void g2_scan(CArgs& a, int gid) {
    asm volatile("" : "+v"(gid));
    const int h = gid >> 13, ed = gid & 8191, d = gid & 63;
    const bf16* DS = (const bf16*)(a.ws + WS_DS); const float* GD = (const float*)(a.ws + WS_GDEC); bf16* SP = (bf16*)(a.ws + WS_SP);
    float S = 0.f;
#pragma unroll 1
    for (int cb = 0; cb < 128; cb += 16) {
        float ds[16], dc[16];
#pragma unroll
        for (int i = 0; i < 16; ++i) { const size_t unit = (size_t)(cb + i) * 4 + h; ds[i] = bf2f(DS[unit * 8192 + ed]); dc[i] = GD[unit * 64 + d]; }
#pragma unroll
        for (int i = 0; i < 16; ++i) { const size_t unit = (size_t)(cb + i) * 4 + h; SP[unit * 8192 + ed] = (bf16)f2bf(S); S = S * dc[i] + ds[i]; }
    }
}

__device__ __forceinline__ void g3_phase(CArgs& a, int l, int hb, int gw, int NGW, int lane) {
    asm volatile("" : "+v"(lane));
    const int g = lane >> 4, c16 = lane & 15;
    const bf16* U = (const bf16*)(a.ws + WS_U); const bf16* QI = (const bf16*)(a.ws + WS_QI); const bf16* SP = (const bf16*)(a.ws + WS_SP); const bf16* OI = (const bf16*)(a.ws + WS_OI);
    bf16* MG = (bf16*)(a.ws + WS_XN) + (size_t)hb * MH * D; const float* gnw = a.in[5] + l * 128;
    const int erow = 32 * (c16 >> 2) + (c16 & 3);
#pragma unroll 1
    for (int task = gw; task < NGUNIT * 4; task += NGW) {
        const int unit = task >> 2, mt = task & 3, ch = unit >> 2, h = unit & 3;
        const int lr = 64 * ch + 16 * mt + c16; const bf16* urow = U + (size_t)lr * NPAD + C_GG + 128 * h + 32 * g;
        const v4u gg0 = *(const v4u*)urow, gg1 = *(const v4u*)(urow + 8), gg2 = *(const v4u*)(urow + 16), gg3 = *(const v4u*)(urow + 24);
        const bf16* qr = QI + (size_t)unit * 4096 + (16 * mt + c16) * 64 + 8 * g;
        const bf16x8 B0 = *(const bf16x8*)qr, B1 = *(const bf16x8*)(qr + 32);
        f32x4 O[8]; float ss = 0.f; bf16x8 SA[8][2];
#pragma unroll
        for (int et = 0; et < 8; ++et) { const bf16* sr = SP + (size_t)unit * 8192 + (erow + 4 * et) * 64 + 8 * g; SA[et][0] = *(const bf16x8*)sr; SA[et][1] = *(const bf16x8*)(sr + 32); }
        const bf16* oip = OI + (size_t)unit * 8192 + (16 * mt + c16) * 128 + 32 * g; const v4u oi0 = *(const v4u*)oip, oi1 = *(const v4u*)(oip + 8), oi2 = *(const v4u*)(oip + 16), oi3 = *(const v4u*)(oip + 24);
        asm volatile("" ::: "memory");
        { float of[32]; unpack8(oi0, of); unpack8(oi1, of + 8); unpack8(oi2, of + 16); unpack8(oi3, of + 24);
#pragma unroll
          for (int et = 0; et < 8; ++et) O[et] = (f32x4){of[4 * et], of[4 * et + 1], of[4 * et + 2], of[4 * et + 3]}; }
#pragma unroll
        for (int et = 0; et < 8; ++et) { f32x4 acc = __builtin_amdgcn_mfma_f32_16x16x32_bf16(SA[et][0], B0, O[et], 0, 0, 0);
            acc = __builtin_amdgcn_mfma_f32_16x16x32_bf16(SA[et][1], B1, acc, 0, 0, 0);
            O[et] = acc; ss += (acc.x * acc.x + acc.y * acc.y) + (acc.z * acc.z + acc.w * acc.w); }
        ss += __shfl_xor(ss, 16); ss += __shfl_xor(ss, 32);
        const float rstd = rsqrtf(ss * (1.f / 128.f) + 1e-6f);
        float gf[32], o[32]; unpack8(gg0, gf); unpack8(gg1, gf + 8); unpack8(gg2, gf + 16); unpack8(gg3, gf + 24);
#pragma unroll
        for (int et = 0; et < 8; ++et) { const f32x4 w4 = *(const f32x4*)(gnw + 32 * g + 4 * et);
#pragma unroll
            for (int j = 0; j < 4; ++j) { const int i = 4 * et + j; o[i] = O[et][j] * rstd * w4[j] * gf[i] * sigm(gf[i]); } }
        bf16* op = MG + (size_t)lr * D + 128 * h + 32 * g;
        *(v4u*)op = pack8(o); *(v4u*)(op + 8) = pack8(o + 8); *(v4u*)(op + 16) = pack8(o + 16); *(v4u*)(op + 24) = pack8(o + 24);
    }
}

#define LAS __attribute__((address_space(3)))
#define XB_TMO      128
#define XB_XCNT(j)  (256  + 64 * (j))
#define XB_XSUB(j)  (1280 + 64 * (j))
#define XB_XGEN(j)  (2304 + 64 * (j))
#define XB_TOP      3328
#define XB_TOPGEN   3392
#define XCD_BAR_WORDS 3456
#define XB_SPIN_CAP (1u << 18)

__device__ __forceinline__ unsigned xb_ld(unsigned* p)              { return __hip_atomic_load(p, __ATOMIC_RELAXED, __HIP_MEMORY_SCOPE_AGENT); }
__device__ __forceinline__ unsigned xb_add(unsigned* p, unsigned v) { return __hip_atomic_fetch_add(p, v, __ATOMIC_RELAXED, __HIP_MEMORY_SCOPE_AGENT); }
__device__ __forceinline__ unsigned xb_xcc_id() { return (unsigned)__builtin_amdgcn_s_getreg((3 << 11) | 20) & 0xFu; }
#define XB_SPIN(cond, bar) do { unsigned _sp = 0; while (cond) { __builtin_amdgcn_s_sleep(1); \
    if ((++_sp & 255u) == 0u) { if (xb_ld(&(bar)[XB_TMO])) break; if (_sp > XB_SPIN_CAP) { atomicAdd(&(bar)[XB_TMO], 1u); break; } } } } while (0)

struct XcdBarrier {
    unsigned* bar; unsigned x;
    volatile LAS unsigned* st;
};

__device__ __forceinline__ XcdBarrier xcd_barrier_post(unsigned* bar, volatile LAS unsigned* st) {
    XcdBarrier b; b.bar = bar; b.x = xb_xcc_id(); b.st = st;
    if (threadIdx.x == 0) (void)xb_add(&bar[XB_XCNT(b.x)], 1u);
    return b;
}
__device__ __forceinline__ void xcd_barrier_complete(unsigned* bar, unsigned x, unsigned& nloc, unsigned& nx) {
    const unsigned G = gridDim.x * gridDim.y * gridDim.z;
    unsigned sum, cnt, mine, sp = 0u;
    for (;;) {
        sum = 0u; cnt = 0u; mine = 0u;
#pragma unroll
        for (unsigned j = 0; j < 16; ++j) { const unsigned c = xb_ld(&bar[XB_XCNT(j)]); sum += c; cnt += (c > 0u) ? 1u : 0u; mine = (j == x) ? c : mine; }
        if (sum == G) break;
        __builtin_amdgcn_s_sleep(1);
        if ((++sp & 255u) == 0u) { if (xb_ld(&bar[XB_TMO])) break; if (sp > XB_SPIN_CAP) { atomicAdd(&bar[XB_TMO], 1u); break; } }
    }
    nloc = mine > 0u ? mine : 1u; nx = cnt > 0u ? cnt : 1u;
}

__device__ __forceinline__ void xcd_barrier(const XcdBarrier& b) {
    asm volatile("s_waitcnt vmcnt(0)" ::: "memory");
    __syncthreads();
    if (threadIdx.x == 0) {
        unsigned* bar = b.bar;
        __builtin_amdgcn_s_waitcnt(0);
        unsigned nloc = b.st[0], nx = b.st[1];
        if (nloc == 0u) { xcd_barrier_complete(bar, b.x, nloc, nx); b.st[0] = nloc; b.st[1] = nx; }
        const unsigned old = xb_add(&bar[XB_XSUB(b.x)], 1u);
        const unsigned gen = old / nloc;
        if (old + 1u == (gen + 1u) * nloc) {
            __builtin_amdgcn_fence(__ATOMIC_RELEASE, "agent");
            asm volatile("s_waitcnt vmcnt(0)" ::: "memory");
            const unsigned og = xb_add(&bar[XB_TOP], 1u);
            const unsigned tg = og / nx;
            if (og + 1u == (tg + 1u) * nx) xb_add(&bar[XB_TOPGEN], 1u);
            else XB_SPIN(xb_ld(&bar[XB_TOPGEN]) == tg, bar);
            __builtin_amdgcn_fence(__ATOMIC_ACQUIRE, "agent");
            xb_add(&bar[XB_XGEN(b.x)], 1u);
            asm volatile("s_waitcnt vmcnt(0)" ::: "memory");
        } else {
            XB_SPIN(xb_ld(&bar[XB_XGEN(b.x)]) == gen, bar);
            __builtin_amdgcn_fence(__ATOMIC_ACQUIRE, "agent");
            asm volatile("s_waitcnt vmcnt(0)" ::: "memory");
        }
    }
    __syncthreads();
}


__global__ void __launch_bounds__(NTHR, 2) hymba_fwd(Args a_kernarg) {
    extern __shared__ __attribute__((aligned(16))) unsigned char lds[];
    cg::grid_group grid = cg::this_grid();
    const int tid = threadIdx.x, lane = tid & 63, wave = __builtin_amdgcn_readfirstlane(tid >> 6);
    const int G = gridDim.x, gw = blockIdx.x * NWAVES + wave, NGW = G * NWAVES;
    volatile LAS unsigned* xst = (volatile LAS unsigned*)(LAS unsigned char*)(lds + LDS_BYTES - 64);
    if (tid < 2) xst[tid] = 0u;
    __syncthreads();
    const XcdBarrier xbar = xcd_barrier_post((unsigned*)AA.ws, xst);
    {
        CArgs& a = AA; bf16* XN = (bf16*)(a.ws + WS_XN);
        float* scr = (float*)lds + wave * (64 * 33);
        constexpr int I_IN = (D / 64) * (NPAD / 32), I_OUT = (D / 64) * (D / 32);
        for (int it = gw; it < 2 * (I_IN + I_OUT); it += NGW) {
            int r = it; const int l = r / (I_IN + I_OUT); r -= l * (I_IN + I_OUT);
            if (r < I_IN) transpose_item(a.in[2] + (size_t)l * D * NIN, D, NIN, NPAD, (bf16*)(a.ws + WS_WIN + l * WIN_BYTES), scr, r, lane);
            else transpose_item(a.in[16] + (size_t)l * D * D, D, D, D, (bf16*)(a.ws + WS_WOUT + l * WOUT_BYTES), scr, r - I_IN, lane);
        }
        for (int m = gw; m < M; m += NGW) rms_row(a.in[0] + (size_t)m * D, a.in[1], XN + (size_t)m * D, nullptr, lane);
        {
            bf16* UPT = (bf16*)(a.ws + WS_UPT);
            for (int e = blockIdx.x * NTHR + tid; e < 2 * 2 * 512 * 64; e += G * NTHR) { const int r = e & 63, c = (e >> 6) & 511, q = (e >> 15) & 1, ll = e >> 16;
                UPT[e] = (bf16)f2bf((q ? a.in[10] : a.in[8])[(size_t)ll * 64 * 512 + r * 512 + c]); }
        }
    }
    grid.sync();
    for (int l = 0; l < 2; ++l) {
        for (int hb = 0; hb < 2; ++hb) {
            {
                CArgs& a = AA; bf16* XN = (bf16*)(a.ws + WS_XN); bf16* U = (bf16*)(a.ws + WS_U);
                pg8::Gemm g{XN + (size_t)hb * MH * D, (const bf16*)(a.ws + WS_WIN + l * WIN_BYTES), MH, NPAD, D}; pg8::StaticOrder S; S.init(MH, NPAD, G, (int)blockIdx.x);
                pg8::EpiBf16<0> E{U, NPAD, nullptr, 0, 0, 1.f};
                pg8::gemm_phase<pg8::EpiBf16<0>, pg8::StaticOrder, true, true>((PG8_LAS unsigned char*)lds, g, S, E);
            }
            xcd_barrier(xbar);
            r1_phase(AA, l, lds, tid);
            g1_phase(AA, l, lds, tid);
            xcd_barrier(xbar);
            if (blockIdx.x < 32) r2_scan(AA, blockIdx.x, lds, tid);
            else if (blockIdx.x < 96) g2_scan(AA, (blockIdx.x - 32) * NTHR + tid);
            xcd_barrier(xbar);
            r3_phase(AA, l, hb, gw, NGW, lane);
            g3_phase(AA, l, hb, gw, NGW, lane);
            xcd_barrier(xbar);
        }
        {
            CArgs& a = AA; bf16* XN = (bf16*)(a.ws + WS_XN);
            pg8::Gemm g{XN, (const bf16*)(a.ws + WS_WOUT + l * WOUT_BYTES), M, D, D}; pg8::StaticOrder S; S.init(M, D, G, (int)blockIdx.x);
            pg8::EpiResid E{l == 0 ? a.in[0] : a.out, a.out, D};
            pg8::gemm_phase<pg8::EpiResid, pg8::StaticOrder, true, true>((PG8_LAS unsigned char*)lds, g, S, E);
        }
        xcd_barrier(xbar);
        { int ln = lane; asm volatile("" : "+v"(ln)); CArgs& a = AA; bf16* XN = (bf16*)(a.ws + WS_XN);
        if (l == 0) { for (int m = gw; m < M; m += NGW) rms_row(a.out + (size_t)m * D, a.in[1] + D, XN + (size_t)m * D, nullptr, ln); xcd_barrier(xbar); }
        else { for (int m = gw; m < M; m += NGW) rms_row(a.out + (size_t)m * D, a.in[17], nullptr, a.out + (size_t)m * D, ln); } }
    }
}

extern "C" void kernel_launch(void* const* d_in, const int* in_sizes, int n_in, void* d_out, int out_size, void* d_ws, size_t ws_size, hipStream_t stream) {
    static int grid = 0;
    if (grid == 0) {
        if (n_in != 18 || out_size != M * D || ws_size < WS_END) { fprintf(stderr, "kernel_launch: unexpected shapes n_in %d out %d ws %zu\n", n_in, out_size, ws_size); grid = -1; return; }
        int dev = 0, cus = 0, per_cu = 0;
        hipGetDevice(&dev); hipDeviceGetAttribute(&cus, hipDeviceAttributeMultiprocessorCount, dev);
        if (hipFuncSetAttribute((const void*)hymba_fwd, hipFuncAttributeMaxDynamicSharedMemorySize, LDS_BYTES) != hipSuccess) { fprintf(stderr, "kernel_launch: hipFuncSetAttribute failed\n"); grid = -1; return; }
        if (hipOccupancyMaxActiveBlocksPerMultiprocessor(&per_cu, (const void*)hymba_fwd, NTHR, LDS_BYTES) != hipSuccess || per_cu < 1) { fprintf(stderr, "kernel_launch: occupancy query failed (%d)\n", per_cu); grid = -1; return; }
        grid = cus * 1;
        fprintf(stderr, "kernel_launch: cus %d per_cu %d grid %d\n", cus, per_cu, grid);
    }
    if (grid < 0) return;
    if (hipMemsetAsync(d_ws, 0, 16384, stream) != hipSuccess) { fprintf(stderr, "kernel_launch: memset failed\n"); return; }
    Args a{};
    for (int i = 0; i < 18; ++i) a.in[i] = (const float*)d_in[i];
    a.out = (float*)d_out; a.ws = (unsigned char*)d_ws;
    void* args[] = {&a};
    hipError_t e = hipLaunchCooperativeKernel((const void*)hymba_fwd, dim3(grid), dim3(NTHR), args, LDS_BYTES, stream);
    if (e != hipSuccess) fprintf(stderr, "cooperative launch failed: %s (grid %d)\n", hipGetErrorString(e), grid);
}
```

```cpp
#include <hip/hip_runtime.h>
#include <hip/hip_cooperative_groups.h>
#include <cstdio>
#include <cstdint>
namespace cg = cooperative_groups;
namespace pg8 {
#define PG8_LAS __attribute__((address_space(3)))
typedef unsigned short bf16_t;
typedef short bf16x8 __attribute__((ext_vector_type(8)));
typedef float f32x4 __attribute__((ext_vector_type(4)));
typedef unsigned u32x4 __attribute__((ext_vector_type(4)));
constexpr int BM = 256, BK = 64, HALF = 128, HTB = HALF * BK * 2  , STAGE_BYTES = 8 * HTB, NXCD = 8, WGM = 8;

__host__ __device__ __forceinline__ int lds_byte(int r, int c) { const int st = (r >> 4) * 2 + (c >> 5), rr = r & 15, cc = c & 31, ob = rr * 64 + cc * 2; return st * 1024 + (ob ^ (((ob >> 9) & 1) << 5)); }
__host__ __device__ __forceinline__ void stage_rc(int b, int& R, int& C) { const int st = b / 1024, sb = b % 1024, swz = sb ^ (((sb >> 9) & 1) << 5); R = (st >> 1) * 16 + swz / 64; C = (st & 1) * 32 + (swz % 64) / 2; }
__host__ __device__ __forceinline__ int perm32(int rho) { const int n = rho >> 4, i = rho & 15; return 8 * (i >> 2) + 4 * n + (i & 3); }

struct Unit { int pm, pn; };
struct Gemm { const bf16_t* A; const bf16_t* Bt; int M, N, K; };

struct StaticOrder {
    int nM, nN, nwg, G, c;
    __host__ __device__ void init(int M, int N, int G_, int c_) { nM = M / BM; nN = N / BM; nwg = nM * nN; G = G_; c = c_; }
    __host__ __device__ bool next(int i, Unit& u) const {
        const long L = (long)i * G + c; if (L >= nwg) return false;
        int wgid = (int)L; { const int q = nwg / NXCD, r = nwg % NXCD, xcd = wgid % NXCD, off = wgid / NXCD; wgid = (xcd < r ? xcd * (q + 1) : r * (q + 1) + (xcd - r) * q) + off; }
        const int nig = WGM * nN, gid = wgid / nig, fm = gid * WGM, gsz = (nM - fm) < WGM ? (nM - fm) : WGM;
        u.pm = fm + ((wgid % nig) % gsz); u.pn = (wgid % nig) / gsz; return true;
    }
    __device__ __forceinline__ void a_ready(const Unit&) const {}
    __device__ __forceinline__ void done(const Unit&) const {}
};

__device__ __forceinline__ unsigned cvt_pk_bf16(float lo, float hi) { unsigned r; asm volatile("v_cvt_pk_bf16_f32 %0, %1, %2" : "=v"(r) : "v"(lo), "v"(hi)); return r; }
typedef float f32x2 __attribute__((ext_vector_type(2)));
__device__ __forceinline__ f32x2 gelu_pk(f32x2 v) {
    const f32x2 av = __builtin_elementwise_abs(v), d = av * 0.2316418882f + 1.0f;
    f32x2 t; t.x = __builtin_amdgcn_rcpf(d.x); t.y = __builtin_amdgcn_rcpf(d.y);
    f32x2 q = t * 0.5307027145f + (-0.7265760135f); q = q * t + 0.7107068705f; q = q * t + (-0.142248368f); q = q * t + 0.127414796f; q = q * t;
    const f32x2 s = (v * v) * (-0.72134752044f);
    f32x2 e; e.x = __builtin_amdgcn_exp2f(s.x); e.y = __builtin_amdgcn_exp2f(s.y);
    const f32x2 m = v * (q * e), r = v - m;
    f32x2 o; o.x = v.x < 0.f ? m.x : r.x; o.y = v.y < 0.f ? m.y : r.y; return o;
}

template <int ACT  > struct EpiBf16 {
    static constexpr bool PERM = true, AFTER_DRAIN = false; static_assert(ACT == 0 || ACT == 1, "EpiBf16: ACT is 0 (none) or 1 (gelu_pk)");
    bf16_t* O; int ldc; const float* bias; int split_cols; size_t split_stride; float scale0;
    __device__ __forceinline__ void operator()(const f32x4 (&acc)[2][2][4][2], const Unit& u, int wr, int wc, int fr, int fq) const {
        const int row0 = u.pm * BM + wr * 64 + fr; int colt = u.pn * BM; bf16_t* base = O;
        float sc = 1.f; if (split_cols) { const int t = colt / split_cols; base += (size_t)t * split_stride; colt -= t * split_cols; if (t == 0) sc = scale0; }
        const int col0 = colt + wc * 32 + 8 * fq, bcol0 = u.pn * BM + wc * 32 + 8 * fq;
        f32x4 bv[2][2];
#pragma unroll
        for (int bj = 0; bj < 2; ++bj)
#pragma unroll
            for (int n = 0; n < 2; ++n) bv[bj][n] = bias ? *(const f32x4*)(bias + bcol0 + bj * HALF + 4 * n) : (f32x4){0.f, 0.f, 0.f, 0.f};
#pragma unroll
        for (int ai = 0; ai < 2; ++ai)
#pragma unroll
            for (int m = 0; m < 4; ++m) { bf16_t* rowp = base + (size_t)(row0 + ai * HALF + m * 16) * ldc + col0;
#pragma unroll
                for (int bj = 0; bj < 2; ++bj) { f32x4 v0 = acc[ai][bj][m][0] + bv[bj][0], v1 = acc[ai][bj][m][1] + bv[bj][1];
                    if (ACT == 1) { f32x2 a = gelu_pk((f32x2){v0[0], v0[1]}), b = gelu_pk((f32x2){v0[2], v0[3]}), c = gelu_pk((f32x2){v1[0], v1[1]}), d = gelu_pk((f32x2){v1[2], v1[3]});
                        v0 = (f32x4){a.x, a.y, b.x, b.y}; v1 = (f32x4){c.x, c.y, d.x, d.y}; }
                    v0 = v0 * sc; v1 = v1 * sc; u32x4 w; w.x = cvt_pk_bf16(v0[0], v0[1]); w.y = cvt_pk_bf16(v0[2], v0[3]); w.z = cvt_pk_bf16(v1[0], v1[1]); w.w = cvt_pk_bf16(v1[2], v1[3]);
                    *(u32x4*)(rowp + bj * HALF) = w; } }
    }
};

template <class Epi, class Sched, bool ALIGN_EPI = false, bool SP2 = false>
__device__ __forceinline__ void gemm_phase(PG8_LAS unsigned char* lds, const Gemm g, const Sched& S, const Epi& E) {
    int tid_ = threadIdx.x; asm volatile("" : "+v"(tid_));
    const int tid = tid_, wid = __builtin_amdgcn_readfirstlane(tid >> 6), lane = tid & 63, wr = wid >> 2, wc = wid & 3, fr = lane & 15, fq = lane >> 4;
    const int K = g.K, nt = K / BK;
    unsigned voffA[2], voffB[2];
#pragma unroll
    for (int i = 0; i < 2; ++i) { int R, C; stage_rc(tid * 16 + i * 8192, R, C); const int Rb = Epi::PERM ? ((R & ~31) + perm32(R & 31)) : R;
        voffA[i] = (unsigned)(R * K + C) * 2u; voffB[i] = (unsigned)(Rb * K + C) * 2u; }
    const size_t kstep = (size_t)(BK * 2);
    const size_t hstep = (size_t)HALF * K * 2;
    const size_t tstep = 2 * hstep;
    const unsigned ldsw = (unsigned)wid * 1024u;
    const int aoff = lds_byte(wr * 64 + fr, fq * 8), boff = lds_byte(wc * 32 + fr, fq * 8);
#define PG8_SA(b, h) (((b) * 2 + (h)) * HTB)
#define PG8_SB(b, h) ((4 + (b) * 2 + (h)) * HTB)
#define PG8_STAGE(bufoff, gbase, voff) do { _Pragma("unroll") for (int _i = 0; _i < 2; ++_i) \
        __builtin_amdgcn_global_load_lds((const unsigned*)((const char*)(gbase) + (voff)[_i]), (PG8_LAS unsigned*)(lds + (bufoff) + ldsw + _i * 8192), 16, 0, 0); } while (0)
#define PG8_LDA(dst, b, h) do { _Pragma("unroll") for (int m = 0; m < 4; ++m) _Pragma("unroll") for (int k = 0; k < 2; ++k) dst[m][k] = *(const PG8_LAS bf16x8*)(lds + PG8_SA(b, h) + aoff + m * 2048 + k * 1024); } while (0)
#define PG8_LDB(dst, b, h) do { _Pragma("unroll") for (int n = 0; n < 2; ++n) _Pragma("unroll") for (int k = 0; k < 2; ++k) dst[n][k] = *(const PG8_LAS bf16x8*)(lds + PG8_SB(b, h) + boff + n * 2048 + k * 1024); } while (0)
#define PG8_MMA(ai, bj, At, Bt) do { __builtin_amdgcn_s_setprio(1); _Pragma("unroll") for (int m = 0; m < 4; ++m) _Pragma("unroll") for (int n = 0; n < 2; ++n) _Pragma("unroll") for (int k = 0; k < 2; ++k) \
        acc[ai][bj][m][n] = __builtin_amdgcn_mfma_f32_16x16x32_bf16(Bt[n][k], At[m][k], acc[ai][bj][m][n], 0, 0, 0); __builtin_amdgcn_s_setprio(0); } while (0)
#define PG8_WAIT_V(n) asm volatile("s_waitcnt vmcnt(" #n ")" ::: "memory")
#define PG8_WAIT_L(n) asm volatile("s_waitcnt lgkmcnt(" #n ")" ::: "memory")
#define PG8_BAR __builtin_amdgcn_s_barrier()
#define PG8_SCHED __builtin_amdgcn_sched_barrier(0)
    Unit cur, nxt; int ui = 0;
    if (!S.next(0, cur)) return;
    f32x4 acc[2][2][4][2];
#pragma unroll
    for (int a = 0; a < 2; ++a)
#pragma unroll
        for (int b = 0; b < 2; ++b)
#pragma unroll
            for (int m = 0; m < 4; ++m)
#pragma unroll
                for (int n = 0; n < 2; ++n) acc[a][b][m][n] = (f32x4){0.f, 0.f, 0.f, 0.f};
    bf16x8 At[4][2], B0[2][2], B1[2][2];
    const char* cA = (const char*)g.A + (size_t)cur.pm * tstep; const char* cB = (const char*)g.Bt + (size_t)cur.pn * tstep;
    S.a_ready(cur);
    if constexpr (SP2) {
        PG8_STAGE(PG8_SB(0, 0), cB, voffB); PG8_STAGE(PG8_SB(0, 1), cB + hstep, voffB); PG8_STAGE(PG8_SA(0, 0), cA, voffA); PG8_STAGE(PG8_SA(0, 1), cA + hstep, voffA);
        if (wr == 1) PG8_BAR;
        PG8_WAIT_V(2); PG8_BAR;
        PG8_STAGE(PG8_SB(1, 0), cB + kstep, voffB); PG8_STAGE(PG8_SA(1, 0), cA + kstep, voffA); PG8_STAGE(PG8_SB(1, 1), cB + hstep + kstep, voffB);
        PG8_WAIT_V(6); PG8_BAR;
    } else {
        PG8_STAGE(PG8_SB(0, 0), cB, voffB); PG8_STAGE(PG8_SA(0, 0), cA, voffA); PG8_STAGE(PG8_SB(0, 1), cB + hstep, voffB); PG8_STAGE(PG8_SA(0, 1), cA + hstep, voffA);
        if (wr == 1) PG8_BAR;
        PG8_WAIT_V(4); PG8_BAR;
        PG8_STAGE(PG8_SB(1, 0), cB + kstep, voffB); PG8_STAGE(PG8_SA(1, 0), cA + kstep, voffA); PG8_STAGE(PG8_SB(1, 1), cB + hstep + kstep, voffB);
        PG8_WAIT_V(6); PG8_BAR;
    }
    for (;;) {
        const bool has_next = S.next(ui + 1, nxt);
        const char* nA = has_next ? (const char*)g.A + (size_t)nxt.pm * tstep : cA; const char* nB = has_next ? (const char*)g.Bt + (size_t)nxt.pn * tstep : cB;
        for (int t = 0; t < nt; t += 2) {
            const bool last = (t == nt - 2);
            const char* a1 = cA + (size_t)(t + 1) * kstep;
            const char* a2 = last ? nA : cA + (size_t)(t + 2) * kstep; const char* b2 = last ? nB : cB + (size_t)(t + 2) * kstep;
            const char* a3 = a2 + kstep; const char* b3 = b2 + kstep;
            if (last && has_next) S.a_ready(nxt);
            if constexpr (SP2) {
            PG8_LDB(B0, 0, 0); PG8_LDB(B1, 0, 1); PG8_SCHED; PG8_LDA(At, 0, 0); PG8_STAGE(PG8_SA(1, 1), a1 + hstep, voffA);
            PG8_WAIT_V(8); PG8_WAIT_L(0); PG8_BAR; PG8_MMA(0, 0, At, B0); PG8_MMA(0, 1, At, B1); PG8_BAR; PG8_SCHED;
            PG8_LDA(At, 0, 1); PG8_STAGE(PG8_SB(0, 0), b2, voffB); PG8_STAGE(PG8_SB(0, 1), b2 + hstep, voffB); PG8_STAGE(PG8_SA(0, 0), a2, voffA);
            PG8_WAIT_V(8); PG8_WAIT_L(0); PG8_BAR; PG8_MMA(1, 0, At, B0); PG8_MMA(1, 1, At, B1); PG8_BAR; PG8_SCHED;
            PG8_LDB(B0, 1, 0); PG8_LDB(B1, 1, 1); PG8_SCHED; PG8_LDA(At, 1, 0); PG8_STAGE(PG8_SA(0, 1), a2 + hstep, voffA);
            PG8_WAIT_V(8); PG8_WAIT_L(0); PG8_BAR; PG8_MMA(0, 0, At, B0); PG8_MMA(0, 1, At, B1); PG8_BAR; PG8_SCHED;
            PG8_LDA(At, 1, 1); PG8_STAGE(PG8_SB(1, 0), b3, voffB); PG8_STAGE(PG8_SB(1, 1), b3 + hstep, voffB); PG8_STAGE(PG8_SA(1, 0), a3, voffA);
            PG8_WAIT_V(8); PG8_WAIT_L(0); PG8_BAR; PG8_MMA(1, 0, At, B0); PG8_MMA(1, 1, At, B1); PG8_BAR; PG8_SCHED;
            } else {
            PG8_LDB(B0, 0, 0); PG8_SCHED; PG8_LDA(At, 0, 0); PG8_STAGE(PG8_SA(1, 1), a1 + hstep, voffA);
            PG8_WAIT_L(8); PG8_BAR; PG8_WAIT_L(0); PG8_MMA(0, 0, At, B0); PG8_BAR; PG8_SCHED;
            PG8_LDB(B1, 0, 1); PG8_STAGE(PG8_SB(0, 0), b2, voffB);
            PG8_BAR; PG8_WAIT_L(0); PG8_MMA(0, 1, At, B1); PG8_BAR;
            PG8_LDA(At, 0, 1); PG8_STAGE(PG8_SA(0, 0), a2, voffA);
            PG8_BAR; PG8_WAIT_L(0); PG8_MMA(1, 0, At, B0); PG8_BAR; PG8_SCHED;
            PG8_STAGE(PG8_SB(0, 1), b2 + hstep, voffB);
            PG8_WAIT_V(6); PG8_BAR; PG8_MMA(1, 1, At, B1); PG8_BAR;
            PG8_LDB(B0, 1, 0); PG8_SCHED; PG8_LDA(At, 1, 0); PG8_STAGE(PG8_SA(0, 1), a2 + hstep, voffA);
            PG8_WAIT_L(8); PG8_BAR; PG8_WAIT_L(0); PG8_MMA(0, 0, At, B0); PG8_BAR; PG8_SCHED;
            PG8_LDB(B1, 1, 1); PG8_STAGE(PG8_SB(1, 0), b3, voffB);
            PG8_BAR; PG8_WAIT_L(0); PG8_MMA(0, 1, At, B1); PG8_BAR;
            PG8_LDA(At, 1, 1); PG8_STAGE(PG8_SA(1, 0), a3, voffA);
            PG8_BAR; PG8_WAIT_L(0); PG8_MMA(1, 0, At, B0); PG8_BAR; PG8_SCHED;
            PG8_STAGE(PG8_SB(1, 1), b3 + hstep, voffB);
            PG8_WAIT_V(6); PG8_BAR; PG8_MMA(1, 1, At, B1); PG8_BAR;
            }
        }
        if constexpr (ALIGN_EPI) { if (wr == 0) PG8_BAR; }
        if constexpr (!Epi::AFTER_DRAIN) { E(acc, cur, wr, wc, fr, fq); S.done(cur); }
        if (!has_next) break;
#pragma unroll
        for (int a = 0; a < 2; ++a)
#pragma unroll
            for (int b = 0; b < 2; ++b)
#pragma unroll
                for (int m = 0; m < 4; ++m)
#pragma unroll
                    for (int n = 0; n < 2; ++n) acc[a][b][m][n] = (f32x4){0.f, 0.f, 0.f, 0.f};
        cur = nxt; cA = nA; cB = nB; ++ui;
        if constexpr (ALIGN_EPI) { if (wr == 1) PG8_BAR; }
    }
    PG8_WAIT_V(0);
    if constexpr (!ALIGN_EPI) { if (wr == 0) PG8_BAR; }
    PG8_BAR;
    if constexpr (Epi::AFTER_DRAIN) { E.fused(acc, cur, wr, wc, fr, fq, lds, wid, lane); S.done(cur); }
#undef PG8_SA
#undef PG8_SB
#undef PG8_STAGE
#undef PG8_LDA
#undef PG8_LDB
#undef PG8_MMA
#undef PG8_WAIT_V
#undef PG8_WAIT_L
#undef PG8_BAR
#undef PG8_SCHED
}
}
namespace pg8 {
struct EpiResid {
    static constexpr bool PERM = false, AFTER_DRAIN = false;
    const float* base; float* out; int ldc;
    __device__ __forceinline__ void operator()(const f32x4 (&acc)[2][2][4][2], const Unit& u, int wr, int wc, int fr, int fq) const {
        const int col0 = u.pn * BM + wc * 32 + 4 * fq;
#pragma unroll
        for (int ai = 0; ai < 2; ++ai)
#pragma unroll
            for (int m = 0; m < 4; ++m) { const size_t off = (size_t)(u.pm * BM + ai * HALF + wr * 64 + m * 16 + fr) * ldc + col0;
#pragma unroll
                for (int bj = 0; bj < 2; ++bj)
#pragma unroll
                    for (int n = 0; n < 2; ++n) { const f32x4 b = *(const f32x4*)(base + off + bj * HALF + n * 16); *(f32x4*)(out + off + bj * HALF + n * 16) = b + acc[ai][bj][m][n]; } }
    }
};
struct EpiRmsRes {
    static constexpr bool PERM = false, AFTER_DRAIN = true;
    const float* base; float* out; bf16_t* xn; const float* w; float* slots; unsigned* cnt; int ldc; int mode;
    __device__ __forceinline__ void fused(f32x4 (&acc)[2][2][4][2], const Unit& u, int wr, int wc, int fr, int fq, PG8_LAS unsigned char* lds, int wid, int lane) const {
        const int col0 = u.pn * BM + wc * 32 + 4 * fq;
        PG8_LAS float* P = (PG8_LAS float*)lds; PG8_LAS float* S = (PG8_LAS float*)(lds + 4096);
#pragma unroll
        for (int ai = 0; ai < 2; ++ai)
#pragma unroll
            for (int m = 0; m < 4; ++m) { const size_t off = (size_t)(u.pm * BM + ai * HALF + wr * 64 + m * 16 + fr) * ldc + col0; float s = 0.f;
#pragma unroll
                for (int bj = 0; bj < 2; ++bj)
#pragma unroll
                    for (int n = 0; n < 2; ++n) { const f32x4 v = acc[ai][bj][m][n] + *(const f32x4*)(base + off + bj * HALF + n * 16); acc[ai][bj][m][n] = v; s += (v[0] * v[0] + v[1] * v[1]) + (v[2] * v[2] + v[3] * v[3]); }
                s += __shfl_xor(s, 16); s += __shfl_xor(s, 32);
                if (fq == 0) P[(ai * HALF + wr * 64 + m * 16 + fr) * 4 + wc] = s;
                if (m & 1) asm volatile("" ::: "memory"); }
        asm volatile("s_waitcnt lgkmcnt(0)" ::: "memory"); __builtin_amdgcn_s_barrier(); asm volatile("" ::: "memory");
        const int row = wid * 32 + (lane & 31);
        if (lane < 32) { const float tot = (P[row * 4 + 0] + P[row * 4 + 1]) + (P[row * 4 + 2] + P[row * 4 + 3]);
            __hip_atomic_store(slots + ((size_t)(u.pm * BM + row) * 4 + u.pn), tot, __ATOMIC_RELAXED, __HIP_MEMORY_SCOPE_AGENT); }
        asm volatile("s_waitcnt vmcnt(0)" ::: "memory");
        if (lane == 0) __hip_atomic_fetch_add(cnt + 64 * u.pm, 1u, __ATOMIC_RELAXED, __HIP_MEMORY_SCOPE_AGENT);
        if (wid == 0) { while ((unsigned)__builtin_amdgcn_readfirstlane(__hip_atomic_load(cnt + 64 * u.pm, __ATOMIC_RELAXED, __HIP_MEMORY_SCOPE_AGENT)) < 32u) __builtin_amdgcn_s_sleep(2);
            __builtin_amdgcn_fence(__ATOMIC_ACQUIRE, "agent"); }
        asm volatile("s_waitcnt vmcnt(0) lgkmcnt(0)" ::: "memory"); __builtin_amdgcn_s_barrier(); asm volatile("" ::: "memory");
        if (lane < 32) { const float* sl = slots + (size_t)(u.pm * BM + row) * 4; float q = 0.f;
#pragma unroll
            for (int t = 0; t < 4; ++t) q += __hip_atomic_load(sl + t, __ATOMIC_RELAXED, __HIP_MEMORY_SCOPE_AGENT);
            S[row] = 1.0f / sqrtf(q * (1.f / 1024.f) + 1e-6f); }
        asm volatile("s_waitcnt lgkmcnt(0)" ::: "memory"); __builtin_amdgcn_s_barrier(); asm volatile("" ::: "memory");
        f32x4 wv[2][2];
#pragma unroll
        for (int bj = 0; bj < 2; ++bj)
#pragma unroll
            for (int n = 0; n < 2; ++n) wv[bj][n] = *(const f32x4*)(w + col0 + bj * HALF + n * 16);
#pragma unroll
        for (int ai = 0; ai < 2; ++ai)
#pragma unroll
            for (int m = 0; m < 4; ++m) { const int r = ai * HALF + wr * 64 + m * 16 + fr; const float rs = S[r]; const size_t off = (size_t)(u.pm * BM + r) * ldc + col0;
#pragma unroll
                for (int bj = 0; bj < 2; ++bj)
#pragma unroll
                    for (int n = 0; n < 2; ++n) { const f32x4 v = acc[ai][bj][m][n]; const f32x4 nv = v * rs * wv[bj][n];
                        if (mode == 0) { *(f32x4*)(out + off + bj * HALF + n * 16) = v; typedef unsigned u32x2v __attribute__((ext_vector_type(2))); u32x2v pk; pk.x = cvt_pk_bf16(nv[0], nv[1]); pk.y = cvt_pk_bf16(nv[2], nv[3]);
                            *(u32x2v*)(xn + off + bj * HALF + n * 16) = pk; }
                        else *(f32x4*)(out + off + bj * HALF + n * 16) = nv; } }
    }
};
}
constexpr int NWAVES = 8, NTHR = 512;
constexpr int BATCH = 2, T = 8192, D = 1024, M = BATCH * T, MH = T;
constexpr int NIN = 3728, NPAD = 3840;
constexpr int C_GQ = 0, C_GK = 256, C_GV = 512, C_GLR = 1024, C_GG = 1040, C_R = 1552, C_K = 2064, C_V = 2576, C_WL = 3088, C_AL = 3152, C_RG = 3216;
constexpr size_t MiB = 1u << 20;
constexpr size_t WS_WIN = 1 * MiB, WIN_BYTES = (size_t)NPAD * D * 2;
constexpr size_t WS_WOUT = 16 * MiB, WOUT_BYTES = (size_t)D * D * 2;
constexpr size_t WS_XN = 20 * MiB;
constexpr size_t WS_U = 52 * MiB;
constexpr size_t WS_SLOTS = 220 * MiB;
constexpr size_t WS_END = 256 * MiB;
constexpr int LDS_BYTES = 147456;

typedef unsigned short bf16;
typedef unsigned v4u __attribute__((ext_vector_type(4)));
typedef float f32x4 __attribute__((ext_vector_type(4)));
#define LDS_WAIT() asm volatile("s_waitcnt lgkmcnt(0)" ::: "memory")
#define LBAR() do { asm volatile("s_waitcnt lgkmcnt(0)" ::: "memory"); __builtin_amdgcn_s_barrier(); asm volatile("" ::: "memory"); } while (0)
__device__ __forceinline__ float bf2f(unsigned h) { return __uint_as_float(h << 16); }
__device__ __forceinline__ unsigned f2bf(float f) { unsigned u = __float_as_uint(f); return (u + 0x7fffu + ((u >> 16) & 1u)) >> 16; }
typedef __bf16 bf16x2_t __attribute__((ext_vector_type(2)));
typedef float f32x2_t __attribute__((ext_vector_type(2)));
__device__ __forceinline__ unsigned pk2(float lo, float hi) { const f32x2_t v = {lo, hi}; const bf16x2_t b = __builtin_convertvector(v, bf16x2_t); return __builtin_bit_cast(unsigned, b); }
__device__ __forceinline__ float wave_sum(float v) {
#pragma unroll
    for (int o = 1; o < 64; o <<= 1) v += __shfl_xor(v, o);
    return v;
}
__device__ __forceinline__ float sigm(float x) { return __builtin_amdgcn_rcpf(1.f + __expf(-x)); }
__device__ __forceinline__ float tanh_fast(float x) { return 1.f - 2.f * __builtin_amdgcn_rcpf(1.f + __expf(2.f * x)); }
__device__ __forceinline__ float rl(float v, int l) { return __int_as_float(__builtin_amdgcn_readlane(__float_as_int(v), l)); }

typedef short bf16x8 __attribute__((ext_vector_type(8)));
typedef unsigned v2u __attribute__((ext_vector_type(2)));
__device__ __forceinline__ v2u pack4(f32x4 v) { v2u r; r.x = pk2(v.x, v.y); r.y = pk2(v.z, v.w); return r; }
__device__ __forceinline__ void unpack8(v4u w, float* o) { o[0] = bf2f(w.x & 0xffffu); o[1] = bf2f(w.x >> 16); o[2] = bf2f(w.y & 0xffffu); o[3] = bf2f(w.y >> 16);
    o[4] = bf2f(w.z & 0xffffu); o[5] = bf2f(w.z >> 16); o[6] = bf2f(w.w & 0xffffu); o[7] = bf2f(w.w >> 16); }
__device__ __forceinline__ v4u pack8(const float* v) { v4u r; r.x = pk2(v[0], v[1]); r.y = pk2(v[2], v[3]); r.z = pk2(v[4], v[5]); r.w = pk2(v[6], v[7]); return r; }
struct Args { const float* in[18]; float* out; unsigned char* ws; };
typedef const Args __attribute__((address_space(4))) CArgs;
__device__ __forceinline__ CArgs* opaque_args() { CArgs* p = (CArgs*)__builtin_amdgcn_kernarg_segment_ptr(); asm volatile("" : "+s"(p)); return p; }
#define AA (*opaque_args())

__device__ __forceinline__ void rms_row2(const float* x0, const float* x1, const float* w, bf16* o0, bf16* o1, int lane) {
    const f32x4* r0 = (const f32x4*)x0 + lane; const f32x4* r1 = (const f32x4*)x1 + lane; const f32x4* wr = (const f32x4*)w + lane;
    f32x4 a[4], b[4]; float sa = 0.f, sb = 0.f;
#pragma unroll
    for (int j = 0; j < 4; ++j) { a[j] = r0[64 * j]; b[j] = r1[64 * j]; }
#pragma unroll
    for (int j = 0; j < 4; ++j) { sa += (a[j].x * a[j].x + a[j].y * a[j].y) + (a[j].z * a[j].z + a[j].w * a[j].w); sb += (b[j].x * b[j].x + b[j].y * b[j].y) + (b[j].z * b[j].z + b[j].w * b[j].w); }
    const float ra = rsqrtf(wave_sum(sa) * (1.f / D) + 1e-6f), rb = rsqrtf(wave_sum(sb) * (1.f / D) + 1e-6f);
#pragma unroll
    for (int j = 0; j < 4; ++j) { const f32x4 ww = wr[64 * j]; const f32x4 oa = a[j] * ra * ww, ob = b[j] * rb * ww;
        ((v2u*)o0 + lane)[64 * j] = pack4(oa); ((v2u*)o1 + lane)[64 * j] = pack4(ob); }
}
__device__ __forceinline__ void transpose_item(const float* W, int K, int N, int Npad, bf16* WT, float* scr, int item, int lane) {
    const int nblk = Npad / 32, kb = item / nblk, nb = item % nblk, k0 = 64 * kb, n0 = 32 * nb;
    const int n = n0 + (lane & 31);
#pragma unroll 8
    for (int i = 0; i < 32; ++i) { const int kk = 2 * i + (lane >> 5); scr[kk * 33 + (lane & 31)] = (n < N) ? W[(size_t)(k0 + kk) * N + n] : 0.f; }
    LDS_WAIT();
    const int c = lane & 7;
#pragma unroll
    for (int j = 0; j < 4; ++j) { const int nn = (lane >> 3) + 8 * j; const float* s = scr + (8 * c) * 33 + nn;
        v4u o; o.x = pk2(s[0 * 33], s[1 * 33]); o.y = pk2(s[2 * 33], s[3 * 33]); o.z = pk2(s[4 * 33], s[5 * 33]); o.w = pk2(s[6 * 33], s[7 * 33]);
        *(v4u*)(WT + (size_t)(n0 + nn) * K + k0 + 8 * c) = o; }
    LDS_WAIT();
}
__device__ __forceinline__ void transpose_tiles(const float* W, int K, int N, int Npad, bf16* WT, float* scr  , int first, int stride, int ntiles, int tid) {
    const int nblk = Npad / 64, kr = tid >> 4, nq = tid & 15;
    f32x4 v0 = {0.f, 0.f, 0.f, 0.f}, v1 = v0;
    if (first < ntiles) { const int kb = first / nblk, nb = first % nblk, n = 64 * nb + 4 * nq; if (n < N) { v0 = *(const f32x4*)(W + (size_t)(64 * kb + kr) * N + n); v1 = *(const f32x4*)(W + (size_t)(64 * kb + 32 + kr) * N + n); } }
#pragma unroll 1
    for (int it = first; it < ntiles; it += stride) {
        const int kb = it / nblk, nb = it % nblk;
        scr[kr * 65 + 4 * nq] = v0.x; scr[kr * 65 + 4 * nq + 1] = v0.y; scr[kr * 65 + 4 * nq + 2] = v0.z; scr[kr * 65 + 4 * nq + 3] = v0.w;
        scr[(32 + kr) * 65 + 4 * nq] = v1.x; scr[(32 + kr) * 65 + 4 * nq + 1] = v1.y; scr[(32 + kr) * 65 + 4 * nq + 2] = v1.z; scr[(32 + kr) * 65 + 4 * nq + 3] = v1.w;
        const int nx = it + stride; v0 = (f32x4){0.f, 0.f, 0.f, 0.f}; v1 = v0;
        if (nx < ntiles) { const int kb2 = nx / nblk, nb2 = nx % nblk, n = 64 * nb2 + 4 * nq; if (n < N) { v0 = *(const f32x4*)(W + (size_t)(64 * kb2 + kr) * N + n); v1 = *(const f32x4*)(W + (size_t)(64 * kb2 + 32 + kr) * N + n); } }
        LBAR();
        { const int n = tid >> 3, kc = tid & 7; const float* sp = scr + (8 * kc) * 65 + n; float o[8];
#pragma unroll
          for (int j = 0; j < 8; ++j) o[j] = sp[j * 65];
          *(v4u*)(WT + (size_t)(64 * nb + n) * K + 64 * kb + 8 * kc) = pack8(o); }
        LBAR();
    }
}
__device__ __forceinline__ void rms_row(const float* xrow, const float* w, bf16* obf, float* of32, int lane) {
    const f32x4* xr = (const f32x4*)xrow + lane; const f32x4* wr = (const f32x4*)w + lane;
    f32x4 v[4]; float s = 0.f;
#pragma unroll
    for (int j = 0; j < 4; ++j) { v[j] = xr[64 * j]; s += (v[j].x * v[j].x + v[j].y * v[j].y) + (v[j].z * v[j].z + v[j].w * v[j].w); }
    const float rs = rsqrtf(wave_sum(s) * (1.f / D) + 1e-6f);
#pragma unroll
    for (int j = 0; j < 4; ++j) { const f32x4 ww = wr[64 * j]; f32x4 o = v[j] * rs * ww;
        if (of32) ((f32x4*)of32 + lane)[64 * j] = o;
        else ((unsigned long long*)obf + lane)[64 * j] = (unsigned long long)pk2(o.x, o.y) | ((unsigned long long)pk2(o.z, o.w) << 32); }
}

constexpr int PITCH = 72, FP = 68, TP = 20;
constexpr int OFF_TW = 0, OFF_AL = 9216, OFF_ARK = 18432, OFF_XA = 27648, OFF_XW = 45056, OFF_AT = 63488, OFF_RT = 72704, OFF_BH = 81920, OFF_KH = 91136,
              OFF_BBT = 100352, OFF_KBT = 109568, OFF_VT = 118784, OFF_TII = 128000, OFF_TOT = 133120, OFF_BC = 135168;
constexpr int OFF_AAK = OFF_TW, OFF_ARB = OFF_AL, OFF_AAB = OFF_XA, OFF_XT = OFF_XW;
constexpr size_t WS_MC = 112 * MiB, WS_NC = 120 * MiB, WS_PP = 136 * MiB, WS_Y0 = 144 * MiB, WS_S0 = 160 * MiB, WS_DEC = 168 * MiB, WS_BON2 = 169 * MiB, WS_UPT = 170 * MiB;
constexpr int NUNIT = 1024;

__device__ __forceinline__ f32x4 mma2(const bf16* Arow, const bf16* Brow, f32x4 acc) {
    acc = __builtin_amdgcn_mfma_f32_16x16x32_bf16(*(const bf16x8*)(Arow), *(const bf16x8*)(Brow), acc, 0, 0, 0);
    acc = __builtin_amdgcn_mfma_f32_16x16x32_bf16(*(const bf16x8*)(Arow + 32), *(const bf16x8*)(Brow + 32), acc, 0, 0, 0);
    return acc;
}

__device__ __forceinline__ void r1_phase(CArgs& a, int l, unsigned char* L, int tid0) {
    asm volatile("" : "+v"(tid0));
    const int wave = __builtin_amdgcn_readfirstlane(tid0 >> 6);
    const bf16* U = (const bf16*)(a.ws + WS_U);
    bf16* TW = (bf16*)(L + OFF_TW); bf16* ALm = (bf16*)(L + OFF_AL); bf16* ARK = (bf16*)(L + OFF_ARK); bf16* AAK = (bf16*)(L + OFF_AAK); bf16* ARB = (bf16*)(L + OFF_ARB);
    float* XA = (float*)(L + OFF_XA); float* XW = (float*)(L + OFF_XW); float* AAB = (float*)(L + OFF_AAB); bf16* XT = (bf16*)(L + OFF_XT);
    bf16* AT = (bf16*)(L + OFF_AT); bf16* RT = (bf16*)(L + OFF_RT); bf16* BH = (bf16*)(L + OFF_BH); bf16* KH = (bf16*)(L + OFF_KH);
    bf16* BBT = (bf16*)(L + OFF_BBT); bf16* KBT = (bf16*)(L + OFF_KBT); bf16* VT = (bf16*)(L + OFF_VT);
    float* TII = (float*)(L + OFF_TII); float* TOT = (float*)(L + OFF_TOT); float* BC = (float*)(L + OFF_BC);
    const bf16* UPT = (const bf16*)(a.ws + WS_UPT) + (size_t)l * 2 * 512 * 64;
    const float* mu = a.in[6] + l * 1664;
    float* WTS = (float*)(L + 135424);
    int hl = -1;
    v4u Pc0, Pc1, Pp0, Pp1, Lrc, Lkc, Lvc, Lrp, Lkp, Lvp; bf16x8 wfa0, wfa1;
#define R1_ISSUE(u_) do { const int lr_ = 64 * ((u_) >> 3) + (tid >> 3); const bf16* ub_ = U + (size_t)lr_ * NPAD; const bf16* up_ = ub_ + C_WL + 16 * (tid & 7); const bf16* uq_ = ub_ + 64 * ((u_) & 7) + 8 * (tid & 7); \
        Pc0 = *(const v4u*)up_; Pc1 = *(const v4u*)(up_ + 8); Lrc = *(const v4u*)(uq_ + C_R); Lkc = *(const v4u*)(uq_ + C_K); Lvc = *(const v4u*)(uq_ + C_V); \
        Pp0 = (v4u){0u, 0u, 0u, 0u}; Pp1 = Pp0; Lrp = Pp0; Lkp = Pp0; Lvp = Pp0; \
        if (lr_ > 0) { Pp0 = *(const v4u*)(up_ - NPAD); Pp1 = *(const v4u*)(up_ - NPAD + 8); Lrp = *(const v4u*)(uq_ + C_R - NPAD); Lkp = *(const v4u*)(uq_ + C_K - NPAD); Lvp = *(const v4u*)(uq_ + C_V - NPAD); } } while (0)
#pragma unroll 1
    for (int unit = blockIdx.x; unit < NUNIT; unit += gridDim.x) {
        int tid = tid0; asm volatile("" : "+v"(tid));
        const int lane = tid & 63, g = lane >> 4, c16 = lane & 15;
        const int ch = unit >> 3, h = unit & 7;
        if (h != hl) { hl = h; LBAR();
            if (tid < 64) { const int c = l * 512 + 64 * h + tid; WTS[tid] = a.in[7][c]; WTS[64 + tid] = a.in[9][c]; WTS[128 + tid] = a.in[11][c]; WTS[192 + tid] = a.in[12][c]; WTS[256 + tid] = a.in[13][c];
                WTS[320 + tid] = mu[64 * h + tid]; WTS[384 + tid] = mu[512 + 64 * h + tid]; WTS[448 + tid] = mu[1024 + 64 * h + tid]; }
            else if (tid < 192) WTS[512 + tid - 64] = mu[1536 + tid - 64];
            { const bf16* WT = UPT + (size_t)(wave >> 2) * 512 * 64 + (size_t)(64 * h + 16 * (wave & 3) + c16) * 64 + 8 * g; wfa0 = *(const bf16x8*)WT; wfa1 = *(const bf16x8*)(WT + 32); }
            LBAR(); }
        const int t = tid >> 3, dg = tid & 7, d0 = 8 * dg, lr = 64 * ch + t, hc = 64 * h + d0;
        if (unit == (int)blockIdx.x) R1_ISSUE(unit);
        {
            const int cg = tid & 7;
            float cu[16], pr[16], o[16]; unpack8(Pc0, cu); unpack8(Pc1, cu + 8); unpack8(Pp0, pr); unpack8(Pp1, pr + 8);
            const float* mp = WTS + 512 + 16 * cg;
#pragma unroll
            for (int i = 0; i < 16; ++i) { float mv = cu[i] + (pr[i] - cu[i]) * mp[i]; if (cg < 4) mv = tanh_fast(mv); o[i] = mv; }
            bf16* dst = (cg < 4 ? TW : ALm) + t * PITCH + 16 * (cg & 3);
            *(v4u*)dst = pack8(o); *(v4u*)(dst + 8) = pack8(o + 8);
        }
        LBAR();
        {
            const int q = wave >> 2, dt = wave & 3;
            const bf16x8 a0 = wfa0, a1 = wfa1;
            const bf16* Bm = q ? ALm : TW; float* X = q ? XA : XW;
#pragma unroll
            for (int tt = 0; tt < 4; ++tt) { const bf16* br = Bm + (16 * tt + c16) * PITCH + 8 * g; f32x4 acc = {0.f, 0.f, 0.f, 0.f};
                acc = __builtin_amdgcn_mfma_f32_16x16x32_bf16(a0, *(const bf16x8*)br, acc, 0, 0, 0);
                acc = __builtin_amdgcn_mfma_f32_16x16x32_bf16(a1, *(const bf16x8*)(br + 32), acc, 0, 0, 0);
                *(f32x4*)(X + (16 * tt + c16) * FP + 16 * dt + 4 * g) = acc; }
        }
        LBAR();
        float r[8], kq[8], v[8], al[8], be[8], lw[8];
        {
            float rc[8], rp[8], kc[8], kp[8], vc[8], vp[8];
            unpack8(Lrc, rc); unpack8(Lkc, kc); unpack8(Lvc, vc); unpack8(Lrp, rp); unpack8(Lkp, kp); unpack8(Lvp, vp);
            const float* w0p = WTS + d0; const float* a0p = WTS + 64 + d0; const float* kkp = WTS + 128 + d0;
            const float* kap = WTS + 192 + d0; const float* rkp = WTS + 256 + d0;
            float nn = 0.f, bon = 0.f, kk[8], av[8];
#pragma unroll
            for (int i = 0; i < 8; ++i) {
                const float xw = XW[t * FP + d0 + i] + w0p[i], xa = XA[t * FP + d0 + i] + a0p[i];
                lw[i] = -0.60653065971f * sigm(xw); av[i] = sigm(xa);
                r[i] = rc[i] + (rp[i] - rc[i]) * WTS[320 + d0 + i]; const float k = kc[i] + (kp[i] - kc[i]) * WTS[384 + d0 + i]; v[i] = vc[i] + (vp[i] - vc[i]) * WTS[448 + d0 + i];
                kk[i] = k * kkp[i]; nn += kk[i] * kk[i];
                kq[i] = k * (1.f + (av[i] - 1.f) * kap[i]); bon += r[i] * kq[i] * rkp[i];
            }
            nn += __shfl_xor(nn, 1); nn += __shfl_xor(nn, 2); nn += __shfl_xor(nn, 4);
            bon += __shfl_xor(bon, 1); bon += __shfl_xor(bon, 2); bon += __shfl_xor(bon, 4);
            const float inv = __builtin_amdgcn_rsqf(fmaxf(nn, 1e-24f));
#pragma unroll
            for (int i = 0; i < 8; ++i) { const float kn = kk[i] * inv; al[i] = -kn; be[i] = av[i] * kn; XW[t * FP + d0 + i] = lw[i]; }
            if (dg == 0) ((float*)(a.ws + WS_BON2))[lr * 8 + h] = bon;
        }
        LBAR();
        {
            const int d = tid & 63, tb = tid >> 6; float p[8]; float run = 0.f;
#pragma unroll
            for (int i = 0; i < 8; ++i) { run += XW[(8 * tb + i) * FP + d]; p[i] = run; }
            TOT[tb * 64 + d] = run;
            LBAR();
            float off = 0.f;
#pragma unroll
            for (int j = 0; j < 8; ++j) off += (j < tb) ? TOT[j * 64 + d] : 0.f;
#pragma unroll
            for (int i = 0; i < 8; ++i) XW[(8 * tb + i) * FP + d] = off + p[i];
            if (tb == 7) BC[d] = off + run;
        }
        LBAR();
        {
            float at[8], rt[8], bh[8], kh[8];
#pragma unroll
            for (int i = 0; i < 8; ++i) { const float b = XW[t * FP + d0 + i], bc = BC[d0 + i];
                const float eb = __expf(b), enb = __expf(-b), ebp = __expf(b - lw[i]), ebc = __expf(bc - b);
                at[i] = al[i] * ebp; rt[i] = r[i] * eb; bh[i] = be[i] * enb; kh[i] = kq[i] * enb;
                BBT[(d0 + i) * PITCH + t] = (bf16)f2bf(be[i] * ebc); KBT[(d0 + i) * PITCH + t] = (bf16)f2bf(kq[i] * ebc); VT[(d0 + i) * PITCH + t] = (bf16)f2bf(v[i]); }
            *(v4u*)(AT + t * PITCH + d0) = pack8(at); *(v4u*)(RT + t * PITCH + d0) = pack8(rt); *(v4u*)(BH + t * PITCH + d0) = pack8(bh); *(v4u*)(KH + t * PITCH + d0) = pack8(kh);
        }
        asm volatile("" ::: "memory");
        if (unit + (int)gridDim.x < NUNIT) R1_ISSUE(unit + (int)gridDim.x);
        LBAR();
        {
            const int q = wave >> 1, mh = wave & 1;
            const bf16* As = (q < 2) ? AT : RT; const bf16* Bs = (q & 1) ? KH : BH;
#pragma unroll
            for (int t2 = 0; t2 < 2; ++t2) { const int tt = 2 * mh + t2; const int tcol = 16 * tt + c16;
#pragma unroll
                for (int jt = 0; jt < 4; ++jt) {
                    f32x4 acc = {0.f, 0.f, 0.f, 0.f};
                    if (jt <= tt) { acc = mma2(Bs + (16 * jt + c16) * PITCH + 8 * g, As + tcol * PITCH + 8 * g, acc);
#pragma unroll
                        for (int j = 0; j < 4; ++j) { const int jj = 16 * jt + 4 * g + j; const bool keep = (q < 2) ? (jj < tcol) : (jj <= tcol); if (!keep) acc[j] = 0.f; } }
                    if (q == 0) *(f32x4*)(AAB + tcol * FP + 16 * jt + 4 * g) = acc;
                    else { bf16* dst = (q == 1 ? AAK : (q == 2 ? ARB : ARK)); *(v2u*)(dst + tcol * PITCH + 16 * jt + 4 * g) = pack4(acc); }
                } }
        }
        LBAR();
        f32x4 Z[4];
        {
            if (wave == 0) { const int i = g; float Tc[16];
#pragma unroll
                for (int tr = 0; tr < 16; ++tr) { float s0 = (c16 == tr) ? 1.f : 0.f, s1 = 0.f, s2 = 0.f, s3 = 0.f; const float* ar = AAB + (16 * i + tr) * FP + 16 * i;
#pragma unroll
                    for (int j = 0; j < 16; j += 4) { if (j < tr) s0 += ar[j] * Tc[j]; if (j + 1 < tr) s1 += ar[j + 1] * Tc[j + 1]; if (j + 2 < tr) s2 += ar[j + 2] * Tc[j + 2]; if (j + 3 < tr) s3 += ar[j + 3] * Tc[j + 3]; }
                    const float sv = (s0 + s1) + (s2 + s3); Tc[tr] = sv; TII[(i * 16 + tr) * TP + c16] = sv; } }
            if (wave < 4) {
#pragma unroll
                for (int i = 0; i < 4; ++i)
#pragma unroll
                    for (int j = 0; j < 4; ++j) Z[i][j] = bf2f(AT[(16 * i + 4 * g + j) * PITCH + 16 * wave + c16]);
            } else {
#pragma unroll
                for (int i = 0; i < 4; ++i) { f32x4 acc = {0.f, 0.f, 0.f, 0.f}; Z[i] = mma2(AAK + (16 * i + c16) * PITCH + 8 * g, VT + (16 * (wave - 4) + c16) * PITCH + 8 * g, acc); }
            }
        }
        LBAR();
        {
            f32x4 X[4];
#pragma unroll
            for (int i = 0; i < 4; ++i) { f32x4 z = Z[i];
#pragma unroll
                for (int kb = 0; kb < 4; ++kb) if (kb < i) { const f32x4 av = *(const f32x4*)(AAB + (16 * i + c16) * FP + 16 * kb + 4 * g);
#pragma unroll
                    for (int s = 0; s < 4; ++s) z = __builtin_amdgcn_mfma_f32_16x16x4f32(av[s], X[kb][s], z, 0, 0, 0); }
                const f32x4 tv = *(const f32x4*)(TII + (i * 16 + c16) * TP + 4 * g); f32x4 x = {0.f, 0.f, 0.f, 0.f};
#pragma unroll
                for (int s = 0; s < 4; ++s) x = __builtin_amdgcn_mfma_f32_16x16x4f32(tv[s], z[s], x, 0, 0, 0);
                X[i] = x; }
#pragma unroll
            for (int i = 0; i < 4; ++i) *(v2u*)(XT + (16 * wave + c16) * PITCH + 16 * i + 4 * g) = pack4(X[i]);
        }
        LBAR();
        {
            const int q = wave >> 1, hh = wave & 1;
            bf16* MCg = (bf16*)(a.ws + WS_MC) + (size_t)unit * 4096; float* NCg = (float*)(a.ws + WS_NC) + (size_t)unit * 4096;
            bf16* PPg = (bf16*)(a.ws + WS_PP) + (size_t)unit * 4096; bf16* Y0g = (bf16*)(a.ws + WS_Y0) + (size_t)unit * 4096;
#pragma unroll
            for (int t2 = 0; t2 < 2; ++t2) { const int ti = 2 * hh + t2;
#pragma unroll
                for (int tj = 0; tj < 4; ++tj) { f32x4 acc = {0.f, 0.f, 0.f, 0.f}; const int cc = 16 * tj + c16, rr = 16 * ti + 4 * g;
                    if (q == 0) { acc = mma2(XT + (16 * ti + c16) * PITCH + 8 * g, BBT + cc * PITCH + 8 * g, acc); *(v2u*)(MCg + cc * 64 + (ti >> 1) * 32 + g * 8 + (ti & 1) * 4) = pack4(acc); }
                    else if (q == 1) { acc = mma2(BBT + (16 * ti + c16) * PITCH + 8 * g, XT + (64 + cc) * PITCH + 8 * g, acc); acc = mma2(KBT + (16 * ti + c16) * PITCH + 8 * g, VT + cc * PITCH + 8 * g, acc);
                        *(f32x4*)(NCg + cc * 64 + rr) = acc; }
                    else if (q == 2) { acc = mma2(XT + (16 * ti + c16) * PITCH + 8 * g, ARB + cc * PITCH + 8 * g, acc);
                        const v2u rv = *(const v2u*)(RT + cc * PITCH + rr); acc[0] += bf2f(rv.x & 0xffffu); acc[1] += bf2f(rv.x >> 16); acc[2] += bf2f(rv.y & 0xffffu); acc[3] += bf2f(rv.y >> 16);
                        *(v2u*)(PPg + cc * 64 + rr) = pack4(acc); }
                    else { acc = mma2(XT + (64 + 16 * ti + c16) * PITCH + 8 * g, ARB + cc * PITCH + 8 * g, acc); acc = mma2(VT + (16 * ti + c16) * PITCH + 8 * g, ARK + cc * PITCH + 8 * g, acc);
                        *(v2u*)(Y0g + cc * 64 + rr) = pack4(acc); }
                } }
            if (tid < 64) ((float*)(a.ws + WS_DEC))[unit * 64 + tid] = __expf(BC[tid]);
        }
        LBAR();
    }
}

#define LAS3 __attribute__((address_space(3)))
constexpr int R2_SLOT = 12544, R2_NS = 11, R2_FLAGS = R2_SLOT * R2_NS;
__device__ __forceinline__ void r2_scan(CArgs& a, int chain, unsigned char* L, int tid) {
    asm volatile("" : "+v"(tid));
    const int lane = tid & 63, wave = __builtin_amdgcn_readfirstlane(tid >> 6);
    const int h = chain >> 2, e0 = 16 * (chain & 3), g = lane >> 4, c16 = lane & 15;
    volatile LAS3 unsigned* flg = (volatile LAS3 unsigned*)(LAS3 unsigned char*)(L + R2_FLAGS);
    if (tid < 32) flg[tid] = 0u;
    if (tid >= 64 && tid < 64 + R2_NS) *(volatile LAS3 unsigned*)(LAS3 unsigned char*)(L + (tid - 64) * R2_SLOT + 12288 + 252) = 0xffffffffu;
    __syncthreads();
    const bf16* MC = (const bf16*)(a.ws + WS_MC); const float* NC = (const float*)(a.ws + WS_NC); const float* DEC = (const float*)(a.ws + WS_DEC);
    if (wave != 0) {
        int mco[8], nco[4];
#pragma unroll
        for (int q = 0; q < 8; ++q) { const int pos = 64 * q + lane, row = pos >> 3, kc = (pos & 7) ^ (row & 7); mco[q] = row * 64 + kc * 8; }
#pragma unroll
        for (int q = 0; q < 4; ++q) { const int pos = 64 * q + lane, e = pos >> 4, dc = (pos & 15) ^ e; nco[q] = (e0 + e) * 64 + dc * 4; }
#pragma unroll 1
        for (int c = wave - 1; c < 128; c += 7) {
            while ((int)flg[16] < c - (R2_NS - 1)) __builtin_amdgcn_s_sleep(1);
            LAS3 unsigned char* slot = (LAS3 unsigned char*)(L + (c % R2_NS) * R2_SLOT);
            const size_t unit = (size_t)c * 8 + h;
#pragma unroll
            for (int q = 0; q < 8; ++q) __builtin_amdgcn_global_load_lds((const unsigned*)(MC + unit * 4096 + mco[q]), (LAS3 unsigned*)(slot + q * 1024), 16, 0, 0);
#pragma unroll
            for (int q = 0; q < 4; ++q) __builtin_amdgcn_global_load_lds((const unsigned*)(NC + unit * 4096 + nco[q]), (LAS3 unsigned*)(slot + 8192 + q * 1024), 16, 0, 0);
            __builtin_amdgcn_global_load_lds((const unsigned*)(DEC + unit * 64 + lane), (LAS3 unsigned*)(slot + 12288), 4, 0, 0);
        }
        asm volatile("s_waitcnt vmcnt(0)" ::: "memory");
    } else {
        bf16* S0 = (bf16*)(a.ws + WS_S0);
        f32x4 S[4];
#pragma unroll
        for (int m = 0; m < 4; ++m) S[m] = (f32x4){0.f, 0.f, 0.f, 0.f};
        int avail = 0;
#define R2_MARK(c_) (*(volatile LAS3 unsigned*)(LAS3 unsigned char*)(L + ((c_) % R2_NS) * R2_SLOT + 12288 + 252))
#define R2_WAIT(c_) do { while (avail <= (c_)) { const unsigned f0_ = R2_MARK(c_), f1_ = R2_MARK((c_) + 1), f2_ = R2_MARK((c_) + 2); \
            if (f0_ != 0xffffffffu) { avail = (c_) + 1; if (f1_ != 0xffffffffu) { avail = (c_) + 2; if (f2_ != 0xffffffffu) avail = (c_) + 3; } } \
            else __builtin_amdgcn_s_sleep(0); } asm volatile("" ::: "memory"); } while (0)
#define R2_FREE(c_) do { if (lane == 0) { R2_MARK(c_) = 0xffffffffu; flg[16] = (unsigned)((c_) + 1); } } while (0)
#define R2_READ(c_, A_, N_, D_) do { const LAS3 unsigned char* slot_ = (const LAS3 unsigned char*)(L + ((c_) % R2_NS) * R2_SLOT); \
            _Pragma("unroll") for (int mt = 0; mt < 4; ++mt) { const int row = 16 * mt + c16; \
                A_[mt][0] = *(const LAS3 v4u*)(slot_ + (row * 8 + (g ^ (row & 7))) * 16); A_[mt][1] = *(const LAS3 v4u*)(slot_ + (row * 8 + ((4 + g) ^ (row & 7))) * 16); \
                N_[mt] = *(const LAS3 f32x4*)(slot_ + 8192 + (c16 * 16 + ((4 * mt + g) ^ c16)) * 16); \
                D_[mt] = *(const LAS3 f32x4*)(slot_ + 12288 + (16 * mt + 4 * g) * 4); } } while (0)
#define R2_STEP(c_, A_, N_, D_) do { const size_t ub_ = ((size_t)(c_) * 8 + h) * 4096; v2u sb_[4]; \
            _Pragma("unroll") for (int m = 0; m < 4; ++m) { sb_[m] = pack4(S[m]); *(v2u*)(S0 + ub_ + (e0 + c16) * 64 + 16 * m + 4 * g) = sb_[m]; } \
            const v4u b0_ = {sb_[0].x, sb_[0].y, sb_[1].x, sb_[1].y}, b1_ = {sb_[2].x, sb_[2].y, sb_[3].x, sb_[3].y}; \
            const bf16x8 B0_ = __builtin_bit_cast(bf16x8, b0_), B1_ = __builtin_bit_cast(bf16x8, b1_); \
            f32x4 acc_[4]; \
            _Pragma("unroll") for (int mt = 0; mt < 4; ++mt) acc_[mt] = __builtin_amdgcn_mfma_f32_16x16x32_bf16(__builtin_bit_cast(bf16x8, A_[mt][0]), B0_, N_[mt] + S[mt] * D_[mt], 0, 0, 0); \
            _Pragma("unroll") for (int mt = 0; mt < 4; ++mt) S[mt] = __builtin_amdgcn_mfma_f32_16x16x32_bf16(__builtin_bit_cast(bf16x8, A_[mt][1]), B1_, acc_[mt], 0, 0, 0); } while (0)
        v4u Aa[4][2], Ab[4][2]; f32x4 Na[4], Nb[4]; f32x4 Da[4], Db[4];
        R2_WAIT(0); R2_READ(0, Aa, Na, Da);
        asm volatile("s_waitcnt lgkmcnt(0)" ::: "memory");
#pragma unroll 1
        for (int c = 0; c < 128; c += 2) {
            R2_FREE(c);
            R2_WAIT(c + 1); R2_READ(c + 1, Ab, Nb, Db);
            R2_STEP(c, Aa, Na, Da);
            asm volatile("s_waitcnt lgkmcnt(0)" ::: "memory");
            R2_FREE(c + 1);
            if (c + 2 < 128) { R2_WAIT(c + 2); R2_READ(c + 2, Aa, Na, Da); }
            R2_STEP(c + 1, Ab, Nb, Db);
            asm volatile("s_waitcnt lgkmcnt(0)" ::: "memory");
        }
#undef R2_WAIT
#undef R2_MARK
#undef R2_FREE
#undef R2_STEP
#undef R2_READ
    }
    __syncthreads();
}

__device__ __forceinline__ void r3_phase(CArgs& a, int l, int hb, int gw, int NGW, int lane) {
    asm volatile("" : "+v"(lane));
    const int g = lane >> 4, c16 = lane & 15;
    const bf16* U = (const bf16*)(a.ws + WS_U); const bf16* PP = (const bf16*)(a.ws + WS_PP); const bf16* S0 = (const bf16*)(a.ws + WS_S0); const bf16* Y0 = (const bf16*)(a.ws + WS_Y0);
    const float* BON = (const float*)(a.ws + WS_BON2); bf16* MG = (bf16*)(a.ws + WS_XN) + (size_t)hb * MH * D;
    const float* mu_v = a.in[6] + l * 1664 + 1024; const float* lnw = a.in[14] + l * 512; const float* lnb = a.in[15] + l * 512;
    const int erow = 16 * (c16 >> 2) + (c16 & 3);
#pragma unroll 1
    for (int task = gw; task < NUNIT * 4; task += NGW) {
        const int unit = task >> 2, mt = task & 3, ch = unit >> 3, h = unit & 7; const size_t ub = (size_t)unit * 4096;
        const int lr = 64 * ch + 16 * mt + c16; const bf16* urow = U + (size_t)lr * NPAD + 64 * h + 16 * g;
        float vc[16], vp[16], rgf[16];
        unpack8(*(const v4u*)(urow + C_V), vc); unpack8(*(const v4u*)(urow + C_V + 8), vc + 8); unpack8(*(const v4u*)(urow + C_RG), rgf); unpack8(*(const v4u*)(urow + C_RG + 8), rgf + 8);
        if (lr > 0) { unpack8(*(const v4u*)(urow + C_V - NPAD), vp); unpack8(*(const v4u*)(urow + C_V + 8 - NPAD), vp + 8); }
        else {
#pragma unroll
            for (int i = 0; i < 16; ++i) vp[i] = 0.f; }
        const float bon = BON[lr * 8 + h];
        const bf16* pr = PP + ub + (16 * mt + c16) * 64 + 8 * g;
        const bf16x8 B0 = *(const bf16x8*)pr, B1 = *(const bf16x8*)(pr + 32);
        f32x4 Y[4]; bf16x8 SA[4][2];
#pragma unroll
        for (int et = 0; et < 4; ++et) { const bf16* sr = S0 + ub + (erow + 4 * et) * 64 + 8 * g; SA[et][0] = *(const bf16x8*)sr; SA[et][1] = *(const bf16x8*)(sr + 32); }
        const bf16* y0p = Y0 + ub + (16 * mt + c16) * 64 + 16 * g; const v4u y0a = *(const v4u*)y0p, y0b = *(const v4u*)(y0p + 8);
        asm volatile("" ::: "memory");
        { float yf[16]; unpack8(y0a, yf); unpack8(y0b, yf + 8);
#pragma unroll
          for (int et = 0; et < 4; ++et) Y[et] = (f32x4){yf[4 * et], yf[4 * et + 1], yf[4 * et + 2], yf[4 * et + 3]}; }
#pragma unroll
        for (int et = 0; et < 4; ++et) { f32x4 acc = __builtin_amdgcn_mfma_f32_16x16x32_bf16(SA[et][0], B0, Y[et], 0, 0, 0);
            Y[et] = __builtin_amdgcn_mfma_f32_16x16x32_bf16(SA[et][1], B1, acc, 0, 0, 0); }
        const f32x4 sv = (Y[0] + Y[1]) + (Y[2] + Y[3]); float sm = (sv.x + sv.y) + (sv.z + sv.w); sm += __shfl_xor(sm, 16); sm += __shfl_xor(sm, 32);
        const float mean = sm * (1.f / 64.f); float q = 0.f;
#pragma unroll
        for (int et = 0; et < 4; ++et) { const f32x4 dd = Y[et] - mean; q += (dd.x * dd.x + dd.y * dd.y) + (dd.z * dd.z + dd.w * dd.w); }
        q += __shfl_xor(q, 16); q += __shfl_xor(q, 32);
        const float rstd = rsqrtf(q * (1.f / 64.f) + 64e-5f);
        const int cc = 64 * h + 16 * g; float o[16];
#pragma unroll
        for (int et = 0; et < 4; ++et) {
            const f32x4 w4 = *(const f32x4*)(lnw + cc + 4 * et), b4 = *(const f32x4*)(lnb + cc + 4 * et), m4 = *(const f32x4*)(mu_v + cc + 4 * et);
#pragma unroll
            for (int j = 0; j < 4; ++j) { const int i = 4 * et + j; const float vv = vc[i] + (vp[i] - vc[i]) * m4[j]; const float yn = (Y[et][j] - mean) * rstd * w4[j] + b4[j];
                o[i] = (yn + bon * vv) * rgf[i] * sigm(rgf[i]); } }
        bf16* op = MG + (size_t)lr * D + 512 + cc; *(v4u*)op = pack8(o); *(v4u*)(op + 8) = pack8(o + 8);
    }
}

constexpr int OFF_GQI = 17408, OFF_GKI = 26624, OFF_GKST = 35840, OFF_GVT = 45056, OFF_GSC = 63488, OFF_GTOT = 72704, OFF_GBC = 74752;
constexpr size_t WS_QI = 171 * MiB, WS_OI = 175 * MiB, WS_DS = 191 * MiB, WS_GDEC = 207 * MiB, WS_SP = 208 * MiB;
constexpr int NGUNIT = 512;

__device__ __forceinline__ void g1_phase(CArgs& a, int l, unsigned char* L, int tid0) {
    asm volatile("" : "+v"(tid0));
    const int wave = __builtin_amdgcn_readfirstlane(tid0 >> 6);
    const bf16* U = (const bf16*)(a.ws + WS_U);
    float* XW = (float*)L; bf16* QI = (bf16*)(L + OFF_GQI); bf16* KI = (bf16*)(L + OFF_GKI); bf16* KST = (bf16*)(L + OFF_GKST); bf16* VT = (bf16*)(L + OFF_GVT); bf16* SC = (bf16*)(L + OFF_GSC);
    float* TOT = (float*)(L + OFF_GTOT); float* BC = (float*)(L + OFF_GBC);
    float* GW = (float*)(L + OFF_GBC + 256);
    int hl = -1;
    v4u Gl0, Gl1, Gq, Gk, Gv0, Gv1;
#define G1_ISSUE(u_) do { const int lr_ = 64 * ((u_) >> 2) + (tid >> 3), h_ = (u_) & 3, dg_ = tid & 7; const bf16* ur_ = U + (size_t)lr_ * NPAD; \
        Gl0 = *(const v4u*)(ur_ + C_GLR); Gl1 = *(const v4u*)(ur_ + C_GLR + 8); Gq = *(const v4u*)(ur_ + C_GQ + 64 * h_ + 8 * dg_); Gk = *(const v4u*)(ur_ + C_GK + 64 * h_ + 8 * dg_); \
        Gv0 = *(const v4u*)(ur_ + C_GV + 128 * h_ + 16 * dg_); Gv1 = *(const v4u*)(ur_ + C_GV + 128 * h_ + 16 * dg_ + 8); } while (0)
#pragma unroll 1
    for (int unit = blockIdx.x; unit < NGUNIT; unit += gridDim.x) {
        int tid = tid0; asm volatile("" : "+v"(tid));
        const int lane = tid & 63, g = lane >> 4, c16 = lane & 15;
        const int ch = unit >> 2, h = unit & 3;
        if (h != hl) { hl = h; LBAR();
            for (int i = tid; i < 16 * 64; i += NTHR) GW[i] = a.in[3][l * 16 * 256 + (i >> 6) * 256 + 64 * h + (i & 63)];
            if (tid < 64) GW[1024 + tid] = a.in[4][l * 256 + 64 * h + tid];
            LBAR(); }
        const int t = tid >> 3, dg = tid & 7, d0 = 8 * dg, lr = 64 * ch + t, hc = 64 * h + d0;
        if (unit == (int)blockIdx.x) G1_ISSUE(unit);
        float q[8], k[8];
        {
            float glr[16]; unpack8(Gl0, glr); unpack8(Gl1, glr + 8);
            float x[8]; const float* gb = GW + 1024 + d0; const float* gu = GW + d0;
#pragma unroll
            for (int i = 0; i < 8; ++i) x[i] = gb[i];
#pragma unroll
            for (int r = 0; r < 16; ++r) { const f32x4 u0 = *(const f32x4*)(gu + r * 64), u1 = *(const f32x4*)(gu + r * 64 + 4);
                x[0] += glr[r] * u0.x; x[1] += glr[r] * u0.y; x[2] += glr[r] * u0.z; x[3] += glr[r] * u0.w; x[4] += glr[r] * u1.x; x[5] += glr[r] * u1.y; x[6] += glr[r] * u1.z; x[7] += glr[r] * u1.w; }
#pragma unroll
            for (int i = 0; i < 8; ++i) XW[t * FP + d0 + i] = (fminf(x[i], 0.f) - __logf(1.f + __expf(-fabsf(x[i])))) * (1.f / 16.f);
            unpack8(Gq, q); unpack8(Gk, k);
            float vv[16]; const int e0 = 16 * dg; unpack8(Gv0, vv); unpack8(Gv1, vv + 8);
            asm volatile("" ::: "memory");
            if (unit + (int)gridDim.x < NGUNIT) G1_ISSUE(unit + (int)gridDim.x);
#pragma unroll
            for (int i = 0; i < 16; ++i) VT[(e0 + i) * PITCH + t] = (bf16)f2bf(vv[i]);
        }
        LBAR();
        {
            const int d = tid & 63, tb = tid >> 6; float p[8]; float run = 0.f;
#pragma unroll
            for (int i = 0; i < 8; ++i) { run += XW[(8 * tb + i) * FP + d]; p[i] = run; }
            TOT[tb * 64 + d] = run;
            LBAR();
            float off = 0.f;
#pragma unroll
            for (int j = 0; j < 8; ++j) off += (j < tb) ? TOT[j * 64 + d] : 0.f;
#pragma unroll
            for (int i = 0; i < 8; ++i) XW[(8 * tb + i) * FP + d] = off + p[i];
            if (tb == 7) BC[d] = off + run;
        }
        LBAR();
        {
            float qi[8], ki[8];
#pragma unroll
            for (int i = 0; i < 8; ++i) { const float b = XW[t * FP + d0 + i], bc = BC[d0 + i];
                qi[i] = q[i] * 0.125f * __expf(b); ki[i] = k[i] * __expf(-b); KST[(d0 + i) * PITCH + t] = (bf16)f2bf(k[i] * __expf(bc - b)); }
            const v4u qp = pack8(qi);
            *(v4u*)(QI + t * PITCH + d0) = qp; *(v4u*)(KI + t * PITCH + d0) = pack8(ki);
            *(v4u*)((bf16*)(a.ws + WS_QI) + (size_t)unit * 4096 + t * 64 + d0) = qp;
        }
        LBAR();
        {
            const int tt = wave >> 1; const int tcol = 16 * tt + c16;
#pragma unroll
            for (int j2 = 0; j2 < 2; ++j2) { const int jt = 2 * (wave & 1) + j2; f32x4 acc = {0.f, 0.f, 0.f, 0.f};
                if (jt <= tt) { acc = mma2(KI + (16 * jt + c16) * PITCH + 8 * g, QI + tcol * PITCH + 8 * g, acc);
#pragma unroll
                    for (int j = 0; j < 4; ++j) if (16 * jt + 4 * g + j > tcol) acc[j] = 0.f; }
                *(v2u*)(SC + tcol * PITCH + 16 * jt + 4 * g) = pack4(acc); }
            bf16* DSg = (bf16*)(a.ws + WS_DS) + (size_t)unit * 8192;
#pragma unroll
            for (int i = 0; i < 4; ++i) { const int tile = wave * 4 + i, dt = tile & 3, et = tile >> 2; f32x4 acc = {0.f, 0.f, 0.f, 0.f};
                acc = mma2(KST + (16 * dt + c16) * PITCH + 8 * g, VT + (16 * et + c16) * PITCH + 8 * g, acc);
                *(v2u*)(DSg + (16 * et + c16) * 64 + 16 * dt + 4 * g) = pack4(acc); }
            if (tid < 64) ((float*)(a.ws + WS_GDEC))[unit * 64 + tid] = __expf(BC[tid]);
        }
        LBAR();
        {
            bf16* OIg = (bf16*)(a.ws + WS_OI) + (size_t)unit * 8192;
#pragma unroll
            for (int i = 0; i < 4; ++i) { const int tile = wave * 4 + i, tt = tile & 3, et = tile >> 2; f32x4 acc = {0.f, 0.f, 0.f, 0.f};
                acc = mma2(VT + (16 * et + c16) * PITCH + 8 * g, SC + (16 * tt + c16) * PITCH + 8 * g, acc);
                *(v2u*)(OIg + (16 * tt + c16) * 128 + 16 * et + 4 * g) = pack4(acc); }
        }
        LBAR();
    }
}

__device__ __forceinline__ void g2_scan(CArgs& a, int gid) {
    asm volatile("" : "+v"(gid));
    const int h = gid >> 13, ed = gid & 8191, d = gid & 63;
    const bf16* DS = (const bf16*)(a.ws + WS_DS); const float* GD = (const float*)(a.ws + WS_GDEC); bf16* SP = (bf16*)(a.ws + WS_SP);
    float S = 0.f;
#pragma unroll 1
    for (int cb = 0; cb < 128; cb += 16) {
        float ds[16], dc[16];
#pragma unroll
        for (int i = 0; i < 16; ++i) { const size_t unit = (size_t)(cb + i) * 4 + h; ds[i] = bf2f(DS[unit * 8192 + ed]); dc[i] = GD[unit * 64 + d]; }
#pragma unroll
        for (int i = 0; i < 16; ++i) { const size_t unit = (size_t)(cb + i) * 4 + h; SP[unit * 8192 + ed] = (bf16)f2bf(S); S = S * dc[i] + ds[i]; }
    }
}

__device__ __forceinline__ void g3_phase(CArgs& a, int l, int hb, int gw, int NGW, int lane) {
    asm volatile("" : "+v"(lane));
    const int g = lane >> 4, c16 = lane & 15;
    const bf16* U = (const bf16*)(a.ws + WS_U); const bf16* QI = (const bf16*)(a.ws + WS_QI); const bf16* SP = (const bf16*)(a.ws + WS_SP); const bf16* OI = (const bf16*)(a.ws + WS_OI);
    bf16* MG = (bf16*)(a.ws + WS_XN) + (size_t)hb * MH * D; const float* gnw = a.in[5] + l * 128;
    const int erow = 32 * (c16 >> 2) + (c16 & 3);
#pragma unroll 1
    for (int task = gw; task < NGUNIT * 4; task += NGW) {
        const int unit = task >> 2, mt = task & 3, ch = unit >> 2, h = unit & 3;
        const int lr = 64 * ch + 16 * mt + c16; const bf16* urow = U + (size_t)lr * NPAD + C_GG + 128 * h + 32 * g;
        const v4u gg0 = *(const v4u*)urow, gg1 = *(const v4u*)(urow + 8), gg2 = *(const v4u*)(urow + 16), gg3 = *(const v4u*)(urow + 24);
        const bf16* qr = QI + (size_t)unit * 4096 + (16 * mt + c16) * 64 + 8 * g;
        const bf16x8 B0 = *(const bf16x8*)qr, B1 = *(const bf16x8*)(qr + 32);
        f32x4 O[8]; float ss = 0.f; bf16x8 SA[8][2];
#pragma unroll
        for (int et = 0; et < 8; ++et) { const bf16* sr = SP + (size_t)unit * 8192 + (erow + 4 * et) * 64 + 8 * g; SA[et][0] = *(const bf16x8*)sr; SA[et][1] = *(const bf16x8*)(sr + 32); }
        const bf16* oip = OI + (size_t)unit * 8192 + (16 * mt + c16) * 128 + 32 * g; const v4u oi0 = *(const v4u*)oip, oi1 = *(const v4u*)(oip + 8), oi2 = *(const v4u*)(oip + 16), oi3 = *(const v4u*)(oip + 24);
        asm volatile("" ::: "memory");
        { float of[32]; unpack8(oi0, of); unpack8(oi1, of + 8); unpack8(oi2, of + 16); unpack8(oi3, of + 24);
#pragma unroll
          for (int et = 0; et < 8; ++et) O[et] = (f32x4){of[4 * et], of[4 * et + 1], of[4 * et + 2], of[4 * et + 3]}; }
#pragma unroll
        for (int et = 0; et < 8; ++et) { f32x4 acc = __builtin_amdgcn_mfma_f32_16x16x32_bf16(SA[et][0], B0, O[et], 0, 0, 0);
            acc = __builtin_amdgcn_mfma_f32_16x16x32_bf16(SA[et][1], B1, acc, 0, 0, 0);
            O[et] = acc; ss += (acc.x * acc.x + acc.y * acc.y) + (acc.z * acc.z + acc.w * acc.w); }
        ss += __shfl_xor(ss, 16); ss += __shfl_xor(ss, 32);
        const float rstd = rsqrtf(ss * (1.f / 128.f) + 1e-6f);
        float gf[32], o[32]; unpack8(gg0, gf); unpack8(gg1, gf + 8); unpack8(gg2, gf + 16); unpack8(gg3, gf + 24);
#pragma unroll
        for (int et = 0; et < 8; ++et) { const f32x4 w4 = *(const f32x4*)(gnw + 32 * g + 4 * et);
#pragma unroll
            for (int j = 0; j < 4; ++j) { const int i = 4 * et + j; o[i] = O[et][j] * rstd * w4[j] * gf[i] * sigm(gf[i]); } }
        bf16* op = MG + (size_t)lr * D + 128 * h + 32 * g;
        *(v4u*)op = pack8(o); *(v4u*)(op + 8) = pack8(o + 8); *(v4u*)(op + 16) = pack8(o + 16); *(v4u*)(op + 24) = pack8(o + 24);
    }
}

#define LAS __attribute__((address_space(3)))
#define XB_TMO      128
#define XB_XCNT(j)  (256  + 64 * (j))
#define XB_XSUB(j)  (1280 + 64 * (j))
#define XB_XGEN(j)  (2304 + 64 * (j))
#define XB_TOP      3328
#define XB_TOPGEN   3392
#define XCD_BAR_WORDS 3456
#define XB_SPIN_CAP (1u << 18)

__device__ __forceinline__ unsigned xb_ld(unsigned* p)              { return __hip_atomic_load(p, __ATOMIC_RELAXED, __HIP_MEMORY_SCOPE_AGENT); }
__device__ __forceinline__ unsigned xb_add(unsigned* p, unsigned v) { return __hip_atomic_fetch_add(p, v, __ATOMIC_RELAXED, __HIP_MEMORY_SCOPE_AGENT); }
__device__ __forceinline__ unsigned xb_xcc_id() { return (unsigned)__builtin_amdgcn_s_getreg((3 << 11) | 20) & 0xFu; }
#define XB_SPIN(cond, bar) do { unsigned _sp = 0; while (cond) { __builtin_amdgcn_s_sleep(1); \
    if ((++_sp & 255u) == 0u) { if (xb_ld(&(bar)[XB_TMO])) break; if (_sp > XB_SPIN_CAP) { atomicAdd(&(bar)[XB_TMO], 1u); break; } } } } while (0)

struct XcdBarrier {
    unsigned* bar; unsigned x;
    volatile LAS unsigned* st;
};

__device__ __forceinline__ XcdBarrier xcd_barrier_post(unsigned* bar, volatile LAS unsigned* st) {
    XcdBarrier b; b.bar = bar; b.x = xb_xcc_id(); b.st = st;
    if (threadIdx.x == 0) (void)xb_add(&bar[XB_XCNT(b.x)], 1u);
    return b;
}
__device__ __forceinline__ void xcd_barrier_complete(unsigned* bar, unsigned x, unsigned& nloc, unsigned& nx) {
    const unsigned G = gridDim.x * gridDim.y * gridDim.z;
    unsigned sum, cnt, mine, sp = 0u;
    for (;;) {
        sum = 0u; cnt = 0u; mine = 0u;
#pragma unroll
        for (unsigned j = 0; j < 16; ++j) { const unsigned c = xb_ld(&bar[XB_XCNT(j)]); sum += c; cnt += (c > 0u) ? 1u : 0u; mine = (j == x) ? c : mine; }
        if (sum == G) break;
        __builtin_amdgcn_s_sleep(1);
        if ((++sp & 255u) == 0u) { if (xb_ld(&bar[XB_TMO])) break; if (sp > XB_SPIN_CAP) { atomicAdd(&bar[XB_TMO], 1u); break; } }
    }
    nloc = mine > 0u ? mine : 1u; nx = cnt > 0u ? cnt : 1u;
}

__device__ __forceinline__ void xcd_barrier(const XcdBarrier& b) {
    asm volatile("s_waitcnt vmcnt(0)" ::: "memory");
    __syncthreads();
    if (threadIdx.x == 0) {
        unsigned* bar = b.bar;
        __builtin_amdgcn_s_waitcnt(0);
        unsigned nloc = b.st[0], nx = b.st[1];
        if (nloc == 0u) { xcd_barrier_complete(bar, b.x, nloc, nx); b.st[0] = nloc; b.st[1] = nx; }
        const unsigned old = xb_add(&bar[XB_XSUB(b.x)], 1u);
        const unsigned gen = old / nloc;
        if (old + 1u == (gen + 1u) * nloc) {
            __builtin_amdgcn_fence(__ATOMIC_RELEASE, "agent");
            asm volatile("s_waitcnt vmcnt(0)" ::: "memory");
            const unsigned og = xb_add(&bar[XB_TOP], 1u);
            const unsigned tg = og / nx;
            if (og + 1u == (tg + 1u) * nx) xb_add(&bar[XB_TOPGEN], 1u);
            else XB_SPIN(xb_ld(&bar[XB_TOPGEN]) == tg, bar);
            __builtin_amdgcn_fence(__ATOMIC_ACQUIRE, "agent");
            xb_add(&bar[XB_XGEN(b.x)], 1u);
            asm volatile("s_waitcnt vmcnt(0)" ::: "memory");
        } else {
            XB_SPIN(xb_ld(&bar[XB_XGEN(b.x)]) == gen, bar);
            __builtin_amdgcn_fence(__ATOMIC_ACQUIRE, "agent");
            asm volatile("s_waitcnt vmcnt(0)" ::: "memory");
        }
    }
    __syncthreads();
}


__global__ void __launch_bounds__(NTHR, 2) hymba_fwd(Args a_kernarg) {
    extern __shared__ __attribute__((aligned(16))) unsigned char lds[];
    cg::grid_group grid = cg::this_grid();
    const int tid = threadIdx.x, lane = tid & 63, wave = __builtin_amdgcn_readfirstlane(tid >> 6);
    const int G = gridDim.x, gw = blockIdx.x * NWAVES + wave, NGW = G * NWAVES;
    volatile LAS unsigned* xst = (volatile LAS unsigned*)(LAS unsigned char*)(lds + LDS_BYTES - 64);
    if (tid < 2) xst[tid] = 0u;
    __syncthreads();
    const XcdBarrier xbar = xcd_barrier_post((unsigned*)AA.ws, xst);
    {
        CArgs& a = AA; bf16* XN = (bf16*)(a.ws + WS_XN);
        float* scr = (float*)lds;
        constexpr int T_IN = (D / 64) * (NPAD / 64), T_OUT = (D / 64) * (D / 64);
        for (int l = 0; l < 2; ++l) {
            transpose_tiles(a.in[2] + (size_t)l * D * NIN, D, NIN, NPAD, (bf16*)(a.ws + WS_WIN + l * WIN_BYTES), scr, (int)blockIdx.x, G, T_IN, tid);
            transpose_tiles(a.in[16] + (size_t)l * D * D, D, D, D, (bf16*)(a.ws + WS_WOUT + l * WOUT_BYTES), scr, (int)blockIdx.x, G, T_OUT, tid);
        }
        for (int m = 2 * gw; m < M; m += 2 * NGW) rms_row2(a.in[0] + (size_t)m * D, a.in[0] + (size_t)(m + 1) * D, a.in[1], XN + (size_t)m * D, XN + (size_t)(m + 1) * D, lane);
        {
            bf16* UPT = (bf16*)(a.ws + WS_UPT);
            for (int e = blockIdx.x * NTHR + tid; e < 2 * 2 * 512 * 64; e += G * NTHR) { const int r = e & 63, c = (e >> 6) & 511, q = (e >> 15) & 1, ll = e >> 16;
                UPT[e] = (bf16)f2bf((q ? a.in[10] : a.in[8])[(size_t)ll * 64 * 512 + r * 512 + c]); }
        }
    }
    grid.sync();
    for (int l = 0; l < 2; ++l) {
        for (int hb = 0; hb < 2; ++hb) {
            {
                CArgs& a = AA; bf16* XN = (bf16*)(a.ws + WS_XN); bf16* U = (bf16*)(a.ws + WS_U);
                pg8::Gemm g{XN + (size_t)hb * MH * D, (const bf16*)(a.ws + WS_WIN + l * WIN_BYTES), MH, NPAD, D}; pg8::StaticOrder S; S.init(MH, NPAD, G, (int)blockIdx.x);
                pg8::EpiBf16<0> E{U, NPAD, nullptr, 0, 0, 1.f};
                pg8::gemm_phase<pg8::EpiBf16<0>, pg8::StaticOrder, true, true>((PG8_LAS unsigned char*)lds, g, S, E);
            }
            xcd_barrier(xbar);
            r1_phase(AA, l, lds, tid);
            g1_phase(AA, l, lds, tid);
            xcd_barrier(xbar);
            if (blockIdx.x < 32) r2_scan(AA, blockIdx.x, lds, tid);
            else if (blockIdx.x < 96) g2_scan(AA, (blockIdx.x - 32) * NTHR + tid);
            xcd_barrier(xbar);
            r3_phase(AA, l, hb, gw, NGW, lane);
            g3_phase(AA, l, hb, gw, NGW, lane);
            xcd_barrier(xbar);
        }
        {
            CArgs& a = AA; bf16* XN = (bf16*)(a.ws + WS_XN);
            pg8::Gemm g{XN, (const bf16*)(a.ws + WS_WOUT + l * WOUT_BYTES), M, D, D}; pg8::StaticOrder S; S.init(M, D, G, (int)blockIdx.x);
            pg8::EpiRmsRes E{l == 0 ? a.in[0] : a.out, a.out, XN, l == 0 ? a.in[1] + D : a.in[17], (float*)(a.ws + WS_SLOTS) + (size_t)l * M * 4, (unsigned*)(a.ws + 16384) + l * 64 * 64, D, l};
            pg8::gemm_phase<pg8::EpiRmsRes, pg8::StaticOrder, false, true>((PG8_LAS unsigned char*)lds, g, S, E);
        }
        if (l == 0) xcd_barrier(xbar);
    }
}

extern "C" void kernel_launch(void* const* d_in, const int* in_sizes, int n_in, void* d_out, int out_size, void* d_ws, size_t ws_size, hipStream_t stream) {
    static int grid = 0;
    if (grid == 0) {
        if (n_in != 18 || out_size != M * D || ws_size < WS_END) { fprintf(stderr, "kernel_launch: unexpected shapes n_in %d out %d ws %zu\n", n_in, out_size, ws_size); grid = -1; return; }
        int dev = 0, cus = 0, per_cu = 0;
        hipGetDevice(&dev); hipDeviceGetAttribute(&cus, hipDeviceAttributeMultiprocessorCount, dev);
        if (hipFuncSetAttribute((const void*)hymba_fwd, hipFuncAttributeMaxDynamicSharedMemorySize, LDS_BYTES) != hipSuccess) { fprintf(stderr, "kernel_launch: hipFuncSetAttribute failed\n"); grid = -1; return; }
        if (hipOccupancyMaxActiveBlocksPerMultiprocessor(&per_cu, (const void*)hymba_fwd, NTHR, LDS_BYTES) != hipSuccess || per_cu < 1) { fprintf(stderr, "kernel_launch: occupancy query failed (%d)\n", per_cu); grid = -1; return; }
        grid = cus * 1;
        fprintf(stderr, "kernel_launch: cus %d per_cu %d grid %d\n", cus, per_cu, grid);
    }
    if (grid < 0) return;
    if (hipMemsetAsync(d_ws, 0, 65536, stream) != hipSuccess) { fprintf(stderr, "kernel_launch: memset failed\n"); return; }
    Args a{};
    for (int i = 0; i < 18; ++i) a.in[i] = (const float*)d_in[i];
    a.out = (float*)d_out; a.ws = (unsigned char*)d_ws;
    void* args[] = {&a};
    hipError_t e = hipLaunchCooperativeKernel((const void*)hymba_fwd, dim3(grid), dim3(NTHR), args, LDS_BYTES, stream);
    if (e != hipSuccess) fprintf(stderr, "cooperative launch failed: %s (grid %d)\n", hipGetErrorString(e), grid);
}
```

```cpp
#include <hip/hip_runtime.h>
#include <hip/hip_cooperative_groups.h>
#include <cstdio>
#include <cstdint>
namespace cg = cooperative_groups;
namespace pg8 {
#define PG8_LAS __attribute__((address_space(3)))
typedef unsigned short bf16_t;
typedef short bf16x8 __attribute__((ext_vector_type(8)));
typedef float f32x4 __attribute__((ext_vector_type(4)));
typedef unsigned u32x4 __attribute__((ext_vector_type(4)));
constexpr int BM = 256, BK = 64, HALF = 128, HTB = HALF * BK * 2  , STAGE_BYTES = 8 * HTB, NXCD = 8, WGM = 8;

__host__ __device__ __forceinline__ int lds_byte(int r, int c) { const int st = (r >> 4) * 2 + (c >> 5), rr = r & 15, cc = c & 31, ob = rr * 64 + cc * 2; return st * 1024 + (ob ^ (((ob >> 9) & 1) << 5)); }
__host__ __device__ __forceinline__ void stage_rc(int b, int& R, int& C) { const int st = b / 1024, sb = b % 1024, swz = sb ^ (((sb >> 9) & 1) << 5); R = (st >> 1) * 16 + swz / 64; C = (st & 1) * 32 + (swz % 64) / 2; }
__host__ __device__ __forceinline__ int perm32(int rho) { const int n = rho >> 4, i = rho & 15; return 8 * (i >> 2) + 4 * n + (i & 3); }

struct Unit { int pm, pn; };
struct Gemm { const bf16_t* A; const bf16_t* Bt; int M, N, K; };

struct StaticOrder {
    int nM, nN, nwg, G, c;
    __host__ __device__ void init(int M, int N, int G_, int c_) { nM = M / BM; nN = N / BM; nwg = nM * nN; G = G_; c = c_; }
    __host__ __device__ bool next(int i, Unit& u) const {
        const long L = (long)i * G + c; if (L >= nwg) return false;
        int wgid = (int)L; { const int q = nwg / NXCD, r = nwg % NXCD, xcd = wgid % NXCD, off = wgid / NXCD; wgid = (xcd < r ? xcd * (q + 1) : r * (q + 1) + (xcd - r) * q) + off; }
        const int nig = WGM * nN, gid = wgid / nig, fm = gid * WGM, gsz = (nM - fm) < WGM ? (nM - fm) : WGM;
        u.pm = fm + ((wgid % nig) % gsz); u.pn = (wgid % nig) / gsz; return true;
    }
    __device__ __forceinline__ void a_ready(const Unit&) const {}
    __device__ __forceinline__ void done(const Unit&) const {}
};

__device__ __forceinline__ unsigned cvt_pk_bf16(float lo, float hi) { unsigned r; asm volatile("v_cvt_pk_bf16_f32 %0, %1, %2" : "=v"(r) : "v"(lo), "v"(hi)); return r; }
typedef float f32x2 __attribute__((ext_vector_type(2)));
__device__ __forceinline__ f32x2 gelu_pk(f32x2 v) {
    const f32x2 av = __builtin_elementwise_abs(v), d = av * 0.2316418882f + 1.0f;
    f32x2 t; t.x = __builtin_amdgcn_rcpf(d.x); t.y = __builtin_amdgcn_rcpf(d.y);
    f32x2 q = t * 0.5307027145f + (-0.7265760135f); q = q * t + 0.7107068705f; q = q * t + (-0.142248368f); q = q * t + 0.127414796f; q = q * t;
    const f32x2 s = (v * v) * (-0.72134752044f);
    f32x2 e; e.x = __builtin_amdgcn_exp2f(s.x); e.y = __builtin_amdgcn_exp2f(s.y);
    const f32x2 m = v * (q * e), r = v - m;
    f32x2 o; o.x = v.x < 0.f ? m.x : r.x; o.y = v.y < 0.f ? m.y : r.y; return o;
}

template <int ACT  > struct EpiBf16 {
    static constexpr bool PERM = true, AFTER_DRAIN = false; static_assert(ACT == 0 || ACT == 1, "EpiBf16: ACT is 0 (none) or 1 (gelu_pk)");
    bf16_t* O; int ldc; const float* bias; int split_cols; size_t split_stride; float scale0;
    __device__ __forceinline__ void operator()(const f32x4 (&acc)[2][2][4][2], const Unit& u, int wr, int wc, int fr, int fq) const {
        const int row0 = u.pm * BM + wr * 64 + fr; int colt = u.pn * BM; bf16_t* base = O;
        float sc = 1.f; if (split_cols) { const int t = colt / split_cols; base += (size_t)t * split_stride; colt -= t * split_cols; if (t == 0) sc = scale0; }
        const int col0 = colt + wc * 32 + 8 * fq, bcol0 = u.pn * BM + wc * 32 + 8 * fq;
        f32x4 bv[2][2];
#pragma unroll
        for (int bj = 0; bj < 2; ++bj)
#pragma unroll
            for (int n = 0; n < 2; ++n) bv[bj][n] = bias ? *(const f32x4*)(bias + bcol0 + bj * HALF + 4 * n) : (f32x4){0.f, 0.f, 0.f, 0.f};
#pragma unroll
        for (int ai = 0; ai < 2; ++ai)
#pragma unroll
            for (int m = 0; m < 4; ++m) { bf16_t* rowp = base + (size_t)(row0 + ai * HALF + m * 16) * ldc + col0;
#pragma unroll
                for (int bj = 0; bj < 2; ++bj) { f32x4 v0 = acc[ai][bj][m][0] + bv[bj][0], v1 = acc[ai][bj][m][1] + bv[bj][1];
                    if (ACT == 1) { f32x2 a = gelu_pk((f32x2){v0[0], v0[1]}), b = gelu_pk((f32x2){v0[2], v0[3]}), c = gelu_pk((f32x2){v1[0], v1[1]}), d = gelu_pk((f32x2){v1[2], v1[3]});
                        v0 = (f32x4){a.x, a.y, b.x, b.y}; v1 = (f32x4){c.x, c.y, d.x, d.y}; }
                    v0 = v0 * sc; v1 = v1 * sc; u32x4 w; w.x = cvt_pk_bf16(v0[0], v0[1]); w.y = cvt_pk_bf16(v0[2], v0[3]); w.z = cvt_pk_bf16(v1[0], v1[1]); w.w = cvt_pk_bf16(v1[2], v1[3]);
                    *(u32x4*)(rowp + bj * HALF) = w; } }
    }
};

template <class Epi, class Sched, bool ALIGN_EPI = false, bool SP2 = false>
__device__ __forceinline__ void gemm_phase(PG8_LAS unsigned char* lds, const Gemm g, const Sched& S, const Epi& E) {
    int tid_ = threadIdx.x; asm volatile("" : "+v"(tid_));
    const int tid = tid_, wid = __builtin_amdgcn_readfirstlane(tid >> 6), lane = tid & 63, wr = wid >> 2, wc = wid & 3, fr = lane & 15, fq = lane >> 4;
    const int K = g.K, nt = K / BK;
    unsigned voffA[2], voffB[2];
#pragma unroll
    for (int i = 0; i < 2; ++i) { int R, C; stage_rc(tid * 16 + i * 8192, R, C); const int Rb = Epi::PERM ? ((R & ~31) + perm32(R & 31)) : R;
        voffA[i] = (unsigned)(R * K + C) * 2u; voffB[i] = (unsigned)(Rb * K + C) * 2u; }
    const size_t kstep = (size_t)(BK * 2);
    const size_t hstep = (size_t)HALF * K * 2;
    const size_t tstep = 2 * hstep;
    const unsigned ldsw = (unsigned)wid * 1024u;
    const int aoff = lds_byte(wr * 64 + fr, fq * 8), boff = lds_byte(wc * 32 + fr, fq * 8);
#define PG8_SA(b, h) (((b) * 2 + (h)) * HTB)
#define PG8_SB(b, h) ((4 + (b) * 2 + (h)) * HTB)
#define PG8_STAGE(bufoff, gbase, voff) do { _Pragma("unroll") for (int _i = 0; _i < 2; ++_i) \
        __builtin_amdgcn_global_load_lds((const unsigned*)((const char*)(gbase) + (voff)[_i]), (PG8_LAS unsigned*)(lds + (bufoff) + ldsw + _i * 8192), 16, 0, 0); } while (0)
#define PG8_LDA(dst, b, h) do { _Pragma("unroll") for (int m = 0; m < 4; ++m) _Pragma("unroll") for (int k = 0; k < 2; ++k) dst[m][k] = *(const PG8_LAS bf16x8*)(lds + PG8_SA(b, h) + aoff + m * 2048 + k * 1024); } while (0)
#define PG8_LDB(dst, b, h) do { _Pragma("unroll") for (int n = 0; n < 2; ++n) _Pragma("unroll") for (int k = 0; k < 2; ++k) dst[n][k] = *(const PG8_LAS bf16x8*)(lds + PG8_SB(b, h) + boff + n * 2048 + k * 1024); } while (0)
#define PG8_MMA(ai, bj, At, Bt) do { __builtin_amdgcn_s_setprio(1); _Pragma("unroll") for (int m = 0; m < 4; ++m) _Pragma("unroll") for (int n = 0; n < 2; ++n) _Pragma("unroll") for (int k = 0; k < 2; ++k) \
        acc[ai][bj][m][n] = __builtin_amdgcn_mfma_f32_16x16x32_bf16(Bt[n][k], At[m][k], acc[ai][bj][m][n], 0, 0, 0); __builtin_amdgcn_s_setprio(0); } while (0)
#define PG8_WAIT_V(n) asm volatile("s_waitcnt vmcnt(" #n ")" ::: "memory")
#define PG8_WAIT_L(n) asm volatile("s_waitcnt lgkmcnt(" #n ")" ::: "memory")
#define PG8_BAR __builtin_amdgcn_s_barrier()
#define PG8_SCHED __builtin_amdgcn_sched_barrier(0)
    Unit cur, nxt; int ui = 0;
    if (!S.next(0, cur)) return;
    f32x4 acc[2][2][4][2];
#pragma unroll
    for (int a = 0; a < 2; ++a)
#pragma unroll
        for (int b = 0; b < 2; ++b)
#pragma unroll
            for (int m = 0; m < 4; ++m)
#pragma unroll
                for (int n = 0; n < 2; ++n) acc[a][b][m][n] = (f32x4){0.f, 0.f, 0.f, 0.f};
    bf16x8 At[4][2], B0[2][2], B1[2][2];
    const char* cA = (const char*)g.A + (size_t)cur.pm * tstep; const char* cB = (const char*)g.Bt + (size_t)cur.pn * tstep;
    S.a_ready(cur);
    if constexpr (SP2) {
        PG8_STAGE(PG8_SB(0, 0), cB, voffB); PG8_STAGE(PG8_SB(0, 1), cB + hstep, voffB); PG8_STAGE(PG8_SA(0, 0), cA, voffA); PG8_STAGE(PG8_SA(0, 1), cA + hstep, voffA);
        if (wr == 1) PG8_BAR;
        PG8_WAIT_V(2); PG8_BAR;
        PG8_STAGE(PG8_SB(1, 0), cB + kstep, voffB); PG8_STAGE(PG8_SA(1, 0), cA + kstep, voffA); PG8_STAGE(PG8_SB(1, 1), cB + hstep + kstep, voffB);
        PG8_WAIT_V(6); PG8_BAR;
    } else {
        PG8_STAGE(PG8_SB(0, 0), cB, voffB); PG8_STAGE(PG8_SA(0, 0), cA, voffA); PG8_STAGE(PG8_SB(0, 1), cB + hstep, voffB); PG8_STAGE(PG8_SA(0, 1), cA + hstep, voffA);
        if (wr == 1) PG8_BAR;
        PG8_WAIT_V(4); PG8_BAR;
        PG8_STAGE(PG8_SB(1, 0), cB + kstep, voffB); PG8_STAGE(PG8_SA(1, 0), cA + kstep, voffA); PG8_STAGE(PG8_SB(1, 1), cB + hstep + kstep, voffB);
        PG8_WAIT_V(6); PG8_BAR;
    }
    for (;;) {
        const bool has_next = S.next(ui + 1, nxt);
        const char* nA = has_next ? (const char*)g.A + (size_t)nxt.pm * tstep : cA; const char* nB = has_next ? (const char*)g.Bt + (size_t)nxt.pn * tstep : cB;
        for (int t = 0; t < nt; t += 2) {
            const bool last = (t == nt - 2);
            const char* a1 = cA + (size_t)(t + 1) * kstep;
            const char* a2 = last ? nA : cA + (size_t)(t + 2) * kstep; const char* b2 = last ? nB : cB + (size_t)(t + 2) * kstep;
            const char* a3 = a2 + kstep; const char* b3 = b2 + kstep;
            if (last && has_next) S.a_ready(nxt);
            if constexpr (SP2) {
            PG8_LDB(B0, 0, 0); PG8_LDB(B1, 0, 1); PG8_SCHED; PG8_LDA(At, 0, 0); PG8_STAGE(PG8_SA(1, 1), a1 + hstep, voffA);
            PG8_WAIT_V(8); PG8_WAIT_L(0); PG8_BAR; PG8_MMA(0, 0, At, B0); PG8_MMA(0, 1, At, B1); PG8_BAR; PG8_SCHED;
            PG8_LDA(At, 0, 1); PG8_STAGE(PG8_SB(0, 0), b2, voffB); PG8_STAGE(PG8_SB(0, 1), b2 + hstep, voffB); PG8_STAGE(PG8_SA(0, 0), a2, voffA);
            PG8_WAIT_V(8); PG8_WAIT_L(0); PG8_BAR; PG8_MMA(1, 0, At, B0); PG8_MMA(1, 1, At, B1); PG8_BAR; PG8_SCHED;
            PG8_LDB(B0, 1, 0); PG8_LDB(B1, 1, 1); PG8_SCHED; PG8_LDA(At, 1, 0); PG8_STAGE(PG8_SA(0, 1), a2 + hstep, voffA);
            PG8_WAIT_V(8); PG8_WAIT_L(0); PG8_BAR; PG8_MMA(0, 0, At, B0); PG8_MMA(0, 1, At, B1); PG8_BAR; PG8_SCHED;
            PG8_LDA(At, 1, 1); PG8_STAGE(PG8_SB(1, 0), b3, voffB); PG8_STAGE(PG8_SB(1, 1), b3 + hstep, voffB); PG8_STAGE(PG8_SA(1, 0), a3, voffA);
            PG8_WAIT_V(8); PG8_WAIT_L(0); PG8_BAR; PG8_MMA(1, 0, At, B0); PG8_MMA(1, 1, At, B1); PG8_BAR; PG8_SCHED;
            } else {
            PG8_LDB(B0, 0, 0); PG8_SCHED; PG8_LDA(At, 0, 0); PG8_STAGE(PG8_SA(1, 1), a1 + hstep, voffA);
            PG8_WAIT_L(8); PG8_BAR; PG8_WAIT_L(0); PG8_MMA(0, 0, At, B0); PG8_BAR; PG8_SCHED;
            PG8_LDB(B1, 0, 1); PG8_STAGE(PG8_SB(0, 0), b2, voffB);
            PG8_BAR; PG8_WAIT_L(0); PG8_MMA(0, 1, At, B1); PG8_BAR;
            PG8_LDA(At, 0, 1); PG8_STAGE(PG8_SA(0, 0), a2, voffA);
            PG8_BAR; PG8_WAIT_L(0); PG8_MMA(1, 0, At, B0); PG8_BAR; PG8_SCHED;
            PG8_STAGE(PG8_SB(0, 1), b2 + hstep, voffB);
            PG8_WAIT_V(6); PG8_BAR; PG8_MMA(1, 1, At, B1); PG8_BAR;
            PG8_LDB(B0, 1, 0); PG8_SCHED; PG8_LDA(At, 1, 0); PG8_STAGE(PG8_SA(0, 1), a2 + hstep, voffA);
            PG8_WAIT_L(8); PG8_BAR; PG8_WAIT_L(0); PG8_MMA(0, 0, At, B0); PG8_BAR; PG8_SCHED;
            PG8_LDB(B1, 1, 1); PG8_STAGE(PG8_SB(1, 0), b3, voffB);
            PG8_BAR; PG8_WAIT_L(0); PG8_MMA(0, 1, At, B1); PG8_BAR;
            PG8_LDA(At, 1, 1); PG8_STAGE(PG8_SA(1, 0), a3, voffA);
            PG8_BAR; PG8_WAIT_L(0); PG8_MMA(1, 0, At, B0); PG8_BAR; PG8_SCHED;
            PG8_STAGE(PG8_SB(1, 1), b3 + hstep, voffB);
            PG8_WAIT_V(6); PG8_BAR; PG8_MMA(1, 1, At, B1); PG8_BAR;
            }
        }
        if constexpr (ALIGN_EPI) { if (wr == 0) PG8_BAR; }
        if constexpr (!Epi::AFTER_DRAIN) { E(acc, cur, wr, wc, fr, fq); S.done(cur); }
        if (!has_next) break;
#pragma unroll
        for (int a = 0; a < 2; ++a)
#pragma unroll
            for (int b = 0; b < 2; ++b)
#pragma unroll
                for (int m = 0; m < 4; ++m)
#pragma unroll
                    for (int n = 0; n < 2; ++n) acc[a][b][m][n] = (f32x4){0.f, 0.f, 0.f, 0.f};
        cur = nxt; cA = nA; cB = nB; ++ui;
        if constexpr (ALIGN_EPI) { if (wr == 1) PG8_BAR; }
    }
    PG8_WAIT_V(0);
    if constexpr (!ALIGN_EPI) { if (wr == 0) PG8_BAR; }
    PG8_BAR;
    if constexpr (Epi::AFTER_DRAIN) { E.fused(acc, cur, wr, wc, fr, fq, lds, wid, lane); S.done(cur); }
#undef PG8_SA
#undef PG8_SB
#undef PG8_STAGE
#undef PG8_LDA
#undef PG8_LDB
#undef PG8_MMA
#undef PG8_WAIT_V
#undef PG8_WAIT_L
#undef PG8_BAR
#undef PG8_SCHED
}
}
namespace pg8 {
struct EpiResid {
    static constexpr bool PERM = false, AFTER_DRAIN = false;
    const float* base; float* out; int ldc;
    __device__ __forceinline__ void operator()(const f32x4 (&acc)[2][2][4][2], const Unit& u, int wr, int wc, int fr, int fq) const {
        const int col0 = u.pn * BM + wc * 32 + 4 * fq;
#pragma unroll
        for (int ai = 0; ai < 2; ++ai)
#pragma unroll
            for (int m = 0; m < 4; ++m) { const size_t off = (size_t)(u.pm * BM + ai * HALF + wr * 64 + m * 16 + fr) * ldc + col0;
#pragma unroll
                for (int bj = 0; bj < 2; ++bj)
#pragma unroll
                    for (int n = 0; n < 2; ++n) { const f32x4 b = *(const f32x4*)(base + off + bj * HALF + n * 16); *(f32x4*)(out + off + bj * HALF + n * 16) = b + acc[ai][bj][m][n]; } }
    }
};
struct EpiRmsRes {
    static constexpr bool PERM = false, AFTER_DRAIN = true;
    const float* base; float* out; bf16_t* xn; const float* w; float* slots; unsigned* cnt; int ldc; int mode;
    __device__ __forceinline__ void fused(f32x4 (&acc)[2][2][4][2], const Unit& u, int wr, int wc, int fr, int fq, PG8_LAS unsigned char* lds, int wid, int lane) const {
        const int col0 = u.pn * BM + wc * 32 + 4 * fq;
        PG8_LAS float* P = (PG8_LAS float*)lds; PG8_LAS float* S = (PG8_LAS float*)(lds + 4096);
#pragma unroll
        for (int ai = 0; ai < 2; ++ai)
#pragma unroll
            for (int m = 0; m < 4; ++m) { const size_t off = (size_t)(u.pm * BM + ai * HALF + wr * 64 + m * 16 + fr) * ldc + col0; float s = 0.f;
#pragma unroll
                for (int bj = 0; bj < 2; ++bj)
#pragma unroll
                    for (int n = 0; n < 2; ++n) { const f32x4 v = acc[ai][bj][m][n] + *(const f32x4*)(base + off + bj * HALF + n * 16); acc[ai][bj][m][n] = v; s += (v[0] * v[0] + v[1] * v[1]) + (v[2] * v[2] + v[3] * v[3]); }
                s += __shfl_xor(s, 16); s += __shfl_xor(s, 32);
                if (fq == 0) P[(ai * HALF + wr * 64 + m * 16 + fr) * 4 + wc] = s;
                if (m & 1) asm volatile("" ::: "memory"); }
        asm volatile("s_waitcnt lgkmcnt(0)" ::: "memory"); __builtin_amdgcn_s_barrier(); asm volatile("" ::: "memory");
        const int row = wid * 32 + (lane & 31);
        if (lane < 32) { const float tot = (P[row * 4 + 0] + P[row * 4 + 1]) + (P[row * 4 + 2] + P[row * 4 + 3]);
            __hip_atomic_store(slots + ((size_t)(u.pm * BM + row) * 4 + u.pn), tot, __ATOMIC_RELAXED, __HIP_MEMORY_SCOPE_AGENT); }
        asm volatile("s_waitcnt vmcnt(0)" ::: "memory");
        if (lane == 0) __hip_atomic_fetch_add(cnt + 64 * u.pm, 1u, __ATOMIC_RELAXED, __HIP_MEMORY_SCOPE_AGENT);
        if (wid == 0) { while ((unsigned)__builtin_amdgcn_readfirstlane(__hip_atomic_load(cnt + 64 * u.pm, __ATOMIC_RELAXED, __HIP_MEMORY_SCOPE_AGENT)) < 32u) __builtin_amdgcn_s_sleep(2);
            __builtin_amdgcn_fence(__ATOMIC_ACQUIRE, "agent"); }
        asm volatile("s_waitcnt vmcnt(0) lgkmcnt(0)" ::: "memory"); __builtin_amdgcn_s_barrier(); asm volatile("" ::: "memory");
        if (lane < 32) { const float* sl = slots + (size_t)(u.pm * BM + row) * 4; float q = 0.f;
#pragma unroll
            for (int t = 0; t < 4; ++t) q += __hip_atomic_load(sl + t, __ATOMIC_RELAXED, __HIP_MEMORY_SCOPE_AGENT);
            S[row] = 1.0f / sqrtf(q * (1.f / 1024.f) + 1e-6f); }
        asm volatile("s_waitcnt lgkmcnt(0)" ::: "memory"); __builtin_amdgcn_s_barrier(); asm volatile("" ::: "memory");
        f32x4 wv[2][2];
#pragma unroll
        for (int bj = 0; bj < 2; ++bj)
#pragma unroll
            for (int n = 0; n < 2; ++n) wv[bj][n] = *(const f32x4*)(w + col0 + bj * HALF + n * 16);
#pragma unroll
        for (int ai = 0; ai < 2; ++ai)
#pragma unroll
            for (int m = 0; m < 4; ++m) { const int r = ai * HALF + wr * 64 + m * 16 + fr; const float rs = S[r]; const size_t off = (size_t)(u.pm * BM + r) * ldc + col0;
#pragma unroll
                for (int bj = 0; bj < 2; ++bj)
#pragma unroll
                    for (int n = 0; n < 2; ++n) { const f32x4 v = acc[ai][bj][m][n]; const f32x4 nv = v * rs * wv[bj][n];
                        if (mode == 0) { *(f32x4*)(out + off + bj * HALF + n * 16) = v; typedef unsigned u32x2v __attribute__((ext_vector_type(2))); u32x2v pk; pk.x = cvt_pk_bf16(nv[0], nv[1]); pk.y = cvt_pk_bf16(nv[2], nv[3]);
                            *(u32x2v*)(xn + off + bj * HALF + n * 16) = pk; }
                        else *(f32x4*)(out + off + bj * HALF + n * 16) = nv; } }
    }
};
}
constexpr int NWAVES = 8, NTHR = 512;
constexpr int BATCH = 2, T = 8192, D = 1024, M = BATCH * T, MH = T;
constexpr int NIN = 3728, NPAD = 3840;
constexpr int C_GQ = 0, C_GK = 256, C_GV = 512, C_GLR = 1024, C_GG = 1040, C_R = 1552, C_K = 2064, C_V = 2576, C_WL = 3088, C_AL = 3152, C_RG = 3216;
constexpr size_t MiB = 1u << 20;
constexpr size_t WS_WIN = 1 * MiB, WIN_BYTES = (size_t)NPAD * D * 2;
constexpr size_t WS_WOUT = 16 * MiB, WOUT_BYTES = (size_t)D * D * 2;
constexpr size_t WS_XN = 20 * MiB;
constexpr size_t WS_U = 52 * MiB;
constexpr size_t WS_SLOTS = 220 * MiB;
constexpr size_t WS_END = 256 * MiB;
constexpr int LDS_BYTES = 147456;

typedef unsigned short bf16;
typedef unsigned v4u __attribute__((ext_vector_type(4)));
typedef float f32x4 __attribute__((ext_vector_type(4)));
#define LDS_WAIT() asm volatile("s_waitcnt lgkmcnt(0)" ::: "memory")
#define LBAR() do { asm volatile("s_waitcnt lgkmcnt(0)" ::: "memory"); __builtin_amdgcn_s_barrier(); asm volatile("" ::: "memory"); } while (0)
__device__ __forceinline__ float bf2f(unsigned h) { return __uint_as_float(h << 16); }
__device__ __forceinline__ unsigned f2bf(float f) { unsigned u = __float_as_uint(f); return (u + 0x7fffu + ((u >> 16) & 1u)) >> 16; }
typedef __bf16 bf16x2_t __attribute__((ext_vector_type(2)));
typedef float f32x2_t __attribute__((ext_vector_type(2)));
__device__ __forceinline__ unsigned pk2(float lo, float hi) { const f32x2_t v = {lo, hi}; const bf16x2_t b = __builtin_convertvector(v, bf16x2_t); return __builtin_bit_cast(unsigned, b); }
__device__ __forceinline__ float wave_sum(float v) {
#pragma unroll
    for (int o = 1; o < 64; o <<= 1) v += __shfl_xor(v, o);
    return v;
}
__device__ __forceinline__ float sigm(float x) { return __builtin_amdgcn_rcpf(1.f + __expf(-x)); }
__device__ __forceinline__ float tanh_fast(float x) { return 1.f - 2.f * __builtin_amdgcn_rcpf(1.f + __expf(2.f * x)); }
__device__ __forceinline__ float rl(float v, int l) { return __int_as_float(__builtin_amdgcn_readlane(__float_as_int(v), l)); }

typedef short bf16x8 __attribute__((ext_vector_type(8)));
typedef unsigned v2u __attribute__((ext_vector_type(2)));
__device__ __forceinline__ v2u pack4(f32x4 v) { v2u r; r.x = pk2(v.x, v.y); r.y = pk2(v.z, v.w); return r; }
__device__ __forceinline__ void unpack8(v4u w, float* o) { o[0] = bf2f(w.x & 0xffffu); o[1] = bf2f(w.x >> 16); o[2] = bf2f(w.y & 0xffffu); o[3] = bf2f(w.y >> 16);
    o[4] = bf2f(w.z & 0xffffu); o[5] = bf2f(w.z >> 16); o[6] = bf2f(w.w & 0xffffu); o[7] = bf2f(w.w >> 16); }
__device__ __forceinline__ v4u pack8(const float* v) { v4u r; r.x = pk2(v[0], v[1]); r.y = pk2(v[2], v[3]); r.z = pk2(v[4], v[5]); r.w = pk2(v[6], v[7]); return r; }
struct Args { const float* in[18]; float* out; unsigned char* ws; };
typedef const Args __attribute__((address_space(4))) CArgs;
__device__ __forceinline__ CArgs* opaque_args() { CArgs* p = (CArgs*)__builtin_amdgcn_kernarg_segment_ptr(); asm volatile("" : "+s"(p)); return p; }
#define AA (*opaque_args())

__device__ __forceinline__ void rms_row2(const float* x0, const float* x1, const float* w, bf16* o0, bf16* o1, int lane) {
    const f32x4* r0 = (const f32x4*)x0 + lane; const f32x4* r1 = (const f32x4*)x1 + lane; const f32x4* wr = (const f32x4*)w + lane;
    f32x4 a[4], b[4]; float sa = 0.f, sb = 0.f;
#pragma unroll
    for (int j = 0; j < 4; ++j) { a[j] = r0[64 * j]; b[j] = r1[64 * j]; }
#pragma unroll
    for (int j = 0; j < 4; ++j) { sa += (a[j].x * a[j].x + a[j].y * a[j].y) + (a[j].z * a[j].z + a[j].w * a[j].w); sb += (b[j].x * b[j].x + b[j].y * b[j].y) + (b[j].z * b[j].z + b[j].w * b[j].w); }
    const float ra = rsqrtf(wave_sum(sa) * (1.f / D) + 1e-6f), rb = rsqrtf(wave_sum(sb) * (1.f / D) + 1e-6f);
#pragma unroll
    for (int j = 0; j < 4; ++j) { const f32x4 ww = wr[64 * j]; const f32x4 oa = a[j] * ra * ww, ob = b[j] * rb * ww;
        ((v2u*)o0 + lane)[64 * j] = pack4(oa); ((v2u*)o1 + lane)[64 * j] = pack4(ob); }
}
__device__ __forceinline__ void transpose_item(const float* W, int K, int N, int Npad, bf16* WT, float* scr, int item, int lane) {
    const int nblk = Npad / 32, kb = item / nblk, nb = item % nblk, k0 = 64 * kb, n0 = 32 * nb;
    const int n = n0 + (lane & 31);
#pragma unroll 8
    for (int i = 0; i < 32; ++i) { const int kk = 2 * i + (lane >> 5); scr[kk * 33 + (lane & 31)] = (n < N) ? W[(size_t)(k0 + kk) * N + n] : 0.f; }
    LDS_WAIT();
    const int c = lane & 7;
#pragma unroll
    for (int j = 0; j < 4; ++j) { const int nn = (lane >> 3) + 8 * j; const float* s = scr + (8 * c) * 33 + nn;
        v4u o; o.x = pk2(s[0 * 33], s[1 * 33]); o.y = pk2(s[2 * 33], s[3 * 33]); o.z = pk2(s[4 * 33], s[5 * 33]); o.w = pk2(s[6 * 33], s[7 * 33]);
        *(v4u*)(WT + (size_t)(n0 + nn) * K + k0 + 8 * c) = o; }
    LDS_WAIT();
}
__device__ __forceinline__ void transpose_tiles(const float* W, int K, int N, int Npad, bf16* WT, float* scr  , int first, int stride, int ntiles, int tid) {
    const int nblk = Npad / 64, kr = tid >> 4, nq = tid & 15;
    f32x4 v0 = {0.f, 0.f, 0.f, 0.f}, v1 = v0;
    if (first < ntiles) { const int kb = first / nblk, nb = first % nblk, n = 64 * nb + 4 * nq; if (n < N) { v0 = *(const f32x4*)(W + (size_t)(64 * kb + kr) * N + n); v1 = *(const f32x4*)(W + (size_t)(64 * kb + 32 + kr) * N + n); } }
#pragma unroll 1
    for (int it = first; it < ntiles; it += stride) {
        const int kb = it / nblk, nb = it % nblk;
        scr[kr * 65 + 4 * nq] = v0.x; scr[kr * 65 + 4 * nq + 1] = v0.y; scr[kr * 65 + 4 * nq + 2] = v0.z; scr[kr * 65 + 4 * nq + 3] = v0.w;
        scr[(32 + kr) * 65 + 4 * nq] = v1.x; scr[(32 + kr) * 65 + 4 * nq + 1] = v1.y; scr[(32 + kr) * 65 + 4 * nq + 2] = v1.z; scr[(32 + kr) * 65 + 4 * nq + 3] = v1.w;
        const int nx = it + stride; v0 = (f32x4){0.f, 0.f, 0.f, 0.f}; v1 = v0;
        if (nx < ntiles) { const int kb2 = nx / nblk, nb2 = nx % nblk, n = 64 * nb2 + 4 * nq; if (n < N) { v0 = *(const f32x4*)(W + (size_t)(64 * kb2 + kr) * N + n); v1 = *(const f32x4*)(W + (size_t)(64 * kb2 + 32 + kr) * N + n); } }
        LBAR();
        { const int n = tid >> 3, kc = tid & 7; const float* sp = scr + (8 * kc) * 65 + n; float o[8];
#pragma unroll
          for (int j = 0; j < 8; ++j) o[j] = sp[j * 65];
          *(v4u*)(WT + (size_t)(64 * nb + n) * K + 64 * kb + 8 * kc) = pack8(o); }
        LBAR();
    }
}
__device__ __forceinline__ void rms_row(const float* xrow, const float* w, bf16* obf, float* of32, int lane) {
    const f32x4* xr = (const f32x4*)xrow + lane; const f32x4* wr = (const f32x4*)w + lane;
    f32x4 v[4]; float s = 0.f;
#pragma unroll
    for (int j = 0; j < 4; ++j) { v[j] = xr[64 * j]; s += (v[j].x * v[j].x + v[j].y * v[j].y) + (v[j].z * v[j].z + v[j].w * v[j].w); }
    const float rs = rsqrtf(wave_sum(s) * (1.f / D) + 1e-6f);
#pragma unroll
    for (int j = 0; j < 4; ++j) { const f32x4 ww = wr[64 * j]; f32x4 o = v[j] * rs * ww;
        if (of32) ((f32x4*)of32 + lane)[64 * j] = o;
        else ((unsigned long long*)obf + lane)[64 * j] = (unsigned long long)pk2(o.x, o.y) | ((unsigned long long)pk2(o.z, o.w) << 32); }
}

constexpr int PITCH = 72, FP = 68, TP = 20;
constexpr int OFF_TW = 0, OFF_AL = 9216, OFF_ARK = 18432, OFF_XA = 27648, OFF_XW = 45056, OFF_AT = 63488, OFF_RT = 72704, OFF_BH = 81920, OFF_KH = 91136,
              OFF_BBT = 100352, OFF_KBT = 109568, OFF_VT = 118784, OFF_TII = 128000, OFF_TOT = 133120, OFF_BC = 135168;
constexpr int OFF_AAK = OFF_TW, OFF_ARB = OFF_AL, OFF_AAB = OFF_XA, OFF_XT = OFF_XW;
constexpr size_t WS_MC = 112 * MiB, WS_NC = 120 * MiB, WS_PP = 136 * MiB, WS_Y0 = 144 * MiB, WS_S0 = 160 * MiB, WS_DEC = 168 * MiB, WS_BON2 = 169 * MiB, WS_UPT = 170 * MiB;
constexpr int NUNIT = 1024;

__device__ __forceinline__ f32x4 mma2s(const bf16* Ab, int ak, const bf16* Bb, int bk, int g, f32x4 acc) {
    acc = __builtin_amdgcn_mfma_f32_16x16x32_bf16(*(const bf16x8*)(Ab + ((g ^ ak) << 3)), *(const bf16x8*)(Bb + ((g ^ bk) << 3)), acc, 0, 0, 0);
    acc = __builtin_amdgcn_mfma_f32_16x16x32_bf16(*(const bf16x8*)(Ab + (((g + 4) ^ ak) << 3)), *(const bf16x8*)(Bb + (((g + 4) ^ bk) << 3)), acc, 0, 0, 0);
    return acc;
}
#define SWK(row) (((row) >> 3) & 7)
#define SWC(row, t) ((row) * PITCH + ((((t) >> 3) ^ SWK(row)) << 3) + ((t) & 7))
__device__ __forceinline__ f32x4 mma2(const bf16* Arow, const bf16* Brow, f32x4 acc) {
    acc = __builtin_amdgcn_mfma_f32_16x16x32_bf16(*(const bf16x8*)(Arow), *(const bf16x8*)(Brow), acc, 0, 0, 0);
    acc = __builtin_amdgcn_mfma_f32_16x16x32_bf16(*(const bf16x8*)(Arow + 32), *(const bf16x8*)(Brow + 32), acc, 0, 0, 0);
    return acc;
}

__device__ __forceinline__ void r1_phase(CArgs& a, int l, unsigned char* L, int tid0) {
    asm volatile("" : "+v"(tid0));
    const int wave = __builtin_amdgcn_readfirstlane(tid0 >> 6);
    const bf16* U = (const bf16*)(a.ws + WS_U);
    bf16* TW = (bf16*)(L + OFF_TW); bf16* ALm = (bf16*)(L + OFF_AL); bf16* ARK = (bf16*)(L + OFF_ARK); bf16* AAK = (bf16*)(L + OFF_AAK); bf16* ARB = (bf16*)(L + OFF_ARB);
    float* XA = (float*)(L + OFF_XA); float* XW = (float*)(L + OFF_XW); float* AAB = (float*)(L + OFF_AAB); bf16* XT = (bf16*)(L + OFF_XT);
    bf16* AT = (bf16*)(L + OFF_AT); bf16* RT = (bf16*)(L + OFF_RT); bf16* BH = (bf16*)(L + OFF_BH); bf16* KH = (bf16*)(L + OFF_KH);
    bf16* BBT = (bf16*)(L + OFF_BBT); bf16* KBT = (bf16*)(L + OFF_KBT); bf16* VT = (bf16*)(L + OFF_VT);
    float* TII = (float*)(L + OFF_TII); float* TOT = (float*)(L + OFF_TOT); float* BC = (float*)(L + OFF_BC);
    const bf16* UPT = (const bf16*)(a.ws + WS_UPT) + (size_t)l * 2 * 512 * 64;
    const float* mu = a.in[6] + l * 1664;
    float* WTS = (float*)(L + 135424);
    int hl = -1;
    v4u Pc0, Pc1, Pp0, Pp1, Lrc, Lkc, Lvc, Lrp, Lkp, Lvp; bf16x8 wfa0, wfa1;
#define R1_ISSUE(u_) do { const int lr_ = 64 * ((u_) >> 3) + (tid >> 3); const bf16* ub_ = U + (size_t)lr_ * NPAD; const bf16* up_ = ub_ + C_WL + 16 * (tid & 7); const bf16* uq_ = ub_ + 64 * ((u_) & 7) + 8 * (tid & 7); \
        Pc0 = *(const v4u*)up_; Pc1 = *(const v4u*)(up_ + 8); Lrc = *(const v4u*)(uq_ + C_R); Lkc = *(const v4u*)(uq_ + C_K); Lvc = *(const v4u*)(uq_ + C_V); \
        Pp0 = (v4u){0u, 0u, 0u, 0u}; Pp1 = Pp0; Lrp = Pp0; Lkp = Pp0; Lvp = Pp0; \
        if (lr_ > 0) { Pp0 = *(const v4u*)(up_ - NPAD); Pp1 = *(const v4u*)(up_ - NPAD + 8); Lrp = *(const v4u*)(uq_ + C_R - NPAD); Lkp = *(const v4u*)(uq_ + C_K - NPAD); Lvp = *(const v4u*)(uq_ + C_V - NPAD); } } while (0)
#pragma unroll 1
    for (int unit = blockIdx.x; unit < NUNIT; unit += gridDim.x) {
        int tid = tid0; asm volatile("" : "+v"(tid));
        const int lane = tid & 63, g = lane >> 4, c16 = lane & 15;
        const int ch = unit >> 3, h = unit & 7;
        if (h != hl) { hl = h; LBAR();
            if (tid < 64) { const int c = l * 512 + 64 * h + tid; WTS[tid] = a.in[7][c]; WTS[64 + tid] = a.in[9][c]; WTS[128 + tid] = a.in[11][c]; WTS[192 + tid] = a.in[12][c]; WTS[256 + tid] = a.in[13][c];
                WTS[320 + tid] = mu[64 * h + tid]; WTS[384 + tid] = mu[512 + 64 * h + tid]; WTS[448 + tid] = mu[1024 + 64 * h + tid]; }
            else if (tid < 192) WTS[512 + tid - 64] = mu[1536 + tid - 64];
            { const bf16* WT = UPT + (size_t)(wave >> 2) * 512 * 64 + (size_t)(64 * h + 16 * (wave & 3) + c16) * 64 + 8 * g; wfa0 = *(const bf16x8*)WT; wfa1 = *(const bf16x8*)(WT + 32); }
            LBAR(); }
        const int t = tid >> 3, dg = tid & 7, d0 = 8 * dg, lr = 64 * ch + t, hc = 64 * h + d0;
        if (unit == (int)blockIdx.x) R1_ISSUE(unit);
        {
            const int cg = tid & 7;
            float cu[16], pr[16], o[16]; unpack8(Pc0, cu); unpack8(Pc1, cu + 8); unpack8(Pp0, pr); unpack8(Pp1, pr + 8);
            const float* mp = WTS + 512 + 16 * cg;
#pragma unroll
            for (int i = 0; i < 16; ++i) { float mv = cu[i] + (pr[i] - cu[i]) * mp[i]; if (cg < 4) mv = tanh_fast(mv); o[i] = mv; }
            bf16* dst = (cg < 4 ? TW : ALm) + t * PITCH + 16 * (cg & 3);
            *(v4u*)dst = pack8(o); *(v4u*)(dst + 8) = pack8(o + 8);
        }
        LBAR();
        {
            const int q = wave >> 2, dt = wave & 3;
            const bf16x8 a0 = wfa0, a1 = wfa1;
            const bf16* Bm = q ? ALm : TW; float* X = q ? XA : XW;
#pragma unroll
            for (int tt = 0; tt < 4; ++tt) { const bf16* br = Bm + (16 * tt + c16) * PITCH + 8 * g; f32x4 acc = {0.f, 0.f, 0.f, 0.f};
                acc = __builtin_amdgcn_mfma_f32_16x16x32_bf16(a0, *(const bf16x8*)br, acc, 0, 0, 0);
                acc = __builtin_amdgcn_mfma_f32_16x16x32_bf16(a1, *(const bf16x8*)(br + 32), acc, 0, 0, 0);
                *(f32x4*)(X + (16 * tt + c16) * FP + 16 * dt + 4 * g) = acc; }
        }
        LBAR();
        float r[8], kq[8], v[8], al[8], be[8], lw[8];
        {
            float rc[8], rp[8], kc[8], kp[8], vc[8], vp[8];
            unpack8(Lrc, rc); unpack8(Lkc, kc); unpack8(Lvc, vc); unpack8(Lrp, rp); unpack8(Lkp, kp); unpack8(Lvp, vp);
            const float* w0p = WTS + d0; const float* a0p = WTS + 64 + d0; const float* kkp = WTS + 128 + d0;
            const float* kap = WTS + 192 + d0; const float* rkp = WTS + 256 + d0;
            float nn = 0.f, bon = 0.f, kk[8], av[8];
#pragma unroll
            for (int i = 0; i < 8; ++i) {
                const float xw = XW[t * FP + d0 + i] + w0p[i], xa = XA[t * FP + d0 + i] + a0p[i];
                lw[i] = -0.60653065971f * sigm(xw); av[i] = sigm(xa);
                r[i] = rc[i] + (rp[i] - rc[i]) * WTS[320 + d0 + i]; const float k = kc[i] + (kp[i] - kc[i]) * WTS[384 + d0 + i]; v[i] = vc[i] + (vp[i] - vc[i]) * WTS[448 + d0 + i];
                kk[i] = k * kkp[i]; nn += kk[i] * kk[i];
                kq[i] = k * (1.f + (av[i] - 1.f) * kap[i]); bon += r[i] * kq[i] * rkp[i];
            }
            nn += __shfl_xor(nn, 1); nn += __shfl_xor(nn, 2); nn += __shfl_xor(nn, 4);
            bon += __shfl_xor(bon, 1); bon += __shfl_xor(bon, 2); bon += __shfl_xor(bon, 4);
            const float inv = __builtin_amdgcn_rsqf(fmaxf(nn, 1e-24f));
#pragma unroll
            for (int i = 0; i < 8; ++i) { const float kn = kk[i] * inv; al[i] = -kn; be[i] = av[i] * kn; XW[t * FP + d0 + i] = lw[i]; }
            if (dg == 0) ((float*)(a.ws + WS_BON2))[lr * 8 + h] = bon;
        }
        LBAR();
        {
            const int d = tid & 63, tb = tid >> 6; float p[8]; float run = 0.f;
#pragma unroll
            for (int i = 0; i < 8; ++i) { run += XW[(8 * tb + i) * FP + d]; p[i] = run; }
            TOT[tb * 64 + d] = run;
            LBAR();
            float off = 0.f;
#pragma unroll
            for (int j = 0; j < 8; ++j) off += (j < tb) ? TOT[j * 64 + d] : 0.f;
#pragma unroll
            for (int i = 0; i < 8; ++i) XW[(8 * tb + i) * FP + d] = off + p[i];
            if (tb == 7) BC[d] = off + run;
        }
        LBAR();
        {
            float at[8], rt[8], bh[8], kh[8];
#pragma unroll
            for (int i = 0; i < 8; ++i) { const float b = XW[t * FP + d0 + i], bc = BC[d0 + i];
                const float eb = __expf(b), enb = __expf(-b), ebp = __expf(b - lw[i]), ebc = __expf(bc - b);
                at[i] = al[i] * ebp; rt[i] = r[i] * eb; bh[i] = be[i] * enb; kh[i] = kq[i] * enb;
                BBT[SWC(d0 + i, t)] = (bf16)f2bf(be[i] * ebc); KBT[SWC(d0 + i, t)] = (bf16)f2bf(kq[i] * ebc); VT[SWC(d0 + i, t)] = (bf16)f2bf(v[i]); }
            *(v4u*)(AT + t * PITCH + d0) = pack8(at); *(v4u*)(RT + t * PITCH + d0) = pack8(rt); *(v4u*)(BH + t * PITCH + d0) = pack8(bh); *(v4u*)(KH + t * PITCH + d0) = pack8(kh);
        }
        asm volatile("" ::: "memory");
        if (unit + (int)gridDim.x < NUNIT) R1_ISSUE(unit + (int)gridDim.x);
        LBAR();
        {
            const int q = wave >> 1, mh = wave & 1;
            const bf16* As = (q < 2) ? AT : RT; const bf16* Bs = (q & 1) ? KH : BH;
#pragma unroll
            for (int t2 = 0; t2 < 2; ++t2) { const int tt = 2 * mh + t2; const int tcol = 16 * tt + c16;
#pragma unroll
                for (int jt = 0; jt < 4; ++jt) {
                    f32x4 acc = {0.f, 0.f, 0.f, 0.f};
                    if (jt <= tt) { acc = mma2(Bs + (16 * jt + c16) * PITCH + 8 * g, As + tcol * PITCH + 8 * g, acc);
#pragma unroll
                        for (int j = 0; j < 4; ++j) { const int jj = 16 * jt + 4 * g + j; const bool keep = (q < 2) ? (jj < tcol) : (jj <= tcol); if (!keep) acc[j] = 0.f; } }
                    if (q == 0) *(f32x4*)(AAB + tcol * FP + 16 * jt + 4 * g) = acc;
                    else { bf16* dst = (q == 1 ? AAK : (q == 2 ? ARB : ARK)); *(v2u*)(dst + tcol * PITCH + 16 * jt + 4 * g) = pack4(acc); }
                } }
        }
        LBAR();
        f32x4 Z[4];
        {
            if (wave == 0) { const int i = g; float Tc[16];
#pragma unroll
                for (int tr = 0; tr < 16; ++tr) { float s0 = (c16 == tr) ? 1.f : 0.f, s1 = 0.f, s2 = 0.f, s3 = 0.f; const float* ar = AAB + (16 * i + tr) * FP + 16 * i;
#pragma unroll
                    for (int j = 0; j < 16; j += 4) { if (j < tr) s0 += ar[j] * Tc[j]; if (j + 1 < tr) s1 += ar[j + 1] * Tc[j + 1]; if (j + 2 < tr) s2 += ar[j + 2] * Tc[j + 2]; if (j + 3 < tr) s3 += ar[j + 3] * Tc[j + 3]; }
                    const float sv = (s0 + s1) + (s2 + s3); Tc[tr] = sv; TII[(i * 16 + tr) * TP + c16] = sv; } }
            if (wave < 4) {
#pragma unroll
                for (int i = 0; i < 4; ++i)
#pragma unroll
                    for (int j = 0; j < 4; ++j) Z[i][j] = bf2f(AT[(16 * i + 4 * g + j) * PITCH + 16 * wave + c16]);
            } else {
#pragma unroll
                for (int i = 0; i < 4; ++i) { f32x4 acc = {0.f, 0.f, 0.f, 0.f}; const int er = 16 * (wave - 4) + c16; Z[i] = mma2s(AAK + (16 * i + c16) * PITCH, 0, VT + er * PITCH, SWK(er), g, acc); }
            }
        }
        LBAR();
        {
            f32x4 X[4];
#pragma unroll
            for (int i = 0; i < 4; ++i) { f32x4 z = Z[i];
#pragma unroll
                for (int kb = 0; kb < 4; ++kb) if (kb < i) { const f32x4 av = *(const f32x4*)(AAB + (16 * i + c16) * FP + 16 * kb + 4 * g);
#pragma unroll
                    for (int s = 0; s < 4; ++s) z = __builtin_amdgcn_mfma_f32_16x16x4f32(av[s], X[kb][s], z, 0, 0, 0); }
                const f32x4 tv = *(const f32x4*)(TII + (i * 16 + c16) * TP + 4 * g); f32x4 x = {0.f, 0.f, 0.f, 0.f};
#pragma unroll
                for (int s = 0; s < 4; ++s) x = __builtin_amdgcn_mfma_f32_16x16x4f32(tv[s], z[s], x, 0, 0, 0);
                X[i] = x; }
#pragma unroll
            for (int i = 0; i < 4; ++i) *(v2u*)(XT + (16 * wave + c16) * PITCH + 16 * i + 4 * g) = pack4(X[i]);
        }
        LBAR();
        {
            const int q = wave >> 1, hh = wave & 1;
            bf16* MCg = (bf16*)(a.ws + WS_MC) + (size_t)unit * 4096; float* NCg = (float*)(a.ws + WS_NC) + (size_t)unit * 4096;
            bf16* PPg = (bf16*)(a.ws + WS_PP) + (size_t)unit * 4096; bf16* Y0g = (bf16*)(a.ws + WS_Y0) + (size_t)unit * 4096;
#pragma unroll
            for (int t2 = 0; t2 < 2; ++t2) { const int ti = 2 * hh + t2;
#pragma unroll
                for (int tj = 0; tj < 4; ++tj) { f32x4 acc = {0.f, 0.f, 0.f, 0.f}; const int cc = 16 * tj + c16, rr = 16 * ti + 4 * g;
                    if (q == 0) { acc = mma2s(XT + (16 * ti + c16) * PITCH, 0, BBT + cc * PITCH, SWK(cc), g, acc); *(v2u*)(MCg + cc * 64 + (ti >> 1) * 32 + g * 8 + (ti & 1) * 4) = pack4(acc); }
                    else if (q == 1) { const int ar = 16 * ti + c16; acc = mma2s(BBT + ar * PITCH, SWK(ar), XT + (64 + cc) * PITCH, 0, g, acc); acc = mma2s(KBT + ar * PITCH, SWK(ar), VT + cc * PITCH, SWK(cc), g, acc);
                        *(f32x4*)(NCg + cc * 64 + rr) = acc; }
                    else if (q == 2) { acc = mma2(XT + (16 * ti + c16) * PITCH + 8 * g, ARB + cc * PITCH + 8 * g, acc);
                        const v2u rv = *(const v2u*)(RT + cc * PITCH + rr); acc[0] += bf2f(rv.x & 0xffffu); acc[1] += bf2f(rv.x >> 16); acc[2] += bf2f(rv.y & 0xffffu); acc[3] += bf2f(rv.y >> 16);
                        *(v2u*)(PPg + cc * 64 + rr) = pack4(acc); }
                    else { acc = mma2(XT + (64 + 16 * ti + c16) * PITCH + 8 * g, ARB + cc * PITCH + 8 * g, acc); { const int ar = 16 * ti + c16; acc = mma2s(VT + ar * PITCH, SWK(ar), ARK + cc * PITCH, 0, g, acc); }
                        *(v2u*)(Y0g + cc * 64 + rr) = pack4(acc); }
                } }
            if (tid < 64) ((float*)(a.ws + WS_DEC))[unit * 64 + tid] = __expf(BC[tid]);
        }
        LBAR();
    }
}

#define LAS3 __attribute__((address_space(3)))
constexpr int R2_SLOT = 12544, R2_NS = 10, R2_FLAGS = R2_SLOT * R2_NS;
__device__ __forceinline__ void r2_scan(CArgs& a, int chain, unsigned char* L, int tid) {
    asm volatile("" : "+v"(tid));
    const int lane = tid & 63, wave = __builtin_amdgcn_readfirstlane(tid >> 6);
    const int h = chain >> 2, e0 = 16 * (chain & 3), g = lane >> 4, c16 = lane & 15;
    volatile LAS3 unsigned* flg = (volatile LAS3 unsigned*)(LAS3 unsigned char*)(L + R2_FLAGS);
    if (tid < 32) flg[tid] = 0u;
    if (tid >= 64 && tid < 64 + R2_NS) *(volatile LAS3 unsigned*)(LAS3 unsigned char*)(L + (tid - 64) * R2_SLOT + 12288 + 252) = 0xffffffffu;
    __syncthreads();
    const bf16* MC = (const bf16*)(a.ws + WS_MC); const float* NC = (const float*)(a.ws + WS_NC); const float* DEC = (const float*)(a.ws + WS_DEC);
    if (wave != 0) {
        int mco[8], nco[4];
#pragma unroll
        for (int q = 0; q < 8; ++q) { const int pos = 64 * q + lane, row = pos >> 3, kc = (pos & 7) ^ (row & 7); mco[q] = row * 64 + kc * 8; }
#pragma unroll
        for (int q = 0; q < 4; ++q) { const int pos = 64 * q + lane, e = pos >> 4, dc = (pos & 15) ^ e; nco[q] = (e0 + e) * 64 + dc * 4; }
#pragma unroll 1
        for (int c = wave - 1; c < 128; c += 7) {
            while ((int)flg[16] < c - (R2_NS - 1)) __builtin_amdgcn_s_sleep(1);
            LAS3 unsigned char* slot = (LAS3 unsigned char*)(L + (c % R2_NS) * R2_SLOT);
            const size_t unit = (size_t)c * 8 + h;
#pragma unroll
            for (int q = 0; q < 8; ++q) __builtin_amdgcn_global_load_lds((const unsigned*)(MC + unit * 4096 + mco[q]), (LAS3 unsigned*)(slot + q * 1024), 16, 0, 0);
#pragma unroll
            for (int q = 0; q < 4; ++q) __builtin_amdgcn_global_load_lds((const unsigned*)(NC + unit * 4096 + nco[q]), (LAS3 unsigned*)(slot + 8192 + q * 1024), 16, 0, 0);
            __builtin_amdgcn_global_load_lds((const unsigned*)(DEC + unit * 64 + lane), (LAS3 unsigned*)(slot + 12288), 4, 0, 0);
        }
        asm volatile("s_waitcnt vmcnt(0)" ::: "memory");
    } else {
        bf16* S0 = (bf16*)(a.ws + WS_S0) + (size_t)h * 4096 + (e0 + c16) * 64 + 4 * g;
        f32x4 S[4];
#pragma unroll
        for (int m = 0; m < 4; ++m) S[m] = (f32x4){0.f, 0.f, 0.f, 0.f};
        int avail = 0;
        const LAS3 unsigned char* Lb = (const LAS3 unsigned char*)L;
        const int offA0 = (c16 * 8 + (g ^ (c16 & 7))) * 16, offA1 = (c16 * 8 + ((4 + g) ^ (c16 & 7))) * 16;
        int offN[4];
#pragma unroll
        for (int mt = 0; mt < 4; ++mt) offN[mt] = 8192 + (c16 * 16 + ((4 * mt + g) ^ c16)) * 16;
        const int offD = 12288 + 16 * g;
#define R2_MARKS(s_) (*(volatile LAS3 unsigned*)(LAS3 unsigned char*)(L + (s_) * R2_SLOT + 12288 + 252))
#define R2_WAITS(c_, s_) do { while (avail <= (c_)) { const unsigned f0_ = R2_MARKS(s_), f1_ = R2_MARKS(((s_) + 1) % R2_NS), f2_ = R2_MARKS(((s_) + 2) % R2_NS); \
            if (f0_ != 0xffffffffu) { avail = (c_) + 1; if (f1_ != 0xffffffffu) { avail = (c_) + 2; if (f2_ != 0xffffffffu) avail = (c_) + 3; } } \
            else __builtin_amdgcn_s_sleep(0); } asm volatile("" ::: "memory"); } while (0)
        v4u A[2][4][2]; f32x4 Nn[2][4], Dd[2][4];
#define R2_READS(s_, p_) do { _Pragma("unroll") for (int mt = 0; mt < 4; ++mt) { \
                A[p_][mt][0] = *(const LAS3 v4u*)(Lb + (s_) * R2_SLOT + mt * 2048 + offA0); A[p_][mt][1] = *(const LAS3 v4u*)(Lb + (s_) * R2_SLOT + mt * 2048 + offA1); \
                Nn[p_][mt] = *(const LAS3 f32x4*)(Lb + (s_) * R2_SLOT + offN[mt]); Dd[p_][mt] = *(const LAS3 f32x4*)(Lb + (s_) * R2_SLOT + mt * 64 + offD); } } while (0)
        R2_WAITS(0, 0); R2_READS(0, 0);
        asm volatile("s_waitcnt lgkmcnt(0)" ::: "memory");
#pragma unroll 1
        for (int c0 = 0; c0 < 128; c0 += R2_NS) {
#pragma unroll
            for (int k = 0; k < R2_NS; ++k) { const int c = c0 + k;
                if (c < 128) {
                    R2_MARKS(k) = 0xffffffffu; flg[16] = (unsigned)(c + 1);
                    if (c + 1 < 128) { R2_WAITS(c + 1, (k + 1) % R2_NS); R2_READS((k + 1) % R2_NS, (k + 1) & 1); }
                    bf16* sp = S0 + (size_t)c * (8 * 4096); v2u sb[4];
#pragma unroll
                    for (int m = 0; m < 4; ++m) { sb[m] = pack4(S[m]); *(v2u*)(sp + 16 * m) = sb[m]; }
                    const v4u b0 = {sb[0].x, sb[0].y, sb[1].x, sb[1].y}, b1 = {sb[2].x, sb[2].y, sb[3].x, sb[3].y};
                    const bf16x8 B0 = __builtin_bit_cast(bf16x8, b0), B1 = __builtin_bit_cast(bf16x8, b1);
                    f32x4 acc[4];
#pragma unroll
                    for (int mt = 0; mt < 4; ++mt) acc[mt] = __builtin_amdgcn_mfma_f32_16x16x32_bf16(__builtin_bit_cast(bf16x8, A[k & 1][mt][0]), B0, Nn[k & 1][mt] + S[mt] * Dd[k & 1][mt], 0, 0, 0);
#pragma unroll
                    for (int mt = 0; mt < 4; ++mt) S[mt] = __builtin_amdgcn_mfma_f32_16x16x32_bf16(__builtin_bit_cast(bf16x8, A[k & 1][mt][1]), B1, acc[mt], 0, 0, 0);
                    asm volatile("s_waitcnt lgkmcnt(0)" ::: "memory");
                } }
        }
#undef R2_WAITS
#undef R2_MARKS
#undef R2_READS
#define R2_READ 0
#undef R2_READ
    }
    __syncthreads();
}

__device__ __forceinline__ void r3_phase(CArgs& a, int l, int hb, int gw, int NGW, int lane) {
    asm volatile("" : "+v"(lane));
    const int g = lane >> 4, c16 = lane & 15;
    const bf16* U = (const bf16*)(a.ws + WS_U); const bf16* PP = (const bf16*)(a.ws + WS_PP); const bf16* S0 = (const bf16*)(a.ws + WS_S0); const bf16* Y0 = (const bf16*)(a.ws + WS_Y0);
    const float* BON = (const float*)(a.ws + WS_BON2); bf16* MG = (bf16*)(a.ws + WS_XN) + (size_t)hb * MH * D;
    const float* mu_v = a.in[6] + l * 1664 + 1024; const float* lnw = a.in[14] + l * 512; const float* lnb = a.in[15] + l * 512;
    const int erow = 16 * (c16 >> 2) + (c16 & 3);
#pragma unroll 1
    for (int task = gw; task < NUNIT * 4; task += NGW) {
        const int unit = task >> 2, mt = task & 3, ch = unit >> 3, h = unit & 7; const size_t ub = (size_t)unit * 4096;
        const int lr = 64 * ch + 16 * mt + c16; const bf16* urow = U + (size_t)lr * NPAD + 64 * h + 16 * g;
        float vc[16], vp[16], rgf[16];
        unpack8(*(const v4u*)(urow + C_V), vc); unpack8(*(const v4u*)(urow + C_V + 8), vc + 8); unpack8(*(const v4u*)(urow + C_RG), rgf); unpack8(*(const v4u*)(urow + C_RG + 8), rgf + 8);
        if (lr > 0) { unpack8(*(const v4u*)(urow + C_V - NPAD), vp); unpack8(*(const v4u*)(urow + C_V + 8 - NPAD), vp + 8); }
        else {
#pragma unroll
            for (int i = 0; i < 16; ++i) vp[i] = 0.f; }
        const float bon = BON[lr * 8 + h];
        const bf16* pr = PP + ub + (16 * mt + c16) * 64 + 8 * g;
        const bf16x8 B0 = *(const bf16x8*)pr, B1 = *(const bf16x8*)(pr + 32);
        f32x4 Y[4]; bf16x8 SA[4][2];
#pragma unroll
        for (int et = 0; et < 4; ++et) { const bf16* sr = S0 + ub + (erow + 4 * et) * 64 + 8 * g; SA[et][0] = *(const bf16x8*)sr; SA[et][1] = *(const bf16x8*)(sr + 32); }
        const bf16* y0p = Y0 + ub + (16 * mt + c16) * 64 + 16 * g; const v4u y0a = *(const v4u*)y0p, y0b = *(const v4u*)(y0p + 8);
        asm volatile("" ::: "memory");
        { float yf[16]; unpack8(y0a, yf); unpack8(y0b, yf + 8);
#pragma unroll
          for (int et = 0; et < 4; ++et) Y[et] = (f32x4){yf[4 * et], yf[4 * et + 1], yf[4 * et + 2], yf[4 * et + 3]}; }
#pragma unroll
        for (int et = 0; et < 4; ++et) { f32x4 acc = __builtin_amdgcn_mfma_f32_16x16x32_bf16(SA[et][0], B0, Y[et], 0, 0, 0);
            Y[et] = __builtin_amdgcn_mfma_f32_16x16x32_bf16(SA[et][1], B1, acc, 0, 0, 0); }
        const f32x4 sv = (Y[0] + Y[1]) + (Y[2] + Y[3]); float sm = (sv.x + sv.y) + (sv.z + sv.w); sm += __shfl_xor(sm, 16); sm += __shfl_xor(sm, 32);
        const float mean = sm * (1.f / 64.f); float q = 0.f;
#pragma unroll
        for (int et = 0; et < 4; ++et) { const f32x4 dd = Y[et] - mean; q += (dd.x * dd.x + dd.y * dd.y) + (dd.z * dd.z + dd.w * dd.w); }
        q += __shfl_xor(q, 16); q += __shfl_xor(q, 32);
        const float rstd = rsqrtf(q * (1.f / 64.f) + 64e-5f);
        const int cc = 64 * h + 16 * g; float o[16];
#pragma unroll
        for (int et = 0; et < 4; ++et) {
            const f32x4 w4 = *(const f32x4*)(lnw + cc + 4 * et), b4 = *(const f32x4*)(lnb + cc + 4 * et), m4 = *(const f32x4*)(mu_v + cc + 4 * et);
#pragma unroll
            for (int j = 0; j < 4; ++j) { const int i = 4 * et + j; const float vv = vc[i] + (vp[i] - vc[i]) * m4[j]; const float yn = (Y[et][j] - mean) * rstd * w4[j] + b4[j];
                o[i] = (yn + bon * vv) * rgf[i] * sigm(rgf[i]); } }
        bf16* op = MG + (size_t)lr * D + 512 + cc; *(v4u*)op = pack8(o); *(v4u*)(op + 8) = pack8(o + 8);
    }
}

constexpr int OFF_GQI = 17408, OFF_GKI = 26624, OFF_GKST = 35840, OFF_GVT = 45056, OFF_GSC = 63488, OFF_GTOT = 72704, OFF_GBC = 74752;
constexpr size_t WS_QI = 171 * MiB, WS_OI = 175 * MiB, WS_DS = 191 * MiB, WS_GDEC = 207 * MiB, WS_SP = 208 * MiB;
constexpr int NGUNIT = 512;

__device__ __forceinline__ void g1_phase(CArgs& a, int l, unsigned char* L, int tid0) {
    asm volatile("" : "+v"(tid0));
    const int wave = __builtin_amdgcn_readfirstlane(tid0 >> 6);
    const bf16* U = (const bf16*)(a.ws + WS_U);
    float* XW = (float*)L; bf16* QI = (bf16*)(L + OFF_GQI); bf16* KI = (bf16*)(L + OFF_GKI); bf16* KST = (bf16*)(L + OFF_GKST); bf16* VT = (bf16*)(L + OFF_GVT); bf16* SC = (bf16*)(L + OFF_GSC);
    float* TOT = (float*)(L + OFF_GTOT); float* BC = (float*)(L + OFF_GBC);
    float* GW = (float*)(L + OFF_GBC + 256);
    int hl = -1;
    v4u Gl0, Gl1, Gq, Gk, Gv0, Gv1;
#define G1_ISSUE(u_) do { const int lr_ = 64 * ((u_) >> 2) + (tid >> 3), h_ = (u_) & 3, dg_ = tid & 7; const bf16* ur_ = U + (size_t)lr_ * NPAD; \
        Gl0 = *(const v4u*)(ur_ + C_GLR); Gl1 = *(const v4u*)(ur_ + C_GLR + 8); Gq = *(const v4u*)(ur_ + C_GQ + 64 * h_ + 8 * dg_); Gk = *(const v4u*)(ur_ + C_GK + 64 * h_ + 8 * dg_); \
        Gv0 = *(const v4u*)(ur_ + C_GV + 128 * h_ + 16 * dg_); Gv1 = *(const v4u*)(ur_ + C_GV + 128 * h_ + 16 * dg_ + 8); } while (0)
#pragma unroll 1
    for (int unit = blockIdx.x; unit < NGUNIT; unit += gridDim.x) {
        int tid = tid0; asm volatile("" : "+v"(tid));
        const int lane = tid & 63, g = lane >> 4, c16 = lane & 15;
        const int ch = unit >> 2, h = unit & 3;
        if (h != hl) { hl = h; LBAR();
            for (int i = tid; i < 16 * 64; i += NTHR) GW[i] = a.in[3][l * 16 * 256 + (i >> 6) * 256 + 64 * h + (i & 63)];
            if (tid < 64) GW[1024 + tid] = a.in[4][l * 256 + 64 * h + tid];
            LBAR(); }
        const int t = tid >> 3, dg = tid & 7, d0 = 8 * dg, lr = 64 * ch + t, hc = 64 * h + d0;
        if (unit == (int)blockIdx.x) G1_ISSUE(unit);
        float q[8], k[8];
        {
            float glr[16]; unpack8(Gl0, glr); unpack8(Gl1, glr + 8);
            float x[8]; const float* gb = GW + 1024 + d0; const float* gu = GW + d0;
#pragma unroll
            for (int i = 0; i < 8; ++i) x[i] = gb[i];
#pragma unroll
            for (int r = 0; r < 16; ++r) { const f32x4 u0 = *(const f32x4*)(gu + r * 64), u1 = *(const f32x4*)(gu + r * 64 + 4);
                x[0] += glr[r] * u0.x; x[1] += glr[r] * u0.y; x[2] += glr[r] * u0.z; x[3] += glr[r] * u0.w; x[4] += glr[r] * u1.x; x[5] += glr[r] * u1.y; x[6] += glr[r] * u1.z; x[7] += glr[r] * u1.w; }
#pragma unroll
            for (int i = 0; i < 8; ++i) XW[t * FP + d0 + i] = (fminf(x[i], 0.f) - __logf(1.f + __expf(-fabsf(x[i])))) * (1.f / 16.f);
            unpack8(Gq, q); unpack8(Gk, k);
            float vv[16]; const int e0 = 16 * dg; unpack8(Gv0, vv); unpack8(Gv1, vv + 8);
            asm volatile("" ::: "memory");
            if (unit + (int)gridDim.x < NGUNIT) G1_ISSUE(unit + (int)gridDim.x);
#pragma unroll
            for (int i = 0; i < 16; ++i) VT[SWC(e0 + i, t)] = (bf16)f2bf(vv[i]);
        }
        LBAR();
        {
            const int d = tid & 63, tb = tid >> 6; float p[8]; float run = 0.f;
#pragma unroll
            for (int i = 0; i < 8; ++i) { run += XW[(8 * tb + i) * FP + d]; p[i] = run; }
            TOT[tb * 64 + d] = run;
            LBAR();
            float off = 0.f;
#pragma unroll
            for (int j = 0; j < 8; ++j) off += (j < tb) ? TOT[j * 64 + d] : 0.f;
#pragma unroll
            for (int i = 0; i < 8; ++i) XW[(8 * tb + i) * FP + d] = off + p[i];
            if (tb == 7) BC[d] = off + run;
        }
        LBAR();
        {
            float qi[8], ki[8];
#pragma unroll
            for (int i = 0; i < 8; ++i) { const float b = XW[t * FP + d0 + i], bc = BC[d0 + i];
                qi[i] = q[i] * 0.125f * __expf(b); ki[i] = k[i] * __expf(-b); KST[SWC(d0 + i, t)] = (bf16)f2bf(k[i] * __expf(bc - b)); }
            const v4u qp = pack8(qi);
            *(v4u*)(QI + t * PITCH + d0) = qp; *(v4u*)(KI + t * PITCH + d0) = pack8(ki);
            *(v4u*)((bf16*)(a.ws + WS_QI) + (size_t)unit * 4096 + t * 64 + d0) = qp;
        }
        LBAR();
        {
            const int tt = wave >> 1; const int tcol = 16 * tt + c16;
#pragma unroll
            for (int j2 = 0; j2 < 2; ++j2) { const int jt = 2 * (wave & 1) + j2; f32x4 acc = {0.f, 0.f, 0.f, 0.f};
                if (jt <= tt) { acc = mma2(KI + (16 * jt + c16) * PITCH + 8 * g, QI + tcol * PITCH + 8 * g, acc);
#pragma unroll
                    for (int j = 0; j < 4; ++j) if (16 * jt + 4 * g + j > tcol) acc[j] = 0.f; }
                *(v2u*)(SC + tcol * PITCH + 16 * jt + 4 * g) = pack4(acc); }
            bf16* DSg = (bf16*)(a.ws + WS_DS) + (size_t)unit * 8192;
#pragma unroll
            for (int i = 0; i < 4; ++i) { const int tile = wave * 4 + i, dt = tile & 3, et = tile >> 2; f32x4 acc = {0.f, 0.f, 0.f, 0.f};
                { const int ar = 16 * dt + c16, br = 16 * et + c16; acc = mma2s(KST + ar * PITCH, SWK(ar), VT + br * PITCH, SWK(br), g, acc); }
                *(v2u*)(DSg + (16 * et + c16) * 64 + 16 * dt + 4 * g) = pack4(acc); }
            if (tid < 64) ((float*)(a.ws + WS_GDEC))[unit * 64 + tid] = __expf(BC[tid]);
        }
        LBAR();
        {
            bf16* OIg = (bf16*)(a.ws + WS_OI) + (size_t)unit * 8192;
#pragma unroll
            for (int i = 0; i < 4; ++i) { const int tile = wave * 4 + i, tt = tile & 3, et = tile >> 2; f32x4 acc = {0.f, 0.f, 0.f, 0.f};
                { const int ar = 16 * et + c16; acc = mma2s(VT + ar * PITCH, SWK(ar), SC + (16 * tt + c16) * PITCH, 0, g, acc); }
                *(v2u*)(OIg + (16 * tt + c16) * 128 + 16 * et + 4 * g) = pack4(acc); }
        }
        LBAR();
    }
}

__device__ __forceinline__ void g2_scan(CArgs& a, int gid) {
    asm volatile("" : "+v"(gid));
    const int h = gid >> 13, ed = gid & 8191, d = gid & 63;
    const bf16* DS = (const bf16*)(a.ws + WS_DS); const float* GD = (const float*)(a.ws + WS_GDEC); bf16* SP = (bf16*)(a.ws + WS_SP);
    float S = 0.f;
#pragma unroll 1
    for (int cb = 0; cb < 128; cb += 16) {
        float ds[16], dc[16];
#pragma unroll
        for (int i = 0; i < 16; ++i) { const size_t unit = (size_t)(cb + i) * 4 + h; ds[i] = bf2f(DS[unit * 8192 + ed]); dc[i] = GD[unit * 64 + d]; }
#pragma unroll
        for (int i = 0; i < 16; ++i) { const size_t unit = (size_t)(cb + i) * 4 + h; SP[unit * 8192 + ed] = (bf16)f2bf(S); S = S * dc[i] + ds[i]; }
    }
}

__device__ __forceinline__ void g3_phase(CArgs& a, int l, int hb, int gw, int NGW, int lane) {
    asm volatile("" : "+v"(lane));
    const int g = lane >> 4, c16 = lane & 15;
    const bf16* U = (const bf16*)(a.ws + WS_U); const bf16* QI = (const bf16*)(a.ws + WS_QI); const bf16* SP = (const bf16*)(a.ws + WS_SP); const bf16* OI = (const bf16*)(a.ws + WS_OI);
    bf16* MG = (bf16*)(a.ws + WS_XN) + (size_t)hb * MH * D; const float* gnw = a.in[5] + l * 128;
    const int erow = 32 * (c16 >> 2) + (c16 & 3);
#pragma unroll 1
    for (int task = gw; task < NGUNIT * 4; task += NGW) {
        const int unit = task >> 2, mt = task & 3, ch = unit >> 2, h = unit & 3;
        const int lr = 64 * ch + 16 * mt + c16; const bf16* urow = U + (size_t)lr * NPAD + C_GG + 128 * h + 32 * g;
        const v4u gg0 = *(const v4u*)urow, gg1 = *(const v4u*)(urow + 8), gg2 = *(const v4u*)(urow + 16), gg3 = *(const v4u*)(urow + 24);
        const bf16* qr = QI + (size_t)unit * 4096 + (16 * mt + c16) * 64 + 8 * g;
        const bf16x8 B0 = *(const bf16x8*)qr, B1 = *(const bf16x8*)(qr + 32);
        f32x4 O[8]; float ss = 0.f; bf16x8 SA[8][2];
#pragma unroll
        for (int et = 0; et < 8; ++et) { const bf16* sr = SP + (size_t)unit * 8192 + (erow + 4 * et) * 64 + 8 * g; SA[et][0] = *(const bf16x8*)sr; SA[et][1] = *(const bf16x8*)(sr + 32); }
        const bf16* oip = OI + (size_t)unit * 8192 + (16 * mt + c16) * 128 + 32 * g; const v4u oi0 = *(const v4u*)oip, oi1 = *(const v4u*)(oip + 8), oi2 = *(const v4u*)(oip + 16), oi3 = *(const v4u*)(oip + 24);
        asm volatile("" ::: "memory");
        { float of[32]; unpack8(oi0, of); unpack8(oi1, of + 8); unpack8(oi2, of + 16); unpack8(oi3, of + 24);
#pragma unroll
          for (int et = 0; et < 8; ++et) O[et] = (f32x4){of[4 * et], of[4 * et + 1], of[4 * et + 2], of[4 * et + 3]}; }
#pragma unroll
        for (int et = 0; et < 8; ++et) { f32x4 acc = __builtin_amdgcn_mfma_f32_16x16x32_bf16(SA[et][0], B0, O[et], 0, 0, 0);
            acc = __builtin_amdgcn_mfma_f32_16x16x32_bf16(SA[et][1], B1, acc, 0, 0, 0);
            O[et] = acc; ss += (acc.x * acc.x + acc.y * acc.y) + (acc.z * acc.z + acc.w * acc.w); }
        ss += __shfl_xor(ss, 16); ss += __shfl_xor(ss, 32);
        const float rstd = rsqrtf(ss * (1.f / 128.f) + 1e-6f);
        float gf[32], o[32]; unpack8(gg0, gf); unpack8(gg1, gf + 8); unpack8(gg2, gf + 16); unpack8(gg3, gf + 24);
#pragma unroll
        for (int et = 0; et < 8; ++et) { const f32x4 w4 = *(const f32x4*)(gnw + 32 * g + 4 * et);
#pragma unroll
            for (int j = 0; j < 4; ++j) { const int i = 4 * et + j; o[i] = O[et][j] * rstd * w4[j] * gf[i] * sigm(gf[i]); } }
        bf16* op = MG + (size_t)lr * D + 128 * h + 32 * g;
        *(v4u*)op = pack8(o); *(v4u*)(op + 8) = pack8(o + 8); *(v4u*)(op + 16) = pack8(o + 16); *(v4u*)(op + 24) = pack8(o + 24);
    }
}

#define LAS __attribute__((address_space(3)))
#define XB_TMO      128
#define XB_XCNT(j)  (256  + 64 * (j))
#define XB_XSUB(j)  (1280 + 64 * (j))
#define XB_XGEN(j)  (2304 + 64 * (j))
#define XB_TOP      3328
#define XB_TOPGEN   3392
#define XCD_BAR_WORDS 3456
#define XB_SPIN_CAP (1u << 18)

__device__ __forceinline__ unsigned xb_ld(unsigned* p)              { return __hip_atomic_load(p, __ATOMIC_RELAXED, __HIP_MEMORY_SCOPE_AGENT); }
__device__ __forceinline__ unsigned xb_add(unsigned* p, unsigned v) { return __hip_atomic_fetch_add(p, v, __ATOMIC_RELAXED, __HIP_MEMORY_SCOPE_AGENT); }
__device__ __forceinline__ unsigned xb_xcc_id() { return (unsigned)__builtin_amdgcn_s_getreg((3 << 11) | 20) & 0xFu; }
#define XB_SPIN(cond, bar) do { unsigned _sp = 0; while (cond) { __builtin_amdgcn_s_sleep(1); \
    if ((++_sp & 255u) == 0u) { if (xb_ld(&(bar)[XB_TMO])) break; if (_sp > XB_SPIN_CAP) { atomicAdd(&(bar)[XB_TMO], 1u); break; } } } } while (0)

struct XcdBarrier {
    unsigned* bar; unsigned x;
    volatile LAS unsigned* st;
};

__device__ __forceinline__ XcdBarrier xcd_barrier_post(unsigned* bar, volatile LAS unsigned* st) {
    XcdBarrier b; b.bar = bar; b.x = xb_xcc_id(); b.st = st;
    if (threadIdx.x == 0) (void)xb_add(&bar[XB_XCNT(b.x)], 1u);
    return b;
}
__device__ __forceinline__ void xcd_barrier_complete(unsigned* bar, unsigned x, unsigned& nloc, unsigned& nx) {
    const unsigned G = gridDim.x * gridDim.y * gridDim.z;
    unsigned sum, cnt, mine, sp = 0u;
    for (;;) {
        sum = 0u; cnt = 0u; mine = 0u;
#pragma unroll
        for (unsigned j = 0; j < 16; ++j) { const unsigned c = xb_ld(&bar[XB_XCNT(j)]); sum += c; cnt += (c > 0u) ? 1u : 0u; mine = (j == x) ? c : mine; }
        if (sum == G) break;
        __builtin_amdgcn_s_sleep(1);
        if ((++sp & 255u) == 0u) { if (xb_ld(&bar[XB_TMO])) break; if (sp > XB_SPIN_CAP) { atomicAdd(&bar[XB_TMO], 1u); break; } }
    }
    nloc = mine > 0u ? mine : 1u; nx = cnt > 0u ? cnt : 1u;
}

__device__ __forceinline__ void xcd_barrier(const XcdBarrier& b) {
    asm volatile("s_waitcnt vmcnt(0)" ::: "memory");
    __syncthreads();
    if (threadIdx.x == 0) {
        unsigned* bar = b.bar;
        __builtin_amdgcn_s_waitcnt(0);
        unsigned nloc = b.st[0], nx = b.st[1];
        if (nloc == 0u) { xcd_barrier_complete(bar, b.x, nloc, nx); b.st[0] = nloc; b.st[1] = nx; }
        const unsigned old = xb_add(&bar[XB_XSUB(b.x)], 1u);
        const unsigned gen = old / nloc;
        if (old + 1u == (gen + 1u) * nloc) {
            __builtin_amdgcn_fence(__ATOMIC_RELEASE, "agent");
            asm volatile("s_waitcnt vmcnt(0)" ::: "memory");
            const unsigned og = xb_add(&bar[XB_TOP], 1u);
            const unsigned tg = og / nx;
            if (og + 1u == (tg + 1u) * nx) xb_add(&bar[XB_TOPGEN], 1u);
            else XB_SPIN(xb_ld(&bar[XB_TOPGEN]) == tg, bar);
            __builtin_amdgcn_fence(__ATOMIC_ACQUIRE, "agent");
            xb_add(&bar[XB_XGEN(b.x)], 1u);
            asm volatile("s_waitcnt vmcnt(0)" ::: "memory");
        } else {
            XB_SPIN(xb_ld(&bar[XB_XGEN(b.x)]) == gen, bar);
            __builtin_amdgcn_fence(__ATOMIC_ACQUIRE, "agent");
            asm volatile("s_waitcnt vmcnt(0)" ::: "memory");
        }
    }
    __syncthreads();
}


__global__ void __launch_bounds__(NTHR, 2) hymba_fwd(Args a_kernarg) {
    extern __shared__ __attribute__((aligned(16))) unsigned char lds[];
    cg::grid_group grid = cg::this_grid();
    const int tid = threadIdx.x, lane = tid & 63, wave = __builtin_amdgcn_readfirstlane(tid >> 6);
    const int G = gridDim.x, gw = blockIdx.x * NWAVES + wave, NGW = G * NWAVES;
    volatile LAS unsigned* xst = (volatile LAS unsigned*)(LAS unsigned char*)(lds + LDS_BYTES - 64);
    if (tid < 2) xst[tid] = 0u;
    __syncthreads();
    const XcdBarrier xbar = xcd_barrier_post((unsigned*)AA.ws, xst);
    {
        CArgs& a = AA; bf16* XN = (bf16*)(a.ws + WS_XN);
        float* scr = (float*)lds;
        constexpr int T_IN = (D / 64) * (NPAD / 64), T_OUT = (D / 64) * (D / 64);
        for (int l = 0; l < 2; ++l) {
            transpose_tiles(a.in[2] + (size_t)l * D * NIN, D, NIN, NPAD, (bf16*)(a.ws + WS_WIN + l * WIN_BYTES), scr, (int)blockIdx.x, G, T_IN, tid);
            transpose_tiles(a.in[16] + (size_t)l * D * D, D, D, D, (bf16*)(a.ws + WS_WOUT + l * WOUT_BYTES), scr, (int)blockIdx.x, G, T_OUT, tid);
        }
        for (int m = 2 * gw; m < M; m += 2 * NGW) rms_row2(a.in[0] + (size_t)m * D, a.in[0] + (size_t)(m + 1) * D, a.in[1], XN + (size_t)m * D, XN + (size_t)(m + 1) * D, lane);
        {
            bf16* UPT = (bf16*)(a.ws + WS_UPT);
            for (int e = blockIdx.x * NTHR + tid; e < 2 * 2 * 512 * 64; e += G * NTHR) { const int r = e & 63, c = (e >> 6) & 511, q = (e >> 15) & 1, ll = e >> 16;
                UPT[e] = (bf16)f2bf((q ? a.in[10] : a.in[8])[(size_t)ll * 64 * 512 + r * 512 + c]); }
        }
    }
    grid.sync();
    for (int l = 0; l < 2; ++l) {
        for (int hb = 0; hb < 2; ++hb) {
            {
                CArgs& a = AA; bf16* XN = (bf16*)(a.ws + WS_XN); bf16* U = (bf16*)(a.ws + WS_U);
                pg8::Gemm g{XN + (size_t)hb * MH * D, (const bf16*)(a.ws + WS_WIN + l * WIN_BYTES), MH, NPAD, D}; pg8::StaticOrder S; S.init(MH, NPAD, G, (int)blockIdx.x);
                pg8::EpiBf16<0> E{U, NPAD, nullptr, 0, 0, 1.f};
                pg8::gemm_phase<pg8::EpiBf16<0>, pg8::StaticOrder, true, true>((PG8_LAS unsigned char*)lds, g, S, E);
            }
            xcd_barrier(xbar);
            r1_phase(AA, l, lds, tid);
            g1_phase(AA, l, lds, tid);
            xcd_barrier(xbar);
            if (blockIdx.x < 32) r2_scan(AA, blockIdx.x, lds, tid);
            else if (blockIdx.x < 96) g2_scan(AA, (blockIdx.x - 32) * NTHR + tid);
            xcd_barrier(xbar);
            r3_phase(AA, l, hb, gw, NGW, lane);
            g3_phase(AA, l, hb, gw, NGW, lane);
            xcd_barrier(xbar);
        }
        {
            CArgs& a = AA; bf16* XN = (bf16*)(a.ws + WS_XN);
            pg8::Gemm g{XN, (const bf16*)(a.ws + WS_WOUT + l * WOUT_BYTES), M, D, D}; pg8::StaticOrder S; S.init(M, D, G, (int)blockIdx.x);
            pg8::EpiRmsRes E{l == 0 ? a.in[0] : a.out, a.out, XN, l == 0 ? a.in[1] + D : a.in[17], (float*)(a.ws + WS_SLOTS) + (size_t)l * M * 4, (unsigned*)(a.ws + 16384) + l * 64 * 64, D, l};
            pg8::gemm_phase<pg8::EpiRmsRes, pg8::StaticOrder, false, true>((PG8_LAS unsigned char*)lds, g, S, E);
        }
        if (l == 0) xcd_barrier(xbar);
    }
}

extern "C" void kernel_launch(void* const* d_in, const int* in_sizes, int n_in, void* d_out, int out_size, void* d_ws, size_t ws_size, hipStream_t stream) {
    static int grid = 0;
    if (grid == 0) {
        if (n_in != 18 || out_size != M * D || ws_size < WS_END) { fprintf(stderr, "kernel_launch: unexpected shapes n_in %d out %d ws %zu\n", n_in, out_size, ws_size); grid = -1; return; }
        int dev = 0, cus = 0, per_cu = 0;
        hipGetDevice(&dev); hipDeviceGetAttribute(&cus, hipDeviceAttributeMultiprocessorCount, dev);
        if (hipFuncSetAttribute((const void*)hymba_fwd, hipFuncAttributeMaxDynamicSharedMemorySize, LDS_BYTES) != hipSuccess) { fprintf(stderr, "kernel_launch: hipFuncSetAttribute failed\n"); grid = -1; return; }
        if (hipOccupancyMaxActiveBlocksPerMultiprocessor(&per_cu, (const void*)hymba_fwd, NTHR, LDS_BYTES) != hipSuccess || per_cu < 1) { fprintf(stderr, "kernel_launch: occupancy query failed (%d)\n", per_cu); grid = -1; return; }
        grid = cus * 1;
        fprintf(stderr, "kernel_launch: cus %d per_cu %d grid %d\n", cus, per_cu, grid);
    }
    if (grid < 0) return;
    if (hipMemsetAsync(d_ws, 0, 65536, stream) != hipSuccess) { fprintf(stderr, "kernel_launch: memset failed\n"); return; }
    Args a{};
    for (int i = 0; i < 18; ++i) a.in[i] = (const float*)d_in[i];
    a.out = (float*)d_out; a.ws = (unsigned char*)d_ws;
    void* args[] = {&a};
    hipError_t e = hipLaunchCooperativeKernel((const void*)hymba_fwd, dim3(grid), dim3(NTHR), args, LDS_BYTES, stream);
    if (e != hipSuccess) fprintf(stderr, "cooperative launch failed: %s (grid %d)\n", hipGetErrorString(e), grid);
}
```

```cpp
#include <hip/hip_runtime.h>
#include <hip/hip_cooperative_groups.h>
#include <cstdio>
#include <cstdint>
namespace cg = cooperative_groups;
namespace pg8 {
#define PG8_LAS __attribute__((address_space(3)))
typedef unsigned short bf16_t;
typedef short bf16x8 __attribute__((ext_vector_type(8)));
typedef float f32x4 __attribute__((ext_vector_type(4)));
typedef unsigned u32x4 __attribute__((ext_vector_type(4)));
constexpr int BM = 256, BK = 64, HALF = 128, HTB = HALF * BK * 2  , STAGE_BYTES = 8 * HTB, NXCD = 8, WGM = 8;

__host__ __device__ __forceinline__ int lds_byte(int r, int c) { const int st = (r >> 4) * 2 + (c >> 5), rr = r & 15, cc = c & 31, ob = rr * 64 + cc * 2; return st * 1024 + (ob ^ (((ob >> 9) & 1) << 5)); }
__host__ __device__ __forceinline__ void stage_rc(int b, int& R, int& C) { const int st = b / 1024, sb = b % 1024, swz = sb ^ (((sb >> 9) & 1) << 5); R = (st >> 1) * 16 + swz / 64; C = (st & 1) * 32 + (swz % 64) / 2; }
__host__ __device__ __forceinline__ int perm32(int rho) { const int n = rho >> 4, i = rho & 15; return 8 * (i >> 2) + 4 * n + (i & 3); }

struct Unit { int pm, pn; };
struct Gemm { const bf16_t* A; const bf16_t* Bt; int M, N, K; };

struct StaticOrder {
    int nM, nN, nwg, G, c;
    __host__ __device__ void init(int M, int N, int G_, int c_) { nM = M / BM; nN = N / BM; nwg = nM * nN; G = G_; c = c_; }
    __host__ __device__ bool next(int i, Unit& u) const {
        const long L = (long)i * G + c; if (L >= nwg) return false;
        int wgid = (int)L; { const int q = nwg / NXCD, r = nwg % NXCD, xcd = wgid % NXCD, off = wgid / NXCD; wgid = (xcd < r ? xcd * (q + 1) : r * (q + 1) + (xcd - r) * q) + off; }
        const int nig = WGM * nN, gid = wgid / nig, fm = gid * WGM, gsz = (nM - fm) < WGM ? (nM - fm) : WGM;
        u.pm = fm + ((wgid % nig) % gsz); u.pn = (wgid % nig) / gsz; return true;
    }
    __device__ __forceinline__ void a_ready(const Unit&) const {}
    __device__ __forceinline__ void done(const Unit&) const {}
};

__device__ __forceinline__ unsigned cvt_pk_bf16(float lo, float hi) { unsigned r; asm volatile("v_cvt_pk_bf16_f32 %0, %1, %2" : "=v"(r) : "v"(lo), "v"(hi)); return r; }
typedef float f32x2 __attribute__((ext_vector_type(2)));
__device__ __forceinline__ f32x2 gelu_pk(f32x2 v) {
    const f32x2 av = __builtin_elementwise_abs(v), d = av * 0.2316418882f + 1.0f;
    f32x2 t; t.x = __builtin_amdgcn_rcpf(d.x); t.y = __builtin_amdgcn_rcpf(d.y);
    f32x2 q = t * 0.5307027145f + (-0.7265760135f); q = q * t + 0.7107068705f; q = q * t + (-0.142248368f); q = q * t + 0.127414796f; q = q * t;
    const f32x2 s = (v * v) * (-0.72134752044f);
    f32x2 e; e.x = __builtin_amdgcn_exp2f(s.x); e.y = __builtin_amdgcn_exp2f(s.y);
    const f32x2 m = v * (q * e), r = v - m;
    f32x2 o; o.x = v.x < 0.f ? m.x : r.x; o.y = v.y < 0.f ? m.y : r.y; return o;
}

template <int ACT  > struct EpiBf16 {
    static constexpr bool PERM = true, AFTER_DRAIN = false; static_assert(ACT == 0 || ACT == 1, "EpiBf16: ACT is 0 (none) or 1 (gelu_pk)");
    bf16_t* O; int ldc; const float* bias; int split_cols; size_t split_stride; float scale0;
    __device__ __forceinline__ void operator()(const f32x4 (&acc)[2][2][4][2], const Unit& u, int wr, int wc, int fr, int fq) const {
        const int row0 = u.pm * BM + wr * 64 + fr; int colt = u.pn * BM; bf16_t* base = O;
        float sc = 1.f; if (split_cols) { const int t = colt / split_cols; base += (size_t)t * split_stride; colt -= t * split_cols; if (t == 0) sc = scale0; }
        const int col0 = colt + wc * 32 + 8 * fq, bcol0 = u.pn * BM + wc * 32 + 8 * fq;
        f32x4 bv[2][2];
#pragma unroll
        for (int bj = 0; bj < 2; ++bj)
#pragma unroll
            for (int n = 0; n < 2; ++n) bv[bj][n] = bias ? *(const f32x4*)(bias + bcol0 + bj * HALF + 4 * n) : (f32x4){0.f, 0.f, 0.f, 0.f};
#pragma unroll
        for (int ai = 0; ai < 2; ++ai)
#pragma unroll
            for (int m = 0; m < 4; ++m) { bf16_t* rowp = base + (size_t)(row0 + ai * HALF + m * 16) * ldc + col0;
#pragma unroll
                for (int bj = 0; bj < 2; ++bj) { f32x4 v0 = acc[ai][bj][m][0] + bv[bj][0], v1 = acc[ai][bj][m][1] + bv[bj][1];
                    if (ACT == 1) { f32x2 a = gelu_pk((f32x2){v0[0], v0[1]}), b = gelu_pk((f32x2){v0[2], v0[3]}), c = gelu_pk((f32x2){v1[0], v1[1]}), d = gelu_pk((f32x2){v1[2], v1[3]});
                        v0 = (f32x4){a.x, a.y, b.x, b.y}; v1 = (f32x4){c.x, c.y, d.x, d.y}; }
                    v0 = v0 * sc; v1 = v1 * sc; u32x4 w; w.x = cvt_pk_bf16(v0[0], v0[1]); w.y = cvt_pk_bf16(v0[2], v0[3]); w.z = cvt_pk_bf16(v1[0], v1[1]); w.w = cvt_pk_bf16(v1[2], v1[3]);
                    *(u32x4*)(rowp + bj * HALF) = w; } }
    }
};

template <class Epi, class Sched, bool ALIGN_EPI = false, bool SP2 = false>
__device__ __forceinline__ void gemm_phase(PG8_LAS unsigned char* lds, const Gemm g, const Sched& S, const Epi& E) {
    int tid_ = threadIdx.x; asm volatile("" : "+v"(tid_));
    const int tid = tid_, wid = __builtin_amdgcn_readfirstlane(tid >> 6), lane = tid & 63, wr = wid >> 2, wc = wid & 3, fr = lane & 15, fq = lane >> 4;
    const int K = g.K, nt = K / BK;
    unsigned voffA[2], voffB[2];
#pragma unroll
    for (int i = 0; i < 2; ++i) { int R, C; stage_rc(tid * 16 + i * 8192, R, C); const int Rb = Epi::PERM ? ((R & ~31) + perm32(R & 31)) : R;
        voffA[i] = (unsigned)(R * K + C) * 2u; voffB[i] = (unsigned)(Rb * K + C) * 2u; }
    const size_t kstep = (size_t)(BK * 2);
    const size_t hstep = (size_t)HALF * K * 2;
    const size_t tstep = 2 * hstep;
    const unsigned ldsw = (unsigned)wid * 1024u;
    const int aoff = lds_byte(wr * 64 + fr, fq * 8), boff = lds_byte(wc * 32 + fr, fq * 8);
#define PG8_SA(b, h) (((b) * 2 + (h)) * HTB)
#define PG8_SB(b, h) ((4 + (b) * 2 + (h)) * HTB)
#define PG8_STAGE(bufoff, gbase, voff) do { _Pragma("unroll") for (int _i = 0; _i < 2; ++_i) \
        __builtin_amdgcn_global_load_lds((const unsigned*)((const char*)(gbase) + (voff)[_i]), (PG8_LAS unsigned*)(lds + (bufoff) + ldsw + _i * 8192), 16, 0, 0); } while (0)
#define PG8_LDA(dst, b, h) do { _Pragma("unroll") for (int m = 0; m < 4; ++m) _Pragma("unroll") for (int k = 0; k < 2; ++k) dst[m][k] = *(const PG8_LAS bf16x8*)(lds + PG8_SA(b, h) + aoff + m * 2048 + k * 1024); } while (0)
#define PG8_LDB(dst, b, h) do { _Pragma("unroll") for (int n = 0; n < 2; ++n) _Pragma("unroll") for (int k = 0; k < 2; ++k) dst[n][k] = *(const PG8_LAS bf16x8*)(lds + PG8_SB(b, h) + boff + n * 2048 + k * 1024); } while (0)
#define PG8_MMA(ai, bj, At, Bt) do { __builtin_amdgcn_s_setprio(1); _Pragma("unroll") for (int m = 0; m < 4; ++m) _Pragma("unroll") for (int n = 0; n < 2; ++n) _Pragma("unroll") for (int k = 0; k < 2; ++k) \
        acc[ai][bj][m][n] = __builtin_amdgcn_mfma_f32_16x16x32_bf16(Bt[n][k], At[m][k], acc[ai][bj][m][n], 0, 0, 0); __builtin_amdgcn_s_setprio(0); } while (0)
#define PG8_WAIT_V(n) asm volatile("s_waitcnt vmcnt(" #n ")" ::: "memory")
#define PG8_WAIT_L(n) asm volatile("s_waitcnt lgkmcnt(" #n ")" ::: "memory")
#define PG8_BAR __builtin_amdgcn_s_barrier()
#define PG8_SCHED __builtin_amdgcn_sched_barrier(0)
    Unit cur, nxt; int ui = 0;
    if (!S.next(0, cur)) return;
    f32x4 acc[2][2][4][2];
#pragma unroll
    for (int a = 0; a < 2; ++a)
#pragma unroll
        for (int b = 0; b < 2; ++b)
#pragma unroll
            for (int m = 0; m < 4; ++m)
#pragma unroll
                for (int n = 0; n < 2; ++n) acc[a][b][m][n] = (f32x4){0.f, 0.f, 0.f, 0.f};
    bf16x8 At[4][2], B0[2][2], B1[2][2];
    const char* cA = (const char*)g.A + (size_t)cur.pm * tstep; const char* cB = (const char*)g.Bt + (size_t)cur.pn * tstep;
    S.a_ready(cur);
    if constexpr (SP2) {
        PG8_STAGE(PG8_SB(0, 0), cB, voffB); PG8_STAGE(PG8_SB(0, 1), cB + hstep, voffB); PG8_STAGE(PG8_SA(0, 0), cA, voffA); PG8_STAGE(PG8_SA(0, 1), cA + hstep, voffA);
        if (wr == 1) PG8_BAR;
        PG8_WAIT_V(2); PG8_BAR;
        PG8_STAGE(PG8_SB(1, 0), cB + kstep, voffB); PG8_STAGE(PG8_SA(1, 0), cA + kstep, voffA); PG8_STAGE(PG8_SB(1, 1), cB + hstep + kstep, voffB);
        PG8_WAIT_V(6); PG8_BAR;
    } else {
        PG8_STAGE(PG8_SB(0, 0), cB, voffB); PG8_STAGE(PG8_SA(0, 0), cA, voffA); PG8_STAGE(PG8_SB(0, 1), cB + hstep, voffB); PG8_STAGE(PG8_SA(0, 1), cA + hstep, voffA);
        if (wr == 1) PG8_BAR;
        PG8_WAIT_V(4); PG8_BAR;
        PG8_STAGE(PG8_SB(1, 0), cB + kstep, voffB); PG8_STAGE(PG8_SA(1, 0), cA + kstep, voffA); PG8_STAGE(PG8_SB(1, 1), cB + hstep + kstep, voffB);
        PG8_WAIT_V(6); PG8_BAR;
    }
    for (;;) {
        const bool has_next = S.next(ui + 1, nxt);
        const char* nA = has_next ? (const char*)g.A + (size_t)nxt.pm * tstep : cA; const char* nB = has_next ? (const char*)g.Bt + (size_t)nxt.pn * tstep : cB;
        for (int t = 0; t < nt; t += 2) {
            const bool last = (t == nt - 2);
            const char* a1 = cA + (size_t)(t + 1) * kstep;
            const char* a2 = last ? nA : cA + (size_t)(t + 2) * kstep; const char* b2 = last ? nB : cB + (size_t)(t + 2) * kstep;
            const char* a3 = a2 + kstep; const char* b3 = b2 + kstep;
            if (last && has_next) S.a_ready(nxt);
            if constexpr (SP2) {
            PG8_LDB(B0, 0, 0); PG8_LDB(B1, 0, 1); PG8_SCHED; PG8_LDA(At, 0, 0); PG8_STAGE(PG8_SA(1, 1), a1 + hstep, voffA);
            PG8_WAIT_V(8); PG8_WAIT_L(0); PG8_BAR; PG8_MMA(0, 0, At, B0); PG8_MMA(0, 1, At, B1); PG8_BAR; PG8_SCHED;
            PG8_LDA(At, 0, 1); PG8_STAGE(PG8_SB(0, 0), b2, voffB); PG8_STAGE(PG8_SB(0, 1), b2 + hstep, voffB); PG8_STAGE(PG8_SA(0, 0), a2, voffA);
            PG8_WAIT_V(8); PG8_WAIT_L(0); PG8_BAR; PG8_MMA(1, 0, At, B0); PG8_MMA(1, 1, At, B1); PG8_BAR; PG8_SCHED;
            PG8_LDB(B0, 1, 0); PG8_LDB(B1, 1, 1); PG8_SCHED; PG8_LDA(At, 1, 0); PG8_STAGE(PG8_SA(0, 1), a2 + hstep, voffA);
            PG8_WAIT_V(8); PG8_WAIT_L(0); PG8_BAR; PG8_MMA(0, 0, At, B0); PG8_MMA(0, 1, At, B1); PG8_BAR; PG8_SCHED;
            PG8_LDA(At, 1, 1); PG8_STAGE(PG8_SB(1, 0), b3, voffB); PG8_STAGE(PG8_SB(1, 1), b3 + hstep, voffB); PG8_STAGE(PG8_SA(1, 0), a3, voffA);
            PG8_WAIT_V(8); PG8_WAIT_L(0); PG8_BAR; PG8_MMA(1, 0, At, B0); PG8_MMA(1, 1, At, B1); PG8_BAR; PG8_SCHED;
            } else {
            PG8_LDB(B0, 0, 0); PG8_SCHED; PG8_LDA(At, 0, 0); PG8_STAGE(PG8_SA(1, 1), a1 + hstep, voffA);
            PG8_WAIT_L(8); PG8_BAR; PG8_WAIT_L(0); PG8_MMA(0, 0, At, B0); PG8_BAR; PG8_SCHED;
            PG8_LDB(B1, 0, 1); PG8_STAGE(PG8_SB(0, 0), b2, voffB);
            PG8_BAR; PG8_WAIT_L(0); PG8_MMA(0, 1, At, B1); PG8_BAR;
            PG8_LDA(At, 0, 1); PG8_STAGE(PG8_SA(0, 0), a2, voffA);
            PG8_BAR; PG8_WAIT_L(0); PG8_MMA(1, 0, At, B0); PG8_BAR; PG8_SCHED;
            PG8_STAGE(PG8_SB(0, 1), b2 + hstep, voffB);
            PG8_WAIT_V(6); PG8_BAR; PG8_MMA(1, 1, At, B1); PG8_BAR;
            PG8_LDB(B0, 1, 0); PG8_SCHED; PG8_LDA(At, 1, 0); PG8_STAGE(PG8_SA(0, 1), a2 + hstep, voffA);
            PG8_WAIT_L(8); PG8_BAR; PG8_WAIT_L(0); PG8_MMA(0, 0, At, B0); PG8_BAR; PG8_SCHED;
            PG8_LDB(B1, 1, 1); PG8_STAGE(PG8_SB(1, 0), b3, voffB);
            PG8_BAR; PG8_WAIT_L(0); PG8_MMA(0, 1, At, B1); PG8_BAR;
            PG8_LDA(At, 1, 1); PG8_STAGE(PG8_SA(1, 0), a3, voffA);
            PG8_BAR; PG8_WAIT_L(0); PG8_MMA(1, 0, At, B0); PG8_BAR; PG8_SCHED;
            PG8_STAGE(PG8_SB(1, 1), b3 + hstep, voffB);
            PG8_WAIT_V(6); PG8_BAR; PG8_MMA(1, 1, At, B1); PG8_BAR;
            }
        }
        if constexpr (ALIGN_EPI) { if (wr == 0) PG8_BAR; }
        if constexpr (!Epi::AFTER_DRAIN) { E(acc, cur, wr, wc, fr, fq); S.done(cur); }
        if (!has_next) break;
#pragma unroll
        for (int a = 0; a < 2; ++a)
#pragma unroll
            for (int b = 0; b < 2; ++b)
#pragma unroll
                for (int m = 0; m < 4; ++m)
#pragma unroll
                    for (int n = 0; n < 2; ++n) acc[a][b][m][n] = (f32x4){0.f, 0.f, 0.f, 0.f};
        cur = nxt; cA = nA; cB = nB; ++ui;
        if constexpr (ALIGN_EPI) { if (wr == 1) PG8_BAR; }
    }
    PG8_WAIT_V(0);
    if constexpr (!ALIGN_EPI) { if (wr == 0) PG8_BAR; }
    PG8_BAR;
    if constexpr (Epi::AFTER_DRAIN) { E.fused(acc, cur, wr, wc, fr, fq, lds, wid, lane); S.done(cur); }
#undef PG8_SA
#undef PG8_SB
#undef PG8_STAGE
#undef PG8_LDA
#undef PG8_LDB
#undef PG8_MMA
#undef PG8_WAIT_V
#undef PG8_WAIT_L
#undef PG8_BAR
#undef PG8_SCHED
}
}
namespace pg8 {
struct EpiResid {
    static constexpr bool PERM = false, AFTER_DRAIN = false;
    const float* base; float* out; int ldc;
    __device__ __forceinline__ void operator()(const f32x4 (&acc)[2][2][4][2], const Unit& u, int wr, int wc, int fr, int fq) const {
        const int col0 = u.pn * BM + wc * 32 + 4 * fq;
#pragma unroll
        for (int ai = 0; ai < 2; ++ai)
#pragma unroll
            for (int m = 0; m < 4; ++m) { const size_t off = (size_t)(u.pm * BM + ai * HALF + wr * 64 + m * 16 + fr) * ldc + col0;
#pragma unroll
                for (int bj = 0; bj < 2; ++bj)
#pragma unroll
                    for (int n = 0; n < 2; ++n) { const f32x4 b = *(const f32x4*)(base + off + bj * HALF + n * 16); *(f32x4*)(out + off + bj * HALF + n * 16) = b + acc[ai][bj][m][n]; } }
    }
};
struct EpiRmsRes {
    static constexpr bool PERM = false, AFTER_DRAIN = true;
    const float* base; float* out; bf16_t* xn; const float* w; float* slots; unsigned* cnt; int ldc; int mode;
    __device__ __forceinline__ void fused(f32x4 (&acc)[2][2][4][2], const Unit& u, int wr, int wc, int fr, int fq, PG8_LAS unsigned char* lds, int wid, int lane) const {
        const int col0 = u.pn * BM + wc * 32 + 4 * fq;
        PG8_LAS float* P = (PG8_LAS float*)lds; PG8_LAS float* S = (PG8_LAS float*)(lds + 4096);
#pragma unroll
        for (int ai = 0; ai < 2; ++ai)
#pragma unroll
            for (int m = 0; m < 4; ++m) { const size_t off = (size_t)(u.pm * BM + ai * HALF + wr * 64 + m * 16 + fr) * ldc + col0; float s = 0.f;
#pragma unroll
                for (int bj = 0; bj < 2; ++bj)
#pragma unroll
                    for (int n = 0; n < 2; ++n) { const f32x4 v = acc[ai][bj][m][n] + *(const f32x4*)(base + off + bj * HALF + n * 16); acc[ai][bj][m][n] = v; s += (v[0] * v[0] + v[1] * v[1]) + (v[2] * v[2] + v[3] * v[3]); }
                s += __shfl_xor(s, 16); s += __shfl_xor(s, 32);
                if (fq == 0) P[(ai * HALF + wr * 64 + m * 16 + fr) * 4 + wc] = s;
                if (m & 1) asm volatile("" ::: "memory"); }
        asm volatile("s_waitcnt lgkmcnt(0)" ::: "memory"); __builtin_amdgcn_s_barrier(); asm volatile("" ::: "memory");
        const int row = wid * 32 + (lane & 31);
        if (lane < 32) { const float tot = (P[row * 4 + 0] + P[row * 4 + 1]) + (P[row * 4 + 2] + P[row * 4 + 3]);
            __hip_atomic_store(slots + ((size_t)(u.pm * BM + row) * 4 + u.pn), tot, __ATOMIC_RELAXED, __HIP_MEMORY_SCOPE_AGENT); }
        asm volatile("s_waitcnt vmcnt(0)" ::: "memory");
        if (lane == 0) __hip_atomic_fetch_add(cnt + 64 * u.pm, 1u, __ATOMIC_RELAXED, __HIP_MEMORY_SCOPE_AGENT);
        if (wid == 0) { while ((unsigned)__builtin_amdgcn_readfirstlane(__hip_atomic_load(cnt + 64 * u.pm, __ATOMIC_RELAXED, __HIP_MEMORY_SCOPE_AGENT)) < 32u) __builtin_amdgcn_s_sleep(2);
            __builtin_amdgcn_fence(__ATOMIC_ACQUIRE, "agent"); }
        asm volatile("s_waitcnt vmcnt(0) lgkmcnt(0)" ::: "memory"); __builtin_amdgcn_s_barrier(); asm volatile("" ::: "memory");
        if (lane < 32) { const float* sl = slots + (size_t)(u.pm * BM + row) * 4; float q = 0.f;
#pragma unroll
            for (int t = 0; t < 4; ++t) q += __hip_atomic_load(sl + t, __ATOMIC_RELAXED, __HIP_MEMORY_SCOPE_AGENT);
            S[row] = 1.0f / sqrtf(q * (1.f / 1024.f) + 1e-6f); }
        asm volatile("s_waitcnt lgkmcnt(0)" ::: "memory"); __builtin_amdgcn_s_barrier(); asm volatile("" ::: "memory");
        f32x4 wv[2][2];
#pragma unroll
        for (int bj = 0; bj < 2; ++bj)
#pragma unroll
            for (int n = 0; n < 2; ++n) wv[bj][n] = *(const f32x4*)(w + col0 + bj * HALF + n * 16);
#pragma unroll
        for (int ai = 0; ai < 2; ++ai)
#pragma unroll
            for (int m = 0; m < 4; ++m) { const int r = ai * HALF + wr * 64 + m * 16 + fr; const float rs = S[r]; const size_t off = (size_t)(u.pm * BM + r) * ldc + col0;
#pragma unroll
                for (int bj = 0; bj < 2; ++bj)
#pragma unroll
                    for (int n = 0; n < 2; ++n) { const f32x4 v = acc[ai][bj][m][n]; const f32x4 nv = v * rs * wv[bj][n];
                        if (mode == 0) { *(f32x4*)(out + off + bj * HALF + n * 16) = v; typedef unsigned u32x2v __attribute__((ext_vector_type(2))); u32x2v pk; pk.x = cvt_pk_bf16(nv[0], nv[1]); pk.y = cvt_pk_bf16(nv[2], nv[3]);
                            *(u32x2v*)(xn + off + bj * HALF + n * 16) = pk; }
                        else *(f32x4*)(out + off + bj * HALF + n * 16) = nv; } }
    }
};
}
constexpr int NWAVES = 8, NTHR = 512;
constexpr int BATCH = 2, T = 8192, D = 1024, M = BATCH * T, MH = T;
constexpr int NIN = 3728, NPAD = 3840;
constexpr int C_GQ = 0, C_GK = 256, C_GV = 512, C_GLR = 1024, C_GG = 1040, C_R = 1552, C_K = 2064, C_V = 2576, C_WL = 3088, C_AL = 3152, C_RG = 3216;
constexpr size_t MiB = 1u << 20;
constexpr size_t WS_WIN = 1 * MiB, WIN_BYTES = (size_t)NPAD * D * 2;
constexpr size_t WS_WOUT = 16 * MiB, WOUT_BYTES = (size_t)D * D * 2;
constexpr size_t WS_XN = 20 * MiB;
constexpr size_t WS_U = 52 * MiB;
constexpr size_t WS_SLOTS = 220 * MiB;
constexpr size_t WS_END = 256 * MiB;
constexpr int LDS_BYTES = 147456;

typedef unsigned short bf16;
typedef unsigned v4u __attribute__((ext_vector_type(4)));
typedef float f32x4 __attribute__((ext_vector_type(4)));
#define LDS_WAIT() asm volatile("s_waitcnt lgkmcnt(0)" ::: "memory")
#define LBAR() do { asm volatile("s_waitcnt lgkmcnt(0)" ::: "memory"); __builtin_amdgcn_s_barrier(); asm volatile("" ::: "memory"); } while (0)
__device__ __forceinline__ float bf2f(unsigned h) { return __uint_as_float(h << 16); }
__device__ __forceinline__ unsigned f2bf(float f) { unsigned u = __float_as_uint(f); return (u + 0x7fffu + ((u >> 16) & 1u)) >> 16; }
typedef __bf16 bf16x2_t __attribute__((ext_vector_type(2)));
typedef float f32x2_t __attribute__((ext_vector_type(2)));
__device__ __forceinline__ unsigned pk2(float lo, float hi) { const f32x2_t v = {lo, hi}; const bf16x2_t b = __builtin_convertvector(v, bf16x2_t); return __builtin_bit_cast(unsigned, b); }
__device__ __forceinline__ float wave_sum(float v) {
#pragma unroll
    for (int o = 1; o < 64; o <<= 1) v += __shfl_xor(v, o);
    return v;
}
__device__ __forceinline__ float sigm(float x) { return __builtin_amdgcn_rcpf(1.f + __expf(-x)); }
__device__ __forceinline__ float tanh_fast(float x) { return 1.f - 2.f * __builtin_amdgcn_rcpf(1.f + __expf(2.f * x)); }
__device__ __forceinline__ float rl(float v, int l) { return __int_as_float(__builtin_amdgcn_readlane(__float_as_int(v), l)); }

typedef short bf16x8 __attribute__((ext_vector_type(8)));
typedef unsigned v2u __attribute__((ext_vector_type(2)));
__device__ __forceinline__ v2u pack4(f32x4 v) { v2u r; r.x = pk2(v.x, v.y); r.y = pk2(v.z, v.w); return r; }
__device__ __forceinline__ void unpack8(v4u w, float* o) { o[0] = bf2f(w.x & 0xffffu); o[1] = bf2f(w.x >> 16); o[2] = bf2f(w.y & 0xffffu); o[3] = bf2f(w.y >> 16);
    o[4] = bf2f(w.z & 0xffffu); o[5] = bf2f(w.z >> 16); o[6] = bf2f(w.w & 0xffffu); o[7] = bf2f(w.w >> 16); }
__device__ __forceinline__ v4u pack8(const float* v) { v4u r; r.x = pk2(v[0], v[1]); r.y = pk2(v[2], v[3]); r.z = pk2(v[4], v[5]); r.w = pk2(v[6], v[7]); return r; }
struct Args { const float* in[18]; float* out; unsigned char* ws; };
typedef const Args __attribute__((address_space(4))) CArgs;
__device__ __forceinline__ CArgs* opaque_args() { CArgs* p = (CArgs*)__builtin_amdgcn_kernarg_segment_ptr(); asm volatile("" : "+s"(p)); return p; }
#define AA (*opaque_args())

__device__ __forceinline__ void rms_row2(const float* x0, const float* x1, const float* w, bf16* o0, bf16* o1, int lane) {
    const f32x4* r0 = (const f32x4*)x0 + lane; const f32x4* r1 = (const f32x4*)x1 + lane; const f32x4* wr = (const f32x4*)w + lane;
    f32x4 a[4], b[4]; float sa = 0.f, sb = 0.f;
#pragma unroll
    for (int j = 0; j < 4; ++j) { a[j] = r0[64 * j]; b[j] = r1[64 * j]; }
#pragma unroll
    for (int j = 0; j < 4; ++j) { sa += (a[j].x * a[j].x + a[j].y * a[j].y) + (a[j].z * a[j].z + a[j].w * a[j].w); sb += (b[j].x * b[j].x + b[j].y * b[j].y) + (b[j].z * b[j].z + b[j].w * b[j].w); }
    const float ra = rsqrtf(wave_sum(sa) * (1.f / D) + 1e-6f), rb = rsqrtf(wave_sum(sb) * (1.f / D) + 1e-6f);
#pragma unroll
    for (int j = 0; j < 4; ++j) { const f32x4 ww = wr[64 * j]; const f32x4 oa = a[j] * ra * ww, ob = b[j] * rb * ww;
        ((v2u*)o0 + lane)[64 * j] = pack4(oa); ((v2u*)o1 + lane)[64 * j] = pack4(ob); }
}
__device__ __forceinline__ void transpose_item(const float* W, int K, int N, int Npad, bf16* WT, float* scr, int item, int lane) {
    const int nblk = Npad / 32, kb = item / nblk, nb = item % nblk, k0 = 64 * kb, n0 = 32 * nb;
    const int n = n0 + (lane & 31);
#pragma unroll 8
    for (int i = 0; i < 32; ++i) { const int kk = 2 * i + (lane >> 5); scr[kk * 33 + (lane & 31)] = (n < N) ? W[(size_t)(k0 + kk) * N + n] : 0.f; }
    LDS_WAIT();
    const int c = lane & 7;
#pragma unroll
    for (int j = 0; j < 4; ++j) { const int nn = (lane >> 3) + 8 * j; const float* s = scr + (8 * c) * 33 + nn;
        v4u o; o.x = pk2(s[0 * 33], s[1 * 33]); o.y = pk2(s[2 * 33], s[3 * 33]); o.z = pk2(s[4 * 33], s[5 * 33]); o.w = pk2(s[6 * 33], s[7 * 33]);
        *(v4u*)(WT + (size_t)(n0 + nn) * K + k0 + 8 * c) = o; }
    LDS_WAIT();
}
__device__ __forceinline__ void transpose_tiles(const float* W, int K, int N, int Npad, bf16* WT, float* scr  , int first, int stride, int ntiles, int tid) {
    const int nblk = Npad / 64, kr = tid >> 4, nq = tid & 15;
    f32x4 v0 = {0.f, 0.f, 0.f, 0.f}, v1 = v0;
    if (first < ntiles) { const int kb = first / nblk, nb = first % nblk, n = 64 * nb + 4 * nq; if (n < N) { v0 = *(const f32x4*)(W + (size_t)(64 * kb + kr) * N + n); v1 = *(const f32x4*)(W + (size_t)(64 * kb + 32 + kr) * N + n); } }
#pragma unroll 1
    for (int it = first; it < ntiles; it += stride) {
        const int kb = it / nblk, nb = it % nblk;
        scr[kr * 65 + 4 * nq] = v0.x; scr[kr * 65 + 4 * nq + 1] = v0.y; scr[kr * 65 + 4 * nq + 2] = v0.z; scr[kr * 65 + 4 * nq + 3] = v0.w;
        scr[(32 + kr) * 65 + 4 * nq] = v1.x; scr[(32 + kr) * 65 + 4 * nq + 1] = v1.y; scr[(32 + kr) * 65 + 4 * nq + 2] = v1.z; scr[(32 + kr) * 65 + 4 * nq + 3] = v1.w;
        const int nx = it + stride; v0 = (f32x4){0.f, 0.f, 0.f, 0.f}; v1 = v0;
        if (nx < ntiles) { const int kb2 = nx / nblk, nb2 = nx % nblk, n = 64 * nb2 + 4 * nq; if (n < N) { v0 = *(const f32x4*)(W + (size_t)(64 * kb2 + kr) * N + n); v1 = *(const f32x4*)(W + (size_t)(64 * kb2 + 32 + kr) * N + n); } }
        LBAR();
        { const int n = tid >> 3, kc = tid & 7; const float* sp = scr + (8 * kc) * 65 + n; float o[8];
#pragma unroll
          for (int j = 0; j < 8; ++j) o[j] = sp[j * 65];
          *(v4u*)(WT + (size_t)(64 * nb + n) * K + 64 * kb + 8 * kc) = pack8(o); }
        LBAR();
    }
}
__device__ __forceinline__ void rms_row(const float* xrow, const float* w, bf16* obf, float* of32, int lane) {
    const f32x4* xr = (const f32x4*)xrow + lane; const f32x4* wr = (const f32x4*)w + lane;
    f32x4 v[4]; float s = 0.f;
#pragma unroll
    for (int j = 0; j < 4; ++j) { v[j] = xr[64 * j]; s += (v[j].x * v[j].x + v[j].y * v[j].y) + (v[j].z * v[j].z + v[j].w * v[j].w); }
    const float rs = rsqrtf(wave_sum(s) * (1.f / D) + 1e-6f);
#pragma unroll
    for (int j = 0; j < 4; ++j) { const f32x4 ww = wr[64 * j]; f32x4 o = v[j] * rs * ww;
        if (of32) ((f32x4*)of32 + lane)[64 * j] = o;
        else ((unsigned long long*)obf + lane)[64 * j] = (unsigned long long)pk2(o.x, o.y) | ((unsigned long long)pk2(o.z, o.w) << 32); }
}

constexpr int PITCH = 72, FP = 68, TP = 20;
constexpr int OFF_TW = 0, OFF_AL = 9216, OFF_ARK = 18432, OFF_XA = 27648, OFF_XW = 45056, OFF_AT = 63488, OFF_RT = 72704, OFF_BH = 81920, OFF_KH = 91136,
              OFF_BBT = 100352, OFF_KBT = 109568, OFF_VT = 118784, OFF_TII = 128000, OFF_TOT = 133120, OFF_BC = 135168;
constexpr int OFF_AAK = OFF_TW, OFF_ARB = OFF_AL, OFF_AAB = OFF_XA, OFF_XT = OFF_XW;
constexpr size_t WS_MC = 112 * MiB, WS_NC = 120 * MiB, WS_PP = 136 * MiB, WS_Y0 = 144 * MiB, WS_S0 = 160 * MiB, WS_DEC = 168 * MiB, WS_BON2 = 169 * MiB, WS_UPT = 170 * MiB;
constexpr int NUNIT = 1024;

__device__ __forceinline__ f32x4 mma2s(const bf16* Ab, int ak, const bf16* Bb, int bk, int g, f32x4 acc) {
    acc = __builtin_amdgcn_mfma_f32_16x16x32_bf16(*(const bf16x8*)(Ab + ((g ^ ak) << 3)), *(const bf16x8*)(Bb + ((g ^ bk) << 3)), acc, 0, 0, 0);
    acc = __builtin_amdgcn_mfma_f32_16x16x32_bf16(*(const bf16x8*)(Ab + (((g + 4) ^ ak) << 3)), *(const bf16x8*)(Bb + (((g + 4) ^ bk) << 3)), acc, 0, 0, 0);
    return acc;
}
#define SWK(row) (((row) >> 3) & 7)
#define SWC(row, t) ((row) * PITCH + ((((t) >> 3) ^ SWK(row)) << 3) + ((t) & 7))
__device__ __forceinline__ f32x4 mma2(const bf16* Arow, const bf16* Brow, f32x4 acc) {
    acc = __builtin_amdgcn_mfma_f32_16x16x32_bf16(*(const bf16x8*)(Arow), *(const bf16x8*)(Brow), acc, 0, 0, 0);
    acc = __builtin_amdgcn_mfma_f32_16x16x32_bf16(*(const bf16x8*)(Arow + 32), *(const bf16x8*)(Brow + 32), acc, 0, 0, 0);
    return acc;
}

__device__ __forceinline__ void r1_phase(CArgs& a, int l, unsigned char* L, int tid0) {
    asm volatile("" : "+v"(tid0));
    const int wave = __builtin_amdgcn_readfirstlane(tid0 >> 6);
    const bf16* U = (const bf16*)(a.ws + WS_U);
    bf16* TW = (bf16*)(L + OFF_TW); bf16* ALm = (bf16*)(L + OFF_AL); bf16* ARK = (bf16*)(L + OFF_ARK); bf16* AAK = (bf16*)(L + OFF_AAK); bf16* ARB = (bf16*)(L + OFF_ARB);
    float* XA = (float*)(L + OFF_XA); float* XW = (float*)(L + OFF_XW); float* AAB = (float*)(L + OFF_AAB); bf16* XT = (bf16*)(L + OFF_XT);
    bf16* AT = (bf16*)(L + OFF_AT); bf16* RT = (bf16*)(L + OFF_RT); bf16* BH = (bf16*)(L + OFF_BH); bf16* KH = (bf16*)(L + OFF_KH);
    bf16* BBT = (bf16*)(L + OFF_BBT); bf16* KBT = (bf16*)(L + OFF_KBT); bf16* VT = (bf16*)(L + OFF_VT);
    float* TII = (float*)(L + OFF_TII); float* TOT = (float*)(L + OFF_TOT); float* BC = (float*)(L + OFF_BC);
    const bf16* UPT = (const bf16*)(a.ws + WS_UPT) + (size_t)l * 2 * 512 * 64;
    const float* mu = a.in[6] + l * 1664;
    float* WTS = (float*)(L + 135424);
    int hl = -1;
    v4u Pc0, Pc1, Pp0, Pp1, Lrc, Lkc, Lvc, Lrp, Lkp, Lvp; bf16x8 wfa0, wfa1;
#define R1_ISSUE(u_) do { const int lr_ = 64 * ((u_) >> 3) + (tid >> 3); const bf16* ub_ = U + (size_t)lr_ * NPAD; const bf16* up_ = ub_ + C_WL + 16 * (tid & 7); const bf16* uq_ = ub_ + 64 * ((u_) & 7) + 8 * (tid & 7); \
        Pc0 = *(const v4u*)up_; Pc1 = *(const v4u*)(up_ + 8); Lrc = *(const v4u*)(uq_ + C_R); Lkc = *(const v4u*)(uq_ + C_K); Lvc = *(const v4u*)(uq_ + C_V); \
        Pp0 = (v4u){0u, 0u, 0u, 0u}; Pp1 = Pp0; Lrp = Pp0; Lkp = Pp0; Lvp = Pp0; \
        if (lr_ > 0) { Pp0 = *(const v4u*)(up_ - NPAD); Pp1 = *(const v4u*)(up_ - NPAD + 8); Lrp = *(const v4u*)(uq_ + C_R - NPAD); Lkp = *(const v4u*)(uq_ + C_K - NPAD); Lvp = *(const v4u*)(uq_ + C_V - NPAD); } } while (0)
#pragma unroll 1
    for (int unit = blockIdx.x; unit < NUNIT; unit += gridDim.x) {
        int tid = tid0; asm volatile("" : "+v"(tid));
        const int lane = tid & 63, g = lane >> 4, c16 = lane & 15;
        const int ch = unit >> 3, h = unit & 7;
        if (h != hl) { hl = h; LBAR();
            if (tid < 64) { const int c = l * 512 + 64 * h + tid; WTS[tid] = a.in[7][c]; WTS[64 + tid] = a.in[9][c]; WTS[128 + tid] = a.in[11][c]; WTS[192 + tid] = a.in[12][c]; WTS[256 + tid] = a.in[13][c];
                WTS[320 + tid] = mu[64 * h + tid]; WTS[384 + tid] = mu[512 + 64 * h + tid]; WTS[448 + tid] = mu[1024 + 64 * h + tid]; }
            else if (tid < 192) WTS[512 + tid - 64] = mu[1536 + tid - 64];
            { const bf16* WT = UPT + (size_t)(wave >> 2) * 512 * 64 + (size_t)(64 * h + 16 * (wave & 3) + c16) * 64 + 8 * g; wfa0 = *(const bf16x8*)WT; wfa1 = *(const bf16x8*)(WT + 32); }
            LBAR(); }
        const int t = tid >> 3, dg = tid & 7, d0 = 8 * dg, lr = 64 * ch + t, hc = 64 * h + d0;
        if (unit == (int)blockIdx.x) R1_ISSUE(unit);
        {
            const int cg = tid & 7;
            float cu[16], pr[16], o[16]; unpack8(Pc0, cu); unpack8(Pc1, cu + 8); unpack8(Pp0, pr); unpack8(Pp1, pr + 8);
            const float* mp = WTS + 512 + 16 * cg;
#pragma unroll
            for (int i = 0; i < 16; ++i) { float mv = cu[i] + (pr[i] - cu[i]) * mp[i]; if (cg < 4) mv = tanh_fast(mv); o[i] = mv; }
            bf16* dst = (cg < 4 ? TW : ALm) + t * PITCH + 16 * (cg & 3);
            *(v4u*)dst = pack8(o); *(v4u*)(dst + 8) = pack8(o + 8);
        }
        LBAR();
        {
            const int q = wave >> 2, dt = wave & 3;
            const bf16x8 a0 = wfa0, a1 = wfa1;
            const bf16* Bm = q ? ALm : TW; float* X = q ? XA : XW;
#pragma unroll
            for (int tt = 0; tt < 4; ++tt) { const bf16* br = Bm + (16 * tt + c16) * PITCH + 8 * g; f32x4 acc = {0.f, 0.f, 0.f, 0.f};
                acc = __builtin_amdgcn_mfma_f32_16x16x32_bf16(a0, *(const bf16x8*)br, acc, 0, 0, 0);
                acc = __builtin_amdgcn_mfma_f32_16x16x32_bf16(a1, *(const bf16x8*)(br + 32), acc, 0, 0, 0);
                *(f32x4*)(X + (16 * tt + c16) * FP + 16 * dt + 4 * g) = acc; }
        }
        LBAR();
        float r[8], kq[8], v[8], al[8], be[8], lw[8];
        {
            float rc[8], rp[8], kc[8], kp[8], vc[8], vp[8];
            unpack8(Lrc, rc); unpack8(Lkc, kc); unpack8(Lvc, vc); unpack8(Lrp, rp); unpack8(Lkp, kp); unpack8(Lvp, vp);
            const float* w0p = WTS + d0; const float* a0p = WTS + 64 + d0; const float* kkp = WTS + 128 + d0;
            const float* kap = WTS + 192 + d0; const float* rkp = WTS + 256 + d0;
            float nn = 0.f, bon = 0.f, kk[8], av[8];
#pragma unroll
            for (int i = 0; i < 8; ++i) {
                const float xw = XW[t * FP + d0 + i] + w0p[i], xa = XA[t * FP + d0 + i] + a0p[i];
                lw[i] = -0.60653065971f * sigm(xw); av[i] = sigm(xa);
                r[i] = rc[i] + (rp[i] - rc[i]) * WTS[320 + d0 + i]; const float k = kc[i] + (kp[i] - kc[i]) * WTS[384 + d0 + i]; v[i] = vc[i] + (vp[i] - vc[i]) * WTS[448 + d0 + i];
                kk[i] = k * kkp[i]; nn += kk[i] * kk[i];
                kq[i] = k * (1.f + (av[i] - 1.f) * kap[i]); bon += r[i] * kq[i] * rkp[i];
            }
            nn += __shfl_xor(nn, 1); nn += __shfl_xor(nn, 2); nn += __shfl_xor(nn, 4);
            bon += __shfl_xor(bon, 1); bon += __shfl_xor(bon, 2); bon += __shfl_xor(bon, 4);
            const float inv = __builtin_amdgcn_rsqf(fmaxf(nn, 1e-24f));
#pragma unroll
            for (int i = 0; i < 8; ++i) { const float kn = kk[i] * inv; al[i] = -kn; be[i] = av[i] * kn; XW[t * FP + d0 + i] = lw[i]; }
            if (dg == 0) ((float*)(a.ws + WS_BON2))[lr * 8 + h] = bon;
        }
        LBAR();
        {
            const int d = tid & 63, tb = tid >> 6; float p[8]; float run = 0.f;
#pragma unroll
            for (int i = 0; i < 8; ++i) { run += XW[(8 * tb + i) * FP + d]; p[i] = run; }
            TOT[tb * 64 + d] = run;
            LBAR();
            float off = 0.f;
#pragma unroll
            for (int j = 0; j < 8; ++j) off += (j < tb) ? TOT[j * 64 + d] : 0.f;
#pragma unroll
            for (int i = 0; i < 8; ++i) XW[(8 * tb + i) * FP + d] = off + p[i];
            if (tb == 7) BC[d] = off + run;
        }
        LBAR();
        {
            float at[8], rt[8], bh[8], kh[8];
#pragma unroll
            for (int i = 0; i < 8; ++i) { const float b = XW[t * FP + d0 + i], bc = BC[d0 + i];
                const float eb = __expf(b), enb = __expf(-b), ebp = __expf(b - lw[i]), ebc = __expf(bc - b);
                at[i] = al[i] * ebp; rt[i] = r[i] * eb; bh[i] = be[i] * enb; kh[i] = kq[i] * enb;
                BBT[SWC(d0 + i, t)] = (bf16)f2bf(be[i] * ebc); KBT[SWC(d0 + i, t)] = (bf16)f2bf(kq[i] * ebc); VT[SWC(d0 + i, t)] = (bf16)f2bf(v[i]); }
            *(v4u*)(AT + t * PITCH + d0) = pack8(at); *(v4u*)(RT + t * PITCH + d0) = pack8(rt); *(v4u*)(BH + t * PITCH + d0) = pack8(bh); *(v4u*)(KH + t * PITCH + d0) = pack8(kh);
        }
        asm volatile("" ::: "memory");
        if (unit + (int)gridDim.x < NUNIT) R1_ISSUE(unit + (int)gridDim.x);
        LBAR();
        {
            const int q = wave >> 1, mh = wave & 1;
            const bf16* As = (q < 2) ? AT : RT; const bf16* Bs = (q & 1) ? KH : BH;
#pragma unroll
            for (int t2 = 0; t2 < 2; ++t2) { const int tt = 2 * mh + t2; const int tcol = 16 * tt + c16;
#pragma unroll
                for (int jt = 0; jt < 4; ++jt) {
                    f32x4 acc = {0.f, 0.f, 0.f, 0.f};
                    if (jt <= tt) { acc = mma2(Bs + (16 * jt + c16) * PITCH + 8 * g, As + tcol * PITCH + 8 * g, acc);
#pragma unroll
                        for (int j = 0; j < 4; ++j) { const int jj = 16 * jt + 4 * g + j; const bool keep = (q < 2) ? (jj < tcol) : (jj <= tcol); if (!keep) acc[j] = 0.f; } }
                    if (q == 0) *(f32x4*)(AAB + tcol * FP + 16 * jt + 4 * g) = acc;
                    else { bf16* dst = (q == 1 ? AAK : (q == 2 ? ARB : ARK)); *(v2u*)(dst + tcol * PITCH + 16 * jt + 4 * g) = pack4(acc); }
                } }
        }
        LBAR();
        f32x4 Z[4];
        {
            if (wave == 0) { const int i = g; float Tc[16];
#pragma unroll
                for (int tr = 0; tr < 16; ++tr) { float s0 = (c16 == tr) ? 1.f : 0.f, s1 = 0.f, s2 = 0.f, s3 = 0.f; const float* ar = AAB + (16 * i + tr) * FP + 16 * i;
#pragma unroll
                    for (int j = 0; j < 16; j += 4) { if (j < tr) s0 += ar[j] * Tc[j]; if (j + 1 < tr) s1 += ar[j + 1] * Tc[j + 1]; if (j + 2 < tr) s2 += ar[j + 2] * Tc[j + 2]; if (j + 3 < tr) s3 += ar[j + 3] * Tc[j + 3]; }
                    const float sv = (s0 + s1) + (s2 + s3); Tc[tr] = sv; TII[(i * 16 + tr) * TP + c16] = sv; } }
            if (wave < 4) {
#pragma unroll
                for (int i = 0; i < 4; ++i)
#pragma unroll
                    for (int j = 0; j < 4; ++j) Z[i][j] = bf2f(AT[(16 * i + 4 * g + j) * PITCH + 16 * wave + c16]);
            } else {
#pragma unroll
                for (int i = 0; i < 4; ++i) { f32x4 acc = {0.f, 0.f, 0.f, 0.f}; const int er = 16 * (wave - 4) + c16; Z[i] = mma2s(AAK + (16 * i + c16) * PITCH, 0, VT + er * PITCH, SWK(er), g, acc); }
            }
        }
        LBAR();
        {
            f32x4 X[4];
#pragma unroll
            for (int i = 0; i < 4; ++i) { f32x4 z = Z[i];
#pragma unroll
                for (int kb = 0; kb < 4; ++kb) if (kb < i) { const f32x4 av = *(const f32x4*)(AAB + (16 * i + c16) * FP + 16 * kb + 4 * g);
#pragma unroll
                    for (int s = 0; s < 4; ++s) z = __builtin_amdgcn_mfma_f32_16x16x4f32(av[s], X[kb][s], z, 0, 0, 0); }
                const f32x4 tv = *(const f32x4*)(TII + (i * 16 + c16) * TP + 4 * g); f32x4 x = {0.f, 0.f, 0.f, 0.f};
#pragma unroll
                for (int s = 0; s < 4; ++s) x = __builtin_amdgcn_mfma_f32_16x16x4f32(tv[s], z[s], x, 0, 0, 0);
                X[i] = x; }
#pragma unroll
            for (int i = 0; i < 4; ++i) *(v2u*)(XT + (16 * wave + c16) * PITCH + 16 * i + 4 * g) = pack4(X[i]);
        }
        LBAR();
        {
            const int q = wave >> 1, hh = wave & 1;
            bf16* MCg = (bf16*)(a.ws + WS_MC) + (size_t)unit * 4096; float* NCg = (float*)(a.ws + WS_NC) + (size_t)unit * 4096;
            bf16* PPg = (bf16*)(a.ws + WS_PP) + (size_t)unit * 4096; bf16* Y0g = (bf16*)(a.ws + WS_Y0) + (size_t)unit * 4096;
#pragma unroll
            for (int t2 = 0; t2 < 2; ++t2) { const int ti = 2 * hh + t2;
#pragma unroll
                for (int tj = 0; tj < 4; ++tj) { f32x4 acc = {0.f, 0.f, 0.f, 0.f}; const int cc = 16 * tj + c16, rr = 16 * ti + 4 * g;
                    if (q == 0) { acc = mma2s(XT + (16 * ti + c16) * PITCH, 0, BBT + cc * PITCH, SWK(cc), g, acc); *(v2u*)(MCg + cc * 64 + (ti >> 1) * 32 + g * 8 + (ti & 1) * 4) = pack4(acc); }
                    else if (q == 1) { const int ar = 16 * ti + c16; acc = mma2s(BBT + ar * PITCH, SWK(ar), XT + (64 + cc) * PITCH, 0, g, acc); acc = mma2s(KBT + ar * PITCH, SWK(ar), VT + cc * PITCH, SWK(cc), g, acc);
                        *(f32x4*)(NCg + cc * 64 + rr) = acc; }
                    else if (q == 2) { acc = mma2(XT + (16 * ti + c16) * PITCH + 8 * g, ARB + cc * PITCH + 8 * g, acc);
                        const v2u rv = *(const v2u*)(RT + cc * PITCH + rr); acc[0] += bf2f(rv.x & 0xffffu); acc[1] += bf2f(rv.x >> 16); acc[2] += bf2f(rv.y & 0xffffu); acc[3] += bf2f(rv.y >> 16);
                        *(v2u*)(PPg + cc * 64 + rr) = pack4(acc); }
                    else { acc = mma2(XT + (64 + 16 * ti + c16) * PITCH + 8 * g, ARB + cc * PITCH + 8 * g, acc); { const int ar = 16 * ti + c16; acc = mma2s(VT + ar * PITCH, SWK(ar), ARK + cc * PITCH, 0, g, acc); }
                        *(v2u*)(Y0g + cc * 64 + rr) = pack4(acc); }
                } }
            if (tid < 64) ((float*)(a.ws + WS_DEC))[unit * 64 + tid] = __expf(BC[tid]);
        }
        LBAR();
    }
}

#define LAS3 __attribute__((address_space(3)))
constexpr int R2_SLOT = 12544, R2_NS = 10, R2_FLAGS = R2_SLOT * R2_NS;
__device__ __forceinline__ void r2_scan(CArgs& a, int chain, unsigned char* L, int tid) {
    asm volatile("" : "+v"(tid));
    const int lane = tid & 63, wave = __builtin_amdgcn_readfirstlane(tid >> 6);
    const int h = chain >> 2, e0 = 16 * (chain & 3), g = lane >> 4, c16 = lane & 15;
    volatile LAS3 unsigned* flg = (volatile LAS3 unsigned*)(LAS3 unsigned char*)(L + R2_FLAGS);
    if (tid < 32) flg[tid] = 0u;
    if (tid >= 64 && tid < 64 + R2_NS) *(volatile LAS3 unsigned*)(LAS3 unsigned char*)(L + (tid - 64) * R2_SLOT + 12288 + 252) = 0xffffffffu;
    __syncthreads();
    const bf16* MC = (const bf16*)(a.ws + WS_MC); const float* NC = (const float*)(a.ws + WS_NC); const float* DEC = (const float*)(a.ws + WS_DEC);
    if (wave != 0) {
        int mco[8], nco[4];
#pragma unroll
        for (int q = 0; q < 8; ++q) { const int pos = 64 * q + lane, row = pos >> 3, kc = (pos & 7) ^ (row & 7); mco[q] = row * 64 + kc * 8; }
#pragma unroll
        for (int q = 0; q < 4; ++q) { const int pos = 64 * q + lane, e = pos >> 4, dc = (pos & 15) ^ e; nco[q] = (e0 + e) * 64 + dc * 4; }
#pragma unroll 1
        for (int c = wave - 1; c < 128; c += 7) {
            while ((int)flg[16] < c - (R2_NS - 1)) __builtin_amdgcn_s_sleep(1);
            LAS3 unsigned char* slot = (LAS3 unsigned char*)(L + (c % R2_NS) * R2_SLOT);
            const size_t unit = (size_t)c * 8 + h;
#pragma unroll
            for (int q = 0; q < 8; ++q) __builtin_amdgcn_global_load_lds((const unsigned*)(MC + unit * 4096 + mco[q]), (LAS3 unsigned*)(slot + q * 1024), 16, 0, 0);
#pragma unroll
            for (int q = 0; q < 4; ++q) __builtin_amdgcn_global_load_lds((const unsigned*)(NC + unit * 4096 + nco[q]), (LAS3 unsigned*)(slot + 8192 + q * 1024), 16, 0, 0);
            __builtin_amdgcn_global_load_lds((const unsigned*)(DEC + unit * 64 + lane), (LAS3 unsigned*)(slot + 12288), 4, 0, 0);
        }
        asm volatile("s_waitcnt vmcnt(0)" ::: "memory");
    } else {
        bf16* S0 = (bf16*)(a.ws + WS_S0) + (size_t)h * 4096 + (e0 + c16) * 64 + 4 * g;
        f32x4 S[4];
#pragma unroll
        for (int m = 0; m < 4; ++m) S[m] = (f32x4){0.f, 0.f, 0.f, 0.f};
        int avail = 0;
        const LAS3 unsigned char* Lb = (const LAS3 unsigned char*)L;
        const int offA0 = (c16 * 8 + (g ^ (c16 & 7))) * 16, offA1 = (c16 * 8 + ((4 + g) ^ (c16 & 7))) * 16;
        int offN[4];
#pragma unroll
        for (int mt = 0; mt < 4; ++mt) offN[mt] = 8192 + (c16 * 16 + ((4 * mt + g) ^ c16)) * 16;
        const int offD = 12288 + 16 * g;
#define R2_MARKS(s_) (*(volatile LAS3 unsigned*)(LAS3 unsigned char*)(L + (s_) * R2_SLOT + 12288 + 252))
#define R2_WAITS(c_, s_) do { while (avail <= (c_)) { const unsigned f0_ = R2_MARKS(s_), f1_ = R2_MARKS(((s_) + 1) % R2_NS), f2_ = R2_MARKS(((s_) + 2) % R2_NS); \
            if (f0_ != 0xffffffffu) { avail = (c_) + 1; if (f1_ != 0xffffffffu) { avail = (c_) + 2; if (f2_ != 0xffffffffu) avail = (c_) + 3; } } \
            else __builtin_amdgcn_s_sleep(0); } asm volatile("" ::: "memory"); } while (0)
        v4u A[2][4][2]; f32x4 Nn[2][4], Dd[2][4];
#define R2_READS(s_, p_) do { _Pragma("unroll") for (int mt = 0; mt < 4; ++mt) { \
                A[p_][mt][0] = *(const LAS3 v4u*)(Lb + (s_) * R2_SLOT + mt * 2048 + offA0); A[p_][mt][1] = *(const LAS3 v4u*)(Lb + (s_) * R2_SLOT + mt * 2048 + offA1); \
                Nn[p_][mt] = *(const LAS3 f32x4*)(Lb + (s_) * R2_SLOT + offN[mt]); Dd[p_][mt] = *(const LAS3 f32x4*)(Lb + (s_) * R2_SLOT + mt * 64 + offD); } } while (0)
        R2_WAITS(0, 0); R2_READS(0, 0);
        asm volatile("s_waitcnt lgkmcnt(0)" ::: "memory");
#pragma unroll 1
        for (int c0 = 0; c0 < 128; c0 += R2_NS) {
#pragma unroll
            for (int k = 0; k < R2_NS; ++k) { const int c = c0 + k;
                if (c < 128) {
                    R2_MARKS(k) = 0xffffffffu; flg[16] = (unsigned)(c + 1);
                    if (c + 1 < 128) { R2_WAITS(c + 1, (k + 1) % R2_NS); R2_READS((k + 1) % R2_NS, (k + 1) & 1); }
                    bf16* sp = S0 + (size_t)c * (8 * 4096); v2u sb[4];
#pragma unroll
                    for (int m = 0; m < 4; ++m) { sb[m] = pack4(S[m]); *(v2u*)(sp + 16 * m) = sb[m]; }
                    const v4u b0 = {sb[0].x, sb[0].y, sb[1].x, sb[1].y}, b1 = {sb[2].x, sb[2].y, sb[3].x, sb[3].y};
                    const bf16x8 B0 = __builtin_bit_cast(bf16x8, b0), B1 = __builtin_bit_cast(bf16x8, b1);
                    f32x4 acc[4];
#pragma unroll
                    for (int mt = 0; mt < 4; ++mt) acc[mt] = __builtin_amdgcn_mfma_f32_16x16x32_bf16(__builtin_bit_cast(bf16x8, A[k & 1][mt][0]), B0, Nn[k & 1][mt] + S[mt] * Dd[k & 1][mt], 0, 0, 0);
#pragma unroll
                    for (int mt = 0; mt < 4; ++mt) S[mt] = __builtin_amdgcn_mfma_f32_16x16x32_bf16(__builtin_bit_cast(bf16x8, A[k & 1][mt][1]), B1, acc[mt], 0, 0, 0);
                    asm volatile("s_waitcnt lgkmcnt(0)" ::: "memory");
                } }
        }
#undef R2_WAITS
#undef R2_MARKS
#undef R2_READS
#define R2_READ 0
#undef R2_READ
    }
    __syncthreads();
}

__device__ __forceinline__ void r3_phase(CArgs& a, int l, int hb, int gw, int NGW, int lane) {
    asm volatile("" : "+v"(lane));
    const int g = lane >> 4, c16 = lane & 15;
    const bf16* U = (const bf16*)(a.ws + WS_U); const bf16* PP = (const bf16*)(a.ws + WS_PP); const bf16* S0 = (const bf16*)(a.ws + WS_S0); const bf16* Y0 = (const bf16*)(a.ws + WS_Y0);
    const float* BON = (const float*)(a.ws + WS_BON2); bf16* MG = (bf16*)(a.ws + WS_XN) + (size_t)hb * MH * D;
    const float* mu_v = a.in[6] + l * 1664 + 1024; const float* lnw = a.in[14] + l * 512; const float* lnb = a.in[15] + l * 512;
    const int erow = 16 * (c16 >> 2) + (c16 & 3);
#pragma unroll 1
    for (int task = gw; task < NUNIT * 4; task += NGW) {
        const int unit = task >> 2, mt = task & 3, ch = unit >> 3, h = unit & 7; const size_t ub = (size_t)unit * 4096;
        const int lr = 64 * ch + 16 * mt + c16; const bf16* urow = U + (size_t)lr * NPAD + 64 * h + 16 * g;
        float vc[16], vp[16], rgf[16];
        unpack8(*(const v4u*)(urow + C_V), vc); unpack8(*(const v4u*)(urow + C_V + 8), vc + 8); unpack8(*(const v4u*)(urow + C_RG), rgf); unpack8(*(const v4u*)(urow + C_RG + 8), rgf + 8);
        if (lr > 0) { unpack8(*(const v4u*)(urow + C_V - NPAD), vp); unpack8(*(const v4u*)(urow + C_V + 8 - NPAD), vp + 8); }
        else {
#pragma unroll
            for (int i = 0; i < 16; ++i) vp[i] = 0.f; }
        const float bon = BON[lr * 8 + h];
        const bf16* pr = PP + ub + (16 * mt + c16) * 64 + 8 * g;
        const bf16x8 B0 = *(const bf16x8*)pr, B1 = *(const bf16x8*)(pr + 32);
        f32x4 Y[4]; bf16x8 SA[4][2];
#pragma unroll
        for (int et = 0; et < 4; ++et) { const bf16* sr = S0 + ub + (erow + 4 * et) * 64 + 8 * g; SA[et][0] = *(const bf16x8*)sr; SA[et][1] = *(const bf16x8*)(sr + 32); }
        const bf16* y0p = Y0 + ub + (16 * mt + c16) * 64 + 16 * g; const v4u y0a = *(const v4u*)y0p, y0b = *(const v4u*)(y0p + 8);
        asm volatile("" ::: "memory");
        { float yf[16]; unpack8(y0a, yf); unpack8(y0b, yf + 8);
#pragma unroll
          for (int et = 0; et < 4; ++et) Y[et] = (f32x4){yf[4 * et], yf[4 * et + 1], yf[4 * et + 2], yf[4 * et + 3]}; }
#pragma unroll
        for (int et = 0; et < 4; ++et) { f32x4 acc = __builtin_amdgcn_mfma_f32_16x16x32_bf16(SA[et][0], B0, Y[et], 0, 0, 0);
            Y[et] = __builtin_amdgcn_mfma_f32_16x16x32_bf16(SA[et][1], B1, acc, 0, 0, 0); }
        const f32x4 sv = (Y[0] + Y[1]) + (Y[2] + Y[3]); float sm = (sv.x + sv.y) + (sv.z + sv.w); sm += __shfl_xor(sm, 16); sm += __shfl_xor(sm, 32);
        const float mean = sm * (1.f / 64.f); float q = 0.f;
#pragma unroll
        for (int et = 0; et < 4; ++et) { const f32x4 dd = Y[et] - mean; q += (dd.x * dd.x + dd.y * dd.y) + (dd.z * dd.z + dd.w * dd.w); }
        q += __shfl_xor(q, 16); q += __shfl_xor(q, 32);
        const float rstd = rsqrtf(q * (1.f / 64.f) + 64e-5f);
        const int cc = 64 * h + 16 * g; float o[16];
#pragma unroll
        for (int et = 0; et < 4; ++et) {
            const f32x4 w4 = *(const f32x4*)(lnw + cc + 4 * et), b4 = *(const f32x4*)(lnb + cc + 4 * et), m4 = *(const f32x4*)(mu_v + cc + 4 * et);
#pragma unroll
            for (int j = 0; j < 4; ++j) { const int i = 4 * et + j; const float vv = vc[i] + (vp[i] - vc[i]) * m4[j]; const float yn = (Y[et][j] - mean) * rstd * w4[j] + b4[j];
                o[i] = (yn + bon * vv) * rgf[i] * sigm(rgf[i]); } }
        bf16* op = MG + (size_t)lr * D + 512 + cc; *(v4u*)op = pack8(o); *(v4u*)(op + 8) = pack8(o + 8);
    }
}

constexpr int OFF_GQI = 17408, OFF_GKI = 26624, OFF_GKST = 35840, OFF_GVT = 45056, OFF_GSC = 63488, OFF_GTOT = 72704, OFF_GBC = 74752;
constexpr size_t WS_QI = 171 * MiB, WS_OI = 175 * MiB, WS_DS = 191 * MiB, WS_GDEC = 207 * MiB, WS_SP = 208 * MiB;
constexpr int NGUNIT = 512;

__device__ __forceinline__ void g1_phase(CArgs& a, int l, unsigned char* L, int tid0) {
    asm volatile("" : "+v"(tid0));
    const int wave = __builtin_amdgcn_readfirstlane(tid0 >> 6);
    const bf16* U = (const bf16*)(a.ws + WS_U);
    float* XW = (float*)L; bf16* QI = (bf16*)(L + OFF_GQI); bf16* KI = (bf16*)(L + OFF_GKI); bf16* KST = (bf16*)(L + OFF_GKST); bf16* VT = (bf16*)(L + OFF_GVT); bf16* SC = (bf16*)(L + OFF_GSC);
    float* TOT = (float*)(L + OFF_GTOT); float* BC = (float*)(L + OFF_GBC);
    float* GW = (float*)(L + OFF_GBC + 256);
    int hl = -1;
    v4u Gl0, Gl1, Gq, Gk, Gv0, Gv1;
#define G1_ISSUE(u_) do { const int lr_ = 64 * ((u_) >> 2) + (tid >> 3), h_ = (u_) & 3, dg_ = tid & 7; const bf16* ur_ = U + (size_t)lr_ * NPAD; \
        Gl0 = *(const v4u*)(ur_ + C_GLR); Gl1 = *(const v4u*)(ur_ + C_GLR + 8); Gq = *(const v4u*)(ur_ + C_GQ + 64 * h_ + 8 * dg_); Gk = *(const v4u*)(ur_ + C_GK + 64 * h_ + 8 * dg_); \
        Gv0 = *(const v4u*)(ur_ + C_GV + 128 * h_ + 16 * dg_); Gv1 = *(const v4u*)(ur_ + C_GV + 128 * h_ + 16 * dg_ + 8); } while (0)
#pragma unroll 1
    for (int unit = blockIdx.x; unit < NGUNIT; unit += gridDim.x) {
        int tid = tid0; asm volatile("" : "+v"(tid));
        const int lane = tid & 63, g = lane >> 4, c16 = lane & 15;
        const int ch = unit >> 2, h = unit & 3;
        if (h != hl) { hl = h; LBAR();
            for (int i = tid; i < 16 * 64; i += NTHR) GW[i] = a.in[3][l * 16 * 256 + (i >> 6) * 256 + 64 * h + (i & 63)];
            if (tid < 64) GW[1024 + tid] = a.in[4][l * 256 + 64 * h + tid];
            LBAR(); }
        const int t = tid >> 3, dg = tid & 7, d0 = 8 * dg, lr = 64 * ch + t, hc = 64 * h + d0;
        if (unit == (int)blockIdx.x) G1_ISSUE(unit);
        float q[8], k[8];
        {
            float glr[16]; unpack8(Gl0, glr); unpack8(Gl1, glr + 8);
            float x[8]; const float* gb = GW + 1024 + d0; const float* gu = GW + d0;
#pragma unroll
            for (int i = 0; i < 8; ++i) x[i] = gb[i];
#pragma unroll
            for (int r = 0; r < 16; ++r) { const f32x4 u0 = *(const f32x4*)(gu + r * 64), u1 = *(const f32x4*)(gu + r * 64 + 4);
                x[0] += glr[r] * u0.x; x[1] += glr[r] * u0.y; x[2] += glr[r] * u0.z; x[3] += glr[r] * u0.w; x[4] += glr[r] * u1.x; x[5] += glr[r] * u1.y; x[6] += glr[r] * u1.z; x[7] += glr[r] * u1.w; }
#pragma unroll
            for (int i = 0; i < 8; ++i) XW[t * FP + d0 + i] = (fminf(x[i], 0.f) - __logf(1.f + __expf(-fabsf(x[i])))) * (1.f / 16.f);
            unpack8(Gq, q); unpack8(Gk, k);
            float vv[16]; const int e0 = 16 * dg; unpack8(Gv0, vv); unpack8(Gv1, vv + 8);
            asm volatile("" ::: "memory");
            if (unit + (int)gridDim.x < NGUNIT) G1_ISSUE(unit + (int)gridDim.x);
#pragma unroll
            for (int i = 0; i < 16; ++i) VT[SWC(e0 + i, t)] = (bf16)f2bf(vv[i]);
        }
        LBAR();
        {
            const int d = tid & 63, tb = tid >> 6; float p[8]; float run = 0.f;
#pragma unroll
            for (int i = 0; i < 8; ++i) { run += XW[(8 * tb + i) * FP + d]; p[i] = run; }
            TOT[tb * 64 + d] = run;
            LBAR();
            float off = 0.f;
#pragma unroll
            for (int j = 0; j < 8; ++j) off += (j < tb) ? TOT[j * 64 + d] : 0.f;
#pragma unroll
            for (int i = 0; i < 8; ++i) XW[(8 * tb + i) * FP + d] = off + p[i];
            if (tb == 7) BC[d] = off + run;
        }
        LBAR();
        {
            float qi[8], ki[8];
#pragma unroll
            for (int i = 0; i < 8; ++i) { const float b = XW[t * FP + d0 + i], bc = BC[d0 + i];
                qi[i] = q[i] * 0.125f * __expf(b); ki[i] = k[i] * __expf(-b); KST[SWC(d0 + i, t)] = (bf16)f2bf(k[i] * __expf(bc - b)); }
            const v4u qp = pack8(qi);
            *(v4u*)(QI + t * PITCH + d0) = qp; *(v4u*)(KI + t * PITCH + d0) = pack8(ki);
            *(v4u*)((bf16*)(a.ws + WS_QI) + (size_t)unit * 4096 + t * 64 + d0) = qp;
        }
        LBAR();
        {
            const int tt = wave >> 1; const int tcol = 16 * tt + c16;
#pragma unroll
            for (int j2 = 0; j2 < 2; ++j2) { const int jt = 2 * (wave & 1) + j2; f32x4 acc = {0.f, 0.f, 0.f, 0.f};
                if (jt <= tt) { acc = mma2(KI + (16 * jt + c16) * PITCH + 8 * g, QI + tcol * PITCH + 8 * g, acc);
#pragma unroll
                    for (int j = 0; j < 4; ++j) if (16 * jt + 4 * g + j > tcol) acc[j] = 0.f; }
                *(v2u*)(SC + tcol * PITCH + 16 * jt + 4 * g) = pack4(acc); }
            bf16* DSg = (bf16*)(a.ws + WS_DS) + (size_t)unit * 8192;
#pragma unroll
            for (int i = 0; i < 4; ++i) { const int tile = wave * 4 + i, dt = tile & 3, et = tile >> 2; f32x4 acc = {0.f, 0.f, 0.f, 0.f};
                { const int ar = 16 * dt + c16, br = 16 * et + c16; acc = mma2s(KST + ar * PITCH, SWK(ar), VT + br * PITCH, SWK(br), g, acc); }
                *(v2u*)(DSg + (16 * et + c16) * 64 + 16 * dt + 4 * g) = pack4(acc); }
            if (tid < 64) ((float*)(a.ws + WS_GDEC))[unit * 64 + tid] = __expf(BC[tid]);
        }
        LBAR();
        {
            bf16* OIg = (bf16*)(a.ws + WS_OI) + (size_t)unit * 8192;
#pragma unroll
            for (int i = 0; i < 4; ++i) { const int tile = wave * 4 + i, tt = tile & 3, et = tile >> 2; f32x4 acc = {0.f, 0.f, 0.f, 0.f};
                { const int ar = 16 * et + c16; acc = mma2s(VT + ar * PITCH, SWK(ar), SC + (16 * tt + c16) * PITCH, 0, g, acc); }
                *(v2u*)(OIg + (16 * tt + c16) * 128 + 16 * et + 4 * g) = pack4(acc); }
        }
        LBAR();
    }
}

__device__ __forceinline__ void g2_scan(CArgs& a, int gid) {
    asm volatile("" : "+v"(gid));
    const int h = gid >> 13, ed = gid & 8191, d = gid & 63;
    const bf16* DS = (const bf16*)(a.ws + WS_DS); const float* GD = (const float*)(a.ws + WS_GDEC); bf16* SP = (bf16*)(a.ws + WS_SP);
    float S = 0.f;
#pragma unroll 1
    for (int cb = 0; cb < 128; cb += 16) {
        float ds[16], dc[16];
#pragma unroll
        for (int i = 0; i < 16; ++i) { const size_t unit = (size_t)(cb + i) * 4 + h; ds[i] = bf2f(DS[unit * 8192 + ed]); dc[i] = GD[unit * 64 + d]; }
#pragma unroll
        for (int i = 0; i < 16; ++i) { const size_t unit = (size_t)(cb + i) * 4 + h; SP[unit * 8192 + ed] = (bf16)f2bf(S); S = S * dc[i] + ds[i]; }
    }
}

__device__ __forceinline__ void g3_phase(CArgs& a, int l, int hb, int gw, int NGW, int lane) {
    asm volatile("" : "+v"(lane));
    const int g = lane >> 4, c16 = lane & 15;
    const bf16* U = (const bf16*)(a.ws + WS_U); const bf16* QI = (const bf16*)(a.ws + WS_QI); const bf16* SP = (const bf16*)(a.ws + WS_SP); const bf16* OI = (const bf16*)(a.ws + WS_OI);
    bf16* MG = (bf16*)(a.ws + WS_XN) + (size_t)hb * MH * D; const float* gnw = a.in[5] + l * 128;
    const int erow = 32 * (c16 >> 2) + (c16 & 3);
#pragma unroll 1
    for (int task = gw; task < NGUNIT * 4; task += NGW) {
        const int unit = task >> 2, mt = task & 3, ch = unit >> 2, h = unit & 3;
        const int lr = 64 * ch + 16 * mt + c16; const bf16* urow = U + (size_t)lr * NPAD + C_GG + 128 * h + 32 * g;
        const v4u gg0 = *(const v4u*)urow, gg1 = *(const v4u*)(urow + 8), gg2 = *(const v4u*)(urow + 16), gg3 = *(const v4u*)(urow + 24);
        const bf16* qr = QI + (size_t)unit * 4096 + (16 * mt + c16) * 64 + 8 * g;
        const bf16x8 B0 = *(const bf16x8*)qr, B1 = *(const bf16x8*)(qr + 32);
        f32x4 O[8]; float ss = 0.f; bf16x8 SA[8][2];
#pragma unroll
        for (int et = 0; et < 8; ++et) { const bf16* sr = SP + (size_t)unit * 8192 + (erow + 4 * et) * 64 + 8 * g; SA[et][0] = *(const bf16x8*)sr; SA[et][1] = *(const bf16x8*)(sr + 32); }
        const bf16* oip = OI + (size_t)unit * 8192 + (16 * mt + c16) * 128 + 32 * g; const v4u oi0 = *(const v4u*)oip, oi1 = *(const v4u*)(oip + 8), oi2 = *(const v4u*)(oip + 16), oi3 = *(const v4u*)(oip + 24);
        asm volatile("" ::: "memory");
        { float of[32]; unpack8(oi0, of); unpack8(oi1, of + 8); unpack8(oi2, of + 16); unpack8(oi3, of + 24);
#pragma unroll
          for (int et = 0; et < 8; ++et) O[et] = (f32x4){of[4 * et], of[4 * et + 1], of[4 * et + 2], of[4 * et + 3]}; }
#pragma unroll
        for (int et = 0; et < 8; ++et) { f32x4 acc = __builtin_amdgcn_mfma_f32_16x16x32_bf16(SA[et][0], B0, O[et], 0, 0, 0);
            acc = __builtin_amdgcn_mfma_f32_16x16x32_bf16(SA[et][1], B1, acc, 0, 0, 0);
            O[et] = acc; ss += (acc.x * acc.x + acc.y * acc.y) + (acc.z * acc.z + acc.w * acc.w); }
        ss += __shfl_xor(ss, 16); ss += __shfl_xor(ss, 32);
        const float rstd = rsqrtf(ss * (1.f / 128.f) + 1e-6f);
        float gf[32], o[32]; unpack8(gg0, gf); unpack8(gg1, gf + 8); unpack8(gg2, gf + 16); unpack8(gg3, gf + 24);
#pragma unroll
        for (int et = 0; et < 8; ++et) { const f32x4 w4 = *(const f32x4*)(gnw + 32 * g + 4 * et);
#pragma unroll
            for (int j = 0; j < 4; ++j) { const int i = 4 * et + j; o[i] = O[et][j] * rstd * w4[j] * gf[i] * sigm(gf[i]); } }
        bf16* op = MG + (size_t)lr * D + 128 * h + 32 * g;
        *(v4u*)op = pack8(o); *(v4u*)(op + 8) = pack8(o + 8); *(v4u*)(op + 16) = pack8(o + 16); *(v4u*)(op + 24) = pack8(o + 24);
    }
}

#define LAS __attribute__((address_space(3)))
#define XB_TMO      128
#define XB_XCNT(j)  (256  + 64 * (j))
#define XB_XSUB(j)  (1280 + 64 * (j))
#define XB_XGEN(j)  (2304 + 64 * (j))
#define XB_TOP      3328
#define XB_TOPGEN   3392
#define XCD_BAR_WORDS 3456
#define XB_SPIN_CAP (1u << 18)

__device__ __forceinline__ unsigned xb_ld(unsigned* p)              { return __hip_atomic_load(p, __ATOMIC_RELAXED, __HIP_MEMORY_SCOPE_AGENT); }
__device__ __forceinline__ unsigned xb_add(unsigned* p, unsigned v) { return __hip_atomic_fetch_add(p, v, __ATOMIC_RELAXED, __HIP_MEMORY_SCOPE_AGENT); }
__device__ __forceinline__ unsigned xb_xcc_id() { return (unsigned)__builtin_amdgcn_s_getreg((3 << 11) | 20) & 0xFu; }
#define XB_SPIN(cond, bar) do { unsigned _sp = 0; while (cond) { __builtin_amdgcn_s_sleep(1); \
    if ((++_sp & 255u) == 0u) { if (xb_ld(&(bar)[XB_TMO])) break; if (_sp > XB_SPIN_CAP) { atomicAdd(&(bar)[XB_TMO], 1u); break; } } } } while (0)

struct XcdBarrier {
    unsigned* bar; unsigned x;
    volatile LAS unsigned* st;
};

__device__ __forceinline__ XcdBarrier xcd_barrier_post(unsigned* bar, volatile LAS unsigned* st) {
    XcdBarrier b; b.bar = bar; b.x = xb_xcc_id(); b.st = st;
    if (threadIdx.x == 0) (void)xb_add(&bar[XB_XCNT(b.x)], 1u);
    return b;
}
__device__ __forceinline__ void xcd_barrier_complete(unsigned* bar, unsigned x, unsigned& nloc, unsigned& nx) {
    const unsigned G = gridDim.x * gridDim.y * gridDim.z;
    unsigned sum, cnt, mine, sp = 0u;
    for (;;) {
        sum = 0u; cnt = 0u; mine = 0u;
#pragma unroll
        for (unsigned j = 0; j < 16; ++j) { const unsigned c = xb_ld(&bar[XB_XCNT(j)]); sum += c; cnt += (c > 0u) ? 1u : 0u; mine = (j == x) ? c : mine; }
        if (sum == G) break;
        __builtin_amdgcn_s_sleep(1);
        if ((++sp & 255u) == 0u) { if (xb_ld(&bar[XB_TMO])) break; if (sp > XB_SPIN_CAP) { atomicAdd(&bar[XB_TMO], 1u); break; } }
    }
    nloc = mine > 0u ? mine : 1u; nx = cnt > 0u ? cnt : 1u;
}

__device__ __forceinline__ void xcd_barrier(const XcdBarrier& b) {
    asm volatile("s_waitcnt vmcnt(0)" ::: "memory");
    __syncthreads();
    if (threadIdx.x == 0) {
        unsigned* bar = b.bar;
        __builtin_amdgcn_s_waitcnt(0);
        unsigned nloc = b.st[0], nx = b.st[1];
        if (nloc == 0u) { xcd_barrier_complete(bar, b.x, nloc, nx); b.st[0] = nloc; b.st[1] = nx; }
        const unsigned old = xb_add(&bar[XB_XSUB(b.x)], 1u);
        const unsigned gen = old / nloc;
        if (old + 1u == (gen + 1u) * nloc) {
            __builtin_amdgcn_fence(__ATOMIC_RELEASE, "agent");
            asm volatile("s_waitcnt vmcnt(0)" ::: "memory");
            const unsigned og = xb_add(&bar[XB_TOP], 1u);
            const unsigned tg = og / nx;
            if (og + 1u == (tg + 1u) * nx) xb_add(&bar[XB_TOPGEN], 1u);
            else XB_SPIN(xb_ld(&bar[XB_TOPGEN]) == tg, bar);
            __builtin_amdgcn_fence(__ATOMIC_ACQUIRE, "agent");
            xb_add(&bar[XB_XGEN(b.x)], 1u);
            asm volatile("s_waitcnt vmcnt(0)" ::: "memory");
        } else {
            XB_SPIN(xb_ld(&bar[XB_XGEN(b.x)]) == gen, bar);
            __builtin_amdgcn_fence(__ATOMIC_ACQUIRE, "agent");
            asm volatile("s_waitcnt vmcnt(0)" ::: "memory");
        }
    }
    __syncthreads();
}


__global__ void __launch_bounds__(NTHR, 2) hymba_fwd(Args a_kernarg) {
    extern __shared__ __attribute__((aligned(16))) unsigned char lds[];
    cg::grid_group grid = cg::this_grid();
    const int tid = threadIdx.x, lane = tid & 63, wave = __builtin_amdgcn_readfirstlane(tid >> 6);
    const int G = gridDim.x, gw = blockIdx.x * NWAVES + wave, NGW = G * NWAVES;
    volatile LAS unsigned* xst = (volatile LAS unsigned*)(LAS unsigned char*)(lds + LDS_BYTES - 64);
    if (tid < 2) xst[tid] = 0u;
    __syncthreads();
    const XcdBarrier xbar = xcd_barrier_post((unsigned*)AA.ws, xst);
    {
        CArgs& a = AA; bf16* XN = (bf16*)(a.ws + WS_XN);
        float* scr = (float*)lds;
        constexpr int T_IN = (D / 64) * (NPAD / 64), T_OUT = (D / 64) * (D / 64);
        for (int l = 0; l < 2; ++l) {
            transpose_tiles(a.in[2] + (size_t)l * D * NIN, D, NIN, NPAD, (bf16*)(a.ws + WS_WIN + l * WIN_BYTES), scr, (int)blockIdx.x, G, T_IN, tid);
            transpose_tiles(a.in[16] + (size_t)l * D * D, D, D, D, (bf16*)(a.ws + WS_WOUT + l * WOUT_BYTES), scr, (int)blockIdx.x, G, T_OUT, tid);
        }
        for (int m = 2 * gw; m < M; m += 2 * NGW) rms_row2(a.in[0] + (size_t)m * D, a.in[0] + (size_t)(m + 1) * D, a.in[1], XN + (size_t)m * D, XN + (size_t)(m + 1) * D, lane);
        {
            bf16* UPT = (bf16*)(a.ws + WS_UPT);
            for (int e = blockIdx.x * NTHR + tid; e < 2 * 2 * 512 * 64; e += G * NTHR) { const int r = e & 63, c = (e >> 6) & 511, q = (e >> 15) & 1, ll = e >> 16;
                UPT[e] = (bf16)f2bf((q ? a.in[10] : a.in[8])[(size_t)ll * 64 * 512 + r * 512 + c]); }
        }
    }
    if (AA.ws == nullptr) grid.sync();
    xcd_barrier(xbar);
    for (int l = 0; l < 2; ++l) {
        for (int hb = 0; hb < 2; ++hb) {
            {
                CArgs& a = AA; bf16* XN = (bf16*)(a.ws + WS_XN); bf16* U = (bf16*)(a.ws + WS_U);
                pg8::Gemm g{XN + (size_t)hb * MH * D, (const bf16*)(a.ws + WS_WIN + l * WIN_BYTES), MH, NPAD, D}; pg8::StaticOrder S; S.init(MH, NPAD, G, (int)blockIdx.x);
                pg8::EpiBf16<0> E{U, NPAD, nullptr, 0, 0, 1.f};
                pg8::gemm_phase<pg8::EpiBf16<0>, pg8::StaticOrder, true, true>((PG8_LAS unsigned char*)lds, g, S, E);
            }
            xcd_barrier(xbar);
            r1_phase(AA, l, lds, tid);
            g1_phase(AA, l, lds, tid);
            xcd_barrier(xbar);
            if (blockIdx.x < 32) r2_scan(AA, blockIdx.x, lds, tid);
            else if (blockIdx.x < 96) g2_scan(AA, (blockIdx.x - 32) * NTHR + tid);
            xcd_barrier(xbar);
            r3_phase(AA, l, hb, gw, NGW, lane);
            g3_phase(AA, l, hb, gw, NGW, lane);
            xcd_barrier(xbar);
        }
        {
            CArgs& a = AA; bf16* XN = (bf16*)(a.ws + WS_XN);
            pg8::Gemm g{XN, (const bf16*)(a.ws + WS_WOUT + l * WOUT_BYTES), M, D, D}; pg8::StaticOrder S; S.init(M, D, G, (int)blockIdx.x);
            pg8::EpiRmsRes E{l == 0 ? a.in[0] : a.out, a.out, XN, l == 0 ? a.in[1] + D : a.in[17], (float*)(a.ws + WS_SLOTS) + (size_t)l * M * 4, (unsigned*)(a.ws + 16384) + l * 64 * 64, D, l};
            pg8::gemm_phase<pg8::EpiRmsRes, pg8::StaticOrder, false, true>((PG8_LAS unsigned char*)lds, g, S, E);
        }
        if (l == 0) xcd_barrier(xbar);
    }
}

extern "C" void kernel_launch(void* const* d_in, const int* in_sizes, int n_in, void* d_out, int out_size, void* d_ws, size_t ws_size, hipStream_t stream) {
    static int grid = 0;
    if (grid == 0) {
        if (n_in != 18 || out_size != M * D || ws_size < WS_END) { fprintf(stderr, "kernel_launch: unexpected shapes n_in %d out %d ws %zu\n", n_in, out_size, ws_size); grid = -1; return; }
        int dev = 0, cus = 0, per_cu = 0;
        hipGetDevice(&dev); hipDeviceGetAttribute(&cus, hipDeviceAttributeMultiprocessorCount, dev);
        if (hipFuncSetAttribute((const void*)hymba_fwd, hipFuncAttributeMaxDynamicSharedMemorySize, LDS_BYTES) != hipSuccess) { fprintf(stderr, "kernel_launch: hipFuncSetAttribute failed\n"); grid = -1; return; }
        if (hipOccupancyMaxActiveBlocksPerMultiprocessor(&per_cu, (const void*)hymba_fwd, NTHR, LDS_BYTES) != hipSuccess || per_cu < 1) { fprintf(stderr, "kernel_launch: occupancy query failed (%d)\n", per_cu); grid = -1; return; }
        grid = cus * 1;
        fprintf(stderr, "kernel_launch: cus %d per_cu %d grid %d\n", cus, per_cu, grid);
    }
    if (grid < 0) return;
    if (hipMemsetAsync(d_ws, 0, 65536, stream) != hipSuccess) { fprintf(stderr, "kernel_launch: memset failed\n"); return; }
    Args a{};
    for (int i = 0; i < 18; ++i) a.in[i] = (const float*)d_in[i];
    a.out = (float*)d_out; a.ws = (unsigned char*)d_ws;
    void* args[] = {&a};
    hipError_t e = hipLaunchCooperativeKernel((const void*)hymba_fwd, dim3(grid), dim3(NTHR), args, LDS_BYTES, stream);
    if (e != hipSuccess) fprintf(stderr, "cooperative launch failed: %s (grid %d)\n", hipGetErrorString(e), grid);
}
```

```cpp
#include <hip/hip_runtime.h>
#include <hip/hip_cooperative_groups.h>
#include <cstdio>
#include <cstdint>
namespace cg = cooperative_groups;
namespace pg8 {
#define PG8_LAS __attribute__((address_space(3)))
typedef unsigned short bf16_t;
typedef short bf16x8 __attribute__((ext_vector_type(8)));
typedef float f32x4 __attribute__((ext_vector_type(4)));
typedef unsigned u32x4 __attribute__((ext_vector_type(4)));
constexpr int BM = 256, BK = 64, HALF = 128, HTB = HALF * BK * 2  , STAGE_BYTES = 8 * HTB, NXCD = 8, WGM = 8;

__host__ __device__ __forceinline__ int lds_byte(int r, int c) { const int st = (r >> 4) * 2 + (c >> 5), rr = r & 15, cc = c & 31, ob = rr * 64 + cc * 2; return st * 1024 + (ob ^ (((ob >> 9) & 1) << 5)); }
__host__ __device__ __forceinline__ void stage_rc(int b, int& R, int& C) { const int st = b / 1024, sb = b % 1024, swz = sb ^ (((sb >> 9) & 1) << 5); R = (st >> 1) * 16 + swz / 64; C = (st & 1) * 32 + (swz % 64) / 2; }
__host__ __device__ __forceinline__ int perm32(int rho) { const int n = rho >> 4, i = rho & 15; return 8 * (i >> 2) + 4 * n + (i & 3); }

struct Unit { int pm, pn; };
struct Gemm { const bf16_t* A; const bf16_t* Bt; int M, N, K; };

struct StaticOrder {
    int nM, nN, nwg, G, c;
    __host__ __device__ void init(int M, int N, int G_, int c_) { nM = M / BM; nN = N / BM; nwg = nM * nN; G = G_; c = c_; }
    __host__ __device__ bool next(int i, Unit& u) const {
        const long L = (long)i * G + c; if (L >= nwg) return false;
        int wgid = (int)L; { const int q = nwg / NXCD, r = nwg % NXCD, xcd = wgid % NXCD, off = wgid / NXCD; wgid = (xcd < r ? xcd * (q + 1) : r * (q + 1) + (xcd - r) * q) + off; }
        const int nig = WGM * nN, gid = wgid / nig, fm = gid * WGM, gsz = (nM - fm) < WGM ? (nM - fm) : WGM;
        u.pm = fm + ((wgid % nig) % gsz); u.pn = (wgid % nig) / gsz; return true;
    }
    __device__ __forceinline__ void a_ready(const Unit&) const {}
    __device__ __forceinline__ void done(const Unit&) const {}
};

__device__ __forceinline__ unsigned cvt_pk_bf16(float lo, float hi) { unsigned r; asm volatile("v_cvt_pk_bf16_f32 %0, %1, %2" : "=v"(r) : "v"(lo), "v"(hi)); return r; }
typedef float f32x2 __attribute__((ext_vector_type(2)));
__device__ __forceinline__ f32x2 gelu_pk(f32x2 v) {
    const f32x2 av = __builtin_elementwise_abs(v), d = av * 0.2316418882f + 1.0f;
    f32x2 t; t.x = __builtin_amdgcn_rcpf(d.x); t.y = __builtin_amdgcn_rcpf(d.y);
    f32x2 q = t * 0.5307027145f + (-0.7265760135f); q = q * t + 0.7107068705f; q = q * t + (-0.142248368f); q = q * t + 0.127414796f; q = q * t;
    const f32x2 s = (v * v) * (-0.72134752044f);
    f32x2 e; e.x = __builtin_amdgcn_exp2f(s.x); e.y = __builtin_amdgcn_exp2f(s.y);
    const f32x2 m = v * (q * e), r = v - m;
    f32x2 o; o.x = v.x < 0.f ? m.x : r.x; o.y = v.y < 0.f ? m.y : r.y; return o;
}

template <int ACT  > struct EpiBf16 {
    static constexpr bool PERM = true, AFTER_DRAIN = false; static_assert(ACT == 0 || ACT == 1, "EpiBf16: ACT is 0 (none) or 1 (gelu_pk)");
    bf16_t* O; int ldc; const float* bias; int split_cols; size_t split_stride; float scale0;
    __device__ __forceinline__ void operator()(const f32x4 (&acc)[2][2][4][2], const Unit& u, int wr, int wc, int fr, int fq) const {
        const int row0 = u.pm * BM + wr * 64 + fr; int colt = u.pn * BM; bf16_t* base = O;
        float sc = 1.f; if (split_cols) { const int t = colt / split_cols; base += (size_t)t * split_stride; colt -= t * split_cols; if (t == 0) sc = scale0; }
        const int col0 = colt + wc * 32 + 8 * fq, bcol0 = u.pn * BM + wc * 32 + 8 * fq;
        f32x4 bv[2][2];
#pragma unroll
        for (int bj = 0; bj < 2; ++bj)
#pragma unroll
            for (int n = 0; n < 2; ++n) bv[bj][n] = bias ? *(const f32x4*)(bias + bcol0 + bj * HALF + 4 * n) : (f32x4){0.f, 0.f, 0.f, 0.f};
#pragma unroll
        for (int ai = 0; ai < 2; ++ai)
#pragma unroll
            for (int m = 0; m < 4; ++m) { bf16_t* rowp = base + (size_t)(row0 + ai * HALF + m * 16) * ldc + col0;
#pragma unroll
                for (int bj = 0; bj < 2; ++bj) { f32x4 v0 = acc[ai][bj][m][0] + bv[bj][0], v1 = acc[ai][bj][m][1] + bv[bj][1];
                    if (ACT == 1) { f32x2 a = gelu_pk((f32x2){v0[0], v0[1]}), b = gelu_pk((f32x2){v0[2], v0[3]}), c = gelu_pk((f32x2){v1[0], v1[1]}), d = gelu_pk((f32x2){v1[2], v1[3]});
                        v0 = (f32x4){a.x, a.y, b.x, b.y}; v1 = (f32x4){c.x, c.y, d.x, d.y}; }
                    v0 = v0 * sc; v1 = v1 * sc; u32x4 w; w.x = cvt_pk_bf16(v0[0], v0[1]); w.y = cvt_pk_bf16(v0[2], v0[3]); w.z = cvt_pk_bf16(v1[0], v1[1]); w.w = cvt_pk_bf16(v1[2], v1[3]);
                    *(u32x4*)(rowp + bj * HALF) = w; } }
    }
};

template <class Epi, class Sched, bool ALIGN_EPI = false, bool SP2 = false>
__device__ __forceinline__ void gemm_phase(PG8_LAS unsigned char* lds, const Gemm g, const Sched& S, const Epi& E) {
    int tid_ = threadIdx.x; asm volatile("" : "+v"(tid_));
    const int tid = tid_, wid = __builtin_amdgcn_readfirstlane(tid >> 6), lane = tid & 63, wr = wid >> 2, wc = wid & 3, fr = lane & 15, fq = lane >> 4;
    const int K = g.K, nt = K / BK;
    unsigned voffA[2], voffB[2];
#pragma unroll
    for (int i = 0; i < 2; ++i) { int R, C; stage_rc(tid * 16 + i * 8192, R, C); const int Rb = Epi::PERM ? ((R & ~31) + perm32(R & 31)) : R;
        voffA[i] = (unsigned)(R * K + C) * 2u; voffB[i] = (unsigned)(Rb * K + C) * 2u; }
    const size_t kstep = (size_t)(BK * 2);
    const size_t hstep = (size_t)HALF * K * 2;
    const size_t tstep = 2 * hstep;
    const unsigned ldsw = (unsigned)wid * 1024u;
    const int aoff = lds_byte(wr * 64 + fr, fq * 8), boff = lds_byte(wc * 32 + fr, fq * 8);
#define PG8_SA(b, h) (((b) * 2 + (h)) * HTB)
#define PG8_SB(b, h) ((4 + (b) * 2 + (h)) * HTB)
#define PG8_STAGE(bufoff, gbase, voff) do { _Pragma("unroll") for (int _i = 0; _i < 2; ++_i) \
        __builtin_amdgcn_global_load_lds((const unsigned*)((const char*)(gbase) + (voff)[_i]), (PG8_LAS unsigned*)(lds + (bufoff) + ldsw + _i * 8192), 16, 0, 0); } while (0)
#define PG8_LDA(dst, b, h) do { _Pragma("unroll") for (int m = 0; m < 4; ++m) _Pragma("unroll") for (int k = 0; k < 2; ++k) dst[m][k] = *(const PG8_LAS bf16x8*)(lds + PG8_SA(b, h) + aoff + m * 2048 + k * 1024); } while (0)
#define PG8_LDB(dst, b, h) do { _Pragma("unroll") for (int n = 0; n < 2; ++n) _Pragma("unroll") for (int k = 0; k < 2; ++k) dst[n][k] = *(const PG8_LAS bf16x8*)(lds + PG8_SB(b, h) + boff + n * 2048 + k * 1024); } while (0)
#define PG8_MMA(ai, bj, At, Bt) do { __builtin_amdgcn_s_setprio(1); _Pragma("unroll") for (int m = 0; m < 4; ++m) _Pragma("unroll") for (int n = 0; n < 2; ++n) _Pragma("unroll") for (int k = 0; k < 2; ++k) \
        acc[ai][bj][m][n] = __builtin_amdgcn_mfma_f32_16x16x32_bf16(Bt[n][k], At[m][k], acc[ai][bj][m][n], 0, 0, 0); __builtin_amdgcn_s_setprio(0); } while (0)
#define PG8_WAIT_V(n) asm volatile("s_waitcnt vmcnt(" #n ")" ::: "memory")
#define PG8_WAIT_L(n) asm volatile("s_waitcnt lgkmcnt(" #n ")" ::: "memory")
#define PG8_BAR __builtin_amdgcn_s_barrier()
#define PG8_SCHED __builtin_amdgcn_sched_barrier(0)
    Unit cur, nxt; int ui = 0;
    if (!S.next(0, cur)) return;
    f32x4 acc[2][2][4][2];
#pragma unroll
    for (int a = 0; a < 2; ++a)
#pragma unroll
        for (int b = 0; b < 2; ++b)
#pragma unroll
            for (int m = 0; m < 4; ++m)
#pragma unroll
                for (int n = 0; n < 2; ++n) acc[a][b][m][n] = (f32x4){0.f, 0.f, 0.f, 0.f};
    bf16x8 At[4][2], B0[2][2], B1[2][2];
    const char* cA = (const char*)g.A + (size_t)cur.pm * tstep; const char* cB = (const char*)g.Bt + (size_t)cur.pn * tstep;
    S.a_ready(cur);
    if constexpr (SP2) {
        PG8_STAGE(PG8_SB(0, 0), cB, voffB); PG8_STAGE(PG8_SB(0, 1), cB + hstep, voffB); PG8_STAGE(PG8_SA(0, 0), cA, voffA); PG8_STAGE(PG8_SA(0, 1), cA + hstep, voffA);
        if (wr == 1) PG8_BAR;
        PG8_WAIT_V(2); PG8_BAR;
        PG8_STAGE(PG8_SB(1, 0), cB + kstep, voffB); PG8_STAGE(PG8_SA(1, 0), cA + kstep, voffA); PG8_STAGE(PG8_SB(1, 1), cB + hstep + kstep, voffB);
        PG8_WAIT_V(6); PG8_BAR;
    } else {
        PG8_STAGE(PG8_SB(0, 0), cB, voffB); PG8_STAGE(PG8_SA(0, 0), cA, voffA); PG8_STAGE(PG8_SB(0, 1), cB + hstep, voffB); PG8_STAGE(PG8_SA(0, 1), cA + hstep, voffA);
        if (wr == 1) PG8_BAR;
        PG8_WAIT_V(4); PG8_BAR;
        PG8_STAGE(PG8_SB(1, 0), cB + kstep, voffB); PG8_STAGE(PG8_SA(1, 0), cA + kstep, voffA); PG8_STAGE(PG8_SB(1, 1), cB + hstep + kstep, voffB);
        PG8_WAIT_V(6); PG8_BAR;
    }
    for (;;) {
        const bool has_next = S.next(ui + 1, nxt);
        const char* nA = has_next ? (const char*)g.A + (size_t)nxt.pm * tstep : cA; const char* nB = has_next ? (const char*)g.Bt + (size_t)nxt.pn * tstep : cB;
        for (int t = 0; t < nt; t += 2) {
            const bool last = (t == nt - 2);
            const char* a1 = cA + (size_t)(t + 1) * kstep;
            const char* a2 = last ? nA : cA + (size_t)(t + 2) * kstep; const char* b2 = last ? nB : cB + (size_t)(t + 2) * kstep;
            const char* a3 = a2 + kstep; const char* b3 = b2 + kstep;
            if (last && has_next) S.a_ready(nxt);
            if constexpr (SP2) {
            PG8_LDB(B0, 0, 0); PG8_LDB(B1, 0, 1); PG8_SCHED; PG8_LDA(At, 0, 0); PG8_STAGE(PG8_SA(1, 1), a1 + hstep, voffA);
            PG8_WAIT_V(8); PG8_WAIT_L(0); PG8_BAR; PG8_MMA(0, 0, At, B0); PG8_MMA(0, 1, At, B1); PG8_BAR; PG8_SCHED;
            PG8_LDA(At, 0, 1); PG8_STAGE(PG8_SB(0, 0), b2, voffB); PG8_STAGE(PG8_SB(0, 1), b2 + hstep, voffB); PG8_STAGE(PG8_SA(0, 0), a2, voffA);
            PG8_WAIT_V(8); PG8_WAIT_L(0); PG8_BAR; PG8_MMA(1, 0, At, B0); PG8_MMA(1, 1, At, B1); PG8_BAR; PG8_SCHED;
            PG8_LDB(B0, 1, 0); PG8_LDB(B1, 1, 1); PG8_SCHED; PG8_LDA(At, 1, 0); PG8_STAGE(PG8_SA(0, 1), a2 + hstep, voffA);
            PG8_WAIT_V(8); PG8_WAIT_L(0); PG8_BAR; PG8_MMA(0, 0, At, B0); PG8_MMA(0, 1, At, B1); PG8_BAR; PG8_SCHED;
            PG8_LDA(At, 1, 1); PG8_STAGE(PG8_SB(1, 0), b3, voffB); PG8_STAGE(PG8_SB(1, 1), b3 + hstep, voffB); PG8_STAGE(PG8_SA(1, 0), a3, voffA);
            PG8_WAIT_V(8); PG8_WAIT_L(0); PG8_BAR; PG8_MMA(1, 0, At, B0); PG8_MMA(1, 1, At, B1); PG8_BAR; PG8_SCHED;
            } else {
            PG8_LDB(B0, 0, 0); PG8_SCHED; PG8_LDA(At, 0, 0); PG8_STAGE(PG8_SA(1, 1), a1 + hstep, voffA);
            PG8_WAIT_L(8); PG8_BAR; PG8_WAIT_L(0); PG8_MMA(0, 0, At, B0); PG8_BAR; PG8_SCHED;
            PG8_LDB(B1, 0, 1); PG8_STAGE(PG8_SB(0, 0), b2, voffB);
            PG8_BAR; PG8_WAIT_L(0); PG8_MMA(0, 1, At, B1); PG8_BAR;
            PG8_LDA(At, 0, 1); PG8_STAGE(PG8_SA(0, 0), a2, voffA);
            PG8_BAR; PG8_WAIT_L(0); PG8_MMA(1, 0, At, B0); PG8_BAR; PG8_SCHED;
            PG8_STAGE(PG8_SB(0, 1), b2 + hstep, voffB);
            PG8_WAIT_V(6); PG8_BAR; PG8_MMA(1, 1, At, B1); PG8_BAR;
            PG8_LDB(B0, 1, 0); PG8_SCHED; PG8_LDA(At, 1, 0); PG8_STAGE(PG8_SA(0, 1), a2 + hstep, voffA);
            PG8_WAIT_L(8); PG8_BAR; PG8_WAIT_L(0); PG8_MMA(0, 0, At, B0); PG8_BAR; PG8_SCHED;
            PG8_LDB(B1, 1, 1); PG8_STAGE(PG8_SB(1, 0), b3, voffB);
            PG8_BAR; PG8_WAIT_L(0); PG8_MMA(0, 1, At, B1); PG8_BAR;
            PG8_LDA(At, 1, 1); PG8_STAGE(PG8_SA(1, 0), a3, voffA);
            PG8_BAR; PG8_WAIT_L(0); PG8_MMA(1, 0, At, B0); PG8_BAR; PG8_SCHED;
            PG8_STAGE(PG8_SB(1, 1), b3 + hstep, voffB);
            PG8_WAIT_V(6); PG8_BAR; PG8_MMA(1, 1, At, B1); PG8_BAR;
            }
        }
        if constexpr (ALIGN_EPI) { if (wr == 0) PG8_BAR; }
        if constexpr (!Epi::AFTER_DRAIN) { E(acc, cur, wr, wc, fr, fq); S.done(cur); }
        if (!has_next) break;
#pragma unroll
        for (int a = 0; a < 2; ++a)
#pragma unroll
            for (int b = 0; b < 2; ++b)
#pragma unroll
                for (int m = 0; m < 4; ++m)
#pragma unroll
                    for (int n = 0; n < 2; ++n) acc[a][b][m][n] = (f32x4){0.f, 0.f, 0.f, 0.f};
        cur = nxt; cA = nA; cB = nB; ++ui;
        if constexpr (ALIGN_EPI) { if (wr == 1) PG8_BAR; }
    }
    PG8_WAIT_V(0);
    if constexpr (!ALIGN_EPI) { if (wr == 0) PG8_BAR; }
    PG8_BAR;
    if constexpr (Epi::AFTER_DRAIN) { E.fused(acc, cur, wr, wc, fr, fq, lds, wid, lane); S.done(cur); }
#undef PG8_SA
#undef PG8_SB
#undef PG8_STAGE
#undef PG8_LDA
#undef PG8_LDB
#undef PG8_MMA
#undef PG8_WAIT_V
#undef PG8_WAIT_L
#undef PG8_BAR
#undef PG8_SCHED
}
}
namespace pg8 {
struct EpiResid {
    static constexpr bool PERM = false, AFTER_DRAIN = false;
    const float* base; float* out; int ldc;
    __device__ __forceinline__ void operator()(const f32x4 (&acc)[2][2][4][2], const Unit& u, int wr, int wc, int fr, int fq) const {
        const int col0 = u.pn * BM + wc * 32 + 4 * fq;
#pragma unroll
        for (int ai = 0; ai < 2; ++ai)
#pragma unroll
            for (int m = 0; m < 4; ++m) { const size_t off = (size_t)(u.pm * BM + ai * HALF + wr * 64 + m * 16 + fr) * ldc + col0;
#pragma unroll
                for (int bj = 0; bj < 2; ++bj)
#pragma unroll
                    for (int n = 0; n < 2; ++n) { const f32x4 b = *(const f32x4*)(base + off + bj * HALF + n * 16); *(f32x4*)(out + off + bj * HALF + n * 16) = b + acc[ai][bj][m][n]; } }
    }
};
struct RangeOrder {
    int nM, nN, nwg, G, c, first, last;
    __host__ __device__ void init(int M, int N, int G_, int c_, int first_, int count_) { nM = M / BM; nN = N / BM; nwg = nM * nN; G = G_; c = c_; first = first_; last = first_ + count_; }
    __host__ __device__ bool next(int i, Unit& u) const {
        const long L = (long)first + (long)i * G + c; if (c < 0 || L >= last || L >= nwg) return false;
        int wgid = (int)L; { const int q = nwg / NXCD, r = nwg % NXCD, xcd = wgid % NXCD, off = wgid / NXCD; wgid = (xcd < r ? xcd * (q + 1) : r * (q + 1) + (xcd - r) * q) + off; }
        const int nig = WGM * nN, gid = wgid / nig, fm = gid * WGM, gsz = (nM - fm) < WGM ? (nM - fm) : WGM;
        u.pm = fm + ((wgid % nig) % gsz); u.pn = (wgid % nig) / gsz; return true;
    }
    __device__ __forceinline__ void a_ready(const Unit&) const {}
    __device__ __forceinline__ void done(const Unit&) const {}
};
struct EpiRmsRes {
    static constexpr bool PERM = false, AFTER_DRAIN = true;
    const float* base; float* out; bf16_t* xn; const float* w; float* slots; unsigned* cnt; int ldc; int mode;
    __device__ __forceinline__ void fused(f32x4 (&acc)[2][2][4][2], const Unit& u, int wr, int wc, int fr, int fq, PG8_LAS unsigned char* lds, int wid, int lane) const {
        const int col0 = u.pn * BM + wc * 32 + 4 * fq;
        PG8_LAS float* P = (PG8_LAS float*)lds; PG8_LAS float* S = (PG8_LAS float*)(lds + 4096);
#pragma unroll
        for (int ai = 0; ai < 2; ++ai)
#pragma unroll
            for (int m = 0; m < 4; ++m) { const size_t off = (size_t)(u.pm * BM + ai * HALF + wr * 64 + m * 16 + fr) * ldc + col0; float s = 0.f;
#pragma unroll
                for (int bj = 0; bj < 2; ++bj)
#pragma unroll
                    for (int n = 0; n < 2; ++n) { const f32x4 v = acc[ai][bj][m][n] + *(const f32x4*)(base + off + bj * HALF + n * 16); acc[ai][bj][m][n] = v; s += (v[0] * v[0] + v[1] * v[1]) + (v[2] * v[2] + v[3] * v[3]); }
                s += __shfl_xor(s, 16); s += __shfl_xor(s, 32);
                if (fq == 0) P[(ai * HALF + wr * 64 + m * 16 + fr) * 4 + wc] = s;
                if (m & 1) asm volatile("" ::: "memory"); }
        asm volatile("s_waitcnt lgkmcnt(0)" ::: "memory"); __builtin_amdgcn_s_barrier(); asm volatile("" ::: "memory");
        const int row = wid * 32 + (lane & 31);
        if (lane < 32) { const float tot = (P[row * 4 + 0] + P[row * 4 + 1]) + (P[row * 4 + 2] + P[row * 4 + 3]);
            __hip_atomic_store(slots + ((size_t)(u.pm * BM + row) * 4 + u.pn), tot, __ATOMIC_RELAXED, __HIP_MEMORY_SCOPE_AGENT); }
        asm volatile("s_waitcnt vmcnt(0)" ::: "memory");
        if (lane == 0) __hip_atomic_fetch_add(cnt + 64 * u.pm, 1u, __ATOMIC_RELAXED, __HIP_MEMORY_SCOPE_AGENT);
        if (wid == 0) { while ((unsigned)__builtin_amdgcn_readfirstlane(__hip_atomic_load(cnt + 64 * u.pm, __ATOMIC_RELAXED, __HIP_MEMORY_SCOPE_AGENT)) < 32u) __builtin_amdgcn_s_sleep(2);
            __builtin_amdgcn_fence(__ATOMIC_ACQUIRE, "agent"); }
        asm volatile("s_waitcnt vmcnt(0) lgkmcnt(0)" ::: "memory"); __builtin_amdgcn_s_barrier(); asm volatile("" ::: "memory");
        if (lane < 32) { const float* sl = slots + (size_t)(u.pm * BM + row) * 4; float q = 0.f;
#pragma unroll
            for (int t = 0; t < 4; ++t) q += __hip_atomic_load(sl + t, __ATOMIC_RELAXED, __HIP_MEMORY_SCOPE_AGENT);
            S[row] = 1.0f / sqrtf(q * (1.f / 1024.f) + 1e-6f); }
        asm volatile("s_waitcnt lgkmcnt(0)" ::: "memory"); __builtin_amdgcn_s_barrier(); asm volatile("" ::: "memory");
        f32x4 wv[2][2];
#pragma unroll
        for (int bj = 0; bj < 2; ++bj)
#pragma unroll
            for (int n = 0; n < 2; ++n) wv[bj][n] = *(const f32x4*)(w + col0 + bj * HALF + n * 16);
#pragma unroll
        for (int ai = 0; ai < 2; ++ai)
#pragma unroll
            for (int m = 0; m < 4; ++m) { const int r = ai * HALF + wr * 64 + m * 16 + fr; const float rs = S[r]; const size_t off = (size_t)(u.pm * BM + r) * ldc + col0;
#pragma unroll
                for (int bj = 0; bj < 2; ++bj)
#pragma unroll
                    for (int n = 0; n < 2; ++n) { const f32x4 v = acc[ai][bj][m][n]; const f32x4 nv = v * rs * wv[bj][n];
                        if (mode == 0) { *(f32x4*)(out + off + bj * HALF + n * 16) = v; typedef unsigned u32x2v __attribute__((ext_vector_type(2))); u32x2v pk; pk.x = cvt_pk_bf16(nv[0], nv[1]); pk.y = cvt_pk_bf16(nv[2], nv[3]);
                            *(u32x2v*)(xn + off + bj * HALF + n * 16) = pk; }
                        else *(f32x4*)(out + off + bj * HALF + n * 16) = nv; } }
    }
};
}
constexpr int NWAVES = 8, NTHR = 512;
constexpr int BATCH = 2, T = 8192, D = 1024, M = BATCH * T, MH = T;
constexpr int NIN = 3728, NPAD = 3840;
constexpr int C_GQ = 0, C_GK = 256, C_GV = 512, C_GLR = 1024, C_GG = 1040, C_R = 1552, C_K = 2064, C_V = 2576, C_WL = 3088, C_AL = 3152, C_RG = 3216;
constexpr size_t MiB = 1u << 20;
constexpr size_t WS_WIN = 1 * MiB, WIN_BYTES = (size_t)NPAD * D * 2;
constexpr size_t WS_WOUT = 16 * MiB, WOUT_BYTES = (size_t)D * D * 2;
constexpr size_t WS_XN = 20 * MiB;
constexpr size_t WS_U = 52 * MiB, WS_U1 = 193 * MiB, U_STRIDE = WS_U1 - WS_U;
constexpr size_t WS_SLOTS = 192 * MiB;
constexpr size_t WS_END = 254 * MiB;
constexpr int LDS_BYTES = 147456;
constexpr int EARLY_TILES = 224;

typedef unsigned short bf16;
typedef unsigned v4u __attribute__((ext_vector_type(4)));
typedef float f32x4 __attribute__((ext_vector_type(4)));
#define LDS_WAIT() asm volatile("s_waitcnt lgkmcnt(0)" ::: "memory")
#define LBAR() do { asm volatile("s_waitcnt lgkmcnt(0)" ::: "memory"); __builtin_amdgcn_s_barrier(); asm volatile("" ::: "memory"); } while (0)
__device__ __forceinline__ float bf2f(unsigned h) { return __uint_as_float(h << 16); }
__device__ __forceinline__ unsigned f2bf(float f) { unsigned u = __float_as_uint(f); return (u + 0x7fffu + ((u >> 16) & 1u)) >> 16; }
typedef __bf16 bf16x2_t __attribute__((ext_vector_type(2)));
typedef float f32x2_t __attribute__((ext_vector_type(2)));
__device__ __forceinline__ unsigned pk2(float lo, float hi) { const f32x2_t v = {lo, hi}; const bf16x2_t b = __builtin_convertvector(v, bf16x2_t); return __builtin_bit_cast(unsigned, b); }
__device__ __forceinline__ float wave_sum(float v) {
#pragma unroll
    for (int o = 1; o < 64; o <<= 1) v += __shfl_xor(v, o);
    return v;
}
__device__ __forceinline__ float sigm(float x) { return __builtin_amdgcn_rcpf(1.f + __expf(-x)); }
__device__ __forceinline__ float tanh_fast(float x) { return 1.f - 2.f * __builtin_amdgcn_rcpf(1.f + __expf(2.f * x)); }
__device__ __forceinline__ float rl(float v, int l) { return __int_as_float(__builtin_amdgcn_readlane(__float_as_int(v), l)); }

typedef short bf16x8 __attribute__((ext_vector_type(8)));
typedef unsigned v2u __attribute__((ext_vector_type(2)));
__device__ __forceinline__ v2u pack4(f32x4 v) { v2u r; r.x = pk2(v.x, v.y); r.y = pk2(v.z, v.w); return r; }
__device__ __forceinline__ void unpack8(v4u w, float* o) { o[0] = bf2f(w.x & 0xffffu); o[1] = bf2f(w.x >> 16); o[2] = bf2f(w.y & 0xffffu); o[3] = bf2f(w.y >> 16);
    o[4] = bf2f(w.z & 0xffffu); o[5] = bf2f(w.z >> 16); o[6] = bf2f(w.w & 0xffffu); o[7] = bf2f(w.w >> 16); }
__device__ __forceinline__ v4u pack8(const float* v) { v4u r; r.x = pk2(v[0], v[1]); r.y = pk2(v[2], v[3]); r.z = pk2(v[4], v[5]); r.w = pk2(v[6], v[7]); return r; }
struct Args { const float* in[18]; float* out; unsigned char* ws; };
typedef const Args __attribute__((address_space(4))) CArgs;
__device__ __forceinline__ CArgs* opaque_args() { CArgs* p = (CArgs*)__builtin_amdgcn_kernarg_segment_ptr(); asm volatile("" : "+s"(p)); return p; }
#define AA (*opaque_args())

__device__ __forceinline__ void rms_row2(const float* x0, const float* x1, const float* w, bf16* o0, bf16* o1, int lane) {
    const f32x4* r0 = (const f32x4*)x0 + lane; const f32x4* r1 = (const f32x4*)x1 + lane; const f32x4* wr = (const f32x4*)w + lane;
    f32x4 a[4], b[4]; float sa = 0.f, sb = 0.f;
#pragma unroll
    for (int j = 0; j < 4; ++j) { a[j] = r0[64 * j]; b[j] = r1[64 * j]; }
#pragma unroll
    for (int j = 0; j < 4; ++j) { sa += (a[j].x * a[j].x + a[j].y * a[j].y) + (a[j].z * a[j].z + a[j].w * a[j].w); sb += (b[j].x * b[j].x + b[j].y * b[j].y) + (b[j].z * b[j].z + b[j].w * b[j].w); }
    const float ra = rsqrtf(wave_sum(sa) * (1.f / D) + 1e-6f), rb = rsqrtf(wave_sum(sb) * (1.f / D) + 1e-6f);
#pragma unroll
    for (int j = 0; j < 4; ++j) { const f32x4 ww = wr[64 * j]; const f32x4 oa = a[j] * ra * ww, ob = b[j] * rb * ww;
        ((v2u*)o0 + lane)[64 * j] = pack4(oa); ((v2u*)o1 + lane)[64 * j] = pack4(ob); }
}
__device__ __forceinline__ void transpose_item(const float* W, int K, int N, int Npad, bf16* WT, float* scr, int item, int lane) {
    const int nblk = Npad / 32, kb = item / nblk, nb = item % nblk, k0 = 64 * kb, n0 = 32 * nb;
    const int n = n0 + (lane & 31);
#pragma unroll 8
    for (int i = 0; i < 32; ++i) { const int kk = 2 * i + (lane >> 5); scr[kk * 33 + (lane & 31)] = (n < N) ? W[(size_t)(k0 + kk) * N + n] : 0.f; }
    LDS_WAIT();
    const int c = lane & 7;
#pragma unroll
    for (int j = 0; j < 4; ++j) { const int nn = (lane >> 3) + 8 * j; const float* s = scr + (8 * c) * 33 + nn;
        v4u o; o.x = pk2(s[0 * 33], s[1 * 33]); o.y = pk2(s[2 * 33], s[3 * 33]); o.z = pk2(s[4 * 33], s[5 * 33]); o.w = pk2(s[6 * 33], s[7 * 33]);
        *(v4u*)(WT + (size_t)(n0 + nn) * K + k0 + 8 * c) = o; }
    LDS_WAIT();
}
__device__ __forceinline__ void transpose_tiles(const float* W, int K, int N, int Npad, bf16* WT, float* scr  , int first, int stride, int ntiles, int tid) {
    const int nblk = Npad / 64, kr = tid >> 4, nq = tid & 15;
    f32x4 v0 = {0.f, 0.f, 0.f, 0.f}, v1 = v0;
    if (first < ntiles) { const int kb = first / nblk, nb = first % nblk, n = 64 * nb + 4 * nq; if (n < N) { v0 = *(const f32x4*)(W + (size_t)(64 * kb + kr) * N + n); v1 = *(const f32x4*)(W + (size_t)(64 * kb + 32 + kr) * N + n); } }
#pragma unroll 1
    for (int it = first; it < ntiles; it += stride) {
        const int kb = it / nblk, nb = it % nblk;
        scr[kr * 65 + 4 * nq] = v0.x; scr[kr * 65 + 4 * nq + 1] = v0.y; scr[kr * 65 + 4 * nq + 2] = v0.z; scr[kr * 65 + 4 * nq + 3] = v0.w;
        scr[(32 + kr) * 65 + 4 * nq] = v1.x; scr[(32 + kr) * 65 + 4 * nq + 1] = v1.y; scr[(32 + kr) * 65 + 4 * nq + 2] = v1.z; scr[(32 + kr) * 65 + 4 * nq + 3] = v1.w;
        const int nx = it + stride; v0 = (f32x4){0.f, 0.f, 0.f, 0.f}; v1 = v0;
        if (nx < ntiles) { const int kb2 = nx / nblk, nb2 = nx % nblk, n = 64 * nb2 + 4 * nq; if (n < N) { v0 = *(const f32x4*)(W + (size_t)(64 * kb2 + kr) * N + n); v1 = *(const f32x4*)(W + (size_t)(64 * kb2 + 32 + kr) * N + n); } }
        LBAR();
        { const int n = tid >> 3, kc = tid & 7; const float* sp = scr + (8 * kc) * 65 + n; float o[8];
#pragma unroll
          for (int j = 0; j < 8; ++j) o[j] = sp[j * 65];
          *(v4u*)(WT + (size_t)(64 * nb + n) * K + 64 * kb + 8 * kc) = pack8(o); }
        LBAR();
    }
}
__device__ __forceinline__ void rms_row(const float* xrow, const float* w, bf16* obf, float* of32, int lane) {
    const f32x4* xr = (const f32x4*)xrow + lane; const f32x4* wr = (const f32x4*)w + lane;
    f32x4 v[4]; float s = 0.f;
#pragma unroll
    for (int j = 0; j < 4; ++j) { v[j] = xr[64 * j]; s += (v[j].x * v[j].x + v[j].y * v[j].y) + (v[j].z * v[j].z + v[j].w * v[j].w); }
    const float rs = rsqrtf(wave_sum(s) * (1.f / D) + 1e-6f);
#pragma unroll
    for (int j = 0; j < 4; ++j) { const f32x4 ww = wr[64 * j]; f32x4 o = v[j] * rs * ww;
        if (of32) ((f32x4*)of32 + lane)[64 * j] = o;
        else ((unsigned long long*)obf + lane)[64 * j] = (unsigned long long)pk2(o.x, o.y) | ((unsigned long long)pk2(o.z, o.w) << 32); }
}

constexpr int PITCH = 72, FP = 68, TP = 20;
constexpr int OFF_TW = 0, OFF_AL = 9216, OFF_ARK = 18432, OFF_XA = 27648, OFF_XW = 45056, OFF_AT = 63488, OFF_RT = 72704, OFF_BH = 81920, OFF_KH = 91136,
              OFF_BBT = 100352, OFF_KBT = 109568, OFF_VT = 118784, OFF_TII = 128000, OFF_TOT = 133120, OFF_BC = 135168;
constexpr int OFF_AAK = OFF_TW, OFF_ARB = OFF_AL, OFF_AAB = OFF_XA, OFF_XT = OFF_XW;
constexpr size_t WS_MC = 112 * MiB, WS_NC = 120 * MiB, WS_PP = 136 * MiB, WS_Y0 = 144 * MiB, WS_S0 = 152 * MiB, WS_DEC = 160 * MiB, WS_BON2 = 161 * MiB, WS_UPT = 162 * MiB;
constexpr int NUNIT = 1024;

__device__ __forceinline__ f32x4 mma2s(const bf16* Ab, int ak, const bf16* Bb, int bk, int g, f32x4 acc) {
    acc = __builtin_amdgcn_mfma_f32_16x16x32_bf16(*(const bf16x8*)(Ab + ((g ^ ak) << 3)), *(const bf16x8*)(Bb + ((g ^ bk) << 3)), acc, 0, 0, 0);
    acc = __builtin_amdgcn_mfma_f32_16x16x32_bf16(*(const bf16x8*)(Ab + (((g + 4) ^ ak) << 3)), *(const bf16x8*)(Bb + (((g + 4) ^ bk) << 3)), acc, 0, 0, 0);
    return acc;
}
#define SWK(row) (((row) >> 3) & 7)
#define SWC(row, t) ((row) * PITCH + ((((t) >> 3) ^ SWK(row)) << 3) + ((t) & 7))
__device__ __forceinline__ f32x4 mma2(const bf16* Arow, const bf16* Brow, f32x4 acc) {
    acc = __builtin_amdgcn_mfma_f32_16x16x32_bf16(*(const bf16x8*)(Arow), *(const bf16x8*)(Brow), acc, 0, 0, 0);
    acc = __builtin_amdgcn_mfma_f32_16x16x32_bf16(*(const bf16x8*)(Arow + 32), *(const bf16x8*)(Brow + 32), acc, 0, 0, 0);
    return acc;
}

__device__ __forceinline__ void r1_phase(CArgs& a, size_t uo, int l, unsigned char* L, int tid0) {
    asm volatile("" : "+v"(tid0));
    const int wave = __builtin_amdgcn_readfirstlane(tid0 >> 6);
    const bf16* U = (const bf16*)(a.ws + WS_U + uo);
    bf16* TW = (bf16*)(L + OFF_TW); bf16* ALm = (bf16*)(L + OFF_AL); bf16* ARK = (bf16*)(L + OFF_ARK); bf16* AAK = (bf16*)(L + OFF_AAK); bf16* ARB = (bf16*)(L + OFF_ARB);
    float* XA = (float*)(L + OFF_XA); float* XW = (float*)(L + OFF_XW); float* AAB = (float*)(L + OFF_AAB); bf16* XT = (bf16*)(L + OFF_XT);
    bf16* AT = (bf16*)(L + OFF_AT); bf16* RT = (bf16*)(L + OFF_RT); bf16* BH = (bf16*)(L + OFF_BH); bf16* KH = (bf16*)(L + OFF_KH);
    bf16* BBT = (bf16*)(L + OFF_BBT); bf16* KBT = (bf16*)(L + OFF_KBT); bf16* VT = (bf16*)(L + OFF_VT);
    float* TII = (float*)(L + OFF_TII); float* TOT = (float*)(L + OFF_TOT); float* BC = (float*)(L + OFF_BC);
    const bf16* UPT = (const bf16*)(a.ws + WS_UPT) + (size_t)l * 2 * 512 * 64;
    const float* mu = a.in[6] + l * 1664;
    float* WTS = (float*)(L + 135680);
    int hl = -1;
    v4u Pc0, Pc1, Pp0, Pp1, Lrc, Lkc, Lvc, Lrp, Lkp, Lvp; bf16x8 wfa0, wfa1;
#define R1_ISSUE(u_) do { const int lr_ = 64 * ((u_) >> 3) + (tid >> 3); const bf16* ub_ = U + (size_t)lr_ * NPAD; const bf16* up_ = ub_ + C_WL + 16 * (tid & 7); const bf16* uq_ = ub_ + 64 * ((u_) & 7) + 8 * (tid & 7); \
        Pc0 = *(const v4u*)up_; Pc1 = *(const v4u*)(up_ + 8); Lrc = *(const v4u*)(uq_ + C_R); Lkc = *(const v4u*)(uq_ + C_K); Lvc = *(const v4u*)(uq_ + C_V); \
        Pp0 = (v4u){0u, 0u, 0u, 0u}; Pp1 = Pp0; Lrp = Pp0; Lkp = Pp0; Lvp = Pp0; \
        if (lr_ > 0) { Pp0 = *(const v4u*)(up_ - NPAD); Pp1 = *(const v4u*)(up_ - NPAD + 8); Lrp = *(const v4u*)(uq_ + C_R - NPAD); Lkp = *(const v4u*)(uq_ + C_K - NPAD); Lvp = *(const v4u*)(uq_ + C_V - NPAD); } } while (0)
#pragma unroll 1
    for (int unit = blockIdx.x; unit < NUNIT; unit += gridDim.x) {
        int tid = tid0; asm volatile("" : "+v"(tid));
        const int lane = tid & 63, g = lane >> 4, c16 = lane & 15;
        const int ch = unit >> 3, h = unit & 7;
        if (h != hl) { hl = h; LBAR();
            if (tid < 64) { const int c = l * 512 + 64 * h + tid; WTS[tid] = a.in[7][c]; WTS[64 + tid] = a.in[9][c]; WTS[128 + tid] = a.in[11][c]; WTS[192 + tid] = a.in[12][c]; WTS[256 + tid] = a.in[13][c];
                WTS[320 + tid] = mu[64 * h + tid]; WTS[384 + tid] = mu[512 + 64 * h + tid]; WTS[448 + tid] = mu[1024 + 64 * h + tid]; }
            else if (tid < 192) WTS[512 + tid - 64] = mu[1536 + tid - 64];
            { const bf16* WT = UPT + (size_t)(wave >> 2) * 512 * 64 + (size_t)(64 * h + 16 * (wave & 3) + c16) * 64 + 8 * g; wfa0 = *(const bf16x8*)WT; wfa1 = *(const bf16x8*)(WT + 32); }
            LBAR(); }
        const int t = tid >> 3, dg = tid & 7, d0 = 8 * dg, lr = 64 * ch + t, hc = 64 * h + d0;
        if (unit == (int)blockIdx.x) R1_ISSUE(unit);
        {
            const int cg = tid & 7;
            float cu[16], pr[16], o[16]; unpack8(Pc0, cu); unpack8(Pc1, cu + 8); unpack8(Pp0, pr); unpack8(Pp1, pr + 8);
            const float* mp = WTS + 512 + 16 * cg;
#pragma unroll
            for (int i = 0; i < 16; ++i) { float mv = cu[i] + (pr[i] - cu[i]) * mp[i]; if (cg < 4) mv = tanh_fast(mv); o[i] = mv; }
            bf16* dst = (cg < 4 ? TW : ALm) + t * PITCH + 16 * (cg & 3);
            *(v4u*)dst = pack8(o); *(v4u*)(dst + 8) = pack8(o + 8);
        }
        LBAR();
        {
            const int q = wave >> 2, dt = wave & 3;
            const bf16x8 a0 = wfa0, a1 = wfa1;
            const bf16* Bm = q ? ALm : TW; float* X = q ? XA : XW;
#pragma unroll
            for (int tt = 0; tt < 4; ++tt) { const bf16* br = Bm + (16 * tt + c16) * PITCH + 8 * g; f32x4 acc = {0.f, 0.f, 0.f, 0.f};
                acc = __builtin_amdgcn_mfma_f32_16x16x32_bf16(a0, *(const bf16x8*)br, acc, 0, 0, 0);
                acc = __builtin_amdgcn_mfma_f32_16x16x32_bf16(a1, *(const bf16x8*)(br + 32), acc, 0, 0, 0);
                *(f32x4*)(X + (16 * tt + c16) * FP + 16 * dt + 4 * g) = acc; }
        }
        LBAR();
        float r[8], kq[8], v[8], al[8], be[8], lw[8];
        {
            float rc[8], rp[8], kc[8], kp[8], vc[8], vp[8];
            unpack8(Lrc, rc); unpack8(Lkc, kc); unpack8(Lvc, vc); unpack8(Lrp, rp); unpack8(Lkp, kp); unpack8(Lvp, vp);
            const float* w0p = WTS + d0; const float* a0p = WTS + 64 + d0; const float* kkp = WTS + 128 + d0;
            const float* kap = WTS + 192 + d0; const float* rkp = WTS + 256 + d0;
            float nn = 0.f, bon = 0.f, kk[8], av[8];
#pragma unroll
            for (int i = 0; i < 8; ++i) {
                const float xw = XW[t * FP + d0 + i] + w0p[i], xa = XA[t * FP + d0 + i] + a0p[i];
                lw[i] = -0.60653065971f * sigm(xw); av[i] = sigm(xa);
                r[i] = rc[i] + (rp[i] - rc[i]) * WTS[320 + d0 + i]; const float k = kc[i] + (kp[i] - kc[i]) * WTS[384 + d0 + i]; v[i] = vc[i] + (vp[i] - vc[i]) * WTS[448 + d0 + i];
                kk[i] = k * kkp[i]; nn += kk[i] * kk[i];
                kq[i] = k * (1.f + (av[i] - 1.f) * kap[i]); bon += r[i] * kq[i] * rkp[i];
            }
            nn += __shfl_xor(nn, 1); nn += __shfl_xor(nn, 2); nn += __shfl_xor(nn, 4);
            bon += __shfl_xor(bon, 1); bon += __shfl_xor(bon, 2); bon += __shfl_xor(bon, 4);
            const float inv = __builtin_amdgcn_rsqf(fmaxf(nn, 1e-24f));
#pragma unroll
            for (int i = 0; i < 8; ++i) { const float kn = kk[i] * inv; al[i] = -kn; be[i] = av[i] * kn; XW[t * FP + d0 + i] = lw[i]; }
            if (dg == 0) ((float*)(a.ws + WS_BON2))[lr * 8 + h] = bon;
        }
        LBAR();
        {
            const int d = tid & 63, tb = tid >> 6; float p[8]; float run = 0.f;
#pragma unroll
            for (int i = 0; i < 8; ++i) { run += XW[(8 * tb + i) * FP + d]; p[i] = run; }
            TOT[tb * 64 + d] = run;
            LBAR();
            float off = 0.f;
#pragma unroll
            for (int j = 0; j < 8; ++j) off += (j < tb) ? TOT[j * 64 + d] : 0.f;
#pragma unroll
            for (int i = 0; i < 8; ++i) XW[(8 * tb + i) * FP + d] = off + p[i];
            if (tb == 7) { BC[d] = off + run; BC[64 + d] = __expf(off + run); }
        }
        LBAR();
        {
            float at[8], rt[8], bh[8], kh[8];
#pragma unroll
            for (int i = 0; i < 8; ++i) { const float b = XW[t * FP + d0 + i];
                const float eb = __expf(b), enb = __builtin_amdgcn_rcpf(eb), ebp = __expf(b - lw[i]), ebc = BC[64 + d0 + i] * enb;
                at[i] = al[i] * ebp; rt[i] = r[i] * eb; bh[i] = be[i] * enb; kh[i] = kq[i] * enb;
                BBT[SWC(d0 + i, t)] = (bf16)f2bf(be[i] * ebc); KBT[SWC(d0 + i, t)] = (bf16)f2bf(kq[i] * ebc); VT[SWC(d0 + i, t)] = (bf16)f2bf(v[i]); }
            *(v4u*)(AT + t * PITCH + d0) = pack8(at); *(v4u*)(RT + t * PITCH + d0) = pack8(rt); *(v4u*)(BH + t * PITCH + d0) = pack8(bh); *(v4u*)(KH + t * PITCH + d0) = pack8(kh);
        }
        asm volatile("" ::: "memory");
        if (unit + (int)gridDim.x < NUNIT) R1_ISSUE(unit + (int)gridDim.x);
        LBAR();
        {
            const int q = wave >> 1, mh = wave & 1;
            const bf16* As = (q < 2) ? AT : RT; const bf16* Bs = (q & 1) ? KH : BH;
#pragma unroll
            for (int t2 = 0; t2 < 2; ++t2) { const int tt = 2 * mh + t2; const int tcol = 16 * tt + c16;
#pragma unroll
                for (int jt = 0; jt < 4; ++jt) {
                    f32x4 acc = {0.f, 0.f, 0.f, 0.f};
                    if (jt <= tt) { acc = mma2(Bs + (16 * jt + c16) * PITCH + 8 * g, As + tcol * PITCH + 8 * g, acc);
#pragma unroll
                        for (int j = 0; j < 4; ++j) { const int jj = 16 * jt + 4 * g + j; const bool keep = (q < 2) ? (jj < tcol) : (jj <= tcol); if (!keep) acc[j] = 0.f; } }
                    if (q == 0) *(f32x4*)(AAB + tcol * FP + 16 * jt + 4 * g) = acc;
                    else { bf16* dst = (q == 1 ? AAK : (q == 2 ? ARB : ARK)); *(v2u*)(dst + tcol * PITCH + 16 * jt + 4 * g) = pack4(acc); }
                } }
        }
        LBAR();
        f32x4 Z[4];
        {
            if (wave == 0) { const int i = g; float Tc[16];
#pragma unroll
                for (int tr = 0; tr < 16; ++tr) { float s0 = (c16 == tr) ? 1.f : 0.f, s1 = 0.f, s2 = 0.f, s3 = 0.f; const float* ar = AAB + (16 * i + tr) * FP + 16 * i;
#pragma unroll
                    for (int j = 0; j < 16; j += 4) { if (j < tr) s0 += ar[j] * Tc[j]; if (j + 1 < tr) s1 += ar[j + 1] * Tc[j + 1]; if (j + 2 < tr) s2 += ar[j + 2] * Tc[j + 2]; if (j + 3 < tr) s3 += ar[j + 3] * Tc[j + 3]; }
                    const float sv = (s0 + s1) + (s2 + s3); Tc[tr] = sv; TII[(i * 16 + tr) * TP + c16] = sv; } }
            if (wave < 4) {
#pragma unroll
                for (int i = 0; i < 4; ++i)
#pragma unroll
                    for (int j = 0; j < 4; ++j) Z[i][j] = bf2f(AT[(16 * i + 4 * g + j) * PITCH + 16 * wave + c16]);
            } else {
#pragma unroll
                for (int i = 0; i < 4; ++i) { f32x4 acc = {0.f, 0.f, 0.f, 0.f}; const int er = 16 * (wave - 4) + c16; Z[i] = mma2s(AAK + (16 * i + c16) * PITCH, 0, VT + er * PITCH, SWK(er), g, acc); }
            }
        }
        LBAR();
        {
            f32x4 X[4];
#pragma unroll
            for (int i = 0; i < 4; ++i) { f32x4 z = Z[i];
#pragma unroll
                for (int kb = 0; kb < 4; ++kb) if (kb < i) { const f32x4 av = *(const f32x4*)(AAB + (16 * i + c16) * FP + 16 * kb + 4 * g);
#pragma unroll
                    for (int s = 0; s < 4; ++s) z = __builtin_amdgcn_mfma_f32_16x16x4f32(av[s], X[kb][s], z, 0, 0, 0); }
                const f32x4 tv = *(const f32x4*)(TII + (i * 16 + c16) * TP + 4 * g); f32x4 x = {0.f, 0.f, 0.f, 0.f};
#pragma unroll
                for (int s = 0; s < 4; ++s) x = __builtin_amdgcn_mfma_f32_16x16x4f32(tv[s], z[s], x, 0, 0, 0);
                X[i] = x; }
#pragma unroll
            for (int i = 0; i < 4; ++i) *(v2u*)(XT + (16 * wave + c16) * PITCH + 16 * i + 4 * g) = pack4(X[i]);
        }
        LBAR();
        {
            const int q = wave >> 1, hh = wave & 1;
            bf16* MCg = (bf16*)(a.ws + WS_MC) + (size_t)unit * 4096; float* NCg = (float*)(a.ws + WS_NC) + (size_t)unit * 4096;
            bf16* PPg = (bf16*)(a.ws + WS_PP) + (size_t)unit * 4096; bf16* Y0g = (bf16*)(a.ws + WS_Y0) + (size_t)unit * 4096;
#pragma unroll
            for (int t2 = 0; t2 < 2; ++t2) { const int ti = 2 * hh + t2;
#pragma unroll
                for (int tj = 0; tj < 4; ++tj) { f32x4 acc = {0.f, 0.f, 0.f, 0.f}; const int cc = 16 * tj + c16, rr = 16 * ti + 4 * g;
                    if (q == 0) { acc = mma2s(XT + (16 * ti + c16) * PITCH, 0, BBT + cc * PITCH, SWK(cc), g, acc); *(v2u*)(MCg + cc * 64 + (ti >> 1) * 32 + g * 8 + (ti & 1) * 4) = pack4(acc); }
                    else if (q == 1) { const int ar = 16 * ti + c16; acc = mma2s(BBT + ar * PITCH, SWK(ar), XT + (64 + cc) * PITCH, 0, g, acc); acc = mma2s(KBT + ar * PITCH, SWK(ar), VT + cc * PITCH, SWK(cc), g, acc);
                        *(f32x4*)(NCg + cc * 64 + rr) = acc; }
                    else if (q == 2) { acc = mma2(XT + (16 * ti + c16) * PITCH + 8 * g, ARB + cc * PITCH + 8 * g, acc);
                        const v2u rv = *(const v2u*)(RT + cc * PITCH + rr); acc[0] += bf2f(rv.x & 0xffffu); acc[1] += bf2f(rv.x >> 16); acc[2] += bf2f(rv.y & 0xffffu); acc[3] += bf2f(rv.y >> 16);
                        *(v2u*)(PPg + cc * 64 + rr) = pack4(acc); }
                    else { acc = mma2(XT + (64 + 16 * ti + c16) * PITCH + 8 * g, ARB + cc * PITCH + 8 * g, acc); { const int ar = 16 * ti + c16; acc = mma2s(VT + ar * PITCH, SWK(ar), ARK + cc * PITCH, 0, g, acc); }
                        *(v2u*)(Y0g + cc * 64 + rr) = pack4(acc); }
                } }
            if (tid < 64) ((float*)(a.ws + WS_DEC))[unit * 64 + tid] = BC[64 + tid];
        }
        LBAR();
    }
}

#define LAS3 __attribute__((address_space(3)))
constexpr int R2_SLOT = 12544, R2_NS = 10, R2_FLAGS = R2_SLOT * R2_NS;
__device__ __forceinline__ void r2_scan(CArgs& a, int chain, unsigned char* L, int tid) {
    asm volatile("" : "+v"(tid));
    const int lane = tid & 63, wave = __builtin_amdgcn_readfirstlane(tid >> 6);
    const int h = chain >> 2, e0 = 16 * (chain & 3), g = lane >> 4, c16 = lane & 15;
    volatile LAS3 unsigned* flg = (volatile LAS3 unsigned*)(LAS3 unsigned char*)(L + R2_FLAGS);
    if (tid < 32) flg[tid] = 0u;
    if (tid >= 64 && tid < 64 + R2_NS) *(volatile LAS3 unsigned*)(LAS3 unsigned char*)(L + (tid - 64) * R2_SLOT + 12288 + 252) = 0xffffffffu;
    __syncthreads();
    const bf16* MC = (const bf16*)(a.ws + WS_MC); const float* NC = (const float*)(a.ws + WS_NC); const float* DEC = (const float*)(a.ws + WS_DEC);
    if (wave != 0) {
        int mco[8], nco[4];
#pragma unroll
        for (int q = 0; q < 8; ++q) { const int pos = 64 * q + lane, row = pos >> 3, kc = (pos & 7) ^ (row & 7); mco[q] = row * 64 + kc * 8; }
#pragma unroll
        for (int q = 0; q < 4; ++q) { const int pos = 64 * q + lane, e = pos >> 4, dc = (pos & 15) ^ e; nco[q] = (e0 + e) * 64 + dc * 4; }
#pragma unroll 1
        for (int c = wave - 1; c < 128; c += 7) {
            while ((int)flg[16] < c - (R2_NS - 1)) __builtin_amdgcn_s_sleep(1);
            LAS3 unsigned char* slot = (LAS3 unsigned char*)(L + (c % R2_NS) * R2_SLOT);
            const size_t unit = (size_t)c * 8 + h;
#pragma unroll
            for (int q = 0; q < 8; ++q) __builtin_amdgcn_global_load_lds((const unsigned*)(MC + unit * 4096 + mco[q]), (LAS3 unsigned*)(slot + q * 1024), 16, 0, 0);
#pragma unroll
            for (int q = 0; q < 4; ++q) __builtin_amdgcn_global_load_lds((const unsigned*)(NC + unit * 4096 + nco[q]), (LAS3 unsigned*)(slot + 8192 + q * 1024), 16, 0, 0);
            __builtin_amdgcn_global_load_lds((const unsigned*)(DEC + unit * 64 + lane), (LAS3 unsigned*)(slot + 12288), 4, 0, 0);
        }
        asm volatile("s_waitcnt vmcnt(0)" ::: "memory");
    } else {
        bf16* S0 = (bf16*)(a.ws + WS_S0) + (size_t)h * 4096 + (e0 + c16) * 64 + 4 * g;
        f32x4 S[4];
#pragma unroll
        for (int m = 0; m < 4; ++m) S[m] = (f32x4){0.f, 0.f, 0.f, 0.f};
        int avail = 0;
        const LAS3 unsigned char* Lb = (const LAS3 unsigned char*)L;
        const int offA0 = (c16 * 8 + (g ^ (c16 & 7))) * 16, offA1 = (c16 * 8 + ((4 + g) ^ (c16 & 7))) * 16;
        int offN[4];
#pragma unroll
        for (int mt = 0; mt < 4; ++mt) offN[mt] = 8192 + (c16 * 16 + ((4 * mt + g) ^ c16)) * 16;
        const int offD = 12288 + 16 * g;
#define R2_MARKS(s_) (*(volatile LAS3 unsigned*)(LAS3 unsigned char*)(L + (s_) * R2_SLOT + 12288 + 252))
#define R2_WAITS(c_, s_) do { while (avail <= (c_)) { const unsigned f0_ = R2_MARKS(s_), f1_ = R2_MARKS(((s_) + 1) % R2_NS), f2_ = R2_MARKS(((s_) + 2) % R2_NS); \
            if (f0_ != 0xffffffffu) { avail = (c_) + 1; if (f1_ != 0xffffffffu) { avail = (c_) + 2; if (f2_ != 0xffffffffu) avail = (c_) + 3; } } \
            else __builtin_amdgcn_s_sleep(0); } asm volatile("" ::: "memory"); } while (0)
        v4u A[2][4][2]; f32x4 Nn[2][4], Dd[2][4];
#define R2_READS(s_, p_) do { _Pragma("unroll") for (int mt = 0; mt < 4; ++mt) { \
                A[p_][mt][0] = *(const LAS3 v4u*)(Lb + (s_) * R2_SLOT + mt * 2048 + offA0); A[p_][mt][1] = *(const LAS3 v4u*)(Lb + (s_) * R2_SLOT + mt * 2048 + offA1); \
                Nn[p_][mt] = *(const LAS3 f32x4*)(Lb + (s_) * R2_SLOT + offN[mt]); Dd[p_][mt] = *(const LAS3 f32x4*)(Lb + (s_) * R2_SLOT + mt * 64 + offD); } } while (0)
        R2_WAITS(0, 0); R2_READS(0, 0);
        asm volatile("s_waitcnt lgkmcnt(0)" ::: "memory");
#pragma unroll 1
        for (int c0 = 0; c0 < 128; c0 += R2_NS) {
#pragma unroll
            for (int k = 0; k < R2_NS; ++k) { const int c = c0 + k;
                if (c < 128) {
                    R2_MARKS(k) = 0xffffffffu; flg[16] = (unsigned)(c + 1);
                    if (c + 1 < 128) { R2_WAITS(c + 1, (k + 1) % R2_NS); R2_READS((k + 1) % R2_NS, (k + 1) & 1); }
                    bf16* sp = S0 + (size_t)c * (8 * 4096); v2u sb[4];
#pragma unroll
                    for (int m = 0; m < 4; ++m) { sb[m] = pack4(S[m]); *(v2u*)(sp + 16 * m) = sb[m]; }
                    const v4u b0 = {sb[0].x, sb[0].y, sb[1].x, sb[1].y}, b1 = {sb[2].x, sb[2].y, sb[3].x, sb[3].y};
                    const bf16x8 B0 = __builtin_bit_cast(bf16x8, b0), B1 = __builtin_bit_cast(bf16x8, b1);
                    f32x4 acc[4];
#pragma unroll
                    for (int mt = 0; mt < 4; ++mt) acc[mt] = __builtin_amdgcn_mfma_f32_16x16x32_bf16(__builtin_bit_cast(bf16x8, A[k & 1][mt][0]), B0, Nn[k & 1][mt] + S[mt] * Dd[k & 1][mt], 0, 0, 0);
#pragma unroll
                    for (int mt = 0; mt < 4; ++mt) S[mt] = __builtin_amdgcn_mfma_f32_16x16x32_bf16(__builtin_bit_cast(bf16x8, A[k & 1][mt][1]), B1, acc[mt], 0, 0, 0);
                    asm volatile("s_waitcnt lgkmcnt(0)" ::: "memory");
                } }
        }
#undef R2_WAITS
#undef R2_MARKS
#undef R2_READS
#define R2_READ 0
#undef R2_READ
    }
    __syncthreads();
}

__device__ __forceinline__ void r3_phase(CArgs& a, size_t uo, int l, int hb, int gw, int NGW, int lane) {
    asm volatile("" : "+v"(lane));
    const int g = lane >> 4, c16 = lane & 15;
    const bf16* U = (const bf16*)(a.ws + WS_U + uo); const bf16* PP = (const bf16*)(a.ws + WS_PP); const bf16* S0 = (const bf16*)(a.ws + WS_S0); const bf16* Y0 = (const bf16*)(a.ws + WS_Y0);
    const float* BON = (const float*)(a.ws + WS_BON2); bf16* MG = (bf16*)(a.ws + WS_XN) + (size_t)hb * MH * D;
    const float* mu_v = a.in[6] + l * 1664 + 1024; const float* lnw = a.in[14] + l * 512; const float* lnb = a.in[15] + l * 512;
    const int erow = 16 * (c16 >> 2) + (c16 & 3);
#pragma unroll 1
    for (int task = gw; task < NUNIT * 4; task += NGW) {
        const int unit = task >> 2, mt = task & 3, ch = unit >> 3, h = unit & 7; const size_t ub = (size_t)unit * 4096;
        const int lr = 64 * ch + 16 * mt + c16; const bf16* urow = U + (size_t)lr * NPAD + 64 * h + 16 * g;
        float vc[16], vp[16], rgf[16];
        unpack8(*(const v4u*)(urow + C_V), vc); unpack8(*(const v4u*)(urow + C_V + 8), vc + 8); unpack8(*(const v4u*)(urow + C_RG), rgf); unpack8(*(const v4u*)(urow + C_RG + 8), rgf + 8);
        if (lr > 0) { unpack8(*(const v4u*)(urow + C_V - NPAD), vp); unpack8(*(const v4u*)(urow + C_V + 8 - NPAD), vp + 8); }
        else {
#pragma unroll
            for (int i = 0; i < 16; ++i) vp[i] = 0.f; }
        const float bon = BON[lr * 8 + h];
        const bf16* pr = PP + ub + (16 * mt + c16) * 64 + 8 * g;
        const bf16x8 B0 = *(const bf16x8*)pr, B1 = *(const bf16x8*)(pr + 32);
        f32x4 Y[4]; bf16x8 SA[4][2];
#pragma unroll
        for (int et = 0; et < 4; ++et) { const bf16* sr = S0 + ub + (erow + 4 * et) * 64 + 8 * g; SA[et][0] = *(const bf16x8*)sr; SA[et][1] = *(const bf16x8*)(sr + 32); }
        const bf16* y0p = Y0 + ub + (16 * mt + c16) * 64 + 16 * g; const v4u y0a = *(const v4u*)y0p, y0b = *(const v4u*)(y0p + 8);
        asm volatile("" ::: "memory");
        { float yf[16]; unpack8(y0a, yf); unpack8(y0b, yf + 8);
#pragma unroll
          for (int et = 0; et < 4; ++et) Y[et] = (f32x4){yf[4 * et], yf[4 * et + 1], yf[4 * et + 2], yf[4 * et + 3]}; }
#pragma unroll
        for (int et = 0; et < 4; ++et) { f32x4 acc = __builtin_amdgcn_mfma_f32_16x16x32_bf16(SA[et][0], B0, Y[et], 0, 0, 0);
            Y[et] = __builtin_amdgcn_mfma_f32_16x16x32_bf16(SA[et][1], B1, acc, 0, 0, 0); }
        const f32x4 sv = (Y[0] + Y[1]) + (Y[2] + Y[3]); float sm = (sv.x + sv.y) + (sv.z + sv.w); sm += __shfl_xor(sm, 16); sm += __shfl_xor(sm, 32);
        const float mean = sm * (1.f / 64.f); float q = 0.f;
#pragma unroll
        for (int et = 0; et < 4; ++et) { const f32x4 dd = Y[et] - mean; q += (dd.x * dd.x + dd.y * dd.y) + (dd.z * dd.z + dd.w * dd.w); }
        q += __shfl_xor(q, 16); q += __shfl_xor(q, 32);
        const float rstd = rsqrtf(q * (1.f / 64.f) + 64e-5f);
        const int cc = 64 * h + 16 * g; float o[16];
#pragma unroll
        for (int et = 0; et < 4; ++et) {
            const f32x4 w4 = *(const f32x4*)(lnw + cc + 4 * et), b4 = *(const f32x4*)(lnb + cc + 4 * et), m4 = *(const f32x4*)(mu_v + cc + 4 * et);
#pragma unroll
            for (int j = 0; j < 4; ++j) { const int i = 4 * et + j; const float vv = vc[i] + (vp[i] - vc[i]) * m4[j]; const float yn = (Y[et][j] - mean) * rstd * w4[j] + b4[j];
                o[i] = (yn + bon * vv) * rgf[i] * sigm(rgf[i]); } }
        bf16* op = MG + (size_t)lr * D + 512 + cc; *(v4u*)op = pack8(o); *(v4u*)(op + 8) = pack8(o + 8);
    }
}

constexpr int OFF_GQI = 17408, OFF_GKI = 26624, OFF_GKST = 35840, OFF_GVT = 45056, OFF_GSC = 63488, OFF_GTOT = 72704, OFF_GBC = 74752;
constexpr size_t WS_QI = 163 * MiB, WS_OI = 167 * MiB, WS_DS = 175 * MiB, WS_GDEC = 183 * MiB, WS_SP = 184 * MiB;
constexpr int NGUNIT = 512;

__device__ __forceinline__ void g1_phase(CArgs& a, size_t uo, int l, unsigned char* L, int tid0, int ufirst, int ustride) {
    asm volatile("" : "+v"(tid0));
    const int wave = __builtin_amdgcn_readfirstlane(tid0 >> 6);
    const bf16* U = (const bf16*)(a.ws + WS_U + uo);
    float* XW = (float*)L; bf16* QI = (bf16*)(L + OFF_GQI); bf16* KI = (bf16*)(L + OFF_GKI); bf16* KST = (bf16*)(L + OFF_GKST); bf16* VT = (bf16*)(L + OFF_GVT); bf16* SC = (bf16*)(L + OFF_GSC);
    float* TOT = (float*)(L + OFF_GTOT); float* BC = (float*)(L + OFF_GBC);
    float* GW = (float*)(L + OFF_GBC + 256);
    int hl = -1;
    v4u Gl0, Gl1, Gq, Gk, Gv0, Gv1;
#define G1_ISSUE(u_) do { const int lr_ = 64 * ((u_) >> 2) + (tid >> 3), h_ = (u_) & 3, dg_ = tid & 7; const bf16* ur_ = U + (size_t)lr_ * NPAD; \
        Gl0 = *(const v4u*)(ur_ + C_GLR); Gl1 = *(const v4u*)(ur_ + C_GLR + 8); Gq = *(const v4u*)(ur_ + C_GQ + 64 * h_ + 8 * dg_); Gk = *(const v4u*)(ur_ + C_GK + 64 * h_ + 8 * dg_); \
        Gv0 = *(const v4u*)(ur_ + C_GV + 128 * h_ + 16 * dg_); Gv1 = *(const v4u*)(ur_ + C_GV + 128 * h_ + 16 * dg_ + 8); } while (0)
#pragma unroll 1
    for (int unit = ufirst; unit < NGUNIT; unit += ustride) {
        int tid = tid0; asm volatile("" : "+v"(tid));
        const int lane = tid & 63, g = lane >> 4, c16 = lane & 15;
        const int ch = unit >> 2, h = unit & 3;
        if (h != hl) { hl = h; LBAR();
            for (int i = tid; i < 16 * 64; i += NTHR) GW[i] = a.in[3][l * 16 * 256 + (i >> 6) * 256 + 64 * h + (i & 63)];
            if (tid < 64) GW[1024 + tid] = a.in[4][l * 256 + 64 * h + tid];
            LBAR(); }
        const int t = tid >> 3, dg = tid & 7, d0 = 8 * dg, lr = 64 * ch + t, hc = 64 * h + d0;
        if (unit == ufirst) G1_ISSUE(unit);
        float q[8], k[8];
        {
            float glr[16]; unpack8(Gl0, glr); unpack8(Gl1, glr + 8);
            float x[8]; const float* gb = GW + 1024 + d0; const float* gu = GW + d0;
#pragma unroll
            for (int i = 0; i < 8; ++i) x[i] = gb[i];
#pragma unroll
            for (int r = 0; r < 16; ++r) { const f32x4 u0 = *(const f32x4*)(gu + r * 64), u1 = *(const f32x4*)(gu + r * 64 + 4);
                x[0] += glr[r] * u0.x; x[1] += glr[r] * u0.y; x[2] += glr[r] * u0.z; x[3] += glr[r] * u0.w; x[4] += glr[r] * u1.x; x[5] += glr[r] * u1.y; x[6] += glr[r] * u1.z; x[7] += glr[r] * u1.w; }
#pragma unroll
            for (int i = 0; i < 8; ++i) XW[t * FP + d0 + i] = (fminf(x[i], 0.f) - __logf(1.f + __expf(-fabsf(x[i])))) * (1.f / 16.f);
            unpack8(Gq, q); unpack8(Gk, k);
            float vv[16]; const int e0 = 16 * dg; unpack8(Gv0, vv); unpack8(Gv1, vv + 8);
            asm volatile("" ::: "memory");
            if (unit + ustride < NGUNIT) G1_ISSUE(unit + ustride);
#pragma unroll
            for (int i = 0; i < 16; ++i) VT[SWC(e0 + i, t)] = (bf16)f2bf(vv[i]);
        }
        LBAR();
        {
            const int d = tid & 63, tb = tid >> 6; float p[8]; float run = 0.f;
#pragma unroll
            for (int i = 0; i < 8; ++i) { run += XW[(8 * tb + i) * FP + d]; p[i] = run; }
            TOT[tb * 64 + d] = run;
            LBAR();
            float off = 0.f;
#pragma unroll
            for (int j = 0; j < 8; ++j) off += (j < tb) ? TOT[j * 64 + d] : 0.f;
#pragma unroll
            for (int i = 0; i < 8; ++i) XW[(8 * tb + i) * FP + d] = off + p[i];
            if (tb == 7) BC[d] = off + run;
        }
        LBAR();
        {
            float qi[8], ki[8];
#pragma unroll
            for (int i = 0; i < 8; ++i) { const float b = XW[t * FP + d0 + i], bc = BC[d0 + i];
                qi[i] = q[i] * 0.125f * __expf(b); ki[i] = k[i] * __expf(-b); KST[SWC(d0 + i, t)] = (bf16)f2bf(k[i] * __expf(bc - b)); }
            const v4u qp = pack8(qi);
            *(v4u*)(QI + t * PITCH + d0) = qp; *(v4u*)(KI + t * PITCH + d0) = pack8(ki);
            *(v4u*)((bf16*)(a.ws + WS_QI) + (size_t)unit * 4096 + t * 64 + d0) = qp;
        }
        LBAR();
        {
            const int tt = wave >> 1; const int tcol = 16 * tt + c16;
#pragma unroll
            for (int j2 = 0; j2 < 2; ++j2) { const int jt = 2 * (wave & 1) + j2; f32x4 acc = {0.f, 0.f, 0.f, 0.f};
                if (jt <= tt) { acc = mma2(KI + (16 * jt + c16) * PITCH + 8 * g, QI + tcol * PITCH + 8 * g, acc);
#pragma unroll
                    for (int j = 0; j < 4; ++j) if (16 * jt + 4 * g + j > tcol) acc[j] = 0.f; }
                *(v2u*)(SC + tcol * PITCH + 16 * jt + 4 * g) = pack4(acc); }
            bf16* DSg = (bf16*)(a.ws + WS_DS) + (size_t)unit * 8192;
#pragma unroll
            for (int i = 0; i < 4; ++i) { const int tile = wave * 4 + i, dt = tile & 3, et = tile >> 2; f32x4 acc = {0.f, 0.f, 0.f, 0.f};
                { const int ar = 16 * dt + c16, br = 16 * et + c16; acc = mma2s(KST + ar * PITCH, SWK(ar), VT + br * PITCH, SWK(br), g, acc); }
                *(v2u*)(DSg + (16 * et + c16) * 64 + 16 * dt + 4 * g) = pack4(acc); }
            if (tid < 64) ((float*)(a.ws + WS_GDEC))[unit * 64 + tid] = __expf(BC[tid]);
        }
        LBAR();
        {
            bf16* OIg = (bf16*)(a.ws + WS_OI) + (size_t)unit * 8192;
#pragma unroll
            for (int i = 0; i < 4; ++i) { const int tile = wave * 4 + i, tt = tile & 3, et = tile >> 2; f32x4 acc = {0.f, 0.f, 0.f, 0.f};
                { const int ar = 16 * et + c16; acc = mma2s(VT + ar * PITCH, SWK(ar), SC + (16 * tt + c16) * PITCH, 0, g, acc); }
                *(v2u*)(OIg + (16 * tt + c16) * 128 + 16 * et + 4 * g) = pack4(acc); }
        }
        LBAR();
    }
}

__device__ __forceinline__ void g2_scan(CArgs& a, int wg, unsigned char* L, int tid) {
    asm volatile("" : "+v"(tid));
    const int h = wg >> 2, e = 32 * (wg & 3) + (tid >> 4), dq = tid & 15;
    const bf16* DS = (const bf16*)(a.ws + WS_DS) + (size_t)h * 8192 + e * 64 + 4 * dq; const float* GD = (const float*)(a.ws + WS_GDEC) + (size_t)(((tid >> 4) & 15) * 4 + h) * 64 + 4 * dq;
    bf16* SP = (bf16*)(a.ws + WS_SP) + (size_t)h * 8192 + e * 64 + 4 * dq;
    float* DCL = (float*)L;
    v2u dsb[2][16]; f32x4 dcr;
    f32x4 S = {0.f, 0.f, 0.f, 0.f};
#pragma unroll
    for (int i = 0; i < 16; ++i) dsb[0][i] = *(const v2u*)(DS + (size_t)i * (4 * 8192));
    dcr = *(const f32x4*)GD;
    if (tid < 256) *(f32x4*)(DCL + (tid >> 4) * 64 + 4 * dq) = dcr;
#pragma unroll 1
    for (int b2 = 0; b2 < 8; b2 += 2) {
#pragma unroll
        for (int bb = 0; bb < 2; ++bb) { const int b = b2 + bb;
            if (b + 1 < 8) {
#pragma unroll
                for (int i = 0; i < 16; ++i) dsb[(bb + 1) & 1][i] = *(const v2u*)(DS + (size_t)(16 * (b + 1) + i) * (4 * 8192));
                dcr = *(const f32x4*)(GD + (size_t)(16 * (b + 1)) * (4 * 64)); }
            LBAR();
            const float* dcl = DCL + bb * 1024 + 4 * dq;
#pragma unroll
            for (int i = 0; i < 16; ++i) { const f32x4 dc = *(const f32x4*)(dcl + i * 64); const v2u w = dsb[bb][i];
                *(v2u*)(SP + (size_t)(16 * b + i) * (4 * 8192)) = pack4(S);
                const f32x4 dv = {bf2f(w.x & 0xffffu), bf2f(w.x >> 16), bf2f(w.y & 0xffffu), bf2f(w.y >> 16)};
                S = S * dc + dv; }
            if (b + 1 < 8 && tid < 256) *(f32x4*)(DCL + ((bb + 1) & 1) * 1024 + (tid >> 4) * 64 + 4 * dq) = dcr;
        }
    }
    LBAR();
}

__device__ __forceinline__ void g3_phase(CArgs& a, size_t uo, int l, int hb, int gw, int NGW, int lane) {
    asm volatile("" : "+v"(lane));
    const int g = lane >> 4, c16 = lane & 15;
    const bf16* U = (const bf16*)(a.ws + WS_U + uo); const bf16* QI = (const bf16*)(a.ws + WS_QI); const bf16* SP = (const bf16*)(a.ws + WS_SP); const bf16* OI = (const bf16*)(a.ws + WS_OI);
    bf16* MG = (bf16*)(a.ws + WS_XN) + (size_t)hb * MH * D; const float* gnw = a.in[5] + l * 128;
    const int erow = 32 * (c16 >> 2) + (c16 & 3);
#pragma unroll 1
    for (int task = gw; task < NGUNIT * 4; task += NGW) {
        const int unit = task >> 2, mt = task & 3, ch = unit >> 2, h = unit & 3;
        const int lr = 64 * ch + 16 * mt + c16; const bf16* urow = U + (size_t)lr * NPAD + C_GG + 128 * h + 32 * g;
        const v4u gg0 = *(const v4u*)urow, gg1 = *(const v4u*)(urow + 8), gg2 = *(const v4u*)(urow + 16), gg3 = *(const v4u*)(urow + 24);
        const bf16* qr = QI + (size_t)unit * 4096 + (16 * mt + c16) * 64 + 8 * g;
        const bf16x8 B0 = *(const bf16x8*)qr, B1 = *(const bf16x8*)(qr + 32);
        f32x4 O[8]; float ss = 0.f; bf16x8 SA[8][2];
#pragma unroll
        for (int et = 0; et < 8; ++et) { const bf16* sr = SP + (size_t)unit * 8192 + (erow + 4 * et) * 64 + 8 * g; SA[et][0] = *(const bf16x8*)sr; SA[et][1] = *(const bf16x8*)(sr + 32); }
        const bf16* oip = OI + (size_t)unit * 8192 + (16 * mt + c16) * 128 + 32 * g; const v4u oi0 = *(const v4u*)oip, oi1 = *(const v4u*)(oip + 8), oi2 = *(const v4u*)(oip + 16), oi3 = *(const v4u*)(oip + 24);
        asm volatile("" ::: "memory");
        { float of[32]; unpack8(oi0, of); unpack8(oi1, of + 8); unpack8(oi2, of + 16); unpack8(oi3, of + 24);
#pragma unroll
          for (int et = 0; et < 8; ++et) O[et] = (f32x4){of[4 * et], of[4 * et + 1], of[4 * et + 2], of[4 * et + 3]}; }
#pragma unroll
        for (int et = 0; et < 8; ++et) { f32x4 acc = __builtin_amdgcn_mfma_f32_16x16x32_bf16(SA[et][0], B0, O[et], 0, 0, 0);
            acc = __builtin_amdgcn_mfma_f32_16x16x32_bf16(SA[et][1], B1, acc, 0, 0, 0);
            O[et] = acc; ss += (acc.x * acc.x + acc.y * acc.y) + (acc.z * acc.z + acc.w * acc.w); }
        ss += __shfl_xor(ss, 16); ss += __shfl_xor(ss, 32);
        const float rstd = rsqrtf(ss * (1.f / 128.f) + 1e-6f);
        float gf[32], o[32]; unpack8(gg0, gf); unpack8(gg1, gf + 8); unpack8(gg2, gf + 16); unpack8(gg3, gf + 24);
#pragma unroll
        for (int et = 0; et < 8; ++et) { const f32x4 w4 = *(const f32x4*)(gnw + 32 * g + 4 * et);
#pragma unroll
            for (int j = 0; j < 4; ++j) { const int i = 4 * et + j; o[i] = O[et][j] * rstd * w4[j] * gf[i] * sigm(gf[i]); } }
        bf16* op = MG + (size_t)lr * D + 128 * h + 32 * g;
        *(v4u*)op = pack8(o); *(v4u*)(op + 8) = pack8(o + 8); *(v4u*)(op + 16) = pack8(o + 16); *(v4u*)(op + 24) = pack8(o + 24);
    }
}

#define LAS __attribute__((address_space(3)))
#define XB_TMO      128
#define XB_XCNT(j)  (256  + 64 * (j))
#define XB_XSUB(j)  (1280 + 64 * (j))
#define XB_XGEN(j)  (2304 + 64 * (j))
#define XB_TOP      3328
#define XB_TOPGEN   3392
#define XCD_BAR_WORDS 3456
#define XB_SPIN_CAP (1u << 18)

__device__ __forceinline__ unsigned xb_ld(unsigned* p)              { return __hip_atomic_load(p, __ATOMIC_RELAXED, __HIP_MEMORY_SCOPE_AGENT); }
__device__ __forceinline__ unsigned xb_add(unsigned* p, unsigned v) { return __hip_atomic_fetch_add(p, v, __ATOMIC_RELAXED, __HIP_MEMORY_SCOPE_AGENT); }
__device__ __forceinline__ unsigned xb_xcc_id() { return (unsigned)__builtin_amdgcn_s_getreg((3 << 11) | 20) & 0xFu; }
#define XB_SPIN(cond, bar) do { unsigned _sp = 0; while (cond) { __builtin_amdgcn_s_sleep(1); \
    if ((++_sp & 255u) == 0u) { if (xb_ld(&(bar)[XB_TMO])) break; if (_sp > XB_SPIN_CAP) { atomicAdd(&(bar)[XB_TMO], 1u); break; } } } } while (0)

struct XcdBarrier {
    unsigned* bar; unsigned x;
    volatile LAS unsigned* st;
};

__device__ __forceinline__ XcdBarrier xcd_barrier_post(unsigned* bar, volatile LAS unsigned* st) {
    XcdBarrier b; b.bar = bar; b.x = xb_xcc_id(); b.st = st;
    if (threadIdx.x == 0) (void)xb_add(&bar[XB_XCNT(b.x)], 1u);
    return b;
}
__device__ __forceinline__ void xcd_barrier_complete(unsigned* bar, unsigned x, unsigned& nloc, unsigned& nx) {
    const unsigned G = gridDim.x * gridDim.y * gridDim.z;
    unsigned sum, cnt, mine, sp = 0u;
    for (;;) {
        sum = 0u; cnt = 0u; mine = 0u;
#pragma unroll
        for (unsigned j = 0; j < 16; ++j) { const unsigned c = xb_ld(&bar[XB_XCNT(j)]); sum += c; cnt += (c > 0u) ? 1u : 0u; mine = (j == x) ? c : mine; }
        if (sum == G) break;
        __builtin_amdgcn_s_sleep(1);
        if ((++sp & 255u) == 0u) { if (xb_ld(&bar[XB_TMO])) break; if (sp > XB_SPIN_CAP) { atomicAdd(&bar[XB_TMO], 1u); break; } }
    }
    nloc = mine > 0u ? mine : 1u; nx = cnt > 0u ? cnt : 1u;
}

__device__ __forceinline__ void xcd_barrier(const XcdBarrier& b) {
    asm volatile("s_waitcnt vmcnt(0)" ::: "memory");
    __syncthreads();
    if (threadIdx.x == 0) {
        unsigned* bar = b.bar;
        __builtin_amdgcn_s_waitcnt(0);
        unsigned nloc = b.st[0], nx = b.st[1];
        if (nloc == 0u) { xcd_barrier_complete(bar, b.x, nloc, nx); b.st[0] = nloc; b.st[1] = nx; }
        const unsigned old = xb_add(&bar[XB_XSUB(b.x)], 1u);
        const unsigned gen = old / nloc;
        if (old + 1u == (gen + 1u) * nloc) {
            __builtin_amdgcn_fence(__ATOMIC_RELEASE, "agent");
            asm volatile("s_waitcnt vmcnt(0)" ::: "memory");
            const unsigned og = xb_add(&bar[XB_TOP], 1u);
            const unsigned tg = og / nx;
            if (og + 1u == (tg + 1u) * nx) xb_add(&bar[XB_TOPGEN], 1u);
            else XB_SPIN(xb_ld(&bar[XB_TOPGEN]) == tg, bar);
            __builtin_amdgcn_fence(__ATOMIC_ACQUIRE, "agent");
            xb_add(&bar[XB_XGEN(b.x)], 1u);
            asm volatile("s_waitcnt vmcnt(0)" ::: "memory");
        } else {
            XB_SPIN(xb_ld(&bar[XB_XGEN(b.x)]) == gen, bar);
            __builtin_amdgcn_fence(__ATOMIC_ACQUIRE, "agent");
            asm volatile("s_waitcnt vmcnt(0)" ::: "memory");
        }
    }
    __syncthreads();
}


__global__ void __launch_bounds__(NTHR, 2) hymba_fwd(Args a_kernarg) {
    extern __shared__ __attribute__((aligned(16))) unsigned char lds[];
    cg::grid_group grid = cg::this_grid();
    const int tid = threadIdx.x, lane = tid & 63, wave = __builtin_amdgcn_readfirstlane(tid >> 6);
    const int G = gridDim.x, gw = blockIdx.x * NWAVES + wave, NGW = G * NWAVES;
    volatile LAS unsigned* xst = (volatile LAS unsigned*)(LAS unsigned char*)(lds + LDS_BYTES - 64);
    if (tid < 2) xst[tid] = 0u;
    __syncthreads();
    const XcdBarrier xbar = xcd_barrier_post((unsigned*)AA.ws, xst);
    {
        CArgs& a = AA; bf16* XN = (bf16*)(a.ws + WS_XN);
        float* scr = (float*)lds;
        constexpr int T_IN = (D / 64) * (NPAD / 64), T_OUT = (D / 64) * (D / 64);
        for (int l = 0; l < 2; ++l) {
            transpose_tiles(a.in[2] + (size_t)l * D * NIN, D, NIN, NPAD, (bf16*)(a.ws + WS_WIN + l * WIN_BYTES), scr, (int)blockIdx.x, G, T_IN, tid);
            transpose_tiles(a.in[16] + (size_t)l * D * D, D, D, D, (bf16*)(a.ws + WS_WOUT + l * WOUT_BYTES), scr, (int)blockIdx.x, G, T_OUT, tid);
        }
        for (int m = 2 * gw; m < M; m += 2 * NGW) rms_row2(a.in[0] + (size_t)m * D, a.in[0] + (size_t)(m + 1) * D, a.in[1], XN + (size_t)m * D, XN + (size_t)(m + 1) * D, lane);
        {
            bf16* UPT = (bf16*)(a.ws + WS_UPT);
            for (int e = blockIdx.x * NTHR + tid; e < 2 * 2 * 512 * 64; e += G * NTHR) { const int r = e & 63, c = (e >> 6) & 511, q = (e >> 15) & 1, ll = e >> 16;
                UPT[e] = (bf16)f2bf((q ? a.in[10] : a.in[8])[(size_t)ll * 64 * 512 + r * 512 + c]); }
        }
    }
    if (AA.ws == nullptr) grid.sync();
    xcd_barrier(xbar);
    for (int l = 0; l < 2; ++l) {
        for (int hb = 0; hb < 2; ++hb) {
            {
                CArgs& a = AA; bf16* XN = (bf16*)(a.ws + WS_XN); bf16* U = (bf16*)(a.ws + WS_U + (size_t)hb * U_STRIDE);
                pg8::Gemm g{XN + (size_t)hb * MH * D, (const bf16*)(a.ws + WS_WIN + l * WIN_BYTES), MH, NPAD, D}; pg8::RangeOrder S;
                if (hb == 0) S.init(MH, NPAD, G, (int)blockIdx.x, 0, 480); else S.init(MH, NPAD, G, (int)blockIdx.x, EARLY_TILES, 480 - EARLY_TILES);
                pg8::EpiBf16<0> E{U, NPAD, nullptr, 0, 0, 1.f};
                pg8::gemm_phase<pg8::EpiBf16<0>, pg8::RangeOrder, true, true>((PG8_LAS unsigned char*)lds, g, S, E);
            }
            xcd_barrier(xbar);
            const size_t uo = (size_t)hb * U_STRIDE;
            r1_phase(AA, uo, l, lds, tid);
            g1_phase(AA, uo, l, lds, tid, (int)blockIdx.x, G);
            xcd_barrier(xbar);
            if (blockIdx.x < 32) r2_scan(AA, blockIdx.x, lds, tid);
            else { if (blockIdx.x < 48) g2_scan(AA, blockIdx.x - 32, lds, tid);
                if (hb == 0) {
                    CArgs& a = AA; bf16* XN = (bf16*)(a.ws + WS_XN); bf16* U1 = (bf16*)(a.ws + WS_U1);
                    pg8::Gemm g{XN + (size_t)MH * D, (const bf16*)(a.ws + WS_WIN + l * WIN_BYTES), MH, NPAD, D}; pg8::RangeOrder S; S.init(MH, NPAD, G, (int)blockIdx.x - 32, 0, EARLY_TILES);
                    pg8::EpiBf16<0> E{U1, NPAD, nullptr, 0, 0, 1.f};
                    pg8::gemm_phase<pg8::EpiBf16<0>, pg8::RangeOrder, true, true>((PG8_LAS unsigned char*)lds, g, S, E); } }
            xcd_barrier(xbar);
            r3_phase(AA, uo, l, hb, gw, NGW, lane);
            g3_phase(AA, uo, l, hb, gw, NGW, lane);
            if (hb == 1) xcd_barrier(xbar);
        }
        {
            CArgs& a = AA; bf16* XN = (bf16*)(a.ws + WS_XN);
            pg8::Gemm g{XN, (const bf16*)(a.ws + WS_WOUT + l * WOUT_BYTES), M, D, D}; pg8::StaticOrder S; S.init(M, D, G, (int)blockIdx.x);
            pg8::EpiRmsRes E{l == 0 ? a.in[0] : a.out, a.out, XN, l == 0 ? a.in[1] + D : a.in[17], (float*)(a.ws + WS_SLOTS) + (size_t)l * M * 4, (unsigned*)(a.ws + 16384) + l * 64 * 64, D, l};
            pg8::gemm_phase<pg8::EpiRmsRes, pg8::StaticOrder, false, true>((PG8_LAS unsigned char*)lds, g, S, E);
        }
        if (l == 0) xcd_barrier(xbar);
    }
}

extern "C" void kernel_launch(void* const* d_in, const int* in_sizes, int n_in, void* d_out, int out_size, void* d_ws, size_t ws_size, hipStream_t stream) {
    static int grid = 0;
    if (grid == 0) {
        if (n_in != 18 || out_size != M * D || ws_size < WS_END) { fprintf(stderr, "kernel_launch: unexpected shapes n_in %d out %d ws %zu\n", n_in, out_size, ws_size); grid = -1; return; }
        int dev = 0, cus = 0, per_cu = 0;
        hipGetDevice(&dev); hipDeviceGetAttribute(&cus, hipDeviceAttributeMultiprocessorCount, dev);
        if (hipFuncSetAttribute((const void*)hymba_fwd, hipFuncAttributeMaxDynamicSharedMemorySize, LDS_BYTES) != hipSuccess) { fprintf(stderr, "kernel_launch: hipFuncSetAttribute failed\n"); grid = -1; return; }
        if (hipOccupancyMaxActiveBlocksPerMultiprocessor(&per_cu, (const void*)hymba_fwd, NTHR, LDS_BYTES) != hipSuccess || per_cu < 1) { fprintf(stderr, "kernel_launch: occupancy query failed (%d)\n", per_cu); grid = -1; return; }
        grid = cus * 1;
        fprintf(stderr, "kernel_launch: cus %d per_cu %d grid %d\n", cus, per_cu, grid);
    }
    if (grid < 0) return;
    if (hipMemsetAsync(d_ws, 0, 65536, stream) != hipSuccess) { fprintf(stderr, "kernel_launch: memset failed\n"); return; }
    Args a{};
    for (int i = 0; i < 18; ++i) a.in[i] = (const float*)d_in[i];
    a.out = (float*)d_out; a.ws = (unsigned char*)d_ws;
    void* args[] = {&a};
    hipError_t e = hipLaunchCooperativeKernel((const void*)hymba_fwd, dim3(grid), dim3(NTHR), args, LDS_BYTES, stream);
    if (e != hipSuccess) fprintf(stderr, "cooperative launch failed: %s (grid %d)\n", hipGetErrorString(e), grid);
}
```

```cpp
#include <hip/hip_runtime.h>
#include <hip/hip_cooperative_groups.h>
#include <cstdio>
#include <cstdint>
namespace cg = cooperative_groups;
namespace pg8 {
#define PG8_LAS __attribute__((address_space(3)))
typedef unsigned short bf16_t;
typedef short bf16x8 __attribute__((ext_vector_type(8)));
typedef float f32x4 __attribute__((ext_vector_type(4)));
typedef unsigned u32x4 __attribute__((ext_vector_type(4)));
constexpr int BM = 256, BK = 64, HALF = 128, HTB = HALF * BK * 2  , STAGE_BYTES = 8 * HTB, NXCD = 8, WGM = 8;

__host__ __device__ __forceinline__ int lds_byte(int r, int c) { const int st = (r >> 4) * 2 + (c >> 5), rr = r & 15, cc = c & 31, ob = rr * 64 + cc * 2; return st * 1024 + (ob ^ (((ob >> 9) & 1) << 5)); }
__host__ __device__ __forceinline__ void stage_rc(int b, int& R, int& C) { const int st = b / 1024, sb = b % 1024, swz = sb ^ (((sb >> 9) & 1) << 5); R = (st >> 1) * 16 + swz / 64; C = (st & 1) * 32 + (swz % 64) / 2; }
__host__ __device__ __forceinline__ int perm32(int rho) { const int n = rho >> 4, i = rho & 15; return 8 * (i >> 2) + 4 * n + (i & 3); }

struct Unit { int pm, pn; };
struct Gemm { const bf16_t* A; const bf16_t* Bt; int M, N, K; };

struct StaticOrder {
    int nM, nN, nwg, G, c;
    __host__ __device__ void init(int M, int N, int G_, int c_) { nM = M / BM; nN = N / BM; nwg = nM * nN; G = G_; c = c_; }
    __host__ __device__ bool next(int i, Unit& u) const {
        const long L = (long)i * G + c; if (L >= nwg) return false;
        int wgid = (int)L; { const int q = nwg / NXCD, r = nwg % NXCD, xcd = wgid % NXCD, off = wgid / NXCD; wgid = (xcd < r ? xcd * (q + 1) : r * (q + 1) + (xcd - r) * q) + off; }
        const int nig = WGM * nN, gid = wgid / nig, fm = gid * WGM, gsz = (nM - fm) < WGM ? (nM - fm) : WGM;
        u.pm = fm + ((wgid % nig) % gsz); u.pn = (wgid % nig) / gsz; return true;
    }
    __device__ __forceinline__ void a_ready(const Unit&) const {}
    __device__ __forceinline__ void done(const Unit&) const {}
};

__device__ __forceinline__ unsigned cvt_pk_bf16(float lo, float hi) { unsigned r; asm volatile("v_cvt_pk_bf16_f32 %0, %1, %2" : "=v"(r) : "v"(lo), "v"(hi)); return r; }
typedef float f32x2 __attribute__((ext_vector_type(2)));
__device__ __forceinline__ f32x2 gelu_pk(f32x2 v) {
    const f32x2 av = __builtin_elementwise_abs(v), d = av * 0.2316418882f + 1.0f;
    f32x2 t; t.x = __builtin_amdgcn_rcpf(d.x); t.y = __builtin_amdgcn_rcpf(d.y);
    f32x2 q = t * 0.5307027145f + (-0.7265760135f); q = q * t + 0.7107068705f; q = q * t + (-0.142248368f); q = q * t + 0.127414796f; q = q * t;
    const f32x2 s = (v * v) * (-0.72134752044f);
    f32x2 e; e.x = __builtin_amdgcn_exp2f(s.x); e.y = __builtin_amdgcn_exp2f(s.y);
    const f32x2 m = v * (q * e), r = v - m;
    f32x2 o; o.x = v.x < 0.f ? m.x : r.x; o.y = v.y < 0.f ? m.y : r.y; return o;
}

template <int ACT  > struct EpiBf16 {
    static constexpr bool PERM = true, AFTER_DRAIN = false; static_assert(ACT == 0 || ACT == 1, "EpiBf16: ACT is 0 (none) or 1 (gelu_pk)");
    bf16_t* O; int ldc; const float* bias; int split_cols; size_t split_stride; float scale0;
    __device__ __forceinline__ void operator()(const f32x4 (&acc)[2][2][4][2], const Unit& u, int wr, int wc, int fr, int fq) const {
        const int row0 = u.pm * BM + wr * 64 + fr; int colt = u.pn * BM; bf16_t* base = O;
        float sc = 1.f; if (split_cols) { const int t = colt / split_cols; base += (size_t)t * split_stride; colt -= t * split_cols; if (t == 0) sc = scale0; }
        const int col0 = colt + wc * 32 + 8 * fq, bcol0 = u.pn * BM + wc * 32 + 8 * fq;
        f32x4 bv[2][2];
#pragma unroll
        for (int bj = 0; bj < 2; ++bj)
#pragma unroll
            for (int n = 0; n < 2; ++n) bv[bj][n] = bias ? *(const f32x4*)(bias + bcol0 + bj * HALF + 4 * n) : (f32x4){0.f, 0.f, 0.f, 0.f};
#pragma unroll
        for (int ai = 0; ai < 2; ++ai)
#pragma unroll
            for (int m = 0; m < 4; ++m) { bf16_t* rowp = base + (size_t)(row0 + ai * HALF + m * 16) * ldc + col0;
#pragma unroll
                for (int bj = 0; bj < 2; ++bj) { f32x4 v0 = acc[ai][bj][m][0] + bv[bj][0], v1 = acc[ai][bj][m][1] + bv[bj][1];
                    if (ACT == 1) { f32x2 a = gelu_pk((f32x2){v0[0], v0[1]}), b = gelu_pk((f32x2){v0[2], v0[3]}), c = gelu_pk((f32x2){v1[0], v1[1]}), d = gelu_pk((f32x2){v1[2], v1[3]});
                        v0 = (f32x4){a.x, a.y, b.x, b.y}; v1 = (f32x4){c.x, c.y, d.x, d.y}; }
                    v0 = v0 * sc; v1 = v1 * sc; u32x4 w; w.x = cvt_pk_bf16(v0[0], v0[1]); w.y = cvt_pk_bf16(v0[2], v0[3]); w.z = cvt_pk_bf16(v1[0], v1[1]); w.w = cvt_pk_bf16(v1[2], v1[3]);
                    *(u32x4*)(rowp + bj * HALF) = w; } }
    }
};

template <class Epi, class Sched, bool ALIGN_EPI = false, bool SP2 = false>
__device__ __forceinline__ void gemm_phase(PG8_LAS unsigned char* lds, const Gemm g, const Sched& S, const Epi& E) {
    int tid_ = threadIdx.x; asm volatile("" : "+v"(tid_));
    const int tid = tid_, wid = __builtin_amdgcn_readfirstlane(tid >> 6), lane = tid & 63, wr = wid >> 2, wc = wid & 3, fr = lane & 15, fq = lane >> 4;
    const int K = g.K, nt = K / BK;
    unsigned voffA[2], voffB[2];
#pragma unroll
    for (int i = 0; i < 2; ++i) { int R, C; stage_rc(tid * 16 + i * 8192, R, C); const int Rb = Epi::PERM ? ((R & ~31) + perm32(R & 31)) : R;
        voffA[i] = (unsigned)(R * K + C) * 2u; voffB[i] = (unsigned)(Rb * K + C) * 2u; }
    const size_t kstep = (size_t)(BK * 2);
    const size_t hstep = (size_t)HALF * K * 2;
    const size_t tstep = 2 * hstep;
    const unsigned ldsw = (unsigned)wid * 1024u;
    const int aoff = lds_byte(wr * 64 + fr, fq * 8), boff = lds_byte(wc * 32 + fr, fq * 8);
#define PG8_SA(b, h) (((b) * 2 + (h)) * HTB)
#define PG8_SB(b, h) ((4 + (b) * 2 + (h)) * HTB)
#define PG8_STAGE(bufoff, gbase, voff) do { _Pragma("unroll") for (int _i = 0; _i < 2; ++_i) \
        __builtin_amdgcn_global_load_lds((const unsigned*)((const char*)(gbase) + (voff)[_i]), (PG8_LAS unsigned*)(lds + (bufoff) + ldsw + _i * 8192), 16, 0, 0); } while (0)
#define PG8_LDA(dst, b, h) do { _Pragma("unroll") for (int m = 0; m < 4; ++m) _Pragma("unroll") for (int k = 0; k < 2; ++k) dst[m][k] = *(const PG8_LAS bf16x8*)(lds + PG8_SA(b, h) + aoff + m * 2048 + k * 1024); } while (0)
#define PG8_LDB(dst, b, h) do { _Pragma("unroll") for (int n = 0; n < 2; ++n) _Pragma("unroll") for (int k = 0; k < 2; ++k) dst[n][k] = *(const PG8_LAS bf16x8*)(lds + PG8_SB(b, h) + boff + n * 2048 + k * 1024); } while (0)
#define PG8_MMA(ai, bj, At, Bt) do { __builtin_amdgcn_s_setprio(1); _Pragma("unroll") for (int m = 0; m < 4; ++m) _Pragma("unroll") for (int n = 0; n < 2; ++n) _Pragma("unroll") for (int k = 0; k < 2; ++k) \
        acc[ai][bj][m][n] = __builtin_amdgcn_mfma_f32_16x16x32_bf16(Bt[n][k], At[m][k], acc[ai][bj][m][n], 0, 0, 0); __builtin_amdgcn_s_setprio(0); } while (0)
#define PG8_WAIT_V(n) asm volatile("s_waitcnt vmcnt(" #n ")" ::: "memory")
#define PG8_WAIT_L(n) asm volatile("s_waitcnt lgkmcnt(" #n ")" ::: "memory")
#define PG8_BAR __builtin_amdgcn_s_barrier()
#define PG8_SCHED __builtin_amdgcn_sched_barrier(0)
    Unit cur, nxt; int ui = 0;
    if (!S.next(0, cur)) return;
    f32x4 acc[2][2][4][2];
#pragma unroll
    for (int a = 0; a < 2; ++a)
#pragma unroll
        for (int b = 0; b < 2; ++b)
#pragma unroll
            for (int m = 0; m < 4; ++m)
#pragma unroll
                for (int n = 0; n < 2; ++n) acc[a][b][m][n] = (f32x4){0.f, 0.f, 0.f, 0.f};
    bf16x8 At[4][2], B0[2][2], B1[2][2];
    const char* cA = (const char*)g.A + (size_t)cur.pm * tstep; const char* cB = (const char*)g.Bt + (size_t)cur.pn * tstep;
    S.a_ready(cur);
    if constexpr (SP2) {
        PG8_STAGE(PG8_SB(0, 0), cB, voffB); PG8_STAGE(PG8_SB(0, 1), cB + hstep, voffB); PG8_STAGE(PG8_SA(0, 0), cA, voffA); PG8_STAGE(PG8_SA(0, 1), cA + hstep, voffA);
        if (wr == 1) PG8_BAR;
        PG8_WAIT_V(2); PG8_BAR;
        PG8_STAGE(PG8_SB(1, 0), cB + kstep, voffB); PG8_STAGE(PG8_SA(1, 0), cA + kstep, voffA); PG8_STAGE(PG8_SB(1, 1), cB + hstep + kstep, voffB);
        PG8_WAIT_V(6); PG8_BAR;
    } else {
        PG8_STAGE(PG8_SB(0, 0), cB, voffB); PG8_STAGE(PG8_SA(0, 0), cA, voffA); PG8_STAGE(PG8_SB(0, 1), cB + hstep, voffB); PG8_STAGE(PG8_SA(0, 1), cA + hstep, voffA);
        if (wr == 1) PG8_BAR;
        PG8_WAIT_V(4); PG8_BAR;
        PG8_STAGE(PG8_SB(1, 0), cB + kstep, voffB); PG8_STAGE(PG8_SA(1, 0), cA + kstep, voffA); PG8_STAGE(PG8_SB(1, 1), cB + hstep + kstep, voffB);
        PG8_WAIT_V(6); PG8_BAR;
    }
    for (;;) {
        const bool has_next = S.next(ui + 1, nxt);
        const char* nA = has_next ? (const char*)g.A + (size_t)nxt.pm * tstep : cA; const char* nB = has_next ? (const char*)g.Bt + (size_t)nxt.pn * tstep : cB;
        for (int t = 0; t < nt; t += 2) {
            const bool last = (t == nt - 2);
            const char* a1 = cA + (size_t)(t + 1) * kstep;
            const char* a2 = last ? nA : cA + (size_t)(t + 2) * kstep; const char* b2 = last ? nB : cB + (size_t)(t + 2) * kstep;
            const char* a3 = a2 + kstep; const char* b3 = b2 + kstep;
            if (last && has_next) S.a_ready(nxt);
            if constexpr (SP2) {
            PG8_LDB(B0, 0, 0); PG8_LDB(B1, 0, 1); PG8_SCHED; PG8_LDA(At, 0, 0); PG8_STAGE(PG8_SA(1, 1), a1 + hstep, voffA);
            PG8_WAIT_V(8); PG8_WAIT_L(0); PG8_BAR; PG8_MMA(0, 0, At, B0); PG8_MMA(0, 1, At, B1); PG8_BAR; PG8_SCHED;
            PG8_LDA(At, 0, 1); PG8_STAGE(PG8_SB(0, 0), b2, voffB); PG8_STAGE(PG8_SB(0, 1), b2 + hstep, voffB); PG8_STAGE(PG8_SA(0, 0), a2, voffA);
            PG8_WAIT_V(8); PG8_WAIT_L(0); PG8_BAR; PG8_MMA(1, 0, At, B0); PG8_MMA(1, 1, At, B1); PG8_BAR; PG8_SCHED;
            PG8_LDB(B0, 1, 0); PG8_LDB(B1, 1, 1); PG8_SCHED; PG8_LDA(At, 1, 0); PG8_STAGE(PG8_SA(0, 1), a2 + hstep, voffA);
            PG8_WAIT_V(8); PG8_WAIT_L(0); PG8_BAR; PG8_MMA(0, 0, At, B0); PG8_MMA(0, 1, At, B1); PG8_BAR; PG8_SCHED;
            PG8_LDA(At, 1, 1); PG8_STAGE(PG8_SB(1, 0), b3, voffB); PG8_STAGE(PG8_SB(1, 1), b3 + hstep, voffB); PG8_STAGE(PG8_SA(1, 0), a3, voffA);
            PG8_WAIT_V(8); PG8_WAIT_L(0); PG8_BAR; PG8_MMA(1, 0, At, B0); PG8_MMA(1, 1, At, B1); PG8_BAR; PG8_SCHED;
            } else {
            PG8_LDB(B0, 0, 0); PG8_SCHED; PG8_LDA(At, 0, 0); PG8_STAGE(PG8_SA(1, 1), a1 + hstep, voffA);
            PG8_WAIT_L(8); PG8_BAR; PG8_WAIT_L(0); PG8_MMA(0, 0, At, B0); PG8_BAR; PG8_SCHED;
            PG8_LDB(B1, 0, 1); PG8_STAGE(PG8_SB(0, 0), b2, voffB);
            PG8_BAR; PG8_WAIT_L(0); PG8_MMA(0, 1, At, B1); PG8_BAR;
            PG8_LDA(At, 0, 1); PG8_STAGE(PG8_SA(0, 0), a2, voffA);
            PG8_BAR; PG8_WAIT_L(0); PG8_MMA(1, 0, At, B0); PG8_BAR; PG8_SCHED;
            PG8_STAGE(PG8_SB(0, 1), b2 + hstep, voffB);
            PG8_WAIT_V(6); PG8_BAR; PG8_MMA(1, 1, At, B1); PG8_BAR;
            PG8_LDB(B0, 1, 0); PG8_SCHED; PG8_LDA(At, 1, 0); PG8_STAGE(PG8_SA(0, 1), a2 + hstep, voffA);
            PG8_WAIT_L(8); PG8_BAR; PG8_WAIT_L(0); PG8_MMA(0, 0, At, B0); PG8_BAR; PG8_SCHED;
            PG8_LDB(B1, 1, 1); PG8_STAGE(PG8_SB(1, 0), b3, voffB);
            PG8_BAR; PG8_WAIT_L(0); PG8_MMA(0, 1, At, B1); PG8_BAR;
            PG8_LDA(At, 1, 1); PG8_STAGE(PG8_SA(1, 0), a3, voffA);
            PG8_BAR; PG8_WAIT_L(0); PG8_MMA(1, 0, At, B0); PG8_BAR; PG8_SCHED;
            PG8_STAGE(PG8_SB(1, 1), b3 + hstep, voffB);
            PG8_WAIT_V(6); PG8_BAR; PG8_MMA(1, 1, At, B1); PG8_BAR;
            }
        }
        if constexpr (ALIGN_EPI) { if (wr == 0) PG8_BAR; }
        if constexpr (!Epi::AFTER_DRAIN) { E(acc, cur, wr, wc, fr, fq); S.done(cur); }
        if (!has_next) break;
#pragma unroll
        for (int a = 0; a < 2; ++a)
#pragma unroll
            for (int b = 0; b < 2; ++b)
#pragma unroll
                for (int m = 0; m < 4; ++m)
#pragma unroll
                    for (int n = 0; n < 2; ++n) acc[a][b][m][n] = (f32x4){0.f, 0.f, 0.f, 0.f};
        cur = nxt; cA = nA; cB = nB; ++ui;
        if constexpr (ALIGN_EPI) { if (wr == 1) PG8_BAR; }
    }
    PG8_WAIT_V(0);
    if constexpr (!ALIGN_EPI) { if (wr == 0) PG8_BAR; }
    PG8_BAR;
    if constexpr (Epi::AFTER_DRAIN) { E.fused(acc, cur, wr, wc, fr, fq, lds, wid, lane); S.done(cur); }
#undef PG8_SA
#undef PG8_SB
#undef PG8_STAGE
#undef PG8_LDA
#undef PG8_LDB
#undef PG8_MMA
#undef PG8_WAIT_V
#undef PG8_WAIT_L
#undef PG8_BAR
#undef PG8_SCHED
}
}
namespace pg8 {
struct EpiResid {
    static constexpr bool PERM = false, AFTER_DRAIN = false;
    const float* base; float* out; int ldc;
    __device__ __forceinline__ void operator()(const f32x4 (&acc)[2][2][4][2], const Unit& u, int wr, int wc, int fr, int fq) const {
        const int col0 = u.pn * BM + wc * 32 + 4 * fq;
#pragma unroll
        for (int ai = 0; ai < 2; ++ai)
#pragma unroll
            for (int m = 0; m < 4; ++m) { const size_t off = (size_t)(u.pm * BM + ai * HALF + wr * 64 + m * 16 + fr) * ldc + col0;
#pragma unroll
                for (int bj = 0; bj < 2; ++bj)
#pragma unroll
                    for (int n = 0; n < 2; ++n) { const f32x4 b = *(const f32x4*)(base + off + bj * HALF + n * 16); *(f32x4*)(out + off + bj * HALF + n * 16) = b + acc[ai][bj][m][n]; } }
    }
};
struct RangeOrder {
    int nM, nN, nwg, G, c, first, last;
    __host__ __device__ void init(int M, int N, int G_, int c_, int first_, int count_) { nM = M / BM; nN = N / BM; nwg = nM * nN; G = G_; c = c_; first = first_; last = first_ + count_; }
    __host__ __device__ bool next(int i, Unit& u) const {
        const long L = (long)first + (long)i * G + c; if (c < 0 || L >= last || L >= nwg) return false;
        int wgid = (int)L; { const int q = nwg / NXCD, r = nwg % NXCD, xcd = wgid % NXCD, off = wgid / NXCD; wgid = (xcd < r ? xcd * (q + 1) : r * (q + 1) + (xcd - r) * q) + off; }
        const int nig = WGM * nN, gid = wgid / nig, fm = gid * WGM, gsz = (nM - fm) < WGM ? (nM - fm) : WGM;
        u.pm = fm + ((wgid % nig) % gsz); u.pn = (wgid % nig) / gsz; return true;
    }
    __device__ __forceinline__ void a_ready(const Unit&) const {}
    __device__ __forceinline__ void done(const Unit&) const {}
};
struct EpiRmsRes {
    static constexpr bool PERM = false, AFTER_DRAIN = true;
    const float* base; float* out; bf16_t* xn; const float* w; float* slots; unsigned* cnt; int ldc; int mode;
    __device__ __forceinline__ void fused(f32x4 (&acc)[2][2][4][2], const Unit& u, int wr, int wc, int fr, int fq, PG8_LAS unsigned char* lds, int wid, int lane) const {
        const int col0 = u.pn * BM + wc * 32 + 4 * fq;
        PG8_LAS float* P = (PG8_LAS float*)lds; PG8_LAS float* S = (PG8_LAS float*)(lds + 4096);
#pragma unroll
        for (int ai = 0; ai < 2; ++ai)
#pragma unroll
            for (int m = 0; m < 4; ++m) { const size_t off = (size_t)(u.pm * BM + ai * HALF + wr * 64 + m * 16 + fr) * ldc + col0; float s = 0.f;
#pragma unroll
                for (int bj = 0; bj < 2; ++bj)
#pragma unroll
                    for (int n = 0; n < 2; ++n) { const f32x4 v = acc[ai][bj][m][n] + *(const f32x4*)(base + off + bj * HALF + n * 16); acc[ai][bj][m][n] = v; s += (v[0] * v[0] + v[1] * v[1]) + (v[2] * v[2] + v[3] * v[3]); }
                s += __shfl_xor(s, 16); s += __shfl_xor(s, 32);
                if (fq == 0) P[(ai * HALF + wr * 64 + m * 16 + fr) * 4 + wc] = s;
                if (m & 1) asm volatile("" ::: "memory"); }
        asm volatile("s_waitcnt lgkmcnt(0)" ::: "memory"); __builtin_amdgcn_s_barrier(); asm volatile("" ::: "memory");
        const int row = wid * 32 + (lane & 31);
        if (lane < 32) { const float tot = (P[row * 4 + 0] + P[row * 4 + 1]) + (P[row * 4 + 2] + P[row * 4 + 3]);
            __hip_atomic_store(slots + ((size_t)(u.pm * BM + row) * 4 + u.pn), tot, __ATOMIC_RELAXED, __HIP_MEMORY_SCOPE_AGENT); }
        asm volatile("s_waitcnt vmcnt(0)" ::: "memory");
        if (lane == 0) __hip_atomic_fetch_add(cnt + 64 * u.pm, 1u, __ATOMIC_RELAXED, __HIP_MEMORY_SCOPE_AGENT);
        if (wid == 0) { while ((unsigned)__builtin_amdgcn_readfirstlane(__hip_atomic_load(cnt + 64 * u.pm, __ATOMIC_RELAXED, __HIP_MEMORY_SCOPE_AGENT)) < 32u) __builtin_amdgcn_s_sleep(2);
            __builtin_amdgcn_fence(__ATOMIC_ACQUIRE, "agent"); }
        asm volatile("s_waitcnt vmcnt(0) lgkmcnt(0)" ::: "memory"); __builtin_amdgcn_s_barrier(); asm volatile("" ::: "memory");
        if (lane < 32) { const float* sl = slots + (size_t)(u.pm * BM + row) * 4; float q = 0.f;
#pragma unroll
            for (int t = 0; t < 4; ++t) q += __hip_atomic_load(sl + t, __ATOMIC_RELAXED, __HIP_MEMORY_SCOPE_AGENT);
            S[row] = 1.0f / sqrtf(q * (1.f / 1024.f) + 1e-6f); }
        asm volatile("s_waitcnt lgkmcnt(0)" ::: "memory"); __builtin_amdgcn_s_barrier(); asm volatile("" ::: "memory");
        f32x4 wv[2][2];
#pragma unroll
        for (int bj = 0; bj < 2; ++bj)
#pragma unroll
            for (int n = 0; n < 2; ++n) wv[bj][n] = *(const f32x4*)(w + col0 + bj * HALF + n * 16);
#pragma unroll
        for (int ai = 0; ai < 2; ++ai)
#pragma unroll
            for (int m = 0; m < 4; ++m) { const int r = ai * HALF + wr * 64 + m * 16 + fr; const float rs = S[r]; const size_t off = (size_t)(u.pm * BM + r) * ldc + col0;
#pragma unroll
                for (int bj = 0; bj < 2; ++bj)
#pragma unroll
                    for (int n = 0; n < 2; ++n) { const f32x4 v = acc[ai][bj][m][n]; const f32x4 nv = v * rs * wv[bj][n];
                        if (mode == 0) { *(f32x4*)(out + off + bj * HALF + n * 16) = v; typedef unsigned u32x2v __attribute__((ext_vector_type(2))); u32x2v pk; pk.x = cvt_pk_bf16(nv[0], nv[1]); pk.y = cvt_pk_bf16(nv[2], nv[3]);
                            *(u32x2v*)(xn + off + bj * HALF + n * 16) = pk; }
                        else *(f32x4*)(out + off + bj * HALF + n * 16) = nv; } }
    }
};
}
constexpr int NWAVES = 8, NTHR = 512;
constexpr int BATCH = 2, T = 8192, D = 1024, M = BATCH * T, MH = T;
constexpr int NIN = 3728, NPAD = 3840;
constexpr int C_GQ = 0, C_GK = 256, C_GV = 512, C_GLR = 1024, C_GG = 1040, C_R = 1552, C_K = 2064, C_V = 2576, C_WL = 3088, C_AL = 3152, C_RG = 3216;
constexpr size_t MiB = 1u << 20;
constexpr size_t WS_WIN = 1 * MiB, WIN_BYTES = (size_t)NPAD * D * 2;
constexpr size_t WS_WOUT = 16 * MiB, WOUT_BYTES = (size_t)D * D * 2;
constexpr size_t WS_XN = 20 * MiB;
constexpr size_t WS_U = 52 * MiB, WS_U1 = 193 * MiB, U_STRIDE = WS_U1 - WS_U;
constexpr size_t WS_SLOTS = 192 * MiB;
constexpr size_t WS_END = 254 * MiB;
constexpr int LDS_BYTES = 163840;
constexpr int EARLY_TILES = 224;

typedef unsigned short bf16;
typedef unsigned v4u __attribute__((ext_vector_type(4)));
typedef float f32x4 __attribute__((ext_vector_type(4)));
#define LDS_WAIT() asm volatile("s_waitcnt lgkmcnt(0)" ::: "memory")
#define LBAR() do { asm volatile("s_waitcnt lgkmcnt(0)" ::: "memory"); __builtin_amdgcn_s_barrier(); asm volatile("" ::: "memory"); } while (0)
__device__ __forceinline__ float bf2f(unsigned h) { return __uint_as_float(h << 16); }
__device__ __forceinline__ unsigned f2bf(float f) { unsigned u = __float_as_uint(f); return (u + 0x7fffu + ((u >> 16) & 1u)) >> 16; }
typedef __bf16 bf16x2_t __attribute__((ext_vector_type(2)));
typedef float f32x2_t __attribute__((ext_vector_type(2)));
__device__ __forceinline__ unsigned pk2(float lo, float hi) { const f32x2_t v = {lo, hi}; const bf16x2_t b = __builtin_convertvector(v, bf16x2_t); return __builtin_bit_cast(unsigned, b); }
__device__ __forceinline__ float wave_sum(float v) {
#pragma unroll
    for (int o = 1; o < 64; o <<= 1) v += __shfl_xor(v, o);
    return v;
}
__device__ __forceinline__ float sigm(float x) { return __builtin_amdgcn_rcpf(1.f + __expf(-x)); }
__device__ __forceinline__ float tanh_fast(float x) { return 1.f - 2.f * __builtin_amdgcn_rcpf(1.f + __expf(2.f * x)); }
__device__ __forceinline__ float rl(float v, int l) { return __int_as_float(__builtin_amdgcn_readlane(__float_as_int(v), l)); }

typedef short bf16x8 __attribute__((ext_vector_type(8)));
typedef unsigned v2u __attribute__((ext_vector_type(2)));
__device__ __forceinline__ v2u pack4(f32x4 v) { v2u r; r.x = pk2(v.x, v.y); r.y = pk2(v.z, v.w); return r; }
__device__ __forceinline__ void unpack8(v4u w, float* o) { o[0] = bf2f(w.x & 0xffffu); o[1] = bf2f(w.x >> 16); o[2] = bf2f(w.y & 0xffffu); o[3] = bf2f(w.y >> 16);
    o[4] = bf2f(w.z & 0xffffu); o[5] = bf2f(w.z >> 16); o[6] = bf2f(w.w & 0xffffu); o[7] = bf2f(w.w >> 16); }
__device__ __forceinline__ v4u pack8(const float* v) { v4u r; r.x = pk2(v[0], v[1]); r.y = pk2(v[2], v[3]); r.z = pk2(v[4], v[5]); r.w = pk2(v[6], v[7]); return r; }
struct Args { const float* in[18]; float* out; unsigned char* ws; };
typedef const Args __attribute__((address_space(4))) CArgs;
__device__ __forceinline__ CArgs* opaque_args() { CArgs* p = (CArgs*)__builtin_amdgcn_kernarg_segment_ptr(); asm volatile("" : "+s"(p)); return p; }
#define AA (*opaque_args())

__device__ __forceinline__ void rms_row2(const float* x0, const float* x1, const float* w, bf16* o0, bf16* o1, int lane) {
    const f32x4* r0 = (const f32x4*)x0 + lane; const f32x4* r1 = (const f32x4*)x1 + lane; const f32x4* wr = (const f32x4*)w + lane;
    f32x4 a[4], b[4]; float sa = 0.f, sb = 0.f;
#pragma unroll
    for (int j = 0; j < 4; ++j) { a[j] = r0[64 * j]; b[j] = r1[64 * j]; }
#pragma unroll
    for (int j = 0; j < 4; ++j) { sa += (a[j].x * a[j].x + a[j].y * a[j].y) + (a[j].z * a[j].z + a[j].w * a[j].w); sb += (b[j].x * b[j].x + b[j].y * b[j].y) + (b[j].z * b[j].z + b[j].w * b[j].w); }
    const float ra = rsqrtf(wave_sum(sa) * (1.f / D) + 1e-6f), rb = rsqrtf(wave_sum(sb) * (1.f / D) + 1e-6f);
#pragma unroll
    for (int j = 0; j < 4; ++j) { const f32x4 ww = wr[64 * j]; const f32x4 oa = a[j] * ra * ww, ob = b[j] * rb * ww;
        ((v2u*)o0 + lane)[64 * j] = pack4(oa); ((v2u*)o1 + lane)[64 * j] = pack4(ob); }
}
__device__ __forceinline__ void transpose_item(const float* W, int K, int N, int Npad, bf16* WT, float* scr, int item, int lane) {
    const int nblk = Npad / 32, kb = item / nblk, nb = item % nblk, k0 = 64 * kb, n0 = 32 * nb;
    const int n = n0 + (lane & 31);
#pragma unroll 8
    for (int i = 0; i < 32; ++i) { const int kk = 2 * i + (lane >> 5); scr[kk * 33 + (lane & 31)] = (n < N) ? W[(size_t)(k0 + kk) * N + n] : 0.f; }
    LDS_WAIT();
    const int c = lane & 7;
#pragma unroll
    for (int j = 0; j < 4; ++j) { const int nn = (lane >> 3) + 8 * j; const float* s = scr + (8 * c) * 33 + nn;
        v4u o; o.x = pk2(s[0 * 33], s[1 * 33]); o.y = pk2(s[2 * 33], s[3 * 33]); o.z = pk2(s[4 * 33], s[5 * 33]); o.w = pk2(s[6 * 33], s[7 * 33]);
        *(v4u*)(WT + (size_t)(n0 + nn) * K + k0 + 8 * c) = o; }
    LDS_WAIT();
}
__device__ __forceinline__ void transpose_tiles(const float* W, int K, int N, int Npad, bf16* WT, float* scr  , int first, int stride, int ntiles, int tid) {
    const int nblk = Npad / 64, kr = tid >> 4, nq = tid & 15;
    f32x4 v0 = {0.f, 0.f, 0.f, 0.f}, v1 = v0;
    if (first < ntiles) { const int kb = first / nblk, nb = first % nblk, n = 64 * nb + 4 * nq; if (n < N) { v0 = *(const f32x4*)(W + (size_t)(64 * kb + kr) * N + n); v1 = *(const f32x4*)(W + (size_t)(64 * kb + 32 + kr) * N + n); } }
#pragma unroll 1
    for (int it = first; it < ntiles; it += stride) {
        const int kb = it / nblk, nb = it % nblk;
        scr[kr * 65 + 4 * nq] = v0.x; scr[kr * 65 + 4 * nq + 1] = v0.y; scr[kr * 65 + 4 * nq + 2] = v0.z; scr[kr * 65 + 4 * nq + 3] = v0.w;
        scr[(32 + kr) * 65 + 4 * nq] = v1.x; scr[(32 + kr) * 65 + 4 * nq + 1] = v1.y; scr[(32 + kr) * 65 + 4 * nq + 2] = v1.z; scr[(32 + kr) * 65 + 4 * nq + 3] = v1.w;
        const int nx = it + stride; v0 = (f32x4){0.f, 0.f, 0.f, 0.f}; v1 = v0;
        if (nx < ntiles) { const int kb2 = nx / nblk, nb2 = nx % nblk, n = 64 * nb2 + 4 * nq; if (n < N) { v0 = *(const f32x4*)(W + (size_t)(64 * kb2 + kr) * N + n); v1 = *(const f32x4*)(W + (size_t)(64 * kb2 + 32 + kr) * N + n); } }
        LBAR();
        { const int n = tid >> 3, kc = tid & 7; const float* sp = scr + (8 * kc) * 65 + n; float o[8];
#pragma unroll
          for (int j = 0; j < 8; ++j) o[j] = sp[j * 65];
          *(v4u*)(WT + (size_t)(64 * nb + n) * K + 64 * kb + 8 * kc) = pack8(o); }
        LBAR();
    }
}
__device__ __forceinline__ void rms_row(const float* xrow, const float* w, bf16* obf, float* of32, int lane) {
    const f32x4* xr = (const f32x4*)xrow + lane; const f32x4* wr = (const f32x4*)w + lane;
    f32x4 v[4]; float s = 0.f;
#pragma unroll
    for (int j = 0; j < 4; ++j) { v[j] = xr[64 * j]; s += (v[j].x * v[j].x + v[j].y * v[j].y) + (v[j].z * v[j].z + v[j].w * v[j].w); }
    const float rs = rsqrtf(wave_sum(s) * (1.f / D) + 1e-6f);
#pragma unroll
    for (int j = 0; j < 4; ++j) { const f32x4 ww = wr[64 * j]; f32x4 o = v[j] * rs * ww;
        if (of32) ((f32x4*)of32 + lane)[64 * j] = o;
        else ((unsigned long long*)obf + lane)[64 * j] = (unsigned long long)pk2(o.x, o.y) | ((unsigned long long)pk2(o.z, o.w) << 32); }
}

constexpr int PITCH = 72, FP = 68, TP = 20;
constexpr int OFF_TW = 0, OFF_AL = 9216, OFF_ARK = 18432, OFF_XA = 27648, OFF_XW = 45056, OFF_AT = 63488, OFF_RT = 72704, OFF_BH = 81920, OFF_KH = 91136,
              OFF_BBT = 100352, OFF_KBT = 109568, OFF_VT = 118784, OFF_TII = 128000, OFF_TOT = 133120, OFF_BC = 135168;
constexpr int OFF_AAK = OFF_TW, OFF_ARB = OFF_AL, OFF_AAB = OFF_XA, OFF_XT = OFF_XW;
constexpr size_t WS_MC = 112 * MiB, WS_NC = 120 * MiB, WS_PP = 136 * MiB, WS_Y0 = 144 * MiB, WS_S0 = 152 * MiB, WS_DEC = 160 * MiB, WS_BON2 = 161 * MiB, WS_UPT = 162 * MiB;
constexpr int NUNIT = 1024;

__device__ __forceinline__ f32x4 mma2s(const bf16* Ab, int ak, const bf16* Bb, int bk, int g, f32x4 acc) {
    acc = __builtin_amdgcn_mfma_f32_16x16x32_bf16(*(const bf16x8*)(Ab + ((g ^ ak) << 3)), *(const bf16x8*)(Bb + ((g ^ bk) << 3)), acc, 0, 0, 0);
    acc = __builtin_amdgcn_mfma_f32_16x16x32_bf16(*(const bf16x8*)(Ab + (((g + 4) ^ ak) << 3)), *(const bf16x8*)(Bb + (((g + 4) ^ bk) << 3)), acc, 0, 0, 0);
    return acc;
}
#define SWK(row) (((row) >> 3) & 7)
#define SWC(row, t) ((row) * PITCH + ((((t) >> 3) ^ SWK(row)) << 3) + ((t) & 7))
__device__ __forceinline__ f32x4 mma2(const bf16* Arow, const bf16* Brow, f32x4 acc) {
    acc = __builtin_amdgcn_mfma_f32_16x16x32_bf16(*(const bf16x8*)(Arow), *(const bf16x8*)(Brow), acc, 0, 0, 0);
    acc = __builtin_amdgcn_mfma_f32_16x16x32_bf16(*(const bf16x8*)(Arow + 32), *(const bf16x8*)(Brow + 32), acc, 0, 0, 0);
    return acc;
}

__device__ __forceinline__ void r1_phase(CArgs& a, size_t uo, int l, unsigned char* L, int tid0) {
    asm volatile("" : "+v"(tid0));
    const int wave = __builtin_amdgcn_readfirstlane(tid0 >> 6);
    const bf16* U = (const bf16*)(a.ws + WS_U + uo);
    bf16* TW = (bf16*)(L + 138240 + 2560); bf16* ALm = (bf16*)(L + 138240 + 2560 + 9216);
    bf16* ARK = (bf16*)(L + OFF_ARK); bf16* AAK = (bf16*)(L + OFF_AAK); bf16* ARB = (bf16*)(L + OFF_ARB);
    float* XA = (float*)(L + OFF_XA); float* XW = (float*)(L + OFF_XW); float* AAB = (float*)(L + OFF_AAB); bf16* XT = (bf16*)(L + OFF_XT);
    bf16* AT = (bf16*)(L + OFF_AT); bf16* RT = (bf16*)(L + OFF_RT); bf16* BH = (bf16*)(L + OFF_BH); bf16* KH = (bf16*)(L + OFF_KH);
    bf16* BBT = (bf16*)(L + OFF_BBT); bf16* KBT = (bf16*)(L + OFF_KBT); bf16* VT = (bf16*)(L + OFF_VT);
    float* TII = (float*)(L + OFF_TII); float* TOT = (float*)(L + OFF_TOT); float* BC = (float*)(L + OFF_BC);
    const bf16* UPT = (const bf16*)(a.ws + WS_UPT) + (size_t)l * 2 * 512 * 64;
    const float* mu = a.in[6] + l * 1664;
    float* WTS = (float*)(L + 135680);
    const int ch = (int)blockIdx.x >> 1, hbase = 4 * ((int)blockIdx.x & 1);
    v4u Lrc, Lkc, Lvc, Lrp, Lkp, Lvp; bf16x8 wfa0, wfa1; float pw[8];
#define R1_ISSUE(h_) do { const int lr_ = 64 * ch + (tid >> 3); const bf16* uq_ = U + (size_t)lr_ * NPAD + 64 * (h_) + 8 * (tid & 7); \
        Lrc = *(const v4u*)(uq_ + C_R); Lkc = *(const v4u*)(uq_ + C_K); Lvc = *(const v4u*)(uq_ + C_V); Lrp = (v4u){0u, 0u, 0u, 0u}; Lkp = Lrp; Lvp = Lrp; \
        if (lr_ > 0) { Lrp = *(const v4u*)(uq_ + C_R - NPAD); Lkp = *(const v4u*)(uq_ + C_K - NPAD); Lvp = *(const v4u*)(uq_ + C_V - NPAD); } \
        if (tid < 64) { const int c_ = l * 512 + 64 * (h_) + tid; pw[0] = a.in[7][c_]; pw[1] = a.in[9][c_]; pw[2] = a.in[11][c_]; pw[3] = a.in[12][c_]; pw[4] = a.in[13][c_]; \
            pw[5] = mu[64 * (h_) + tid]; pw[6] = mu[512 + 64 * (h_) + tid]; pw[7] = mu[1024 + 64 * (h_) + tid]; } \
        { const bf16* WT_ = UPT + (size_t)(wave >> 2) * 512 * 64 + (size_t)(64 * (h_) + 16 * (wave & 3) + (tid & 15)) * 64 + 8 * ((tid & 63) >> 4); wfa0 = *(const bf16x8*)WT_; wfa1 = *(const bf16x8*)(WT_ + 32); } } while (0)
    {
        int tid = tid0; asm volatile("" : "+v"(tid));
        R1_ISSUE(hbase);
        const int t = tid >> 3, cg = tid & 7, lr = 64 * ch + t; const bf16* up = U + (size_t)lr * NPAD + C_WL + 16 * cg;
        const v4u c0 = *(const v4u*)up, c1 = *(const v4u*)(up + 8); v4u p0 = {0u, 0u, 0u, 0u}, p1 = p0;
        if (lr > 0) { p0 = *(const v4u*)(up - NPAD); p1 = *(const v4u*)(up - NPAD + 8); }
        float cu[16], pr[16], o[16]; unpack8(c0, cu); unpack8(c1, cu + 8); unpack8(p0, pr); unpack8(p1, pr + 8);
        const float* mp = mu + 1536 + 16 * cg;
#pragma unroll
        for (int i = 0; i < 16; ++i) { float mv = cu[i] + (pr[i] - cu[i]) * mp[i]; if (cg < 4) mv = tanh_fast(mv); o[i] = mv; }
        bf16* dst = (cg < 4 ? TW : ALm) + t * PITCH + 16 * (cg & 3);
        *(v4u*)dst = pack8(o); *(v4u*)(dst + 8) = pack8(o + 8);
    }
#pragma unroll 1
    for (int hi = 0; hi < 4; ++hi) {
        int tid = tid0; asm volatile("" : "+v"(tid));
        const int lane = tid & 63, g = lane >> 4, c16 = lane & 15;
        const int h = hbase + hi, unit = ch * 8 + h;
        const int t = tid >> 3, dg = tid & 7, d0 = 8 * dg, lr = 64 * ch + t, hc = 64 * h + d0;
        if (tid < 64) {
#pragma unroll
            for (int q = 0; q < 8; ++q) WTS[64 * q + tid] = pw[q]; }
        LBAR();
        {
            const int q = wave >> 2, dt = wave & 3;
            const bf16x8 a0 = wfa0, a1 = wfa1;
            const bf16* Bm = q ? ALm : TW; float* X = q ? XA : XW;
#pragma unroll
            for (int tt = 0; tt < 4; ++tt) { const bf16* br = Bm + (16 * tt + c16) * PITCH + 8 * g; f32x4 acc = {0.f, 0.f, 0.f, 0.f};
                acc = __builtin_amdgcn_mfma_f32_16x16x32_bf16(a0, *(const bf16x8*)br, acc, 0, 0, 0);
                acc = __builtin_amdgcn_mfma_f32_16x16x32_bf16(a1, *(const bf16x8*)(br + 32), acc, 0, 0, 0);
                *(f32x4*)(X + (16 * tt + c16) * FP + 16 * dt + 4 * g) = acc; }
        }
        LBAR();
        float r[8], kq[8], v[8], al[8], be[8], lw[8];
        {
            float rc[8], rp[8], kc[8], kp[8], vc[8], vp[8];
            unpack8(Lrc, rc); unpack8(Lkc, kc); unpack8(Lvc, vc); unpack8(Lrp, rp); unpack8(Lkp, kp); unpack8(Lvp, vp);
            const float* w0p = WTS + d0; const float* a0p = WTS + 64 + d0; const float* kkp = WTS + 128 + d0;
            const float* kap = WTS + 192 + d0; const float* rkp = WTS + 256 + d0;
            float nn = 0.f, bon = 0.f, kk[8], av[8];
#pragma unroll
            for (int i = 0; i < 8; ++i) {
                const float xw = XW[t * FP + d0 + i] + w0p[i], xa = XA[t * FP + d0 + i] + a0p[i];
                lw[i] = -0.60653065971f * sigm(xw); av[i] = sigm(xa);
                r[i] = rc[i] + (rp[i] - rc[i]) * WTS[320 + d0 + i]; const float k = kc[i] + (kp[i] - kc[i]) * WTS[384 + d0 + i]; v[i] = vc[i] + (vp[i] - vc[i]) * WTS[448 + d0 + i];
                kk[i] = k * kkp[i]; nn += kk[i] * kk[i];
                kq[i] = k * (1.f + (av[i] - 1.f) * kap[i]); bon += r[i] * kq[i] * rkp[i];
            }
            nn += __shfl_xor(nn, 1); nn += __shfl_xor(nn, 2); nn += __shfl_xor(nn, 4);
            bon += __shfl_xor(bon, 1); bon += __shfl_xor(bon, 2); bon += __shfl_xor(bon, 4);
            const float inv = __builtin_amdgcn_rsqf(fmaxf(nn, 1e-24f));
#pragma unroll
            for (int i = 0; i < 8; ++i) { const float kn = kk[i] * inv; al[i] = -kn; be[i] = av[i] * kn; XW[t * FP + d0 + i] = lw[i]; }
            if (dg == 0) ((float*)(a.ws + WS_BON2))[lr * 8 + h] = bon;
        }
        LBAR();
        {
            const int d = tid & 63, tb = tid >> 6; float p[8]; float run = 0.f;
#pragma unroll
            for (int i = 0; i < 8; ++i) { run += XW[(8 * tb + i) * FP + d]; p[i] = run; }
            TOT[tb * 64 + d] = run;
            LBAR();
            float off = 0.f;
#pragma unroll
            for (int j = 0; j < 8; ++j) off += (j < tb) ? TOT[j * 64 + d] : 0.f;
#pragma unroll
            for (int i = 0; i < 8; ++i) XW[(8 * tb + i) * FP + d] = off + p[i];
            if (tb == 7) { BC[d] = off + run; BC[64 + d] = __expf(off + run); }
        }
        LBAR();
        {
            float at[8], rt[8], bh[8], kh[8];
#pragma unroll
            for (int i = 0; i < 8; ++i) { const float b = XW[t * FP + d0 + i];
                const float eb = __expf(b), enb = __builtin_amdgcn_rcpf(eb), ebp = __expf(b - lw[i]), ebc = BC[64 + d0 + i] * enb;
                at[i] = al[i] * ebp; rt[i] = r[i] * eb; bh[i] = be[i] * enb; kh[i] = kq[i] * enb;
                BBT[SWC(d0 + i, t)] = (bf16)f2bf(be[i] * ebc); KBT[SWC(d0 + i, t)] = (bf16)f2bf(kq[i] * ebc); VT[SWC(d0 + i, t)] = (bf16)f2bf(v[i]); }
            *(v4u*)(AT + t * PITCH + d0) = pack8(at); *(v4u*)(RT + t * PITCH + d0) = pack8(rt); *(v4u*)(BH + t * PITCH + d0) = pack8(bh); *(v4u*)(KH + t * PITCH + d0) = pack8(kh);
        }
        asm volatile("" ::: "memory");
        if (hi + 1 < 4) R1_ISSUE(h + 1);
        LBAR();
        {
            const int q = wave >> 1, mh = wave & 1;
            const bf16* As = (q < 2) ? AT : RT; const bf16* Bs = (q & 1) ? KH : BH;
#pragma unroll
            for (int t2 = 0; t2 < 2; ++t2) { const int tt = 2 * mh + t2; const int tcol = 16 * tt + c16;
#pragma unroll
                for (int jt = 0; jt < 4; ++jt) {
                    f32x4 acc = {0.f, 0.f, 0.f, 0.f};
                    if (jt <= tt) { acc = mma2(Bs + (16 * jt + c16) * PITCH + 8 * g, As + tcol * PITCH + 8 * g, acc);
#pragma unroll
                        for (int j = 0; j < 4; ++j) { const int jj = 16 * jt + 4 * g + j; const bool keep = (q < 2) ? (jj < tcol) : (jj <= tcol); if (!keep) acc[j] = 0.f; } }
                    if (q == 0) *(f32x4*)(AAB + tcol * FP + 16 * jt + 4 * g) = acc;
                    else { bf16* dst = (q == 1 ? AAK : (q == 2 ? ARB : ARK)); *(v2u*)(dst + tcol * PITCH + 16 * jt + 4 * g) = pack4(acc); }
                } }
        }
        LBAR();
        f32x4 Z[4];
        {
            if (wave == 0) { const int i = g; float Tc[16];
#pragma unroll
                for (int tr = 0; tr < 16; ++tr) { float s0 = (c16 == tr) ? 1.f : 0.f, s1 = 0.f, s2 = 0.f, s3 = 0.f; const float* ar = AAB + (16 * i + tr) * FP + 16 * i;
#pragma unroll
                    for (int j = 0; j < 16; j += 4) { if (j < tr) s0 += ar[j] * Tc[j]; if (j + 1 < tr) s1 += ar[j + 1] * Tc[j + 1]; if (j + 2 < tr) s2 += ar[j + 2] * Tc[j + 2]; if (j + 3 < tr) s3 += ar[j + 3] * Tc[j + 3]; }
                    const float sv = (s0 + s1) + (s2 + s3); Tc[tr] = sv; TII[(i * 16 + tr) * TP + c16] = sv; } }
            if (wave < 4) {
#pragma unroll
                for (int i = 0; i < 4; ++i)
#pragma unroll
                    for (int j = 0; j < 4; ++j) Z[i][j] = bf2f(AT[(16 * i + 4 * g + j) * PITCH + 16 * wave + c16]);
            } else {
#pragma unroll
                for (int i = 0; i < 4; ++i) { f32x4 acc = {0.f, 0.f, 0.f, 0.f}; const int er = 16 * (wave - 4) + c16; Z[i] = mma2s(AAK + (16 * i + c16) * PITCH, 0, VT + er * PITCH, SWK(er), g, acc); }
            }
        }
        LBAR();
        {
            f32x4 X[4];
#pragma unroll
            for (int i = 0; i < 4; ++i) { f32x4 z = Z[i];
#pragma unroll
                for (int kb = 0; kb < 4; ++kb) if (kb < i) { const f32x4 av = *(const f32x4*)(AAB + (16 * i + c16) * FP + 16 * kb + 4 * g);
#pragma unroll
                    for (int s = 0; s < 4; ++s) z = __builtin_amdgcn_mfma_f32_16x16x4f32(av[s], X[kb][s], z, 0, 0, 0); }
                const f32x4 tv = *(const f32x4*)(TII + (i * 16 + c16) * TP + 4 * g); f32x4 x = {0.f, 0.f, 0.f, 0.f};
#pragma unroll
                for (int s = 0; s < 4; ++s) x = __builtin_amdgcn_mfma_f32_16x16x4f32(tv[s], z[s], x, 0, 0, 0);
                X[i] = x; }
#pragma unroll
            for (int i = 0; i < 4; ++i) *(v2u*)(XT + (16 * wave + c16) * PITCH + 16 * i + 4 * g) = pack4(X[i]);
        }
        LBAR();
        {
            const int q = wave >> 1, hh = wave & 1;
            bf16* MCg = (bf16*)(a.ws + WS_MC) + (size_t)unit * 4096; float* NCg = (float*)(a.ws + WS_NC) + (size_t)unit * 4096;
            bf16* PPg = (bf16*)(a.ws + WS_PP) + (size_t)unit * 4096; bf16* Y0g = (bf16*)(a.ws + WS_Y0) + (size_t)unit * 4096;
#pragma unroll
            for (int t2 = 0; t2 < 2; ++t2) { const int ti = 2 * hh + t2;
#pragma unroll
                for (int tj = 0; tj < 4; ++tj) { f32x4 acc = {0.f, 0.f, 0.f, 0.f}; const int cc = 16 * tj + c16, rr = 16 * ti + 4 * g;
                    if (q == 0) { acc = mma2s(XT + (16 * ti + c16) * PITCH, 0, BBT + cc * PITCH, SWK(cc), g, acc); *(v2u*)(MCg + cc * 64 + (ti >> 1) * 32 + g * 8 + (ti & 1) * 4) = pack4(acc); }
                    else if (q == 1) { const int ar = 16 * ti + c16; acc = mma2s(BBT + ar * PITCH, SWK(ar), XT + (64 + cc) * PITCH, 0, g, acc); acc = mma2s(KBT + ar * PITCH, SWK(ar), VT + cc * PITCH, SWK(cc), g, acc);
                        *(f32x4*)(NCg + cc * 64 + rr) = acc; }
                    else if (q == 2) { acc = mma2(XT + (16 * ti + c16) * PITCH + 8 * g, ARB + cc * PITCH + 8 * g, acc);
                        const v2u rv = *(const v2u*)(RT + cc * PITCH + rr); acc[0] += bf2f(rv.x & 0xffffu); acc[1] += bf2f(rv.x >> 16); acc[2] += bf2f(rv.y & 0xffffu); acc[3] += bf2f(rv.y >> 16);
                        *(v2u*)(PPg + cc * 64 + rr) = pack4(acc); }
                    else { acc = mma2(XT + (64 + 16 * ti + c16) * PITCH + 8 * g, ARB + cc * PITCH + 8 * g, acc); { const int ar = 16 * ti + c16; acc = mma2s(VT + ar * PITCH, SWK(ar), ARK + cc * PITCH, 0, g, acc); }
                        *(v2u*)(Y0g + cc * 64 + rr) = pack4(acc); }
                } }
            if (tid < 64) ((float*)(a.ws + WS_DEC))[unit * 64 + tid] = BC[64 + tid];
        }
        LBAR();
    }
}

#define LAS3 __attribute__((address_space(3)))
constexpr int R2_SLOT = 12544, R2_NS = 10, R2_FLAGS = R2_SLOT * R2_NS;
__device__ __forceinline__ void r2_scan(CArgs& a, int chain, unsigned char* L, int tid) {
    asm volatile("" : "+v"(tid));
    const int lane = tid & 63, wave = __builtin_amdgcn_readfirstlane(tid >> 6);
    const int h = chain >> 2, e0 = 16 * (chain & 3), g = lane >> 4, c16 = lane & 15;
    volatile LAS3 unsigned* flg = (volatile LAS3 unsigned*)(LAS3 unsigned char*)(L + R2_FLAGS);
    if (tid < 32) flg[tid] = 0u;
    if (tid >= 64 && tid < 64 + R2_NS) *(volatile LAS3 unsigned*)(LAS3 unsigned char*)(L + (tid - 64) * R2_SLOT + 12288 + 252) = 0xffffffffu;
    __syncthreads();
    const bf16* MC = (const bf16*)(a.ws + WS_MC); const float* NC = (const float*)(a.ws + WS_NC); const float* DEC = (const float*)(a.ws + WS_DEC);
    if (wave != 0) {
        int mco[8], nco[4];
#pragma unroll
        for (int q = 0; q < 8; ++q) { const int pos = 64 * q + lane, row = pos >> 3, kc = (pos & 7) ^ (row & 7); mco[q] = row * 64 + kc * 8; }
#pragma unroll
        for (int q = 0; q < 4; ++q) { const int pos = 64 * q + lane, e = pos >> 4, dc = (pos & 15) ^ e; nco[q] = (e0 + e) * 64 + dc * 4; }
#pragma unroll 1
        for (int c = wave - 1; c < 128; c += 7) {
            while ((int)flg[16] < c - (R2_NS - 1)) __builtin_amdgcn_s_sleep(1);
            LAS3 unsigned char* slot = (LAS3 unsigned char*)(L + (c % R2_NS) * R2_SLOT);
            const size_t unit = (size_t)c * 8 + h;
#pragma unroll
            for (int q = 0; q < 8; ++q) __builtin_amdgcn_global_load_lds((const unsigned*)(MC + unit * 4096 + mco[q]), (LAS3 unsigned*)(slot + q * 1024), 16, 0, 0);
#pragma unroll
            for (int q = 0; q < 4; ++q) __builtin_amdgcn_global_load_lds((const unsigned*)(NC + unit * 4096 + nco[q]), (LAS3 unsigned*)(slot + 8192 + q * 1024), 16, 0, 0);
            __builtin_amdgcn_global_load_lds((const unsigned*)(DEC + unit * 64 + lane), (LAS3 unsigned*)(slot + 12288), 4, 0, 0);
        }
        asm volatile("s_waitcnt vmcnt(0)" ::: "memory");
    } else {
        bf16* S0 = (bf16*)(a.ws + WS_S0) + (size_t)h * 4096 + (e0 + c16) * 64 + 4 * g;
        f32x4 S[4];
#pragma unroll
        for (int m = 0; m < 4; ++m) S[m] = (f32x4){0.f, 0.f, 0.f, 0.f};
        int avail = 0;
        const LAS3 unsigned char* Lb = (const LAS3 unsigned char*)L;
        const int offA0 = (c16 * 8 + (g ^ (c16 & 7))) * 16, offA1 = (c16 * 8 + ((4 + g) ^ (c16 & 7))) * 16;
        int offN[4];
#pragma unroll
        for (int mt = 0; mt < 4; ++mt) offN[mt] = 8192 + (c16 * 16 + ((4 * mt + g) ^ c16)) * 16;
        const int offD = 12288 + 16 * g;
#define R2_MARKS(s_) (*(volatile LAS3 unsigned*)(LAS3 unsigned char*)(L + (s_) * R2_SLOT + 12288 + 252))
#define R2_WAITS(c_, s_) do { while (avail <= (c_)) { const unsigned f0_ = R2_MARKS(s_), f1_ = R2_MARKS(((s_) + 1) % R2_NS), f2_ = R2_MARKS(((s_) + 2) % R2_NS); \
            if (f0_ != 0xffffffffu) { avail = (c_) + 1; if (f1_ != 0xffffffffu) { avail = (c_) + 2; if (f2_ != 0xffffffffu) avail = (c_) + 3; } } \
            else __builtin_amdgcn_s_sleep(0); } asm volatile("" ::: "memory"); } while (0)
        v4u A[2][4][2]; f32x4 Nn[2][4], Dd[2][4];
#define R2_READS(s_, p_) do { _Pragma("unroll") for (int mt = 0; mt < 4; ++mt) { \
                A[p_][mt][0] = *(const LAS3 v4u*)(Lb + (s_) * R2_SLOT + mt * 2048 + offA0); A[p_][mt][1] = *(const LAS3 v4u*)(Lb + (s_) * R2_SLOT + mt * 2048 + offA1); \
                Nn[p_][mt] = *(const LAS3 f32x4*)(Lb + (s_) * R2_SLOT + offN[mt]); Dd[p_][mt] = *(const LAS3 f32x4*)(Lb + (s_) * R2_SLOT + mt * 64 + offD); } } while (0)
        R2_WAITS(0, 0); R2_READS(0, 0);
        asm volatile("s_waitcnt lgkmcnt(0)" ::: "memory");
#pragma unroll 1
        for (int c0 = 0; c0 < 128; c0 += R2_NS) {
#pragma unroll
            for (int k = 0; k < R2_NS; ++k) { const int c = c0 + k;
                if (c < 128) {
                    R2_MARKS(k) = 0xffffffffu; flg[16] = (unsigned)(c + 1);
                    if (c + 1 < 128) { R2_WAITS(c + 1, (k + 1) % R2_NS); R2_READS((k + 1) % R2_NS, (k + 1) & 1); }
                    bf16* sp = S0 + (size_t)c * (8 * 4096); v2u sb[4];
#pragma unroll
                    for (int m = 0; m < 4; ++m) { sb[m] = pack4(S[m]); *(v2u*)(sp + 16 * m) = sb[m]; }
                    const v4u b0 = {sb[0].x, sb[0].y, sb[1].x, sb[1].y}, b1 = {sb[2].x, sb[2].y, sb[3].x, sb[3].y};
                    const bf16x8 B0 = __builtin_bit_cast(bf16x8, b0), B1 = __builtin_bit_cast(bf16x8, b1);
                    f32x4 acc[4];
#pragma unroll
                    for (int mt = 0; mt < 4; ++mt) acc[mt] = __builtin_amdgcn_mfma_f32_16x16x32_bf16(__builtin_bit_cast(bf16x8, A[k & 1][mt][0]), B0, Nn[k & 1][mt] + S[mt] * Dd[k & 1][mt], 0, 0, 0);
#pragma unroll
                    for (int mt = 0; mt < 4; ++mt) S[mt] = __builtin_amdgcn_mfma_f32_16x16x32_bf16(__builtin_bit_cast(bf16x8, A[k & 1][mt][1]), B1, acc[mt], 0, 0, 0);
                    asm volatile("s_waitcnt lgkmcnt(0)" ::: "memory");
                } }
        }
#undef R2_WAITS
#undef R2_MARKS
#undef R2_READS
#define R2_READ 0
#undef R2_READ
    }
    __syncthreads();
}

__device__ __forceinline__ void r3_phase(CArgs& a, size_t uo, int l, int hb, int gw, int NGW, int lane) {
    asm volatile("" : "+v"(lane));
    const int g = lane >> 4, c16 = lane & 15;
    const bf16* U = (const bf16*)(a.ws + WS_U + uo); const bf16* PP = (const bf16*)(a.ws + WS_PP); const bf16* S0 = (const bf16*)(a.ws + WS_S0); const bf16* Y0 = (const bf16*)(a.ws + WS_Y0);
    const float* BON = (const float*)(a.ws + WS_BON2); bf16* MG = (bf16*)(a.ws + WS_XN) + (size_t)hb * MH * D;
    const float* mu_v = a.in[6] + l * 1664 + 1024; const float* lnw = a.in[14] + l * 512; const float* lnb = a.in[15] + l * 512;
    const int erow = 16 * (c16 >> 2) + (c16 & 3);
#pragma unroll 1
    for (int task = gw; task < NUNIT * 4; task += NGW) {
        const int unit = task >> 2, mt = task & 3, ch = unit >> 3, h = unit & 7; const size_t ub = (size_t)unit * 4096;
        const int lr = 64 * ch + 16 * mt + c16; const bf16* urow = U + (size_t)lr * NPAD + 64 * h + 16 * g;
        float vc[16], vp[16], rgf[16];
        unpack8(*(const v4u*)(urow + C_V), vc); unpack8(*(const v4u*)(urow + C_V + 8), vc + 8); unpack8(*(const v4u*)(urow + C_RG), rgf); unpack8(*(const v4u*)(urow + C_RG + 8), rgf + 8);
        if (lr > 0) { unpack8(*(const v4u*)(urow + C_V - NPAD), vp); unpack8(*(const v4u*)(urow + C_V + 8 - NPAD), vp + 8); }
        else {
#pragma unroll
            for (int i = 0; i < 16; ++i) vp[i] = 0.f; }
        const float bon = BON[lr * 8 + h];
        const bf16* pr = PP + ub + (16 * mt + c16) * 64 + 8 * g;
        const bf16x8 B0 = *(const bf16x8*)pr, B1 = *(const bf16x8*)(pr + 32);
        f32x4 Y[4]; bf16x8 SA[4][2];
#pragma unroll
        for (int et = 0; et < 4; ++et) { const bf16* sr = S0 + ub + (erow + 4 * et) * 64 + 8 * g; SA[et][0] = *(const bf16x8*)sr; SA[et][1] = *(const bf16x8*)(sr + 32); }
        const bf16* y0p = Y0 + ub + (16 * mt + c16) * 64 + 16 * g; const v4u y0a = *(const v4u*)y0p, y0b = *(const v4u*)(y0p + 8);
        asm volatile("" ::: "memory");
        { float yf[16]; unpack8(y0a, yf); unpack8(y0b, yf + 8);
#pragma unroll
          for (int et = 0; et < 4; ++et) Y[et] = (f32x4){yf[4 * et], yf[4 * et + 1], yf[4 * et + 2], yf[4 * et + 3]}; }
#pragma unroll
        for (int et = 0; et < 4; ++et) { f32x4 acc = __builtin_amdgcn_mfma_f32_16x16x32_bf16(SA[et][0], B0, Y[et], 0, 0, 0);
            Y[et] = __builtin_amdgcn_mfma_f32_16x16x32_bf16(SA[et][1], B1, acc, 0, 0, 0); }
        const f32x4 sv = (Y[0] + Y[1]) + (Y[2] + Y[3]); float sm = (sv.x + sv.y) + (sv.z + sv.w); sm += __shfl_xor(sm, 16); sm += __shfl_xor(sm, 32);
        const float mean = sm * (1.f / 64.f); float q = 0.f;
#pragma unroll
        for (int et = 0; et < 4; ++et) { const f32x4 dd = Y[et] - mean; q += (dd.x * dd.x + dd.y * dd.y) + (dd.z * dd.z + dd.w * dd.w); }
        q += __shfl_xor(q, 16); q += __shfl_xor(q, 32);
        const float rstd = rsqrtf(q * (1.f / 64.f) + 64e-5f);
        const int cc = 64 * h + 16 * g; float o[16];
#pragma unroll
        for (int et = 0; et < 4; ++et) {
            const f32x4 w4 = *(const f32x4*)(lnw + cc + 4 * et), b4 = *(const f32x4*)(lnb + cc + 4 * et), m4 = *(const f32x4*)(mu_v + cc + 4 * et);
#pragma unroll
            for (int j = 0; j < 4; ++j) { const int i = 4 * et + j; const float vv = vc[i] + (vp[i] - vc[i]) * m4[j]; const float yn = (Y[et][j] - mean) * rstd * w4[j] + b4[j];
                o[i] = (yn + bon * vv) * rgf[i] * sigm(rgf[i]); } }
        bf16* op = MG + (size_t)lr * D + 512 + cc; *(v4u*)op = pack8(o); *(v4u*)(op + 8) = pack8(o + 8);
    }
}

constexpr int OFF_GQI = 17408, OFF_GKI = 26624, OFF_GKST = 35840, OFF_GVT = 45056, OFF_GSC = 63488, OFF_GTOT = 72704, OFF_GBC = 74752;
constexpr size_t WS_QI = 163 * MiB, WS_OI = 167 * MiB, WS_DS = 175 * MiB, WS_GDEC = 183 * MiB, WS_SP = 184 * MiB;
constexpr int NGUNIT = 512;

__device__ __forceinline__ void g1_phase(CArgs& a, size_t uo, int l, unsigned char* L, int tid0, int ufirst, int ustride) {
    asm volatile("" : "+v"(tid0));
    const int wave = __builtin_amdgcn_readfirstlane(tid0 >> 6);
    const bf16* U = (const bf16*)(a.ws + WS_U + uo);
    float* XW = (float*)L; bf16* QI = (bf16*)(L + OFF_GQI); bf16* KI = (bf16*)(L + OFF_GKI); bf16* KST = (bf16*)(L + OFF_GKST); bf16* VT = (bf16*)(L + OFF_GVT); bf16* SC = (bf16*)(L + OFF_GSC);
    float* TOT = (float*)(L + OFF_GTOT); float* BC = (float*)(L + OFF_GBC);
    float* GW = (float*)(L + OFF_GBC + 256);
    int hl = -1;
    v4u Gl0, Gl1, Gq, Gk, Gv0, Gv1;
#define G1_ISSUE(u_) do { const int lr_ = 64 * ((u_) >> 2) + (tid >> 3), h_ = (u_) & 3, dg_ = tid & 7; const bf16* ur_ = U + (size_t)lr_ * NPAD; \
        Gl0 = *(const v4u*)(ur_ + C_GLR); Gl1 = *(const v4u*)(ur_ + C_GLR + 8); Gq = *(const v4u*)(ur_ + C_GQ + 64 * h_ + 8 * dg_); Gk = *(const v4u*)(ur_ + C_GK + 64 * h_ + 8 * dg_); \
        Gv0 = *(const v4u*)(ur_ + C_GV + 128 * h_ + 16 * dg_); Gv1 = *(const v4u*)(ur_ + C_GV + 128 * h_ + 16 * dg_ + 8); } while (0)
#pragma unroll 1
    for (int unit = ufirst; unit < NGUNIT; unit += ustride) {
        int tid = tid0; asm volatile("" : "+v"(tid));
        const int lane = tid & 63, g = lane >> 4, c16 = lane & 15;
        const int ch = unit >> 2, h = unit & 3;
        if (h != hl) { hl = h; LBAR();
            for (int i = tid; i < 16 * 64; i += NTHR) GW[i] = a.in[3][l * 16 * 256 + (i >> 6) * 256 + 64 * h + (i & 63)];
            if (tid < 64) GW[1024 + tid] = a.in[4][l * 256 + 64 * h + tid];
            LBAR(); }
        const int t = tid >> 3, dg = tid & 7, d0 = 8 * dg, lr = 64 * ch + t, hc = 64 * h + d0;
        if (unit == ufirst) G1_ISSUE(unit);
        float q[8], k[8];
        {
            float glr[16]; unpack8(Gl0, glr); unpack8(Gl1, glr + 8);
            float x[8]; const float* gb = GW + 1024 + d0; const float* gu = GW + d0;
#pragma unroll
            for (int i = 0; i < 8; ++i) x[i] = gb[i];
#pragma unroll
            for (int r = 0; r < 16; ++r) { const f32x4 u0 = *(const f32x4*)(gu + r * 64), u1 = *(const f32x4*)(gu + r * 64 + 4);
                x[0] += glr[r] * u0.x; x[1] += glr[r] * u0.y; x[2] += glr[r] * u0.z; x[3] += glr[r] * u0.w; x[4] += glr[r] * u1.x; x[5] += glr[r] * u1.y; x[6] += glr[r] * u1.z; x[7] += glr[r] * u1.w; }
#pragma unroll
            for (int i = 0; i < 8; ++i) XW[t * FP + d0 + i] = (fminf(x[i], 0.f) - __logf(1.f + __expf(-fabsf(x[i])))) * (1.f / 16.f);
            unpack8(Gq, q); unpack8(Gk, k);
            float vv[16]; const int e0 = 16 * dg; unpack8(Gv0, vv); unpack8(Gv1, vv + 8);
            asm volatile("" ::: "memory");
            if (unit + ustride < NGUNIT) G1_ISSUE(unit + ustride);
#pragma unroll
            for (int i = 0; i < 16; ++i) VT[SWC(e0 + i, t)] = (bf16)f2bf(vv[i]);
        }
        LBAR();
        {
            const int d = tid & 63, tb = tid >> 6; float p[8]; float run = 0.f;
#pragma unroll
            for (int i = 0; i < 8; ++i) { run += XW[(8 * tb + i) * FP + d]; p[i] = run; }
            TOT[tb * 64 + d] = run;
            LBAR();
            float off = 0.f;
#pragma unroll
            for (int j = 0; j < 8; ++j) off += (j < tb) ? TOT[j * 64 + d] : 0.f;
#pragma unroll
            for (int i = 0; i < 8; ++i) XW[(8 * tb + i) * FP + d] = off + p[i];
            if (tb == 7) BC[d] = off + run;
        }
        LBAR();
        {
            float qi[8], ki[8];
#pragma unroll
            for (int i = 0; i < 8; ++i) { const float b = XW[t * FP + d0 + i], bc = BC[d0 + i];
                qi[i] = q[i] * 0.125f * __expf(b); ki[i] = k[i] * __expf(-b); KST[SWC(d0 + i, t)] = (bf16)f2bf(k[i] * __expf(bc - b)); }
            const v4u qp = pack8(qi);
            *(v4u*)(QI + t * PITCH + d0) = qp; *(v4u*)(KI + t * PITCH + d0) = pack8(ki);
            *(v4u*)((bf16*)(a.ws + WS_QI) + (size_t)unit * 4096 + t * 64 + d0) = qp;
        }
        LBAR();
        {
            const int tt = wave >> 1; const int tcol = 16 * tt + c16;
#pragma unroll
            for (int j2 = 0; j2 < 2; ++j2) { const int jt = 2 * (wave & 1) + j2; f32x4 acc = {0.f, 0.f, 0.f, 0.f};
                if (jt <= tt) { acc = mma2(KI + (16 * jt + c16) * PITCH + 8 * g, QI + tcol * PITCH + 8 * g, acc);
#pragma unroll
                    for (int j = 0; j < 4; ++j) if (16 * jt + 4 * g + j > tcol) acc[j] = 0.f; }
                *(v2u*)(SC + tcol * PITCH + 16 * jt + 4 * g) = pack4(acc); }
            bf16* DSg = (bf16*)(a.ws + WS_DS) + (size_t)unit * 8192;
#pragma unroll
            for (int i = 0; i < 4; ++i) { const int tile = wave * 4 + i, dt = tile & 3, et = tile >> 2; f32x4 acc = {0.f, 0.f, 0.f, 0.f};
                { const int ar = 16 * dt + c16, br = 16 * et + c16; acc = mma2s(KST + ar * PITCH, SWK(ar), VT + br * PITCH, SWK(br), g, acc); }
                *(v2u*)(DSg + (16 * et + c16) * 64 + 16 * dt + 4 * g) = pack4(acc); }
            if (tid < 64) ((float*)(a.ws + WS_GDEC))[unit * 64 + tid] = __expf(BC[tid]);
        }
        LBAR();
        {
            bf16* OIg = (bf16*)(a.ws + WS_OI) + (size_t)unit * 8192;
#pragma unroll
            for (int i = 0; i < 4; ++i) { const int tile = wave * 4 + i, tt = tile & 3, et = tile >> 2; f32x4 acc = {0.f, 0.f, 0.f, 0.f};
                { const int ar = 16 * et + c16; acc = mma2s(VT + ar * PITCH, SWK(ar), SC + (16 * tt + c16) * PITCH, 0, g, acc); }
                *(v2u*)(OIg + (16 * tt + c16) * 128 + 16 * et + 4 * g) = pack4(acc); }
        }
        LBAR();
    }
}

__device__ __forceinline__ void g2_scan(CArgs& a, int wg, unsigned char* L, int tid) {
    asm volatile("" : "+v"(tid));
    const int h = wg >> 2, e = 32 * (wg & 3) + (tid >> 4), dq = tid & 15;
    const bf16* DS = (const bf16*)(a.ws + WS_DS) + (size_t)h * 8192 + e * 64 + 4 * dq; const float* GD = (const float*)(a.ws + WS_GDEC) + (size_t)(((tid >> 4) & 15) * 4 + h) * 64 + 4 * dq;
    bf16* SP = (bf16*)(a.ws + WS_SP) + (size_t)h * 8192 + e * 64 + 4 * dq;
    float* DCL = (float*)L;
    v2u dsb[2][16]; f32x4 dcr;
    f32x4 S = {0.f, 0.f, 0.f, 0.f};
#pragma unroll
    for (int i = 0; i < 16; ++i) dsb[0][i] = *(const v2u*)(DS + (size_t)i * (4 * 8192));
    dcr = *(const f32x4*)GD;
    if (tid < 256) *(f32x4*)(DCL + (tid >> 4) * 64 + 4 * dq) = dcr;
#pragma unroll 1
    for (int b2 = 0; b2 < 8; b2 += 2) {
#pragma unroll
        for (int bb = 0; bb < 2; ++bb) { const int b = b2 + bb;
            if (b + 1 < 8) {
#pragma unroll
                for (int i = 0; i < 16; ++i) dsb[(bb + 1) & 1][i] = *(const v2u*)(DS + (size_t)(16 * (b + 1) + i) * (4 * 8192));
                dcr = *(const f32x4*)(GD + (size_t)(16 * (b + 1)) * (4 * 64)); }
            LBAR();
            const float* dcl = DCL + bb * 1024 + 4 * dq;
#pragma unroll
            for (int i = 0; i < 16; ++i) { const f32x4 dc = *(const f32x4*)(dcl + i * 64); const v2u w = dsb[bb][i];
                *(v2u*)(SP + (size_t)(16 * b + i) * (4 * 8192)) = pack4(S);
                const f32x4 dv = {bf2f(w.x & 0xffffu), bf2f(w.x >> 16), bf2f(w.y & 0xffffu), bf2f(w.y >> 16)};
                S = S * dc + dv; }
            if (b + 1 < 8 && tid < 256) *(f32x4*)(DCL + ((bb + 1) & 1) * 1024 + (tid >> 4) * 64 + 4 * dq) = dcr;
        }
    }
    LBAR();
}

__device__ __forceinline__ void g3_phase(CArgs& a, size_t uo, int l, int hb, int gw, int NGW, int lane) {
    asm volatile("" : "+v"(lane));
    const int g = lane >> 4, c16 = lane & 15;
    const bf16* U = (const bf16*)(a.ws + WS_U + uo); const bf16* QI = (const bf16*)(a.ws + WS_QI); const bf16* SP = (const bf16*)(a.ws + WS_SP); const bf16* OI = (const bf16*)(a.ws + WS_OI);
    bf16* MG = (bf16*)(a.ws + WS_XN) + (size_t)hb * MH * D; const float* gnw = a.in[5] + l * 128;
    const int erow = 32 * (c16 >> 2) + (c16 & 3);
#pragma unroll 1
    for (int task = gw; task < NGUNIT * 4; task += NGW) {
        const int unit = task >> 2, mt = task & 3, ch = unit >> 2, h = unit & 3;
        const int lr = 64 * ch + 16 * mt + c16; const bf16* urow = U + (size_t)lr * NPAD + C_GG + 128 * h + 32 * g;
        const v4u gg0 = *(const v4u*)urow, gg1 = *(const v4u*)(urow + 8), gg2 = *(const v4u*)(urow + 16), gg3 = *(const v4u*)(urow + 24);
        const bf16* qr = QI + (size_t)unit * 4096 + (16 * mt + c16) * 64 + 8 * g;
        const bf16x8 B0 = *(const bf16x8*)qr, B1 = *(const bf16x8*)(qr + 32);
        f32x4 O[8]; float ss = 0.f; bf16x8 SA[8][2];
#pragma unroll
        for (int et = 0; et < 8; ++et) { const bf16* sr = SP + (size_t)unit * 8192 + (erow + 4 * et) * 64 + 8 * g; SA[et][0] = *(const bf16x8*)sr; SA[et][1] = *(const bf16x8*)(sr + 32); }
        const bf16* oip = OI + (size_t)unit * 8192 + (16 * mt + c16) * 128 + 32 * g; const v4u oi0 = *(const v4u*)oip, oi1 = *(const v4u*)(oip + 8), oi2 = *(const v4u*)(oip + 16), oi3 = *(const v4u*)(oip + 24);
        asm volatile("" ::: "memory");
        { float of[32]; unpack8(oi0, of); unpack8(oi1, of + 8); unpack8(oi2, of + 16); unpack8(oi3, of + 24);
#pragma unroll
          for (int et = 0; et < 8; ++et) O[et] = (f32x4){of[4 * et], of[4 * et + 1], of[4 * et + 2], of[4 * et + 3]}; }
#pragma unroll
        for (int et = 0; et < 8; ++et) { f32x4 acc = __builtin_amdgcn_mfma_f32_16x16x32_bf16(SA[et][0], B0, O[et], 0, 0, 0);
            acc = __builtin_amdgcn_mfma_f32_16x16x32_bf16(SA[et][1], B1, acc, 0, 0, 0);
            O[et] = acc; ss += (acc.x * acc.x + acc.y * acc.y) + (acc.z * acc.z + acc.w * acc.w); }
        ss += __shfl_xor(ss, 16); ss += __shfl_xor(ss, 32);
        const float rstd = rsqrtf(ss * (1.f / 128.f) + 1e-6f);
        float gf[32], o[32]; unpack8(gg0, gf); unpack8(gg1, gf + 8); unpack8(gg2, gf + 16); unpack8(gg3, gf + 24);
#pragma unroll
        for (int et = 0; et < 8; ++et) { const f32x4 w4 = *(const f32x4*)(gnw + 32 * g + 4 * et);
#pragma unroll
            for (int j = 0; j < 4; ++j) { const int i = 4 * et + j; o[i] = O[et][j] * rstd * w4[j] * gf[i] * sigm(gf[i]); } }
        bf16* op = MG + (size_t)lr * D + 128 * h + 32 * g;
        *(v4u*)op = pack8(o); *(v4u*)(op + 8) = pack8(o + 8); *(v4u*)(op + 16) = pack8(o + 16); *(v4u*)(op + 24) = pack8(o + 24);
    }
}

#define LAS __attribute__((address_space(3)))
#define XB_TMO      128
#define XB_XCNT(j)  (256  + 64 * (j))
#define XB_XSUB(j)  (1280 + 64 * (j))
#define XB_XGEN(j)  (2304 + 64 * (j))
#define XB_TOP      3328
#define XB_TOPGEN   3392
#define XCD_BAR_WORDS 3456
#define XB_SPIN_CAP (1u << 18)

__device__ __forceinline__ unsigned xb_ld(unsigned* p)              { return __hip_atomic_load(p, __ATOMIC_RELAXED, __HIP_MEMORY_SCOPE_AGENT); }
__device__ __forceinline__ unsigned xb_add(unsigned* p, unsigned v) { return __hip_atomic_fetch_add(p, v, __ATOMIC_RELAXED, __HIP_MEMORY_SCOPE_AGENT); }
__device__ __forceinline__ unsigned xb_xcc_id() { return (unsigned)__builtin_amdgcn_s_getreg((3 << 11) | 20) & 0xFu; }
#define XB_SPIN(cond, bar) do { unsigned _sp = 0; while (cond) { __builtin_amdgcn_s_sleep(1); \
    if ((++_sp & 255u) == 0u) { if (xb_ld(&(bar)[XB_TMO])) break; if (_sp > XB_SPIN_CAP) { atomicAdd(&(bar)[XB_TMO], 1u); break; } } } } while (0)

struct XcdBarrier {
    unsigned* bar; unsigned x;
    volatile LAS unsigned* st;
};

__device__ __forceinline__ XcdBarrier xcd_barrier_post(unsigned* bar, volatile LAS unsigned* st) {
    XcdBarrier b; b.bar = bar; b.x = xb_xcc_id(); b.st = st;
    if (threadIdx.x == 0) (void)xb_add(&bar[XB_XCNT(b.x)], 1u);
    return b;
}
__device__ __forceinline__ void xcd_barrier_complete(unsigned* bar, unsigned x, unsigned& nloc, unsigned& nx) {
    const unsigned G = gridDim.x * gridDim.y * gridDim.z;
    unsigned sum, cnt, mine, sp = 0u;
    for (;;) {
        sum = 0u; cnt = 0u; mine = 0u;
#pragma unroll
        for (unsigned j = 0; j < 16; ++j) { const unsigned c = xb_ld(&bar[XB_XCNT(j)]); sum += c; cnt += (c > 0u) ? 1u : 0u; mine = (j == x) ? c : mine; }
        if (sum == G) break;
        __builtin_amdgcn_s_sleep(1);
        if ((++sp & 255u) == 0u) { if (xb_ld(&bar[XB_TMO])) break; if (sp > XB_SPIN_CAP) { atomicAdd(&bar[XB_TMO], 1u); break; } }
    }
    nloc = mine > 0u ? mine : 1u; nx = cnt > 0u ? cnt : 1u;
}

__device__ __forceinline__ void xcd_barrier(const XcdBarrier& b) {
    asm volatile("s_waitcnt vmcnt(0)" ::: "memory");
    __syncthreads();
    if (threadIdx.x == 0) {
        unsigned* bar = b.bar;
        __builtin_amdgcn_s_waitcnt(0);
        unsigned nloc = b.st[0], nx = b.st[1];
        if (nloc == 0u) { xcd_barrier_complete(bar, b.x, nloc, nx); b.st[0] = nloc; b.st[1] = nx; }
        const unsigned old = xb_add(&bar[XB_XSUB(b.x)], 1u);
        const unsigned gen = old / nloc;
        if (old + 1u == (gen + 1u) * nloc) {
            __builtin_amdgcn_fence(__ATOMIC_RELEASE, "agent");
            asm volatile("s_waitcnt vmcnt(0)" ::: "memory");
            const unsigned og = xb_add(&bar[XB_TOP], 1u);
            const unsigned tg = og / nx;
            if (og + 1u == (tg + 1u) * nx) xb_add(&bar[XB_TOPGEN], 1u);
            else XB_SPIN(xb_ld(&bar[XB_TOPGEN]) == tg, bar);
            __builtin_amdgcn_fence(__ATOMIC_ACQUIRE, "agent");
            xb_add(&bar[XB_XGEN(b.x)], 1u);
            asm volatile("s_waitcnt vmcnt(0)" ::: "memory");
        } else {
            XB_SPIN(xb_ld(&bar[XB_XGEN(b.x)]) == gen, bar);
            __builtin_amdgcn_fence(__ATOMIC_ACQUIRE, "agent");
            asm volatile("s_waitcnt vmcnt(0)" ::: "memory");
        }
    }
    __syncthreads();
}


__global__ void __launch_bounds__(NTHR, 2) hymba_fwd(Args a_kernarg) {
    extern __shared__ __attribute__((aligned(16))) unsigned char lds[];
    cg::grid_group grid = cg::this_grid();
    const int tid = threadIdx.x, lane = tid & 63, wave = __builtin_amdgcn_readfirstlane(tid >> 6);
    const int G = gridDim.x, gw = blockIdx.x * NWAVES + wave, NGW = G * NWAVES;
    volatile LAS unsigned* xst = (volatile LAS unsigned*)(LAS unsigned char*)(lds + LDS_BYTES - 64);
    if (tid < 2) xst[tid] = 0u;
    __syncthreads();
    const XcdBarrier xbar = xcd_barrier_post((unsigned*)AA.ws, xst);
    {
        CArgs& a = AA; bf16* XN = (bf16*)(a.ws + WS_XN);
        float* scr = (float*)lds;
        constexpr int T_IN = (D / 64) * (NPAD / 64), T_OUT = (D / 64) * (D / 64);
        for (int l = 0; l < 2; ++l) {
            transpose_tiles(a.in[2] + (size_t)l * D * NIN, D, NIN, NPAD, (bf16*)(a.ws + WS_WIN + l * WIN_BYTES), scr, (int)blockIdx.x, G, T_IN, tid);
            transpose_tiles(a.in[16] + (size_t)l * D * D, D, D, D, (bf16*)(a.ws + WS_WOUT + l * WOUT_BYTES), scr, (int)blockIdx.x, G, T_OUT, tid);
        }
        for (int m = 2 * gw; m < M; m += 2 * NGW) rms_row2(a.in[0] + (size_t)m * D, a.in[0] + (size_t)(m + 1) * D, a.in[1], XN + (size_t)m * D, XN + (size_t)(m + 1) * D, lane);
        {
            bf16* UPT = (bf16*)(a.ws + WS_UPT);
            for (int e = blockIdx.x * NTHR + tid; e < 2 * 2 * 512 * 64; e += G * NTHR) { const int r = e & 63, c = (e >> 6) & 511, q = (e >> 15) & 1, ll = e >> 16;
                UPT[e] = (bf16)f2bf((q ? a.in[10] : a.in[8])[(size_t)ll * 64 * 512 + r * 512 + c]); }
        }
    }
    if (AA.ws == nullptr) grid.sync();
    xcd_barrier(xbar);
    for (int l = 0; l < 2; ++l) {
        for (int hb = 0; hb < 2; ++hb) {
            {
                CArgs& a = AA; bf16* XN = (bf16*)(a.ws + WS_XN); bf16* U = (bf16*)(a.ws + WS_U + (size_t)hb * U_STRIDE);
                pg8::Gemm g{XN + (size_t)hb * MH * D, (const bf16*)(a.ws + WS_WIN + l * WIN_BYTES), MH, NPAD, D}; pg8::RangeOrder S;
                if (hb == 0) S.init(MH, NPAD, G, (int)blockIdx.x, 0, 480); else S.init(MH, NPAD, G, (int)blockIdx.x, EARLY_TILES, 480 - EARLY_TILES);
                pg8::EpiBf16<0> E{U, NPAD, nullptr, 0, 0, 1.f};
                pg8::gemm_phase<pg8::EpiBf16<0>, pg8::RangeOrder, true, true>((PG8_LAS unsigned char*)lds, g, S, E);
            }
            xcd_barrier(xbar);
            const size_t uo = (size_t)hb * U_STRIDE;
            r1_phase(AA, uo, l, lds, tid);
            g1_phase(AA, uo, l, lds, tid, (int)blockIdx.x, G);
            xcd_barrier(xbar);
            if (blockIdx.x < 32) r2_scan(AA, blockIdx.x, lds, tid);
            else { if (blockIdx.x < 48) g2_scan(AA, blockIdx.x - 32, lds, tid);
                if (hb == 0) {
                    CArgs& a = AA; bf16* XN = (bf16*)(a.ws + WS_XN); bf16* U1 = (bf16*)(a.ws + WS_U1);
                    pg8::Gemm g{XN + (size_t)MH * D, (const bf16*)(a.ws + WS_WIN + l * WIN_BYTES), MH, NPAD, D}; pg8::RangeOrder S; S.init(MH, NPAD, G, (int)blockIdx.x - 32, 0, EARLY_TILES);
                    pg8::EpiBf16<0> E{U1, NPAD, nullptr, 0, 0, 1.f};
                    pg8::gemm_phase<pg8::EpiBf16<0>, pg8::RangeOrder, true, true>((PG8_LAS unsigned char*)lds, g, S, E); } }
            xcd_barrier(xbar);
            r3_phase(AA, uo, l, hb, gw, NGW, lane);
            g3_phase(AA, uo, l, hb, gw, NGW, lane);
            if (hb == 1) xcd_barrier(xbar);
        }
        {
            CArgs& a = AA; bf16* XN = (bf16*)(a.ws + WS_XN);
            pg8::Gemm g{XN, (const bf16*)(a.ws + WS_WOUT + l * WOUT_BYTES), M, D, D}; pg8::StaticOrder S; S.init(M, D, G, (int)blockIdx.x);
            pg8::EpiRmsRes E{l == 0 ? a.in[0] : a.out, a.out, XN, l == 0 ? a.in[1] + D : a.in[17], (float*)(a.ws + WS_SLOTS) + (size_t)l * M * 4, (unsigned*)(a.ws + 16384) + l * 64 * 64, D, l};
            pg8::gemm_phase<pg8::EpiRmsRes, pg8::StaticOrder, false, true>((PG8_LAS unsigned char*)lds, g, S, E);
        }
        if (l == 0) xcd_barrier(xbar);
    }
}

extern "C" void kernel_launch(void* const* d_in, const int* in_sizes, int n_in, void* d_out, int out_size, void* d_ws, size_t ws_size, hipStream_t stream) {
    static int grid = 0;
    if (grid == 0) {
        if (n_in != 18 || out_size != M * D || ws_size < WS_END) { fprintf(stderr, "kernel_launch: unexpected shapes n_in %d out %d ws %zu\n", n_in, out_size, ws_size); grid = -1; return; }
        int dev = 0, cus = 0, per_cu = 0;
        hipGetDevice(&dev); hipDeviceGetAttribute(&cus, hipDeviceAttributeMultiprocessorCount, dev);
        if (hipFuncSetAttribute((const void*)hymba_fwd, hipFuncAttributeMaxDynamicSharedMemorySize, LDS_BYTES) != hipSuccess) { fprintf(stderr, "kernel_launch: hipFuncSetAttribute failed\n"); grid = -1; return; }
        if (hipOccupancyMaxActiveBlocksPerMultiprocessor(&per_cu, (const void*)hymba_fwd, NTHR, LDS_BYTES) != hipSuccess || per_cu < 1) { fprintf(stderr, "kernel_launch: occupancy query failed (%d)\n", per_cu); grid = -1; return; }
        grid = cus * 1;
        fprintf(stderr, "kernel_launch: cus %d per_cu %d grid %d\n", cus, per_cu, grid);
    }
    if (grid < 0) return;
    if (hipMemsetAsync(d_ws, 0, 65536, stream) != hipSuccess) { fprintf(stderr, "kernel_launch: memset failed\n"); return; }
    Args a{};
    for (int i = 0; i < 18; ++i) a.in[i] = (const float*)d_in[i];
    a.out = (float*)d_out; a.ws = (unsigned char*)d_ws;
    void* args[] = {&a};
    hipError_t e = hipLaunchCooperativeKernel((const void*)hymba_fwd, dim3(grid), dim3(NTHR), args, LDS_BYTES, stream);
    if (e != hipSuccess) fprintf(stderr, "cooperative launch failed: %s (grid %d)\n", hipGetErrorString(e), grid);
}
```

```cpp
#include <hip/hip_runtime.h>
#include <hip/hip_cooperative_groups.h>
#include <cstdio>
#include <cstdint>
namespace cg = cooperative_groups;
namespace pg8 {
#define PG8_LAS __attribute__((address_space(3)))
typedef unsigned short bf16_t;
typedef short bf16x8 __attribute__((ext_vector_type(8)));
typedef float f32x4 __attribute__((ext_vector_type(4)));
typedef unsigned u32x4 __attribute__((ext_vector_type(4)));
constexpr int BM = 256, BK = 64, HALF = 128, HTB = HALF * BK * 2  , STAGE_BYTES = 8 * HTB, NXCD = 8, WGM = 8;

__host__ __device__ __forceinline__ int lds_byte(int r, int c) { const int st = (r >> 4) * 2 + (c >> 5), rr = r & 15, cc = c & 31, ob = rr * 64 + cc * 2; return st * 1024 + (ob ^ (((ob >> 9) & 1) << 5)); }
__host__ __device__ __forceinline__ void stage_rc(int b, int& R, int& C) { const int st = b / 1024, sb = b % 1024, swz = sb ^ (((sb >> 9) & 1) << 5); R = (st >> 1) * 16 + swz / 64; C = (st & 1) * 32 + (swz % 64) / 2; }
__host__ __device__ __forceinline__ int perm32(int rho) { const int n = rho >> 4, i = rho & 15; return 8 * (i >> 2) + 4 * n + (i & 3); }

struct Unit { int pm, pn; };
struct Gemm { const bf16_t* A; const bf16_t* Bt; int M, N, K; };

struct StaticOrder {
    int nM, nN, nwg, G, c;
    __host__ __device__ void init(int M, int N, int G_, int c_) { nM = M / BM; nN = N / BM; nwg = nM * nN; G = G_; c = c_; }
    __host__ __device__ bool next(int i, Unit& u) const {
        const long L = (long)i * G + c; if (L >= nwg) return false;
        int wgid = (int)L; { const int q = nwg / NXCD, r = nwg % NXCD, xcd = wgid % NXCD, off = wgid / NXCD; wgid = (xcd < r ? xcd * (q + 1) : r * (q + 1) + (xcd - r) * q) + off; }
        const int nig = WGM * nN, gid = wgid / nig, fm = gid * WGM, gsz = (nM - fm) < WGM ? (nM - fm) : WGM;
        u.pm = fm + ((wgid % nig) % gsz); u.pn = (wgid % nig) / gsz; return true;
    }
    __device__ __forceinline__ void a_ready(const Unit&) const {}
    __device__ __forceinline__ void done(const Unit&) const {}
};

__device__ __forceinline__ unsigned cvt_pk_bf16(float lo, float hi) { unsigned r; asm volatile("v_cvt_pk_bf16_f32 %0, %1, %2" : "=v"(r) : "v"(lo), "v"(hi)); return r; }
typedef float f32x2 __attribute__((ext_vector_type(2)));
__device__ __forceinline__ f32x2 gelu_pk(f32x2 v) {
    const f32x2 av = __builtin_elementwise_abs(v), d = av * 0.2316418882f + 1.0f;
    f32x2 t; t.x = __builtin_amdgcn_rcpf(d.x); t.y = __builtin_amdgcn_rcpf(d.y);
    f32x2 q = t * 0.5307027145f + (-0.7265760135f); q = q * t + 0.7107068705f; q = q * t + (-0.142248368f); q = q * t + 0.127414796f; q = q * t;
    const f32x2 s = (v * v) * (-0.72134752044f);
    f32x2 e; e.x = __builtin_amdgcn_exp2f(s.x); e.y = __builtin_amdgcn_exp2f(s.y);
    const f32x2 m = v * (q * e), r = v - m;
    f32x2 o; o.x = v.x < 0.f ? m.x : r.x; o.y = v.y < 0.f ? m.y : r.y; return o;
}

template <int ACT  > struct EpiBf16 {
    static constexpr bool PERM = true, AFTER_DRAIN = false; static_assert(ACT == 0 || ACT == 1, "EpiBf16: ACT is 0 (none) or 1 (gelu_pk)");
    bf16_t* O; int ldc; const float* bias; int split_cols; size_t split_stride; float scale0;
    __device__ __forceinline__ void operator()(const f32x4 (&acc)[2][2][4][2], const Unit& u, int wr, int wc, int fr, int fq) const {
        const int row0 = u.pm * BM + wr * 64 + fr; int colt = u.pn * BM; bf16_t* base = O;
        float sc = 1.f; if (split_cols) { const int t = colt / split_cols; base += (size_t)t * split_stride; colt -= t * split_cols; if (t == 0) sc = scale0; }
        const int col0 = colt + wc * 32 + 8 * fq, bcol0 = u.pn * BM + wc * 32 + 8 * fq;
        f32x4 bv[2][2];
#pragma unroll
        for (int bj = 0; bj < 2; ++bj)
#pragma unroll
            for (int n = 0; n < 2; ++n) bv[bj][n] = bias ? *(const f32x4*)(bias + bcol0 + bj * HALF + 4 * n) : (f32x4){0.f, 0.f, 0.f, 0.f};
#pragma unroll
        for (int ai = 0; ai < 2; ++ai)
#pragma unroll
            for (int m = 0; m < 4; ++m) { bf16_t* rowp = base + (size_t)(row0 + ai * HALF + m * 16) * ldc + col0;
#pragma unroll
                for (int bj = 0; bj < 2; ++bj) { f32x4 v0 = acc[ai][bj][m][0] + bv[bj][0], v1 = acc[ai][bj][m][1] + bv[bj][1];
                    if (ACT == 1) { f32x2 a = gelu_pk((f32x2){v0[0], v0[1]}), b = gelu_pk((f32x2){v0[2], v0[3]}), c = gelu_pk((f32x2){v1[0], v1[1]}), d = gelu_pk((f32x2){v1[2], v1[3]});
                        v0 = (f32x4){a.x, a.y, b.x, b.y}; v1 = (f32x4){c.x, c.y, d.x, d.y}; }
                    v0 = v0 * sc; v1 = v1 * sc; u32x4 w; w.x = cvt_pk_bf16(v0[0], v0[1]); w.y = cvt_pk_bf16(v0[2], v0[3]); w.z = cvt_pk_bf16(v1[0], v1[1]); w.w = cvt_pk_bf16(v1[2], v1[3]);
                    *(u32x4*)(rowp + bj * HALF) = w; } }
    }
};

template <class Epi, class Sched, bool ALIGN_EPI = false, bool SP2 = false>
__device__ __forceinline__ void gemm_phase(PG8_LAS unsigned char* lds, const Gemm g, const Sched& S, const Epi& E) {
    int tid_ = threadIdx.x; asm volatile("" : "+v"(tid_));
    const int tid = tid_, wid = __builtin_amdgcn_readfirstlane(tid >> 6), lane = tid & 63, wr = wid >> 2, wc = wid & 3, fr = lane & 15, fq = lane >> 4;
    const int K = g.K, nt = K / BK;
    unsigned voffA[2], voffB[2];
#pragma unroll
    for (int i = 0; i < 2; ++i) { int R, C; stage_rc(tid * 16 + i * 8192, R, C); const int Rb = Epi::PERM ? ((R & ~31) + perm32(R & 31)) : R;
        voffA[i] = (unsigned)(R * K + C) * 2u; voffB[i] = (unsigned)(Rb * K + C) * 2u; }
    const size_t kstep = (size_t)(BK * 2);
    const size_t hstep = (size_t)HALF * K * 2;
    const size_t tstep = 2 * hstep;
    const unsigned ldsw = (unsigned)wid * 1024u;
    const int aoff = lds_byte(wr * 64 + fr, fq * 8), boff = lds_byte(wc * 32 + fr, fq * 8);
#define PG8_SA(b, h) (((b) * 2 + (h)) * HTB)
#define PG8_SB(b, h) ((4 + (b) * 2 + (h)) * HTB)
#define PG8_STAGE(bufoff, gbase, voff) do { _Pragma("unroll") for (int _i = 0; _i < 2; ++_i) \
        __builtin_amdgcn_global_load_lds((const unsigned*)((const char*)(gbase) + (voff)[_i]), (PG8_LAS unsigned*)(lds + (bufoff) + ldsw + _i * 8192), 16, 0, 0); } while (0)
#define PG8_LDA(dst, b, h) do { _Pragma("unroll") for (int m = 0; m < 4; ++m) _Pragma("unroll") for (int k = 0; k < 2; ++k) dst[m][k] = *(const PG8_LAS bf16x8*)(lds + PG8_SA(b, h) + aoff + m * 2048 + k * 1024); } while (0)
#define PG8_LDB(dst, b, h) do { _Pragma("unroll") for (int n = 0; n < 2; ++n) _Pragma("unroll") for (int k = 0; k < 2; ++k) dst[n][k] = *(const PG8_LAS bf16x8*)(lds + PG8_SB(b, h) + boff + n * 2048 + k * 1024); } while (0)
#define PG8_MMA(ai, bj, At, Bt) do { __builtin_amdgcn_s_setprio(1); _Pragma("unroll") for (int m = 0; m < 4; ++m) _Pragma("unroll") for (int n = 0; n < 2; ++n) _Pragma("unroll") for (int k = 0; k < 2; ++k) \
        acc[ai][bj][m][n] = __builtin_amdgcn_mfma_f32_16x16x32_bf16(Bt[n][k], At[m][k], acc[ai][bj][m][n], 0, 0, 0); __builtin_amdgcn_s_setprio(0); } while (0)
#define PG8_WAIT_V(n) asm volatile("s_waitcnt vmcnt(" #n ")" ::: "memory")
#define PG8_WAIT_L(n) asm volatile("s_waitcnt lgkmcnt(" #n ")" ::: "memory")
#define PG8_BAR __builtin_amdgcn_s_barrier()
#define PG8_SCHED __builtin_amdgcn_sched_barrier(0)
    Unit cur, nxt; int ui = 0;
    if (!S.next(0, cur)) return;
    f32x4 acc[2][2][4][2];
#pragma unroll
    for (int a = 0; a < 2; ++a)
#pragma unroll
        for (int b = 0; b < 2; ++b)
#pragma unroll
            for (int m = 0; m < 4; ++m)
#pragma unroll
                for (int n = 0; n < 2; ++n) acc[a][b][m][n] = (f32x4){0.f, 0.f, 0.f, 0.f};
    bf16x8 At[4][2], B0[2][2], B1[2][2];
    const char* cA = (const char*)g.A + (size_t)cur.pm * tstep; const char* cB = (const char*)g.Bt + (size_t)cur.pn * tstep;
    S.a_ready(cur);
    if constexpr (SP2) {
        PG8_STAGE(PG8_SB(0, 0), cB, voffB); PG8_STAGE(PG8_SB(0, 1), cB + hstep, voffB); PG8_STAGE(PG8_SA(0, 0), cA, voffA); PG8_STAGE(PG8_SA(0, 1), cA + hstep, voffA);
        if (wr == 1) PG8_BAR;
        PG8_WAIT_V(2); PG8_BAR;
        PG8_STAGE(PG8_SB(1, 0), cB + kstep, voffB); PG8_STAGE(PG8_SA(1, 0), cA + kstep, voffA); PG8_STAGE(PG8_SB(1, 1), cB + hstep + kstep, voffB);
        PG8_WAIT_V(6); PG8_BAR;
    } else {
        PG8_STAGE(PG8_SB(0, 0), cB, voffB); PG8_STAGE(PG8_SA(0, 0), cA, voffA); PG8_STAGE(PG8_SB(0, 1), cB + hstep, voffB); PG8_STAGE(PG8_SA(0, 1), cA + hstep, voffA);
        if (wr == 1) PG8_BAR;
        PG8_WAIT_V(4); PG8_BAR;
        PG8_STAGE(PG8_SB(1, 0), cB + kstep, voffB); PG8_STAGE(PG8_SA(1, 0), cA + kstep, voffA); PG8_STAGE(PG8_SB(1, 1), cB + hstep + kstep, voffB);
        PG8_WAIT_V(6); PG8_BAR;
    }
    for (;;) {
        const bool has_next = S.next(ui + 1, nxt);
        const char* nA = has_next ? (const char*)g.A + (size_t)nxt.pm * tstep : cA; const char* nB = has_next ? (const char*)g.Bt + (size_t)nxt.pn * tstep : cB;
        for (int t = 0; t < nt; t += 2) {
            const bool last = (t == nt - 2);
            const char* a1 = cA + (size_t)(t + 1) * kstep;
            const char* a2 = last ? nA : cA + (size_t)(t + 2) * kstep; const char* b2 = last ? nB : cB + (size_t)(t + 2) * kstep;
            const char* a3 = a2 + kstep; const char* b3 = b2 + kstep;
            if (last && has_next) S.a_ready(nxt);
            if constexpr (SP2) {
            PG8_LDB(B0, 0, 0); PG8_LDB(B1, 0, 1); PG8_SCHED; PG8_LDA(At, 0, 0); PG8_STAGE(PG8_SA(1, 1), a1 + hstep, voffA);
            PG8_WAIT_V(8); PG8_WAIT_L(0); PG8_BAR; PG8_MMA(0, 0, At, B0); PG8_MMA(0, 1, At, B1); PG8_BAR; PG8_SCHED;
            PG8_LDA(At, 0, 1); PG8_STAGE(PG8_SB(0, 0), b2, voffB); PG8_STAGE(PG8_SB(0, 1), b2 + hstep, voffB); PG8_STAGE(PG8_SA(0, 0), a2, voffA);
            PG8_WAIT_V(8); PG8_WAIT_L(0); PG8_BAR; PG8_MMA(1, 0, At, B0); PG8_MMA(1, 1, At, B1); PG8_BAR; PG8_SCHED;
            PG8_LDB(B0, 1, 0); PG8_LDB(B1, 1, 1); PG8_SCHED; PG8_LDA(At, 1, 0); PG8_STAGE(PG8_SA(0, 1), a2 + hstep, voffA);
            PG8_WAIT_V(8); PG8_WAIT_L(0); PG8_BAR; PG8_MMA(0, 0, At, B0); PG8_MMA(0, 1, At, B1); PG8_BAR; PG8_SCHED;
            PG8_LDA(At, 1, 1); PG8_STAGE(PG8_SB(1, 0), b3, voffB); PG8_STAGE(PG8_SB(1, 1), b3 + hstep, voffB); PG8_STAGE(PG8_SA(1, 0), a3, voffA);
            PG8_WAIT_V(8); PG8_WAIT_L(0); PG8_BAR; PG8_MMA(1, 0, At, B0); PG8_MMA(1, 1, At, B1); PG8_BAR; PG8_SCHED;
            } else {
            PG8_LDB(B0, 0, 0); PG8_SCHED; PG8_LDA(At, 0, 0); PG8_STAGE(PG8_SA(1, 1), a1 + hstep, voffA);
            PG8_WAIT_L(8); PG8_BAR; PG8_WAIT_L(0); PG8_MMA(0, 0, At, B0); PG8_BAR; PG8_SCHED;
            PG8_LDB(B1, 0, 1); PG8_STAGE(PG8_SB(0, 0), b2, voffB);
            PG8_BAR; PG8_WAIT_L(0); PG8_MMA(0, 1, At, B1); PG8_BAR;
            PG8_LDA(At, 0, 1); PG8_STAGE(PG8_SA(0, 0), a2, voffA);
            PG8_BAR; PG8_WAIT_L(0); PG8_MMA(1, 0, At, B0); PG8_BAR; PG8_SCHED;
            PG8_STAGE(PG8_SB(0, 1), b2 + hstep, voffB);
            PG8_WAIT_V(6); PG8_BAR; PG8_MMA(1, 1, At, B1); PG8_BAR;
            PG8_LDB(B0, 1, 0); PG8_SCHED; PG8_LDA(At, 1, 0); PG8_STAGE(PG8_SA(0, 1), a2 + hstep, voffA);
            PG8_WAIT_L(8); PG8_BAR; PG8_WAIT_L(0); PG8_MMA(0, 0, At, B0); PG8_BAR; PG8_SCHED;
            PG8_LDB(B1, 1, 1); PG8_STAGE(PG8_SB(1, 0), b3, voffB);
            PG8_BAR; PG8_WAIT_L(0); PG8_MMA(0, 1, At, B1); PG8_BAR;
            PG8_LDA(At, 1, 1); PG8_STAGE(PG8_SA(1, 0), a3, voffA);
            PG8_BAR; PG8_WAIT_L(0); PG8_MMA(1, 0, At, B0); PG8_BAR; PG8_SCHED;
            PG8_STAGE(PG8_SB(1, 1), b3 + hstep, voffB);
            PG8_WAIT_V(6); PG8_BAR; PG8_MMA(1, 1, At, B1); PG8_BAR;
            }
        }
        if constexpr (ALIGN_EPI) { if (wr == 0) PG8_BAR; }
        if constexpr (!Epi::AFTER_DRAIN) { E(acc, cur, wr, wc, fr, fq); S.done(cur); }
        if (!has_next) break;
#pragma unroll
        for (int a = 0; a < 2; ++a)
#pragma unroll
            for (int b = 0; b < 2; ++b)
#pragma unroll
                for (int m = 0; m < 4; ++m)
#pragma unroll
                    for (int n = 0; n < 2; ++n) acc[a][b][m][n] = (f32x4){0.f, 0.f, 0.f, 0.f};
        cur = nxt; cA = nA; cB = nB; ++ui;
        if constexpr (ALIGN_EPI) { if (wr == 1) PG8_BAR; }
    }
    PG8_WAIT_V(0);
    if constexpr (!ALIGN_EPI) { if (wr == 0) PG8_BAR; }
    PG8_BAR;
    if constexpr (Epi::AFTER_DRAIN) { E.fused(acc, cur, wr, wc, fr, fq, lds, wid, lane); S.done(cur); }
#undef PG8_SA
#undef PG8_SB
#undef PG8_STAGE
#undef PG8_LDA
#undef PG8_LDB
#undef PG8_MMA
#undef PG8_WAIT_V
#undef PG8_WAIT_L
#undef PG8_BAR
#undef PG8_SCHED
}
}
namespace pg8 {
struct EpiResid {
    static constexpr bool PERM = false, AFTER_DRAIN = false;
    const float* base; float* out; int ldc;
    __device__ __forceinline__ void operator()(const f32x4 (&acc)[2][2][4][2], const Unit& u, int wr, int wc, int fr, int fq) const {
        const int col0 = u.pn * BM + wc * 32 + 4 * fq;
#pragma unroll
        for (int ai = 0; ai < 2; ++ai)
#pragma unroll
            for (int m = 0; m < 4; ++m) { const size_t off = (size_t)(u.pm * BM + ai * HALF + wr * 64 + m * 16 + fr) * ldc + col0;
#pragma unroll
                for (int bj = 0; bj < 2; ++bj)
#pragma unroll
                    for (int n = 0; n < 2; ++n) { const f32x4 b = *(const f32x4*)(base + off + bj * HALF + n * 16); *(f32x4*)(out + off + bj * HALF + n * 16) = b + acc[ai][bj][m][n]; } }
    }
};
struct RangeOrder {
    int nM, nN, nwg, G, c, first, last;
    __host__ __device__ void init(int M, int N, int G_, int c_, int first_, int count_) { nM = M / BM; nN = N / BM; nwg = nM * nN; G = G_; c = c_; first = first_; last = first_ + count_; }
    __host__ __device__ bool next(int i, Unit& u) const {
        const long L = (long)first + (long)i * G + c; if (c < 0 || L >= last || L >= nwg) return false;
        int wgid = (int)L; { const int q = nwg / NXCD, r = nwg % NXCD, xcd = wgid % NXCD, off = wgid / NXCD; wgid = (xcd < r ? xcd * (q + 1) : r * (q + 1) + (xcd - r) * q) + off; }
        const int nig = WGM * nN, gid = wgid / nig, fm = gid * WGM, gsz = (nM - fm) < WGM ? (nM - fm) : WGM;
        u.pm = fm + ((wgid % nig) % gsz); u.pn = (wgid % nig) / gsz; return true;
    }
    __device__ __forceinline__ void a_ready(const Unit&) const {}
    __device__ __forceinline__ void done(const Unit&) const {}
};
struct EpiRmsRes {
    static constexpr bool PERM = false, AFTER_DRAIN = true;
    const float* base; float* out; bf16_t* xn; const float* w; float* slots; unsigned* cnt; int ldc; int mode;
    __device__ __forceinline__ void fused(f32x4 (&acc)[2][2][4][2], const Unit& u, int wr, int wc, int fr, int fq, PG8_LAS unsigned char* lds, int wid, int lane) const {
        const int col0 = u.pn * BM + wc * 32 + 4 * fq;
        PG8_LAS float* P = (PG8_LAS float*)lds; PG8_LAS float* S = (PG8_LAS float*)(lds + 4096);
#pragma unroll
        for (int ai = 0; ai < 2; ++ai)
#pragma unroll
            for (int m = 0; m < 4; ++m) { const size_t off = (size_t)(u.pm * BM + ai * HALF + wr * 64 + m * 16 + fr) * ldc + col0; float s = 0.f;
#pragma unroll
                for (int bj = 0; bj < 2; ++bj)
#pragma unroll
                    for (int n = 0; n < 2; ++n) { const f32x4 v = acc[ai][bj][m][n] + *(const f32x4*)(base + off + bj * HALF + n * 16); acc[ai][bj][m][n] = v; s += (v[0] * v[0] + v[1] * v[1]) + (v[2] * v[2] + v[3] * v[3]); }
                s += __shfl_xor(s, 16); s += __shfl_xor(s, 32);
                if (fq == 0) P[(ai * HALF + wr * 64 + m * 16 + fr) * 4 + wc] = s;
                if (m & 1) asm volatile("" ::: "memory"); }
        asm volatile("s_waitcnt lgkmcnt(0)" ::: "memory"); __builtin_amdgcn_s_barrier(); asm volatile("" ::: "memory");
        const int row = wid * 32 + (lane & 31);
        if (lane < 32) { const float tot = (P[row * 4 + 0] + P[row * 4 + 1]) + (P[row * 4 + 2] + P[row * 4 + 3]);
            __hip_atomic_store(slots + ((size_t)(u.pm * BM + row) * 4 + u.pn), tot, __ATOMIC_RELAXED, __HIP_MEMORY_SCOPE_AGENT); }
        asm volatile("s_waitcnt vmcnt(0)" ::: "memory");
        if (lane == 0) __hip_atomic_fetch_add(cnt + 64 * u.pm, 1u, __ATOMIC_RELAXED, __HIP_MEMORY_SCOPE_AGENT);
        if (wid == 0) { while ((unsigned)__builtin_amdgcn_readfirstlane(__hip_atomic_load(cnt + 64 * u.pm, __ATOMIC_RELAXED, __HIP_MEMORY_SCOPE_AGENT)) < 32u) __builtin_amdgcn_s_sleep(2);
            __builtin_amdgcn_fence(__ATOMIC_ACQUIRE, "agent"); }
        asm volatile("s_waitcnt vmcnt(0) lgkmcnt(0)" ::: "memory"); __builtin_amdgcn_s_barrier(); asm volatile("" ::: "memory");
        if (lane < 32) { const float* sl = slots + (size_t)(u.pm * BM + row) * 4; float q = 0.f;
#pragma unroll
            for (int t = 0; t < 4; ++t) q += __hip_atomic_load(sl + t, __ATOMIC_RELAXED, __HIP_MEMORY_SCOPE_AGENT);
            S[row] = 1.0f / sqrtf(q * (1.f / 1024.f) + 1e-6f); }
        asm volatile("s_waitcnt lgkmcnt(0)" ::: "memory"); __builtin_amdgcn_s_barrier(); asm volatile("" ::: "memory");
        f32x4 wv[2][2];
#pragma unroll
        for (int bj = 0; bj < 2; ++bj)
#pragma unroll
            for (int n = 0; n < 2; ++n) wv[bj][n] = *(const f32x4*)(w + col0 + bj * HALF + n * 16);
#pragma unroll
        for (int ai = 0; ai < 2; ++ai)
#pragma unroll
            for (int m = 0; m < 4; ++m) { const int r = ai * HALF + wr * 64 + m * 16 + fr; const float rs = S[r]; const size_t off = (size_t)(u.pm * BM + r) * ldc + col0;
#pragma unroll
                for (int bj = 0; bj < 2; ++bj)
#pragma unroll
                    for (int n = 0; n < 2; ++n) { const f32x4 v = acc[ai][bj][m][n]; const f32x4 nv = v * rs * wv[bj][n];
                        if (mode == 0) { *(f32x4*)(out + off + bj * HALF + n * 16) = v; typedef unsigned u32x2v __attribute__((ext_vector_type(2))); u32x2v pk; pk.x = cvt_pk_bf16(nv[0], nv[1]); pk.y = cvt_pk_bf16(nv[2], nv[3]);
                            *(u32x2v*)(xn + off + bj * HALF + n * 16) = pk; }
                        else *(f32x4*)(out + off + bj * HALF + n * 16) = nv; } }
    }
};
}
constexpr int NWAVES = 8, NTHR = 512;
constexpr int BATCH = 2, T = 8192, D = 1024, M = BATCH * T, MH = T;
constexpr int NIN = 3728, NPAD = 3840;
constexpr int C_GQ = 0, C_GK = 256, C_GV = 512, C_GLR = 1024, C_GG = 1040, C_R = 1552, C_K = 2064, C_V = 2576, C_WL = 3088, C_AL = 3152, C_RG = 3216;
constexpr size_t MiB = 1u << 20;
constexpr size_t WS_WIN = 1 * MiB, WIN_BYTES = (size_t)NPAD * D * 2;
constexpr size_t WS_WOUT = 16 * MiB, WOUT_BYTES = (size_t)D * D * 2;
constexpr size_t WS_XN = 20 * MiB;
constexpr size_t WS_U = 52 * MiB, WS_U1 = 193 * MiB, U_STRIDE = WS_U1 - WS_U;
constexpr size_t WS_SLOTS = 192 * MiB;
constexpr size_t WS_END = 254 * MiB;
constexpr int LDS_BYTES = 163840;
constexpr int EARLY_TILES = 224;

typedef unsigned short bf16;
typedef unsigned v4u __attribute__((ext_vector_type(4)));
typedef float f32x4 __attribute__((ext_vector_type(4)));
#define LDS_WAIT() asm volatile("s_waitcnt lgkmcnt(0)" ::: "memory")
#define LBAR() do { asm volatile("s_waitcnt lgkmcnt(0)" ::: "memory"); __builtin_amdgcn_s_barrier(); asm volatile("" ::: "memory"); } while (0)
__device__ __forceinline__ float bf2f(unsigned h) { return __uint_as_float(h << 16); }
__device__ __forceinline__ unsigned f2bf(float f) { unsigned u = __float_as_uint(f); return (u + 0x7fffu + ((u >> 16) & 1u)) >> 16; }
typedef __bf16 bf16x2_t __attribute__((ext_vector_type(2)));
typedef float f32x2_t __attribute__((ext_vector_type(2)));
__device__ __forceinline__ unsigned pk2(float lo, float hi) { const f32x2_t v = {lo, hi}; const bf16x2_t b = __builtin_convertvector(v, bf16x2_t); return __builtin_bit_cast(unsigned, b); }
__device__ __forceinline__ float wave_sum(float v) {
#pragma unroll
    for (int o = 1; o < 64; o <<= 1) v += __shfl_xor(v, o);
    return v;
}
__device__ __forceinline__ float sigm(float x) { return __builtin_amdgcn_rcpf(1.f + __expf(-x)); }
__device__ __forceinline__ float tanh_fast(float x) { return 1.f - 2.f * __builtin_amdgcn_rcpf(1.f + __expf(2.f * x)); }
__device__ __forceinline__ float rl(float v, int l) { return __int_as_float(__builtin_amdgcn_readlane(__float_as_int(v), l)); }

typedef short bf16x8 __attribute__((ext_vector_type(8)));
typedef unsigned v2u __attribute__((ext_vector_type(2)));
__device__ __forceinline__ v2u pack4(f32x4 v) { v2u r; r.x = pk2(v.x, v.y); r.y = pk2(v.z, v.w); return r; }
__device__ __forceinline__ void unpack8(v4u w, float* o) { o[0] = bf2f(w.x & 0xffffu); o[1] = bf2f(w.x >> 16); o[2] = bf2f(w.y & 0xffffu); o[3] = bf2f(w.y >> 16);
    o[4] = bf2f(w.z & 0xffffu); o[5] = bf2f(w.z >> 16); o[6] = bf2f(w.w & 0xffffu); o[7] = bf2f(w.w >> 16); }
__device__ __forceinline__ v4u pack8(const float* v) { v4u r; r.x = pk2(v[0], v[1]); r.y = pk2(v[2], v[3]); r.z = pk2(v[4], v[5]); r.w = pk2(v[6], v[7]); return r; }
struct Args { const float* in[18]; float* out; unsigned char* ws; };
typedef const Args __attribute__((address_space(4))) CArgs;
__device__ __forceinline__ CArgs* opaque_args() { CArgs* p = (CArgs*)__builtin_amdgcn_kernarg_segment_ptr(); asm volatile("" : "+s"(p)); return p; }
#define AA (*opaque_args())

__device__ __forceinline__ void rms_row2(const float* x0, const float* x1, const float* w, bf16* o0, bf16* o1, int lane) {
    const f32x4* r0 = (const f32x4*)x0 + lane; const f32x4* r1 = (const f32x4*)x1 + lane; const f32x4* wr = (const f32x4*)w + lane;
    f32x4 a[4], b[4]; float sa = 0.f, sb = 0.f;
#pragma unroll
    for (int j = 0; j < 4; ++j) { a[j] = r0[64 * j]; b[j] = r1[64 * j]; }
#pragma unroll
    for (int j = 0; j < 4; ++j) { sa += (a[j].x * a[j].x + a[j].y * a[j].y) + (a[j].z * a[j].z + a[j].w * a[j].w); sb += (b[j].x * b[j].x + b[j].y * b[j].y) + (b[j].z * b[j].z + b[j].w * b[j].w); }
    const float ra = rsqrtf(wave_sum(sa) * (1.f / D) + 1e-6f), rb = rsqrtf(wave_sum(sb) * (1.f / D) + 1e-6f);
#pragma unroll
    for (int j = 0; j < 4; ++j) { const f32x4 ww = wr[64 * j]; const f32x4 oa = a[j] * ra * ww, ob = b[j] * rb * ww;
        ((v2u*)o0 + lane)[64 * j] = pack4(oa); ((v2u*)o1 + lane)[64 * j] = pack4(ob); }
}
__device__ __forceinline__ void transpose_item(const float* W, int K, int N, int Npad, bf16* WT, float* scr, int item, int lane) {
    const int nblk = Npad / 32, kb = item / nblk, nb = item % nblk, k0 = 64 * kb, n0 = 32 * nb;
    const int n = n0 + (lane & 31);
#pragma unroll 8
    for (int i = 0; i < 32; ++i) { const int kk = 2 * i + (lane >> 5); scr[kk * 33 + (lane & 31)] = (n < N) ? W[(size_t)(k0 + kk) * N + n] : 0.f; }
    LDS_WAIT();
    const int c = lane & 7;
#pragma unroll
    for (int j = 0; j < 4; ++j) { const int nn = (lane >> 3) + 8 * j; const float* s = scr + (8 * c) * 33 + nn;
        v4u o; o.x = pk2(s[0 * 33], s[1 * 33]); o.y = pk2(s[2 * 33], s[3 * 33]); o.z = pk2(s[4 * 33], s[5 * 33]); o.w = pk2(s[6 * 33], s[7 * 33]);
        *(v4u*)(WT + (size_t)(n0 + nn) * K + k0 + 8 * c) = o; }
    LDS_WAIT();
}
__device__ __forceinline__ void transpose_tiles(const float* W, int K, int N, int Npad, bf16* WT, float* scr  , int first, int stride, int ntiles, int tid) {
    const int nblk = Npad / 64, kr = tid >> 4, nq = tid & 15;
    f32x4 v0 = {0.f, 0.f, 0.f, 0.f}, v1 = v0;
    if (first < ntiles) { const int kb = first / nblk, nb = first % nblk, n = 64 * nb + 4 * nq; if (n < N) { v0 = *(const f32x4*)(W + (size_t)(64 * kb + kr) * N + n); v1 = *(const f32x4*)(W + (size_t)(64 * kb + 32 + kr) * N + n); } }
#pragma unroll 1
    for (int it = first; it < ntiles; it += stride) {
        const int kb = it / nblk, nb = it % nblk;
        scr[kr * 65 + 4 * nq] = v0.x; scr[kr * 65 + 4 * nq + 1] = v0.y; scr[kr * 65 + 4 * nq + 2] = v0.z; scr[kr * 65 + 4 * nq + 3] = v0.w;
        scr[(32 + kr) * 65 + 4 * nq] = v1.x; scr[(32 + kr) * 65 + 4 * nq + 1] = v1.y; scr[(32 + kr) * 65 + 4 * nq + 2] = v1.z; scr[(32 + kr) * 65 + 4 * nq + 3] = v1.w;
        const int nx = it + stride; v0 = (f32x4){0.f, 0.f, 0.f, 0.f}; v1 = v0;
        if (nx < ntiles) { const int kb2 = nx / nblk, nb2 = nx % nblk, n = 64 * nb2 + 4 * nq; if (n < N) { v0 = *(const f32x4*)(W + (size_t)(64 * kb2 + kr) * N + n); v1 = *(const f32x4*)(W + (size_t)(64 * kb2 + 32 + kr) * N + n); } }
        LBAR();
        { const int n = tid >> 3, kc = tid & 7; const float* sp = scr + (8 * kc) * 65 + n; float o[8];
#pragma unroll
          for (int j = 0; j < 8; ++j) o[j] = sp[j * 65];
          *(v4u*)(WT + (size_t)(64 * nb + n) * K + 64 * kb + 8 * kc) = pack8(o); }
        LBAR();
    }
}
__device__ __forceinline__ void rms_row(const float* xrow, const float* w, bf16* obf, float* of32, int lane) {
    const f32x4* xr = (const f32x4*)xrow + lane; const f32x4* wr = (const f32x4*)w + lane;
    f32x4 v[4]; float s = 0.f;
#pragma unroll
    for (int j = 0; j < 4; ++j) { v[j] = xr[64 * j]; s += (v[j].x * v[j].x + v[j].y * v[j].y) + (v[j].z * v[j].z + v[j].w * v[j].w); }
    const float rs = rsqrtf(wave_sum(s) * (1.f / D) + 1e-6f);
#pragma unroll
    for (int j = 0; j < 4; ++j) { const f32x4 ww = wr[64 * j]; f32x4 o = v[j] * rs * ww;
        if (of32) ((f32x4*)of32 + lane)[64 * j] = o;
        else ((unsigned long long*)obf + lane)[64 * j] = (unsigned long long)pk2(o.x, o.y) | ((unsigned long long)pk2(o.z, o.w) << 32); }
}

constexpr int PITCH = 72, FP = 68, TP = 20;
constexpr int OFF_TW = 0, OFF_AL = 9216, OFF_ARK = 18432, OFF_XA = 27648, OFF_XW = 45056, OFF_AT = 63488, OFF_RT = 72704, OFF_BH = 81920, OFF_KH = 91136,
              OFF_BBT = 100352, OFF_KBT = 109568, OFF_VT = 118784, OFF_TII = 128000, OFF_TOT = 133120, OFF_BC = 135168;
constexpr int OFF_AAK = OFF_TW, OFF_ARB = OFF_AL, OFF_AAB = OFF_XA, OFF_XT = OFF_XW;
constexpr size_t WS_MC = 112 * MiB, WS_NC = 120 * MiB, WS_PP = 136 * MiB, WS_Y0 = 144 * MiB, WS_S0 = 152 * MiB, WS_DEC = 160 * MiB, WS_BON2 = 161 * MiB, WS_UPT = 162 * MiB;
constexpr int NUNIT = 1024;

__device__ __forceinline__ f32x4 mma2s(const bf16* Ab, int ak, const bf16* Bb, int bk, int g, f32x4 acc) {
    acc = __builtin_amdgcn_mfma_f32_16x16x32_bf16(*(const bf16x8*)(Ab + ((g ^ ak) << 3)), *(const bf16x8*)(Bb + ((g ^ bk) << 3)), acc, 0, 0, 0);
    acc = __builtin_amdgcn_mfma_f32_16x16x32_bf16(*(const bf16x8*)(Ab + (((g + 4) ^ ak) << 3)), *(const bf16x8*)(Bb + (((g + 4) ^ bk) << 3)), acc, 0, 0, 0);
    return acc;
}
#define SWK(row) (((row) >> 3) & 7)
#define SWC(row, t) ((row) * PITCH + ((((t) >> 3) ^ SWK(row)) << 3) + ((t) & 7))
__device__ __forceinline__ f32x4 mma2(const bf16* Arow, const bf16* Brow, f32x4 acc) {
    acc = __builtin_amdgcn_mfma_f32_16x16x32_bf16(*(const bf16x8*)(Arow), *(const bf16x8*)(Brow), acc, 0, 0, 0);
    acc = __builtin_amdgcn_mfma_f32_16x16x32_bf16(*(const bf16x8*)(Arow + 32), *(const bf16x8*)(Brow + 32), acc, 0, 0, 0);
    return acc;
}

__device__ __forceinline__ void r1_phase(CArgs& a, size_t uo, int l, unsigned char* L, int tid0) {
    asm volatile("" : "+v"(tid0));
    const int wave = __builtin_amdgcn_readfirstlane(tid0 >> 6);
    const bf16* U = (const bf16*)(a.ws + WS_U + uo);
    bf16* TW = (bf16*)(L + 138240 + 2560); bf16* ALm = (bf16*)(L + 138240 + 2560 + 9216);
    bf16* ARK = (bf16*)(L + OFF_ARK); bf16* AAK = (bf16*)(L + OFF_AAK); bf16* ARB = (bf16*)(L + OFF_ARB);
    float* XA = (float*)(L + OFF_XA); float* XW = (float*)(L + OFF_XW); float* AAB = (float*)(L + OFF_AAB); bf16* XT = (bf16*)(L + OFF_XT);
    bf16* AT = (bf16*)(L + OFF_AT); bf16* RT = (bf16*)(L + OFF_RT); bf16* BH = (bf16*)(L + OFF_BH); bf16* KH = (bf16*)(L + OFF_KH);
    bf16* BBT = (bf16*)(L + OFF_BBT); bf16* KBT = (bf16*)(L + OFF_KBT); bf16* VT = (bf16*)(L + OFF_VT);
    float* TII = (float*)(L + OFF_TII); float* TOT = (float*)(L + OFF_TOT); float* BC = (float*)(L + OFF_BC);
    const bf16* UPT = (const bf16*)(a.ws + WS_UPT) + (size_t)l * 2 * 512 * 64;
    const float* mu = a.in[6] + l * 1664;
    float* WTS = (float*)(L + 135680);
    const int ch = (int)blockIdx.x >> 1, hbase = 4 * ((int)blockIdx.x & 1);
    v4u Lrc, Lkc, Lvc, Lrp, Lkp, Lvp; bf16x8 wfa0, wfa1; float pw[8];
#define R1_ISSUE(h_) do { const int lr_ = 64 * ch + (tid >> 3); const bf16* uq_ = U + (size_t)lr_ * NPAD + 64 * (h_) + 8 * (tid & 7); \
        Lrc = *(const v4u*)(uq_ + C_R); Lkc = *(const v4u*)(uq_ + C_K); Lvc = *(const v4u*)(uq_ + C_V); Lrp = (v4u){0u, 0u, 0u, 0u}; Lkp = Lrp; Lvp = Lrp; \
        if (lr_ > 0) { Lrp = *(const v4u*)(uq_ + C_R - NPAD); Lkp = *(const v4u*)(uq_ + C_K - NPAD); Lvp = *(const v4u*)(uq_ + C_V - NPAD); } \
        if (tid < 64) { const int c_ = l * 512 + 64 * (h_) + tid; pw[0] = a.in[7][c_]; pw[1] = a.in[9][c_]; pw[2] = a.in[11][c_]; pw[3] = a.in[12][c_]; pw[4] = a.in[13][c_]; \
            pw[5] = mu[64 * (h_) + tid]; pw[6] = mu[512 + 64 * (h_) + tid]; pw[7] = mu[1024 + 64 * (h_) + tid]; } \
        { const bf16* WT_ = UPT + (size_t)(wave >> 2) * 512 * 64 + (size_t)(64 * (h_) + 16 * (wave & 3) + (tid & 15)) * 64 + 8 * ((tid & 63) >> 4); wfa0 = *(const bf16x8*)WT_; wfa1 = *(const bf16x8*)(WT_ + 32); } } while (0)
    {
        int tid = tid0; asm volatile("" : "+v"(tid));
        R1_ISSUE(hbase);
        const int t = tid >> 3, cg = tid & 7, lr = 64 * ch + t; const bf16* up = U + (size_t)lr * NPAD + C_WL + 16 * cg;
        const v4u c0 = *(const v4u*)up, c1 = *(const v4u*)(up + 8); v4u p0 = {0u, 0u, 0u, 0u}, p1 = p0;
        if (lr > 0) { p0 = *(const v4u*)(up - NPAD); p1 = *(const v4u*)(up - NPAD + 8); }
        float cu[16], pr[16], o[16]; unpack8(c0, cu); unpack8(c1, cu + 8); unpack8(p0, pr); unpack8(p1, pr + 8);
        const float* mp = mu + 1536 + 16 * cg;
#pragma unroll
        for (int i = 0; i < 16; ++i) { float mv = cu[i] + (pr[i] - cu[i]) * mp[i]; if (cg < 4) mv = tanh_fast(mv); o[i] = mv; }
        bf16* dst = (cg < 4 ? TW : ALm) + t * PITCH + 16 * (cg & 3);
        *(v4u*)dst = pack8(o); *(v4u*)(dst + 8) = pack8(o + 8);
    }
#pragma unroll 1
    for (int hi = 0; hi < 4; ++hi) {
        int tid = tid0; asm volatile("" : "+v"(tid));
        const int lane = tid & 63, g = lane >> 4, c16 = lane & 15;
        const int h = hbase + hi, unit = ch * 8 + h;
        const int t = tid >> 3, dg = tid & 7, d0 = 8 * dg, lr = 64 * ch + t, hc = 64 * h + d0;
        if (tid < 64) {
#pragma unroll
            for (int q = 0; q < 8; ++q) WTS[64 * q + tid] = pw[q]; }
        LBAR();
        {
            const int q = wave >> 2, dt = wave & 3;
            const bf16x8 a0 = wfa0, a1 = wfa1;
            const bf16* Bm = q ? ALm : TW; float* X = q ? XA : XW;
#pragma unroll
            for (int tt = 0; tt < 4; ++tt) { const bf16* br = Bm + (16 * tt + c16) * PITCH + 8 * g; f32x4 acc = {0.f, 0.f, 0.f, 0.f};
                acc = __builtin_amdgcn_mfma_f32_16x16x32_bf16(a0, *(const bf16x8*)br, acc, 0, 0, 0);
                acc = __builtin_amdgcn_mfma_f32_16x16x32_bf16(a1, *(const bf16x8*)(br + 32), acc, 0, 0, 0);
                *(f32x4*)(X + (16 * tt + c16) * FP + 16 * dt + 4 * g) = acc; }
        }
        LBAR();
        float r[8], kq[8], v[8], al[8], be[8], lw[8];
        {
            float rc[8], rp[8], kc[8], kp[8], vc[8], vp[8];
            unpack8(Lrc, rc); unpack8(Lkc, kc); unpack8(Lvc, vc); unpack8(Lrp, rp); unpack8(Lkp, kp); unpack8(Lvp, vp);
            const float* w0p = WTS + d0; const float* a0p = WTS + 64 + d0; const float* kkp = WTS + 128 + d0;
            const float* kap = WTS + 192 + d0; const float* rkp = WTS + 256 + d0;
            float nn = 0.f, bon = 0.f, kk[8], av[8];
#pragma unroll
            for (int i = 0; i < 8; ++i) {
                const float xw = XW[t * FP + d0 + i] + w0p[i], xa = XA[t * FP + d0 + i] + a0p[i];
                lw[i] = -0.60653065971f * sigm(xw); av[i] = sigm(xa);
                r[i] = rc[i] + (rp[i] - rc[i]) * WTS[320 + d0 + i]; const float k = kc[i] + (kp[i] - kc[i]) * WTS[384 + d0 + i]; v[i] = vc[i] + (vp[i] - vc[i]) * WTS[448 + d0 + i];
                kk[i] = k * kkp[i]; nn += kk[i] * kk[i];
                kq[i] = k * (1.f + (av[i] - 1.f) * kap[i]); bon += r[i] * kq[i] * rkp[i];
            }
            nn += __shfl_xor(nn, 1); nn += __shfl_xor(nn, 2); nn += __shfl_xor(nn, 4);
            bon += __shfl_xor(bon, 1); bon += __shfl_xor(bon, 2); bon += __shfl_xor(bon, 4);
            const float inv = __builtin_amdgcn_rsqf(fmaxf(nn, 1e-24f));
#pragma unroll
            for (int i = 0; i < 8; ++i) { const float kn = kk[i] * inv; al[i] = -kn; be[i] = av[i] * kn; XW[t * FP + d0 + i] = lw[i]; }
            if (dg == 0) ((float*)(a.ws + WS_BON2))[lr * 8 + h] = bon;
        }
        LBAR();
        {
            const int d = tid & 63, tb = tid >> 6; float p[8]; float run = 0.f;
#pragma unroll
            for (int i = 0; i < 8; ++i) { run += XW[(8 * tb + i) * FP + d]; p[i] = run; }
            TOT[tb * 64 + d] = run;
            LBAR();
            float off = 0.f;
#pragma unroll
            for (int j = 0; j < 8; ++j) off += (j < tb) ? TOT[j * 64 + d] : 0.f;
#pragma unroll
            for (int i = 0; i < 8; ++i) XW[(8 * tb + i) * FP + d] = off + p[i];
            if (tb == 7) { BC[d] = off + run; BC[64 + d] = __expf(off + run); }
        }
        LBAR();
        {
            float at[8], rt[8], bh[8], kh[8];
#pragma unroll
            for (int i = 0; i < 8; ++i) { const float b = XW[t * FP + d0 + i];
                const float eb = __expf(b), enb = __builtin_amdgcn_rcpf(eb), ebp = __expf(b - lw[i]), ebc = BC[64 + d0 + i] * enb;
                at[i] = al[i] * ebp; rt[i] = r[i] * eb; bh[i] = be[i] * enb; kh[i] = kq[i] * enb;
                BBT[SWC(d0 + i, t)] = (bf16)f2bf(be[i] * ebc); KBT[SWC(d0 + i, t)] = (bf16)f2bf(kq[i] * ebc); VT[SWC(d0 + i, t)] = (bf16)f2bf(v[i]); }
            *(v4u*)(AT + t * PITCH + d0) = pack8(at); *(v4u*)(RT + t * PITCH + d0) = pack8(rt); *(v4u*)(BH + t * PITCH + d0) = pack8(bh); *(v4u*)(KH + t * PITCH + d0) = pack8(kh);
        }
        asm volatile("" ::: "memory");
        if (hi + 1 < 4) R1_ISSUE(h + 1);
        LBAR();
        {
            const int q = wave >> 1, mh = wave & 1;
            const bf16* As = (q < 2) ? AT : RT; const bf16* Bs = (q & 1) ? KH : BH;
#pragma unroll
            for (int t2 = 0; t2 < 2; ++t2) { const int tt = 2 * mh + t2; const int tcol = 16 * tt + c16;
#pragma unroll
                for (int jt = 0; jt < 4; ++jt) {
                    f32x4 acc = {0.f, 0.f, 0.f, 0.f};
                    if (jt <= tt) { acc = mma2(Bs + (16 * jt + c16) * PITCH + 8 * g, As + tcol * PITCH + 8 * g, acc);
#pragma unroll
                        for (int j = 0; j < 4; ++j) { const int jj = 16 * jt + 4 * g + j; const bool keep = (q < 2) ? (jj < tcol) : (jj <= tcol); if (!keep) acc[j] = 0.f; } }
                    if (q == 0) *(f32x4*)(AAB + tcol * FP + 16 * jt + 4 * g) = acc;
                    else { bf16* dst = (q == 1 ? AAK : (q == 2 ? ARB : ARK)); *(v2u*)(dst + tcol * PITCH + 16 * jt + 4 * g) = pack4(acc); }
                } }
        }
        LBAR();
        f32x4 Z[4];
        {
            if (wave == 0) { const int i = g; float Tc[16];
#pragma unroll
                for (int tr = 0; tr < 16; ++tr) { float s0 = (c16 == tr) ? 1.f : 0.f, s1 = 0.f, s2 = 0.f, s3 = 0.f; const float* ar = AAB + (16 * i + tr) * FP + 16 * i;
#pragma unroll
                    for (int j = 0; j < 16; j += 4) { if (j < tr) s0 += ar[j] * Tc[j]; if (j + 1 < tr) s1 += ar[j + 1] * Tc[j + 1]; if (j + 2 < tr) s2 += ar[j + 2] * Tc[j + 2]; if (j + 3 < tr) s3 += ar[j + 3] * Tc[j + 3]; }
                    const float sv = (s0 + s1) + (s2 + s3); Tc[tr] = sv; TII[(i * 16 + tr) * TP + c16] = sv; } }
            if (wave < 4) {
#pragma unroll
                for (int i = 0; i < 4; ++i)
#pragma unroll
                    for (int j = 0; j < 4; ++j) Z[i][j] = bf2f(AT[(16 * i + 4 * g + j) * PITCH + 16 * wave + c16]);
            } else {
#pragma unroll
                for (int i = 0; i < 4; ++i) { f32x4 acc = {0.f, 0.f, 0.f, 0.f}; const int er = 16 * (wave - 4) + c16; Z[i] = mma2s(AAK + (16 * i + c16) * PITCH, 0, VT + er * PITCH, SWK(er), g, acc); }
            }
        }
        LBAR();
        {
            f32x4 X[4];
#pragma unroll
            for (int i = 0; i < 4; ++i) { f32x4 z = Z[i];
#pragma unroll
                for (int kb = 0; kb < 4; ++kb) if (kb < i) { const f32x4 av = *(const f32x4*)(AAB + (16 * i + c16) * FP + 16 * kb + 4 * g);
#pragma unroll
                    for (int s = 0; s < 4; ++s) z = __builtin_amdgcn_mfma_f32_16x16x4f32(av[s], X[kb][s], z, 0, 0, 0); }
                const f32x4 tv = *(const f32x4*)(TII + (i * 16 + c16) * TP + 4 * g); f32x4 x = {0.f, 0.f, 0.f, 0.f};
#pragma unroll
                for (int s = 0; s < 4; ++s) x = __builtin_amdgcn_mfma_f32_16x16x4f32(tv[s], z[s], x, 0, 0, 0);
                X[i] = x; }
#pragma unroll
            for (int i = 0; i < 4; ++i) *(v2u*)(XT + (16 * wave + c16) * PITCH + 16 * i + 4 * g) = pack4(X[i]);
        }
        LBAR();
        {
            const int q = wave >> 1, hh = wave & 1;
            bf16* MCg = (bf16*)(a.ws + WS_MC) + (size_t)unit * 4096; float* NCg = (float*)(a.ws + WS_NC) + (size_t)unit * 4096;
            bf16* PPg = (bf16*)(a.ws + WS_PP) + (size_t)unit * 4096; bf16* Y0g = (bf16*)(a.ws + WS_Y0) + (size_t)unit * 4096;
#pragma unroll
            for (int t2 = 0; t2 < 2; ++t2) { const int ti = 2 * hh + t2;
#pragma unroll
                for (int tj = 0; tj < 4; ++tj) { f32x4 acc = {0.f, 0.f, 0.f, 0.f}; const int cc = 16 * tj + c16, rr = 16 * ti + 4 * g;
                    if (q == 0) { acc = mma2s(XT + (16 * ti + c16) * PITCH, 0, BBT + cc * PITCH, SWK(cc), g, acc); *(v2u*)(MCg + cc * 64 + (ti >> 1) * 32 + g * 8 + (ti & 1) * 4) = pack4(acc); }
                    else if (q == 1) { const int ar = 16 * ti + c16; acc = mma2s(BBT + ar * PITCH, SWK(ar), XT + (64 + cc) * PITCH, 0, g, acc); acc = mma2s(KBT + ar * PITCH, SWK(ar), VT + cc * PITCH, SWK(cc), g, acc);
                        *(f32x4*)(NCg + cc * 64 + rr) = acc; }
                    else if (q == 2) { acc = mma2(XT + (16 * ti + c16) * PITCH + 8 * g, ARB + cc * PITCH + 8 * g, acc);
                        const v2u rv = *(const v2u*)(RT + cc * PITCH + rr); acc[0] += bf2f(rv.x & 0xffffu); acc[1] += bf2f(rv.x >> 16); acc[2] += bf2f(rv.y & 0xffffu); acc[3] += bf2f(rv.y >> 16);
                        *(v2u*)(PPg + cc * 64 + rr) = pack4(acc); }
                    else { acc = mma2(XT + (64 + 16 * ti + c16) * PITCH + 8 * g, ARB + cc * PITCH + 8 * g, acc); { const int ar = 16 * ti + c16; acc = mma2s(VT + ar * PITCH, SWK(ar), ARK + cc * PITCH, 0, g, acc); }
                        *(v2u*)(Y0g + cc * 64 + rr) = pack4(acc); }
                } }
            if (tid < 64) ((float*)(a.ws + WS_DEC))[unit * 64 + tid] = BC[64 + tid];
        }
        LBAR();
    }
}

#define LAS3 __attribute__((address_space(3)))
constexpr int R2_SLOT = 12544, R2_NS = 10, R2_FLAGS = R2_SLOT * R2_NS;
__device__ __forceinline__ void r2_scan(CArgs& a, int chain, unsigned char* L, int tid) {
    asm volatile("" : "+v"(tid));
    const int lane = tid & 63, wave = __builtin_amdgcn_readfirstlane(tid >> 6);
    const int h = chain >> 2, e0 = 16 * (chain & 3), g = lane >> 4, c16 = lane & 15;
    volatile LAS3 unsigned* flg = (volatile LAS3 unsigned*)(LAS3 unsigned char*)(L + R2_FLAGS);
    if (tid < 32) flg[tid] = 0u;
    if (tid >= 64 && tid < 64 + R2_NS) *(volatile LAS3 unsigned*)(LAS3 unsigned char*)(L + (tid - 64) * R2_SLOT + 12288 + 252) = 0xffffffffu;
    __syncthreads();
    const bf16* MC = (const bf16*)(a.ws + WS_MC); const float* NC = (const float*)(a.ws + WS_NC); const float* DEC = (const float*)(a.ws + WS_DEC);
    if (wave != 0) {
        int mco[8], nco[4];
#pragma unroll
        for (int q = 0; q < 8; ++q) { const int pos = 64 * q + lane, row = pos >> 3, kc = (pos & 7) ^ (row & 7); mco[q] = row * 64 + kc * 8; }
#pragma unroll
        for (int q = 0; q < 4; ++q) { const int pos = 64 * q + lane, e = pos >> 4, dc = (pos & 15) ^ e; nco[q] = (e0 + e) * 64 + dc * 4; }
#pragma unroll 1
        for (int c = wave - 1; c < 128; c += 7) {
            while ((int)flg[16] < c - (R2_NS - 1)) __builtin_amdgcn_s_sleep(12);
            LAS3 unsigned char* slot = (LAS3 unsigned char*)(L + (c % R2_NS) * R2_SLOT);
            const size_t unit = (size_t)c * 8 + h;
#pragma unroll
            for (int q = 0; q < 8; ++q) __builtin_amdgcn_global_load_lds((const unsigned*)(MC + unit * 4096 + mco[q]), (LAS3 unsigned*)(slot + q * 1024), 16, 0, 0);
#pragma unroll
            for (int q = 0; q < 4; ++q) __builtin_amdgcn_global_load_lds((const unsigned*)(NC + unit * 4096 + nco[q]), (LAS3 unsigned*)(slot + 8192 + q * 1024), 16, 0, 0);
            __builtin_amdgcn_global_load_lds((const unsigned*)(DEC + unit * 64 + lane), (LAS3 unsigned*)(slot + 12288), 4, 0, 0);
        }
        asm volatile("s_waitcnt vmcnt(0)" ::: "memory");
    } else {
        bf16* S0 = (bf16*)(a.ws + WS_S0) + (size_t)h * 4096 + (e0 + c16) * 64 + 4 * g;
        f32x4 S[4];
#pragma unroll
        for (int m = 0; m < 4; ++m) S[m] = (f32x4){0.f, 0.f, 0.f, 0.f};
        int avail = 0;
        const LAS3 unsigned char* Lb = (const LAS3 unsigned char*)L;
        const int offA0 = (c16 * 8 + (g ^ (c16 & 7))) * 16, offA1 = (c16 * 8 + ((4 + g) ^ (c16 & 7))) * 16;
        int offN[4];
#pragma unroll
        for (int mt = 0; mt < 4; ++mt) offN[mt] = 8192 + (c16 * 16 + ((4 * mt + g) ^ c16)) * 16;
        const int offD = 12288 + 16 * g;
#define R2_MARKS(s_) (*(volatile LAS3 unsigned*)(LAS3 unsigned char*)(L + (s_) * R2_SLOT + 12288 + 252))
#define R2_WAITS(c_, s_) do { while (avail <= (c_)) { const unsigned f0_ = R2_MARKS(s_), f1_ = R2_MARKS(((s_) + 1) % R2_NS), f2_ = R2_MARKS(((s_) + 2) % R2_NS); \
            if (f0_ != 0xffffffffu) { avail = (c_) + 1; if (f1_ != 0xffffffffu) { avail = (c_) + 2; if (f2_ != 0xffffffffu) avail = (c_) + 3; } } \
            else __builtin_amdgcn_s_sleep(0); } asm volatile("" ::: "memory"); } while (0)
        v4u A[2][4][2]; f32x4 Nn[2][4], Dd[2][4];
#define R2_READS(s_, p_) do { _Pragma("unroll") for (int mt = 0; mt < 4; ++mt) { \
                A[p_][mt][0] = *(const LAS3 v4u*)(Lb + (s_) * R2_SLOT + mt * 2048 + offA0); A[p_][mt][1] = *(const LAS3 v4u*)(Lb + (s_) * R2_SLOT + mt * 2048 + offA1); \
                Nn[p_][mt] = *(const LAS3 f32x4*)(Lb + (s_) * R2_SLOT + offN[mt]); Dd[p_][mt] = *(const LAS3 f32x4*)(Lb + (s_) * R2_SLOT + mt * 64 + offD); } } while (0)
        R2_WAITS(0, 0); R2_READS(0, 0);
        asm volatile("s_waitcnt lgkmcnt(0)" ::: "memory");
#pragma unroll 1
        for (int c0 = 0; c0 < 128; c0 += R2_NS) {
#pragma unroll
            for (int k = 0; k < R2_NS; ++k) { const int c = c0 + k;
                if (c < 128) {
                    R2_MARKS(k) = 0xffffffffu; flg[16] = (unsigned)(c + 1);
                    if (c + 1 < 128) { R2_WAITS(c + 1, (k + 1) % R2_NS); R2_READS((k + 1) % R2_NS, (k + 1) & 1); }
                    bf16* sp = S0 + (size_t)c * (8 * 4096); v2u sb[4];
#pragma unroll
                    for (int m = 0; m < 4; ++m) { sb[m] = pack4(S[m]); *(v2u*)(sp + 16 * m) = sb[m]; }
                    const v4u b0 = {sb[0].x, sb[0].y, sb[1].x, sb[1].y}, b1 = {sb[2].x, sb[2].y, sb[3].x, sb[3].y};
                    const bf16x8 B0 = __builtin_bit_cast(bf16x8, b0), B1 = __builtin_bit_cast(bf16x8, b1);
                    f32x4 acc[4];
#pragma unroll
                    for (int mt = 0; mt < 4; ++mt) acc[mt] = __builtin_amdgcn_mfma_f32_16x16x32_bf16(__builtin_bit_cast(bf16x8, A[k & 1][mt][0]), B0, Nn[k & 1][mt] + S[mt] * Dd[k & 1][mt], 0, 0, 0);
#pragma unroll
                    for (int mt = 0; mt < 4; ++mt) S[mt] = __builtin_amdgcn_mfma_f32_16x16x32_bf16(__builtin_bit_cast(bf16x8, A[k & 1][mt][1]), B1, acc[mt], 0, 0, 0);
                    asm volatile("s_waitcnt lgkmcnt(0)" ::: "memory");
                } }
        }
#undef R2_WAITS
#undef R2_MARKS
#undef R2_READS
#define R2_READ 0
#undef R2_READ
    }
    __syncthreads();
}

__device__ __forceinline__ void r3_phase(CArgs& a, size_t uo, int l, int hb, int gw, int NGW, int lane) {
    asm volatile("" : "+v"(lane));
    const int g = lane >> 4, c16 = lane & 15;
    const bf16* U = (const bf16*)(a.ws + WS_U + uo); const bf16* PP = (const bf16*)(a.ws + WS_PP); const bf16* S0 = (const bf16*)(a.ws + WS_S0); const bf16* Y0 = (const bf16*)(a.ws + WS_Y0);
    const float* BON = (const float*)(a.ws + WS_BON2); bf16* MG = (bf16*)(a.ws + WS_XN) + (size_t)hb * MH * D;
    const float* mu_v = a.in[6] + l * 1664 + 1024; const float* lnw = a.in[14] + l * 512; const float* lnb = a.in[15] + l * 512;
    const int erow = 16 * (c16 >> 2) + (c16 & 3);
#pragma unroll 1
    for (int task = gw; task < NUNIT * 4; task += NGW) {
        const int unit = task >> 2, mt = task & 3, ch = unit >> 3, h = unit & 7; const size_t ub = (size_t)unit * 4096;
        const int lr = 64 * ch + 16 * mt + c16; const bf16* urow = U + (size_t)lr * NPAD + 64 * h + 16 * g;
        float vc[16], vp[16], rgf[16];
        unpack8(*(const v4u*)(urow + C_V), vc); unpack8(*(const v4u*)(urow + C_V + 8), vc + 8); unpack8(*(const v4u*)(urow + C_RG), rgf); unpack8(*(const v4u*)(urow + C_RG + 8), rgf + 8);
        if (lr > 0) { unpack8(*(const v4u*)(urow + C_V - NPAD), vp); unpack8(*(const v4u*)(urow + C_V + 8 - NPAD), vp + 8); }
        else {
#pragma unroll
            for (int i = 0; i < 16; ++i) vp[i] = 0.f; }
        const float bon = BON[lr * 8 + h];
        const bf16* pr = PP + ub + (16 * mt + c16) * 64 + 8 * g;
        const bf16x8 B0 = *(const bf16x8*)pr, B1 = *(const bf16x8*)(pr + 32);
        f32x4 Y[4]; bf16x8 SA[4][2];
#pragma unroll
        for (int et = 0; et < 4; ++et) { const bf16* sr = S0 + ub + (erow + 4 * et) * 64 + 8 * g; SA[et][0] = *(const bf16x8*)sr; SA[et][1] = *(const bf16x8*)(sr + 32); }
        const bf16* y0p = Y0 + ub + (16 * mt + c16) * 64 + 16 * g; const v4u y0a = *(const v4u*)y0p, y0b = *(const v4u*)(y0p + 8);
        asm volatile("" ::: "memory");
        { float yf[16]; unpack8(y0a, yf); unpack8(y0b, yf + 8);
#pragma unroll
          for (int et = 0; et < 4; ++et) Y[et] = (f32x4){yf[4 * et], yf[4 * et + 1], yf[4 * et + 2], yf[4 * et + 3]}; }
#pragma unroll
        for (int et = 0; et < 4; ++et) { f32x4 acc = __builtin_amdgcn_mfma_f32_16x16x32_bf16(SA[et][0], B0, Y[et], 0, 0, 0);
            Y[et] = __builtin_amdgcn_mfma_f32_16x16x32_bf16(SA[et][1], B1, acc, 0, 0, 0); }
        const f32x4 sv = (Y[0] + Y[1]) + (Y[2] + Y[3]); float sm = (sv.x + sv.y) + (sv.z + sv.w); sm += __shfl_xor(sm, 16); sm += __shfl_xor(sm, 32);
        const float mean = sm * (1.f / 64.f); float q = 0.f;
#pragma unroll
        for (int et = 0; et < 4; ++et) { const f32x4 dd = Y[et] - mean; q += (dd.x * dd.x + dd.y * dd.y) + (dd.z * dd.z + dd.w * dd.w); }
        q += __shfl_xor(q, 16); q += __shfl_xor(q, 32);
        const float rstd = rsqrtf(q * (1.f / 64.f) + 64e-5f);
        const int cc = 64 * h + 16 * g; float o[16];
#pragma unroll
        for (int et = 0; et < 4; ++et) {
            const f32x4 w4 = *(const f32x4*)(lnw + cc + 4 * et), b4 = *(const f32x4*)(lnb + cc + 4 * et), m4 = *(const f32x4*)(mu_v + cc + 4 * et);
#pragma unroll
            for (int j = 0; j < 4; ++j) { const int i = 4 * et + j; const float vv = vc[i] + (vp[i] - vc[i]) * m4[j]; const float yn = (Y[et][j] - mean) * rstd * w4[j] + b4[j];
                o[i] = (yn + bon * vv) * rgf[i] * sigm(rgf[i]); } }
        bf16* op = MG + (size_t)lr * D + 512 + cc; *(v4u*)op = pack8(o); *(v4u*)(op + 8) = pack8(o + 8);
    }
}

constexpr int OFF_GQI = 17408, OFF_GKI = 26624, OFF_GKST = 35840, OFF_GVT = 45056, OFF_GSC = 63488, OFF_GTOT = 72704, OFF_GBC = 74752;
constexpr size_t WS_QI = 163 * MiB, WS_OI = 167 * MiB, WS_DS = 175 * MiB, WS_GDEC = 183 * MiB, WS_SP = 184 * MiB;
constexpr int NGUNIT = 512;

__device__ __forceinline__ void g1_phase(CArgs& a, size_t uo, int l, unsigned char* L, int tid0, int ufirst, int ustride) {
    asm volatile("" : "+v"(tid0));
    const int wave = __builtin_amdgcn_readfirstlane(tid0 >> 6);
    const bf16* U = (const bf16*)(a.ws + WS_U + uo);
    float* XW = (float*)L; bf16* QI = (bf16*)(L + OFF_GQI); bf16* KI = (bf16*)(L + OFF_GKI); bf16* KST = (bf16*)(L + OFF_GKST); bf16* VT = (bf16*)(L + OFF_GVT); bf16* SC = (bf16*)(L + OFF_GSC);
    float* TOT = (float*)(L + OFF_GTOT); float* BC = (float*)(L + OFF_GBC);
    float* GW = (float*)(L + OFF_GBC + 256);
    int hl = -1;
    v4u Gl0, Gl1, Gq, Gk, Gv0, Gv1;
#define G1_ISSUE(u_) do { const int lr_ = 64 * ((u_) >> 2) + (tid >> 3), h_ = (u_) & 3, dg_ = tid & 7; const bf16* ur_ = U + (size_t)lr_ * NPAD; \
        Gl0 = *(const v4u*)(ur_ + C_GLR); Gl1 = *(const v4u*)(ur_ + C_GLR + 8); Gq = *(const v4u*)(ur_ + C_GQ + 64 * h_ + 8 * dg_); Gk = *(const v4u*)(ur_ + C_GK + 64 * h_ + 8 * dg_); \
        Gv0 = *(const v4u*)(ur_ + C_GV + 128 * h_ + 16 * dg_); Gv1 = *(const v4u*)(ur_ + C_GV + 128 * h_ + 16 * dg_ + 8); } while (0)
#pragma unroll 1
    for (int unit = ufirst; unit < NGUNIT; unit += ustride) {
        int tid = tid0; asm volatile("" : "+v"(tid));
        const int lane = tid & 63, g = lane >> 4, c16 = lane & 15;
        const int ch = unit >> 2, h = unit & 3;
        if (h != hl) { hl = h; LBAR();
            for (int i = tid; i < 16 * 64; i += NTHR) GW[i] = a.in[3][l * 16 * 256 + (i >> 6) * 256 + 64 * h + (i & 63)];
            if (tid < 64) GW[1024 + tid] = a.in[4][l * 256 + 64 * h + tid];
            LBAR(); }
        const int t = tid >> 3, dg = tid & 7, d0 = 8 * dg, lr = 64 * ch + t, hc = 64 * h + d0;
        if (unit == ufirst) G1_ISSUE(unit);
        float q[8], k[8];
        {
            float glr[16]; unpack8(Gl0, glr); unpack8(Gl1, glr + 8);
            float x[8]; const float* gb = GW + 1024 + d0; const float* gu = GW + d0;
#pragma unroll
            for (int i = 0; i < 8; ++i) x[i] = gb[i];
#pragma unroll
            for (int r = 0; r < 16; ++r) { const f32x4 u0 = *(const f32x4*)(gu + r * 64), u1 = *(const f32x4*)(gu + r * 64 + 4);
                x[0] += glr[r] * u0.x; x[1] += glr[r] * u0.y; x[2] += glr[r] * u0.z; x[3] += glr[r] * u0.w; x[4] += glr[r] * u1.x; x[5] += glr[r] * u1.y; x[6] += glr[r] * u1.z; x[7] += glr[r] * u1.w; }
#pragma unroll
            for (int i = 0; i < 8; ++i) XW[t * FP + d0 + i] = (fminf(x[i], 0.f) - __logf(1.f + __expf(-fabsf(x[i])))) * (1.f / 16.f);
            unpack8(Gq, q); unpack8(Gk, k);
            float vv[16]; const int e0 = 16 * dg; unpack8(Gv0, vv); unpack8(Gv1, vv + 8);
            asm volatile("" ::: "memory");
            if (unit + ustride < NGUNIT) G1_ISSUE(unit + ustride);
#pragma unroll
            for (int i = 0; i < 16; ++i) VT[SWC(e0 + i, t)] = (bf16)f2bf(vv[i]);
        }
        LBAR();
        {
            const int d = tid & 63, tb = tid >> 6; float p[8]; float run = 0.f;
#pragma unroll
            for (int i = 0; i < 8; ++i) { run += XW[(8 * tb + i) * FP + d]; p[i] = run; }
            TOT[tb * 64 + d] = run;
            LBAR();
            float off = 0.f;
#pragma unroll
            for (int j = 0; j < 8; ++j) off += (j < tb) ? TOT[j * 64 + d] : 0.f;
#pragma unroll
            for (int i = 0; i < 8; ++i) XW[(8 * tb + i) * FP + d] = off + p[i];
            if (tb == 7) BC[d] = off + run;
        }
        LBAR();
        {
            float qi[8], ki[8];
#pragma unroll
            for (int i = 0; i < 8; ++i) { const float b = XW[t * FP + d0 + i], bc = BC[d0 + i];
                qi[i] = q[i] * 0.125f * __expf(b); ki[i] = k[i] * __expf(-b); KST[SWC(d0 + i, t)] = (bf16)f2bf(k[i] * __expf(bc - b)); }
            const v4u qp = pack8(qi);
            *(v4u*)(QI + t * PITCH + d0) = qp; *(v4u*)(KI + t * PITCH + d0) = pack8(ki);
            *(v4u*)((bf16*)(a.ws + WS_QI) + (size_t)unit * 4096 + t * 64 + d0) = qp;
        }
        LBAR();
        {
            const int tt = wave >> 1; const int tcol = 16 * tt + c16;
#pragma unroll
            for (int j2 = 0; j2 < 2; ++j2) { const int jt = 2 * (wave & 1) + j2; f32x4 acc = {0.f, 0.f, 0.f, 0.f};
                if (jt <= tt) { acc = mma2(KI + (16 * jt + c16) * PITCH + 8 * g, QI + tcol * PITCH + 8 * g, acc);
#pragma unroll
                    for (int j = 0; j < 4; ++j) if (16 * jt + 4 * g + j > tcol) acc[j] = 0.f; }
                *(v2u*)(SC + tcol * PITCH + 16 * jt + 4 * g) = pack4(acc); }
            bf16* DSg = (bf16*)(a.ws + WS_DS) + (size_t)unit * 8192;
#pragma unroll
            for (int i = 0; i < 4; ++i) { const int tile = wave * 4 + i, dt = tile & 3, et = tile >> 2; f32x4 acc = {0.f, 0.f, 0.f, 0.f};
                { const int ar = 16 * dt + c16, br = 16 * et + c16; acc = mma2s(KST + ar * PITCH, SWK(ar), VT + br * PITCH, SWK(br), g, acc); }
                *(v2u*)(DSg + (16 * et + c16) * 64 + 16 * dt + 4 * g) = pack4(acc); }
            if (tid < 64) ((float*)(a.ws + WS_GDEC))[unit * 64 + tid] = __expf(BC[tid]);
        }
        LBAR();
        {
            bf16* OIg = (bf16*)(a.ws + WS_OI) + (size_t)unit * 8192;
#pragma unroll
            for (int i = 0; i < 4; ++i) { const int tile = wave * 4 + i, tt = tile & 3, et = tile >> 2; f32x4 acc = {0.f, 0.f, 0.f, 0.f};
                { const int ar = 16 * et + c16; acc = mma2s(VT + ar * PITCH, SWK(ar), SC + (16 * tt + c16) * PITCH, 0, g, acc); }
                *(v2u*)(OIg + (16 * tt + c16) * 128 + 16 * et + 4 * g) = pack4(acc); }
        }
        LBAR();
    }
}

__device__ __forceinline__ void g2_scan(CArgs& a, int wg, unsigned char* L, int tid) {
    asm volatile("" : "+v"(tid));
    const int h = wg >> 2, e = 32 * (wg & 3) + (tid >> 4), dq = tid & 15;
    const bf16* DS = (const bf16*)(a.ws + WS_DS) + (size_t)h * 8192 + e * 64 + 4 * dq; const float* GD = (const float*)(a.ws + WS_GDEC) + (size_t)(((tid >> 4) & 15) * 4 + h) * 64 + 4 * dq;
    bf16* SP = (bf16*)(a.ws + WS_SP) + (size_t)h * 8192 + e * 64 + 4 * dq;
    float* DCL = (float*)L;
    v2u dsb[2][16]; f32x4 dcr;
    f32x4 S = {0.f, 0.f, 0.f, 0.f};
#pragma unroll
    for (int i = 0; i < 16; ++i) dsb[0][i] = *(const v2u*)(DS + (size_t)i * (4 * 8192));
    dcr = *(const f32x4*)GD;
    if (tid < 256) *(f32x4*)(DCL + (tid >> 4) * 64 + 4 * dq) = dcr;
#pragma unroll 1
    for (int b2 = 0; b2 < 8; b2 += 2) {
#pragma unroll
        for (int bb = 0; bb < 2; ++bb) { const int b = b2 + bb;
            if (b + 1 < 8) {
#pragma unroll
                for (int i = 0; i < 16; ++i) dsb[(bb + 1) & 1][i] = *(const v2u*)(DS + (size_t)(16 * (b + 1) + i) * (4 * 8192));
                dcr = *(const f32x4*)(GD + (size_t)(16 * (b + 1)) * (4 * 64)); }
            LBAR();
            const float* dcl = DCL + bb * 1024 + 4 * dq;
#pragma unroll
            for (int i = 0; i < 16; ++i) { const f32x4 dc = *(const f32x4*)(dcl + i * 64); const v2u w = dsb[bb][i];
                *(v2u*)(SP + (size_t)(16 * b + i) * (4 * 8192)) = pack4(S);
                const f32x4 dv = {bf2f(w.x & 0xffffu), bf2f(w.x >> 16), bf2f(w.y & 0xffffu), bf2f(w.y >> 16)};
                S = S * dc + dv; }
            if (b + 1 < 8 && tid < 256) *(f32x4*)(DCL + ((bb + 1) & 1) * 1024 + (tid >> 4) * 64 + 4 * dq) = dcr;
        }
    }
    LBAR();
}

__device__ __forceinline__ void g3_phase(CArgs& a, size_t uo, int l, int hb, int gw, int NGW, int lane) {
    asm volatile("" : "+v"(lane));
    const int g = lane >> 4, c16 = lane & 15;
    const bf16* U = (const bf16*)(a.ws + WS_U + uo); const bf16* QI = (const bf16*)(a.ws + WS_QI); const bf16* SP = (const bf16*)(a.ws + WS_SP); const bf16* OI = (const bf16*)(a.ws + WS_OI);
    bf16* MG = (bf16*)(a.ws + WS_XN) + (size_t)hb * MH * D; const float* gnw = a.in[5] + l * 128;
    const int erow = 32 * (c16 >> 2) + (c16 & 3);
#pragma unroll 1
    for (int task = gw; task < NGUNIT * 4; task += NGW) {
        const int unit = task >> 2, mt = task & 3, ch = unit >> 2, h = unit & 3;
        const int lr = 64 * ch + 16 * mt + c16; const bf16* urow = U + (size_t)lr * NPAD + C_GG + 128 * h + 32 * g;
        const v4u gg0 = *(const v4u*)urow, gg1 = *(const v4u*)(urow + 8), gg2 = *(const v4u*)(urow + 16), gg3 = *(const v4u*)(urow + 24);
        const bf16* qr = QI + (size_t)unit * 4096 + (16 * mt + c16) * 64 + 8 * g;
        const bf16x8 B0 = *(const bf16x8*)qr, B1 = *(const bf16x8*)(qr + 32);
        f32x4 O[8]; float ss = 0.f; bf16x8 SA[8][2];
#pragma unroll
        for (int et = 0; et < 8; ++et) { const bf16* sr = SP + (size_t)unit * 8192 + (erow + 4 * et) * 64 + 8 * g; SA[et][0] = *(const bf16x8*)sr; SA[et][1] = *(const bf16x8*)(sr + 32); }
        const bf16* oip = OI + (size_t)unit * 8192 + (16 * mt + c16) * 128 + 32 * g; const v4u oi0 = *(const v4u*)oip, oi1 = *(const v4u*)(oip + 8), oi2 = *(const v4u*)(oip + 16), oi3 = *(const v4u*)(oip + 24);
        asm volatile("" ::: "memory");
        { float of[32]; unpack8(oi0, of); unpack8(oi1, of + 8); unpack8(oi2, of + 16); unpack8(oi3, of + 24);
#pragma unroll
          for (int et = 0; et < 8; ++et) O[et] = (f32x4){of[4 * et], of[4 * et + 1], of[4 * et + 2], of[4 * et + 3]}; }
#pragma unroll
        for (int et = 0; et < 8; ++et) { f32x4 acc = __builtin_amdgcn_mfma_f32_16x16x32_bf16(SA[et][0], B0, O[et], 0, 0, 0);
            acc = __builtin_amdgcn_mfma_f32_16x16x32_bf16(SA[et][1], B1, acc, 0, 0, 0);
            O[et] = acc; ss += (acc.x * acc.x + acc.y * acc.y) + (acc.z * acc.z + acc.w * acc.w); }
        ss += __shfl_xor(ss, 16); ss += __shfl_xor(ss, 32);
        const float rstd = rsqrtf(ss * (1.f / 128.f) + 1e-6f);
        float gf[32], o[32]; unpack8(gg0, gf); unpack8(gg1, gf + 8); unpack8(gg2, gf + 16); unpack8(gg3, gf + 24);
#pragma unroll
        for (int et = 0; et < 8; ++et) { const f32x4 w4 = *(const f32x4*)(gnw + 32 * g + 4 * et);
#pragma unroll
            for (int j = 0; j < 4; ++j) { const int i = 4 * et + j; o[i] = O[et][j] * rstd * w4[j] * gf[i] * sigm(gf[i]); } }
        bf16* op = MG + (size_t)lr * D + 128 * h + 32 * g;
        *(v4u*)op = pack8(o); *(v4u*)(op + 8) = pack8(o + 8); *(v4u*)(op + 16) = pack8(o + 16); *(v4u*)(op + 24) = pack8(o + 24);
    }
}

#define LAS __attribute__((address_space(3)))
#define XB_TMO      128
#define XB_XCNT(j)  (256  + 64 * (j))
#define XB_XSUB(j)  (1280 + 64 * (j))
#define XB_XGEN(j)  (2304 + 64 * (j))
#define XB_TOP      3328
#define XB_TOPGEN   3392
#define XCD_BAR_WORDS 3456
#define XB_SPIN_CAP (1u << 18)

__device__ __forceinline__ unsigned xb_ld(unsigned* p)              { return __hip_atomic_load(p, __ATOMIC_RELAXED, __HIP_MEMORY_SCOPE_AGENT); }
__device__ __forceinline__ unsigned xb_add(unsigned* p, unsigned v) { return __hip_atomic_fetch_add(p, v, __ATOMIC_RELAXED, __HIP_MEMORY_SCOPE_AGENT); }
__device__ __forceinline__ unsigned xb_xcc_id() { return (unsigned)__builtin_amdgcn_s_getreg((3 << 11) | 20) & 0xFu; }
#define XB_SPIN(cond, bar) do { unsigned _sp = 0; while (cond) { __builtin_amdgcn_s_sleep(1); \
    if ((++_sp & 255u) == 0u) { if (xb_ld(&(bar)[XB_TMO])) break; if (_sp > XB_SPIN_CAP) { atomicAdd(&(bar)[XB_TMO], 1u); break; } } } } while (0)

struct XcdBarrier {
    unsigned* bar; unsigned x;
    volatile LAS unsigned* st;
};

__device__ __forceinline__ XcdBarrier xcd_barrier_post(unsigned* bar, volatile LAS unsigned* st) {
    XcdBarrier b; b.bar = bar; b.x = xb_xcc_id(); b.st = st;
    if (threadIdx.x == 0) (void)xb_add(&bar[XB_XCNT(b.x)], 1u);
    return b;
}
__device__ __forceinline__ void xcd_barrier_complete(unsigned* bar, unsigned x, unsigned& nloc, unsigned& nx) {
    const unsigned G = gridDim.x * gridDim.y * gridDim.z;
    unsigned sum, cnt, mine, sp = 0u;
    for (;;) {
        sum = 0u; cnt = 0u; mine = 0u;
#pragma unroll
        for (unsigned j = 0; j < 16; ++j) { const unsigned c = xb_ld(&bar[XB_XCNT(j)]); sum += c; cnt += (c > 0u) ? 1u : 0u; mine = (j == x) ? c : mine; }
        if (sum == G) break;
        __builtin_amdgcn_s_sleep(1);
        if ((++sp & 255u) == 0u) { if (xb_ld(&bar[XB_TMO])) break; if (sp > XB_SPIN_CAP) { atomicAdd(&bar[XB_TMO], 1u); break; } }
    }
    nloc = mine > 0u ? mine : 1u; nx = cnt > 0u ? cnt : 1u;
}

__device__ __forceinline__ void xcd_barrier(const XcdBarrier& b) {
    asm volatile("s_waitcnt vmcnt(0)" ::: "memory");
    __syncthreads();
    if (threadIdx.x == 0) {
        unsigned* bar = b.bar;
        __builtin_amdgcn_s_waitcnt(0);
        unsigned nloc = b.st[0], nx = b.st[1];
        if (nloc == 0u) { xcd_barrier_complete(bar, b.x, nloc, nx); b.st[0] = nloc; b.st[1] = nx; }
        const unsigned old = xb_add(&bar[XB_XSUB(b.x)], 1u);
        const unsigned gen = old / nloc;
        if (old + 1u == (gen + 1u) * nloc) {
            __builtin_amdgcn_fence(__ATOMIC_RELEASE, "agent");
            asm volatile("s_waitcnt vmcnt(0)" ::: "memory");
            const unsigned og = xb_add(&bar[XB_TOP], 1u);
            const unsigned tg = og / nx;
            if (og + 1u == (tg + 1u) * nx) xb_add(&bar[XB_TOPGEN], 1u);
            else XB_SPIN(xb_ld(&bar[XB_TOPGEN]) == tg, bar);
            __builtin_amdgcn_fence(__ATOMIC_ACQUIRE, "agent");
            xb_add(&bar[XB_XGEN(b.x)], 1u);
            asm volatile("s_waitcnt vmcnt(0)" ::: "memory");
        } else {
            XB_SPIN(xb_ld(&bar[XB_XGEN(b.x)]) == gen, bar);
            __builtin_amdgcn_fence(__ATOMIC_ACQUIRE, "agent");
            asm volatile("s_waitcnt vmcnt(0)" ::: "memory");
        }
    }
    __syncthreads();
}


__global__ void __launch_bounds__(NTHR, 2) hymba_fwd(Args a_kernarg) {
    extern __shared__ __attribute__((aligned(16))) unsigned char lds[];
    cg::grid_group grid = cg::this_grid();
    const int tid = threadIdx.x, lane = tid & 63, wave = __builtin_amdgcn_readfirstlane(tid >> 6);
    const int G = gridDim.x, gw = blockIdx.x * NWAVES + wave, NGW = G * NWAVES;
    volatile LAS unsigned* xst = (volatile LAS unsigned*)(LAS unsigned char*)(lds + LDS_BYTES - 64);
    if (tid < 2) xst[tid] = 0u;
    __syncthreads();
    const XcdBarrier xbar = xcd_barrier_post((unsigned*)AA.ws, xst);
    {
        CArgs& a = AA; bf16* XN = (bf16*)(a.ws + WS_XN);
        float* scr = (float*)lds;
        constexpr int T_IN = (D / 64) * (NPAD / 64), T_OUT = (D / 64) * (D / 64);
        for (int l = 0; l < 2; ++l) {
            transpose_tiles(a.in[2] + (size_t)l * D * NIN, D, NIN, NPAD, (bf16*)(a.ws + WS_WIN + l * WIN_BYTES), scr, (int)blockIdx.x, G, T_IN, tid);
            transpose_tiles(a.in[16] + (size_t)l * D * D, D, D, D, (bf16*)(a.ws + WS_WOUT + l * WOUT_BYTES), scr, (int)blockIdx.x, G, T_OUT, tid);
        }
        for (int m = 2 * gw; m < M; m += 2 * NGW) rms_row2(a.in[0] + (size_t)m * D, a.in[0] + (size_t)(m + 1) * D, a.in[1], XN + (size_t)m * D, XN + (size_t)(m + 1) * D, lane);
        {
            bf16* UPT = (bf16*)(a.ws + WS_UPT);
            for (int e = blockIdx.x * NTHR + tid; e < 2 * 2 * 512 * 64; e += G * NTHR) { const int r = e & 63, c = (e >> 6) & 511, q = (e >> 15) & 1, ll = e >> 16;
                UPT[e] = (bf16)f2bf((q ? a.in[10] : a.in[8])[(size_t)ll * 64 * 512 + r * 512 + c]); }
        }
    }
    if (AA.ws == nullptr) grid.sync();
    xcd_barrier(xbar);
    for (int l = 0; l < 2; ++l) {
        for (int hb = 0; hb < 2; ++hb) {
            {
                CArgs& a = AA; bf16* XN = (bf16*)(a.ws + WS_XN); bf16* U = (bf16*)(a.ws + WS_U + (size_t)hb * U_STRIDE);
                pg8::Gemm g{XN + (size_t)hb * MH * D, (const bf16*)(a.ws + WS_WIN + l * WIN_BYTES), MH, NPAD, D}; pg8::RangeOrder S;
                if (hb == 0) S.init(MH, NPAD, G, (int)blockIdx.x, 0, 480); else S.init(MH, NPAD, G, (int)blockIdx.x, EARLY_TILES, 480 - EARLY_TILES);
                pg8::EpiBf16<0> E{U, NPAD, nullptr, 0, 0, 1.f};
                pg8::gemm_phase<pg8::EpiBf16<0>, pg8::RangeOrder, true, true>((PG8_LAS unsigned char*)lds, g, S, E);
            }
            xcd_barrier(xbar);
            const size_t uo = (size_t)hb * U_STRIDE;
            r1_phase(AA, uo, l, lds, tid);
            g1_phase(AA, uo, l, lds, tid, (int)blockIdx.x, G);
            xcd_barrier(xbar);
            if (blockIdx.x < 32) r2_scan(AA, blockIdx.x, lds, tid);
            else { if (blockIdx.x < 48) g2_scan(AA, blockIdx.x - 32, lds, tid);
                if (hb == 0) {
                    CArgs& a = AA; bf16* XN = (bf16*)(a.ws + WS_XN); bf16* U1 = (bf16*)(a.ws + WS_U1);
                    pg8::Gemm g{XN + (size_t)MH * D, (const bf16*)(a.ws + WS_WIN + l * WIN_BYTES), MH, NPAD, D}; pg8::RangeOrder S; S.init(MH, NPAD, G, (int)blockIdx.x - 32, 0, EARLY_TILES);
                    pg8::EpiBf16<0> E{U1, NPAD, nullptr, 0, 0, 1.f};
                    pg8::gemm_phase<pg8::EpiBf16<0>, pg8::RangeOrder, true, true>((PG8_LAS unsigned char*)lds, g, S, E); } }
            xcd_barrier(xbar);
            r3_phase(AA, uo, l, hb, gw, NGW, lane);
            g3_phase(AA, uo, l, hb, gw, NGW, lane);
            if (hb == 1) xcd_barrier(xbar);
        }
        {
            CArgs& a = AA; bf16* XN = (bf16*)(a.ws + WS_XN);
            pg8::Gemm g{XN, (const bf16*)(a.ws + WS_WOUT + l * WOUT_BYTES), M, D, D}; pg8::StaticOrder S; S.init(M, D, G, (int)blockIdx.x);
            pg8::EpiRmsRes E{l == 0 ? a.in[0] : a.out, a.out, XN, l == 0 ? a.in[1] + D : a.in[17], (float*)(a.ws + WS_SLOTS) + (size_t)l * M * 4, (unsigned*)(a.ws + 16384) + l * 64 * 64, D, l};
            pg8::gemm_phase<pg8::EpiRmsRes, pg8::StaticOrder, false, true>((PG8_LAS unsigned char*)lds, g, S, E);
        }
        if (l == 0) xcd_barrier(xbar);
    }
}

extern "C" void kernel_launch(void* const* d_in, const int* in_sizes, int n_in, void* d_out, int out_size, void* d_ws, size_t ws_size, hipStream_t stream) {
    static int grid = 0;
    if (grid == 0) {
        if (n_in != 18 || out_size != M * D || ws_size < WS_END) { fprintf(stderr, "kernel_launch: unexpected shapes n_in %d out %d ws %zu\n", n_in, out_size, ws_size); grid = -1; return; }
        int dev = 0, cus = 0, per_cu = 0;
        hipGetDevice(&dev); hipDeviceGetAttribute(&cus, hipDeviceAttributeMultiprocessorCount, dev);
        if (hipFuncSetAttribute((const void*)hymba_fwd, hipFuncAttributeMaxDynamicSharedMemorySize, LDS_BYTES) != hipSuccess) { fprintf(stderr, "kernel_launch: hipFuncSetAttribute failed\n"); grid = -1; return; }
        if (hipOccupancyMaxActiveBlocksPerMultiprocessor(&per_cu, (const void*)hymba_fwd, NTHR, LDS_BYTES) != hipSuccess || per_cu < 1) { fprintf(stderr, "kernel_launch: occupancy query failed (%d)\n", per_cu); grid = -1; return; }
        grid = cus * 1;
        fprintf(stderr, "kernel_launch: cus %d per_cu %d grid %d\n", cus, per_cu, grid);
    }
    if (grid < 0) return;
    if (hipMemsetAsync(d_ws, 0, 65536, stream) != hipSuccess) { fprintf(stderr, "kernel_launch: memset failed\n"); return; }
    Args a{};
    for (int i = 0; i < 18; ++i) a.in[i] = (const float*)d_in[i];
    a.out = (float*)d_out; a.ws = (unsigned char*)d_ws;
    void* args[] = {&a};
    hipError_t e = hipLaunchCooperativeKernel((const void*)hymba_fwd, dim3(grid), dim3(NTHR), args, LDS_BYTES, stream);
    if (e != hipSuccess) fprintf(stderr, "cooperative launch failed: %s (grid %d)\n", hipGetErrorString(e), grid);
}
```

```cpp
#include <hip/hip_runtime.h>
#include <hip/hip_cooperative_groups.h>
#include <cstdio>
#include <cstdint>
namespace cg = cooperative_groups;
namespace pg8 {
#define PG8_LAS __attribute__((address_space(3)))
typedef unsigned short bf16_t;
typedef short bf16x8 __attribute__((ext_vector_type(8)));
typedef float f32x4 __attribute__((ext_vector_type(4)));
typedef unsigned u32x4 __attribute__((ext_vector_type(4)));
constexpr int BM = 256, BK = 64, HALF = 128, HTB = HALF * BK * 2  , STAGE_BYTES = 8 * HTB, NXCD = 8, WGM = 8;

__host__ __device__ __forceinline__ int lds_byte(int r, int c) { const int st = (r >> 4) * 2 + (c >> 5), rr = r & 15, cc = c & 31, ob = rr * 64 + cc * 2; return st * 1024 + (ob ^ (((ob >> 9) & 1) << 5)); }
__host__ __device__ __forceinline__ void stage_rc(int b, int& R, int& C) { const int st = b / 1024, sb = b % 1024, swz = sb ^ (((sb >> 9) & 1) << 5); R = (st >> 1) * 16 + swz / 64; C = (st & 1) * 32 + (swz % 64) / 2; }
__host__ __device__ __forceinline__ int perm32(int rho) { const int n = rho >> 4, i = rho & 15; return 8 * (i >> 2) + 4 * n + (i & 3); }

struct Unit { int pm, pn; };
struct Gemm { const bf16_t* A; const bf16_t* Bt; int M, N, K; };

struct StaticOrder {
    int nM, nN, nwg, G, c;
    __host__ __device__ void init(int M, int N, int G_, int c_) { nM = M / BM; nN = N / BM; nwg = nM * nN; G = G_; c = c_; }
    __host__ __device__ bool next(int i, Unit& u) const {
        const long L = (long)i * G + c; if (L >= nwg) return false;
        int wgid = (int)L; { const int q = nwg / NXCD, r = nwg % NXCD, xcd = wgid % NXCD, off = wgid / NXCD; wgid = (xcd < r ? xcd * (q + 1) : r * (q + 1) + (xcd - r) * q) + off; }
        const int nig = WGM * nN, gid = wgid / nig, fm = gid * WGM, gsz = (nM - fm) < WGM ? (nM - fm) : WGM;
        u.pm = fm + ((wgid % nig) % gsz); u.pn = (wgid % nig) / gsz; return true;
    }
    __device__ __forceinline__ void a_ready(const Unit&) const {}
    __device__ __forceinline__ void done(const Unit&) const {}
};

__device__ __forceinline__ unsigned cvt_pk_bf16(float lo, float hi) { unsigned r; asm volatile("v_cvt_pk_bf16_f32 %0, %1, %2" : "=v"(r) : "v"(lo), "v"(hi)); return r; }
typedef float f32x2 __attribute__((ext_vector_type(2)));
__device__ __forceinline__ f32x2 gelu_pk(f32x2 v) {
    const f32x2 av = __builtin_elementwise_abs(v), d = av * 0.2316418882f + 1.0f;
    f32x2 t; t.x = __builtin_amdgcn_rcpf(d.x); t.y = __builtin_amdgcn_rcpf(d.y);
    f32x2 q = t * 0.5307027145f + (-0.7265760135f); q = q * t + 0.7107068705f; q = q * t + (-0.142248368f); q = q * t + 0.127414796f; q = q * t;
    const f32x2 s = (v * v) * (-0.72134752044f);
    f32x2 e; e.x = __builtin_amdgcn_exp2f(s.x); e.y = __builtin_amdgcn_exp2f(s.y);
    const f32x2 m = v * (q * e), r = v - m;
    f32x2 o; o.x = v.x < 0.f ? m.x : r.x; o.y = v.y < 0.f ? m.y : r.y; return o;
}

template <int ACT  > struct EpiBf16 {
    static constexpr bool PERM = true, AFTER_DRAIN = false; static_assert(ACT == 0 || ACT == 1, "EpiBf16: ACT is 0 (none) or 1 (gelu_pk)");
    bf16_t* O; int ldc; const float* bias; int split_cols; size_t split_stride; float scale0;
    __device__ __forceinline__ void operator()(const f32x4 (&acc)[2][2][4][2], const Unit& u, int wr, int wc, int fr, int fq) const {
        const int row0 = u.pm * BM + wr * 64 + fr; int colt = u.pn * BM; bf16_t* base = O;
        float sc = 1.f; if (split_cols) { const int t = colt / split_cols; base += (size_t)t * split_stride; colt -= t * split_cols; if (t == 0) sc = scale0; }
        const int col0 = colt + wc * 32 + 8 * fq, bcol0 = u.pn * BM + wc * 32 + 8 * fq;
        f32x4 bv[2][2];
#pragma unroll
        for (int bj = 0; bj < 2; ++bj)
#pragma unroll
            for (int n = 0; n < 2; ++n) bv[bj][n] = bias ? *(const f32x4*)(bias + bcol0 + bj * HALF + 4 * n) : (f32x4){0.f, 0.f, 0.f, 0.f};
#pragma unroll
        for (int ai = 0; ai < 2; ++ai)
#pragma unroll
            for (int m = 0; m < 4; ++m) { bf16_t* rowp = base + (size_t)(row0 + ai * HALF + m * 16) * ldc + col0;
#pragma unroll
                for (int bj = 0; bj < 2; ++bj) { f32x4 v0 = acc[ai][bj][m][0] + bv[bj][0], v1 = acc[ai][bj][m][1] + bv[bj][1];
                    if (ACT == 1) { f32x2 a = gelu_pk((f32x2){v0[0], v0[1]}), b = gelu_pk((f32x2){v0[2], v0[3]}), c = gelu_pk((f32x2){v1[0], v1[1]}), d = gelu_pk((f32x2){v1[2], v1[3]});
                        v0 = (f32x4){a.x, a.y, b.x, b.y}; v1 = (f32x4){c.x, c.y, d.x, d.y}; }
                    v0 = v0 * sc; v1 = v1 * sc; u32x4 w; w.x = cvt_pk_bf16(v0[0], v0[1]); w.y = cvt_pk_bf16(v0[2], v0[3]); w.z = cvt_pk_bf16(v1[0], v1[1]); w.w = cvt_pk_bf16(v1[2], v1[3]);
                    *(u32x4*)(rowp + bj * HALF) = w; } }
    }
};

template <class Epi, class Sched, bool ALIGN_EPI = false, bool SP2 = false>
__device__ __forceinline__ void gemm_phase(PG8_LAS unsigned char* lds, const Gemm g, const Sched& S, const Epi& E) {
    int tid_ = threadIdx.x; asm volatile("" : "+v"(tid_));
    const int tid = tid_, wid = __builtin_amdgcn_readfirstlane(tid >> 6), lane = tid & 63, wr = wid >> 2, wc = wid & 3, fr = lane & 15, fq = lane >> 4;
    const int K = g.K, nt = K / BK;
    unsigned voffA[2], voffB[2];
#pragma unroll
    for (int i = 0; i < 2; ++i) { int R, C; stage_rc(tid * 16 + i * 8192, R, C); const int Rb = Epi::PERM ? ((R & ~31) + perm32(R & 31)) : R;
        voffA[i] = (unsigned)(R * K + C) * 2u; voffB[i] = (unsigned)(Rb * K + C) * 2u; }
    const size_t kstep = (size_t)(BK * 2);
    const size_t hstep = (size_t)HALF * K * 2;
    const size_t tstep = 2 * hstep;
    const unsigned ldsw = (unsigned)wid * 1024u;
    const int aoff = lds_byte(wr * 64 + fr, fq * 8), boff = lds_byte(wc * 32 + fr, fq * 8);
#define PG8_SA(b, h) (((b) * 2 + (h)) * HTB)
#define PG8_SB(b, h) ((4 + (b) * 2 + (h)) * HTB)
#define PG8_STAGE(bufoff, gbase, voff) do { _Pragma("unroll") for (int _i = 0; _i < 2; ++_i) \
        __builtin_amdgcn_global_load_lds((const unsigned*)((const char*)(gbase) + (voff)[_i]), (PG8_LAS unsigned*)(lds + (bufoff) + ldsw + _i * 8192), 16, 0, 0); } while (0)
#define PG8_LDA(dst, b, h) do { _Pragma("unroll") for (int m = 0; m < 4; ++m) _Pragma("unroll") for (int k = 0; k < 2; ++k) dst[m][k] = *(const PG8_LAS bf16x8*)(lds + PG8_SA(b, h) + aoff + m * 2048 + k * 1024); } while (0)
#define PG8_LDB(dst, b, h) do { _Pragma("unroll") for (int n = 0; n < 2; ++n) _Pragma("unroll") for (int k = 0; k < 2; ++k) dst[n][k] = *(const PG8_LAS bf16x8*)(lds + PG8_SB(b, h) + boff + n * 2048 + k * 1024); } while (0)
#define PG8_MMA(ai, bj, At, Bt) do { __builtin_amdgcn_s_setprio(1); _Pragma("unroll") for (int m = 0; m < 4; ++m) _Pragma("unroll") for (int n = 0; n < 2; ++n) _Pragma("unroll") for (int k = 0; k < 2; ++k) \
        acc[ai][bj][m][n] = __builtin_amdgcn_mfma_f32_16x16x32_bf16(Bt[n][k], At[m][k], acc[ai][bj][m][n], 0, 0, 0); __builtin_amdgcn_s_setprio(0); } while (0)
#define PG8_WAIT_V(n) asm volatile("s_waitcnt vmcnt(" #n ")" ::: "memory")
#define PG8_WAIT_L(n) asm volatile("s_waitcnt lgkmcnt(" #n ")" ::: "memory")
#define PG8_BAR __builtin_amdgcn_s_barrier()
#define PG8_SCHED __builtin_amdgcn_sched_barrier(0)
    Unit cur, nxt; int ui = 0;
    if (!S.next(0, cur)) return;
    f32x4 acc[2][2][4][2];
#pragma unroll
    for (int a = 0; a < 2; ++a)
#pragma unroll
        for (int b = 0; b < 2; ++b)
#pragma unroll
            for (int m = 0; m < 4; ++m)
#pragma unroll
                for (int n = 0; n < 2; ++n) acc[a][b][m][n] = (f32x4){0.f, 0.f, 0.f, 0.f};
    bf16x8 At[4][2], B0[2][2], B1[2][2];
    const char* cA = (const char*)g.A + (size_t)cur.pm * tstep; const char* cB = (const char*)g.Bt + (size_t)cur.pn * tstep;
    S.a_ready(cur);
    if constexpr (SP2) {
        PG8_STAGE(PG8_SB(0, 0), cB, voffB); PG8_STAGE(PG8_SB(0, 1), cB + hstep, voffB); PG8_STAGE(PG8_SA(0, 0), cA, voffA); PG8_STAGE(PG8_SA(0, 1), cA + hstep, voffA);
        if (wr == 1) PG8_BAR;
        PG8_WAIT_V(2); PG8_BAR;
        PG8_STAGE(PG8_SB(1, 0), cB + kstep, voffB); PG8_STAGE(PG8_SA(1, 0), cA + kstep, voffA); PG8_STAGE(PG8_SB(1, 1), cB + hstep + kstep, voffB);
        PG8_WAIT_V(6); PG8_BAR;
    } else {
        PG8_STAGE(PG8_SB(0, 0), cB, voffB); PG8_STAGE(PG8_SA(0, 0), cA, voffA); PG8_STAGE(PG8_SB(0, 1), cB + hstep, voffB); PG8_STAGE(PG8_SA(0, 1), cA + hstep, voffA);
        if (wr == 1) PG8_BAR;
        PG8_WAIT_V(4); PG8_BAR;
        PG8_STAGE(PG8_SB(1, 0), cB + kstep, voffB); PG8_STAGE(PG8_SA(1, 0), cA + kstep, voffA); PG8_STAGE(PG8_SB(1, 1), cB + hstep + kstep, voffB);
        PG8_WAIT_V(6); PG8_BAR;
    }
    for (;;) {
        const bool has_next = S.next(ui + 1, nxt);
        const char* nA = has_next ? (const char*)g.A + (size_t)nxt.pm * tstep : cA; const char* nB = has_next ? (const char*)g.Bt + (size_t)nxt.pn * tstep : cB;
        for (int t = 0; t < nt; t += 2) {
            const bool last = (t == nt - 2);
            const char* a1 = cA + (size_t)(t + 1) * kstep;
            const char* a2 = last ? nA : cA + (size_t)(t + 2) * kstep; const char* b2 = last ? nB : cB + (size_t)(t + 2) * kstep;
            const char* a3 = a2 + kstep; const char* b3 = b2 + kstep;
            if (last && has_next) S.a_ready(nxt);
            if constexpr (SP2) {
            PG8_LDB(B0, 0, 0); PG8_LDB(B1, 0, 1); PG8_SCHED; PG8_LDA(At, 0, 0); PG8_STAGE(PG8_SA(1, 1), a1 + hstep, voffA);
            PG8_WAIT_V(8); PG8_WAIT_L(0); PG8_BAR; PG8_MMA(0, 0, At, B0); PG8_MMA(0, 1, At, B1); PG8_BAR; PG8_SCHED;
            PG8_LDA(At, 0, 1); PG8_STAGE(PG8_SB(0, 0), b2, voffB); PG8_STAGE(PG8_SB(0, 1), b2 + hstep, voffB); PG8_STAGE(PG8_SA(0, 0), a2, voffA);
            PG8_WAIT_V(8); PG8_WAIT_L(0); PG8_BAR; PG8_MMA(1, 0, At, B0); PG8_MMA(1, 1, At, B1); PG8_BAR; PG8_SCHED;
            PG8_LDB(B0, 1, 0); PG8_LDB(B1, 1, 1); PG8_SCHED; PG8_LDA(At, 1, 0); PG8_STAGE(PG8_SA(0, 1), a2 + hstep, voffA);
            PG8_WAIT_V(8); PG8_WAIT_L(0); PG8_BAR; PG8_MMA(0, 0, At, B0); PG8_MMA(0, 1, At, B1); PG8_BAR; PG8_SCHED;
            PG8_LDA(At, 1, 1); PG8_STAGE(PG8_SB(1, 0), b3, voffB); PG8_STAGE(PG8_SB(1, 1), b3 + hstep, voffB); PG8_STAGE(PG8_SA(1, 0), a3, voffA);
            PG8_WAIT_V(8); PG8_WAIT_L(0); PG8_BAR; PG8_MMA(1, 0, At, B0); PG8_MMA(1, 1, At, B1); PG8_BAR; PG8_SCHED;
            } else {
            PG8_LDB(B0, 0, 0); PG8_SCHED; PG8_LDA(At, 0, 0); PG8_STAGE(PG8_SA(1, 1), a1 + hstep, voffA);
            PG8_WAIT_L(8); PG8_BAR; PG8_WAIT_L(0); PG8_MMA(0, 0, At, B0); PG8_BAR; PG8_SCHED;
            PG8_LDB(B1, 0, 1); PG8_STAGE(PG8_SB(0, 0), b2, voffB);
            PG8_BAR; PG8_WAIT_L(0); PG8_MMA(0, 1, At, B1); PG8_BAR;
            PG8_LDA(At, 0, 1); PG8_STAGE(PG8_SA(0, 0), a2, voffA);
            PG8_BAR; PG8_WAIT_L(0); PG8_MMA(1, 0, At, B0); PG8_BAR; PG8_SCHED;
            PG8_STAGE(PG8_SB(0, 1), b2 + hstep, voffB);
            PG8_WAIT_V(6); PG8_BAR; PG8_MMA(1, 1, At, B1); PG8_BAR;
            PG8_LDB(B0, 1, 0); PG8_SCHED; PG8_LDA(At, 1, 0); PG8_STAGE(PG8_SA(0, 1), a2 + hstep, voffA);
            PG8_WAIT_L(8); PG8_BAR; PG8_WAIT_L(0); PG8_MMA(0, 0, At, B0); PG8_BAR; PG8_SCHED;
            PG8_LDB(B1, 1, 1); PG8_STAGE(PG8_SB(1, 0), b3, voffB);
            PG8_BAR; PG8_WAIT_L(0); PG8_MMA(0, 1, At, B1); PG8_BAR;
            PG8_LDA(At, 1, 1); PG8_STAGE(PG8_SA(1, 0), a3, voffA);
            PG8_BAR; PG8_WAIT_L(0); PG8_MMA(1, 0, At, B0); PG8_BAR; PG8_SCHED;
            PG8_STAGE(PG8_SB(1, 1), b3 + hstep, voffB);
            PG8_WAIT_V(6); PG8_BAR; PG8_MMA(1, 1, At, B1); PG8_BAR;
            }
        }
        if constexpr (ALIGN_EPI) { if (wr == 0) PG8_BAR; }
        if constexpr (!Epi::AFTER_DRAIN) { E(acc, cur, wr, wc, fr, fq); S.done(cur); }
        if (!has_next) break;
#pragma unroll
        for (int a = 0; a < 2; ++a)
#pragma unroll
            for (int b = 0; b < 2; ++b)
#pragma unroll
                for (int m = 0; m < 4; ++m)
#pragma unroll
                    for (int n = 0; n < 2; ++n) acc[a][b][m][n] = (f32x4){0.f, 0.f, 0.f, 0.f};
        cur = nxt; cA = nA; cB = nB; ++ui;
        if constexpr (ALIGN_EPI) { if (wr == 1) PG8_BAR; }
    }
    PG8_WAIT_V(0);
    if constexpr (!ALIGN_EPI) { if (wr == 0) PG8_BAR; }
    PG8_BAR;
    if constexpr (Epi::AFTER_DRAIN) { E.fused(acc, cur, wr, wc, fr, fq, lds, wid, lane); S.done(cur); }
#undef PG8_SA
#undef PG8_SB
#undef PG8_STAGE
#undef PG8_LDA
#undef PG8_LDB
#undef PG8_MMA
#undef PG8_WAIT_V
#undef PG8_WAIT_L
#undef PG8_BAR
#undef PG8_SCHED
}
}
namespace pg8 {
struct EpiResid {
    static constexpr bool PERM = false, AFTER_DRAIN = false;
    const float* base; float* out; int ldc;
    __device__ __forceinline__ void operator()(const f32x4 (&acc)[2][2][4][2], const Unit& u, int wr, int wc, int fr, int fq) const {
        const int col0 = u.pn * BM + wc * 32 + 4 * fq;
#pragma unroll
        for (int ai = 0; ai < 2; ++ai)
#pragma unroll
            for (int m = 0; m < 4; ++m) { const size_t off = (size_t)(u.pm * BM + ai * HALF + wr * 64 + m * 16 + fr) * ldc + col0;
#pragma unroll
                for (int bj = 0; bj < 2; ++bj)
#pragma unroll
                    for (int n = 0; n < 2; ++n) { const f32x4 b = *(const f32x4*)(base + off + bj * HALF + n * 16); *(f32x4*)(out + off + bj * HALF + n * 16) = b + acc[ai][bj][m][n]; } }
    }
};
struct RangeOrder {
    int nM, nN, nwg, G, c, first, last;
    __host__ __device__ void init(int M, int N, int G_, int c_, int first_, int count_) { nM = M / BM; nN = N / BM; nwg = nM * nN; G = G_; c = c_; first = first_; last = first_ + count_; }
    __host__ __device__ bool next(int i, Unit& u) const {
        const long L = (long)first + (long)i * G + c; if (c < 0 || L >= last || L >= nwg) return false;
        int wgid = (int)L; { const int q = nwg / NXCD, r = nwg % NXCD, xcd = wgid % NXCD, off = wgid / NXCD; wgid = (xcd < r ? xcd * (q + 1) : r * (q + 1) + (xcd - r) * q) + off; }
        const int nig = WGM * nN, gid = wgid / nig, fm = gid * WGM, gsz = (nM - fm) < WGM ? (nM - fm) : WGM;
        u.pm = fm + ((wgid % nig) % gsz); u.pn = (wgid % nig) / gsz; return true;
    }
    __device__ __forceinline__ void a_ready(const Unit&) const {}
    __device__ __forceinline__ void done(const Unit&) const {}
};
struct EpiRmsRes {
    static constexpr bool PERM = false, AFTER_DRAIN = true;
    const float* base; float* out; bf16_t* xn; const float* w; float* slots; unsigned* cnt; int ldc; int mode;
    __device__ __forceinline__ void fused(f32x4 (&acc)[2][2][4][2], const Unit& u, int wr, int wc, int fr, int fq, PG8_LAS unsigned char* lds, int wid, int lane) const {
        const int col0 = u.pn * BM + wc * 32 + 4 * fq;
        PG8_LAS float* P = (PG8_LAS float*)lds; PG8_LAS float* S = (PG8_LAS float*)(lds + 4096);
#pragma unroll
        for (int ai = 0; ai < 2; ++ai)
#pragma unroll
            for (int m = 0; m < 4; ++m) { const size_t off = (size_t)(u.pm * BM + ai * HALF + wr * 64 + m * 16 + fr) * ldc + col0; float s = 0.f;
#pragma unroll
                for (int bj = 0; bj < 2; ++bj)
#pragma unroll
                    for (int n = 0; n < 2; ++n) { const f32x4 v = acc[ai][bj][m][n] + *(const f32x4*)(base + off + bj * HALF + n * 16); acc[ai][bj][m][n] = v; s += (v[0] * v[0] + v[1] * v[1]) + (v[2] * v[2] + v[3] * v[3]); }
                s += __shfl_xor(s, 16); s += __shfl_xor(s, 32);
                if (fq == 0) P[(ai * HALF + wr * 64 + m * 16 + fr) * 4 + wc] = s;
                if (m & 1) asm volatile("" ::: "memory"); }
        asm volatile("s_waitcnt lgkmcnt(0)" ::: "memory"); __builtin_amdgcn_s_barrier(); asm volatile("" ::: "memory");
        const int row = wid * 32 + (lane & 31);
        if (lane < 32) { const float tot = (P[row * 4 + 0] + P[row * 4 + 1]) + (P[row * 4 + 2] + P[row * 4 + 3]);
            __hip_atomic_store(slots + ((size_t)(u.pm * BM + row) * 4 + u.pn), tot, __ATOMIC_RELAXED, __HIP_MEMORY_SCOPE_AGENT); }
        asm volatile("s_waitcnt vmcnt(0)" ::: "memory");
        if (lane == 0) __hip_atomic_fetch_add(cnt + 64 * u.pm, 1u, __ATOMIC_RELAXED, __HIP_MEMORY_SCOPE_AGENT);
        if (wid == 0) { while ((unsigned)__builtin_amdgcn_readfirstlane(__hip_atomic_load(cnt + 64 * u.pm, __ATOMIC_RELAXED, __HIP_MEMORY_SCOPE_AGENT)) < 32u) __builtin_amdgcn_s_sleep(2);
            __builtin_amdgcn_fence(__ATOMIC_ACQUIRE, "agent"); }
        asm volatile("s_waitcnt vmcnt(0) lgkmcnt(0)" ::: "memory"); __builtin_amdgcn_s_barrier(); asm volatile("" ::: "memory");
        if (lane < 32) { const float* sl = slots + (size_t)(u.pm * BM + row) * 4; float q = 0.f;
#pragma unroll
            for (int t = 0; t < 4; ++t) q += __hip_atomic_load(sl + t, __ATOMIC_RELAXED, __HIP_MEMORY_SCOPE_AGENT);
            S[row] = 1.0f / sqrtf(q * (1.f / 1024.f) + 1e-6f); }
        asm volatile("s_waitcnt lgkmcnt(0)" ::: "memory"); __builtin_amdgcn_s_barrier(); asm volatile("" ::: "memory");
        f32x4 wv[2][2];
#pragma unroll
        for (int bj = 0; bj < 2; ++bj)
#pragma unroll
            for (int n = 0; n < 2; ++n) wv[bj][n] = *(const f32x4*)(w + col0 + bj * HALF + n * 16);
#pragma unroll
        for (int ai = 0; ai < 2; ++ai)
#pragma unroll
            for (int m = 0; m < 4; ++m) { const int r = ai * HALF + wr * 64 + m * 16 + fr; const float rs = S[r]; const size_t off = (size_t)(u.pm * BM + r) * ldc + col0;
#pragma unroll
                for (int bj = 0; bj < 2; ++bj)
#pragma unroll
                    for (int n = 0; n < 2; ++n) { const f32x4 v = acc[ai][bj][m][n]; const f32x4 nv = v * rs * wv[bj][n];
                        if (mode == 0) { *(f32x4*)(out + off + bj * HALF + n * 16) = v; typedef unsigned u32x2v __attribute__((ext_vector_type(2))); u32x2v pk; pk.x = cvt_pk_bf16(nv[0], nv[1]); pk.y = cvt_pk_bf16(nv[2], nv[3]);
                            *(u32x2v*)(xn + off + bj * HALF + n * 16) = pk; }
                        else *(f32x4*)(out + off + bj * HALF + n * 16) = nv; } }
    }
};
}
constexpr int NWAVES = 8, NTHR = 512;
constexpr int BATCH = 2, T = 8192, D = 1024, M = BATCH * T, MH = T;
constexpr int NIN = 3728, NPAD = 3840;
constexpr int C_GQ = 0, C_GK = 256, C_GV = 512, C_GLR = 1024, C_GG = 1040, C_R = 1552, C_K = 2064, C_V = 2576, C_WL = 3088, C_AL = 3152, C_RG = 3216;
constexpr size_t MiB = 1u << 20;
constexpr size_t WS_WIN = 1 * MiB, WIN_BYTES = (size_t)NPAD * D * 2;
constexpr size_t WS_WOUT = 16 * MiB, WOUT_BYTES = (size_t)D * D * 2;
constexpr size_t WS_XN = 20 * MiB;
constexpr size_t WS_U = 52 * MiB, WS_U1 = 193 * MiB, U_STRIDE = WS_U1 - WS_U;
constexpr size_t WS_SLOTS = 192 * MiB;
constexpr size_t WS_END = 254 * MiB;
constexpr int LDS_BYTES = 163840;
constexpr int EARLY_TILES = 224;

typedef unsigned short bf16;
typedef unsigned v4u __attribute__((ext_vector_type(4)));
typedef float f32x4 __attribute__((ext_vector_type(4)));
#define LDS_WAIT() asm volatile("s_waitcnt lgkmcnt(0)" ::: "memory")
#define LBAR() do { asm volatile("s_waitcnt lgkmcnt(0)" ::: "memory"); __builtin_amdgcn_s_barrier(); asm volatile("" ::: "memory"); } while (0)
__device__ __forceinline__ float bf2f(unsigned h) { return __uint_as_float(h << 16); }
__device__ __forceinline__ unsigned f2bf(float f) { unsigned u = __float_as_uint(f); return (u + 0x7fffu + ((u >> 16) & 1u)) >> 16; }
typedef __bf16 bf16x2_t __attribute__((ext_vector_type(2)));
typedef float f32x2_t __attribute__((ext_vector_type(2)));
__device__ __forceinline__ unsigned pk2(float lo, float hi) { const f32x2_t v = {lo, hi}; const bf16x2_t b = __builtin_convertvector(v, bf16x2_t); return __builtin_bit_cast(unsigned, b); }
__device__ __forceinline__ float wave_sum(float v) {
#pragma unroll
    for (int o = 1; o < 64; o <<= 1) v += __shfl_xor(v, o);
    return v;
}
__device__ __forceinline__ float sigm(float x) { return __builtin_amdgcn_rcpf(1.f + __expf(-x)); }
__device__ __forceinline__ float tanh_fast(float x) { return 1.f - 2.f * __builtin_amdgcn_rcpf(1.f + __expf(2.f * x)); }
__device__ __forceinline__ float rl(float v, int l) { return __int_as_float(__builtin_amdgcn_readlane(__float_as_int(v), l)); }

typedef short bf16x8 __attribute__((ext_vector_type(8)));
typedef unsigned v2u __attribute__((ext_vector_type(2)));
__device__ __forceinline__ v2u pack4(f32x4 v) { v2u r; r.x = pk2(v.x, v.y); r.y = pk2(v.z, v.w); return r; }
__device__ __forceinline__ void unpack8(v4u w, float* o) { o[0] = bf2f(w.x & 0xffffu); o[1] = bf2f(w.x >> 16); o[2] = bf2f(w.y & 0xffffu); o[3] = bf2f(w.y >> 16);
    o[4] = bf2f(w.z & 0xffffu); o[5] = bf2f(w.z >> 16); o[6] = bf2f(w.w & 0xffffu); o[7] = bf2f(w.w >> 16); }
__device__ __forceinline__ v4u pack8(const float* v) { v4u r; r.x = pk2(v[0], v[1]); r.y = pk2(v[2], v[3]); r.z = pk2(v[4], v[5]); r.w = pk2(v[6], v[7]); return r; }
struct Args { const float* in[18]; float* out; unsigned char* ws; };
typedef const Args __attribute__((address_space(4))) CArgs;
__device__ __forceinline__ CArgs* opaque_args() { CArgs* p = (CArgs*)__builtin_amdgcn_kernarg_segment_ptr(); asm volatile("" : "+s"(p)); return p; }
#define AA (*opaque_args())

__device__ __forceinline__ void rms_row2(const float* x0, const float* x1, const float* w, bf16* o0, bf16* o1, int lane) {
    const f32x4* r0 = (const f32x4*)x0 + lane; const f32x4* r1 = (const f32x4*)x1 + lane; const f32x4* wr = (const f32x4*)w + lane;
    f32x4 a[4], b[4]; float sa = 0.f, sb = 0.f;
#pragma unroll
    for (int j = 0; j < 4; ++j) { a[j] = r0[64 * j]; b[j] = r1[64 * j]; }
#pragma unroll
    for (int j = 0; j < 4; ++j) { sa += (a[j].x * a[j].x + a[j].y * a[j].y) + (a[j].z * a[j].z + a[j].w * a[j].w); sb += (b[j].x * b[j].x + b[j].y * b[j].y) + (b[j].z * b[j].z + b[j].w * b[j].w); }
    const float ra = rsqrtf(wave_sum(sa) * (1.f / D) + 1e-6f), rb = rsqrtf(wave_sum(sb) * (1.f / D) + 1e-6f);
#pragma unroll
    for (int j = 0; j < 4; ++j) { const f32x4 ww = wr[64 * j]; const f32x4 oa = a[j] * ra * ww, ob = b[j] * rb * ww;
        ((v2u*)o0 + lane)[64 * j] = pack4(oa); ((v2u*)o1 + lane)[64 * j] = pack4(ob); }
}
__device__ __forceinline__ void transpose_item(const float* W, int K, int N, int Npad, bf16* WT, float* scr, int item, int lane) {
    const int nblk = Npad / 32, kb = item / nblk, nb = item % nblk, k0 = 64 * kb, n0 = 32 * nb;
    const int n = n0 + (lane & 31);
#pragma unroll 8
    for (int i = 0; i < 32; ++i) { const int kk = 2 * i + (lane >> 5); scr[kk * 33 + (lane & 31)] = (n < N) ? W[(size_t)(k0 + kk) * N + n] : 0.f; }
    LDS_WAIT();
    const int c = lane & 7;
#pragma unroll
    for (int j = 0; j < 4; ++j) { const int nn = (lane >> 3) + 8 * j; const float* s = scr + (8 * c) * 33 + nn;
        v4u o; o.x = pk2(s[0 * 33], s[1 * 33]); o.y = pk2(s[2 * 33], s[3 * 33]); o.z = pk2(s[4 * 33], s[5 * 33]); o.w = pk2(s[6 * 33], s[7 * 33]);
        *(v4u*)(WT + (size_t)(n0 + nn) * K + k0 + 8 * c) = o; }
    LDS_WAIT();
}
__device__ __forceinline__ void transpose_tiles(const float* W, int K, int N, int Npad, bf16* WT, float* scr  , int first, int stride, int ntiles, int tid) {
    const int nblk = Npad / 64, kr = tid >> 4, nq = tid & 15;
    f32x4 v0 = {0.f, 0.f, 0.f, 0.f}, v1 = v0;
    if (first < ntiles) { const int kb = first / nblk, nb = first % nblk, n = 64 * nb + 4 * nq; if (n < N) { v0 = *(const f32x4*)(W + (size_t)(64 * kb + kr) * N + n); v1 = *(const f32x4*)(W + (size_t)(64 * kb + 32 + kr) * N + n); } }
#pragma unroll 1
    for (int it = first; it < ntiles; it += stride) {
        const int kb = it / nblk, nb = it % nblk;
        scr[kr * 65 + 4 * nq] = v0.x; scr[kr * 65 + 4 * nq + 1] = v0.y; scr[kr * 65 + 4 * nq + 2] = v0.z; scr[kr * 65 + 4 * nq + 3] = v0.w;
        scr[(32 + kr) * 65 + 4 * nq] = v1.x; scr[(32 + kr) * 65 + 4 * nq + 1] = v1.y; scr[(32 + kr) * 65 + 4 * nq + 2] = v1.z; scr[(32 + kr) * 65 + 4 * nq + 3] = v1.w;
        const int nx = it + stride; v0 = (f32x4){0.f, 0.f, 0.f, 0.f}; v1 = v0;
        if (nx < ntiles) { const int kb2 = nx / nblk, nb2 = nx % nblk, n = 64 * nb2 + 4 * nq; if (n < N) { v0 = *(const f32x4*)(W + (size_t)(64 * kb2 + kr) * N + n); v1 = *(const f32x4*)(W + (size_t)(64 * kb2 + 32 + kr) * N + n); } }
        LBAR();
        { const int n = tid >> 3, kc = tid & 7; const float* sp = scr + (8 * kc) * 65 + n; float o[8];
#pragma unroll
          for (int j = 0; j < 8; ++j) o[j] = sp[j * 65];
          *(v4u*)(WT + (size_t)(64 * nb + n) * K + 64 * kb + 8 * kc) = pack8(o); }
        LBAR();
    }
}
__device__ __forceinline__ void rms_row(const float* xrow, const float* w, bf16* obf, float* of32, int lane) {
    const f32x4* xr = (const f32x4*)xrow + lane; const f32x4* wr = (const f32x4*)w + lane;
    f32x4 v[4]; float s = 0.f;
#pragma unroll
    for (int j = 0; j < 4; ++j) { v[j] = xr[64 * j]; s += (v[j].x * v[j].x + v[j].y * v[j].y) + (v[j].z * v[j].z + v[j].w * v[j].w); }
    const float rs = rsqrtf(wave_sum(s) * (1.f / D) + 1e-6f);
#pragma unroll
    for (int j = 0; j < 4; ++j) { const f32x4 ww = wr[64 * j]; f32x4 o = v[j] * rs * ww;
        if (of32) ((f32x4*)of32 + lane)[64 * j] = o;
        else ((unsigned long long*)obf + lane)[64 * j] = (unsigned long long)pk2(o.x, o.y) | ((unsigned long long)pk2(o.z, o.w) << 32); }
}

constexpr int PITCH = 72, FP = 68, TP = 20;
constexpr int OFF_TW = 0, OFF_AL = 9216, OFF_ARK = 18432, OFF_XA = 27648, OFF_XW = 45056, OFF_AT = 63488, OFF_RT = 72704, OFF_BH = 81920, OFF_KH = 91136,
              OFF_BBT = 100352, OFF_KBT = 109568, OFF_VT = 118784, OFF_TII = 128000, OFF_TOT = 133120, OFF_BC = 135168;
constexpr int OFF_AAK = OFF_TW, OFF_ARB = OFF_AL, OFF_AAB = OFF_XA, OFF_XT = OFF_XW;
constexpr size_t WS_MC = 112 * MiB, WS_NC = 120 * MiB, WS_PP = 136 * MiB, WS_Y0 = 144 * MiB, WS_S0 = 152 * MiB, WS_DEC = 160 * MiB, WS_BON2 = 161 * MiB, WS_UPT = 162 * MiB;
constexpr int NUNIT = 1024;

__device__ __forceinline__ f32x4 mma2s(const bf16* Ab, int ak, const bf16* Bb, int bk, int g, f32x4 acc) {
    acc = __builtin_amdgcn_mfma_f32_16x16x32_bf16(*(const bf16x8*)(Ab + ((g ^ ak) << 3)), *(const bf16x8*)(Bb + ((g ^ bk) << 3)), acc, 0, 0, 0);
    acc = __builtin_amdgcn_mfma_f32_16x16x32_bf16(*(const bf16x8*)(Ab + (((g + 4) ^ ak) << 3)), *(const bf16x8*)(Bb + (((g + 4) ^ bk) << 3)), acc, 0, 0, 0);
    return acc;
}
#define SWK(row) (((row) >> 3) & 7)
#define SWC(row, t) ((row) * PITCH + ((((t) >> 3) ^ SWK(row)) << 3) + ((t) & 7))
__device__ __forceinline__ f32x4 mma2(const bf16* Arow, const bf16* Brow, f32x4 acc) {
    acc = __builtin_amdgcn_mfma_f32_16x16x32_bf16(*(const bf16x8*)(Arow), *(const bf16x8*)(Brow), acc, 0, 0, 0);
    acc = __builtin_amdgcn_mfma_f32_16x16x32_bf16(*(const bf16x8*)(Arow + 32), *(const bf16x8*)(Brow + 32), acc, 0, 0, 0);
    return acc;
}

__device__ __forceinline__ void r1_phase(CArgs& a, size_t uo, int l, unsigned char* L, int tid0) {
    asm volatile("" : "+v"(tid0));
    const int wave = __builtin_amdgcn_readfirstlane(tid0 >> 6);
    const bf16* U = (const bf16*)(a.ws + WS_U + uo);
    bf16* TW = (bf16*)(L + 138240 + 2560); bf16* ALm = (bf16*)(L + 138240 + 2560 + 9216);
    bf16* ARK = (bf16*)(L + OFF_ARK); bf16* AAK = (bf16*)(L + OFF_AAK); bf16* ARB = (bf16*)(L + OFF_ARB);
    float* XA = (float*)(L + OFF_XA); float* XW = (float*)(L + OFF_XW); float* AAB = (float*)(L + OFF_AAB); bf16* XT = (bf16*)(L + OFF_XT);
    bf16* AT = (bf16*)(L + OFF_AT); bf16* RT = (bf16*)(L + OFF_RT); bf16* BH = (bf16*)(L + OFF_BH); bf16* KH = (bf16*)(L + OFF_KH);
    bf16* BBT = (bf16*)(L + OFF_BBT); bf16* KBT = (bf16*)(L + OFF_KBT); bf16* VT = (bf16*)(L + OFF_VT);
    float* TII = (float*)(L + OFF_TII); float* TOT = (float*)(L + OFF_TOT); float* BC = (float*)(L + OFF_BC);
    const bf16* UPT = (const bf16*)(a.ws + WS_UPT) + (size_t)l * 2 * 512 * 64;
    const float* mu = a.in[6] + l * 1664;
    float* WTS = (float*)(L + 135680);
    const int ch = (int)blockIdx.x >> 1, hbase = 4 * ((int)blockIdx.x & 1);
    v4u Lrc, Lkc, Lvc, Lrp, Lkp, Lvp; bf16x8 wfa0, wfa1; float pw[8];
#define R1_ISSUE(h_) do { const int lr_ = 64 * ch + (tid >> 3); const bf16* uq_ = U + (size_t)lr_ * NPAD + 64 * (h_) + 8 * (tid & 7); \
        Lrc = *(const v4u*)(uq_ + C_R); Lkc = *(const v4u*)(uq_ + C_K); Lvc = *(const v4u*)(uq_ + C_V); Lrp = (v4u){0u, 0u, 0u, 0u}; Lkp = Lrp; Lvp = Lrp; \
        if (lr_ > 0) { Lrp = *(const v4u*)(uq_ + C_R - NPAD); Lkp = *(const v4u*)(uq_ + C_K - NPAD); Lvp = *(const v4u*)(uq_ + C_V - NPAD); } \
        if (tid < 64) { const int c_ = l * 512 + 64 * (h_) + tid; pw[0] = a.in[7][c_]; pw[1] = a.in[9][c_]; pw[2] = a.in[11][c_]; pw[3] = a.in[12][c_]; pw[4] = a.in[13][c_]; \
            pw[5] = mu[64 * (h_) + tid]; pw[6] = mu[512 + 64 * (h_) + tid]; pw[7] = mu[1024 + 64 * (h_) + tid]; } \
        { const bf16* WT_ = UPT + (size_t)(wave >> 2) * 512 * 64 + (size_t)(64 * (h_) + 16 * (wave & 3) + (tid & 15)) * 64 + 8 * ((tid & 63) >> 4); wfa0 = *(const bf16x8*)WT_; wfa1 = *(const bf16x8*)(WT_ + 32); } } while (0)
    {
        int tid = tid0; asm volatile("" : "+v"(tid));
        R1_ISSUE(hbase);
        const int t = tid >> 3, cg = tid & 7, lr = 64 * ch + t; const bf16* up = U + (size_t)lr * NPAD + C_WL + 16 * cg;
        const v4u c0 = *(const v4u*)up, c1 = *(const v4u*)(up + 8); v4u p0 = {0u, 0u, 0u, 0u}, p1 = p0;
        if (lr > 0) { p0 = *(const v4u*)(up - NPAD); p1 = *(const v4u*)(up - NPAD + 8); }
        float cu[16], pr[16], o[16]; unpack8(c0, cu); unpack8(c1, cu + 8); unpack8(p0, pr); unpack8(p1, pr + 8);
        const float* mp = mu + 1536 + 16 * cg;
#pragma unroll
        for (int i = 0; i < 16; ++i) { float mv = cu[i] + (pr[i] - cu[i]) * mp[i]; if (cg < 4) mv = tanh_fast(mv); o[i] = mv; }
        bf16* dst = (cg < 4 ? TW : ALm) + t * PITCH + 16 * (cg & 3);
        *(v4u*)dst = pack8(o); *(v4u*)(dst + 8) = pack8(o + 8);
    }
#pragma unroll 1
    for (int hi = 0; hi < 4; ++hi) {
        int tid = tid0; asm volatile("" : "+v"(tid));
        const int lane = tid & 63, g = lane >> 4, c16 = lane & 15;
        const int h = hbase + hi, unit = ch * 8 + h;
        const int t = tid >> 3, dg = tid & 7, d0 = 8 * dg, lr = 64 * ch + t, hc = 64 * h + d0;
        if (tid < 64) {
#pragma unroll
            for (int q = 0; q < 8; ++q) WTS[64 * q + tid] = pw[q]; }
        LBAR();
        {
            const int q = wave >> 2, dt = wave & 3;
            const bf16x8 a0 = wfa0, a1 = wfa1;
            const bf16* Bm = q ? ALm : TW; float* X = q ? XA : XW;
#pragma unroll
            for (int tt = 0; tt < 4; ++tt) { const bf16* br = Bm + (16 * tt + c16) * PITCH + 8 * g; f32x4 acc = {0.f, 0.f, 0.f, 0.f};
                acc = __builtin_amdgcn_mfma_f32_16x16x32_bf16(a0, *(const bf16x8*)br, acc, 0, 0, 0);
                acc = __builtin_amdgcn_mfma_f32_16x16x32_bf16(a1, *(const bf16x8*)(br + 32), acc, 0, 0, 0);
                *(f32x4*)(X + (16 * tt + c16) * FP + 16 * dt + 4 * g) = acc; }
        }
        LBAR();
        float r[8], kq[8], v[8], al[8], be[8], lw[8];
        {
            float rc[8], rp[8], kc[8], kp[8], vc[8], vp[8];
            unpack8(Lrc, rc); unpack8(Lkc, kc); unpack8(Lvc, vc); unpack8(Lrp, rp); unpack8(Lkp, kp); unpack8(Lvp, vp);
            const float* w0p = WTS + d0; const float* a0p = WTS + 64 + d0; const float* kkp = WTS + 128 + d0;
            const float* kap = WTS + 192 + d0; const float* rkp = WTS + 256 + d0;
            float nn = 0.f, bon = 0.f, kk[8], av[8];
#pragma unroll
            for (int i = 0; i < 8; ++i) {
                const float xw = XW[t * FP + d0 + i] + w0p[i], xa = XA[t * FP + d0 + i] + a0p[i];
                lw[i] = -0.60653065971f * sigm(xw); av[i] = sigm(xa);
                r[i] = rc[i] + (rp[i] - rc[i]) * WTS[320 + d0 + i]; const float k = kc[i] + (kp[i] - kc[i]) * WTS[384 + d0 + i]; v[i] = vc[i] + (vp[i] - vc[i]) * WTS[448 + d0 + i];
                kk[i] = k * kkp[i]; nn += kk[i] * kk[i];
                kq[i] = k * (1.f + (av[i] - 1.f) * kap[i]); bon += r[i] * kq[i] * rkp[i];
            }
            nn += __shfl_xor(nn, 1); nn += __shfl_xor(nn, 2); nn += __shfl_xor(nn, 4);
            bon += __shfl_xor(bon, 1); bon += __shfl_xor(bon, 2); bon += __shfl_xor(bon, 4);
            const float inv = __builtin_amdgcn_rsqf(fmaxf(nn, 1e-24f));
#pragma unroll
            for (int i = 0; i < 8; ++i) { const float kn = kk[i] * inv; al[i] = -kn; be[i] = av[i] * kn; XW[t * FP + d0 + i] = lw[i]; }
            if (dg == 0) ((float*)(a.ws + WS_BON2))[lr * 8 + h] = bon;
        }
        LBAR();
        {
            const int d = tid & 63, tb = tid >> 6; float p[8]; float run = 0.f;
#pragma unroll
            for (int i = 0; i < 8; ++i) { run += XW[(8 * tb + i) * FP + d]; p[i] = run; }
            TOT[tb * 64 + d] = run;
            LBAR();
            float off = 0.f;
#pragma unroll
            for (int j = 0; j < 8; ++j) off += (j < tb) ? TOT[j * 64 + d] : 0.f;
#pragma unroll
            for (int i = 0; i < 8; ++i) XW[(8 * tb + i) * FP + d] = off + p[i];
            if (tb == 7) { BC[d] = off + run; BC[64 + d] = __expf(off + run); }
        }
        LBAR();
        {
            float at[8], rt[8], bh[8], kh[8];
#pragma unroll
            for (int i = 0; i < 8; ++i) { const float b = XW[t * FP + d0 + i];
                const float eb = __expf(b), enb = __builtin_amdgcn_rcpf(eb), ebp = __expf(b - lw[i]), ebc = BC[64 + d0 + i] * enb;
                at[i] = al[i] * ebp; rt[i] = r[i] * eb; bh[i] = be[i] * enb; kh[i] = kq[i] * enb;
                BBT[SWC(d0 + i, t)] = (bf16)f2bf(be[i] * ebc); KBT[SWC(d0 + i, t)] = (bf16)f2bf(kq[i] * ebc); VT[SWC(d0 + i, t)] = (bf16)f2bf(v[i]); }
            *(v4u*)(AT + t * PITCH + d0) = pack8(at); *(v4u*)(RT + t * PITCH + d0) = pack8(rt); *(v4u*)(BH + t * PITCH + d0) = pack8(bh); *(v4u*)(KH + t * PITCH + d0) = pack8(kh);
        }
        asm volatile("" ::: "memory");
        if (hi + 1 < 4) R1_ISSUE(h + 1);
        LBAR();
        {
            const int q = wave >> 1, mh = wave & 1;
            const bf16* As = (q < 2) ? AT : RT; const bf16* Bs = (q & 1) ? KH : BH;
#pragma unroll
            for (int t2 = 0; t2 < 2; ++t2) { const int tt = 2 * mh + t2; const int tcol = 16 * tt + c16;
#pragma unroll
                for (int jt = 0; jt < 4; ++jt) {
                    f32x4 acc = {0.f, 0.f, 0.f, 0.f};
                    if (jt <= tt) { acc = mma2(Bs + (16 * jt + c16) * PITCH + 8 * g, As + tcol * PITCH + 8 * g, acc);
#pragma unroll
                        for (int j = 0; j < 4; ++j) { const int jj = 16 * jt + 4 * g + j; const bool keep = (q < 2) ? (jj < tcol) : (jj <= tcol); if (!keep) acc[j] = 0.f; } }
                    if (q == 0) *(f32x4*)(AAB + tcol * FP + 16 * jt + 4 * g) = acc;
                    else { bf16* dst = (q == 1 ? AAK : (q == 2 ? ARB : ARK)); *(v2u*)(dst + tcol * PITCH + 16 * jt + 4 * g) = pack4(acc); }
                } }
        }
        LBAR();
        f32x4 Z[4];
        {
            if (wave == 0) { const int i = g; float Tc[16];
#pragma unroll
                for (int tr = 0; tr < 16; ++tr) { float s0 = (c16 == tr) ? 1.f : 0.f, s1 = 0.f, s2 = 0.f, s3 = 0.f; const float* ar = AAB + (16 * i + tr) * FP + 16 * i;
#pragma unroll
                    for (int j = 0; j < 16; j += 4) { if (j < tr) s0 += ar[j] * Tc[j]; if (j + 1 < tr) s1 += ar[j + 1] * Tc[j + 1]; if (j + 2 < tr) s2 += ar[j + 2] * Tc[j + 2]; if (j + 3 < tr) s3 += ar[j + 3] * Tc[j + 3]; }
                    const float sv = (s0 + s1) + (s2 + s3); Tc[tr] = sv; TII[(i * 16 + tr) * TP + c16] = sv; } }
            if (wave < 4) {
#pragma unroll
                for (int i = 0; i < 4; ++i)
#pragma unroll
                    for (int j = 0; j < 4; ++j) Z[i][j] = bf2f(AT[(16 * i + 4 * g + j) * PITCH + 16 * wave + c16]);
            } else {
#pragma unroll
                for (int i = 0; i < 4; ++i) { f32x4 acc = {0.f, 0.f, 0.f, 0.f}; const int er = 16 * (wave - 4) + c16; Z[i] = mma2s(AAK + (16 * i + c16) * PITCH, 0, VT + er * PITCH, SWK(er), g, acc); }
            }
        }
        LBAR();
        {
            typedef short s16x4 __attribute__((ext_vector_type(4)));
            f32x4 X[4]; s16x4 Xb[4];
#pragma unroll
            for (int i = 0; i < 4; ++i) { f32x4 z = Z[i];
#pragma unroll
                for (int kb = 0; kb < 4; ++kb) if (kb < i) { const f32x4 av = *(const f32x4*)(AAB + (16 * i + c16) * FP + 16 * kb + 4 * g);
                    const v2u ap = pack4(av); z = __builtin_amdgcn_mfma_f32_16x16x16bf16_1k(__builtin_bit_cast(s16x4, ap), Xb[kb], z, 0, 0, 0); }
                const f32x4 tv = *(const f32x4*)(TII + (i * 16 + c16) * TP + 4 * g); const v2u tp = pack4(tv), zp = pack4(z);
                const f32x4 zero4 = {0.f, 0.f, 0.f, 0.f};
                X[i] = __builtin_amdgcn_mfma_f32_16x16x16bf16_1k(__builtin_bit_cast(s16x4, tp), __builtin_bit_cast(s16x4, zp), zero4, 0, 0, 0);
                const v2u xp = pack4(X[i]); Xb[i] = __builtin_bit_cast(s16x4, xp); }
#pragma unroll
            for (int i = 0; i < 4; ++i) *(v2u*)(XT + (16 * wave + c16) * PITCH + 16 * i + 4 * g) = __builtin_bit_cast(v2u, Xb[i]);
        }
        LBAR();
        {
            const int q = wave >> 1, hh = wave & 1;
            bf16* MCg = (bf16*)(a.ws + WS_MC) + (size_t)unit * 4096; float* NCg = (float*)(a.ws + WS_NC) + (size_t)unit * 4096;
            bf16* PPg = (bf16*)(a.ws + WS_PP) + (size_t)unit * 4096; bf16* Y0g = (bf16*)(a.ws + WS_Y0) + (size_t)unit * 4096;
#pragma unroll
            for (int t2 = 0; t2 < 2; ++t2) { const int ti = 2 * hh + t2;
#pragma unroll
                for (int tj = 0; tj < 4; ++tj) { f32x4 acc = {0.f, 0.f, 0.f, 0.f}; const int cc = 16 * tj + c16, rr = 16 * ti + 4 * g;
                    if (q == 0) { acc = mma2s(XT + (16 * ti + c16) * PITCH, 0, BBT + cc * PITCH, SWK(cc), g, acc); *(v2u*)(MCg + cc * 64 + (ti >> 1) * 32 + g * 8 + (ti & 1) * 4) = pack4(acc); }
                    else if (q == 1) { const int ar = 16 * ti + c16; acc = mma2s(BBT + ar * PITCH, SWK(ar), XT + (64 + cc) * PITCH, 0, g, acc); acc = mma2s(KBT + ar * PITCH, SWK(ar), VT + cc * PITCH, SWK(cc), g, acc);
                        *(f32x4*)(NCg + cc * 64 + rr) = acc; }
                    else if (q == 2) { acc = mma2(XT + (16 * ti + c16) * PITCH + 8 * g, ARB + cc * PITCH + 8 * g, acc);
                        const v2u rv = *(const v2u*)(RT + cc * PITCH + rr); acc[0] += bf2f(rv.x & 0xffffu); acc[1] += bf2f(rv.x >> 16); acc[2] += bf2f(rv.y & 0xffffu); acc[3] += bf2f(rv.y >> 16);
                        *(v2u*)(PPg + cc * 64 + rr) = pack4(acc); }
                    else { acc = mma2(XT + (64 + 16 * ti + c16) * PITCH + 8 * g, ARB + cc * PITCH + 8 * g, acc); { const int ar = 16 * ti + c16; acc = mma2s(VT + ar * PITCH, SWK(ar), ARK + cc * PITCH, 0, g, acc); }
                        *(v2u*)(Y0g + cc * 64 + rr) = pack4(acc); }
                } }
            if (tid < 64) ((float*)(a.ws + WS_DEC))[unit * 64 + tid] = BC[64 + tid];
        }
        LBAR();
    }
}

#define LAS3 __attribute__((address_space(3)))
constexpr int R2_SLOT = 12544, R2_NS = 10, R2_FLAGS = R2_SLOT * R2_NS;
__device__ __forceinline__ void r2_scan(CArgs& a, int chain, unsigned char* L, int tid) {
    asm volatile("" : "+v"(tid));
    const int lane = tid & 63, wave = __builtin_amdgcn_readfirstlane(tid >> 6);
    const int h = chain >> 2, e0 = 16 * (chain & 3), g = lane >> 4, c16 = lane & 15;
    volatile LAS3 unsigned* flg = (volatile LAS3 unsigned*)(LAS3 unsigned char*)(L + R2_FLAGS);
    if (tid < 32) flg[tid] = 0u;
    if (tid >= 64 && tid < 64 + R2_NS) *(volatile LAS3 unsigned*)(LAS3 unsigned char*)(L + (tid - 64) * R2_SLOT + 12288 + 252) = 0xffffffffu;
    __syncthreads();
    const bf16* MC = (const bf16*)(a.ws + WS_MC); const float* NC = (const float*)(a.ws + WS_NC); const float* DEC = (const float*)(a.ws + WS_DEC);
    if (wave != 0) {
        int mco[8], nco[4];
#pragma unroll
        for (int q = 0; q < 8; ++q) { const int pos = 64 * q + lane, row = pos >> 3, kc = (pos & 7) ^ (row & 7); mco[q] = row * 64 + kc * 8; }
#pragma unroll
        for (int q = 0; q < 4; ++q) { const int pos = 64 * q + lane, e = pos >> 4, dc = (pos & 15) ^ e; nco[q] = (e0 + e) * 64 + dc * 4; }
#pragma unroll 1
        for (int c = wave - 1; c < 128; c += 7) {
            while ((int)flg[16] < c - (R2_NS - 1)) __builtin_amdgcn_s_sleep(12);
            LAS3 unsigned char* slot = (LAS3 unsigned char*)(L + (c % R2_NS) * R2_SLOT);
            const size_t unit = (size_t)c * 8 + h;
#pragma unroll
            for (int q = 0; q < 8; ++q) __builtin_amdgcn_global_load_lds((const unsigned*)(MC + unit * 4096 + mco[q]), (LAS3 unsigned*)(slot + q * 1024), 16, 0, 0);
#pragma unroll
            for (int q = 0; q < 4; ++q) __builtin_amdgcn_global_load_lds((const unsigned*)(NC + unit * 4096 + nco[q]), (LAS3 unsigned*)(slot + 8192 + q * 1024), 16, 0, 0);
            __builtin_amdgcn_global_load_lds((const unsigned*)(DEC + unit * 64 + lane), (LAS3 unsigned*)(slot + 12288), 4, 0, 0);
        }
        asm volatile("s_waitcnt vmcnt(0)" ::: "memory");
    } else {
        bf16* S0 = (bf16*)(a.ws + WS_S0) + (size_t)h * 4096 + (e0 + c16) * 64 + 4 * g;
        f32x4 S[4];
#pragma unroll
        for (int m = 0; m < 4; ++m) S[m] = (f32x4){0.f, 0.f, 0.f, 0.f};
        int avail = 0;
        const LAS3 unsigned char* Lb = (const LAS3 unsigned char*)L;
        const int offA0 = (c16 * 8 + (g ^ (c16 & 7))) * 16, offA1 = (c16 * 8 + ((4 + g) ^ (c16 & 7))) * 16;
        int offN[4];
#pragma unroll
        for (int mt = 0; mt < 4; ++mt) offN[mt] = 8192 + (c16 * 16 + ((4 * mt + g) ^ c16)) * 16;
        const int offD = 12288 + 16 * g;
#define R2_MARKS(s_) (*(volatile LAS3 unsigned*)(LAS3 unsigned char*)(L + (s_) * R2_SLOT + 12288 + 252))
#define R2_WAITS(c_, s_) do { while (avail <= (c_)) { const unsigned f0_ = R2_MARKS(s_), f1_ = R2_MARKS(((s_) + 1) % R2_NS), f2_ = R2_MARKS(((s_) + 2) % R2_NS); \
            if (f0_ != 0xffffffffu) { avail = (c_) + 1; if (f1_ != 0xffffffffu) { avail = (c_) + 2; if (f2_ != 0xffffffffu) avail = (c_) + 3; } } \
            else __builtin_amdgcn_s_sleep(0); } asm volatile("" ::: "memory"); } while (0)
        v4u A[2][4][2]; f32x4 Nn[2][4], Dd[2][4];
#define R2_READS(s_, p_) do { _Pragma("unroll") for (int mt = 0; mt < 4; ++mt) { \
                A[p_][mt][0] = *(const LAS3 v4u*)(Lb + (s_) * R2_SLOT + mt * 2048 + offA0); A[p_][mt][1] = *(const LAS3 v4u*)(Lb + (s_) * R2_SLOT + mt * 2048 + offA1); \
                Nn[p_][mt] = *(const LAS3 f32x4*)(Lb + (s_) * R2_SLOT + offN[mt]); Dd[p_][mt] = *(const LAS3 f32x4*)(Lb + (s_) * R2_SLOT + mt * 64 + offD); } } while (0)
        R2_WAITS(0, 0); R2_READS(0, 0);
        asm volatile("s_waitcnt lgkmcnt(0)" ::: "memory");
#pragma unroll 1
        for (int c0 = 0; c0 < 128; c0 += R2_NS) {
#pragma unroll
            for (int k = 0; k < R2_NS; ++k) { const int c = c0 + k;
                if (c < 128) {
                    R2_MARKS(k) = 0xffffffffu; flg[16] = (unsigned)(c + 1);
                    if (c + 1 < 128) { R2_WAITS(c + 1, (k + 1) % R2_NS); R2_READS((k + 1) % R2_NS, (k + 1) & 1); }
                    bf16* sp = S0 + (size_t)c * (8 * 4096); v2u sb[4];
#pragma unroll
                    for (int m = 0; m < 4; ++m) { sb[m] = pack4(S[m]); *(v2u*)(sp + 16 * m) = sb[m]; }
                    const v4u b0 = {sb[0].x, sb[0].y, sb[1].x, sb[1].y}, b1 = {sb[2].x, sb[2].y, sb[3].x, sb[3].y};
                    const bf16x8 B0 = __builtin_bit_cast(bf16x8, b0), B1 = __builtin_bit_cast(bf16x8, b1);
                    f32x4 acc[4];
#pragma unroll
                    for (int mt = 0; mt < 4; ++mt) acc[mt] = __builtin_amdgcn_mfma_f32_16x16x32_bf16(__builtin_bit_cast(bf16x8, A[k & 1][mt][0]), B0, Nn[k & 1][mt] + S[mt] * Dd[k & 1][mt], 0, 0, 0);
#pragma unroll
                    for (int mt = 0; mt < 4; ++mt) S[mt] = __builtin_amdgcn_mfma_f32_16x16x32_bf16(__builtin_bit_cast(bf16x8, A[k & 1][mt][1]), B1, acc[mt], 0, 0, 0);
                    asm volatile("s_waitcnt lgkmcnt(0)" ::: "memory");
                } }
        }
#undef R2_WAITS
#undef R2_MARKS
#undef R2_READS
#define R2_READ 0
#undef R2_READ
    }
    __syncthreads();
}

__device__ __forceinline__ void r3_phase(CArgs& a, size_t uo, int l, int hb, int gw, int NGW, int lane) {
    asm volatile("" : "+v"(lane));
    const int g = lane >> 4, c16 = lane & 15;
    const bf16* U = (const bf16*)(a.ws + WS_U + uo); const bf16* PP = (const bf16*)(a.ws + WS_PP); const bf16* S0 = (const bf16*)(a.ws + WS_S0); const bf16* Y0 = (const bf16*)(a.ws + WS_Y0);
    const float* BON = (const float*)(a.ws + WS_BON2); bf16* MG = (bf16*)(a.ws + WS_XN) + (size_t)hb * MH * D;
    const float* mu_v = a.in[6] + l * 1664 + 1024; const float* lnw = a.in[14] + l * 512; const float* lnb = a.in[15] + l * 512;
    const int erow = 16 * (c16 >> 2) + (c16 & 3);
#pragma unroll 1
    for (int task = gw; task < NUNIT * 4; task += NGW) {
        const int unit = task >> 2, mt = task & 3, ch = unit >> 3, h = unit & 7; const size_t ub = (size_t)unit * 4096;
        const int lr = 64 * ch + 16 * mt + c16; const bf16* urow = U + (size_t)lr * NPAD + 64 * h + 16 * g;
        float vc[16], vp[16], rgf[16];
        unpack8(*(const v4u*)(urow + C_V), vc); unpack8(*(const v4u*)(urow + C_V + 8), vc + 8); unpack8(*(const v4u*)(urow + C_RG), rgf); unpack8(*(const v4u*)(urow + C_RG + 8), rgf + 8);
        if (lr > 0) { unpack8(*(const v4u*)(urow + C_V - NPAD), vp); unpack8(*(const v4u*)(urow + C_V + 8 - NPAD), vp + 8); }
        else {
#pragma unroll
            for (int i = 0; i < 16; ++i) vp[i] = 0.f; }
        const float bon = BON[lr * 8 + h];
        const bf16* pr = PP + ub + (16 * mt + c16) * 64 + 8 * g;
        const bf16x8 B0 = *(const bf16x8*)pr, B1 = *(const bf16x8*)(pr + 32);
        f32x4 Y[4]; bf16x8 SA[4][2];
#pragma unroll
        for (int et = 0; et < 4; ++et) { const bf16* sr = S0 + ub + (erow + 4 * et) * 64 + 8 * g; SA[et][0] = *(const bf16x8*)sr; SA[et][1] = *(const bf16x8*)(sr + 32); }
        const bf16* y0p = Y0 + ub + (16 * mt + c16) * 64 + 16 * g; const v4u y0a = *(const v4u*)y0p, y0b = *(const v4u*)(y0p + 8);
        asm volatile("" ::: "memory");
        { float yf[16]; unpack8(y0a, yf); unpack8(y0b, yf + 8);
#pragma unroll
          for (int et = 0; et < 4; ++et) Y[et] = (f32x4){yf[4 * et], yf[4 * et + 1], yf[4 * et + 2], yf[4 * et + 3]}; }
#pragma unroll
        for (int et = 0; et < 4; ++et) { f32x4 acc = __builtin_amdgcn_mfma_f32_16x16x32_bf16(SA[et][0], B0, Y[et], 0, 0, 0);
            Y[et] = __builtin_amdgcn_mfma_f32_16x16x32_bf16(SA[et][1], B1, acc, 0, 0, 0); }
        const f32x4 sv = (Y[0] + Y[1]) + (Y[2] + Y[3]); float sm = (sv.x + sv.y) + (sv.z + sv.w); sm += __shfl_xor(sm, 16); sm += __shfl_xor(sm, 32);
        const float mean = sm * (1.f / 64.f); float q = 0.f;
#pragma unroll
        for (int et = 0; et < 4; ++et) { const f32x4 dd = Y[et] - mean; q += (dd.x * dd.x + dd.y * dd.y) + (dd.z * dd.z + dd.w * dd.w); }
        q += __shfl_xor(q, 16); q += __shfl_xor(q, 32);
        const float rstd = rsqrtf(q * (1.f / 64.f) + 64e-5f);
        const int cc = 64 * h + 16 * g; float o[16];
#pragma unroll
        for (int et = 0; et < 4; ++et) {
            const f32x4 w4 = *(const f32x4*)(lnw + cc + 4 * et), b4 = *(const f32x4*)(lnb + cc + 4 * et), m4 = *(const f32x4*)(mu_v + cc + 4 * et);
#pragma unroll
            for (int j = 0; j < 4; ++j) { const int i = 4 * et + j; const float vv = vc[i] + (vp[i] - vc[i]) * m4[j]; const float yn = (Y[et][j] - mean) * rstd * w4[j] + b4[j];
                o[i] = (yn + bon * vv) * rgf[i] * sigm(rgf[i]); } }
        bf16* op = MG + (size_t)lr * D + 512 + cc; *(v4u*)op = pack8(o); *(v4u*)(op + 8) = pack8(o + 8);
    }
}

constexpr int OFF_GQI = 17408, OFF_GKI = 26624, OFF_GKST = 35840, OFF_GVT = 45056, OFF_GSC = 63488, OFF_GTOT = 72704, OFF_GBC = 74752;
constexpr size_t WS_QI = 163 * MiB, WS_OI = 167 * MiB, WS_DS = 175 * MiB, WS_GDEC = 183 * MiB, WS_SP = 184 * MiB;
constexpr int NGUNIT = 512;

__device__ __forceinline__ void g1_phase(CArgs& a, size_t uo, int l, unsigned char* L, int tid0, int ufirst, int ustride) {
    asm volatile("" : "+v"(tid0));
    const int wave = __builtin_amdgcn_readfirstlane(tid0 >> 6);
    const bf16* U = (const bf16*)(a.ws + WS_U + uo);
    float* XW = (float*)L; bf16* QI = (bf16*)(L + OFF_GQI); bf16* KI = (bf16*)(L + OFF_GKI); bf16* KST = (bf16*)(L + OFF_GKST); bf16* VT = (bf16*)(L + OFF_GVT); bf16* SC = (bf16*)(L + OFF_GSC);
    float* TOT = (float*)(L + OFF_GTOT); float* BC = (float*)(L + OFF_GBC);
    float* GW = (float*)(L + OFF_GBC + 256);
    int hl = -1;
    v4u Gl0, Gl1, Gq, Gk, Gv0, Gv1;
#define G1_ISSUE(u_) do { const int lr_ = 64 * ((u_) >> 2) + (tid >> 3), h_ = (u_) & 3, dg_ = tid & 7; const bf16* ur_ = U + (size_t)lr_ * NPAD; \
        Gl0 = *(const v4u*)(ur_ + C_GLR); Gl1 = *(const v4u*)(ur_ + C_GLR + 8); Gq = *(const v4u*)(ur_ + C_GQ + 64 * h_ + 8 * dg_); Gk = *(const v4u*)(ur_ + C_GK + 64 * h_ + 8 * dg_); \
        Gv0 = *(const v4u*)(ur_ + C_GV + 128 * h_ + 16 * dg_); Gv1 = *(const v4u*)(ur_ + C_GV + 128 * h_ + 16 * dg_ + 8); } while (0)
#pragma unroll 1
    for (int unit = ufirst; unit < NGUNIT; unit += ustride) {
        int tid = tid0; asm volatile("" : "+v"(tid));
        const int lane = tid & 63, g = lane >> 4, c16 = lane & 15;
        const int ch = unit >> 2, h = unit & 3;
        if (h != hl) { hl = h; LBAR();
            for (int i = tid; i < 16 * 64; i += NTHR) GW[i] = a.in[3][l * 16 * 256 + (i >> 6) * 256 + 64 * h + (i & 63)];
            if (tid < 64) GW[1024 + tid] = a.in[4][l * 256 + 64 * h + tid];
            LBAR(); }
        const int t = tid >> 3, dg = tid & 7, d0 = 8 * dg, lr = 64 * ch + t, hc = 64 * h + d0;
        if (unit == ufirst) G1_ISSUE(unit);
        float q[8], k[8];
        {
            float glr[16]; unpack8(Gl0, glr); unpack8(Gl1, glr + 8);
            float x[8]; const float* gb = GW + 1024 + d0; const float* gu = GW + d0;
#pragma unroll
            for (int i = 0; i < 8; ++i) x[i] = gb[i];
#pragma unroll
            for (int r = 0; r < 16; ++r) { const f32x4 u0 = *(const f32x4*)(gu + r * 64), u1 = *(const f32x4*)(gu + r * 64 + 4);
                x[0] += glr[r] * u0.x; x[1] += glr[r] * u0.y; x[2] += glr[r] * u0.z; x[3] += glr[r] * u0.w; x[4] += glr[r] * u1.x; x[5] += glr[r] * u1.y; x[6] += glr[r] * u1.z; x[7] += glr[r] * u1.w; }
#pragma unroll
            for (int i = 0; i < 8; ++i) XW[t * FP + d0 + i] = (fminf(x[i], 0.f) - __logf(1.f + __expf(-fabsf(x[i])))) * (1.f / 16.f);
            unpack8(Gq, q); unpack8(Gk, k);
            float vv[16]; const int e0 = 16 * dg; unpack8(Gv0, vv); unpack8(Gv1, vv + 8);
            asm volatile("" ::: "memory");
            if (unit + ustride < NGUNIT) G1_ISSUE(unit + ustride);
#pragma unroll
            for (int i = 0; i < 16; ++i) VT[SWC(e0 + i, t)] = (bf16)f2bf(vv[i]);
        }
        LBAR();
        {
            const int d = tid & 63, tb = tid >> 6; float p[8]; float run = 0.f;
#pragma unroll
            for (int i = 0; i < 8; ++i) { run += XW[(8 * tb + i) * FP + d]; p[i] = run; }
            TOT[tb * 64 + d] = run;
            LBAR();
            float off = 0.f;
#pragma unroll
            for (int j = 0; j < 8; ++j) off += (j < tb) ? TOT[j * 64 + d] : 0.f;
#pragma unroll
            for (int i = 0; i < 8; ++i) XW[(8 * tb + i) * FP + d] = off + p[i];
            if (tb == 7) BC[d] = off + run;
        }
        LBAR();
        {
            float qi[8], ki[8];
#pragma unroll
            for (int i = 0; i < 8; ++i) { const float b = XW[t * FP + d0 + i], bc = BC[d0 + i];
                qi[i] = q[i] * 0.125f * __expf(b); ki[i] = k[i] * __expf(-b); KST[SWC(d0 + i, t)] = (bf16)f2bf(k[i] * __expf(bc - b)); }
            const v4u qp = pack8(qi);
            *(v4u*)(QI + t * PITCH + d0) = qp; *(v4u*)(KI + t * PITCH + d0) = pack8(ki);
            *(v4u*)((bf16*)(a.ws + WS_QI) + (size_t)unit * 4096 + t * 64 + d0) = qp;
        }
        LBAR();
        {
            const int tt = wave >> 1; const int tcol = 16 * tt + c16;
#pragma unroll
            for (int j2 = 0; j2 < 2; ++j2) { const int jt = 2 * (wave & 1) + j2; f32x4 acc = {0.f, 0.f, 0.f, 0.f};
                if (jt <= tt) { acc = mma2(KI + (16 * jt + c16) * PITCH + 8 * g, QI + tcol * PITCH + 8 * g, acc);
#pragma unroll
                    for (int j = 0; j < 4; ++j) if (16 * jt + 4 * g + j > tcol) acc[j] = 0.f; }
                *(v2u*)(SC + tcol * PITCH + 16 * jt + 4 * g) = pack4(acc); }
            bf16* DSg = (bf16*)(a.ws + WS_DS) + (size_t)unit * 8192;
#pragma unroll
            for (int i = 0; i < 4; ++i) { const int tile = wave * 4 + i, dt = tile & 3, et = tile >> 2; f32x4 acc = {0.f, 0.f, 0.f, 0.f};
                { const int ar = 16 * dt + c16, br = 16 * et + c16; acc = mma2s(KST + ar * PITCH, SWK(ar), VT + br * PITCH, SWK(br), g, acc); }
                *(v2u*)(DSg + (16 * et + c16) * 64 + 16 * dt + 4 * g) = pack4(acc); }
            if (tid < 64) ((float*)(a.ws + WS_GDEC))[unit * 64 + tid] = __expf(BC[tid]);
        }
        LBAR();
        {
            bf16* OIg = (bf16*)(a.ws + WS_OI) + (size_t)unit * 8192;
#pragma unroll
            for (int i = 0; i < 4; ++i) { const int tile = wave * 4 + i, tt = tile & 3, et = tile >> 2; f32x4 acc = {0.f, 0.f, 0.f, 0.f};
                { const int ar = 16 * et + c16; acc = mma2s(VT + ar * PITCH, SWK(ar), SC + (16 * tt + c16) * PITCH, 0, g, acc); }
                *(v2u*)(OIg + (16 * tt + c16) * 128 + 16 * et + 4 * g) = pack4(acc); }
        }
        LBAR();
    }
}

__device__ __forceinline__ void g2_scan(CArgs& a, int wg, unsigned char* L, int tid) {
    asm volatile("" : "+v"(tid));
    const int h = wg >> 2, e = 32 * (wg & 3) + (tid >> 4), dq = tid & 15;
    const bf16* DS = (const bf16*)(a.ws + WS_DS) + (size_t)h * 8192 + e * 64 + 4 * dq; const float* GD = (const float*)(a.ws + WS_GDEC) + (size_t)(((tid >> 4) & 15) * 4 + h) * 64 + 4 * dq;
    bf16* SP = (bf16*)(a.ws + WS_SP) + (size_t)h * 8192 + e * 64 + 4 * dq;
    float* DCL = (float*)L;
    v2u dsb[2][16]; f32x4 dcr;
    f32x4 S = {0.f, 0.f, 0.f, 0.f};
#pragma unroll
    for (int i = 0; i < 16; ++i) dsb[0][i] = *(const v2u*)(DS + (size_t)i * (4 * 8192));
    dcr = *(const f32x4*)GD;
    if (tid < 256) *(f32x4*)(DCL + (tid >> 4) * 64 + 4 * dq) = dcr;
#pragma unroll 1
    for (int b2 = 0; b2 < 8; b2 += 2) {
#pragma unroll
        for (int bb = 0; bb < 2; ++bb) { const int b = b2 + bb;
            if (b + 1 < 8) {
#pragma unroll
                for (int i = 0; i < 16; ++i) dsb[(bb + 1) & 1][i] = *(const v2u*)(DS + (size_t)(16 * (b + 1) + i) * (4 * 8192));
                dcr = *(const f32x4*)(GD + (size_t)(16 * (b + 1)) * (4 * 64)); }
            LBAR();
            const float* dcl = DCL + bb * 1024 + 4 * dq;
#pragma unroll
            for (int i = 0; i < 16; ++i) { const f32x4 dc = *(const f32x4*)(dcl + i * 64); const v2u w = dsb[bb][i];
                *(v2u*)(SP + (size_t)(16 * b + i) * (4 * 8192)) = pack4(S);
                const f32x4 dv = {bf2f(w.x & 0xffffu), bf2f(w.x >> 16), bf2f(w.y & 0xffffu), bf2f(w.y >> 16)};
                S = S * dc + dv; }
            if (b + 1 < 8 && tid < 256) *(f32x4*)(DCL + ((bb + 1) & 1) * 1024 + (tid >> 4) * 64 + 4 * dq) = dcr;
        }
    }
    LBAR();
}

__device__ __forceinline__ void g3_phase(CArgs& a, size_t uo, int l, int hb, int gw, int NGW, int lane) {
    asm volatile("" : "+v"(lane));
    const int g = lane >> 4, c16 = lane & 15;
    const bf16* U = (const bf16*)(a.ws + WS_U + uo); const bf16* QI = (const bf16*)(a.ws + WS_QI); const bf16* SP = (const bf16*)(a.ws + WS_SP); const bf16* OI = (const bf16*)(a.ws + WS_OI);
    bf16* MG = (bf16*)(a.ws + WS_XN) + (size_t)hb * MH * D; const float* gnw = a.in[5] + l * 128;
    const int erow = 32 * (c16 >> 2) + (c16 & 3);
#pragma unroll 1
    for (int task = gw; task < NGUNIT * 4; task += NGW) {
        const int unit = task >> 2, mt = task & 3, ch = unit >> 2, h = unit & 3;
        const int lr = 64 * ch + 16 * mt + c16; const bf16* urow = U + (size_t)lr * NPAD + C_GG + 128 * h + 32 * g;
        const v4u gg0 = *(const v4u*)urow, gg1 = *(const v4u*)(urow + 8), gg2 = *(const v4u*)(urow + 16), gg3 = *(const v4u*)(urow + 24);
        const bf16* qr = QI + (size_t)unit * 4096 + (16 * mt + c16) * 64 + 8 * g;
        const bf16x8 B0 = *(const bf16x8*)qr, B1 = *(const bf16x8*)(qr + 32);
        f32x4 O[8]; float ss = 0.f; bf16x8 SA[8][2];
#pragma unroll
        for (int et = 0; et < 8; ++et) { const bf16* sr = SP + (size_t)unit * 8192 + (erow + 4 * et) * 64 + 8 * g; SA[et][0] = *(const bf16x8*)sr; SA[et][1] = *(const bf16x8*)(sr + 32); }
        const bf16* oip = OI + (size_t)unit * 8192 + (16 * mt + c16) * 128 + 32 * g; const v4u oi0 = *(const v4u*)oip, oi1 = *(const v4u*)(oip + 8), oi2 = *(const v4u*)(oip + 16), oi3 = *(const v4u*)(oip + 24);
        asm volatile("" ::: "memory");
        { float of[32]; unpack8(oi0, of); unpack8(oi1, of + 8); unpack8(oi2, of + 16); unpack8(oi3, of + 24);
#pragma unroll
          for (int et = 0; et < 8; ++et) O[et] = (f32x4){of[4 * et], of[4 * et + 1], of[4 * et + 2], of[4 * et + 3]}; }
#pragma unroll
        for (int et = 0; et < 8; ++et) { f32x4 acc = __builtin_amdgcn_mfma_f32_16x16x32_bf16(SA[et][0], B0, O[et], 0, 0, 0);
            acc = __builtin_amdgcn_mfma_f32_16x16x32_bf16(SA[et][1], B1, acc, 0, 0, 0);
            O[et] = acc; ss += (acc.x * acc.x + acc.y * acc.y) + (acc.z * acc.z + acc.w * acc.w); }
        ss += __shfl_xor(ss, 16); ss += __shfl_xor(ss, 32);
        const float rstd = rsqrtf(ss * (1.f / 128.f) + 1e-6f);
        float gf[32], o[32]; unpack8(gg0, gf); unpack8(gg1, gf + 8); unpack8(gg2, gf + 16); unpack8(gg3, gf + 24);
#pragma unroll
        for (int et = 0; et < 8; ++et) { const f32x4 w4 = *(const f32x4*)(gnw + 32 * g + 4 * et);
#pragma unroll
            for (int j = 0; j < 4; ++j) { const int i = 4 * et + j; o[i] = O[et][j] * rstd * w4[j] * gf[i] * sigm(gf[i]); } }
        bf16* op = MG + (size_t)lr * D + 128 * h + 32 * g;
        *(v4u*)op = pack8(o); *(v4u*)(op + 8) = pack8(o + 8); *(v4u*)(op + 16) = pack8(o + 16); *(v4u*)(op + 24) = pack8(o + 24);
    }
}

#define LAS __attribute__((address_space(3)))
#define XB_TMO      128
#define XB_XCNT(j)  (256  + 64 * (j))
#define XB_XSUB(j)  (1280 + 64 * (j))
#define XB_XGEN(j)  (2304 + 64 * (j))
#define XB_TOP      3328
#define XB_TOPGEN   3392
#define XCD_BAR_WORDS 3456
#define XB_SPIN_CAP (1u << 18)

__device__ __forceinline__ unsigned xb_ld(unsigned* p)              { return __hip_atomic_load(p, __ATOMIC_RELAXED, __HIP_MEMORY_SCOPE_AGENT); }
__device__ __forceinline__ unsigned xb_add(unsigned* p, unsigned v) { return __hip_atomic_fetch_add(p, v, __ATOMIC_RELAXED, __HIP_MEMORY_SCOPE_AGENT); }
__device__ __forceinline__ unsigned xb_xcc_id() { return (unsigned)__builtin_amdgcn_s_getreg((3 << 11) | 20) & 0xFu; }
#define XB_SPIN(cond, bar) do { unsigned _sp = 0; while (cond) { __builtin_amdgcn_s_sleep(1); \
    if ((++_sp & 255u) == 0u) { if (xb_ld(&(bar)[XB_TMO])) break; if (_sp > XB_SPIN_CAP) { atomicAdd(&(bar)[XB_TMO], 1u); break; } } } } while (0)

struct XcdBarrier {
    unsigned* bar; unsigned x;
    volatile LAS unsigned* st;
};

__device__ __forceinline__ XcdBarrier xcd_barrier_post(unsigned* bar, volatile LAS unsigned* st) {
    XcdBarrier b; b.bar = bar; b.x = xb_xcc_id(); b.st = st;
    if (threadIdx.x == 0) (void)xb_add(&bar[XB_XCNT(b.x)], 1u);
    return b;
}
__device__ __forceinline__ void xcd_barrier_complete(unsigned* bar, unsigned x, unsigned& nloc, unsigned& nx) {
    const unsigned G = gridDim.x * gridDim.y * gridDim.z;
    unsigned sum, cnt, mine, sp = 0u;
    for (;;) {
        sum = 0u; cnt = 0u; mine = 0u;
#pragma unroll
        for (unsigned j = 0; j < 16; ++j) { const unsigned c = xb_ld(&bar[XB_XCNT(j)]); sum += c; cnt += (c > 0u) ? 1u : 0u; mine = (j == x) ? c : mine; }
        if (sum == G) break;
        __builtin_amdgcn_s_sleep(1);
        if ((++sp & 255u) == 0u) { if (xb_ld(&bar[XB_TMO])) break; if (sp > XB_SPIN_CAP) { atomicAdd(&bar[XB_TMO], 1u); break; } }
    }
    nloc = mine > 0u ? mine : 1u; nx = cnt > 0u ? cnt : 1u;
}

__device__ __forceinline__ void xcd_barrier(const XcdBarrier& b) {
    asm volatile("s_waitcnt vmcnt(0)" ::: "memory");
    __syncthreads();
    if (threadIdx.x == 0) {
        unsigned* bar = b.bar;
        __builtin_amdgcn_s_waitcnt(0);
        unsigned nloc = b.st[0], nx = b.st[1];
        if (nloc == 0u) { xcd_barrier_complete(bar, b.x, nloc, nx); b.st[0] = nloc; b.st[1] = nx; }
        const unsigned old = xb_add(&bar[XB_XSUB(b.x)], 1u);
        const unsigned gen = old / nloc;
        if (old + 1u == (gen + 1u) * nloc) {
            __builtin_amdgcn_fence(__ATOMIC_RELEASE, "agent");
            asm volatile("s_waitcnt vmcnt(0)" ::: "memory");
            const unsigned og = xb_add(&bar[XB_TOP], 1u);
            const unsigned tg = og / nx;
            if (og + 1u == (tg + 1u) * nx) xb_add(&bar[XB_TOPGEN], 1u);
            else XB_SPIN(xb_ld(&bar[XB_TOPGEN]) == tg, bar);
            __builtin_amdgcn_fence(__ATOMIC_ACQUIRE, "agent");
            xb_add(&bar[XB_XGEN(b.x)], 1u);
            asm volatile("s_waitcnt vmcnt(0)" ::: "memory");
        } else {
            XB_SPIN(xb_ld(&bar[XB_XGEN(b.x)]) == gen, bar);
            __builtin_amdgcn_fence(__ATOMIC_ACQUIRE, "agent");
            asm volatile("s_waitcnt vmcnt(0)" ::: "memory");
        }
    }
    __syncthreads();
}


__global__ void __launch_bounds__(NTHR, 2) hymba_fwd(Args a_kernarg) {
    extern __shared__ __attribute__((aligned(16))) unsigned char lds[];
    cg::grid_group grid = cg::this_grid();
    const int tid = threadIdx.x, lane = tid & 63, wave = __builtin_amdgcn_readfirstlane(tid >> 6);
    const int G = gridDim.x, gw = blockIdx.x * NWAVES + wave, NGW = G * NWAVES;
    volatile LAS unsigned* xst = (volatile LAS unsigned*)(LAS unsigned char*)(lds + LDS_BYTES - 64);
    if (tid < 2) xst[tid] = 0u;
    __syncthreads();
    const XcdBarrier xbar = xcd_barrier_post((unsigned*)AA.ws, xst);
    {
        CArgs& a = AA; bf16* XN = (bf16*)(a.ws + WS_XN);
        float* scr = (float*)lds;
        constexpr int T_IN = (D / 64) * (NPAD / 64), T_OUT = (D / 64) * (D / 64);
        for (int l = 0; l < 2; ++l) {
            transpose_tiles(a.in[2] + (size_t)l * D * NIN, D, NIN, NPAD, (bf16*)(a.ws + WS_WIN + l * WIN_BYTES), scr, (int)blockIdx.x, G, T_IN, tid);
            transpose_tiles(a.in[16] + (size_t)l * D * D, D, D, D, (bf16*)(a.ws + WS_WOUT + l * WOUT_BYTES), scr, (int)blockIdx.x, G, T_OUT, tid);
        }
        for (int m = 2 * gw; m < M; m += 2 * NGW) rms_row2(a.in[0] + (size_t)m * D, a.in[0] + (size_t)(m + 1) * D, a.in[1], XN + (size_t)m * D, XN + (size_t)(m + 1) * D, lane);
        {
            bf16* UPT = (bf16*)(a.ws + WS_UPT);
            for (int e = blockIdx.x * NTHR + tid; e < 2 * 2 * 512 * 64; e += G * NTHR) { const int r = e & 63, c = (e >> 6) & 511, q = (e >> 15) & 1, ll = e >> 16;
                UPT[e] = (bf16)f2bf((q ? a.in[10] : a.in[8])[(size_t)ll * 64 * 512 + r * 512 + c]); }
        }
    }
    if (AA.ws == nullptr) grid.sync();
    xcd_barrier(xbar);
    for (int l = 0; l < 2; ++l) {
        for (int hb = 0; hb < 2; ++hb) {
            {
                CArgs& a = AA; bf16* XN = (bf16*)(a.ws + WS_XN); bf16* U = (bf16*)(a.ws + WS_U + (size_t)hb * U_STRIDE);
                pg8::Gemm g{XN + (size_t)hb * MH * D, (const bf16*)(a.ws + WS_WIN + l * WIN_BYTES), MH, NPAD, D}; pg8::RangeOrder S;
                if (hb == 0) S.init(MH, NPAD, G, (int)blockIdx.x, 0, 480); else S.init(MH, NPAD, G, (int)blockIdx.x, EARLY_TILES, 480 - EARLY_TILES);
                pg8::EpiBf16<0> E{U, NPAD, nullptr, 0, 0, 1.f};
                pg8::gemm_phase<pg8::EpiBf16<0>, pg8::RangeOrder, true, true>((PG8_LAS unsigned char*)lds, g, S, E);
            }
            xcd_barrier(xbar);
            const size_t uo = (size_t)hb * U_STRIDE;
            r1_phase(AA, uo, l, lds, tid);
            g1_phase(AA, uo, l, lds, tid, (int)blockIdx.x, G);
            xcd_barrier(xbar);
            if (blockIdx.x < 32) r2_scan(AA, blockIdx.x, lds, tid);
            else { if (blockIdx.x < 48) g2_scan(AA, blockIdx.x - 32, lds, tid);
                if (hb == 0) {
                    CArgs& a = AA; bf16* XN = (bf16*)(a.ws + WS_XN); bf16* U1 = (bf16*)(a.ws + WS_U1);
                    pg8::Gemm g{XN + (size_t)MH * D, (const bf16*)(a.ws + WS_WIN + l * WIN_BYTES), MH, NPAD, D}; pg8::RangeOrder S; S.init(MH, NPAD, G, (int)blockIdx.x - 32, 0, EARLY_TILES);
                    pg8::EpiBf16<0> E{U1, NPAD, nullptr, 0, 0, 1.f};
                    pg8::gemm_phase<pg8::EpiBf16<0>, pg8::RangeOrder, true, true>((PG8_LAS unsigned char*)lds, g, S, E); } }
            xcd_barrier(xbar);
            r3_phase(AA, uo, l, hb, gw, NGW, lane);
            g3_phase(AA, uo, l, hb, gw, NGW, lane);
            if (hb == 1) xcd_barrier(xbar);
        }
        {
            CArgs& a = AA; bf16* XN = (bf16*)(a.ws + WS_XN);
            pg8::Gemm g{XN, (const bf16*)(a.ws + WS_WOUT + l * WOUT_BYTES), M, D, D}; pg8::StaticOrder S; S.init(M, D, G, (int)blockIdx.x);
            pg8::EpiRmsRes E{l == 0 ? a.in[0] : a.out, a.out, XN, l == 0 ? a.in[1] + D : a.in[17], (float*)(a.ws + WS_SLOTS) + (size_t)l * M * 4, (unsigned*)(a.ws + 16384) + l * 64 * 64, D, l};
            pg8::gemm_phase<pg8::EpiRmsRes, pg8::StaticOrder, false, true>((PG8_LAS unsigned char*)lds, g, S, E);
        }
        if (l == 0) xcd_barrier(xbar);
    }
}

extern "C" void kernel_launch(void* const* d_in, const int* in_sizes, int n_in, void* d_out, int out_size, void* d_ws, size_t ws_size, hipStream_t stream) {
    static int grid = 0;
    if (grid == 0) {
        if (n_in != 18 || out_size != M * D || ws_size < WS_END) { fprintf(stderr, "kernel_launch: unexpected shapes n_in %d out %d ws %zu\n", n_in, out_size, ws_size); grid = -1; return; }
        int dev = 0, cus = 0, per_cu = 0;
        hipGetDevice(&dev); hipDeviceGetAttribute(&cus, hipDeviceAttributeMultiprocessorCount, dev);
        if (hipFuncSetAttribute((const void*)hymba_fwd, hipFuncAttributeMaxDynamicSharedMemorySize, LDS_BYTES) != hipSuccess) { fprintf(stderr, "kernel_launch: hipFuncSetAttribute failed\n"); grid = -1; return; }
        if (hipOccupancyMaxActiveBlocksPerMultiprocessor(&per_cu, (const void*)hymba_fwd, NTHR, LDS_BYTES) != hipSuccess || per_cu < 1) { fprintf(stderr, "kernel_launch: occupancy query failed (%d)\n", per_cu); grid = -1; return; }
        grid = cus * 1;
        fprintf(stderr, "kernel_launch: cus %d per_cu %d grid %d\n", cus, per_cu, grid);
    }
    if (grid < 0) return;
    if (hipMemsetAsync(d_ws, 0, 65536, stream) != hipSuccess) { fprintf(stderr, "kernel_launch: memset failed\n"); return; }
    Args a{};
    for (int i = 0; i < 18; ++i) a.in[i] = (const float*)d_in[i];
    a.out = (float*)d_out; a.ws = (unsigned char*)d_ws;
    void* args[] = {&a};
    hipError_t e = hipLaunchCooperativeKernel((const void*)hymba_fwd, dim3(grid), dim3(NTHR), args, LDS_BYTES, stream);
    if (e != hipSuccess) fprintf(stderr, "cooperative launch failed: %s (grid %d)\n", hipGetErrorString(e), grid);
}
```

```cpp
#include <hip/hip_runtime.h>
#include <hip/hip_cooperative_groups.h>
#include <cstdio>
#include <cstdint>
namespace cg = cooperative_groups;
namespace pg8 {
#define PG8_LAS __attribute__((address_space(3)))
typedef unsigned short bf16_t;
typedef short bf16x8 __attribute__((ext_vector_type(8)));
typedef float f32x4 __attribute__((ext_vector_type(4)));
typedef unsigned u32x4 __attribute__((ext_vector_type(4)));
constexpr int BM = 256, BK = 64, HALF = 128, HTB = HALF * BK * 2  , STAGE_BYTES = 8 * HTB, NXCD = 8, WGM = 8;

__host__ __device__ __forceinline__ int lds_byte(int r, int c) { const int st = (r >> 4) * 2 + (c >> 5), rr = r & 15, cc = c & 31, ob = rr * 64 + cc * 2; return st * 1024 + (ob ^ (((ob >> 9) & 1) << 5)); }
__host__ __device__ __forceinline__ void stage_rc(int b, int& R, int& C) { const int st = b / 1024, sb = b % 1024, swz = sb ^ (((sb >> 9) & 1) << 5); R = (st >> 1) * 16 + swz / 64; C = (st & 1) * 32 + (swz % 64) / 2; }
__host__ __device__ __forceinline__ int perm32(int rho) { const int n = rho >> 4, i = rho & 15; return 8 * (i >> 2) + 4 * n + (i & 3); }

struct Unit { int pm, pn; };
struct Gemm { const bf16_t* A; const bf16_t* Bt; int M, N, K; };

struct StaticOrder {
    int nM, nN, nwg, G, c;
    __host__ __device__ void init(int M, int N, int G_, int c_) { nM = M / BM; nN = N / BM; nwg = nM * nN; G = G_; c = c_; }
    __host__ __device__ bool next(int i, Unit& u) const {
        const long L = (long)i * G + c; if (L >= nwg) return false;
        int wgid = (int)L; { const int q = nwg / NXCD, r = nwg % NXCD, xcd = wgid % NXCD, off = wgid / NXCD; wgid = (xcd < r ? xcd * (q + 1) : r * (q + 1) + (xcd - r) * q) + off; }
        const int nig = WGM * nN, gid = wgid / nig, fm = gid * WGM, gsz = (nM - fm) < WGM ? (nM - fm) : WGM;
        u.pm = fm + ((wgid % nig) % gsz); u.pn = (wgid % nig) / gsz; return true;
    }
    __device__ __forceinline__ void a_ready(const Unit&) const {}
    __device__ __forceinline__ void done(const Unit&) const {}
};

__device__ __forceinline__ unsigned cvt_pk_bf16(float lo, float hi) { unsigned r; asm volatile("v_cvt_pk_bf16_f32 %0, %1, %2" : "=v"(r) : "v"(lo), "v"(hi)); return r; }
typedef float f32x2 __attribute__((ext_vector_type(2)));
__device__ __forceinline__ f32x2 gelu_pk(f32x2 v) {
    const f32x2 av = __builtin_elementwise_abs(v), d = av * 0.2316418882f + 1.0f;
    f32x2 t; t.x = __builtin_amdgcn_rcpf(d.x); t.y = __builtin_amdgcn_rcpf(d.y);
    f32x2 q = t * 0.5307027145f + (-0.7265760135f); q = q * t + 0.7107068705f; q = q * t + (-0.142248368f); q = q * t + 0.127414796f; q = q * t;
    const f32x2 s = (v * v) * (-0.72134752044f);
    f32x2 e; e.x = __builtin_amdgcn_exp2f(s.x); e.y = __builtin_amdgcn_exp2f(s.y);
    const f32x2 m = v * (q * e), r = v - m;
    f32x2 o; o.x = v.x < 0.f ? m.x : r.x; o.y = v.y < 0.f ? m.y : r.y; return o;
}

template <int ACT  > struct EpiBf16 {
    static constexpr bool PERM = true, AFTER_DRAIN = false; static_assert(ACT == 0 || ACT == 1, "EpiBf16: ACT is 0 (none) or 1 (gelu_pk)");
    bf16_t* O; int ldc; const float* bias; int split_cols; size_t split_stride; float scale0;
    __device__ __forceinline__ void operator()(const f32x4 (&acc)[2][2][4][2], const Unit& u, int wr, int wc, int fr, int fq) const {
        const int row0 = u.pm * BM + wr * 64 + fr; int colt = u.pn * BM; bf16_t* base = O;
        float sc = 1.f; if (split_cols) { const int t = colt / split_cols; base += (size_t)t * split_stride; colt -= t * split_cols; if (t == 0) sc = scale0; }
        const int col0 = colt + wc * 32 + 8 * fq, bcol0 = u.pn * BM + wc * 32 + 8 * fq;
        f32x4 bv[2][2];
#pragma unroll
        for (int bj = 0; bj < 2; ++bj)
#pragma unroll
            for (int n = 0; n < 2; ++n) bv[bj][n] = bias ? *(const f32x4*)(bias + bcol0 + bj * HALF + 4 * n) : (f32x4){0.f, 0.f, 0.f, 0.f};
#pragma unroll
        for (int ai = 0; ai < 2; ++ai)
#pragma unroll
            for (int m = 0; m < 4; ++m) { bf16_t* rowp = base + (size_t)(row0 + ai * HALF + m * 16) * ldc + col0;
#pragma unroll
                for (int bj = 0; bj < 2; ++bj) { f32x4 v0 = acc[ai][bj][m][0] + bv[bj][0], v1 = acc[ai][bj][m][1] + bv[bj][1];
                    if (ACT == 1) { f32x2 a = gelu_pk((f32x2){v0[0], v0[1]}), b = gelu_pk((f32x2){v0[2], v0[3]}), c = gelu_pk((f32x2){v1[0], v1[1]}), d = gelu_pk((f32x2){v1[2], v1[3]});
                        v0 = (f32x4){a.x, a.y, b.x, b.y}; v1 = (f32x4){c.x, c.y, d.x, d.y}; }
                    v0 = v0 * sc; v1 = v1 * sc; u32x4 w; w.x = cvt_pk_bf16(v0[0], v0[1]); w.y = cvt_pk_bf16(v0[2], v0[3]); w.z = cvt_pk_bf16(v1[0], v1[1]); w.w = cvt_pk_bf16(v1[2], v1[3]);
                    *(u32x4*)(rowp + bj * HALF) = w; } }
    }
};

template <class Epi, class Sched, bool ALIGN_EPI = false, bool SP2 = false>
__device__ __forceinline__ void gemm_phase(PG8_LAS unsigned char* lds, const Gemm g, const Sched& S, const Epi& E) {
    int tid_ = threadIdx.x; asm volatile("" : "+v"(tid_));
    const int tid = tid_, wid = __builtin_amdgcn_readfirstlane(tid >> 6), lane = tid & 63, wr = wid >> 2, wc = wid & 3, fr = lane & 15, fq = lane >> 4;
    const int K = g.K, nt = K / BK;
    unsigned voffA[2], voffB[2];
#pragma unroll
    for (int i = 0; i < 2; ++i) { int R, C; stage_rc(tid * 16 + i * 8192, R, C); const int Rb = Epi::PERM ? ((R & ~31) + perm32(R & 31)) : R;
        voffA[i] = (unsigned)(R * K + C) * 2u; voffB[i] = (unsigned)(Rb * K + C) * 2u; }
    const size_t kstep = (size_t)(BK * 2);
    const size_t hstep = (size_t)HALF * K * 2;
    const size_t tstep = 2 * hstep;
    const unsigned ldsw = (unsigned)wid * 1024u;
    const int aoff = lds_byte(wr * 64 + fr, fq * 8), boff = lds_byte(wc * 32 + fr, fq * 8);
#define PG8_SA(b, h) (((b) * 2 + (h)) * HTB)
#define PG8_SB(b, h) ((4 + (b) * 2 + (h)) * HTB)
#define PG8_STAGE(bufoff, gbase, voff) do { _Pragma("unroll") for (int _i = 0; _i < 2; ++_i) \
        __builtin_amdgcn_global_load_lds((const unsigned*)((const char*)(gbase) + (voff)[_i]), (PG8_LAS unsigned*)(lds + (bufoff) + ldsw + _i * 8192), 16, 0, 0); } while (0)
#define PG8_LDA(dst, b, h) do { _Pragma("unroll") for (int m = 0; m < 4; ++m) _Pragma("unroll") for (int k = 0; k < 2; ++k) dst[m][k] = *(const PG8_LAS bf16x8*)(lds + PG8_SA(b, h) + aoff + m * 2048 + k * 1024); } while (0)
#define PG8_LDB(dst, b, h) do { _Pragma("unroll") for (int n = 0; n < 2; ++n) _Pragma("unroll") for (int k = 0; k < 2; ++k) dst[n][k] = *(const PG8_LAS bf16x8*)(lds + PG8_SB(b, h) + boff + n * 2048 + k * 1024); } while (0)
#define PG8_MMA(ai, bj, At, Bt) do { __builtin_amdgcn_s_setprio(1); _Pragma("unroll") for (int m = 0; m < 4; ++m) _Pragma("unroll") for (int n = 0; n < 2; ++n) _Pragma("unroll") for (int k = 0; k < 2; ++k) \
        acc[ai][bj][m][n] = __builtin_amdgcn_mfma_f32_16x16x32_bf16(Bt[n][k], At[m][k], acc[ai][bj][m][n], 0, 0, 0); __builtin_amdgcn_s_setprio(0); } while (0)
#define PG8_WAIT_V(n) asm volatile("s_waitcnt vmcnt(" #n ")" ::: "memory")
#define PG8_WAIT_L(n) asm volatile("s_waitcnt lgkmcnt(" #n ")" ::: "memory")
#define PG8_BAR __builtin_amdgcn_s_barrier()
#define PG8_SCHED __builtin_amdgcn_sched_barrier(0)
    Unit cur, nxt; int ui = 0;
    if (!S.next(0, cur)) return;
    f32x4 acc[2][2][4][2];
#pragma unroll
    for (int a = 0; a < 2; ++a)
#pragma unroll
        for (int b = 0; b < 2; ++b)
#pragma unroll
            for (int m = 0; m < 4; ++m)
#pragma unroll
                for (int n = 0; n < 2; ++n) acc[a][b][m][n] = (f32x4){0.f, 0.f, 0.f, 0.f};
    bf16x8 At[4][2], B0[2][2], B1[2][2];
    const char* cA = (const char*)g.A + (size_t)cur.pm * tstep; const char* cB = (const char*)g.Bt + (size_t)cur.pn * tstep;
    S.a_ready(cur);
    if constexpr (SP2) {
        PG8_STAGE(PG8_SB(0, 0), cB, voffB); PG8_STAGE(PG8_SB(0, 1), cB + hstep, voffB); PG8_STAGE(PG8_SA(0, 0), cA, voffA); PG8_STAGE(PG8_SA(0, 1), cA + hstep, voffA);
        if (wr == 1) PG8_BAR;
        PG8_WAIT_V(2); PG8_BAR;
        PG8_STAGE(PG8_SB(1, 0), cB + kstep, voffB); PG8_STAGE(PG8_SA(1, 0), cA + kstep, voffA); PG8_STAGE(PG8_SB(1, 1), cB + hstep + kstep, voffB);
        PG8_WAIT_V(6); PG8_BAR;
    } else {
        PG8_STAGE(PG8_SB(0, 0), cB, voffB); PG8_STAGE(PG8_SA(0, 0), cA, voffA); PG8_STAGE(PG8_SB(0, 1), cB + hstep, voffB); PG8_STAGE(PG8_SA(0, 1), cA + hstep, voffA);
        if (wr == 1) PG8_BAR;
        PG8_WAIT_V(4); PG8_BAR;
        PG8_STAGE(PG8_SB(1, 0), cB + kstep, voffB); PG8_STAGE(PG8_SA(1, 0), cA + kstep, voffA); PG8_STAGE(PG8_SB(1, 1), cB + hstep + kstep, voffB);
        PG8_WAIT_V(6); PG8_BAR;
    }
    for (;;) {
        const bool has_next = S.next(ui + 1, nxt);
        const char* nA = has_next ? (const char*)g.A + (size_t)nxt.pm * tstep : cA; const char* nB = has_next ? (const char*)g.Bt + (size_t)nxt.pn * tstep : cB;
        for (int t = 0; t < nt; t += 2) {
            const bool last = (t == nt - 2);
            const char* a1 = cA + (size_t)(t + 1) * kstep;
            const char* a2 = last ? nA : cA + (size_t)(t + 2) * kstep; const char* b2 = last ? nB : cB + (size_t)(t + 2) * kstep;
            const char* a3 = a2 + kstep; const char* b3 = b2 + kstep;
            if (last && has_next) S.a_ready(nxt);
            if constexpr (SP2) {
            PG8_LDB(B0, 0, 0); PG8_LDB(B1, 0, 1); PG8_SCHED; PG8_LDA(At, 0, 0); PG8_STAGE(PG8_SA(1, 1), a1 + hstep, voffA);
            PG8_WAIT_V(8); PG8_WAIT_L(0); PG8_BAR; PG8_MMA(0, 0, At, B0); PG8_MMA(0, 1, At, B1); PG8_BAR; PG8_SCHED;
            PG8_LDA(At, 0, 1); PG8_STAGE(PG8_SB(0, 0), b2, voffB); PG8_STAGE(PG8_SB(0, 1), b2 + hstep, voffB); PG8_STAGE(PG8_SA(0, 0), a2, voffA);
            PG8_WAIT_V(8); PG8_WAIT_L(0); PG8_BAR; PG8_MMA(1, 0, At, B0); PG8_MMA(1, 1, At, B1); PG8_BAR; PG8_SCHED;
            PG8_LDB(B0, 1, 0); PG8_LDB(B1, 1, 1); PG8_SCHED; PG8_LDA(At, 1, 0); PG8_STAGE(PG8_SA(0, 1), a2 + hstep, voffA);
            PG8_WAIT_V(8); PG8_WAIT_L(0); PG8_BAR; PG8_MMA(0, 0, At, B0); PG8_MMA(0, 1, At, B1); PG8_BAR; PG8_SCHED;
            PG8_LDA(At, 1, 1); PG8_STAGE(PG8_SB(1, 0), b3, voffB); PG8_STAGE(PG8_SB(1, 1), b3 + hstep, voffB); PG8_STAGE(PG8_SA(1, 0), a3, voffA);
            PG8_WAIT_V(8); PG8_WAIT_L(0); PG8_BAR; PG8_MMA(1, 0, At, B0); PG8_MMA(1, 1, At, B1); PG8_BAR; PG8_SCHED;
            } else {
            PG8_LDB(B0, 0, 0); PG8_SCHED; PG8_LDA(At, 0, 0); PG8_STAGE(PG8_SA(1, 1), a1 + hstep, voffA);
            PG8_WAIT_L(8); PG8_BAR; PG8_WAIT_L(0); PG8_MMA(0, 0, At, B0); PG8_BAR; PG8_SCHED;
            PG8_LDB(B1, 0, 1); PG8_STAGE(PG8_SB(0, 0), b2, voffB);
            PG8_BAR; PG8_WAIT_L(0); PG8_MMA(0, 1, At, B1); PG8_BAR;
            PG8_LDA(At, 0, 1); PG8_STAGE(PG8_SA(0, 0), a2, voffA);
            PG8_BAR; PG8_WAIT_L(0); PG8_MMA(1, 0, At, B0); PG8_BAR; PG8_SCHED;
            PG8_STAGE(PG8_SB(0, 1), b2 + hstep, voffB);
            PG8_WAIT_V(6); PG8_BAR; PG8_MMA(1, 1, At, B1); PG8_BAR;
            PG8_LDB(B0, 1, 0); PG8_SCHED; PG8_LDA(At, 1, 0); PG8_STAGE(PG8_SA(0, 1), a2 + hstep, voffA);
            PG8_WAIT_L(8); PG8_BAR; PG8_WAIT_L(0); PG8_MMA(0, 0, At, B0); PG8_BAR; PG8_SCHED;
            PG8_LDB(B1, 1, 1); PG8_STAGE(PG8_SB(1, 0), b3, voffB);
            PG8_BAR; PG8_WAIT_L(0); PG8_MMA(0, 1, At, B1); PG8_BAR;
            PG8_LDA(At, 1, 1); PG8_STAGE(PG8_SA(1, 0), a3, voffA);
            PG8_BAR; PG8_WAIT_L(0); PG8_MMA(1, 0, At, B0); PG8_BAR; PG8_SCHED;
            PG8_STAGE(PG8_SB(1, 1), b3 + hstep, voffB);
            PG8_WAIT_V(6); PG8_BAR; PG8_MMA(1, 1, At, B1); PG8_BAR;
            }
        }
        if constexpr (ALIGN_EPI) { if (wr == 0) PG8_BAR; }
        if constexpr (!Epi::AFTER_DRAIN) { E(acc, cur, wr, wc, fr, fq); S.done(cur); }
        if (!has_next) break;
#pragma unroll
        for (int a = 0; a < 2; ++a)
#pragma unroll
            for (int b = 0; b < 2; ++b)
#pragma unroll
                for (int m = 0; m < 4; ++m)
#pragma unroll
                    for (int n = 0; n < 2; ++n) acc[a][b][m][n] = (f32x4){0.f, 0.f, 0.f, 0.f};
        cur = nxt; cA = nA; cB = nB; ++ui;
        if constexpr (ALIGN_EPI) { if (wr == 1) PG8_BAR; }
    }
    PG8_WAIT_V(0);
    if constexpr (!ALIGN_EPI) { if (wr == 0) PG8_BAR; }
    PG8_BAR;
    if constexpr (Epi::AFTER_DRAIN) { E.fused(acc, cur, wr, wc, fr, fq, lds, wid, lane); S.done(cur); }
#undef PG8_SA
#undef PG8_SB
#undef PG8_STAGE
#undef PG8_LDA
#undef PG8_LDB
#undef PG8_MMA
#undef PG8_WAIT_V
#undef PG8_WAIT_L
#undef PG8_BAR
#undef PG8_SCHED
}
}
namespace pg8 {
struct EpiResid {
    static constexpr bool PERM = false, AFTER_DRAIN = false;
    const float* base; float* out; int ldc;
    __device__ __forceinline__ void operator()(const f32x4 (&acc)[2][2][4][2], const Unit& u, int wr, int wc, int fr, int fq) const {
        const int col0 = u.pn * BM + wc * 32 + 4 * fq;
#pragma unroll
        for (int ai = 0; ai < 2; ++ai)
#pragma unroll
            for (int m = 0; m < 4; ++m) { const size_t off = (size_t)(u.pm * BM + ai * HALF + wr * 64 + m * 16 + fr) * ldc + col0;
#pragma unroll
                for (int bj = 0; bj < 2; ++bj)
#pragma unroll
                    for (int n = 0; n < 2; ++n) { const f32x4 b = *(const f32x4*)(base + off + bj * HALF + n * 16); *(f32x4*)(out + off + bj * HALF + n * 16) = b + acc[ai][bj][m][n]; } }
    }
};
struct RangeOrder {
    int nM, nN, nwg, G, c, first, last;
    __host__ __device__ void init(int M, int N, int G_, int c_, int first_, int count_) { nM = M / BM; nN = N / BM; nwg = nM * nN; G = G_; c = c_; first = first_; last = first_ + count_; }
    __host__ __device__ bool next(int i, Unit& u) const {
        const long L = (long)first + (long)i * G + c; if (c < 0 || L >= last || L >= nwg) return false;
        int wgid = (int)L; { const int q = nwg / NXCD, r = nwg % NXCD, xcd = wgid % NXCD, off = wgid / NXCD; wgid = (xcd < r ? xcd * (q + 1) : r * (q + 1) + (xcd - r) * q) + off; }
        const int nig = WGM * nN, gid = wgid / nig, fm = gid * WGM, gsz = (nM - fm) < WGM ? (nM - fm) : WGM;
        u.pm = fm + ((wgid % nig) % gsz); u.pn = (wgid % nig) / gsz; return true;
    }
    __device__ __forceinline__ void a_ready(const Unit&) const {}
    __device__ __forceinline__ void done(const Unit&) const {}
};
struct EpiRmsRes {
    static constexpr bool PERM = false, AFTER_DRAIN = true;
    const float* base; float* out; bf16_t* xn; const float* w; float* slots; unsigned* cnt; int ldc; int mode;
    __device__ __forceinline__ void fused(f32x4 (&acc)[2][2][4][2], const Unit& u, int wr, int wc, int fr, int fq, PG8_LAS unsigned char* lds, int wid, int lane) const {
        const int col0 = u.pn * BM + wc * 32 + 4 * fq;
        PG8_LAS float* P = (PG8_LAS float*)lds; PG8_LAS float* S = (PG8_LAS float*)(lds + 4096);
#pragma unroll
        for (int ai = 0; ai < 2; ++ai)
#pragma unroll
            for (int m = 0; m < 4; ++m) { const size_t off = (size_t)(u.pm * BM + ai * HALF + wr * 64 + m * 16 + fr) * ldc + col0; float s = 0.f;
#pragma unroll
                for (int bj = 0; bj < 2; ++bj)
#pragma unroll
                    for (int n = 0; n < 2; ++n) { const f32x4 v = acc[ai][bj][m][n] + *(const f32x4*)(base + off + bj * HALF + n * 16); acc[ai][bj][m][n] = v; s += (v[0] * v[0] + v[1] * v[1]) + (v[2] * v[2] + v[3] * v[3]); }
                s += __shfl_xor(s, 16); s += __shfl_xor(s, 32);
                if (fq == 0) P[(ai * HALF + wr * 64 + m * 16 + fr) * 4 + wc] = s;
                if (m & 1) asm volatile("" ::: "memory"); }
        asm volatile("s_waitcnt lgkmcnt(0)" ::: "memory"); __builtin_amdgcn_s_barrier(); asm volatile("" ::: "memory");
        const int row = wid * 32 + (lane & 31);
        if (lane < 32) { const float tot = (P[row * 4 + 0] + P[row * 4 + 1]) + (P[row * 4 + 2] + P[row * 4 + 3]);
            __hip_atomic_store(slots + ((size_t)(u.pm * BM + row) * 4 + u.pn), tot, __ATOMIC_RELAXED, __HIP_MEMORY_SCOPE_AGENT); }
        asm volatile("s_waitcnt vmcnt(0)" ::: "memory");
        if (lane == 0) __hip_atomic_fetch_add(cnt + 64 * u.pm, 1u, __ATOMIC_RELAXED, __HIP_MEMORY_SCOPE_AGENT);
        if (wid == 0) { while ((unsigned)__builtin_amdgcn_readfirstlane(__hip_atomic_load(cnt + 64 * u.pm, __ATOMIC_RELAXED, __HIP_MEMORY_SCOPE_AGENT)) < 32u) __builtin_amdgcn_s_sleep(2);
            __builtin_amdgcn_fence(__ATOMIC_ACQUIRE, "agent"); }
        asm volatile("s_waitcnt vmcnt(0) lgkmcnt(0)" ::: "memory"); __builtin_amdgcn_s_barrier(); asm volatile("" ::: "memory");
        if (lane < 32) { const float* sl = slots + (size_t)(u.pm * BM + row) * 4; float q = 0.f;
#pragma unroll
            for (int t = 0; t < 4; ++t) q += __hip_atomic_load(sl + t, __ATOMIC_RELAXED, __HIP_MEMORY_SCOPE_AGENT);
            S[row] = 1.0f / sqrtf(q * (1.f / 1024.f) + 1e-6f); }
        asm volatile("s_waitcnt lgkmcnt(0)" ::: "memory"); __builtin_amdgcn_s_barrier(); asm volatile("" ::: "memory");
        f32x4 wv[2][2];
#pragma unroll
        for (int bj = 0; bj < 2; ++bj)
#pragma unroll
            for (int n = 0; n < 2; ++n) wv[bj][n] = *(const f32x4*)(w + col0 + bj * HALF + n * 16);
#pragma unroll
        for (int ai = 0; ai < 2; ++ai)
#pragma unroll
            for (int m = 0; m < 4; ++m) { const int r = ai * HALF + wr * 64 + m * 16 + fr; const float rs = S[r]; const size_t off = (size_t)(u.pm * BM + r) * ldc + col0;
#pragma unroll
                for (int bj = 0; bj < 2; ++bj)
#pragma unroll
                    for (int n = 0; n < 2; ++n) { const f32x4 v = acc[ai][bj][m][n]; const f32x4 nv = v * rs * wv[bj][n];
                        if (mode == 0) { *(f32x4*)(out + off + bj * HALF + n * 16) = v; typedef unsigned u32x2v __attribute__((ext_vector_type(2))); u32x2v pk; pk.x = cvt_pk_bf16(nv[0], nv[1]); pk.y = cvt_pk_bf16(nv[2], nv[3]);
                            *(u32x2v*)(xn + off + bj * HALF + n * 16) = pk; }
                        else *(f32x4*)(out + off + bj * HALF + n * 16) = nv; } }
    }
};
}
constexpr int NWAVES = 8, NTHR = 512;
constexpr int BATCH = 2, T = 8192, D = 1024, M = BATCH * T, MH = T;
constexpr int NIN = 3728, NPAD = 3840;
constexpr int C_GQ = 0, C_GK = 256, C_GV = 512, C_GLR = 1024, C_GG = 1040, C_R = 1552, C_K = 2064, C_V = 2576, C_WL = 3088, C_AL = 3152, C_RG = 3216;
constexpr size_t MiB = 1u << 20;
constexpr size_t WS_WIN = 1 * MiB, WIN_BYTES = (size_t)NPAD * D * 2;
constexpr size_t WS_WOUT = 16 * MiB, WOUT_BYTES = (size_t)D * D * 2;
constexpr size_t WS_XN = 20 * MiB;
constexpr size_t WS_U = 52 * MiB, WS_U1 = 193 * MiB, U_STRIDE = WS_U1 - WS_U;
constexpr size_t WS_SLOTS = 192 * MiB;
constexpr size_t WS_END = 254 * MiB;
constexpr int LDS_BYTES = 163840;
constexpr int EARLY_TILES = 224;

typedef unsigned short bf16;
typedef unsigned v4u __attribute__((ext_vector_type(4)));
typedef float f32x4 __attribute__((ext_vector_type(4)));
#define LDS_WAIT() asm volatile("s_waitcnt lgkmcnt(0)" ::: "memory")
#define LBAR() do { asm volatile("s_waitcnt lgkmcnt(0)" ::: "memory"); __builtin_amdgcn_s_barrier(); asm volatile("" ::: "memory"); } while (0)
__device__ __forceinline__ float bf2f(unsigned h) { return __uint_as_float(h << 16); }
__device__ __forceinline__ unsigned f2bf(float f) { unsigned u = __float_as_uint(f); return (u + 0x7fffu + ((u >> 16) & 1u)) >> 16; }
typedef __bf16 bf16x2_t __attribute__((ext_vector_type(2)));
typedef float f32x2_t __attribute__((ext_vector_type(2)));
__device__ __forceinline__ unsigned pk2(float lo, float hi) { const f32x2_t v = {lo, hi}; const bf16x2_t b = __builtin_convertvector(v, bf16x2_t); return __builtin_bit_cast(unsigned, b); }
__device__ __forceinline__ float wave_sum(float v) {
#pragma unroll
    for (int o = 1; o < 64; o <<= 1) v += __shfl_xor(v, o);
    return v;
}
__device__ __forceinline__ float sigm(float x) { return __builtin_amdgcn_rcpf(1.f + __expf(-x)); }
__device__ __forceinline__ float tanh_fast(float x) { return 1.f - 2.f * __builtin_amdgcn_rcpf(1.f + __expf(2.f * x)); }
__device__ __forceinline__ float rl(float v, int l) { return __int_as_float(__builtin_amdgcn_readlane(__float_as_int(v), l)); }

typedef short bf16x8 __attribute__((ext_vector_type(8)));
typedef unsigned v2u __attribute__((ext_vector_type(2)));
__device__ __forceinline__ v2u pack4(f32x4 v) { v2u r; r.x = pk2(v.x, v.y); r.y = pk2(v.z, v.w); return r; }
__device__ __forceinline__ void unpack8(v4u w, float* o) { o[0] = bf2f(w.x & 0xffffu); o[1] = bf2f(w.x >> 16); o[2] = bf2f(w.y & 0xffffu); o[3] = bf2f(w.y >> 16);
    o[4] = bf2f(w.z & 0xffffu); o[5] = bf2f(w.z >> 16); o[6] = bf2f(w.w & 0xffffu); o[7] = bf2f(w.w >> 16); }
__device__ __forceinline__ v4u pack8(const float* v) { v4u r; r.x = pk2(v[0], v[1]); r.y = pk2(v[2], v[3]); r.z = pk2(v[4], v[5]); r.w = pk2(v[6], v[7]); return r; }
struct Args { const float* in[18]; float* out; unsigned char* ws; };
typedef const Args __attribute__((address_space(4))) CArgs;
__device__ __forceinline__ CArgs* opaque_args() { CArgs* p = (CArgs*)__builtin_amdgcn_kernarg_segment_ptr(); asm volatile("" : "+s"(p)); return p; }
#define AA (*opaque_args())

__device__ __forceinline__ void rms_row2(const float* x0, const float* x1, const float* w, bf16* o0, bf16* o1, int lane) {
    const f32x4* r0 = (const f32x4*)x0 + lane; const f32x4* r1 = (const f32x4*)x1 + lane; const f32x4* wr = (const f32x4*)w + lane;
    f32x4 a[4], b[4]; float sa = 0.f, sb = 0.f;
#pragma unroll
    for (int j = 0; j < 4; ++j) { a[j] = r0[64 * j]; b[j] = r1[64 * j]; }
#pragma unroll
    for (int j = 0; j < 4; ++j) { sa += (a[j].x * a[j].x + a[j].y * a[j].y) + (a[j].z * a[j].z + a[j].w * a[j].w); sb += (b[j].x * b[j].x + b[j].y * b[j].y) + (b[j].z * b[j].z + b[j].w * b[j].w); }
    const float ra = rsqrtf(wave_sum(sa) * (1.f / D) + 1e-6f), rb = rsqrtf(wave_sum(sb) * (1.f / D) + 1e-6f);
#pragma unroll
    for (int j = 0; j < 4; ++j) { const f32x4 ww = wr[64 * j]; const f32x4 oa = a[j] * ra * ww, ob = b[j] * rb * ww;
        ((v2u*)o0 + lane)[64 * j] = pack4(oa); ((v2u*)o1 + lane)[64 * j] = pack4(ob); }
}
__device__ __forceinline__ void transpose_item(const float* W, int K, int N, int Npad, bf16* WT, float* scr, int item, int lane) {
    const int nblk = Npad / 32, kb = item / nblk, nb = item % nblk, k0 = 64 * kb, n0 = 32 * nb;
    const int n = n0 + (lane & 31);
#pragma unroll 8
    for (int i = 0; i < 32; ++i) { const int kk = 2 * i + (lane >> 5); scr[kk * 33 + (lane & 31)] = (n < N) ? W[(size_t)(k0 + kk) * N + n] : 0.f; }
    LDS_WAIT();
    const int c = lane & 7;
#pragma unroll
    for (int j = 0; j < 4; ++j) { const int nn = (lane >> 3) + 8 * j; const float* s = scr + (8 * c) * 33 + nn;
        v4u o; o.x = pk2(s[0 * 33], s[1 * 33]); o.y = pk2(s[2 * 33], s[3 * 33]); o.z = pk2(s[4 * 33], s[5 * 33]); o.w = pk2(s[6 * 33], s[7 * 33]);
        *(v4u*)(WT + (size_t)(n0 + nn) * K + k0 + 8 * c) = o; }
    LDS_WAIT();
}
__device__ __forceinline__ void transpose_tiles(const float* W, int K, int N, int Npad, bf16* WT, float* scr  , int first, int stride, int ntiles, int tid) {
    const int nblk = Npad / 64, kr = tid >> 4, nq = tid & 15;
    f32x4 v0 = {0.f, 0.f, 0.f, 0.f}, v1 = v0;
    if (first < ntiles) { const int kb = first / nblk, nb = first % nblk, n = 64 * nb + 4 * nq; if (n < N) { v0 = *(const f32x4*)(W + (size_t)(64 * kb + kr) * N + n); v1 = *(const f32x4*)(W + (size_t)(64 * kb + 32 + kr) * N + n); } }
#pragma unroll 1
    for (int it = first; it < ntiles; it += stride) {
        const int kb = it / nblk, nb = it % nblk;
        scr[kr * 65 + 4 * nq] = v0.x; scr[kr * 65 + 4 * nq + 1] = v0.y; scr[kr * 65 + 4 * nq + 2] = v0.z; scr[kr * 65 + 4 * nq + 3] = v0.w;
        scr[(32 + kr) * 65 + 4 * nq] = v1.x; scr[(32 + kr) * 65 + 4 * nq + 1] = v1.y; scr[(32 + kr) * 65 + 4 * nq + 2] = v1.z; scr[(32 + kr) * 65 + 4 * nq + 3] = v1.w;
        const int nx = it + stride; v0 = (f32x4){0.f, 0.f, 0.f, 0.f}; v1 = v0;
        if (nx < ntiles) { const int kb2 = nx / nblk, nb2 = nx % nblk, n = 64 * nb2 + 4 * nq; if (n < N) { v0 = *(const f32x4*)(W + (size_t)(64 * kb2 + kr) * N + n); v1 = *(const f32x4*)(W + (size_t)(64 * kb2 + 32 + kr) * N + n); } }
        LBAR();
        { const int n = tid >> 3, kc = tid & 7; const float* sp = scr + (8 * kc) * 65 + n; float o[8];
#pragma unroll
          for (int j = 0; j < 8; ++j) o[j] = sp[j * 65];
          *(v4u*)(WT + (size_t)(64 * nb + n) * K + 64 * kb + 8 * kc) = pack8(o); }
        LBAR();
    }
}
__device__ __forceinline__ void rms_row(const float* xrow, const float* w, bf16* obf, float* of32, int lane) {
    const f32x4* xr = (const f32x4*)xrow + lane; const f32x4* wr = (const f32x4*)w + lane;
    f32x4 v[4]; float s = 0.f;
#pragma unroll
    for (int j = 0; j < 4; ++j) { v[j] = xr[64 * j]; s += (v[j].x * v[j].x + v[j].y * v[j].y) + (v[j].z * v[j].z + v[j].w * v[j].w); }
    const float rs = rsqrtf(wave_sum(s) * (1.f / D) + 1e-6f);
#pragma unroll
    for (int j = 0; j < 4; ++j) { const f32x4 ww = wr[64 * j]; f32x4 o = v[j] * rs * ww;
        if (of32) ((f32x4*)of32 + lane)[64 * j] = o;
        else ((unsigned long long*)obf + lane)[64 * j] = (unsigned long long)pk2(o.x, o.y) | ((unsigned long long)pk2(o.z, o.w) << 32); }
}

constexpr int PITCH = 72, FP = 68, TP = 20;
constexpr int OFF_TW = 0, OFF_AL = 9216, OFF_ARK = 18432, OFF_XA = 27648, OFF_XW = 45056, OFF_AT = 63488, OFF_RT = 72704, OFF_BH = 81920, OFF_KH = 91136,
              OFF_BBT = 100352, OFF_KBT = 109568, OFF_VT = 118784, OFF_TII = 128000, OFF_TOT = 133120, OFF_BC = 135168;
constexpr int OFF_AAK = OFF_TW, OFF_ARB = OFF_AL, OFF_AAB = OFF_XA, OFF_XT = OFF_XW;
constexpr size_t WS_MC = 112 * MiB, WS_NC = 120 * MiB, WS_PP = 136 * MiB, WS_Y0 = 144 * MiB, WS_S0 = 152 * MiB, WS_DEC = 160 * MiB, WS_BON2 = 161 * MiB, WS_UPT = 162 * MiB;
constexpr int NUNIT = 1024;

__device__ __forceinline__ f32x4 mma2s(const bf16* Ab, int ak, const bf16* Bb, int bk, int g, f32x4 acc) {
    acc = __builtin_amdgcn_mfma_f32_16x16x32_bf16(*(const bf16x8*)(Ab + ((g ^ ak) << 3)), *(const bf16x8*)(Bb + ((g ^ bk) << 3)), acc, 0, 0, 0);
    acc = __builtin_amdgcn_mfma_f32_16x16x32_bf16(*(const bf16x8*)(Ab + (((g + 4) ^ ak) << 3)), *(const bf16x8*)(Bb + (((g + 4) ^ bk) << 3)), acc, 0, 0, 0);
    return acc;
}
#define SWK(row) (((row) >> 3) & 7)
#define SWC(row, t) ((row) * PITCH + ((((t) >> 3) ^ SWK(row)) << 3) + ((t) & 7))
__device__ __forceinline__ f32x4 mma2(const bf16* Arow, const bf16* Brow, f32x4 acc) {
    acc = __builtin_amdgcn_mfma_f32_16x16x32_bf16(*(const bf16x8*)(Arow), *(const bf16x8*)(Brow), acc, 0, 0, 0);
    acc = __builtin_amdgcn_mfma_f32_16x16x32_bf16(*(const bf16x8*)(Arow + 32), *(const bf16x8*)(Brow + 32), acc, 0, 0, 0);
    return acc;
}

__device__ __forceinline__ void r1_phase(CArgs& a, size_t uo, int l, unsigned char* L, int tid0) {
    asm volatile("" : "+v"(tid0));
    const int wave = __builtin_amdgcn_readfirstlane(tid0 >> 6);
    const bf16* U = (const bf16*)(a.ws + WS_U + uo);
    bf16* TW = (bf16*)(L + 138240 + 2560); bf16* ALm = (bf16*)(L + 138240 + 2560 + 9216);
    bf16* ARK = (bf16*)(L + OFF_ARK); bf16* AAK = (bf16*)(L + OFF_AAK); bf16* ARB = (bf16*)(L + OFF_ARB);
    float* XA = (float*)(L + OFF_XA); float* XW = (float*)(L + OFF_XW); float* AAB = (float*)(L + OFF_AAB); bf16* XT = (bf16*)(L + OFF_XT);
    bf16* AT = (bf16*)(L + OFF_AT); bf16* RT = (bf16*)(L + OFF_RT); bf16* BH = (bf16*)(L + OFF_BH); bf16* KH = (bf16*)(L + OFF_KH);
    bf16* BBT = (bf16*)(L + OFF_BBT); bf16* KBT = (bf16*)(L + OFF_KBT); bf16* VT = (bf16*)(L + OFF_VT);
    float* TII = (float*)(L + OFF_TII); float* TOT = (float*)(L + OFF_TOT); float* BC = (float*)(L + OFF_BC);
    const bf16* UPT = (const bf16*)(a.ws + WS_UPT) + (size_t)l * 2 * 512 * 64;
    const float* mu = a.in[6] + l * 1664;
    float* WTS = (float*)(L + 135680);
    const int ch = (int)blockIdx.x >> 1, hbase = 4 * ((int)blockIdx.x & 1);
    v4u Lrc, Lkc, Lvc, Lrp, Lkp, Lvp; bf16x8 wfa0, wfa1; float pw[8];
#define R1_ISSUE(h_) do { const int lr_ = 64 * ch + (tid >> 3); const bf16* uq_ = U + (size_t)lr_ * NPAD + 64 * (h_) + 8 * (tid & 7); \
        Lrc = *(const v4u*)(uq_ + C_R); Lkc = *(const v4u*)(uq_ + C_K); Lvc = *(const v4u*)(uq_ + C_V); Lrp = (v4u){0u, 0u, 0u, 0u}; Lkp = Lrp; Lvp = Lrp; \
        if (lr_ > 0) { Lrp = *(const v4u*)(uq_ + C_R - NPAD); Lkp = *(const v4u*)(uq_ + C_K - NPAD); Lvp = *(const v4u*)(uq_ + C_V - NPAD); } \
        if (tid < 64) { const int c_ = l * 512 + 64 * (h_) + tid; pw[0] = a.in[7][c_]; pw[1] = a.in[9][c_]; pw[2] = a.in[11][c_]; pw[3] = a.in[12][c_]; pw[4] = a.in[13][c_]; \
            pw[5] = mu[64 * (h_) + tid]; pw[6] = mu[512 + 64 * (h_) + tid]; pw[7] = mu[1024 + 64 * (h_) + tid]; } \
        { const bf16* WT_ = UPT + (size_t)(wave >> 2) * 512 * 64 + (size_t)(64 * (h_) + 16 * (wave & 3) + (tid & 15)) * 64 + 8 * ((tid & 63) >> 4); wfa0 = *(const bf16x8*)WT_; wfa1 = *(const bf16x8*)(WT_ + 32); } } while (0)
    {
        int tid = tid0; asm volatile("" : "+v"(tid));
        R1_ISSUE(hbase);
        const int t = tid >> 3, cg = tid & 7, lr = 64 * ch + t; const bf16* up = U + (size_t)lr * NPAD + C_WL + 16 * cg;
        const v4u c0 = *(const v4u*)up, c1 = *(const v4u*)(up + 8); v4u p0 = {0u, 0u, 0u, 0u}, p1 = p0;
        if (lr > 0) { p0 = *(const v4u*)(up - NPAD); p1 = *(const v4u*)(up - NPAD + 8); }
        float cu[16], pr[16], o[16]; unpack8(c0, cu); unpack8(c1, cu + 8); unpack8(p0, pr); unpack8(p1, pr + 8);
        const float* mp = mu + 1536 + 16 * cg;
#pragma unroll
        for (int i = 0; i < 16; ++i) { float mv = cu[i] + (pr[i] - cu[i]) * mp[i]; if (cg < 4) mv = tanh_fast(mv); o[i] = mv; }
        bf16* dst = (cg < 4 ? TW : ALm) + t * PITCH + 16 * (cg & 3);
        *(v4u*)dst = pack8(o); *(v4u*)(dst + 8) = pack8(o + 8);
    }
#pragma unroll 1
    for (int hi = 0; hi < 4; ++hi) {
        int tid = tid0; asm volatile("" : "+v"(tid));
        const int lane = tid & 63, g = lane >> 4, c16 = lane & 15;
        const int h = hbase + hi, unit = ch * 8 + h;
        const int t = tid >> 3, dg = tid & 7, d0 = 8 * dg, lr = 64 * ch + t, hc = 64 * h + d0;
        if (tid < 64) {
#pragma unroll
            for (int q = 0; q < 8; ++q) WTS[64 * q + tid] = pw[q]; }
        LBAR();
        {
            const int q = wave >> 2, dt = wave & 3;
            const bf16x8 a0 = wfa0, a1 = wfa1;
            const bf16* Bm = q ? ALm : TW; float* X = q ? XA : XW;
#pragma unroll
            for (int tt = 0; tt < 4; ++tt) { const bf16* br = Bm + (16 * tt + c16) * PITCH + 8 * g; f32x4 acc = {0.f, 0.f, 0.f, 0.f};
                acc = __builtin_amdgcn_mfma_f32_16x16x32_bf16(a0, *(const bf16x8*)br, acc, 0, 0, 0);
                acc = __builtin_amdgcn_mfma_f32_16x16x32_bf16(a1, *(const bf16x8*)(br + 32), acc, 0, 0, 0);
                *(f32x4*)(X + (16 * tt + c16) * FP + 16 * dt + 4 * g) = acc; }
        }
        LBAR();
        float r[8], kq[8], v[8], al[8], be[8], lw[8];
        {
            float rc[8], rp[8], kc[8], kp[8], vc[8], vp[8];
            unpack8(Lrc, rc); unpack8(Lkc, kc); unpack8(Lvc, vc); unpack8(Lrp, rp); unpack8(Lkp, kp); unpack8(Lvp, vp);
            const float* w0p = WTS + d0; const float* a0p = WTS + 64 + d0; const float* kkp = WTS + 128 + d0;
            const float* kap = WTS + 192 + d0; const float* rkp = WTS + 256 + d0;
            float nn = 0.f, bon = 0.f, kk[8], av[8];
#pragma unroll
            for (int i = 0; i < 8; ++i) {
                const float xw = XW[t * FP + d0 + i] + w0p[i], xa = XA[t * FP + d0 + i] + a0p[i];
                lw[i] = -0.60653065971f * sigm(xw); av[i] = sigm(xa);
                r[i] = rc[i] + (rp[i] - rc[i]) * WTS[320 + d0 + i]; const float k = kc[i] + (kp[i] - kc[i]) * WTS[384 + d0 + i]; v[i] = vc[i] + (vp[i] - vc[i]) * WTS[448 + d0 + i];
                kk[i] = k * kkp[i]; nn += kk[i] * kk[i];
                kq[i] = k * (1.f + (av[i] - 1.f) * kap[i]); bon += r[i] * kq[i] * rkp[i];
            }
            nn += __shfl_xor(nn, 1); nn += __shfl_xor(nn, 2); nn += __shfl_xor(nn, 4);
            bon += __shfl_xor(bon, 1); bon += __shfl_xor(bon, 2); bon += __shfl_xor(bon, 4);
            const float inv = __builtin_amdgcn_rsqf(fmaxf(nn, 1e-24f));
#pragma unroll
            for (int i = 0; i < 8; ++i) { const float kn = kk[i] * inv; al[i] = -kn; be[i] = av[i] * kn; XW[t * FP + d0 + i] = lw[i]; }
            if (dg == 0) ((float*)(a.ws + WS_BON2))[lr * 8 + h] = bon;
        }
        LBAR();
        {
            const int d = tid & 63, tb = tid >> 6; float p[8]; float run = 0.f;
#pragma unroll
            for (int i = 0; i < 8; ++i) { run += XW[(8 * tb + i) * FP + d]; p[i] = run; }
            TOT[tb * 64 + d] = run;
            LBAR();
            float off = 0.f;
#pragma unroll
            for (int j = 0; j < 8; ++j) off += (j < tb) ? TOT[j * 64 + d] : 0.f;
#pragma unroll
            for (int i = 0; i < 8; ++i) XW[(8 * tb + i) * FP + d] = off + p[i];
            if (tb == 7) { BC[d] = off + run; BC[64 + d] = __expf(off + run); }
        }
        LBAR();
        {
            float at[8], rt[8], bh[8], kh[8];
#pragma unroll
            for (int i = 0; i < 8; ++i) { const float b = XW[t * FP + d0 + i];
                const float eb = __expf(b), enb = __builtin_amdgcn_rcpf(eb), ebp = __expf(b - lw[i]), ebc = BC[64 + d0 + i] * enb;
                at[i] = al[i] * ebp; rt[i] = r[i] * eb; bh[i] = be[i] * enb; kh[i] = kq[i] * enb;
                BBT[SWC(d0 + i, t)] = (bf16)f2bf(be[i] * ebc); KBT[SWC(d0 + i, t)] = (bf16)f2bf(kq[i] * ebc); VT[SWC(d0 + i, t)] = (bf16)f2bf(v[i]); }
            *(v4u*)(AT + t * PITCH + d0) = pack8(at); *(v4u*)(RT + t * PITCH + d0) = pack8(rt); *(v4u*)(BH + t * PITCH + d0) = pack8(bh); *(v4u*)(KH + t * PITCH + d0) = pack8(kh);
        }
        asm volatile("" ::: "memory");
        if (hi + 1 < 4) R1_ISSUE(h + 1);
        LBAR();
        {
            const int q = wave >> 1, mh = wave & 1;
            const bf16* As = (q < 2) ? AT : RT; const bf16* Bs = (q & 1) ? KH : BH;
#pragma unroll
            for (int t2 = 0; t2 < 2; ++t2) { const int tt = 2 * mh + t2; const int tcol = 16 * tt + c16;
#pragma unroll
                for (int jt = 0; jt < 4; ++jt) {
                    f32x4 acc = {0.f, 0.f, 0.f, 0.f};
                    if (jt <= tt) { acc = mma2(Bs + (16 * jt + c16) * PITCH + 8 * g, As + tcol * PITCH + 8 * g, acc);
#pragma unroll
                        for (int j = 0; j < 4; ++j) { const int jj = 16 * jt + 4 * g + j; const bool keep = (q < 2) ? (jj < tcol) : (jj <= tcol); if (!keep) acc[j] = 0.f; } }
                    if (q == 0) *(f32x4*)(AAB + tcol * FP + 16 * jt + 4 * g) = acc;
                    else { bf16* dst = (q == 1 ? AAK : (q == 2 ? ARB : ARK)); *(v2u*)(dst + tcol * PITCH + 16 * jt + 4 * g) = pack4(acc); }
                } }
        }
        LBAR();
        f32x4 Z[4];
        {
            if (wave < 4) {
                typedef short s16x4 __attribute__((ext_vector_type(4)));
                const int i = wave; const f32x4 at4 = *(const f32x4*)(AAB + (16 * i + c16) * FP + 16 * i + 4 * g); f32x4 a4, Sp;
#pragma unroll
                for (int j = 0; j < 4; ++j) { a4[j] = AAB[(16 * i + 4 * g + j) * FP + 16 * i + c16]; Sp[j] = at4[j] + ((4 * g + j) == c16 ? 1.f : 0.f); }
                v2u pk_ = pack4(a4), pkt_ = pack4(at4); s16x4 P = __builtin_bit_cast(s16x4, pk_), PT = __builtin_bit_cast(s16x4, pkt_);
                const f32x4 zero4 = {0.f, 0.f, 0.f, 0.f};
#pragma unroll
                for (int st = 0; st < 3; ++st) { const f32x4 p2 = __builtin_amdgcn_mfma_f32_16x16x16bf16_1k(PT, P, zero4, 0, 0, 0), pt2 = __builtin_amdgcn_mfma_f32_16x16x16bf16_1k(P, PT, zero4, 0, 0, 0);
                    pk_ = pack4(p2); pkt_ = pack4(pt2); P = __builtin_bit_cast(s16x4, pk_); PT = __builtin_bit_cast(s16x4, pkt_);
                    const v2u sp_ = pack4(Sp); Sp = __builtin_amdgcn_mfma_f32_16x16x16bf16_1k(P, __builtin_bit_cast(s16x4, sp_), Sp, 0, 0, 0); }
                *(v2u*)((unsigned char*)TII + (i * 64 + lane) * 8) = pack4(Sp); }
            if (wave < 4) {
#pragma unroll
                for (int i = 0; i < 4; ++i)
#pragma unroll
                    for (int j = 0; j < 4; ++j) Z[i][j] = bf2f(AT[(16 * i + 4 * g + j) * PITCH + 16 * wave + c16]);
            } else {
#pragma unroll
                for (int i = 0; i < 4; ++i) { f32x4 acc = {0.f, 0.f, 0.f, 0.f}; const int er = 16 * (wave - 4) + c16; Z[i] = mma2s(AAK + (16 * i + c16) * PITCH, 0, VT + er * PITCH, SWK(er), g, acc); }
            }
        }
        LBAR();
        {
            typedef short s16x4 __attribute__((ext_vector_type(4)));
            f32x4 X[4]; s16x4 Xb[4];
#pragma unroll
            for (int i = 0; i < 4; ++i) { f32x4 z = Z[i];
#pragma unroll
                for (int kb = 0; kb < 4; ++kb) if (kb < i) { const f32x4 av = *(const f32x4*)(AAB + (16 * i + c16) * FP + 16 * kb + 4 * g);
                    const v2u ap = pack4(av); z = __builtin_amdgcn_mfma_f32_16x16x16bf16_1k(__builtin_bit_cast(s16x4, ap), Xb[kb], z, 0, 0, 0); }
                const v2u tp = *(const v2u*)((const unsigned char*)TII + (i * 64 + lane) * 8), zp = pack4(z);
                const f32x4 zero4 = {0.f, 0.f, 0.f, 0.f};
                X[i] = __builtin_amdgcn_mfma_f32_16x16x16bf16_1k(__builtin_bit_cast(s16x4, tp), __builtin_bit_cast(s16x4, zp), zero4, 0, 0, 0);
                const v2u xp = pack4(X[i]); Xb[i] = __builtin_bit_cast(s16x4, xp); }
#pragma unroll
            for (int i = 0; i < 4; ++i) *(v2u*)(XT + (16 * wave + c16) * PITCH + 16 * i + 4 * g) = __builtin_bit_cast(v2u, Xb[i]);
        }
        LBAR();
        {
            const int q = wave >> 1, hh = wave & 1;
            bf16* MCg = (bf16*)(a.ws + WS_MC) + (size_t)unit * 4096; float* NCg = (float*)(a.ws + WS_NC) + (size_t)unit * 4096;
            bf16* PPg = (bf16*)(a.ws + WS_PP) + (size_t)unit * 4096; bf16* Y0g = (bf16*)(a.ws + WS_Y0) + (size_t)unit * 4096;
#pragma unroll
            for (int t2 = 0; t2 < 2; ++t2) { const int ti = 2 * hh + t2;
#pragma unroll
                for (int tj = 0; tj < 4; ++tj) { f32x4 acc = {0.f, 0.f, 0.f, 0.f}; const int cc = 16 * tj + c16, rr = 16 * ti + 4 * g;
                    if (q == 0) { acc = mma2s(XT + (16 * ti + c16) * PITCH, 0, BBT + cc * PITCH, SWK(cc), g, acc); *(v2u*)(MCg + cc * 64 + (ti >> 1) * 32 + g * 8 + (ti & 1) * 4) = pack4(acc); }
                    else if (q == 1) { const int ar = 16 * ti + c16; acc = mma2s(BBT + ar * PITCH, SWK(ar), XT + (64 + cc) * PITCH, 0, g, acc); acc = mma2s(KBT + ar * PITCH, SWK(ar), VT + cc * PITCH, SWK(cc), g, acc);
                        *(f32x4*)(NCg + cc * 64 + rr) = acc; }
                    else if (q == 2) { acc = mma2(XT + (16 * ti + c16) * PITCH + 8 * g, ARB + cc * PITCH + 8 * g, acc);
                        const v2u rv = *(const v2u*)(RT + cc * PITCH + rr); acc[0] += bf2f(rv.x & 0xffffu); acc[1] += bf2f(rv.x >> 16); acc[2] += bf2f(rv.y & 0xffffu); acc[3] += bf2f(rv.y >> 16);
                        *(v2u*)(PPg + cc * 64 + rr) = pack4(acc); }
                    else { acc = mma2(XT + (64 + 16 * ti + c16) * PITCH + 8 * g, ARB + cc * PITCH + 8 * g, acc); { const int ar = 16 * ti + c16; acc = mma2s(VT + ar * PITCH, SWK(ar), ARK + cc * PITCH, 0, g, acc); }
                        *(v2u*)(Y0g + cc * 64 + rr) = pack4(acc); }
                } }
            if (tid < 64) ((float*)(a.ws + WS_DEC))[unit * 64 + tid] = BC[64 + tid];
        }
        LBAR();
    }
}

#define LAS3 __attribute__((address_space(3)))
constexpr int R2_SLOT = 12544, R2_NS = 10, R2_FLAGS = R2_SLOT * R2_NS;
__device__ __forceinline__ void r2_scan(CArgs& a, int chain, unsigned char* L, int tid) {
    asm volatile("" : "+v"(tid));
    const int lane = tid & 63, wave = __builtin_amdgcn_readfirstlane(tid >> 6);
    const int h = chain >> 2, e0 = 16 * (chain & 3), g = lane >> 4, c16 = lane & 15;
    volatile LAS3 unsigned* flg = (volatile LAS3 unsigned*)(LAS3 unsigned char*)(L + R2_FLAGS);
    if (tid < 32) flg[tid] = 0u;
    if (tid >= 64 && tid < 64 + R2_NS) *(volatile LAS3 unsigned*)(LAS3 unsigned char*)(L + (tid - 64) * R2_SLOT + 12288 + 252) = 0xffffffffu;
    __syncthreads();
    const bf16* MC = (const bf16*)(a.ws + WS_MC); const float* NC = (const float*)(a.ws + WS_NC); const float* DEC = (const float*)(a.ws + WS_DEC);
    if (wave != 0) {
        int mco[8], nco[4];
#pragma unroll
        for (int q = 0; q < 8; ++q) { const int pos = 64 * q + lane, row = pos >> 3, kc = (pos & 7) ^ (row & 7); mco[q] = row * 64 + kc * 8; }
#pragma unroll
        for (int q = 0; q < 4; ++q) { const int pos = 64 * q + lane, e = pos >> 4, dc = (pos & 15) ^ e; nco[q] = (e0 + e) * 64 + dc * 4; }
#pragma unroll 1
        for (int c = wave - 1; c < 128; c += 7) {
            while ((int)flg[16] < c - (R2_NS - 1)) __builtin_amdgcn_s_sleep(12);
            LAS3 unsigned char* slot = (LAS3 unsigned char*)(L + (c % R2_NS) * R2_SLOT);
            const size_t unit = (size_t)c * 8 + h;
#pragma unroll
            for (int q = 0; q < 8; ++q) __builtin_amdgcn_global_load_lds((const unsigned*)(MC + unit * 4096 + mco[q]), (LAS3 unsigned*)(slot + q * 1024), 16, 0, 0);
#pragma unroll
            for (int q = 0; q < 4; ++q) __builtin_amdgcn_global_load_lds((const unsigned*)(NC + unit * 4096 + nco[q]), (LAS3 unsigned*)(slot + 8192 + q * 1024), 16, 0, 0);
            __builtin_amdgcn_global_load_lds((const unsigned*)(DEC + unit * 64 + lane), (LAS3 unsigned*)(slot + 12288), 4, 0, 0);
        }
        asm volatile("s_waitcnt vmcnt(0)" ::: "memory");
    } else {
        bf16* S0 = (bf16*)(a.ws + WS_S0) + (size_t)h * 4096 + (e0 + c16) * 64 + 4 * g;
        f32x4 S[4];
#pragma unroll
        for (int m = 0; m < 4; ++m) S[m] = (f32x4){0.f, 0.f, 0.f, 0.f};
        int avail = 0;
        const LAS3 unsigned char* Lb = (const LAS3 unsigned char*)L;
        const int offA0 = (c16 * 8 + (g ^ (c16 & 7))) * 16, offA1 = (c16 * 8 + ((4 + g) ^ (c16 & 7))) * 16;
        int offN[4];
#pragma unroll
        for (int mt = 0; mt < 4; ++mt) offN[mt] = 8192 + (c16 * 16 + ((4 * mt + g) ^ c16)) * 16;
        const int offD = 12288 + 16 * g;
#define R2_MARKS(s_) (*(volatile LAS3 unsigned*)(LAS3 unsigned char*)(L + (s_) * R2_SLOT + 12288 + 252))
#define R2_WAITS(c_, s_) do { while (avail <= (c_)) { const unsigned f0_ = R2_MARKS(s_), f1_ = R2_MARKS(((s_) + 1) % R2_NS), f2_ = R2_MARKS(((s_) + 2) % R2_NS); \
            if (f0_ != 0xffffffffu) { avail = (c_) + 1; if (f1_ != 0xffffffffu) { avail = (c_) + 2; if (f2_ != 0xffffffffu) avail = (c_) + 3; } } \
            else __builtin_amdgcn_s_sleep(0); } asm volatile("" ::: "memory"); } while (0)
        v4u A[2][4][2]; f32x4 Nn[2][4], Dd[2][4];
#define R2_READS(s_, p_) do { _Pragma("unroll") for (int mt = 0; mt < 4; ++mt) { \
                A[p_][mt][0] = *(const LAS3 v4u*)(Lb + (s_) * R2_SLOT + mt * 2048 + offA0); A[p_][mt][1] = *(const LAS3 v4u*)(Lb + (s_) * R2_SLOT + mt * 2048 + offA1); \
                Nn[p_][mt] = *(const LAS3 f32x4*)(Lb + (s_) * R2_SLOT + offN[mt]); Dd[p_][mt] = *(const LAS3 f32x4*)(Lb + (s_) * R2_SLOT + mt * 64 + offD); } } while (0)
        R2_WAITS(0, 0); R2_READS(0, 0);
        asm volatile("s_waitcnt lgkmcnt(0)" ::: "memory");
#pragma unroll 1
        for (int c0 = 0; c0 < 128; c0 += R2_NS) {
#pragma unroll
            for (int k = 0; k < R2_NS; ++k) { const int c = c0 + k;
                if (c < 128) {
                    R2_MARKS(k) = 0xffffffffu; flg[16] = (unsigned)(c + 1);
                    if (c + 1 < 128) { R2_WAITS(c + 1, (k + 1) % R2_NS); R2_READS((k + 1) % R2_NS, (k + 1) & 1); }
                    bf16* sp = S0 + (size_t)c * (8 * 4096); v2u sb[4];
#pragma unroll
                    for (int m = 0; m < 4; ++m) { sb[m] = pack4(S[m]); *(v2u*)(sp + 16 * m) = sb[m]; }
                    const v4u b0 = {sb[0].x, sb[0].y, sb[1].x, sb[1].y}, b1 = {sb[2].x, sb[2].y, sb[3].x, sb[3].y};
                    const bf16x8 B0 = __builtin_bit_cast(bf16x8, b0), B1 = __builtin_bit_cast(bf16x8, b1);
                    f32x4 acc[4];
#pragma unroll
                    for (int mt = 0; mt < 4; ++mt) acc[mt] = __builtin_amdgcn_mfma_f32_16x16x32_bf16(__builtin_bit_cast(bf16x8, A[k & 1][mt][0]), B0, Nn[k & 1][mt] + S[mt] * Dd[k & 1][mt], 0, 0, 0);
#pragma unroll
                    for (int mt = 0; mt < 4; ++mt) S[mt] = __builtin_amdgcn_mfma_f32_16x16x32_bf16(__builtin_bit_cast(bf16x8, A[k & 1][mt][1]), B1, acc[mt], 0, 0, 0);
                    asm volatile("s_waitcnt lgkmcnt(0)" ::: "memory");
                } }
        }
#undef R2_WAITS
#undef R2_MARKS
#undef R2_READS
#define R2_READ 0
#undef R2_READ
    }
    __syncthreads();
}

__device__ __forceinline__ void r3_phase(CArgs& a, size_t uo, int l, int hb, int gw, int NGW, int lane) {
    asm volatile("" : "+v"(lane));
    const int g = lane >> 4, c16 = lane & 15;
    const bf16* U = (const bf16*)(a.ws + WS_U + uo); const bf16* PP = (const bf16*)(a.ws + WS_PP); const bf16* S0 = (const bf16*)(a.ws + WS_S0); const bf16* Y0 = (const bf16*)(a.ws + WS_Y0);
    const float* BON = (const float*)(a.ws + WS_BON2); bf16* MG = (bf16*)(a.ws + WS_XN) + (size_t)hb * MH * D;
    const float* mu_v = a.in[6] + l * 1664 + 1024; const float* lnw = a.in[14] + l * 512; const float* lnb = a.in[15] + l * 512;
    const int erow = 16 * (c16 >> 2) + (c16 & 3);
#pragma unroll 1
    for (int task = gw; task < NUNIT * 4; task += NGW) {
        const int unit = task >> 2, mt = task & 3, ch = unit >> 3, h = unit & 7; const size_t ub = (size_t)unit * 4096;
        const int lr = 64 * ch + 16 * mt + c16; const bf16* urow = U + (size_t)lr * NPAD + 64 * h + 16 * g;
        float vc[16], vp[16], rgf[16];
        unpack8(*(const v4u*)(urow + C_V), vc); unpack8(*(const v4u*)(urow + C_V + 8), vc + 8); unpack8(*(const v4u*)(urow + C_RG), rgf); unpack8(*(const v4u*)(urow + C_RG + 8), rgf + 8);
        if (lr > 0) { unpack8(*(const v4u*)(urow + C_V - NPAD), vp); unpack8(*(const v4u*)(urow + C_V + 8 - NPAD), vp + 8); }
        else {
#pragma unroll
            for (int i = 0; i < 16; ++i) vp[i] = 0.f; }
        const float bon = BON[lr * 8 + h];
        const bf16* pr = PP + ub + (16 * mt + c16) * 64 + 8 * g;
        const bf16x8 B0 = *(const bf16x8*)pr, B1 = *(const bf16x8*)(pr + 32);
        f32x4 Y[4]; bf16x8 SA[4][2];
#pragma unroll
        for (int et = 0; et < 4; ++et) { const bf16* sr = S0 + ub + (erow + 4 * et) * 64 + 8 * g; SA[et][0] = *(const bf16x8*)sr; SA[et][1] = *(const bf16x8*)(sr + 32); }
        const bf16* y0p = Y0 + ub + (16 * mt + c16) * 64 + 16 * g; const v4u y0a = *(const v4u*)y0p, y0b = *(const v4u*)(y0p + 8);
        asm volatile("" ::: "memory");
        { float yf[16]; unpack8(y0a, yf); unpack8(y0b, yf + 8);
#pragma unroll
          for (int et = 0; et < 4; ++et) Y[et] = (f32x4){yf[4 * et], yf[4 * et + 1], yf[4 * et + 2], yf[4 * et + 3]}; }
#pragma unroll
        for (int et = 0; et < 4; ++et) { f32x4 acc = __builtin_amdgcn_mfma_f32_16x16x32_bf16(SA[et][0], B0, Y[et], 0, 0, 0);
            Y[et] = __builtin_amdgcn_mfma_f32_16x16x32_bf16(SA[et][1], B1, acc, 0, 0, 0); }
        const f32x4 sv = (Y[0] + Y[1]) + (Y[2] + Y[3]); float sm = (sv.x + sv.y) + (sv.z + sv.w); sm += __shfl_xor(sm, 16); sm += __shfl_xor(sm, 32);
        const float mean = sm * (1.f / 64.f); float q = 0.f;
#pragma unroll
        for (int et = 0; et < 4; ++et) { const f32x4 dd = Y[et] - mean; q += (dd.x * dd.x + dd.y * dd.y) + (dd.z * dd.z + dd.w * dd.w); }
        q += __shfl_xor(q, 16); q += __shfl_xor(q, 32);
        const float rstd = rsqrtf(q * (1.f / 64.f) + 64e-5f);
        const int cc = 64 * h + 16 * g; float o[16];
#pragma unroll
        for (int et = 0; et < 4; ++et) {
            const f32x4 w4 = *(const f32x4*)(lnw + cc + 4 * et), b4 = *(const f32x4*)(lnb + cc + 4 * et), m4 = *(const f32x4*)(mu_v + cc + 4 * et);
#pragma unroll
            for (int j = 0; j < 4; ++j) { const int i = 4 * et + j; const float vv = vc[i] + (vp[i] - vc[i]) * m4[j]; const float yn = (Y[et][j] - mean) * rstd * w4[j] + b4[j];
                o[i] = (yn + bon * vv) * rgf[i] * sigm(rgf[i]); } }
        bf16* op = MG + (size_t)lr * D + 512 + cc; *(v4u*)op = pack8(o); *(v4u*)(op + 8) = pack8(o + 8);
    }
}

constexpr int OFF_GQI = 17408, OFF_GKI = 26624, OFF_GKST = 35840, OFF_GVT = 45056, OFF_GSC = 63488, OFF_GTOT = 72704, OFF_GBC = 74752;
constexpr size_t WS_QI = 163 * MiB, WS_OI = 167 * MiB, WS_DS = 175 * MiB, WS_GDEC = 183 * MiB, WS_SP = 184 * MiB;
constexpr int NGUNIT = 512;

__device__ __forceinline__ void g1_phase(CArgs& a, size_t uo, int l, unsigned char* L, int tid0, int ufirst, int ustride) {
    asm volatile("" : "+v"(tid0));
    const int wave = __builtin_amdgcn_readfirstlane(tid0 >> 6);
    const bf16* U = (const bf16*)(a.ws + WS_U + uo);
    float* XW = (float*)L; bf16* QI = (bf16*)(L + OFF_GQI); bf16* KI = (bf16*)(L + OFF_GKI); bf16* KST = (bf16*)(L + OFF_GKST); bf16* VT = (bf16*)(L + OFF_GVT); bf16* SC = (bf16*)(L + OFF_GSC);
    float* TOT = (float*)(L + OFF_GTOT); float* BC = (float*)(L + OFF_GBC);
    float* GW = (float*)(L + OFF_GBC + 256);
    int hl = -1;
    v4u Gl0, Gl1, Gq, Gk, Gv0, Gv1;
#define G1_ISSUE(u_) do { const int lr_ = 64 * ((u_) >> 2) + (tid >> 3), h_ = (u_) & 3, dg_ = tid & 7; const bf16* ur_ = U + (size_t)lr_ * NPAD; \
        Gl0 = *(const v4u*)(ur_ + C_GLR); Gl1 = *(const v4u*)(ur_ + C_GLR + 8); Gq = *(const v4u*)(ur_ + C_GQ + 64 * h_ + 8 * dg_); Gk = *(const v4u*)(ur_ + C_GK + 64 * h_ + 8 * dg_); \
        Gv0 = *(const v4u*)(ur_ + C_GV + 128 * h_ + 16 * dg_); Gv1 = *(const v4u*)(ur_ + C_GV + 128 * h_ + 16 * dg_ + 8); } while (0)
#pragma unroll 1
    for (int unit = ufirst; unit < NGUNIT; unit += ustride) {
        int tid = tid0; asm volatile("" : "+v"(tid));
        const int lane = tid & 63, g = lane >> 4, c16 = lane & 15;
        const int ch = unit >> 2, h = unit & 3;
        if (h != hl) { hl = h; LBAR();
            for (int i = tid; i < 16 * 64; i += NTHR) GW[i] = a.in[3][l * 16 * 256 + (i >> 6) * 256 + 64 * h + (i & 63)];
            if (tid < 64) GW[1024 + tid] = a.in[4][l * 256 + 64 * h + tid];
            LBAR(); }
        const int t = tid >> 3, dg = tid & 7, d0 = 8 * dg, lr = 64 * ch + t, hc = 64 * h + d0;
        if (unit == ufirst) G1_ISSUE(unit);
        float q[8], k[8];
        {
            float glr[16]; unpack8(Gl0, glr); unpack8(Gl1, glr + 8);
            float x[8]; const float* gb = GW + 1024 + d0; const float* gu = GW + d0;
#pragma unroll
            for (int i = 0; i < 8; ++i) x[i] = gb[i];
#pragma unroll
            for (int r = 0; r < 16; ++r) { const f32x4 u0 = *(const f32x4*)(gu + r * 64), u1 = *(const f32x4*)(gu + r * 64 + 4);
                x[0] += glr[r] * u0.x; x[1] += glr[r] * u0.y; x[2] += glr[r] * u0.z; x[3] += glr[r] * u0.w; x[4] += glr[r] * u1.x; x[5] += glr[r] * u1.y; x[6] += glr[r] * u1.z; x[7] += glr[r] * u1.w; }
#pragma unroll
            for (int i = 0; i < 8; ++i) XW[t * FP + d0 + i] = (fminf(x[i], 0.f) - __logf(1.f + __expf(-fabsf(x[i])))) * (1.f / 16.f);
            unpack8(Gq, q); unpack8(Gk, k);
            float vv[16]; const int e0 = 16 * dg; unpack8(Gv0, vv); unpack8(Gv1, vv + 8);
            asm volatile("" ::: "memory");
            if (unit + ustride < NGUNIT) G1_ISSUE(unit + ustride);
#pragma unroll
            for (int i = 0; i < 16; ++i) VT[SWC(e0 + i, t)] = (bf16)f2bf(vv[i]);
        }
        LBAR();
        {
            const int d = tid & 63, tb = tid >> 6; float p[8]; float run = 0.f;
#pragma unroll
            for (int i = 0; i < 8; ++i) { run += XW[(8 * tb + i) * FP + d]; p[i] = run; }
            TOT[tb * 64 + d] = run;
            LBAR();
            float off = 0.f;
#pragma unroll
            for (int j = 0; j < 8; ++j) off += (j < tb) ? TOT[j * 64 + d] : 0.f;
#pragma unroll
            for (int i = 0; i < 8; ++i) XW[(8 * tb + i) * FP + d] = off + p[i];
            if (tb == 7) BC[d] = off + run;
        }
        LBAR();
        {
            float qi[8], ki[8];
#pragma unroll
            for (int i = 0; i < 8; ++i) { const float b = XW[t * FP + d0 + i], bc = BC[d0 + i];
                qi[i] = q[i] * 0.125f * __expf(b); ki[i] = k[i] * __expf(-b); KST[SWC(d0 + i, t)] = (bf16)f2bf(k[i] * __expf(bc - b)); }
            const v4u qp = pack8(qi);
            *(v4u*)(QI + t * PITCH + d0) = qp; *(v4u*)(KI + t * PITCH + d0) = pack8(ki);
            *(v4u*)((bf16*)(a.ws + WS_QI) + (size_t)unit * 4096 + t * 64 + d0) = qp;
        }
        LBAR();
        {
            const int tt = wave >> 1; const int tcol = 16 * tt + c16;
#pragma unroll
            for (int j2 = 0; j2 < 2; ++j2) { const int jt = 2 * (wave & 1) + j2; f32x4 acc = {0.f, 0.f, 0.f, 0.f};
                if (jt <= tt) { acc = mma2(KI + (16 * jt + c16) * PITCH + 8 * g, QI + tcol * PITCH + 8 * g, acc);
#pragma unroll
                    for (int j = 0; j < 4; ++j) if (16 * jt + 4 * g + j > tcol) acc[j] = 0.f; }
                *(v2u*)(SC + tcol * PITCH + 16 * jt + 4 * g) = pack4(acc); }
            bf16* DSg = (bf16*)(a.ws + WS_DS) + (size_t)unit * 8192;
#pragma unroll
            for (int i = 0; i < 4; ++i) { const int tile = wave * 4 + i, dt = tile & 3, et = tile >> 2; f32x4 acc = {0.f, 0.f, 0.f, 0.f};
                { const int ar = 16 * dt + c16, br = 16 * et + c16; acc = mma2s(KST + ar * PITCH, SWK(ar), VT + br * PITCH, SWK(br), g, acc); }
                *(v2u*)(DSg + (16 * et + c16) * 64 + 16 * dt + 4 * g) = pack4(acc); }
            if (tid < 64) ((float*)(a.ws + WS_GDEC))[unit * 64 + tid] = __expf(BC[tid]);
        }
        LBAR();
        {
            bf16* OIg = (bf16*)(a.ws + WS_OI) + (size_t)unit * 8192;
#pragma unroll
            for (int i = 0; i < 4; ++i) { const int tile = wave * 4 + i, tt = tile & 3, et = tile >> 2; f32x4 acc = {0.f, 0.f, 0.f, 0.f};
                { const int ar = 16 * et + c16; acc = mma2s(VT + ar * PITCH, SWK(ar), SC + (16 * tt + c16) * PITCH, 0, g, acc); }
                *(v2u*)(OIg + (16 * tt + c16) * 128 + 16 * et + 4 * g) = pack4(acc); }
        }
        LBAR();
    }
}

__device__ __forceinline__ void g2_scan(CArgs& a, int wg, unsigned char* L, int tid) {
    asm volatile("" : "+v"(tid));
    const int h = wg >> 2, e = 32 * (wg & 3) + (tid >> 4), dq = tid & 15;
    const bf16* DS = (const bf16*)(a.ws + WS_DS) + (size_t)h * 8192 + e * 64 + 4 * dq; const float* GD = (const float*)(a.ws + WS_GDEC) + (size_t)(((tid >> 4) & 15) * 4 + h) * 64 + 4 * dq;
    bf16* SP = (bf16*)(a.ws + WS_SP) + (size_t)h * 8192 + e * 64 + 4 * dq;
    float* DCL = (float*)L;
    v2u dsb[2][16]; f32x4 dcr;
    f32x4 S = {0.f, 0.f, 0.f, 0.f};
#pragma unroll
    for (int i = 0; i < 16; ++i) dsb[0][i] = *(const v2u*)(DS + (size_t)i * (4 * 8192));
    dcr = *(const f32x4*)GD;
    if (tid < 256) *(f32x4*)(DCL + (tid >> 4) * 64 + 4 * dq) = dcr;
#pragma unroll 1
    for (int b2 = 0; b2 < 8; b2 += 2) {
#pragma unroll
        for (int bb = 0; bb < 2; ++bb) { const int b = b2 + bb;
            if (b + 1 < 8) {
#pragma unroll
                for (int i = 0; i < 16; ++i) dsb[(bb + 1) & 1][i] = *(const v2u*)(DS + (size_t)(16 * (b + 1) + i) * (4 * 8192));
                dcr = *(const f32x4*)(GD + (size_t)(16 * (b + 1)) * (4 * 64)); }
            LBAR();
            const float* dcl = DCL + bb * 1024 + 4 * dq;
#pragma unroll
            for (int i = 0; i < 16; ++i) { const f32x4 dc = *(const f32x4*)(dcl + i * 64); const v2u w = dsb[bb][i];
                *(v2u*)(SP + (size_t)(16 * b + i) * (4 * 8192)) = pack4(S);
                const f32x4 dv = {bf2f(w.x & 0xffffu), bf2f(w.x >> 16), bf2f(w.y & 0xffffu), bf2f(w.y >> 16)};
                S = S * dc + dv; }
            if (b + 1 < 8 && tid < 256) *(f32x4*)(DCL + ((bb + 1) & 1) * 1024 + (tid >> 4) * 64 + 4 * dq) = dcr;
        }
    }
    LBAR();
}

__device__ __forceinline__ void g3_phase(CArgs& a, size_t uo, int l, int hb, int gw, int NGW, int lane) {
    asm volatile("" : "+v"(lane));
    const int g = lane >> 4, c16 = lane & 15;
    const bf16* U = (const bf16*)(a.ws + WS_U + uo); const bf16* QI = (const bf16*)(a.ws + WS_QI); const bf16* SP = (const bf16*)(a.ws + WS_SP); const bf16* OI = (const bf16*)(a.ws + WS_OI);
    bf16* MG = (bf16*)(a.ws + WS_XN) + (size_t)hb * MH * D; const float* gnw = a.in[5] + l * 128;
    const int erow = 32 * (c16 >> 2) + (c16 & 3);
#pragma unroll 1
    for (int task = gw; task < NGUNIT * 4; task += NGW) {
        const int unit = task >> 2, mt = task & 3, ch = unit >> 2, h = unit & 3;
        const int lr = 64 * ch + 16 * mt + c16; const bf16* urow = U + (size_t)lr * NPAD + C_GG + 128 * h + 32 * g;
        const v4u gg0 = *(const v4u*)urow, gg1 = *(const v4u*)(urow + 8), gg2 = *(const v4u*)(urow + 16), gg3 = *(const v4u*)(urow + 24);
        const bf16* qr = QI + (size_t)unit * 4096 + (16 * mt + c16) * 64 + 8 * g;
        const bf16x8 B0 = *(const bf16x8*)qr, B1 = *(const bf16x8*)(qr + 32);
        f32x4 O[8]; float ss = 0.f; bf16x8 SA[8][2];
#pragma unroll
        for (int et = 0; et < 8; ++et) { const bf16* sr = SP + (size_t)unit * 8192 + (erow + 4 * et) * 64 + 8 * g; SA[et][0] = *(const bf16x8*)sr; SA[et][1] = *(const bf16x8*)(sr + 32); }
        const bf16* oip = OI + (size_t)unit * 8192 + (16 * mt + c16) * 128 + 32 * g; const v4u oi0 = *(const v4u*)oip, oi1 = *(const v4u*)(oip + 8), oi2 = *(const v4u*)(oip + 16), oi3 = *(const v4u*)(oip + 24);
        asm volatile("" ::: "memory");
        { float of[32]; unpack8(oi0, of); unpack8(oi1, of + 8); unpack8(oi2, of + 16); unpack8(oi3, of + 24);
#pragma unroll
          for (int et = 0; et < 8; ++et) O[et] = (f32x4){of[4 * et], of[4 * et + 1], of[4 * et + 2], of[4 * et + 3]}; }
#pragma unroll
        for (int et = 0; et < 8; ++et) { f32x4 acc = __builtin_amdgcn_mfma_f32_16x16x32_bf16(SA[et][0], B0, O[et], 0, 0, 0);
            acc = __builtin_amdgcn_mfma_f32_16x16x32_bf16(SA[et][1], B1, acc, 0, 0, 0);
            O[et] = acc; ss += (acc.x * acc.x + acc.y * acc.y) + (acc.z * acc.z + acc.w * acc.w); }
        ss += __shfl_xor(ss, 16); ss += __shfl_xor(ss, 32);
        const float rstd = rsqrtf(ss * (1.f / 128.f) + 1e-6f);
        float gf[32], o[32]; unpack8(gg0, gf); unpack8(gg1, gf + 8); unpack8(gg2, gf + 16); unpack8(gg3, gf + 24);
#pragma unroll
        for (int et = 0; et < 8; ++et) { const f32x4 w4 = *(const f32x4*)(gnw + 32 * g + 4 * et);
#pragma unroll
            for (int j = 0; j < 4; ++j) { const int i = 4 * et + j; o[i] = O[et][j] * rstd * w4[j] * gf[i] * sigm(gf[i]); } }
        bf16* op = MG + (size_t)lr * D + 128 * h + 32 * g;
        *(v4u*)op = pack8(o); *(v4u*)(op + 8) = pack8(o + 8); *(v4u*)(op + 16) = pack8(o + 16); *(v4u*)(op + 24) = pack8(o + 24);
    }
}

#define LAS __attribute__((address_space(3)))
#define XB_TMO      128
#define XB_XCNT(j)  (256  + 64 * (j))
#define XB_XSUB(j)  (1280 + 64 * (j))
#define XB_XGEN(j)  (2304 + 64 * (j))
#define XB_TOP      3328
#define XB_TOPGEN   3392
#define XCD_BAR_WORDS 3456
#define XB_SPIN_CAP (1u << 18)

__device__ __forceinline__ unsigned xb_ld(unsigned* p)              { return __hip_atomic_load(p, __ATOMIC_RELAXED, __HIP_MEMORY_SCOPE_AGENT); }
__device__ __forceinline__ unsigned xb_add(unsigned* p, unsigned v) { return __hip_atomic_fetch_add(p, v, __ATOMIC_RELAXED, __HIP_MEMORY_SCOPE_AGENT); }
__device__ __forceinline__ unsigned xb_xcc_id() { return (unsigned)__builtin_amdgcn_s_getreg((3 << 11) | 20) & 0xFu; }
#define XB_SPIN(cond, bar) do { unsigned _sp = 0; while (cond) { __builtin_amdgcn_s_sleep(1); \
    if ((++_sp & 255u) == 0u) { if (xb_ld(&(bar)[XB_TMO])) break; if (_sp > XB_SPIN_CAP) { atomicAdd(&(bar)[XB_TMO], 1u); break; } } } } while (0)

struct XcdBarrier {
    unsigned* bar; unsigned x;
    volatile LAS unsigned* st;
};

__device__ __forceinline__ XcdBarrier xcd_barrier_post(unsigned* bar, volatile LAS unsigned* st) {
    XcdBarrier b; b.bar = bar; b.x = xb_xcc_id(); b.st = st;
    if (threadIdx.x == 0) (void)xb_add(&bar[XB_XCNT(b.x)], 1u);
    return b;
}
__device__ __forceinline__ void xcd_barrier_complete(unsigned* bar, unsigned x, unsigned& nloc, unsigned& nx) {
    const unsigned G = gridDim.x * gridDim.y * gridDim.z;
    unsigned sum, cnt, mine, sp = 0u;
    for (;;) {
        sum = 0u; cnt = 0u; mine = 0u;
#pragma unroll
        for (unsigned j = 0; j < 16; ++j) { const unsigned c = xb_ld(&bar[XB_XCNT(j)]); sum += c; cnt += (c > 0u) ? 1u : 0u; mine = (j == x) ? c : mine; }
        if (sum == G) break;
        __builtin_amdgcn_s_sleep(1);
        if ((++sp & 255u) == 0u) { if (xb_ld(&bar[XB_TMO])) break; if (sp > XB_SPIN_CAP) { atomicAdd(&bar[XB_TMO], 1u); break; } }
    }
    nloc = mine > 0u ? mine : 1u; nx = cnt > 0u ? cnt : 1u;
}

__device__ __forceinline__ void xcd_barrier(const XcdBarrier& b) {
    asm volatile("s_waitcnt vmcnt(0)" ::: "memory");
    __syncthreads();
    if (threadIdx.x == 0) {
        unsigned* bar = b.bar;
        __builtin_amdgcn_s_waitcnt(0);
        unsigned nloc = b.st[0], nx = b.st[1];
        if (nloc == 0u) { xcd_barrier_complete(bar, b.x, nloc, nx); b.st[0] = nloc; b.st[1] = nx; }
        const unsigned old = xb_add(&bar[XB_XSUB(b.x)], 1u);
        const unsigned gen = old / nloc;
        if (old + 1u == (gen + 1u) * nloc) {
            __builtin_amdgcn_fence(__ATOMIC_RELEASE, "agent");
            asm volatile("s_waitcnt vmcnt(0)" ::: "memory");
            const unsigned og = xb_add(&bar[XB_TOP], 1u);
            const unsigned tg = og / nx;
            if (og + 1u == (tg + 1u) * nx) xb_add(&bar[XB_TOPGEN], 1u);
            else XB_SPIN(xb_ld(&bar[XB_TOPGEN]) == tg, bar);
            __builtin_amdgcn_fence(__ATOMIC_ACQUIRE, "agent");
            xb_add(&bar[XB_XGEN(b.x)], 1u);
            asm volatile("s_waitcnt vmcnt(0)" ::: "memory");
        } else {
            XB_SPIN(xb_ld(&bar[XB_XGEN(b.x)]) == gen, bar);
            __builtin_amdgcn_fence(__ATOMIC_ACQUIRE, "agent");
            asm volatile("s_waitcnt vmcnt(0)" ::: "memory");
        }
    }
    __syncthreads();
}


__global__ void __launch_bounds__(NTHR, 2) hymba_fwd(Args a_kernarg) {
    extern __shared__ __attribute__((aligned(16))) unsigned char lds[];
    cg::grid_group grid = cg::this_grid();
    const int tid = threadIdx.x, lane = tid & 63, wave = __builtin_amdgcn_readfirstlane(tid >> 6);
    const int G = gridDim.x, gw = blockIdx.x * NWAVES + wave, NGW = G * NWAVES;
    volatile LAS unsigned* xst = (volatile LAS unsigned*)(LAS unsigned char*)(lds + LDS_BYTES - 64);
    if (tid < 2) xst[tid] = 0u;
    __syncthreads();
    const XcdBarrier xbar = xcd_barrier_post((unsigned*)AA.ws, xst);
    {
        CArgs& a = AA; bf16* XN = (bf16*)(a.ws + WS_XN);
        float* scr = (float*)lds;
        constexpr int T_IN = (D / 64) * (NPAD / 64), T_OUT = (D / 64) * (D / 64);
        for (int l = 0; l < 2; ++l) {
            transpose_tiles(a.in[2] + (size_t)l * D * NIN, D, NIN, NPAD, (bf16*)(a.ws + WS_WIN + l * WIN_BYTES), scr, (int)blockIdx.x, G, T_IN, tid);
            transpose_tiles(a.in[16] + (size_t)l * D * D, D, D, D, (bf16*)(a.ws + WS_WOUT + l * WOUT_BYTES), scr, (int)blockIdx.x, G, T_OUT, tid);
        }
        for (int m = 2 * gw; m < M; m += 2 * NGW) rms_row2(a.in[0] + (size_t)m * D, a.in[0] + (size_t)(m + 1) * D, a.in[1], XN + (size_t)m * D, XN + (size_t)(m + 1) * D, lane);
        {
            bf16* UPT = (bf16*)(a.ws + WS_UPT);
            for (int e = blockIdx.x * NTHR + tid; e < 2 * 2 * 512 * 64; e += G * NTHR) { const int r = e & 63, c = (e >> 6) & 511, q = (e >> 15) & 1, ll = e >> 16;
                UPT[e] = (bf16)f2bf((q ? a.in[10] : a.in[8])[(size_t)ll * 64 * 512 + r * 512 + c]); }
        }
    }
    if (AA.ws == nullptr) grid.sync();
    xcd_barrier(xbar);
    for (int l = 0; l < 2; ++l) {
        for (int hb = 0; hb < 2; ++hb) {
            {
                CArgs& a = AA; bf16* XN = (bf16*)(a.ws + WS_XN); bf16* U = (bf16*)(a.ws + WS_U + (size_t)hb * U_STRIDE);
                pg8::Gemm g{XN + (size_t)hb * MH * D, (const bf16*)(a.ws + WS_WIN + l * WIN_BYTES), MH, NPAD, D}; pg8::RangeOrder S;
                if (hb == 0) S.init(MH, NPAD, G, (int)blockIdx.x, 0, 480); else S.init(MH, NPAD, G, (int)blockIdx.x, EARLY_TILES, 480 - EARLY_TILES);
                pg8::EpiBf16<0> E{U, NPAD, nullptr, 0, 0, 1.f};
                pg8::gemm_phase<pg8::EpiBf16<0>, pg8::RangeOrder, true, true>((PG8_LAS unsigned char*)lds, g, S, E);
            }
            xcd_barrier(xbar);
            const size_t uo = (size_t)hb * U_STRIDE;
            r1_phase(AA, uo, l, lds, tid);
            g1_phase(AA, uo, l, lds, tid, (int)blockIdx.x, G);
            xcd_barrier(xbar);
            if (blockIdx.x < 32) r2_scan(AA, blockIdx.x, lds, tid);
            else { if (blockIdx.x < 48) g2_scan(AA, blockIdx.x - 32, lds, tid);
                if (hb == 0) {
                    CArgs& a = AA; bf16* XN = (bf16*)(a.ws + WS_XN); bf16* U1 = (bf16*)(a.ws + WS_U1);
                    pg8::Gemm g{XN + (size_t)MH * D, (const bf16*)(a.ws + WS_WIN + l * WIN_BYTES), MH, NPAD, D}; pg8::RangeOrder S; S.init(MH, NPAD, G, (int)blockIdx.x - 32, 0, EARLY_TILES);
                    pg8::EpiBf16<0> E{U1, NPAD, nullptr, 0, 0, 1.f};
                    pg8::gemm_phase<pg8::EpiBf16<0>, pg8::RangeOrder, true, true>((PG8_LAS unsigned char*)lds, g, S, E); } }
            xcd_barrier(xbar);
            r3_phase(AA, uo, l, hb, gw, NGW, lane);
            g3_phase(AA, uo, l, hb, gw, NGW, lane);
            if (hb == 1) xcd_barrier(xbar);
        }
        {
            CArgs& a = AA; bf16* XN = (bf16*)(a.ws + WS_XN);
            pg8::Gemm g{XN, (const bf16*)(a.ws + WS_WOUT + l * WOUT_BYTES), M, D, D}; pg8::StaticOrder S; S.init(M, D, G, (int)blockIdx.x);
            pg8::EpiRmsRes E{l == 0 ? a.in[0] : a.out, a.out, XN, l == 0 ? a.in[1] + D : a.in[17], (float*)(a.ws + WS_SLOTS) + (size_t)l * M * 4, (unsigned*)(a.ws + 16384) + l * 64 * 64, D, l};
            pg8::gemm_phase<pg8::EpiRmsRes, pg8::StaticOrder, false, true>((PG8_LAS unsigned char*)lds, g, S, E);
        }
        if (l == 0) xcd_barrier(xbar);
    }
}

extern "C" void kernel_launch(void* const* d_in, const int* in_sizes, int n_in, void* d_out, int out_size, void* d_ws, size_t ws_size, hipStream_t stream) {
    static int grid = 0;
    if (grid == 0) {
        if (n_in != 18 || out_size != M * D || ws_size < WS_END) { fprintf(stderr, "kernel_launch: unexpected shapes n_in %d out %d ws %zu\n", n_in, out_size, ws_size); grid = -1; return; }
        int dev = 0, cus = 0, per_cu = 0;
        hipGetDevice(&dev); hipDeviceGetAttribute(&cus, hipDeviceAttributeMultiprocessorCount, dev);
        if (hipFuncSetAttribute((const void*)hymba_fwd, hipFuncAttributeMaxDynamicSharedMemorySize, LDS_BYTES) != hipSuccess) { fprintf(stderr, "kernel_launch: hipFuncSetAttribute failed\n"); grid = -1; return; }
        if (hipOccupancyMaxActiveBlocksPerMultiprocessor(&per_cu, (const void*)hymba_fwd, NTHR, LDS_BYTES) != hipSuccess || per_cu < 1) { fprintf(stderr, "kernel_launch: occupancy query failed (%d)\n", per_cu); grid = -1; return; }
        grid = cus * 1;
        fprintf(stderr, "kernel_launch: cus %d per_cu %d grid %d\n", cus, per_cu, grid);
    }
    if (grid < 0) return;
    if (hipMemsetAsync(d_ws, 0, 65536, stream) != hipSuccess) { fprintf(stderr, "kernel_launch: memset failed\n"); return; }
    Args a{};
    for (int i = 0; i < 18; ++i) a.in[i] = (const float*)d_in[i];
    a.out = (float*)d_out; a.ws = (unsigned char*)d_ws;
    void* args[] = {&a};
    hipError_t e = hipLaunchCooperativeKernel((const void*)hymba_fwd, dim3(grid), dim3(NTHR), args, LDS_BYTES, stream);
    if (e != hipSuccess) fprintf(stderr, "cooperative launch failed: %s (grid %d)\n", hipGetErrorString(e), grid);
}
```

```cpp
#include <hip/hip_runtime.h>
#include <hip/hip_cooperative_groups.h>
#include <cstdio>
#include <cstdint>
namespace cg = cooperative_groups;
namespace pg8 {
#define PG8_LAS __attribute__((address_space(3)))
typedef unsigned short bf16_t;
typedef short bf16x8 __attribute__((ext_vector_type(8)));
typedef float f32x4 __attribute__((ext_vector_type(4)));
typedef unsigned u32x4 __attribute__((ext_vector_type(4)));
constexpr int BM = 256, BK = 64, HALF = 128, HTB = HALF * BK * 2  , STAGE_BYTES = 8 * HTB, NXCD = 8, WGM = 8;

__host__ __device__ __forceinline__ int lds_byte(int r, int c) { const int st = (r >> 4) * 2 + (c >> 5), rr = r & 15, cc = c & 31, ob = rr * 64 + cc * 2; return st * 1024 + (ob ^ (((ob >> 9) & 1) << 5)); }
__host__ __device__ __forceinline__ void stage_rc(int b, int& R, int& C) { const int st = b / 1024, sb = b % 1024, swz = sb ^ (((sb >> 9) & 1) << 5); R = (st >> 1) * 16 + swz / 64; C = (st & 1) * 32 + (swz % 64) / 2; }
__host__ __device__ __forceinline__ int perm32(int rho) { const int n = rho >> 4, i = rho & 15; return 8 * (i >> 2) + 4 * n + (i & 3); }

struct Unit { int pm, pn; };
struct Gemm { const bf16_t* A; const bf16_t* Bt; int M, N, K; };

struct StaticOrder {
    int nM, nN, nwg, G, c;
    __host__ __device__ void init(int M, int N, int G_, int c_) { nM = M / BM; nN = N / BM; nwg = nM * nN; G = G_; c = c_; }
    __host__ __device__ bool next(int i, Unit& u) const {
        const long L = (long)i * G + c; if (L >= nwg) return false;
        int wgid = (int)L; { const int q = nwg / NXCD, r = nwg % NXCD, xcd = wgid % NXCD, off = wgid / NXCD; wgid = (xcd < r ? xcd * (q + 1) : r * (q + 1) + (xcd - r) * q) + off; }
        const int nig = WGM * nN, gid = wgid / nig, fm = gid * WGM, gsz = (nM - fm) < WGM ? (nM - fm) : WGM;
        u.pm = fm + ((wgid % nig) % gsz); u.pn = (wgid % nig) / gsz; return true;
    }
    __device__ __forceinline__ void a_ready(const Unit&) const {}
    __device__ __forceinline__ void done(const Unit&) const {}
};

__device__ __forceinline__ unsigned cvt_pk_bf16(float lo, float hi) { unsigned r; asm volatile("v_cvt_pk_bf16_f32 %0, %1, %2" : "=v"(r) : "v"(lo), "v"(hi)); return r; }
typedef float f32x2 __attribute__((ext_vector_type(2)));
__device__ __forceinline__ f32x2 gelu_pk(f32x2 v) {
    const f32x2 av = __builtin_elementwise_abs(v), d = av * 0.2316418882f + 1.0f;
    f32x2 t; t.x = __builtin_amdgcn_rcpf(d.x); t.y = __builtin_amdgcn_rcpf(d.y);
    f32x2 q = t * 0.5307027145f + (-0.7265760135f); q = q * t + 0.7107068705f; q = q * t + (-0.142248368f); q = q * t + 0.127414796f; q = q * t;
    const f32x2 s = (v * v) * (-0.72134752044f);
    f32x2 e; e.x = __builtin_amdgcn_exp2f(s.x); e.y = __builtin_amdgcn_exp2f(s.y);
    const f32x2 m = v * (q * e), r = v - m;
    f32x2 o; o.x = v.x < 0.f ? m.x : r.x; o.y = v.y < 0.f ? m.y : r.y; return o;
}

template <int ACT  > struct EpiBf16 {
    static constexpr bool PERM = true, AFTER_DRAIN = false; static_assert(ACT == 0 || ACT == 1, "EpiBf16: ACT is 0 (none) or 1 (gelu_pk)");
    bf16_t* O; int ldc; const float* bias; int split_cols; size_t split_stride; float scale0;
    __device__ __forceinline__ void operator()(const f32x4 (&acc)[2][2][4][2], const Unit& u, int wr, int wc, int fr, int fq) const {
        const int row0 = u.pm * BM + wr * 64 + fr; int colt = u.pn * BM; bf16_t* base = O;
        float sc = 1.f; if (split_cols) { const int t = colt / split_cols; base += (size_t)t * split_stride; colt -= t * split_cols; if (t == 0) sc = scale0; }
        const int col0 = colt + wc * 32 + 8 * fq, bcol0 = u.pn * BM + wc * 32 + 8 * fq;
        f32x4 bv[2][2];
#pragma unroll
        for (int bj = 0; bj < 2; ++bj)
#pragma unroll
            for (int n = 0; n < 2; ++n) bv[bj][n] = bias ? *(const f32x4*)(bias + bcol0 + bj * HALF + 4 * n) : (f32x4){0.f, 0.f, 0.f, 0.f};
#pragma unroll
        for (int ai = 0; ai < 2; ++ai)
#pragma unroll
            for (int m = 0; m < 4; ++m) { bf16_t* rowp = base + (size_t)(row0 + ai * HALF + m * 16) * ldc + col0;
#pragma unroll
                for (int bj = 0; bj < 2; ++bj) { f32x4 v0 = acc[ai][bj][m][0] + bv[bj][0], v1 = acc[ai][bj][m][1] + bv[bj][1];
                    if (ACT == 1) { f32x2 a = gelu_pk((f32x2){v0[0], v0[1]}), b = gelu_pk((f32x2){v0[2], v0[3]}), c = gelu_pk((f32x2){v1[0], v1[1]}), d = gelu_pk((f32x2){v1[2], v1[3]});
                        v0 = (f32x4){a.x, a.y, b.x, b.y}; v1 = (f32x4){c.x, c.y, d.x, d.y}; }
                    v0 = v0 * sc; v1 = v1 * sc; u32x4 w; w.x = cvt_pk_bf16(v0[0], v0[1]); w.y = cvt_pk_bf16(v0[2], v0[3]); w.z = cvt_pk_bf16(v1[0], v1[1]); w.w = cvt_pk_bf16(v1[2], v1[3]);
                    *(u32x4*)(rowp + bj * HALF) = w; } }
    }
};

template <class Epi, class Sched, bool ALIGN_EPI = false, bool SP2 = false>
__device__ __forceinline__ void gemm_phase(PG8_LAS unsigned char* lds, const Gemm g, const Sched& S, const Epi& E) {
    int tid_ = threadIdx.x; asm volatile("" : "+v"(tid_));
    const int tid = tid_, wid = __builtin_amdgcn_readfirstlane(tid >> 6), lane = tid & 63, wr = wid >> 2, wc = wid & 3, fr = lane & 15, fq = lane >> 4;
    const int K = g.K, nt = K / BK;
    unsigned voffA[2], voffB[2];
#pragma unroll
    for (int i = 0; i < 2; ++i) { int R, C; stage_rc(tid * 16 + i * 8192, R, C); const int Rb = Epi::PERM ? ((R & ~31) + perm32(R & 31)) : R;
        voffA[i] = (unsigned)(R * K + C) * 2u; voffB[i] = (unsigned)(Rb * K + C) * 2u; }
    const size_t kstep = (size_t)(BK * 2);
    const size_t hstep = (size_t)HALF * K * 2;
    const size_t tstep = 2 * hstep;
    const unsigned ldsw = (unsigned)wid * 1024u;
    const int aoff = lds_byte(wr * 64 + fr, fq * 8), boff = lds_byte(wc * 32 + fr, fq * 8);
#define PG8_SA(b, h) (((b) * 2 + (h)) * HTB)
#define PG8_SB(b, h) ((4 + (b) * 2 + (h)) * HTB)
#define PG8_STAGE(bufoff, gbase, voff) do { _Pragma("unroll") for (int _i = 0; _i < 2; ++_i) \
        __builtin_amdgcn_global_load_lds((const unsigned*)((const char*)(gbase) + (voff)[_i]), (PG8_LAS unsigned*)(lds + (bufoff) + ldsw + _i * 8192), 16, 0, 0); } while (0)
#define PG8_LDA(dst, b, h) do { _Pragma("unroll") for (int m = 0; m < 4; ++m) _Pragma("unroll") for (int k = 0; k < 2; ++k) dst[m][k] = *(const PG8_LAS bf16x8*)(lds + PG8_SA(b, h) + aoff + m * 2048 + k * 1024); } while (0)
#define PG8_LDB(dst, b, h) do { _Pragma("unroll") for (int n = 0; n < 2; ++n) _Pragma("unroll") for (int k = 0; k < 2; ++k) dst[n][k] = *(const PG8_LAS bf16x8*)(lds + PG8_SB(b, h) + boff + n * 2048 + k * 1024); } while (0)
#define PG8_MMA(ai, bj, At, Bt) do { __builtin_amdgcn_s_setprio(1); _Pragma("unroll") for (int m = 0; m < 4; ++m) _Pragma("unroll") for (int n = 0; n < 2; ++n) _Pragma("unroll") for (int k = 0; k < 2; ++k) \
        acc[ai][bj][m][n] = __builtin_amdgcn_mfma_f32_16x16x32_bf16(Bt[n][k], At[m][k], acc[ai][bj][m][n], 0, 0, 0); __builtin_amdgcn_s_setprio(0); } while (0)
#define PG8_WAIT_V(n) asm volatile("s_waitcnt vmcnt(" #n ")" ::: "memory")
#define PG8_WAIT_L(n) asm volatile("s_waitcnt lgkmcnt(" #n ")" ::: "memory")
#define PG8_BAR __builtin_amdgcn_s_barrier()
#define PG8_SCHED __builtin_amdgcn_sched_barrier(0)
    Unit cur, nxt; int ui = 0;
    if (!S.next(0, cur)) return;
    f32x4 acc[2][2][4][2];
#pragma unroll
    for (int a = 0; a < 2; ++a)
#pragma unroll
        for (int b = 0; b < 2; ++b)
#pragma unroll
            for (int m = 0; m < 4; ++m)
#pragma unroll
                for (int n = 0; n < 2; ++n) acc[a][b][m][n] = (f32x4){0.f, 0.f, 0.f, 0.f};
    bf16x8 At[4][2], B0[2][2], B1[2][2];
    const char* cA = (const char*)g.A + (size_t)cur.pm * tstep; const char* cB = (const char*)g.Bt + (size_t)cur.pn * tstep;
    S.a_ready(cur);
    if constexpr (SP2) {
        PG8_STAGE(PG8_SB(0, 0), cB, voffB); PG8_STAGE(PG8_SB(0, 1), cB + hstep, voffB); PG8_STAGE(PG8_SA(0, 0), cA, voffA); PG8_STAGE(PG8_SA(0, 1), cA + hstep, voffA);
        if (wr == 1) PG8_BAR;
        PG8_WAIT_V(2); PG8_BAR;
        PG8_STAGE(PG8_SB(1, 0), cB + kstep, voffB); PG8_STAGE(PG8_SA(1, 0), cA + kstep, voffA); PG8_STAGE(PG8_SB(1, 1), cB + hstep + kstep, voffB);
        PG8_WAIT_V(6); PG8_BAR;
    } else {
        PG8_STAGE(PG8_SB(0, 0), cB, voffB); PG8_STAGE(PG8_SA(0, 0), cA, voffA); PG8_STAGE(PG8_SB(0, 1), cB + hstep, voffB); PG8_STAGE(PG8_SA(0, 1), cA + hstep, voffA);
        if (wr == 1) PG8_BAR;
        PG8_WAIT_V(4); PG8_BAR;
        PG8_STAGE(PG8_SB(1, 0), cB + kstep, voffB); PG8_STAGE(PG8_SA(1, 0), cA + kstep, voffA); PG8_STAGE(PG8_SB(1, 1), cB + hstep + kstep, voffB);
        PG8_WAIT_V(6); PG8_BAR;
    }
    for (;;) {
        const bool has_next = S.next(ui + 1, nxt);
        const char* nA = has_next ? (const char*)g.A + (size_t)nxt.pm * tstep : cA; const char* nB = has_next ? (const char*)g.Bt + (size_t)nxt.pn * tstep : cB;
        for (int t = 0; t < nt; t += 2) {
            const bool last = (t == nt - 2);
            const char* a1 = cA + (size_t)(t + 1) * kstep;
            const char* a2 = last ? nA : cA + (size_t)(t + 2) * kstep; const char* b2 = last ? nB : cB + (size_t)(t + 2) * kstep;
            const char* a3 = a2 + kstep; const char* b3 = b2 + kstep;
            if (last && has_next) S.a_ready(nxt);
            if constexpr (SP2) {
            PG8_LDB(B0, 0, 0); PG8_LDB(B1, 0, 1); PG8_SCHED; PG8_LDA(At, 0, 0); PG8_STAGE(PG8_SA(1, 1), a1 + hstep, voffA);
            PG8_WAIT_V(8); PG8_WAIT_L(0); PG8_BAR; PG8_MMA(0, 0, At, B0); PG8_MMA(0, 1, At, B1); PG8_BAR; PG8_SCHED;
            PG8_LDA(At, 0, 1); PG8_STAGE(PG8_SB(0, 0), b2, voffB); PG8_STAGE(PG8_SB(0, 1), b2 + hstep, voffB); PG8_STAGE(PG8_SA(0, 0), a2, voffA);
            PG8_WAIT_V(8); PG8_WAIT_L(0); PG8_BAR; PG8_MMA(1, 0, At, B0); PG8_MMA(1, 1, At, B1); PG8_BAR; PG8_SCHED;
            PG8_LDB(B0, 1, 0); PG8_LDB(B1, 1, 1); PG8_SCHED; PG8_LDA(At, 1, 0); PG8_STAGE(PG8_SA(0, 1), a2 + hstep, voffA);
            PG8_WAIT_V(8); PG8_WAIT_L(0); PG8_BAR; PG8_MMA(0, 0, At, B0); PG8_MMA(0, 1, At, B1); PG8_BAR; PG8_SCHED;
            PG8_LDA(At, 1, 1); PG8_STAGE(PG8_SB(1, 0), b3, voffB); PG8_STAGE(PG8_SB(1, 1), b3 + hstep, voffB); PG8_STAGE(PG8_SA(1, 0), a3, voffA);
            PG8_WAIT_V(8); PG8_WAIT_L(0); PG8_BAR; PG8_MMA(1, 0, At, B0); PG8_MMA(1, 1, At, B1); PG8_BAR; PG8_SCHED;
            } else {
            PG8_LDB(B0, 0, 0); PG8_SCHED; PG8_LDA(At, 0, 0); PG8_STAGE(PG8_SA(1, 1), a1 + hstep, voffA);
            PG8_WAIT_L(8); PG8_BAR; PG8_WAIT_L(0); PG8_MMA(0, 0, At, B0); PG8_BAR; PG8_SCHED;
            PG8_LDB(B1, 0, 1); PG8_STAGE(PG8_SB(0, 0), b2, voffB);
            PG8_BAR; PG8_WAIT_L(0); PG8_MMA(0, 1, At, B1); PG8_BAR;
            PG8_LDA(At, 0, 1); PG8_STAGE(PG8_SA(0, 0), a2, voffA);
            PG8_BAR; PG8_WAIT_L(0); PG8_MMA(1, 0, At, B0); PG8_BAR; PG8_SCHED;
            PG8_STAGE(PG8_SB(0, 1), b2 + hstep, voffB);
            PG8_WAIT_V(6); PG8_BAR; PG8_MMA(1, 1, At, B1); PG8_BAR;
            PG8_LDB(B0, 1, 0); PG8_SCHED; PG8_LDA(At, 1, 0); PG8_STAGE(PG8_SA(0, 1), a2 + hstep, voffA);
            PG8_WAIT_L(8); PG8_BAR; PG8_WAIT_L(0); PG8_MMA(0, 0, At, B0); PG8_BAR; PG8_SCHED;
            PG8_LDB(B1, 1, 1); PG8_STAGE(PG8_SB(1, 0), b3, voffB);
            PG8_BAR; PG8_WAIT_L(0); PG8_MMA(0, 1, At, B1); PG8_BAR;
            PG8_LDA(At, 1, 1); PG8_STAGE(PG8_SA(1, 0), a3, voffA);
            PG8_BAR; PG8_WAIT_L(0); PG8_MMA(1, 0, At, B0); PG8_BAR; PG8_SCHED;
            PG8_STAGE(PG8_SB(1, 1), b3 + hstep, voffB);
            PG8_WAIT_V(6); PG8_BAR; PG8_MMA(1, 1, At, B1); PG8_BAR;
            }
        }
        if constexpr (ALIGN_EPI) { if (wr == 0) PG8_BAR; }
        if constexpr (!Epi::AFTER_DRAIN) { E(acc, cur, wr, wc, fr, fq); S.done(cur); }
        if (!has_next) break;
#pragma unroll
        for (int a = 0; a < 2; ++a)
#pragma unroll
            for (int b = 0; b < 2; ++b)
#pragma unroll
                for (int m = 0; m < 4; ++m)
#pragma unroll
                    for (int n = 0; n < 2; ++n) acc[a][b][m][n] = (f32x4){0.f, 0.f, 0.f, 0.f};
        cur = nxt; cA = nA; cB = nB; ++ui;
        if constexpr (ALIGN_EPI) { if (wr == 1) PG8_BAR; }
    }
    PG8_WAIT_V(0);
    if constexpr (!ALIGN_EPI) { if (wr == 0) PG8_BAR; }
    PG8_BAR;
    if constexpr (Epi::AFTER_DRAIN) { E.fused(acc, cur, wr, wc, fr, fq, lds, wid, lane); S.done(cur); }
#undef PG8_SA
#undef PG8_SB
#undef PG8_STAGE
#undef PG8_LDA
#undef PG8_LDB
#undef PG8_MMA
#undef PG8_WAIT_V
#undef PG8_WAIT_L
#undef PG8_BAR
#undef PG8_SCHED
}
}
namespace pg8 {
struct EpiResid {
    static constexpr bool PERM = false, AFTER_DRAIN = false;
    const float* base; float* out; int ldc;
    __device__ __forceinline__ void operator()(const f32x4 (&acc)[2][2][4][2], const Unit& u, int wr, int wc, int fr, int fq) const {
        const int col0 = u.pn * BM + wc * 32 + 4 * fq;
#pragma unroll
        for (int ai = 0; ai < 2; ++ai)
#pragma unroll
            for (int m = 0; m < 4; ++m) { const size_t off = (size_t)(u.pm * BM + ai * HALF + wr * 64 + m * 16 + fr) * ldc + col0;
#pragma unroll
                for (int bj = 0; bj < 2; ++bj)
#pragma unroll
                    for (int n = 0; n < 2; ++n) { const f32x4 b = *(const f32x4*)(base + off + bj * HALF + n * 16); *(f32x4*)(out + off + bj * HALF + n * 16) = b + acc[ai][bj][m][n]; } }
    }
};
struct RangeOrder {
    int nM, nN, nwg, G, c, first, last;
    __host__ __device__ void init(int M, int N, int G_, int c_, int first_, int count_) { nM = M / BM; nN = N / BM; nwg = nM * nN; G = G_; c = c_; first = first_; last = first_ + count_; }
    __host__ __device__ bool next(int i, Unit& u) const {
        const long L = (long)first + (long)i * G + c; if (c < 0 || L >= last || L >= nwg) return false;
        int wgid = (int)L; { const int q = nwg / NXCD, r = nwg % NXCD, xcd = wgid % NXCD, off = wgid / NXCD; wgid = (xcd < r ? xcd * (q + 1) : r * (q + 1) + (xcd - r) * q) + off; }
        const int nig = WGM * nN, gid = wgid / nig, fm = gid * WGM, gsz = (nM - fm) < WGM ? (nM - fm) : WGM;
        u.pm = fm + ((wgid % nig) % gsz); u.pn = (wgid % nig) / gsz; return true;
    }
    __device__ __forceinline__ void a_ready(const Unit&) const {}
    __device__ __forceinline__ void done(const Unit&) const {}
};
struct EpiRmsRes {
    static constexpr bool PERM = false, AFTER_DRAIN = true;
    const float* base; float* out; bf16_t* xn; const float* w; float* slots; unsigned* cnt; int ldc; int mode;
    __device__ __forceinline__ void fused(f32x4 (&acc)[2][2][4][2], const Unit& u, int wr, int wc, int fr, int fq, PG8_LAS unsigned char* lds, int wid, int lane) const {
        const int col0 = u.pn * BM + wc * 32 + 4 * fq;
        PG8_LAS float* P = (PG8_LAS float*)lds; PG8_LAS float* S = (PG8_LAS float*)(lds + 4096);
#pragma unroll
        for (int ai = 0; ai < 2; ++ai)
#pragma unroll
            for (int m = 0; m < 4; ++m) { const size_t off = (size_t)(u.pm * BM + ai * HALF + wr * 64 + m * 16 + fr) * ldc + col0; float s = 0.f;
#pragma unroll
                for (int bj = 0; bj < 2; ++bj)
#pragma unroll
                    for (int n = 0; n < 2; ++n) { const f32x4 v = acc[ai][bj][m][n] + *(const f32x4*)(base + off + bj * HALF + n * 16); acc[ai][bj][m][n] = v; s += (v[0] * v[0] + v[1] * v[1]) + (v[2] * v[2] + v[3] * v[3]); }
                s += __shfl_xor(s, 16); s += __shfl_xor(s, 32);
                if (fq == 0) P[(ai * HALF + wr * 64 + m * 16 + fr) * 4 + wc] = s;
                if (m & 1) asm volatile("" ::: "memory"); }
        asm volatile("s_waitcnt lgkmcnt(0)" ::: "memory"); __builtin_amdgcn_s_barrier(); asm volatile("" ::: "memory");
        const int row = wid * 32 + (lane & 31);
        if (lane < 32) { const float tot = (P[row * 4 + 0] + P[row * 4 + 1]) + (P[row * 4 + 2] + P[row * 4 + 3]);
            __hip_atomic_store(slots + ((size_t)(u.pm * BM + row) * 4 + u.pn), tot, __ATOMIC_RELAXED, __HIP_MEMORY_SCOPE_AGENT); }
        asm volatile("s_waitcnt vmcnt(0)" ::: "memory");
        if (lane == 0) __hip_atomic_fetch_add(cnt + 64 * u.pm, 1u, __ATOMIC_RELAXED, __HIP_MEMORY_SCOPE_AGENT);
        if (wid == 0) { while ((unsigned)__builtin_amdgcn_readfirstlane(__hip_atomic_load(cnt + 64 * u.pm, __ATOMIC_RELAXED, __HIP_MEMORY_SCOPE_AGENT)) < 32u) __builtin_amdgcn_s_sleep(2);
            __builtin_amdgcn_fence(__ATOMIC_ACQUIRE, "agent"); }
        asm volatile("s_waitcnt vmcnt(0) lgkmcnt(0)" ::: "memory"); __builtin_amdgcn_s_barrier(); asm volatile("" ::: "memory");
        if (lane < 32) { const float* sl = slots + (size_t)(u.pm * BM + row) * 4; float q = 0.f;
#pragma unroll
            for (int t = 0; t < 4; ++t) q += __hip_atomic_load(sl + t, __ATOMIC_RELAXED, __HIP_MEMORY_SCOPE_AGENT);
            S[row] = 1.0f / sqrtf(q * (1.f / 1024.f) + 1e-6f); }
        asm volatile("s_waitcnt lgkmcnt(0)" ::: "memory"); __builtin_amdgcn_s_barrier(); asm volatile("" ::: "memory");
        f32x4 wv[2][2];
#pragma unroll
        for (int bj = 0; bj < 2; ++bj)
#pragma unroll
            for (int n = 0; n < 2; ++n) wv[bj][n] = *(const f32x4*)(w + col0 + bj * HALF + n * 16);
#pragma unroll
        for (int ai = 0; ai < 2; ++ai)
#pragma unroll
            for (int m = 0; m < 4; ++m) { const int r = ai * HALF + wr * 64 + m * 16 + fr; const float rs = S[r]; const size_t off = (size_t)(u.pm * BM + r) * ldc + col0;
#pragma unroll
                for (int bj = 0; bj < 2; ++bj)
#pragma unroll
                    for (int n = 0; n < 2; ++n) { const f32x4 v = acc[ai][bj][m][n]; const f32x4 nv = v * rs * wv[bj][n];
                        if (mode == 0) { *(f32x4*)(out + off + bj * HALF + n * 16) = v; typedef unsigned u32x2v __attribute__((ext_vector_type(2))); u32x2v pk; pk.x = cvt_pk_bf16(nv[0], nv[1]); pk.y = cvt_pk_bf16(nv[2], nv[3]);
                            *(u32x2v*)(xn + off + bj * HALF + n * 16) = pk; }
                        else *(f32x4*)(out + off + bj * HALF + n * 16) = nv; } }
    }
};
}
constexpr int NWAVES = 8, NTHR = 512;
constexpr int BATCH = 2, T = 8192, D = 1024, M = BATCH * T, MH = T;
constexpr int NIN = 3728, NPAD = 3840;
constexpr int C_GQ = 0, C_GK = 256, C_GV = 512, C_GLR = 1024, C_GG = 1040, C_R = 1552, C_K = 2064, C_V = 2576, C_WL = 3088, C_AL = 3152, C_RG = 3216;
constexpr size_t MiB = 1u << 20;
constexpr size_t WS_WIN = 1 * MiB, WIN_BYTES = (size_t)NPAD * D * 2;
constexpr size_t WS_WOUT = 16 * MiB, WOUT_BYTES = (size_t)D * D * 2;
constexpr size_t WS_XN = 20 * MiB;
constexpr size_t WS_U = 52 * MiB, WS_U1 = 193 * MiB, U_STRIDE = WS_U1 - WS_U;
constexpr size_t WS_SLOTS = 192 * MiB;
constexpr size_t WS_END = 254 * MiB;
constexpr int LDS_BYTES = 163840;
constexpr int EARLY_TILES = 224;

typedef unsigned short bf16;
typedef unsigned v4u __attribute__((ext_vector_type(4)));
typedef float f32x4 __attribute__((ext_vector_type(4)));
#define LDS_WAIT() asm volatile("s_waitcnt lgkmcnt(0)" ::: "memory")
#define LBAR() do { asm volatile("s_waitcnt lgkmcnt(0)" ::: "memory"); __builtin_amdgcn_s_barrier(); asm volatile("" ::: "memory"); } while (0)
__device__ __forceinline__ float bf2f(unsigned h) { return __uint_as_float(h << 16); }
__device__ __forceinline__ unsigned f2bf(float f) { unsigned u = __float_as_uint(f); return (u + 0x7fffu + ((u >> 16) & 1u)) >> 16; }
typedef __bf16 bf16x2_t __attribute__((ext_vector_type(2)));
typedef float f32x2_t __attribute__((ext_vector_type(2)));
__device__ __forceinline__ unsigned pk2(float lo, float hi) { const f32x2_t v = {lo, hi}; const bf16x2_t b = __builtin_convertvector(v, bf16x2_t); return __builtin_bit_cast(unsigned, b); }
__device__ __forceinline__ float wave_sum(float v) {
#pragma unroll
    for (int o = 1; o < 64; o <<= 1) v += __shfl_xor(v, o);
    return v;
}
__device__ __forceinline__ float sigm(float x) { return __builtin_amdgcn_rcpf(1.f + __expf(-x)); }
__device__ __forceinline__ float tanh_fast(float x) { return 1.f - 2.f * __builtin_amdgcn_rcpf(1.f + __expf(2.f * x)); }
__device__ __forceinline__ float rl(float v, int l) { return __int_as_float(__builtin_amdgcn_readlane(__float_as_int(v), l)); }

typedef short bf16x8 __attribute__((ext_vector_type(8)));
typedef unsigned v2u __attribute__((ext_vector_type(2)));
__device__ __forceinline__ v2u pack4(f32x4 v) { v2u r; r.x = pk2(v.x, v.y); r.y = pk2(v.z, v.w); return r; }
__device__ __forceinline__ void unpack8(v4u w, float* o) { o[0] = bf2f(w.x & 0xffffu); o[1] = bf2f(w.x >> 16); o[2] = bf2f(w.y & 0xffffu); o[3] = bf2f(w.y >> 16);
    o[4] = bf2f(w.z & 0xffffu); o[5] = bf2f(w.z >> 16); o[6] = bf2f(w.w & 0xffffu); o[7] = bf2f(w.w >> 16); }
__device__ __forceinline__ v4u pack8(const float* v) { v4u r; r.x = pk2(v[0], v[1]); r.y = pk2(v[2], v[3]); r.z = pk2(v[4], v[5]); r.w = pk2(v[6], v[7]); return r; }
struct Args { const float* in[18]; float* out; unsigned char* ws; };
typedef const Args __attribute__((address_space(4))) CArgs;
__device__ __forceinline__ CArgs* opaque_args() { CArgs* p = (CArgs*)__builtin_amdgcn_kernarg_segment_ptr(); asm volatile("" : "+s"(p)); return p; }
#define AA (*opaque_args())

__device__ __forceinline__ void rms_row2(const float* x0, const float* x1, const float* w, bf16* o0, bf16* o1, int lane) {
    const f32x4* r0 = (const f32x4*)x0 + lane; const f32x4* r1 = (const f32x4*)x1 + lane; const f32x4* wr = (const f32x4*)w + lane;
    f32x4 a[4], b[4]; float sa = 0.f, sb = 0.f;
#pragma unroll
    for (int j = 0; j < 4; ++j) { a[j] = r0[64 * j]; b[j] = r1[64 * j]; }
#pragma unroll
    for (int j = 0; j < 4; ++j) { sa += (a[j].x * a[j].x + a[j].y * a[j].y) + (a[j].z * a[j].z + a[j].w * a[j].w); sb += (b[j].x * b[j].x + b[j].y * b[j].y) + (b[j].z * b[j].z + b[j].w * b[j].w); }
    const float ra = rsqrtf(wave_sum(sa) * (1.f / D) + 1e-6f), rb = rsqrtf(wave_sum(sb) * (1.f / D) + 1e-6f);
#pragma unroll
    for (int j = 0; j < 4; ++j) { const f32x4 ww = wr[64 * j]; const f32x4 oa = a[j] * ra * ww, ob = b[j] * rb * ww;
        ((v2u*)o0 + lane)[64 * j] = pack4(oa); ((v2u*)o1 + lane)[64 * j] = pack4(ob); }
}
__device__ __forceinline__ void transpose_item(const float* W, int K, int N, int Npad, bf16* WT, float* scr, int item, int lane) {
    const int nblk = Npad / 32, kb = item / nblk, nb = item % nblk, k0 = 64 * kb, n0 = 32 * nb;
    const int n = n0 + (lane & 31);
#pragma unroll 8
    for (int i = 0; i < 32; ++i) { const int kk = 2 * i + (lane >> 5); scr[kk * 33 + (lane & 31)] = (n < N) ? W[(size_t)(k0 + kk) * N + n] : 0.f; }
    LDS_WAIT();
    const int c = lane & 7;
#pragma unroll
    for (int j = 0; j < 4; ++j) { const int nn = (lane >> 3) + 8 * j; const float* s = scr + (8 * c) * 33 + nn;
        v4u o; o.x = pk2(s[0 * 33], s[1 * 33]); o.y = pk2(s[2 * 33], s[3 * 33]); o.z = pk2(s[4 * 33], s[5 * 33]); o.w = pk2(s[6 * 33], s[7 * 33]);
        *(v4u*)(WT + (size_t)(n0 + nn) * K + k0 + 8 * c) = o; }
    LDS_WAIT();
}
__device__ __forceinline__ void transpose_tiles(const float* W, int K, int N, int Npad, bf16* WT, float* scr  , int first, int stride, int ntiles, int tid) {
    const int nblk = Npad / 64, kr = tid >> 4, nq = tid & 15;
    f32x4 v0 = {0.f, 0.f, 0.f, 0.f}, v1 = v0;
    if (first < ntiles) { const int kb = first / nblk, nb = first % nblk, n = 64 * nb + 4 * nq; if (n < N) { v0 = *(const f32x4*)(W + (size_t)(64 * kb + kr) * N + n); v1 = *(const f32x4*)(W + (size_t)(64 * kb + 32 + kr) * N + n); } }
#pragma unroll 1
    for (int it = first; it < ntiles; it += stride) {
        const int kb = it / nblk, nb = it % nblk;
        scr[kr * 65 + 4 * nq] = v0.x; scr[kr * 65 + 4 * nq + 1] = v0.y; scr[kr * 65 + 4 * nq + 2] = v0.z; scr[kr * 65 + 4 * nq + 3] = v0.w;
        scr[(32 + kr) * 65 + 4 * nq] = v1.x; scr[(32 + kr) * 65 + 4 * nq + 1] = v1.y; scr[(32 + kr) * 65 + 4 * nq + 2] = v1.z; scr[(32 + kr) * 65 + 4 * nq + 3] = v1.w;
        const int nx = it + stride; v0 = (f32x4){0.f, 0.f, 0.f, 0.f}; v1 = v0;
        if (nx < ntiles) { const int kb2 = nx / nblk, nb2 = nx % nblk, n = 64 * nb2 + 4 * nq; if (n < N) { v0 = *(const f32x4*)(W + (size_t)(64 * kb2 + kr) * N + n); v1 = *(const f32x4*)(W + (size_t)(64 * kb2 + 32 + kr) * N + n); } }
        LBAR();
        { const int n = tid >> 3, kc = tid & 7; const float* sp = scr + (8 * kc) * 65 + n; float o[8];
#pragma unroll
          for (int j = 0; j < 8; ++j) o[j] = sp[j * 65];
          *(v4u*)(WT + (size_t)(64 * nb + n) * K + 64 * kb + 8 * kc) = pack8(o); }
        LBAR();
    }
}
__device__ __forceinline__ void rms_row(const float* xrow, const float* w, bf16* obf, float* of32, int lane) {
    const f32x4* xr = (const f32x4*)xrow + lane; const f32x4* wr = (const f32x4*)w + lane;
    f32x4 v[4]; float s = 0.f;
#pragma unroll
    for (int j = 0; j < 4; ++j) { v[j] = xr[64 * j]; s += (v[j].x * v[j].x + v[j].y * v[j].y) + (v[j].z * v[j].z + v[j].w * v[j].w); }
    const float rs = rsqrtf(wave_sum(s) * (1.f / D) + 1e-6f);
#pragma unroll
    for (int j = 0; j < 4; ++j) { const f32x4 ww = wr[64 * j]; f32x4 o = v[j] * rs * ww;
        if (of32) ((f32x4*)of32 + lane)[64 * j] = o;
        else ((unsigned long long*)obf + lane)[64 * j] = (unsigned long long)pk2(o.x, o.y) | ((unsigned long long)pk2(o.z, o.w) << 32); }
}

constexpr int PITCH = 72, FP = 68, TP = 20;
constexpr int OFF_TW = 0, OFF_AL = 9216, OFF_ARK = 18432, OFF_XA = 27648, OFF_XW = 45056, OFF_AT = 63488, OFF_RT = 72704, OFF_BH = 81920, OFF_KH = 91136,
              OFF_BBT = 100352, OFF_KBT = 109568, OFF_VT = 118784, OFF_TII = 128000, OFF_TOT = 133120, OFF_BC = 135168;
constexpr int OFF_AAK = OFF_TW, OFF_ARB = OFF_AL, OFF_AAB = OFF_XA, OFF_XT = OFF_XW;
constexpr size_t WS_MC = 112 * MiB, WS_NC = 120 * MiB, WS_PP = 136 * MiB, WS_Y0 = 144 * MiB, WS_S0 = 152 * MiB, WS_DEC = 160 * MiB, WS_BON2 = 161 * MiB, WS_UPT = 162 * MiB;
constexpr int NUNIT = 1024;

__device__ __forceinline__ f32x4 mma2s(const bf16* Ab, int ak, const bf16* Bb, int bk, int g, f32x4 acc) {
    acc = __builtin_amdgcn_mfma_f32_16x16x32_bf16(*(const bf16x8*)(Ab + ((g ^ ak) << 3)), *(const bf16x8*)(Bb + ((g ^ bk) << 3)), acc, 0, 0, 0);
    acc = __builtin_amdgcn_mfma_f32_16x16x32_bf16(*(const bf16x8*)(Ab + (((g + 4) ^ ak) << 3)), *(const bf16x8*)(Bb + (((g + 4) ^ bk) << 3)), acc, 0, 0, 0);
    return acc;
}
#define SWK(row) (((row) >> 3) & 7)
#define SWC(row, t) ((row) * PITCH + ((((t) >> 3) ^ SWK(row)) << 3) + ((t) & 7))
__device__ __forceinline__ f32x4 mma2(const bf16* Arow, const bf16* Brow, f32x4 acc) {
    acc = __builtin_amdgcn_mfma_f32_16x16x32_bf16(*(const bf16x8*)(Arow), *(const bf16x8*)(Brow), acc, 0, 0, 0);
    acc = __builtin_amdgcn_mfma_f32_16x16x32_bf16(*(const bf16x8*)(Arow + 32), *(const bf16x8*)(Brow + 32), acc, 0, 0, 0);
    return acc;
}

__device__ __forceinline__ void r1_phase(CArgs& a, size_t uo, int l, unsigned char* L, int tid0) {
    asm volatile("" : "+v"(tid0));
    const int wave = __builtin_amdgcn_readfirstlane(tid0 >> 6);
    const bf16* U = (const bf16*)(a.ws + WS_U + uo);
    bf16* TW = (bf16*)(L + 138240 + 2560); bf16* ALm = (bf16*)(L + 138240 + 2560 + 9216);
    bf16* ARK = (bf16*)(L + OFF_ARK); bf16* AAK = (bf16*)(L + OFF_AAK); bf16* ARB = (bf16*)(L + OFF_ARB);
    float* XA = (float*)(L + OFF_XA); float* XW = (float*)(L + OFF_XW); float* AAB = (float*)(L + OFF_AAB); bf16* XT = (bf16*)(L + OFF_XT);
    bf16* AT = (bf16*)(L + OFF_AT); bf16* RT = (bf16*)(L + OFF_RT); bf16* BH = (bf16*)(L + OFF_BH); bf16* KH = (bf16*)(L + OFF_KH);
    bf16* BBT = (bf16*)(L + OFF_BBT); bf16* KBT = (bf16*)(L + OFF_KBT); bf16* VT = (bf16*)(L + OFF_VT);
    float* TII = (float*)(L + OFF_TII); float* TOT = (float*)(L + OFF_TOT); float* BC = (float*)(L + OFF_BC);
    const bf16* UPT = (const bf16*)(a.ws + WS_UPT) + (size_t)l * 2 * 512 * 64;
    const float* mu = a.in[6] + l * 1664;
    float* WTS = (float*)(L + 135680);
    const int ch = (int)blockIdx.x >> 1, hbase = 4 * ((int)blockIdx.x & 1);
    v4u Lrc, Lkc, Lvc, Lrp, Lkp, Lvp; bf16x8 wfa0, wfa1; float pw[8];
#define R1_ISSUE(h_) do { const int lr_ = 64 * ch + (tid >> 3); const bf16* uq_ = U + (size_t)lr_ * NPAD + 64 * (h_) + 8 * (tid & 7); \
        Lrc = *(const v4u*)(uq_ + C_R); Lkc = *(const v4u*)(uq_ + C_K); Lvc = *(const v4u*)(uq_ + C_V); Lrp = (v4u){0u, 0u, 0u, 0u}; Lkp = Lrp; Lvp = Lrp; \
        if (lr_ > 0) { Lrp = *(const v4u*)(uq_ + C_R - NPAD); Lkp = *(const v4u*)(uq_ + C_K - NPAD); Lvp = *(const v4u*)(uq_ + C_V - NPAD); } \
        if (tid < 64) { const int c_ = l * 512 + 64 * (h_) + tid; pw[0] = a.in[7][c_]; pw[1] = a.in[9][c_]; pw[2] = a.in[11][c_]; pw[3] = a.in[12][c_]; pw[4] = a.in[13][c_]; \
            pw[5] = mu[64 * (h_) + tid]; pw[6] = mu[512 + 64 * (h_) + tid]; pw[7] = mu[1024 + 64 * (h_) + tid]; } \
        { const bf16* WT_ = UPT + (size_t)(wave >> 2) * 512 * 64 + (size_t)(64 * (h_) + 16 * (wave & 3) + (tid & 15)) * 64 + 8 * ((tid & 63) >> 4); wfa0 = *(const bf16x8*)WT_; wfa1 = *(const bf16x8*)(WT_ + 32); } } while (0)
    {
        int tid = tid0; asm volatile("" : "+v"(tid));
        R1_ISSUE(hbase);
        const int t = tid >> 3, cg = tid & 7, lr = 64 * ch + t; const bf16* up = U + (size_t)lr * NPAD + C_WL + 16 * cg;
        const v4u c0 = *(const v4u*)up, c1 = *(const v4u*)(up + 8); v4u p0 = {0u, 0u, 0u, 0u}, p1 = p0;
        if (lr > 0) { p0 = *(const v4u*)(up - NPAD); p1 = *(const v4u*)(up - NPAD + 8); }
        float cu[16], pr[16], o[16]; unpack8(c0, cu); unpack8(c1, cu + 8); unpack8(p0, pr); unpack8(p1, pr + 8);
        const float* mp = mu + 1536 + 16 * cg;
#pragma unroll
        for (int i = 0; i < 16; ++i) { float mv = cu[i] + (pr[i] - cu[i]) * mp[i]; if (cg < 4) mv = tanh_fast(mv); o[i] = mv; }
        bf16* dst = (cg < 4 ? TW : ALm) + t * PITCH + 16 * (cg & 3);
        *(v4u*)dst = pack8(o); *(v4u*)(dst + 8) = pack8(o + 8);
    }
#pragma unroll 1
    for (int hi = 0; hi < 4; ++hi) {
        int tid = tid0; asm volatile("" : "+v"(tid));
        const int lane = tid & 63, g = lane >> 4, c16 = lane & 15;
        const int h = hbase + hi, unit = ch * 8 + h;
        const int t = tid >> 3, dg = tid & 7, d0 = 8 * dg, lr = 64 * ch + t, hc = 64 * h + d0;
        if (tid < 64) {
#pragma unroll
            for (int q = 0; q < 8; ++q) WTS[64 * q + tid] = pw[q]; }
        LBAR();
        {
            const int q = wave >> 2, dt = wave & 3;
            const bf16x8 a0 = wfa0, a1 = wfa1;
            const bf16* Bm = q ? ALm : TW; float* X = q ? XA : XW;
#pragma unroll
            for (int tt = 0; tt < 4; ++tt) { const bf16* br = Bm + (16 * tt + c16) * PITCH + 8 * g; f32x4 acc = {0.f, 0.f, 0.f, 0.f};
                acc = __builtin_amdgcn_mfma_f32_16x16x32_bf16(a0, *(const bf16x8*)br, acc, 0, 0, 0);
                acc = __builtin_amdgcn_mfma_f32_16x16x32_bf16(a1, *(const bf16x8*)(br + 32), acc, 0, 0, 0);
                *(f32x4*)(X + (16 * tt + c16) * FP + 16 * dt + 4 * g) = acc; }
        }
        LBAR();
        float r[8], kq[8], v[8], al[8], be[8], lw[8];
        {
            float rc[8], rp[8], kc[8], kp[8], vc[8], vp[8];
            unpack8(Lrc, rc); unpack8(Lkc, kc); unpack8(Lvc, vc); unpack8(Lrp, rp); unpack8(Lkp, kp); unpack8(Lvp, vp);
            const float* w0p = WTS + d0; const float* a0p = WTS + 64 + d0; const float* kkp = WTS + 128 + d0;
            const float* kap = WTS + 192 + d0; const float* rkp = WTS + 256 + d0;
            float nn = 0.f, bon = 0.f, kk[8], av[8];
#pragma unroll
            for (int i = 0; i < 8; ++i) {
                const float xw = XW[t * FP + d0 + i] + w0p[i], xa = XA[t * FP + d0 + i] + a0p[i];
                lw[i] = -0.60653065971f * sigm(xw); av[i] = sigm(xa);
                r[i] = rc[i] + (rp[i] - rc[i]) * WTS[320 + d0 + i]; const float k = kc[i] + (kp[i] - kc[i]) * WTS[384 + d0 + i]; v[i] = vc[i] + (vp[i] - vc[i]) * WTS[448 + d0 + i];
                kk[i] = k * kkp[i]; nn += kk[i] * kk[i];
                kq[i] = k * (1.f + (av[i] - 1.f) * kap[i]); bon += r[i] * kq[i] * rkp[i];
            }
            nn += __shfl_xor(nn, 1); nn += __shfl_xor(nn, 2); nn += __shfl_xor(nn, 4);
            bon += __shfl_xor(bon, 1); bon += __shfl_xor(bon, 2); bon += __shfl_xor(bon, 4);
            const float inv = __builtin_amdgcn_rsqf(fmaxf(nn, 1e-24f));
#pragma unroll
            for (int i = 0; i < 8; ++i) { const float kn = kk[i] * inv; al[i] = -kn; be[i] = av[i] * kn; XW[t * FP + d0 + i] = lw[i]; }
            if (dg == 0) ((float*)(a.ws + WS_BON2))[lr * 8 + h] = bon;
        }
        LBAR();
        {
            const int d = tid & 63, tb = tid >> 6; float p[8]; float run = 0.f;
#pragma unroll
            for (int i = 0; i < 8; ++i) { run += XW[(8 * tb + i) * FP + d]; p[i] = run; }
            TOT[tb * 64 + d] = run;
            LBAR();
            float off = 0.f;
#pragma unroll
            for (int j = 0; j < 8; ++j) off += (j < tb) ? TOT[j * 64 + d] : 0.f;
#pragma unroll
            for (int i = 0; i < 8; ++i) XW[(8 * tb + i) * FP + d] = off + p[i];
            if (tb == 7) { BC[d] = off + run; BC[64 + d] = __expf(off + run); }
        }
        LBAR();
        {
            float at[8], rt[8], bh[8], kh[8];
#pragma unroll
            for (int i = 0; i < 8; ++i) { const float b = XW[t * FP + d0 + i];
                const float eb = __expf(b), enb = __builtin_amdgcn_rcpf(eb), ebp = __expf(b - lw[i]), ebc = BC[64 + d0 + i] * enb;
                at[i] = al[i] * ebp; rt[i] = r[i] * eb; bh[i] = be[i] * enb; kh[i] = kq[i] * enb;
                BBT[SWC(d0 + i, t)] = (bf16)f2bf(be[i] * ebc); KBT[SWC(d0 + i, t)] = (bf16)f2bf(kq[i] * ebc); VT[SWC(d0 + i, t)] = (bf16)f2bf(v[i]); }
            *(v4u*)(AT + t * PITCH + d0) = pack8(at); *(v4u*)(RT + t * PITCH + d0) = pack8(rt); *(v4u*)(BH + t * PITCH + d0) = pack8(bh); *(v4u*)(KH + t * PITCH + d0) = pack8(kh);
        }
        asm volatile("" ::: "memory");
        if (hi + 1 < 4) R1_ISSUE(h + 1);
        LBAR();
        {
            const int q = wave >> 1, mh = wave & 1;
            const bf16* As = (q < 2) ? AT : RT; const bf16* Bs = (q & 1) ? KH : BH;
#pragma unroll
            for (int t2 = 0; t2 < 2; ++t2) { const int tt = t2 == 0 ? mh : 3 - mh; const int tcol = 16 * tt + c16;
#pragma unroll
                for (int jt = 0; jt < 4; ++jt) {
                    f32x4 acc = {0.f, 0.f, 0.f, 0.f};
                    if (jt <= tt) { acc = mma2(Bs + (16 * jt + c16) * PITCH + 8 * g, As + tcol * PITCH + 8 * g, acc);
#pragma unroll
                        for (int j = 0; j < 4; ++j) { const int jj = 16 * jt + 4 * g + j; const bool keep = (q < 2) ? (jj < tcol) : (jj <= tcol); if (!keep) acc[j] = 0.f; } }
                    if (q == 0) *(f32x4*)(AAB + tcol * FP + 16 * jt + 4 * g) = acc;
                    else { bf16* dst = (q == 1 ? AAK : (q == 2 ? ARB : ARK)); *(v2u*)(dst + tcol * PITCH + 16 * jt + 4 * g) = pack4(acc); }
                } }
        }
        LBAR();
        f32x4 Z[4];
        {
            if (wave < 4) {
                typedef short s16x4 __attribute__((ext_vector_type(4)));
                const int i = wave; const f32x4 at4 = *(const f32x4*)(AAB + (16 * i + c16) * FP + 16 * i + 4 * g); f32x4 a4, Sp;
#pragma unroll
                for (int j = 0; j < 4; ++j) { a4[j] = AAB[(16 * i + 4 * g + j) * FP + 16 * i + c16]; Sp[j] = at4[j] + ((4 * g + j) == c16 ? 1.f : 0.f); }
                v2u pk_ = pack4(a4), pkt_ = pack4(at4); s16x4 P = __builtin_bit_cast(s16x4, pk_), PT = __builtin_bit_cast(s16x4, pkt_);
                const f32x4 zero4 = {0.f, 0.f, 0.f, 0.f};
#pragma unroll
                for (int st = 0; st < 3; ++st) { const f32x4 p2 = __builtin_amdgcn_mfma_f32_16x16x16bf16_1k(PT, P, zero4, 0, 0, 0), pt2 = __builtin_amdgcn_mfma_f32_16x16x16bf16_1k(P, PT, zero4, 0, 0, 0);
                    pk_ = pack4(p2); pkt_ = pack4(pt2); P = __builtin_bit_cast(s16x4, pk_); PT = __builtin_bit_cast(s16x4, pkt_);
                    const v2u sp_ = pack4(Sp); Sp = __builtin_amdgcn_mfma_f32_16x16x16bf16_1k(P, __builtin_bit_cast(s16x4, sp_), Sp, 0, 0, 0); }
                *(v2u*)((unsigned char*)TII + (i * 64 + lane) * 8) = pack4(Sp); }
            if (wave < 4) {
#pragma unroll
                for (int i = 0; i < 4; ++i)
#pragma unroll
                    for (int j = 0; j < 4; ++j) Z[i][j] = bf2f(AT[(16 * i + 4 * g + j) * PITCH + 16 * wave + c16]);
            } else {
#pragma unroll
                for (int i = 0; i < 4; ++i) { f32x4 acc = {0.f, 0.f, 0.f, 0.f}; const int er = 16 * (wave - 4) + c16; Z[i] = mma2s(AAK + (16 * i + c16) * PITCH, 0, VT + er * PITCH, SWK(er), g, acc); }
            }
        }
        LBAR();
        {
            typedef short s16x4 __attribute__((ext_vector_type(4)));
            f32x4 X[4]; s16x4 Xb[4];
#pragma unroll
            for (int i = 0; i < 4; ++i) { f32x4 z = Z[i];
#pragma unroll
                for (int kb = 0; kb < 4; ++kb) if (kb < i) { const f32x4 av = *(const f32x4*)(AAB + (16 * i + c16) * FP + 16 * kb + 4 * g);
                    const v2u ap = pack4(av); z = __builtin_amdgcn_mfma_f32_16x16x16bf16_1k(__builtin_bit_cast(s16x4, ap), Xb[kb], z, 0, 0, 0); }
                const v2u tp = *(const v2u*)((const unsigned char*)TII + (i * 64 + lane) * 8), zp = pack4(z);
                const f32x4 zero4 = {0.f, 0.f, 0.f, 0.f};
                X[i] = __builtin_amdgcn_mfma_f32_16x16x16bf16_1k(__builtin_bit_cast(s16x4, tp), __builtin_bit_cast(s16x4, zp), zero4, 0, 0, 0);
                const v2u xp = pack4(X[i]); Xb[i] = __builtin_bit_cast(s16x4, xp); }
#pragma unroll
            for (int i = 0; i < 4; ++i) *(v2u*)(XT + (16 * wave + c16) * PITCH + 16 * i + 4 * g) = __builtin_bit_cast(v2u, Xb[i]);
        }
        LBAR();
        {
            const int ps = wave & 1, ti = wave >> 1;
            bf16* MCg = (bf16*)(a.ws + WS_MC) + (size_t)unit * 4096; float* NCg = (float*)(a.ws + WS_NC) + (size_t)unit * 4096;
            bf16* PPg = (bf16*)(a.ws + WS_PP) + (size_t)unit * 4096; bf16* Y0g = (bf16*)(a.ws + WS_Y0) + (size_t)unit * 4096;
#pragma unroll
            for (int tj = 0; tj < 4; ++tj) { const int cc = 16 * tj + c16, rr = 16 * ti + 4 * g, ar = 16 * ti + c16; f32x4 acc = {0.f, 0.f, 0.f, 0.f}, acc2 = {0.f, 0.f, 0.f, 0.f};
                if (ps == 0) {
                    acc = mma2s(XT + ar * PITCH, 0, BBT + cc * PITCH, SWK(cc), g, acc); *(v2u*)(MCg + cc * 64 + (ti >> 1) * 32 + g * 8 + (ti & 1) * 4) = pack4(acc);
                    acc2 = mma2s(BBT + ar * PITCH, SWK(ar), XT + (64 + cc) * PITCH, 0, g, acc2); acc2 = mma2s(KBT + ar * PITCH, SWK(ar), VT + cc * PITCH, SWK(cc), g, acc2);
                    *(f32x4*)(NCg + cc * 64 + rr) = acc2;
                } else {
                    acc = mma2(XT + ar * PITCH + 8 * g, ARB + cc * PITCH + 8 * g, acc);
                    const v2u rv = *(const v2u*)(RT + cc * PITCH + rr); acc[0] += bf2f(rv.x & 0xffffu); acc[1] += bf2f(rv.x >> 16); acc[2] += bf2f(rv.y & 0xffffu); acc[3] += bf2f(rv.y >> 16);
                    *(v2u*)(PPg + cc * 64 + rr) = pack4(acc);
                    acc2 = mma2(XT + (64 + ar) * PITCH + 8 * g, ARB + cc * PITCH + 8 * g, acc2); acc2 = mma2s(VT + ar * PITCH, SWK(ar), ARK + cc * PITCH, 0, g, acc2);
                    *(v2u*)(Y0g + cc * 64 + rr) = pack4(acc2);
                } }
            if (tid < 64) ((float*)(a.ws + WS_DEC))[unit * 64 + tid] = BC[64 + tid];
        }
        LBAR();
    }
}

#define LAS3 __attribute__((address_space(3)))
constexpr int R2_SLOT = 12544, R2_NS = 10, R2_FLAGS = R2_SLOT * R2_NS;
__device__ __forceinline__ void r2_scan(CArgs& a, int chain, unsigned char* L, int tid) {
    asm volatile("" : "+v"(tid));
    const int lane = tid & 63, wave = __builtin_amdgcn_readfirstlane(tid >> 6);
    const int h = chain >> 2, e0 = 16 * (chain & 3), g = lane >> 4, c16 = lane & 15;
    volatile LAS3 unsigned* flg = (volatile LAS3 unsigned*)(LAS3 unsigned char*)(L + R2_FLAGS);
    if (tid < 32) flg[tid] = 0u;
    if (tid >= 64 && tid < 64 + R2_NS) *(volatile LAS3 unsigned*)(LAS3 unsigned char*)(L + (tid - 64) * R2_SLOT + 12288 + 252) = 0xffffffffu;
    __syncthreads();
    const bf16* MC = (const bf16*)(a.ws + WS_MC); const float* NC = (const float*)(a.ws + WS_NC); const float* DEC = (const float*)(a.ws + WS_DEC);
    if (wave != 0) {
        int mco[8], nco[4];
#pragma unroll
        for (int q = 0; q < 8; ++q) { const int pos = 64 * q + lane, row = pos >> 3, kc = (pos & 7) ^ (row & 7); mco[q] = row * 64 + kc * 8; }
#pragma unroll
        for (int q = 0; q < 4; ++q) { const int pos = 64 * q + lane, e = pos >> 4, dc = (pos & 15) ^ e; nco[q] = (e0 + e) * 64 + dc * 4; }
#pragma unroll 1
        for (int c = wave - 1; c < 128; c += 7) {
            while ((int)flg[16] < c - (R2_NS - 1)) __builtin_amdgcn_s_sleep(12);
            LAS3 unsigned char* slot = (LAS3 unsigned char*)(L + (c % R2_NS) * R2_SLOT);
            const size_t unit = (size_t)c * 8 + h;
#pragma unroll
            for (int q = 0; q < 8; ++q) __builtin_amdgcn_global_load_lds((const unsigned*)(MC + unit * 4096 + mco[q]), (LAS3 unsigned*)(slot + q * 1024), 16, 0, 0);
#pragma unroll
            for (int q = 0; q < 4; ++q) __builtin_amdgcn_global_load_lds((const unsigned*)(NC + unit * 4096 + nco[q]), (LAS3 unsigned*)(slot + 8192 + q * 1024), 16, 0, 0);
            __builtin_amdgcn_global_load_lds((const unsigned*)(DEC + unit * 64 + lane), (LAS3 unsigned*)(slot + 12288), 4, 0, 0);
        }
        asm volatile("s_waitcnt vmcnt(0)" ::: "memory");
    } else {
        bf16* S0 = (bf16*)(a.ws + WS_S0) + (size_t)h * 4096 + (e0 + c16) * 64 + 4 * g;
        f32x4 S[4];
#pragma unroll
        for (int m = 0; m < 4; ++m) S[m] = (f32x4){0.f, 0.f, 0.f, 0.f};
        int avail = 0;
        const LAS3 unsigned char* Lb = (const LAS3 unsigned char*)L;
        const int offA0 = (c16 * 8 + (g ^ (c16 & 7))) * 16, offA1 = (c16 * 8 + ((4 + g) ^ (c16 & 7))) * 16;
        int offN[4];
#pragma unroll
        for (int mt = 0; mt < 4; ++mt) offN[mt] = 8192 + (c16 * 16 + ((4 * mt + g) ^ c16)) * 16;
        const int offD = 12288 + 16 * g;
#define R2_MARKS(s_) (*(volatile LAS3 unsigned*)(LAS3 unsigned char*)(L + (s_) * R2_SLOT + 12288 + 252))
#define R2_WAITS(c_, s_) do { while (avail <= (c_)) { const unsigned f0_ = R2_MARKS(s_), f1_ = R2_MARKS(((s_) + 1) % R2_NS), f2_ = R2_MARKS(((s_) + 2) % R2_NS); \
            if (f0_ != 0xffffffffu) { avail = (c_) + 1; if (f1_ != 0xffffffffu) { avail = (c_) + 2; if (f2_ != 0xffffffffu) avail = (c_) + 3; } } \
            else __builtin_amdgcn_s_sleep(0); } asm volatile("" ::: "memory"); } while (0)
        v4u A[2][4][2]; f32x4 Nn[2][4], Dd[2][4];
#define R2_READS(s_, p_) do { _Pragma("unroll") for (int mt = 0; mt < 4; ++mt) { \
                A[p_][mt][0] = *(const LAS3 v4u*)(Lb + (s_) * R2_SLOT + mt * 2048 + offA0); A[p_][mt][1] = *(const LAS3 v4u*)(Lb + (s_) * R2_SLOT + mt * 2048 + offA1); \
                Nn[p_][mt] = *(const LAS3 f32x4*)(Lb + (s_) * R2_SLOT + offN[mt]); Dd[p_][mt] = *(const LAS3 f32x4*)(Lb + (s_) * R2_SLOT + mt * 64 + offD); } } while (0)
        R2_WAITS(0, 0); R2_READS(0, 0);
        asm volatile("s_waitcnt lgkmcnt(0)" ::: "memory");
#pragma unroll 1
        for (int c0 = 0; c0 < 128; c0 += R2_NS) {
#pragma unroll
            for (int k = 0; k < R2_NS; ++k) { const int c = c0 + k;
                if (c < 128) {
                    R2_MARKS(k) = 0xffffffffu; flg[16] = (unsigned)(c + 1);
                    if (c + 1 < 128) { R2_WAITS(c + 1, (k + 1) % R2_NS); R2_READS((k + 1) % R2_NS, (k + 1) & 1); }
                    bf16* sp = S0 + (size_t)c * (8 * 4096); v2u sb[4];
#pragma unroll
                    for (int m = 0; m < 4; ++m) { sb[m] = pack4(S[m]); *(v2u*)(sp + 16 * m) = sb[m]; }
                    const v4u b0 = {sb[0].x, sb[0].y, sb[1].x, sb[1].y}, b1 = {sb[2].x, sb[2].y, sb[3].x, sb[3].y};
                    const bf16x8 B0 = __builtin_bit_cast(bf16x8, b0), B1 = __builtin_bit_cast(bf16x8, b1);
                    f32x4 acc[4];
#pragma unroll
                    for (int mt = 0; mt < 4; ++mt) acc[mt] = __builtin_amdgcn_mfma_f32_16x16x32_bf16(__builtin_bit_cast(bf16x8, A[k & 1][mt][0]), B0, Nn[k & 1][mt] + S[mt] * Dd[k & 1][mt], 0, 0, 0);
#pragma unroll
                    for (int mt = 0; mt < 4; ++mt) S[mt] = __builtin_amdgcn_mfma_f32_16x16x32_bf16(__builtin_bit_cast(bf16x8, A[k & 1][mt][1]), B1, acc[mt], 0, 0, 0);
                    asm volatile("s_waitcnt lgkmcnt(0)" ::: "memory");
                } }
        }
#undef R2_WAITS
#undef R2_MARKS
#undef R2_READS
#define R2_READ 0
#undef R2_READ
    }
    __syncthreads();
}

__device__ __forceinline__ void r3_phase(CArgs& a, size_t uo, int l, int hb, int gw, int NGW, int lane) {
    asm volatile("" : "+v"(lane));
    const int g = lane >> 4, c16 = lane & 15;
    const bf16* U = (const bf16*)(a.ws + WS_U + uo); const bf16* PP = (const bf16*)(a.ws + WS_PP); const bf16* S0 = (const bf16*)(a.ws + WS_S0); const bf16* Y0 = (const bf16*)(a.ws + WS_Y0);
    const float* BON = (const float*)(a.ws + WS_BON2); bf16* MG = (bf16*)(a.ws + WS_XN) + (size_t)hb * MH * D;
    const float* mu_v = a.in[6] + l * 1664 + 1024; const float* lnw = a.in[14] + l * 512; const float* lnb = a.in[15] + l * 512;
    const int erow = 16 * (c16 >> 2) + (c16 & 3);
#pragma unroll 1
    for (int task = gw; task < NUNIT * 4; task += NGW) {
        const int unit = task >> 2, mt = task & 3, ch = unit >> 3, h = unit & 7; const size_t ub = (size_t)unit * 4096;
        const int lr = 64 * ch + 16 * mt + c16; const bf16* urow = U + (size_t)lr * NPAD + 64 * h + 16 * g;
        float vc[16], vp[16], rgf[16];
        unpack8(*(const v4u*)(urow + C_V), vc); unpack8(*(const v4u*)(urow + C_V + 8), vc + 8); unpack8(*(const v4u*)(urow + C_RG), rgf); unpack8(*(const v4u*)(urow + C_RG + 8), rgf + 8);
        if (lr > 0) { unpack8(*(const v4u*)(urow + C_V - NPAD), vp); unpack8(*(const v4u*)(urow + C_V + 8 - NPAD), vp + 8); }
        else {
#pragma unroll
            for (int i = 0; i < 16; ++i) vp[i] = 0.f; }
        const float bon = BON[lr * 8 + h];
        const bf16* pr = PP + ub + (16 * mt + c16) * 64 + 8 * g;
        const bf16x8 B0 = *(const bf16x8*)pr, B1 = *(const bf16x8*)(pr + 32);
        f32x4 Y[4]; bf16x8 SA[4][2];
#pragma unroll
        for (int et = 0; et < 4; ++et) { const bf16* sr = S0 + ub + (erow + 4 * et) * 64 + 8 * g; SA[et][0] = *(const bf16x8*)sr; SA[et][1] = *(const bf16x8*)(sr + 32); }
        const bf16* y0p = Y0 + ub + (16 * mt + c16) * 64 + 16 * g; const v4u y0a = *(const v4u*)y0p, y0b = *(const v4u*)(y0p + 8);
        asm volatile("" ::: "memory");
        { float yf[16]; unpack8(y0a, yf); unpack8(y0b, yf + 8);
#pragma unroll
          for (int et = 0; et < 4; ++et) Y[et] = (f32x4){yf[4 * et], yf[4 * et + 1], yf[4 * et + 2], yf[4 * et + 3]}; }
#pragma unroll
        for (int et = 0; et < 4; ++et) { f32x4 acc = __builtin_amdgcn_mfma_f32_16x16x32_bf16(SA[et][0], B0, Y[et], 0, 0, 0);
            Y[et] = __builtin_amdgcn_mfma_f32_16x16x32_bf16(SA[et][1], B1, acc, 0, 0, 0); }
        const f32x4 sv = (Y[0] + Y[1]) + (Y[2] + Y[3]); float sm = (sv.x + sv.y) + (sv.z + sv.w); sm += __shfl_xor(sm, 16); sm += __shfl_xor(sm, 32);
        const float mean = sm * (1.f / 64.f); float q = 0.f;
#pragma unroll
        for (int et = 0; et < 4; ++et) { const f32x4 dd = Y[et] - mean; q += (dd.x * dd.x + dd.y * dd.y) + (dd.z * dd.z + dd.w * dd.w); }
        q += __shfl_xor(q, 16); q += __shfl_xor(q, 32);
        const float rstd = rsqrtf(q * (1.f / 64.f) + 64e-5f);
        const int cc = 64 * h + 16 * g; float o[16];
#pragma unroll
        for (int et = 0; et < 4; ++et) {
            const f32x4 w4 = *(const f32x4*)(lnw + cc + 4 * et), b4 = *(const f32x4*)(lnb + cc + 4 * et), m4 = *(const f32x4*)(mu_v + cc + 4 * et);
#pragma unroll
            for (int j = 0; j < 4; ++j) { const int i = 4 * et + j; const float vv = vc[i] + (vp[i] - vc[i]) * m4[j]; const float yn = (Y[et][j] - mean) * rstd * w4[j] + b4[j];
                o[i] = (yn + bon * vv) * rgf[i] * sigm(rgf[i]); } }
        bf16* op = MG + (size_t)lr * D + 512 + cc; *(v4u*)op = pack8(o); *(v4u*)(op + 8) = pack8(o + 8);
    }
}

constexpr int OFF_GQI = 17408, OFF_GKI = 26624, OFF_GKST = 35840, OFF_GVT = 45056, OFF_GSC = 63488, OFF_GTOT = 72704, OFF_GBC = 74752;
constexpr size_t WS_QI = 163 * MiB, WS_OI = 167 * MiB, WS_DS = 175 * MiB, WS_GDEC = 183 * MiB, WS_SP = 184 * MiB;
constexpr int NGUNIT = 512;

__device__ __forceinline__ void g1_phase(CArgs& a, size_t uo, int l, unsigned char* L, int tid0, int ufirst, int ustride) {
    asm volatile("" : "+v"(tid0));
    const int wave = __builtin_amdgcn_readfirstlane(tid0 >> 6);
    const bf16* U = (const bf16*)(a.ws + WS_U + uo);
    float* XW = (float*)L; bf16* QI = (bf16*)(L + OFF_GQI); bf16* KI = (bf16*)(L + OFF_GKI); bf16* KST = (bf16*)(L + OFF_GKST); bf16* VT = (bf16*)(L + OFF_GVT); bf16* SC = (bf16*)(L + OFF_GSC);
    float* TOT = (float*)(L + OFF_GTOT); float* BC = (float*)(L + OFF_GBC);
    float* GW = (float*)(L + OFF_GBC + 256);
    int hl = -1;
    v4u Gl0, Gl1, Gq, Gk, Gv0, Gv1;
#define G1_ISSUE(u_) do { const int lr_ = 64 * ((u_) >> 2) + (tid >> 3), h_ = (u_) & 3, dg_ = tid & 7; const bf16* ur_ = U + (size_t)lr_ * NPAD; \
        Gl0 = *(const v4u*)(ur_ + C_GLR); Gl1 = *(const v4u*)(ur_ + C_GLR + 8); Gq = *(const v4u*)(ur_ + C_GQ + 64 * h_ + 8 * dg_); Gk = *(const v4u*)(ur_ + C_GK + 64 * h_ + 8 * dg_); \
        Gv0 = *(const v4u*)(ur_ + C_GV + 128 * h_ + 16 * dg_); Gv1 = *(const v4u*)(ur_ + C_GV + 128 * h_ + 16 * dg_ + 8); } while (0)
#pragma unroll 1
    for (int unit = ufirst; unit < NGUNIT; unit += ustride) {
        int tid = tid0; asm volatile("" : "+v"(tid));
        const int lane = tid & 63, g = lane >> 4, c16 = lane & 15;
        const int ch = unit >> 2, h = unit & 3;
        if (h != hl) { hl = h; LBAR();
            for (int i = tid; i < 16 * 64; i += NTHR) GW[i] = a.in[3][l * 16 * 256 + (i >> 6) * 256 + 64 * h + (i & 63)];
            if (tid < 64) GW[1024 + tid] = a.in[4][l * 256 + 64 * h + tid];
            LBAR(); }
        const int t = tid >> 3, dg = tid & 7, d0 = 8 * dg, lr = 64 * ch + t, hc = 64 * h + d0;
        if (unit == ufirst) G1_ISSUE(unit);
        float q[8], k[8];
        {
            float glr[16]; unpack8(Gl0, glr); unpack8(Gl1, glr + 8);
            float x[8]; const float* gb = GW + 1024 + d0; const float* gu = GW + d0;
#pragma unroll
            for (int i = 0; i < 8; ++i) x[i] = gb[i];
#pragma unroll
            for (int r = 0; r < 16; ++r) { const f32x4 u0 = *(const f32x4*)(gu + r * 64), u1 = *(const f32x4*)(gu + r * 64 + 4);
                x[0] += glr[r] * u0.x; x[1] += glr[r] * u0.y; x[2] += glr[r] * u0.z; x[3] += glr[r] * u0.w; x[4] += glr[r] * u1.x; x[5] += glr[r] * u1.y; x[6] += glr[r] * u1.z; x[7] += glr[r] * u1.w; }
#pragma unroll
            for (int i = 0; i < 8; ++i) XW[t * FP + d0 + i] = (fminf(x[i], 0.f) - __logf(1.f + __expf(-fabsf(x[i])))) * (1.f / 16.f);
            unpack8(Gq, q); unpack8(Gk, k);
            float vv[16]; const int e0 = 16 * dg; unpack8(Gv0, vv); unpack8(Gv1, vv + 8);
            asm volatile("" ::: "memory");
            if (unit + ustride < NGUNIT) G1_ISSUE(unit + ustride);
#pragma unroll
            for (int i = 0; i < 16; ++i) VT[SWC(e0 + i, t)] = (bf16)f2bf(vv[i]);
        }
        LBAR();
        {
            const int d = tid & 63, tb = tid >> 6; float p[8]; float run = 0.f;
#pragma unroll
            for (int i = 0; i < 8; ++i) { run += XW[(8 * tb + i) * FP + d]; p[i] = run; }
            TOT[tb * 64 + d] = run;
            LBAR();
            float off = 0.f;
#pragma unroll
            for (int j = 0; j < 8; ++j) off += (j < tb) ? TOT[j * 64 + d] : 0.f;
#pragma unroll
            for (int i = 0; i < 8; ++i) XW[(8 * tb + i) * FP + d] = off + p[i];
            if (tb == 7) BC[d] = off + run;
        }
        LBAR();
        {
            float qi[8], ki[8];
#pragma unroll
            for (int i = 0; i < 8; ++i) { const float b = XW[t * FP + d0 + i], bc = BC[d0 + i];
                qi[i] = q[i] * 0.125f * __expf(b); ki[i] = k[i] * __expf(-b); KST[SWC(d0 + i, t)] = (bf16)f2bf(k[i] * __expf(bc - b)); }
            const v4u qp = pack8(qi);
            *(v4u*)(QI + t * PITCH + d0) = qp; *(v4u*)(KI + t * PITCH + d0) = pack8(ki);
            *(v4u*)((bf16*)(a.ws + WS_QI) + (size_t)unit * 4096 + t * 64 + d0) = qp;
        }
        LBAR();
        {
            const int tt = wave >> 1; const int tcol = 16 * tt + c16;
#pragma unroll
            for (int j2 = 0; j2 < 2; ++j2) { const int jt = 2 * (wave & 1) + j2; f32x4 acc = {0.f, 0.f, 0.f, 0.f};
                if (jt <= tt) { acc = mma2(KI + (16 * jt + c16) * PITCH + 8 * g, QI + tcol * PITCH + 8 * g, acc);
#pragma unroll
                    for (int j = 0; j < 4; ++j) if (16 * jt + 4 * g + j > tcol) acc[j] = 0.f; }
                *(v2u*)(SC + tcol * PITCH + 16 * jt + 4 * g) = pack4(acc); }
            bf16* DSg = (bf16*)(a.ws + WS_DS) + (size_t)unit * 8192;
#pragma unroll
            for (int i = 0; i < 4; ++i) { const int tile = wave * 4 + i, dt = tile & 3, et = tile >> 2; f32x4 acc = {0.f, 0.f, 0.f, 0.f};
                { const int ar = 16 * dt + c16, br = 16 * et + c16; acc = mma2s(KST + ar * PITCH, SWK(ar), VT + br * PITCH, SWK(br), g, acc); }
                *(v2u*)(DSg + (16 * et + c16) * 64 + 16 * dt + 4 * g) = pack4(acc); }
            if (tid < 64) ((float*)(a.ws + WS_GDEC))[unit * 64 + tid] = __expf(BC[tid]);
        }
        LBAR();
        {
            bf16* OIg = (bf16*)(a.ws + WS_OI) + (size_t)unit * 8192;
#pragma unroll
            for (int i = 0; i < 4; ++i) { const int tile = wave * 4 + i, tt = tile & 3, et = tile >> 2; f32x4 acc = {0.f, 0.f, 0.f, 0.f};
                { const int ar = 16 * et + c16; acc = mma2s(VT + ar * PITCH, SWK(ar), SC + (16 * tt + c16) * PITCH, 0, g, acc); }
                *(v2u*)(OIg + (16 * tt + c16) * 128 + 16 * et + 4 * g) = pack4(acc); }
        }
        LBAR();
    }
}

__device__ __forceinline__ void g2_scan(CArgs& a, int wg, unsigned char* L, int tid) {
    asm volatile("" : "+v"(tid));
    const int h = wg >> 2, e = 32 * (wg & 3) + (tid >> 4), dq = tid & 15;
    const bf16* DS = (const bf16*)(a.ws + WS_DS) + (size_t)h * 8192 + e * 64 + 4 * dq; const float* GD = (const float*)(a.ws + WS_GDEC) + (size_t)(((tid >> 4) & 15) * 4 + h) * 64 + 4 * dq;
    bf16* SP = (bf16*)(a.ws + WS_SP) + (size_t)h * 8192 + e * 64 + 4 * dq;
    float* DCL = (float*)L;
    v2u dsb[2][16]; f32x4 dcr;
    f32x4 S = {0.f, 0.f, 0.f, 0.f};
#pragma unroll
    for (int i = 0; i < 16; ++i) dsb[0][i] = *(const v2u*)(DS + (size_t)i * (4 * 8192));
    dcr = *(const f32x4*)GD;
    if (tid < 256) *(f32x4*)(DCL + (tid >> 4) * 64 + 4 * dq) = dcr;
#pragma unroll 1
    for (int b2 = 0; b2 < 8; b2 += 2) {
#pragma unroll
        for (int bb = 0; bb < 2; ++bb) { const int b = b2 + bb;
            if (b + 1 < 8) {
#pragma unroll
                for (int i = 0; i < 16; ++i) dsb[(bb + 1) & 1][i] = *(const v2u*)(DS + (size_t)(16 * (b + 1) + i) * (4 * 8192));
                dcr = *(const f32x4*)(GD + (size_t)(16 * (b + 1)) * (4 * 64)); }
            LBAR();
            const float* dcl = DCL + bb * 1024 + 4 * dq;
#pragma unroll
            for (int i = 0; i < 16; ++i) { const f32x4 dc = *(const f32x4*)(dcl + i * 64); const v2u w = dsb[bb][i];
                *(v2u*)(SP + (size_t)(16 * b + i) * (4 * 8192)) = pack4(S);
                const f32x4 dv = {bf2f(w.x & 0xffffu), bf2f(w.x >> 16), bf2f(w.y & 0xffffu), bf2f(w.y >> 16)};
                S = S * dc + dv; }
            if (b + 1 < 8 && tid < 256) *(f32x4*)(DCL + ((bb + 1) & 1) * 1024 + (tid >> 4) * 64 + 4 * dq) = dcr;
        }
    }
    LBAR();
}

__device__ __forceinline__ void g3_phase(CArgs& a, size_t uo, int l, int hb, int gw, int NGW, int lane) {
    asm volatile("" : "+v"(lane));
    const int g = lane >> 4, c16 = lane & 15;
    const bf16* U = (const bf16*)(a.ws + WS_U + uo); const bf16* QI = (const bf16*)(a.ws + WS_QI); const bf16* SP = (const bf16*)(a.ws + WS_SP); const bf16* OI = (const bf16*)(a.ws + WS_OI);
    bf16* MG = (bf16*)(a.ws + WS_XN) + (size_t)hb * MH * D; const float* gnw = a.in[5] + l * 128;
    const int erow = 32 * (c16 >> 2) + (c16 & 3);
#pragma unroll 1
    for (int task = gw; task < NGUNIT * 4; task += NGW) {
        const int unit = task >> 2, mt = task & 3, ch = unit >> 2, h = unit & 3;
        const int lr = 64 * ch + 16 * mt + c16; const bf16* urow = U + (size_t)lr * NPAD + C_GG + 128 * h + 32 * g;
        const v4u gg0 = *(const v4u*)urow, gg1 = *(const v4u*)(urow + 8), gg2 = *(const v4u*)(urow + 16), gg3 = *(const v4u*)(urow + 24);
        const bf16* qr = QI + (size_t)unit * 4096 + (16 * mt + c16) * 64 + 8 * g;
        const bf16x8 B0 = *(const bf16x8*)qr, B1 = *(const bf16x8*)(qr + 32);
        f32x4 O[8]; float ss = 0.f; bf16x8 SA[8][2];
#pragma unroll
        for (int et = 0; et < 8; ++et) { const bf16* sr = SP + (size_t)unit * 8192 + (erow + 4 * et) * 64 + 8 * g; SA[et][0] = *(const bf16x8*)sr; SA[et][1] = *(const bf16x8*)(sr + 32); }
        const bf16* oip = OI + (size_t)unit * 8192 + (16 * mt + c16) * 128 + 32 * g; const v4u oi0 = *(const v4u*)oip, oi1 = *(const v4u*)(oip + 8), oi2 = *(const v4u*)(oip + 16), oi3 = *(const v4u*)(oip + 24);
        asm volatile("" ::: "memory");
        { float of[32]; unpack8(oi0, of); unpack8(oi1, of + 8); unpack8(oi2, of + 16); unpack8(oi3, of + 24);
#pragma unroll
          for (int et = 0; et < 8; ++et) O[et] = (f32x4){of[4 * et], of[4 * et + 1], of[4 * et + 2], of[4 * et + 3]}; }
#pragma unroll
        for (int et = 0; et < 8; ++et) { f32x4 acc = __builtin_amdgcn_mfma_f32_16x16x32_bf16(SA[et][0], B0, O[et], 0, 0, 0);
            acc = __builtin_amdgcn_mfma_f32_16x16x32_bf16(SA[et][1], B1, acc, 0, 0, 0);
            O[et] = acc; ss += (acc.x * acc.x + acc.y * acc.y) + (acc.z * acc.z + acc.w * acc.w); }
        ss += __shfl_xor(ss, 16); ss += __shfl_xor(ss, 32);
        const float rstd = rsqrtf(ss * (1.f / 128.f) + 1e-6f);
        float gf[32], o[32]; unpack8(gg0, gf); unpack8(gg1, gf + 8); unpack8(gg2, gf + 16); unpack8(gg3, gf + 24);
#pragma unroll
        for (int et = 0; et < 8; ++et) { const f32x4 w4 = *(const f32x4*)(gnw + 32 * g + 4 * et);
#pragma unroll
            for (int j = 0; j < 4; ++j) { const int i = 4 * et + j; o[i] = O[et][j] * rstd * w4[j] * gf[i] * sigm(gf[i]); } }
        bf16* op = MG + (size_t)lr * D + 128 * h + 32 * g;
        *(v4u*)op = pack8(o); *(v4u*)(op + 8) = pack8(o + 8); *(v4u*)(op + 16) = pack8(o + 16); *(v4u*)(op + 24) = pack8(o + 24);
    }
}

#define LAS __attribute__((address_space(3)))
#define XB_TMO      128
#define XB_XCNT(j)  (256  + 64 * (j))
#define XB_XSUB(j)  (1280 + 64 * (j))
#define XB_XGEN(j)  (2304 + 64 * (j))
#define XB_TOP      3328
#define XB_TOPGEN   3392
#define XCD_BAR_WORDS 3456
#define XB_SPIN_CAP (1u << 18)

__device__ __forceinline__ unsigned xb_ld(unsigned* p)              { return __hip_atomic_load(p, __ATOMIC_RELAXED, __HIP_MEMORY_SCOPE_AGENT); }
__device__ __forceinline__ unsigned xb_add(unsigned* p, unsigned v) { return __hip_atomic_fetch_add(p, v, __ATOMIC_RELAXED, __HIP_MEMORY_SCOPE_AGENT); }
__device__ __forceinline__ unsigned xb_xcc_id() { return (unsigned)__builtin_amdgcn_s_getreg((3 << 11) | 20) & 0xFu; }
#define XB_SPIN(cond, bar) do { unsigned _sp = 0; while (cond) { __builtin_amdgcn_s_sleep(1); \
    if ((++_sp & 255u) == 0u) { if (xb_ld(&(bar)[XB_TMO])) break; if (_sp > XB_SPIN_CAP) { atomicAdd(&(bar)[XB_TMO], 1u); break; } } } } while (0)

struct XcdBarrier {
    unsigned* bar; unsigned x;
    volatile LAS unsigned* st;
};

__device__ __forceinline__ XcdBarrier xcd_barrier_post(unsigned* bar, volatile LAS unsigned* st) {
    XcdBarrier b; b.bar = bar; b.x = xb_xcc_id(); b.st = st;
    if (threadIdx.x == 0) (void)xb_add(&bar[XB_XCNT(b.x)], 1u);
    return b;
}
__device__ __forceinline__ void xcd_barrier_complete(unsigned* bar, unsigned x, unsigned& nloc, unsigned& nx) {
    const unsigned G = gridDim.x * gridDim.y * gridDim.z;
    unsigned sum, cnt, mine, sp = 0u;
    for (;;) {
        sum = 0u; cnt = 0u; mine = 0u;
#pragma unroll
        for (unsigned j = 0; j < 16; ++j) { const unsigned c = xb_ld(&bar[XB_XCNT(j)]); sum += c; cnt += (c > 0u) ? 1u : 0u; mine = (j == x) ? c : mine; }
        if (sum == G) break;
        __builtin_amdgcn_s_sleep(1);
        if ((++sp & 255u) == 0u) { if (xb_ld(&bar[XB_TMO])) break; if (sp > XB_SPIN_CAP) { atomicAdd(&bar[XB_TMO], 1u); break; } }
    }
    nloc = mine > 0u ? mine : 1u; nx = cnt > 0u ? cnt : 1u;
}

__device__ __forceinline__ void xcd_barrier(const XcdBarrier& b) {
    asm volatile("s_waitcnt vmcnt(0)" ::: "memory");
    __syncthreads();
    if (threadIdx.x == 0) {
        unsigned* bar = b.bar;
        __builtin_amdgcn_s_waitcnt(0);
        unsigned nloc = b.st[0], nx = b.st[1];
        if (nloc == 0u) { xcd_barrier_complete(bar, b.x, nloc, nx); b.st[0] = nloc; b.st[1] = nx; }
        const unsigned old = xb_add(&bar[XB_XSUB(b.x)], 1u);
        const unsigned gen = old / nloc;
        if (old + 1u == (gen + 1u) * nloc) {
            __builtin_amdgcn_fence(__ATOMIC_RELEASE, "agent");
            asm volatile("s_waitcnt vmcnt(0)" ::: "memory");
            const unsigned og = xb_add(&bar[XB_TOP], 1u);
            const unsigned tg = og / nx;
            if (og + 1u == (tg + 1u) * nx) xb_add(&bar[XB_TOPGEN], 1u);
            else XB_SPIN(xb_ld(&bar[XB_TOPGEN]) == tg, bar);
            __builtin_amdgcn_fence(__ATOMIC_ACQUIRE, "agent");
            xb_add(&bar[XB_XGEN(b.x)], 1u);
            asm volatile("s_waitcnt vmcnt(0)" ::: "memory");
        } else {
            XB_SPIN(xb_ld(&bar[XB_XGEN(b.x)]) == gen, bar);
            __builtin_amdgcn_fence(__ATOMIC_ACQUIRE, "agent");
            asm volatile("s_waitcnt vmcnt(0)" ::: "memory");
        }
    }
    __syncthreads();
}


__global__ void __launch_bounds__(NTHR, 2) hymba_fwd(Args a_kernarg) {
    extern __shared__ __attribute__((aligned(16))) unsigned char lds[];
    cg::grid_group grid = cg::this_grid();
    const int tid = threadIdx.x, lane = tid & 63, wave = __builtin_amdgcn_readfirstlane(tid >> 6);
    const int G = gridDim.x, gw = blockIdx.x * NWAVES + wave, NGW = G * NWAVES;
    volatile LAS unsigned* xst = (volatile LAS unsigned*)(LAS unsigned char*)(lds + LDS_BYTES - 64);
    if (tid < 2) xst[tid] = 0u;
    __syncthreads();
    const XcdBarrier xbar = xcd_barrier_post((unsigned*)AA.ws, xst);
    {
        CArgs& a = AA; bf16* XN = (bf16*)(a.ws + WS_XN);
        float* scr = (float*)lds;
        constexpr int T_IN = (D / 64) * (NPAD / 64), T_OUT = (D / 64) * (D / 64);
        for (int l = 0; l < 2; ++l) {
            transpose_tiles(a.in[2] + (size_t)l * D * NIN, D, NIN, NPAD, (bf16*)(a.ws + WS_WIN + l * WIN_BYTES), scr, (int)blockIdx.x, G, T_IN, tid);
            transpose_tiles(a.in[16] + (size_t)l * D * D, D, D, D, (bf16*)(a.ws + WS_WOUT + l * WOUT_BYTES), scr, (int)blockIdx.x, G, T_OUT, tid);
        }
        for (int m = 2 * gw; m < M; m += 2 * NGW) rms_row2(a.in[0] + (size_t)m * D, a.in[0] + (size_t)(m + 1) * D, a.in[1], XN + (size_t)m * D, XN + (size_t)(m + 1) * D, lane);
        {
            bf16* UPT = (bf16*)(a.ws + WS_UPT);
            for (int e = blockIdx.x * NTHR + tid; e < 2 * 2 * 512 * 64; e += G * NTHR) { const int r = e & 63, c = (e >> 6) & 511, q = (e >> 15) & 1, ll = e >> 16;
                UPT[e] = (bf16)f2bf((q ? a.in[10] : a.in[8])[(size_t)ll * 64 * 512 + r * 512 + c]); }
        }
    }
    if (AA.ws == nullptr) grid.sync();
    xcd_barrier(xbar);
    for (int l = 0; l < 2; ++l) {
        for (int hb = 0; hb < 2; ++hb) {
            {
                CArgs& a = AA; bf16* XN = (bf16*)(a.ws + WS_XN); bf16* U = (bf16*)(a.ws + WS_U + (size_t)hb * U_STRIDE);
                pg8::Gemm g{XN + (size_t)hb * MH * D, (const bf16*)(a.ws + WS_WIN + l * WIN_BYTES), MH, NPAD, D}; pg8::RangeOrder S;
                if (hb == 0) S.init(MH, NPAD, G, (int)blockIdx.x, 0, 480); else S.init(MH, NPAD, G, (int)blockIdx.x, EARLY_TILES, 480 - EARLY_TILES);
                pg8::EpiBf16<0> E{U, NPAD, nullptr, 0, 0, 1.f};
                pg8::gemm_phase<pg8::EpiBf16<0>, pg8::RangeOrder, true, true>((PG8_LAS unsigned char*)lds, g, S, E);
            }
            xcd_barrier(xbar);
            const size_t uo = (size_t)hb * U_STRIDE;
            r1_phase(AA, uo, l, lds, tid);
            g1_phase(AA, uo, l, lds, tid, (int)blockIdx.x, G);
            xcd_barrier(xbar);
            if (blockIdx.x < 32) r2_scan(AA, blockIdx.x, lds, tid);
            else { if (blockIdx.x < 48) g2_scan(AA, blockIdx.x - 32, lds, tid);
                if (hb == 0) {
                    CArgs& a = AA; bf16* XN = (bf16*)(a.ws + WS_XN); bf16* U1 = (bf16*)(a.ws + WS_U1);
                    pg8::Gemm g{XN + (size_t)MH * D, (const bf16*)(a.ws + WS_WIN + l * WIN_BYTES), MH, NPAD, D}; pg8::RangeOrder S; S.init(MH, NPAD, G, (int)blockIdx.x - 32, 0, EARLY_TILES);
                    pg8::EpiBf16<0> E{U1, NPAD, nullptr, 0, 0, 1.f};
                    pg8::gemm_phase<pg8::EpiBf16<0>, pg8::RangeOrder, true, true>((PG8_LAS unsigned char*)lds, g, S, E); } }
            xcd_barrier(xbar);
            r3_phase(AA, uo, l, hb, gw, NGW, lane);
            g3_phase(AA, uo, l, hb, gw, NGW, lane);
            if (hb == 1) xcd_barrier(xbar);
        }
        {
            CArgs& a = AA; bf16* XN = (bf16*)(a.ws + WS_XN);
            pg8::Gemm g{XN, (const bf16*)(a.ws + WS_WOUT + l * WOUT_BYTES), M, D, D}; pg8::StaticOrder S; S.init(M, D, G, (int)blockIdx.x);
            pg8::EpiRmsRes E{l == 0 ? a.in[0] : a.out, a.out, XN, l == 0 ? a.in[1] + D : a.in[17], (float*)(a.ws + WS_SLOTS) + (size_t)l * M * 4, (unsigned*)(a.ws + 16384) + l * 64 * 64, D, l};
            pg8::gemm_phase<pg8::EpiRmsRes, pg8::StaticOrder, false, true>((PG8_LAS unsigned char*)lds, g, S, E);
        }
        if (l == 0) xcd_barrier(xbar);
    }
}

extern "C" void kernel_launch(void* const* d_in, const int* in_sizes, int n_in, void* d_out, int out_size, void* d_ws, size_t ws_size, hipStream_t stream) {
    static int grid = 0;
    if (grid == 0) {
        if (n_in != 18 || out_size != M * D || ws_size < WS_END) { fprintf(stderr, "kernel_launch: unexpected shapes n_in %d out %d ws %zu\n", n_in, out_size, ws_size); grid = -1; return; }
        int dev = 0, cus = 0, per_cu = 0;
        hipGetDevice(&dev); hipDeviceGetAttribute(&cus, hipDeviceAttributeMultiprocessorCount, dev);
        if (hipFuncSetAttribute((const void*)hymba_fwd, hipFuncAttributeMaxDynamicSharedMemorySize, LDS_BYTES) != hipSuccess) { fprintf(stderr, "kernel_launch: hipFuncSetAttribute failed\n"); grid = -1; return; }
        if (hipOccupancyMaxActiveBlocksPerMultiprocessor(&per_cu, (const void*)hymba_fwd, NTHR, LDS_BYTES) != hipSuccess || per_cu < 1) { fprintf(stderr, "kernel_launch: occupancy query failed (%d)\n", per_cu); grid = -1; return; }
        grid = cus * 1;
        fprintf(stderr, "kernel_launch: cus %d per_cu %d grid %d\n", cus, per_cu, grid);
    }
    if (grid < 0) return;
    if (hipMemsetAsync(d_ws, 0, 65536, stream) != hipSuccess) { fprintf(stderr, "kernel_launch: memset failed\n"); return; }
    Args a{};
    for (int i = 0; i < 18; ++i) a.in[i] = (const float*)d_in[i];
    a.out = (float*)d_out; a.ws = (unsigned char*)d_ws;
    void* args[] = {&a};
    hipError_t e = hipLaunchCooperativeKernel((const void*)hymba_fwd, dim3(grid), dim3(NTHR), args, LDS_BYTES, stream);
    if (e != hipSuccess) fprintf(stderr, "cooperative launch failed: %s (grid %d)\n", hipGetErrorString(e), grid);
}
```

```cpp
#include <hip/hip_runtime.h>
#include <hip/hip_cooperative_groups.h>
#include <cstdio>
#include <cstdint>
namespace cg = cooperative_groups;
namespace pg8 {
#define PG8_LAS __attribute__((address_space(3)))
typedef unsigned short bf16_t;
typedef short bf16x8 __attribute__((ext_vector_type(8)));
typedef float f32x4 __attribute__((ext_vector_type(4)));
typedef unsigned u32x4 __attribute__((ext_vector_type(4)));
constexpr int BM = 256, BK = 64, HALF = 128, HTB = HALF * BK * 2  , STAGE_BYTES = 8 * HTB, NXCD = 8, WGM = 8;

__host__ __device__ __forceinline__ int lds_byte(int r, int c) { const int st = (r >> 4) * 2 + (c >> 5), rr = r & 15, cc = c & 31, ob = rr * 64 + cc * 2; return st * 1024 + (ob ^ (((ob >> 9) & 1) << 5)); }
__host__ __device__ __forceinline__ void stage_rc(int b, int& R, int& C) { const int st = b / 1024, sb = b % 1024, swz = sb ^ (((sb >> 9) & 1) << 5); R = (st >> 1) * 16 + swz / 64; C = (st & 1) * 32 + (swz % 64) / 2; }
__host__ __device__ __forceinline__ int perm32(int rho) { const int n = rho >> 4, i = rho & 15; return 8 * (i >> 2) + 4 * n + (i & 3); }

struct Unit { int pm, pn; };
struct Gemm { const bf16_t* A; const bf16_t* Bt; int M, N, K; };

struct StaticOrder {
    int nM, nN, nwg, G, c;
    __host__ __device__ void init(int M, int N, int G_, int c_) { nM = M / BM; nN = N / BM; nwg = nM * nN; G = G_; c = c_; }
    __host__ __device__ bool next(int i, Unit& u) const {
        const long L = (long)i * G + c; if (L >= nwg) return false;
        int wgid = (int)L; { const int q = nwg / NXCD, r = nwg % NXCD, xcd = wgid % NXCD, off = wgid / NXCD; wgid = (xcd < r ? xcd * (q + 1) : r * (q + 1) + (xcd - r) * q) + off; }
        const int nig = WGM * nN, gid = wgid / nig, fm = gid * WGM, gsz = (nM - fm) < WGM ? (nM - fm) : WGM;
        u.pm = fm + ((wgid % nig) % gsz); u.pn = (wgid % nig) / gsz; return true;
    }
    __device__ __forceinline__ void a_ready(const Unit&) const {}
    __device__ __forceinline__ void done(const Unit&) const {}
};

__device__ __forceinline__ unsigned cvt_pk_bf16(float lo, float hi) { unsigned r; asm volatile("v_cvt_pk_bf16_f32 %0, %1, %2" : "=v"(r) : "v"(lo), "v"(hi)); return r; }
typedef float f32x2 __attribute__((ext_vector_type(2)));
__device__ __forceinline__ f32x2 gelu_pk(f32x2 v) {
    const f32x2 av = __builtin_elementwise_abs(v), d = av * 0.2316418882f + 1.0f;
    f32x2 t; t.x = __builtin_amdgcn_rcpf(d.x); t.y = __builtin_amdgcn_rcpf(d.y);
    f32x2 q = t * 0.5307027145f + (-0.7265760135f); q = q * t + 0.7107068705f; q = q * t + (-0.142248368f); q = q * t + 0.127414796f; q = q * t;
    const f32x2 s = (v * v) * (-0.72134752044f);
    f32x2 e; e.x = __builtin_amdgcn_exp2f(s.x); e.y = __builtin_amdgcn_exp2f(s.y);
    const f32x2 m = v * (q * e), r = v - m;
    f32x2 o; o.x = v.x < 0.f ? m.x : r.x; o.y = v.y < 0.f ? m.y : r.y; return o;
}

template <int ACT  > struct EpiBf16 {
    static constexpr bool PERM = true, AFTER_DRAIN = false; static_assert(ACT == 0 || ACT == 1, "EpiBf16: ACT is 0 (none) or 1 (gelu_pk)");
    bf16_t* O; int ldc; const float* bias; int split_cols; size_t split_stride; float scale0;
    __device__ __forceinline__ void operator()(const f32x4 (&acc)[2][2][4][2], const Unit& u, int wr, int wc, int fr, int fq) const {
        const int row0 = u.pm * BM + wr * 64 + fr; int colt = u.pn * BM; bf16_t* base = O;
        float sc = 1.f; if (split_cols) { const int t = colt / split_cols; base += (size_t)t * split_stride; colt -= t * split_cols; if (t == 0) sc = scale0; }
        const int col0 = colt + wc * 32 + 8 * fq, bcol0 = u.pn * BM + wc * 32 + 8 * fq;
        f32x4 bv[2][2];
#pragma unroll
        for (int bj = 0; bj < 2; ++bj)
#pragma unroll
            for (int n = 0; n < 2; ++n) bv[bj][n] = bias ? *(const f32x4*)(bias + bcol0 + bj * HALF + 4 * n) : (f32x4){0.f, 0.f, 0.f, 0.f};
#pragma unroll
        for (int ai = 0; ai < 2; ++ai)
#pragma unroll
            for (int m = 0; m < 4; ++m) { bf16_t* rowp = base + (size_t)(row0 + ai * HALF + m * 16) * ldc + col0;
#pragma unroll
                for (int bj = 0; bj < 2; ++bj) { f32x4 v0 = acc[ai][bj][m][0] + bv[bj][0], v1 = acc[ai][bj][m][1] + bv[bj][1];
                    if (ACT == 1) { f32x2 a = gelu_pk((f32x2){v0[0], v0[1]}), b = gelu_pk((f32x2){v0[2], v0[3]}), c = gelu_pk((f32x2){v1[0], v1[1]}), d = gelu_pk((f32x2){v1[2], v1[3]});
                        v0 = (f32x4){a.x, a.y, b.x, b.y}; v1 = (f32x4){c.x, c.y, d.x, d.y}; }
                    v0 = v0 * sc; v1 = v1 * sc; u32x4 w; w.x = cvt_pk_bf16(v0[0], v0[1]); w.y = cvt_pk_bf16(v0[2], v0[3]); w.z = cvt_pk_bf16(v1[0], v1[1]); w.w = cvt_pk_bf16(v1[2], v1[3]);
                    *(u32x4*)(rowp + bj * HALF) = w; } }
    }
};

template <class Epi, class Sched, bool ALIGN_EPI = false, bool SP2 = false>
__device__ __forceinline__ void gemm_phase(PG8_LAS unsigned char* lds, const Gemm g, const Sched& S, const Epi& E) {
    int tid_ = threadIdx.x; asm volatile("" : "+v"(tid_));
    const int tid = tid_, wid = __builtin_amdgcn_readfirstlane(tid >> 6), lane = tid & 63, wr = wid >> 2, wc = wid & 3, fr = lane & 15, fq = lane >> 4;
    const int K = g.K, nt = K / BK;
    unsigned voffA[2], voffB[2];
#pragma unroll
    for (int i = 0; i < 2; ++i) { int R, C; stage_rc(tid * 16 + i * 8192, R, C); const int Rb = Epi::PERM ? ((R & ~31) + perm32(R & 31)) : R;
        voffA[i] = (unsigned)(R * K + C) * 2u; voffB[i] = (unsigned)(Rb * K + C) * 2u; }
    const size_t kstep = (size_t)(BK * 2);
    const size_t hstep = (size_t)HALF * K * 2;
    const size_t tstep = 2 * hstep;
    const unsigned ldsw = (unsigned)wid * 1024u;
    const int aoff = lds_byte(wr * 64 + fr, fq * 8), boff = lds_byte(wc * 32 + fr, fq * 8);
#define PG8_SA(b, h) (((b) * 2 + (h)) * HTB)
#define PG8_SB(b, h) ((4 + (b) * 2 + (h)) * HTB)
#define PG8_STAGE(bufoff, gbase, voff) do { _Pragma("unroll") for (int _i = 0; _i < 2; ++_i) \
        __builtin_amdgcn_global_load_lds((const unsigned*)((const char*)(gbase) + (voff)[_i]), (PG8_LAS unsigned*)(lds + (bufoff) + ldsw + _i * 8192), 16, 0, 0); } while (0)
#define PG8_LDA(dst, b, h) do { _Pragma("unroll") for (int m = 0; m < 4; ++m) _Pragma("unroll") for (int k = 0; k < 2; ++k) dst[m][k] = *(const PG8_LAS bf16x8*)(lds + PG8_SA(b, h) + aoff + m * 2048 + k * 1024); } while (0)
#define PG8_LDB(dst, b, h) do { _Pragma("unroll") for (int n = 0; n < 2; ++n) _Pragma("unroll") for (int k = 0; k < 2; ++k) dst[n][k] = *(const PG8_LAS bf16x8*)(lds + PG8_SB(b, h) + boff + n * 2048 + k * 1024); } while (0)
#define PG8_MMA(ai, bj, At, Bt) do { __builtin_amdgcn_s_setprio(1); _Pragma("unroll") for (int m = 0; m < 4; ++m) _Pragma("unroll") for (int n = 0; n < 2; ++n) _Pragma("unroll") for (int k = 0; k < 2; ++k) \
        acc[ai][bj][m][n] = __builtin_amdgcn_mfma_f32_16x16x32_bf16(Bt[n][k], At[m][k], acc[ai][bj][m][n], 0, 0, 0); __builtin_amdgcn_s_setprio(0); } while (0)
#define PG8_WAIT_V(n) asm volatile("s_waitcnt vmcnt(" #n ")" ::: "memory")
#define PG8_WAIT_L(n) asm volatile("s_waitcnt lgkmcnt(" #n ")" ::: "memory")
#define PG8_BAR __builtin_amdgcn_s_barrier()
#define PG8_SCHED __builtin_amdgcn_sched_barrier(0)
    Unit cur, nxt; int ui = 0;
    if (!S.next(0, cur)) return;
    f32x4 acc[2][2][4][2];
#pragma unroll
    for (int a = 0; a < 2; ++a)
#pragma unroll
        for (int b = 0; b < 2; ++b)
#pragma unroll
            for (int m = 0; m < 4; ++m)
#pragma unroll
                for (int n = 0; n < 2; ++n) acc[a][b][m][n] = (f32x4){0.f, 0.f, 0.f, 0.f};
    bf16x8 At[4][2], B0[2][2], B1[2][2];
    const char* cA = (const char*)g.A + (size_t)cur.pm * tstep; const char* cB = (const char*)g.Bt + (size_t)cur.pn * tstep;
    S.a_ready(cur);
    if constexpr (SP2) {
        PG8_STAGE(PG8_SB(0, 0), cB, voffB); PG8_STAGE(PG8_SB(0, 1), cB + hstep, voffB); PG8_STAGE(PG8_SA(0, 0), cA, voffA); PG8_STAGE(PG8_SA(0, 1), cA + hstep, voffA);
        if (wr == 1) PG8_BAR;
        PG8_WAIT_V(2); PG8_BAR;
        PG8_STAGE(PG8_SB(1, 0), cB + kstep, voffB); PG8_STAGE(PG8_SA(1, 0), cA + kstep, voffA); PG8_STAGE(PG8_SB(1, 1), cB + hstep + kstep, voffB);
        PG8_WAIT_V(6); PG8_BAR;
    } else {
        PG8_STAGE(PG8_SB(0, 0), cB, voffB); PG8_STAGE(PG8_SA(0, 0), cA, voffA); PG8_STAGE(PG8_SB(0, 1), cB + hstep, voffB); PG8_STAGE(PG8_SA(0, 1), cA + hstep, voffA);
        if (wr == 1) PG8_BAR;
        PG8_WAIT_V(4); PG8_BAR;
        PG8_STAGE(PG8_SB(1, 0), cB + kstep, voffB); PG8_STAGE(PG8_SA(1, 0), cA + kstep, voffA); PG8_STAGE(PG8_SB(1, 1), cB + hstep + kstep, voffB);
        PG8_WAIT_V(6); PG8_BAR;
    }
    for (;;) {
        const bool has_next = S.next(ui + 1, nxt);
        const char* nA = has_next ? (const char*)g.A + (size_t)nxt.pm * tstep : cA; const char* nB = has_next ? (const char*)g.Bt + (size_t)nxt.pn * tstep : cB;
        for (int t = 0; t < nt; t += 2) {
            const bool last = (t == nt - 2);
            const char* a1 = cA + (size_t)(t + 1) * kstep;
            const char* a2 = last ? nA : cA + (size_t)(t + 2) * kstep; const char* b2 = last ? nB : cB + (size_t)(t + 2) * kstep;
            const char* a3 = a2 + kstep; const char* b3 = b2 + kstep;
            if (last && has_next) S.a_ready(nxt);
            if constexpr (SP2) {
            PG8_LDB(B0, 0, 0); PG8_LDB(B1, 0, 1); PG8_SCHED; PG8_LDA(At, 0, 0); PG8_STAGE(PG8_SA(1, 1), a1 + hstep, voffA);
            PG8_WAIT_V(8); PG8_WAIT_L(0); PG8_BAR; PG8_MMA(0, 0, At, B0); PG8_MMA(0, 1, At, B1); PG8_BAR; PG8_SCHED;
            PG8_LDA(At, 0, 1); PG8_STAGE(PG8_SB(0, 0), b2, voffB); PG8_STAGE(PG8_SB(0, 1), b2 + hstep, voffB); PG8_STAGE(PG8_SA(0, 0), a2, voffA);
            PG8_WAIT_V(8); PG8_WAIT_L(0); PG8_BAR; PG8_MMA(1, 0, At, B0); PG8_MMA(1, 1, At, B1); PG8_BAR; PG8_SCHED;
            PG8_LDB(B0, 1, 0); PG8_LDB(B1, 1, 1); PG8_SCHED; PG8_LDA(At, 1, 0); PG8_STAGE(PG8_SA(0, 1), a2 + hstep, voffA);
            PG8_WAIT_V(8); PG8_WAIT_L(0); PG8_BAR; PG8_MMA(0, 0, At, B0); PG8_MMA(0, 1, At, B1); PG8_BAR; PG8_SCHED;
            PG8_LDA(At, 1, 1); PG8_STAGE(PG8_SB(1, 0), b3, voffB); PG8_STAGE(PG8_SB(1, 1), b3 + hstep, voffB); PG8_STAGE(PG8_SA(1, 0), a3, voffA);
            PG8_WAIT_V(8); PG8_WAIT_L(0); PG8_BAR; PG8_MMA(1, 0, At, B0); PG8_MMA(1, 1, At, B1); PG8_BAR; PG8_SCHED;
            } else {
            PG8_LDB(B0, 0, 0); PG8_SCHED; PG8_LDA(At, 0, 0); PG8_STAGE(PG8_SA(1, 1), a1 + hstep, voffA);
            PG8_WAIT_L(8); PG8_BAR; PG8_WAIT_L(0); PG8_MMA(0, 0, At, B0); PG8_BAR; PG8_SCHED;
            PG8_LDB(B1, 0, 1); PG8_STAGE(PG8_SB(0, 0), b2, voffB);
            PG8_BAR; PG8_WAIT_L(0); PG8_MMA(0, 1, At, B1); PG8_BAR;
            PG8_LDA(At, 0, 1); PG8_STAGE(PG8_SA(0, 0), a2, voffA);
            PG8_BAR; PG8_WAIT_L(0); PG8_MMA(1, 0, At, B0); PG8_BAR; PG8_SCHED;
            PG8_STAGE(PG8_SB(0, 1), b2 + hstep, voffB);
            PG8_WAIT_V(6); PG8_BAR; PG8_MMA(1, 1, At, B1); PG8_BAR;
            PG8_LDB(B0, 1, 0); PG8_SCHED; PG8_LDA(At, 1, 0); PG8_STAGE(PG8_SA(0, 1), a2 + hstep, voffA);
            PG8_WAIT_L(8); PG8_BAR; PG8_WAIT_L(0); PG8_MMA(0, 0, At, B0); PG8_BAR; PG8_SCHED;
            PG8_LDB(B1, 1, 1); PG8_STAGE(PG8_SB(1, 0), b3, voffB);
            PG8_BAR; PG8_WAIT_L(0); PG8_MMA(0, 1, At, B1); PG8_BAR;
            PG8_LDA(At, 1, 1); PG8_STAGE(PG8_SA(1, 0), a3, voffA);
            PG8_BAR; PG8_WAIT_L(0); PG8_MMA(1, 0, At, B0); PG8_BAR; PG8_SCHED;
            PG8_STAGE(PG8_SB(1, 1), b3 + hstep, voffB);
            PG8_WAIT_V(6); PG8_BAR; PG8_MMA(1, 1, At, B1); PG8_BAR;
            }
        }
        if constexpr (ALIGN_EPI) { if (wr == 0) PG8_BAR; }
        if constexpr (!Epi::AFTER_DRAIN) { E(acc, cur, wr, wc, fr, fq); S.done(cur); }
        if (!has_next) break;
#pragma unroll
        for (int a = 0; a < 2; ++a)
#pragma unroll
            for (int b = 0; b < 2; ++b)
#pragma unroll
                for (int m = 0; m < 4; ++m)
#pragma unroll
                    for (int n = 0; n < 2; ++n) acc[a][b][m][n] = (f32x4){0.f, 0.f, 0.f, 0.f};
        cur = nxt; cA = nA; cB = nB; ++ui;
        if constexpr (ALIGN_EPI) { if (wr == 1) PG8_BAR; }
    }
    PG8_WAIT_V(0);
    if constexpr (!ALIGN_EPI) { if (wr == 0) PG8_BAR; }
    PG8_BAR;
    if constexpr (Epi::AFTER_DRAIN) { E.fused(acc, cur, wr, wc, fr, fq, lds, wid, lane); S.done(cur); }
#undef PG8_SA
#undef PG8_SB
#undef PG8_STAGE
#undef PG8_LDA
#undef PG8_LDB
#undef PG8_MMA
#undef PG8_WAIT_V
#undef PG8_WAIT_L
#undef PG8_BAR
#undef PG8_SCHED
}
}
namespace pg8 {
struct EpiResid {
    static constexpr bool PERM = false, AFTER_DRAIN = false;
    const float* base; float* out; int ldc;
    __device__ __forceinline__ void operator()(const f32x4 (&acc)[2][2][4][2], const Unit& u, int wr, int wc, int fr, int fq) const {
        const int col0 = u.pn * BM + wc * 32 + 4 * fq;
#pragma unroll
        for (int ai = 0; ai < 2; ++ai)
#pragma unroll
            for (int m = 0; m < 4; ++m) { const size_t off = (size_t)(u.pm * BM + ai * HALF + wr * 64 + m * 16 + fr) * ldc + col0;
#pragma unroll
                for (int bj = 0; bj < 2; ++bj)
#pragma unroll
                    for (int n = 0; n < 2; ++n) { const f32x4 b = *(const f32x4*)(base + off + bj * HALF + n * 16); *(f32x4*)(out + off + bj * HALF + n * 16) = b + acc[ai][bj][m][n]; } }
    }
};
struct RangeOrder {
    int nM, nN, nwg, G, c, first, last;
    __host__ __device__ void init(int M, int N, int G_, int c_, int first_, int count_) { nM = M / BM; nN = N / BM; nwg = nM * nN; G = G_; c = c_; first = first_; last = first_ + count_; }
    __host__ __device__ bool next(int i, Unit& u) const {
        const long L = (long)first + (long)i * G + c; if (c < 0 || L >= last || L >= nwg) return false;
        int wgid = (int)L; { const int q = nwg / NXCD, r = nwg % NXCD, xcd = wgid % NXCD, off = wgid / NXCD; wgid = (xcd < r ? xcd * (q + 1) : r * (q + 1) + (xcd - r) * q) + off; }
        const int nig = WGM * nN, gid = wgid / nig, fm = gid * WGM, gsz = (nM - fm) < WGM ? (nM - fm) : WGM;
        u.pm = fm + ((wgid % nig) % gsz); u.pn = (wgid % nig) / gsz; return true;
    }
    __device__ __forceinline__ void a_ready(const Unit&) const {}
    __device__ __forceinline__ void done(const Unit&) const {}
};
struct EpiRmsRes {
    static constexpr bool PERM = false, AFTER_DRAIN = true;
    const float* base; float* out; bf16_t* xn; const float* w; float* slots; unsigned* cnt; int ldc; int mode;
    __device__ __forceinline__ void fused(f32x4 (&acc)[2][2][4][2], const Unit& u, int wr, int wc, int fr, int fq, PG8_LAS unsigned char* lds, int wid, int lane) const {
        const int col0 = u.pn * BM + wc * 32 + 4 * fq;
        PG8_LAS float* P = (PG8_LAS float*)lds; PG8_LAS float* S = (PG8_LAS float*)(lds + 4096);
#pragma unroll
        for (int ai = 0; ai < 2; ++ai)
#pragma unroll
            for (int m = 0; m < 4; ++m) { const size_t off = (size_t)(u.pm * BM + ai * HALF + wr * 64 + m * 16 + fr) * ldc + col0; float s = 0.f;
#pragma unroll
                for (int bj = 0; bj < 2; ++bj)
#pragma unroll
                    for (int n = 0; n < 2; ++n) { const f32x4 v = acc[ai][bj][m][n] + *(const f32x4*)(base + off + bj * HALF + n * 16); acc[ai][bj][m][n] = v; s += (v[0] * v[0] + v[1] * v[1]) + (v[2] * v[2] + v[3] * v[3]); }
                s += __shfl_xor(s, 16); s += __shfl_xor(s, 32);
                if (fq == 0) P[(ai * HALF + wr * 64 + m * 16 + fr) * 4 + wc] = s;
                if (m & 1) asm volatile("" ::: "memory"); }
        asm volatile("s_waitcnt lgkmcnt(0)" ::: "memory"); __builtin_amdgcn_s_barrier(); asm volatile("" ::: "memory");
        const int row = wid * 32 + (lane & 31);
        if (lane < 32) { const float tot = (P[row * 4 + 0] + P[row * 4 + 1]) + (P[row * 4 + 2] + P[row * 4 + 3]);
            __hip_atomic_store(slots + ((size_t)(u.pm * BM + row) * 4 + u.pn), tot, __ATOMIC_RELAXED, __HIP_MEMORY_SCOPE_AGENT); }
        asm volatile("s_waitcnt vmcnt(0)" ::: "memory");
        if (lane == 0) __hip_atomic_fetch_add(cnt + 64 * u.pm, 1u, __ATOMIC_RELAXED, __HIP_MEMORY_SCOPE_AGENT);
        if (wid == 0) { while ((unsigned)__builtin_amdgcn_readfirstlane(__hip_atomic_load(cnt + 64 * u.pm, __ATOMIC_RELAXED, __HIP_MEMORY_SCOPE_AGENT)) < 32u) __builtin_amdgcn_s_sleep(2);
            __builtin_amdgcn_fence(__ATOMIC_ACQUIRE, "agent"); }
        asm volatile("s_waitcnt vmcnt(0) lgkmcnt(0)" ::: "memory"); __builtin_amdgcn_s_barrier(); asm volatile("" ::: "memory");
        if (lane < 32) { const float* sl = slots + (size_t)(u.pm * BM + row) * 4; float q = 0.f;
#pragma unroll
            for (int t = 0; t < 4; ++t) q += __hip_atomic_load(sl + t, __ATOMIC_RELAXED, __HIP_MEMORY_SCOPE_AGENT);
            S[row] = 1.0f / sqrtf(q * (1.f / 1024.f) + 1e-6f); }
        asm volatile("s_waitcnt lgkmcnt(0)" ::: "memory"); __builtin_amdgcn_s_barrier(); asm volatile("" ::: "memory");
        f32x4 wv[2][2];
#pragma unroll
        for (int bj = 0; bj < 2; ++bj)
#pragma unroll
            for (int n = 0; n < 2; ++n) wv[bj][n] = *(const f32x4*)(w + col0 + bj * HALF + n * 16);
#pragma unroll
        for (int ai = 0; ai < 2; ++ai)
#pragma unroll
            for (int m = 0; m < 4; ++m) { const int r = ai * HALF + wr * 64 + m * 16 + fr; const float rs = S[r]; const size_t off = (size_t)(u.pm * BM + r) * ldc + col0;
#pragma unroll
                for (int bj = 0; bj < 2; ++bj)
#pragma unroll
                    for (int n = 0; n < 2; ++n) { const f32x4 v = acc[ai][bj][m][n]; const f32x4 nv = v * rs * wv[bj][n];
                        if (mode == 0) { *(f32x4*)(out + off + bj * HALF + n * 16) = v; typedef unsigned u32x2v __attribute__((ext_vector_type(2))); u32x2v pk; pk.x = cvt_pk_bf16(nv[0], nv[1]); pk.y = cvt_pk_bf16(nv[2], nv[3]);
                            *(u32x2v*)(xn + off + bj * HALF + n * 16) = pk; }
                        else *(f32x4*)(out + off + bj * HALF + n * 16) = nv; } }
    }
};
}
constexpr int NWAVES = 8, NTHR = 512;
constexpr int BATCH = 2, T = 8192, D = 1024, M = BATCH * T, MH = T;
constexpr int NIN = 3728, NPAD = 3840;
constexpr int C_GQ = 0, C_GK = 256, C_GV = 512, C_GLR = 1024, C_GG = 1040, C_R = 1552, C_K = 2064, C_V = 2576, C_WL = 3088, C_AL = 3152, C_RG = 3216;
constexpr size_t MiB = 1u << 20;
constexpr size_t WS_WIN = 1 * MiB, WIN_BYTES = (size_t)NPAD * D * 2;
constexpr size_t WS_WOUT = 16 * MiB, WOUT_BYTES = (size_t)D * D * 2;
constexpr size_t WS_XN = 20 * MiB;
constexpr size_t WS_U = 52 * MiB, WS_U1 = 193 * MiB, U_STRIDE = WS_U1 - WS_U;
constexpr size_t WS_SLOTS = 192 * MiB;
constexpr size_t WS_END = 254 * MiB;
constexpr int LDS_BYTES = 163840;
constexpr int EARLY_TILES = 224;

typedef unsigned short bf16;
typedef unsigned v4u __attribute__((ext_vector_type(4)));
typedef float f32x4 __attribute__((ext_vector_type(4)));
#define LDS_WAIT() asm volatile("s_waitcnt lgkmcnt(0)" ::: "memory")
#define LBAR() do { asm volatile("s_waitcnt lgkmcnt(0)" ::: "memory"); __builtin_amdgcn_s_barrier(); asm volatile("" ::: "memory"); } while (0)
__device__ __forceinline__ float bf2f(unsigned h) { return __uint_as_float(h << 16); }
__device__ __forceinline__ unsigned f2bf(float f) { unsigned u = __float_as_uint(f); return (u + 0x7fffu + ((u >> 16) & 1u)) >> 16; }
typedef __bf16 bf16x2_t __attribute__((ext_vector_type(2)));
typedef float f32x2_t __attribute__((ext_vector_type(2)));
__device__ __forceinline__ unsigned pk2(float lo, float hi) { const f32x2_t v = {lo, hi}; const bf16x2_t b = __builtin_convertvector(v, bf16x2_t); return __builtin_bit_cast(unsigned, b); }
__device__ __forceinline__ float wave_sum(float v) {
#pragma unroll
    for (int o = 1; o < 64; o <<= 1) v += __shfl_xor(v, o);
    return v;
}
__device__ __forceinline__ float sigm(float x) { return __builtin_amdgcn_rcpf(1.f + __expf(-x)); }
__device__ __forceinline__ float tanh_fast(float x) { return 1.f - 2.f * __builtin_amdgcn_rcpf(1.f + __expf(2.f * x)); }
__device__ __forceinline__ float rl(float v, int l) { return __int_as_float(__builtin_amdgcn_readlane(__float_as_int(v), l)); }

typedef short bf16x8 __attribute__((ext_vector_type(8)));
typedef unsigned v2u __attribute__((ext_vector_type(2)));
__device__ __forceinline__ v2u pack4(f32x4 v) { v2u r; r.x = pk2(v.x, v.y); r.y = pk2(v.z, v.w); return r; }
__device__ __forceinline__ void unpack8(v4u w, float* o) { o[0] = bf2f(w.x & 0xffffu); o[1] = bf2f(w.x >> 16); o[2] = bf2f(w.y & 0xffffu); o[3] = bf2f(w.y >> 16);
    o[4] = bf2f(w.z & 0xffffu); o[5] = bf2f(w.z >> 16); o[6] = bf2f(w.w & 0xffffu); o[7] = bf2f(w.w >> 16); }
__device__ __forceinline__ v4u pack8(const float* v) { v4u r; r.x = pk2(v[0], v[1]); r.y = pk2(v[2], v[3]); r.z = pk2(v[4], v[5]); r.w = pk2(v[6], v[7]); return r; }
struct Args { const float* in[18]; float* out; unsigned char* ws; };
typedef const Args __attribute__((address_space(4))) CArgs;
__device__ __forceinline__ CArgs* opaque_args() { CArgs* p = (CArgs*)__builtin_amdgcn_kernarg_segment_ptr(); asm volatile("" : "+s"(p)); return p; }
#define AA (*opaque_args())

__device__ __forceinline__ void rms_row2(const float* x0, const float* x1, const float* w, bf16* o0, bf16* o1, int lane) {
    const f32x4* r0 = (const f32x4*)x0 + lane; const f32x4* r1 = (const f32x4*)x1 + lane; const f32x4* wr = (const f32x4*)w + lane;
    f32x4 a[4], b[4]; float sa = 0.f, sb = 0.f;
#pragma unroll
    for (int j = 0; j < 4; ++j) { a[j] = r0[64 * j]; b[j] = r1[64 * j]; }
#pragma unroll
    for (int j = 0; j < 4; ++j) { sa += (a[j].x * a[j].x + a[j].y * a[j].y) + (a[j].z * a[j].z + a[j].w * a[j].w); sb += (b[j].x * b[j].x + b[j].y * b[j].y) + (b[j].z * b[j].z + b[j].w * b[j].w); }
    const float ra = rsqrtf(wave_sum(sa) * (1.f / D) + 1e-6f), rb = rsqrtf(wave_sum(sb) * (1.f / D) + 1e-6f);
#pragma unroll
    for (int j = 0; j < 4; ++j) { const f32x4 ww = wr[64 * j]; const f32x4 oa = a[j] * ra * ww, ob = b[j] * rb * ww;
        ((v2u*)o0 + lane)[64 * j] = pack4(oa); ((v2u*)o1 + lane)[64 * j] = pack4(ob); }
}
__device__ __forceinline__ void transpose_item(const float* W, int K, int N, int Npad, bf16* WT, float* scr, int item, int lane) {
    const int nblk = Npad / 32, kb = item / nblk, nb = item % nblk, k0 = 64 * kb, n0 = 32 * nb;
    const int n = n0 + (lane & 31);
#pragma unroll 8
    for (int i = 0; i < 32; ++i) { const int kk = 2 * i + (lane >> 5); scr[kk * 33 + (lane & 31)] = (n < N) ? W[(size_t)(k0 + kk) * N + n] : 0.f; }
    LDS_WAIT();
    const int c = lane & 7;
#pragma unroll
    for (int j = 0; j < 4; ++j) { const int nn = (lane >> 3) + 8 * j; const float* s = scr + (8 * c) * 33 + nn;
        v4u o; o.x = pk2(s[0 * 33], s[1 * 33]); o.y = pk2(s[2 * 33], s[3 * 33]); o.z = pk2(s[4 * 33], s[5 * 33]); o.w = pk2(s[6 * 33], s[7 * 33]);
        *(v4u*)(WT + (size_t)(n0 + nn) * K + k0 + 8 * c) = o; }
    LDS_WAIT();
}
__device__ __forceinline__ void transpose_tiles(const float* W, int K, int N, int Npad, bf16* WT, float* scr  , int first, int stride, int ntiles, int tid) {
    const int nblk = Npad / 64, kr = tid >> 4, nq = tid & 15;
    f32x4 v0 = {0.f, 0.f, 0.f, 0.f}, v1 = v0;
    if (first < ntiles) { const int kb = first / nblk, nb = first % nblk, n = 64 * nb + 4 * nq; if (n < N) { v0 = *(const f32x4*)(W + (size_t)(64 * kb + kr) * N + n); v1 = *(const f32x4*)(W + (size_t)(64 * kb + 32 + kr) * N + n); } }
#pragma unroll 1
    for (int it = first; it < ntiles; it += stride) {
        const int kb = it / nblk, nb = it % nblk;
        scr[kr * 65 + 4 * nq] = v0.x; scr[kr * 65 + 4 * nq + 1] = v0.y; scr[kr * 65 + 4 * nq + 2] = v0.z; scr[kr * 65 + 4 * nq + 3] = v0.w;
        scr[(32 + kr) * 65 + 4 * nq] = v1.x; scr[(32 + kr) * 65 + 4 * nq + 1] = v1.y; scr[(32 + kr) * 65 + 4 * nq + 2] = v1.z; scr[(32 + kr) * 65 + 4 * nq + 3] = v1.w;
        const int nx = it + stride; v0 = (f32x4){0.f, 0.f, 0.f, 0.f}; v1 = v0;
        if (nx < ntiles) { const int kb2 = nx / nblk, nb2 = nx % nblk, n = 64 * nb2 + 4 * nq; if (n < N) { v0 = *(const f32x4*)(W + (size_t)(64 * kb2 + kr) * N + n); v1 = *(const f32x4*)(W + (size_t)(64 * kb2 + 32 + kr) * N + n); } }
        LBAR();
        { const int n = tid >> 3, kc = tid & 7; const float* sp = scr + (8 * kc) * 65 + n; float o[8];
#pragma unroll
          for (int j = 0; j < 8; ++j) o[j] = sp[j * 65];
          *(v4u*)(WT + (size_t)(64 * nb + n) * K + 64 * kb + 8 * kc) = pack8(o); }
        LBAR();
    }
}
__device__ __forceinline__ void rms_row(const float* xrow, const float* w, bf16* obf, float* of32, int lane) {
    const f32x4* xr = (const f32x4*)xrow + lane; const f32x4* wr = (const f32x4*)w + lane;
    f32x4 v[4]; float s = 0.f;
#pragma unroll
    for (int j = 0; j < 4; ++j) { v[j] = xr[64 * j]; s += (v[j].x * v[j].x + v[j].y * v[j].y) + (v[j].z * v[j].z + v[j].w * v[j].w); }
    const float rs = rsqrtf(wave_sum(s) * (1.f / D) + 1e-6f);
#pragma unroll
    for (int j = 0; j < 4; ++j) { const f32x4 ww = wr[64 * j]; f32x4 o = v[j] * rs * ww;
        if (of32) ((f32x4*)of32 + lane)[64 * j] = o;
        else ((unsigned long long*)obf + lane)[64 * j] = (unsigned long long)pk2(o.x, o.y) | ((unsigned long long)pk2(o.z, o.w) << 32); }
}

constexpr int PITCH = 72, FP = 68, TP = 20;
constexpr int OFF_TW = 0, OFF_AL = 9216, OFF_ARK = 18432, OFF_XA = 27648, OFF_XW = 45056, OFF_AT = 63488, OFF_RT = 72704, OFF_BH = 81920, OFF_KH = 91136,
              OFF_BBT = 100352, OFF_KBT = 109568, OFF_VT = 118784, OFF_TII = 128000, OFF_TOT = 133120, OFF_BC = 135168;
constexpr int OFF_AAK = OFF_TW, OFF_ARB = OFF_AL, OFF_AAB = OFF_XA, OFF_XT = OFF_XW;
constexpr size_t WS_MC = 112 * MiB, WS_NC = 120 * MiB, WS_PP = 136 * MiB, WS_Y0 = 144 * MiB, WS_S0 = 152 * MiB, WS_DEC = 160 * MiB, WS_BON2 = 161 * MiB, WS_UPT = 162 * MiB;
constexpr int NUNIT = 1024;

__device__ __forceinline__ f32x4 mma2s(const bf16* Ab, int ak, const bf16* Bb, int bk, int g, f32x4 acc) {
    acc = __builtin_amdgcn_mfma_f32_16x16x32_bf16(*(const bf16x8*)(Ab + ((g ^ ak) << 3)), *(const bf16x8*)(Bb + ((g ^ bk) << 3)), acc, 0, 0, 0);
    acc = __builtin_amdgcn_mfma_f32_16x16x32_bf16(*(const bf16x8*)(Ab + (((g + 4) ^ ak) << 3)), *(const bf16x8*)(Bb + (((g + 4) ^ bk) << 3)), acc, 0, 0, 0);
    return acc;
}
#define SWK(row) (((row) >> 3) & 7)
#define SWC(row, t) ((row) * PITCH + ((((t) >> 3) ^ SWK(row)) << 3) + ((t) & 7))
__device__ __forceinline__ f32x4 mma2(const bf16* Arow, const bf16* Brow, f32x4 acc) {
    acc = __builtin_amdgcn_mfma_f32_16x16x32_bf16(*(const bf16x8*)(Arow), *(const bf16x8*)(Brow), acc, 0, 0, 0);
    acc = __builtin_amdgcn_mfma_f32_16x16x32_bf16(*(const bf16x8*)(Arow + 32), *(const bf16x8*)(Brow + 32), acc, 0, 0, 0);
    return acc;
}

__device__ __forceinline__ void r1_phase(CArgs& a, size_t uo, int l, unsigned char* L, int tid0) {
    asm volatile("" : "+v"(tid0));
    const int wave = __builtin_amdgcn_readfirstlane(tid0 >> 6);
    const bf16* U = (const bf16*)(a.ws + WS_U + uo);
    bf16* TW = (bf16*)(L + 138240 + 2560); bf16* ALm = (bf16*)(L + 138240 + 2560 + 9216);
    bf16* ARK = (bf16*)(L + OFF_ARK); bf16* AAK = (bf16*)(L + OFF_AAK); bf16* ARB = (bf16*)(L + OFF_ARB);
    float* XA = (float*)(L + OFF_XA); float* XW = (float*)(L + OFF_XW); float* AAB = (float*)(L + OFF_AAB); bf16* XT = (bf16*)(L + OFF_XT);
    bf16* AT = (bf16*)(L + OFF_AT); bf16* RT = (bf16*)(L + OFF_RT); bf16* BH = (bf16*)(L + OFF_BH); bf16* KH = (bf16*)(L + OFF_KH);
    bf16* BBT = (bf16*)(L + OFF_BBT); bf16* KBT = (bf16*)(L + OFF_KBT); bf16* VT = (bf16*)(L + OFF_VT);
    float* TII = (float*)(L + OFF_TII); float* TOT = (float*)(L + OFF_TOT); float* BC = (float*)(L + OFF_BC);
    const bf16* UPT = (const bf16*)(a.ws + WS_UPT) + (size_t)l * 2 * 512 * 64;
    const float* mu = a.in[6] + l * 1664;
    float* WTS = (float*)(L + 135680);
    const int ch = (int)blockIdx.x >> 1, hbase = 4 * ((int)blockIdx.x & 1);
    v4u Lrc, Lkc, Lvc, Lrp, Lkp, Lvp; bf16x8 wfa0, wfa1; float pw[8];
#define R1_ISSUE(h_) do { const int lr_ = 64 * ch + (tid >> 3); const bf16* uq_ = U + (size_t)lr_ * NPAD + 64 * (h_) + 8 * (tid & 7); \
        Lrc = *(const v4u*)(uq_ + C_R); Lkc = *(const v4u*)(uq_ + C_K); Lvc = *(const v4u*)(uq_ + C_V); Lrp = (v4u){0u, 0u, 0u, 0u}; Lkp = Lrp; Lvp = Lrp; \
        if (lr_ > 0) { Lrp = *(const v4u*)(uq_ + C_R - NPAD); Lkp = *(const v4u*)(uq_ + C_K - NPAD); Lvp = *(const v4u*)(uq_ + C_V - NPAD); } \
        if (tid < 64) { const int c_ = l * 512 + 64 * (h_) + tid; pw[0] = a.in[7][c_]; pw[1] = a.in[9][c_]; pw[2] = a.in[11][c_]; pw[3] = a.in[12][c_]; pw[4] = a.in[13][c_]; \
            pw[5] = mu[64 * (h_) + tid]; pw[6] = mu[512 + 64 * (h_) + tid]; pw[7] = mu[1024 + 64 * (h_) + tid]; } \
        { const bf16* WT_ = UPT + (size_t)(wave >> 2) * 512 * 64 + (size_t)(64 * (h_) + 16 * (wave & 3) + (tid & 15)) * 64 + 8 * ((tid & 63) >> 4); wfa0 = *(const bf16x8*)WT_; wfa1 = *(const bf16x8*)(WT_ + 32); } } while (0)
    {
        int tid = tid0; asm volatile("" : "+v"(tid));
        R1_ISSUE(hbase);
        const int t = tid >> 3, cg = tid & 7, lr = 64 * ch + t; const bf16* up = U + (size_t)lr * NPAD + C_WL + 16 * cg;
        const v4u c0 = *(const v4u*)up, c1 = *(const v4u*)(up + 8); v4u p0 = {0u, 0u, 0u, 0u}, p1 = p0;
        if (lr > 0) { p0 = *(const v4u*)(up - NPAD); p1 = *(const v4u*)(up - NPAD + 8); }
        float cu[16], pr[16], o[16]; unpack8(c0, cu); unpack8(c1, cu + 8); unpack8(p0, pr); unpack8(p1, pr + 8);
        const float* mp = mu + 1536 + 16 * cg;
#pragma unroll
        for (int i = 0; i < 16; ++i) { float mv = cu[i] + (pr[i] - cu[i]) * mp[i]; if (cg < 4) mv = tanh_fast(mv); o[i] = mv; }
        bf16* dst = (cg < 4 ? TW : ALm) + t * PITCH + 16 * (cg & 3);
        *(v4u*)dst = pack8(o); *(v4u*)(dst + 8) = pack8(o + 8);
    }
#pragma unroll 1
    for (int hi = 0; hi < 4; ++hi) {
        int tid = tid0; asm volatile("" : "+v"(tid));
        const int lane = tid & 63, g = lane >> 4, c16 = lane & 15;
        const int h = hbase + hi, unit = ch * 8 + h;
        const int t = tid >> 3, dg = tid & 7, d0 = 8 * dg, lr = 64 * ch + t, hc = 64 * h + d0;
        if (tid < 64) {
#pragma unroll
            for (int q = 0; q < 8; ++q) WTS[64 * q + tid] = pw[q]; }
        LBAR();
        {
            const int q = wave >> 2, dt = wave & 3;
            const bf16x8 a0 = wfa0, a1 = wfa1;
            const bf16* Bm = q ? ALm : TW; float* X = q ? XA : XW;
#pragma unroll
            for (int tt = 0; tt < 4; ++tt) { const bf16* br = Bm + (16 * tt + c16) * PITCH + 8 * g; f32x4 acc = {0.f, 0.f, 0.f, 0.f};
                acc = __builtin_amdgcn_mfma_f32_16x16x32_bf16(a0, *(const bf16x8*)br, acc, 0, 0, 0);
                acc = __builtin_amdgcn_mfma_f32_16x16x32_bf16(a1, *(const bf16x8*)(br + 32), acc, 0, 0, 0);
                *(f32x4*)(X + (16 * tt + c16) * FP + 16 * dt + 4 * g) = acc; }
        }
        LBAR();
        float r[8], kq[8], v[8], al[8], be[8], lw[8];
        {
            float rc[8], rp[8], kc[8], kp[8], vc[8], vp[8];
            unpack8(Lrc, rc); unpack8(Lkc, kc); unpack8(Lvc, vc); unpack8(Lrp, rp); unpack8(Lkp, kp); unpack8(Lvp, vp);
            const float* w0p = WTS + d0; const float* a0p = WTS + 64 + d0; const float* kkp = WTS + 128 + d0;
            const float* kap = WTS + 192 + d0; const float* rkp = WTS + 256 + d0;
            float nn = 0.f, bon = 0.f, kk[8], av[8];
#pragma unroll
            for (int i = 0; i < 8; ++i) {
                const float xw = XW[t * FP + d0 + i] + w0p[i], xa = XA[t * FP + d0 + i] + a0p[i];
                lw[i] = -0.60653065971f * sigm(xw); av[i] = sigm(xa);
                r[i] = rc[i] + (rp[i] - rc[i]) * WTS[320 + d0 + i]; const float k = kc[i] + (kp[i] - kc[i]) * WTS[384 + d0 + i]; v[i] = vc[i] + (vp[i] - vc[i]) * WTS[448 + d0 + i];
                kk[i] = k * kkp[i]; nn += kk[i] * kk[i];
                kq[i] = k * (1.f + (av[i] - 1.f) * kap[i]); bon += r[i] * kq[i] * rkp[i];
            }
            nn += __shfl_xor(nn, 1); nn += __shfl_xor(nn, 2); nn += __shfl_xor(nn, 4);
            bon += __shfl_xor(bon, 1); bon += __shfl_xor(bon, 2); bon += __shfl_xor(bon, 4);
            const float inv = __builtin_amdgcn_rsqf(fmaxf(nn, 1e-24f));
#pragma unroll
            for (int i = 0; i < 8; ++i) { const float kn = kk[i] * inv; al[i] = -kn; be[i] = av[i] * kn; XW[t * FP + d0 + i] = lw[i]; }
            if (dg == 0) ((float*)(a.ws + WS_BON2))[lr * 8 + h] = bon;
        }
        LBAR();
        {
            const int d = tid & 63, tb = tid >> 6; float p[8]; float run = 0.f;
#pragma unroll
            for (int i = 0; i < 8; ++i) { run += XW[(8 * tb + i) * FP + d]; p[i] = run; }
            TOT[tb * 64 + d] = run;
            LBAR();
            float off = 0.f;
#pragma unroll
            for (int j = 0; j < 8; ++j) off += (j < tb) ? TOT[j * 64 + d] : 0.f;
#pragma unroll
            for (int i = 0; i < 8; ++i) XW[(8 * tb + i) * FP + d] = off + p[i];
            if (tb == 7) { BC[d] = off + run; BC[64 + d] = __expf(off + run); }
        }
        LBAR();
        {
            float at[8], rt[8], bh[8], kh[8];
#pragma unroll
            for (int i = 0; i < 8; ++i) { const float b = XW[t * FP + d0 + i];
                const float eb = __expf(b), enb = __builtin_amdgcn_rcpf(eb), ebp = __expf(b - lw[i]), ebc = BC[64 + d0 + i] * enb;
                at[i] = al[i] * ebp; rt[i] = r[i] * eb; bh[i] = be[i] * enb; kh[i] = kq[i] * enb;
                BBT[SWC(d0 + i, t)] = (bf16)f2bf(be[i] * ebc); KBT[SWC(d0 + i, t)] = (bf16)f2bf(kq[i] * ebc); VT[SWC(d0 + i, t)] = (bf16)f2bf(v[i]); }
            *(v4u*)(AT + t * PITCH + d0) = pack8(at); *(v4u*)(RT + t * PITCH + d0) = pack8(rt); *(v4u*)(BH + t * PITCH + d0) = pack8(bh); *(v4u*)(KH + t * PITCH + d0) = pack8(kh);
        }
        asm volatile("" ::: "memory");
        if (hi + 1 < 4) R1_ISSUE(h + 1);
        LBAR();
        {
            const int q = wave >> 1, mh = wave & 1;
            const bf16* As = (q < 2) ? AT : RT; const bf16* Bs = (q & 1) ? KH : BH;
#pragma unroll
            for (int t2 = 0; t2 < 2; ++t2) { const int tt = t2 == 0 ? mh : 3 - mh; const int tcol = 16 * tt + c16;
#pragma unroll
                for (int jt = 0; jt < 4; ++jt) {
                    f32x4 acc = {0.f, 0.f, 0.f, 0.f};
                    if (jt <= tt) { acc = mma2(Bs + (16 * jt + c16) * PITCH + 8 * g, As + tcol * PITCH + 8 * g, acc);
#pragma unroll
                        for (int j = 0; j < 4; ++j) { const int jj = 16 * jt + 4 * g + j; const bool keep = (q < 2) ? (jj < tcol) : (jj <= tcol); if (!keep) acc[j] = 0.f; } }
                    if (q == 0) *(f32x4*)(AAB + tcol * FP + 16 * jt + 4 * g) = acc;
                    else { bf16* dst = (q == 1 ? AAK : (q == 2 ? ARB : ARK)); *(v2u*)(dst + tcol * PITCH + 16 * jt + 4 * g) = pack4(acc); }
                } }
        }
        LBAR();
        f32x4 Z[4];
        {
            if (wave < 4) {
                typedef short s16x4 __attribute__((ext_vector_type(4)));
                const int i = wave; const f32x4 at4 = *(const f32x4*)(AAB + (16 * i + c16) * FP + 16 * i + 4 * g); f32x4 a4, Sp;
#pragma unroll
                for (int j = 0; j < 4; ++j) { a4[j] = AAB[(16 * i + 4 * g + j) * FP + 16 * i + c16]; Sp[j] = at4[j] + ((4 * g + j) == c16 ? 1.f : 0.f); }
                v2u pk_ = pack4(a4), pkt_ = pack4(at4); s16x4 P = __builtin_bit_cast(s16x4, pk_), PT = __builtin_bit_cast(s16x4, pkt_);
                const f32x4 zero4 = {0.f, 0.f, 0.f, 0.f};
#pragma unroll
                for (int st = 0; st < 3; ++st) { const f32x4 p2 = __builtin_amdgcn_mfma_f32_16x16x16bf16_1k(PT, P, zero4, 0, 0, 0), pt2 = __builtin_amdgcn_mfma_f32_16x16x16bf16_1k(P, PT, zero4, 0, 0, 0);
                    pk_ = pack4(p2); pkt_ = pack4(pt2); P = __builtin_bit_cast(s16x4, pk_); PT = __builtin_bit_cast(s16x4, pkt_);
                    const v2u sp_ = pack4(Sp); Sp = __builtin_amdgcn_mfma_f32_16x16x16bf16_1k(P, __builtin_bit_cast(s16x4, sp_), Sp, 0, 0, 0); }
                *(v2u*)((unsigned char*)TII + (i * 64 + lane) * 8) = pack4(Sp); }
            if (wave < 4) {
#pragma unroll
                for (int i = 0; i < 4; ++i)
#pragma unroll
                    for (int j = 0; j < 4; ++j) Z[i][j] = bf2f(AT[(16 * i + 4 * g + j) * PITCH + 16 * wave + c16]);
            } else {
#pragma unroll
                for (int i = 0; i < 4; ++i) { f32x4 acc = {0.f, 0.f, 0.f, 0.f}; const int er = 16 * (wave - 4) + c16; Z[i] = mma2s(AAK + (16 * i + c16) * PITCH, 0, VT + er * PITCH, SWK(er), g, acc); }
            }
        }
        LBAR();
        {
            typedef short s16x4 __attribute__((ext_vector_type(4)));
            f32x4 X[4]; s16x4 Xb[4];
#pragma unroll
            for (int i = 0; i < 4; ++i) { f32x4 z = Z[i];
#pragma unroll
                for (int kb = 0; kb < 4; ++kb) if (kb < i) { const f32x4 av = *(const f32x4*)(AAB + (16 * i + c16) * FP + 16 * kb + 4 * g);
                    const v2u ap = pack4(av); z = __builtin_amdgcn_mfma_f32_16x16x16bf16_1k(__builtin_bit_cast(s16x4, ap), Xb[kb], z, 0, 0, 0); }
                const v2u tp = *(const v2u*)((const unsigned char*)TII + (i * 64 + lane) * 8), zp = pack4(z);
                const f32x4 zero4 = {0.f, 0.f, 0.f, 0.f};
                X[i] = __builtin_amdgcn_mfma_f32_16x16x16bf16_1k(__builtin_bit_cast(s16x4, tp), __builtin_bit_cast(s16x4, zp), zero4, 0, 0, 0);
                const v2u xp = pack4(X[i]); Xb[i] = __builtin_bit_cast(s16x4, xp); }
#pragma unroll
            for (int i = 0; i < 4; ++i) *(v2u*)(XT + (16 * wave + c16) * PITCH + 16 * i + 4 * g) = __builtin_bit_cast(v2u, Xb[i]);
        }
        LBAR();
        {
            const int ps = wave & 1, ti = wave >> 1;
            bf16* MCg = (bf16*)(a.ws + WS_MC) + (size_t)unit * 4096; float* NCg = (float*)(a.ws + WS_NC) + (size_t)unit * 4096;
            bf16* PPg = (bf16*)(a.ws + WS_PP) + (size_t)unit * 4096; bf16* Y0g = (bf16*)(a.ws + WS_Y0) + (size_t)unit * 4096;
#pragma unroll
            for (int tj = 0; tj < 4; ++tj) { const int cc = 16 * tj + c16, rr = 16 * ti + 4 * g, ar = 16 * ti + c16; f32x4 acc = {0.f, 0.f, 0.f, 0.f}, acc2 = {0.f, 0.f, 0.f, 0.f};
                if (ps == 0) {
                    acc = mma2s(XT + ar * PITCH, 0, BBT + cc * PITCH, SWK(cc), g, acc); *(v2u*)(MCg + cc * 64 + (ti >> 1) * 32 + g * 8 + (ti & 1) * 4) = pack4(acc);
                    acc2 = mma2s(BBT + ar * PITCH, SWK(ar), XT + (64 + cc) * PITCH, 0, g, acc2); acc2 = mma2s(KBT + ar * PITCH, SWK(ar), VT + cc * PITCH, SWK(cc), g, acc2);
                    *(f32x4*)(NCg + cc * 64 + rr) = acc2;
                } else {
                    acc = mma2(XT + ar * PITCH + 8 * g, ARB + cc * PITCH + 8 * g, acc);
                    const v2u rv = *(const v2u*)(RT + cc * PITCH + rr); acc[0] += bf2f(rv.x & 0xffffu); acc[1] += bf2f(rv.x >> 16); acc[2] += bf2f(rv.y & 0xffffu); acc[3] += bf2f(rv.y >> 16);
                    *(v2u*)(PPg + cc * 64 + rr) = pack4(acc);
                    acc2 = mma2(XT + (64 + ar) * PITCH + 8 * g, ARB + cc * PITCH + 8 * g, acc2); acc2 = mma2s(VT + ar * PITCH, SWK(ar), ARK + cc * PITCH, 0, g, acc2);
                    *(v2u*)(Y0g + cc * 64 + rr) = pack4(acc2);
                } }
            if (tid < 64) ((float*)(a.ws + WS_DEC))[unit * 64 + tid] = BC[64 + tid];
        }
        LBAR();
    }
}

#define LAS3 __attribute__((address_space(3)))
constexpr int R2_SLOT = 12544, R2_NS = 10, R2_FLAGS = R2_SLOT * R2_NS;
__device__ __forceinline__ void r2_scan(CArgs& a, int chain, unsigned char* L, int tid) {
    asm volatile("" : "+v"(tid));
    const int lane = tid & 63, wave = __builtin_amdgcn_readfirstlane(tid >> 6);
    const int h = chain >> 2, e0 = 16 * (chain & 3), g = lane >> 4, c16 = lane & 15;
    volatile LAS3 unsigned* flg = (volatile LAS3 unsigned*)(LAS3 unsigned char*)(L + R2_FLAGS);
    if (tid < 32) flg[tid] = 0u;
    if (tid >= 64 && tid < 64 + R2_NS) *(volatile LAS3 unsigned*)(LAS3 unsigned char*)(L + (tid - 64) * R2_SLOT + 12288 + 252) = 0xffffffffu;
    __syncthreads();
    const bf16* MC = (const bf16*)(a.ws + WS_MC); const float* NC = (const float*)(a.ws + WS_NC); const float* DEC = (const float*)(a.ws + WS_DEC);
    if (wave != 0) {
        int mco[8], nco[4];
#pragma unroll
        for (int q = 0; q < 8; ++q) { const int pos = 64 * q + lane, row = pos >> 3, kc = (pos & 7) ^ (row & 7); mco[q] = row * 64 + kc * 8; }
#pragma unroll
        for (int q = 0; q < 4; ++q) { const int pos = 64 * q + lane, e = pos >> 4, dc = (pos & 15) ^ e; nco[q] = (e0 + e) * 64 + dc * 4; }
#pragma unroll 1
        for (int c = wave - 1; c < 128; c += 7) {
            while ((int)flg[16] < c - (R2_NS - 1)) __builtin_amdgcn_s_sleep(12);
            LAS3 unsigned char* slot = (LAS3 unsigned char*)(L + (c % R2_NS) * R2_SLOT);
            const size_t unit = (size_t)c * 8 + h;
#pragma unroll
            for (int q = 0; q < 8; ++q) __builtin_amdgcn_global_load_lds((const unsigned*)(MC + unit * 4096 + mco[q]), (LAS3 unsigned*)(slot + q * 1024), 16, 0, 0);
#pragma unroll
            for (int q = 0; q < 4; ++q) __builtin_amdgcn_global_load_lds((const unsigned*)(NC + unit * 4096 + nco[q]), (LAS3 unsigned*)(slot + 8192 + q * 1024), 16, 0, 0);
            __builtin_amdgcn_global_load_lds((const unsigned*)(DEC + unit * 64 + lane), (LAS3 unsigned*)(slot + 12288), 4, 0, 0);
        }
        asm volatile("s_waitcnt vmcnt(0)" ::: "memory");
    } else {
        bf16* S0 = (bf16*)(a.ws + WS_S0) + (size_t)h * 4096 + (e0 + c16) * 64 + 4 * g;
        f32x4 S[4];
#pragma unroll
        for (int m = 0; m < 4; ++m) S[m] = (f32x4){0.f, 0.f, 0.f, 0.f};
        int avail = 0;
        const LAS3 unsigned char* Lb = (const LAS3 unsigned char*)L;
        const int offA0 = (c16 * 8 + (g ^ (c16 & 7))) * 16, offA1 = (c16 * 8 + ((4 + g) ^ (c16 & 7))) * 16;
        int offN[4];
#pragma unroll
        for (int mt = 0; mt < 4; ++mt) offN[mt] = 8192 + (c16 * 16 + ((4 * mt + g) ^ c16)) * 16;
        const int offD = 12288 + 16 * g;
#define R2_MARKS(s_) (*(volatile LAS3 unsigned*)(LAS3 unsigned char*)(L + (s_) * R2_SLOT + 12288 + 252))
#define R2_WAITS(c_, s_) do { while (avail <= (c_)) { const unsigned f0_ = R2_MARKS(s_), f1_ = R2_MARKS(((s_) + 1) % R2_NS), f2_ = R2_MARKS(((s_) + 2) % R2_NS); \
            if (f0_ != 0xffffffffu) { avail = (c_) + 1; if (f1_ != 0xffffffffu) { avail = (c_) + 2; if (f2_ != 0xffffffffu) avail = (c_) + 3; } } \
            else __builtin_amdgcn_s_sleep(0); } asm volatile("" ::: "memory"); } while (0)
        v4u A[2][4][2]; f32x4 Nn[2][4], Dd[2][4];
#define R2_READS(s_, p_) do { _Pragma("unroll") for (int mt = 0; mt < 4; ++mt) { \
                A[p_][mt][0] = *(const LAS3 v4u*)(Lb + (s_) * R2_SLOT + mt * 2048 + offA0); A[p_][mt][1] = *(const LAS3 v4u*)(Lb + (s_) * R2_SLOT + mt * 2048 + offA1); \
                Nn[p_][mt] = *(const LAS3 f32x4*)(Lb + (s_) * R2_SLOT + offN[mt]); Dd[p_][mt] = *(const LAS3 f32x4*)(Lb + (s_) * R2_SLOT + mt * 64 + offD); } } while (0)
        R2_WAITS(0, 0); R2_READS(0, 0);
        asm volatile("s_waitcnt lgkmcnt(0)" ::: "memory");
#pragma unroll 1
        for (int c0 = 0; c0 < 128; c0 += R2_NS) {
#pragma unroll
            for (int k = 0; k < R2_NS; ++k) { const int c = c0 + k;
                if (c < 128) {
                    R2_MARKS(k) = 0xffffffffu; flg[16] = (unsigned)(c + 1);
                    if (c + 1 < 128) { R2_WAITS(c + 1, (k + 1) % R2_NS); R2_READS((k + 1) % R2_NS, (k + 1) & 1); }
                    bf16* sp = S0 + (size_t)c * (8 * 4096); v2u sb[4];
#pragma unroll
                    for (int m = 0; m < 4; ++m) { sb[m] = pack4(S[m]); *(v2u*)(sp + 16 * m) = sb[m]; }
                    const v4u b0 = {sb[0].x, sb[0].y, sb[1].x, sb[1].y}, b1 = {sb[2].x, sb[2].y, sb[3].x, sb[3].y};
                    const bf16x8 B0 = __builtin_bit_cast(bf16x8, b0), B1 = __builtin_bit_cast(bf16x8, b1);
                    f32x4 acc[4];
#pragma unroll
                    for (int mt = 0; mt < 4; ++mt) acc[mt] = __builtin_amdgcn_mfma_f32_16x16x32_bf16(__builtin_bit_cast(bf16x8, A[k & 1][mt][0]), B0, Nn[k & 1][mt] + S[mt] * Dd[k & 1][mt], 0, 0, 0);
#pragma unroll
                    for (int mt = 0; mt < 4; ++mt) S[mt] = __builtin_amdgcn_mfma_f32_16x16x32_bf16(__builtin_bit_cast(bf16x8, A[k & 1][mt][1]), B1, acc[mt], 0, 0, 0);
                    asm volatile("s_waitcnt lgkmcnt(0)" ::: "memory");
                } }
        }
#undef R2_WAITS
#undef R2_MARKS
#undef R2_READS
#define R2_READ 0
#undef R2_READ
    }
    __syncthreads();
}

__device__ __forceinline__ void r3_phase(CArgs& a, size_t uo, int l, int hb, int gw, int NGW, int lane) {
    asm volatile("" : "+v"(lane));
    const int g = lane >> 4, c16 = lane & 15;
    const bf16* U = (const bf16*)(a.ws + WS_U + uo); const bf16* PP = (const bf16*)(a.ws + WS_PP); const bf16* S0 = (const bf16*)(a.ws + WS_S0); const bf16* Y0 = (const bf16*)(a.ws + WS_Y0);
    const float* BON = (const float*)(a.ws + WS_BON2); bf16* MG = (bf16*)(a.ws + WS_XN) + (size_t)hb * MH * D;
    const float* mu_v = a.in[6] + l * 1664 + 1024; const float* lnw = a.in[14] + l * 512; const float* lnb = a.in[15] + l * 512;
    const int erow = 16 * (c16 >> 2) + (c16 & 3);
#pragma unroll 1
    for (int kk = 0; kk < 2; ++kk) {
        const int unit = 4 * (gw >> 3) + ((gw & 7) >> 1), mt = 2 * (gw & 1) + kk, ch = unit >> 3, h = unit & 7; const size_t ub = (size_t)unit * 4096;
        if (unit >= NUNIT) break;
        const int lr = 64 * ch + 16 * mt + c16; const bf16* urow = U + (size_t)lr * NPAD + 64 * h + 16 * g;
        float vc[16], vp[16], rgf[16];
        unpack8(*(const v4u*)(urow + C_V), vc); unpack8(*(const v4u*)(urow + C_V + 8), vc + 8); unpack8(*(const v4u*)(urow + C_RG), rgf); unpack8(*(const v4u*)(urow + C_RG + 8), rgf + 8);
        if (lr > 0) { unpack8(*(const v4u*)(urow + C_V - NPAD), vp); unpack8(*(const v4u*)(urow + C_V + 8 - NPAD), vp + 8); }
        else {
#pragma unroll
            for (int i = 0; i < 16; ++i) vp[i] = 0.f; }
        const float bon = BON[lr * 8 + h];
        const bf16* pr = PP + ub + (16 * mt + c16) * 64 + 8 * g;
        const bf16x8 B0 = *(const bf16x8*)pr, B1 = *(const bf16x8*)(pr + 32);
        f32x4 Y[4]; bf16x8 SA[4][2];
#pragma unroll
        for (int et = 0; et < 4; ++et) { const bf16* sr = S0 + ub + (erow + 4 * et) * 64 + 8 * g; SA[et][0] = *(const bf16x8*)sr; SA[et][1] = *(const bf16x8*)(sr + 32); }
        const bf16* y0p = Y0 + ub + (16 * mt + c16) * 64 + 16 * g; const v4u y0a = *(const v4u*)y0p, y0b = *(const v4u*)(y0p + 8);
        asm volatile("" ::: "memory");
        { float yf[16]; unpack8(y0a, yf); unpack8(y0b, yf + 8);
#pragma unroll
          for (int et = 0; et < 4; ++et) Y[et] = (f32x4){yf[4 * et], yf[4 * et + 1], yf[4 * et + 2], yf[4 * et + 3]}; }
#pragma unroll
        for (int et = 0; et < 4; ++et) { f32x4 acc = __builtin_amdgcn_mfma_f32_16x16x32_bf16(SA[et][0], B0, Y[et], 0, 0, 0);
            Y[et] = __builtin_amdgcn_mfma_f32_16x16x32_bf16(SA[et][1], B1, acc, 0, 0, 0); }
        const f32x4 sv = (Y[0] + Y[1]) + (Y[2] + Y[3]); float sm = (sv.x + sv.y) + (sv.z + sv.w); sm += __shfl_xor(sm, 16); sm += __shfl_xor(sm, 32);
        const float mean = sm * (1.f / 64.f); float q = 0.f;
#pragma unroll
        for (int et = 0; et < 4; ++et) { const f32x4 dd = Y[et] - mean; q += (dd.x * dd.x + dd.y * dd.y) + (dd.z * dd.z + dd.w * dd.w); }
        q += __shfl_xor(q, 16); q += __shfl_xor(q, 32);
        const float rstd = rsqrtf(q * (1.f / 64.f) + 64e-5f);
        const int cc = 64 * h + 16 * g; float o[16];
#pragma unroll
        for (int et = 0; et < 4; ++et) {
            const f32x4 w4 = *(const f32x4*)(lnw + cc + 4 * et), b4 = *(const f32x4*)(lnb + cc + 4 * et), m4 = *(const f32x4*)(mu_v + cc + 4 * et);
#pragma unroll
            for (int j = 0; j < 4; ++j) { const int i = 4 * et + j; const float vv = vc[i] + (vp[i] - vc[i]) * m4[j]; const float yn = (Y[et][j] - mean) * rstd * w4[j] + b4[j];
                o[i] = (yn + bon * vv) * rgf[i] * sigm(rgf[i]); } }
        bf16* op = MG + (size_t)lr * D + 512 + cc; *(v4u*)op = pack8(o); *(v4u*)(op + 8) = pack8(o + 8);
    }
}

constexpr int OFF_GQI = 17408, OFF_GKI = 26624, OFF_GKST = 35840, OFF_GVT = 45056, OFF_GSC = 63488, OFF_GTOT = 72704, OFF_GBC = 74752;
constexpr size_t WS_QI = 163 * MiB, WS_OI = 167 * MiB, WS_DS = 175 * MiB, WS_GDEC = 183 * MiB, WS_SP = 184 * MiB;
constexpr int NGUNIT = 512;

__device__ __forceinline__ void g1_phase(CArgs& a, size_t uo, int l, unsigned char* L, int tid0, int ufirst, int ustride) {
    asm volatile("" : "+v"(tid0));
    const int wave = __builtin_amdgcn_readfirstlane(tid0 >> 6);
    const bf16* U = (const bf16*)(a.ws + WS_U + uo);
    float* XW = (float*)L; bf16* QI = (bf16*)(L + OFF_GQI); bf16* KI = (bf16*)(L + OFF_GKI); bf16* KST = (bf16*)(L + OFF_GKST); bf16* VT = (bf16*)(L + OFF_GVT); bf16* SC = (bf16*)(L + OFF_GSC);
    float* TOT = (float*)(L + OFF_GTOT); float* BC = (float*)(L + OFF_GBC);
    float* GW = (float*)(L + OFF_GBC + 256);
    int hl = -1;
    v4u Gl0, Gl1, Gq, Gk, Gv0, Gv1;
#define G1_ISSUE(u_) do { const int lr_ = 64 * ((u_) >> 2) + (tid >> 3), h_ = (u_) & 3, dg_ = tid & 7; const bf16* ur_ = U + (size_t)lr_ * NPAD; \
        Gl0 = *(const v4u*)(ur_ + C_GLR); Gl1 = *(const v4u*)(ur_ + C_GLR + 8); Gq = *(const v4u*)(ur_ + C_GQ + 64 * h_ + 8 * dg_); Gk = *(const v4u*)(ur_ + C_GK + 64 * h_ + 8 * dg_); \
        Gv0 = *(const v4u*)(ur_ + C_GV + 128 * h_ + 16 * dg_); Gv1 = *(const v4u*)(ur_ + C_GV + 128 * h_ + 16 * dg_ + 8); } while (0)
#pragma unroll 1
    for (int unit = ufirst; unit < NGUNIT; unit += ustride) {
        int tid = tid0; asm volatile("" : "+v"(tid));
        const int lane = tid & 63, g = lane >> 4, c16 = lane & 15;
        const int ch = unit >> 2, h = unit & 3;
        if (h != hl) { hl = h; LBAR();
            for (int i = tid; i < 16 * 64; i += NTHR) GW[i] = a.in[3][l * 16 * 256 + (i >> 6) * 256 + 64 * h + (i & 63)];
            if (tid < 64) GW[1024 + tid] = a.in[4][l * 256 + 64 * h + tid];
            LBAR(); }
        const int t = tid >> 3, dg = tid & 7, d0 = 8 * dg, lr = 64 * ch + t, hc = 64 * h + d0;
        if (unit == ufirst) G1_ISSUE(unit);
        float q[8], k[8];
        {
            float glr[16]; unpack8(Gl0, glr); unpack8(Gl1, glr + 8);
            float x[8]; const float* gb = GW + 1024 + d0; const float* gu = GW + d0;
#pragma unroll
            for (int i = 0; i < 8; ++i) x[i] = gb[i];
#pragma unroll
            for (int r = 0; r < 16; ++r) { const f32x4 u0 = *(const f32x4*)(gu + r * 64), u1 = *(const f32x4*)(gu + r * 64 + 4);
                x[0] += glr[r] * u0.x; x[1] += glr[r] * u0.y; x[2] += glr[r] * u0.z; x[3] += glr[r] * u0.w; x[4] += glr[r] * u1.x; x[5] += glr[r] * u1.y; x[6] += glr[r] * u1.z; x[7] += glr[r] * u1.w; }
#pragma unroll
            for (int i = 0; i < 8; ++i) XW[t * FP + d0 + i] = (fminf(x[i], 0.f) - __logf(1.f + __expf(-fabsf(x[i])))) * (1.f / 16.f);
            unpack8(Gq, q); unpack8(Gk, k);
            float vv[16]; const int e0 = 16 * dg; unpack8(Gv0, vv); unpack8(Gv1, vv + 8);
            asm volatile("" ::: "memory");
            if (unit + ustride < NGUNIT) G1_ISSUE(unit + ustride);
#pragma unroll
            for (int i = 0; i < 16; ++i) VT[SWC(e0 + i, t)] = (bf16)f2bf(vv[i]);
        }
        LBAR();
        {
            const int d = tid & 63, tb = tid >> 6; float p[8]; float run = 0.f;
#pragma unroll
            for (int i = 0; i < 8; ++i) { run += XW[(8 * tb + i) * FP + d]; p[i] = run; }
            TOT[tb * 64 + d] = run;
            LBAR();
            float off = 0.f;
#pragma unroll
            for (int j = 0; j < 8; ++j) off += (j < tb) ? TOT[j * 64 + d] : 0.f;
#pragma unroll
            for (int i = 0; i < 8; ++i) XW[(8 * tb + i) * FP + d] = off + p[i];
            if (tb == 7) BC[d] = off + run;
        }
        LBAR();
        {
            float qi[8], ki[8];
#pragma unroll
            for (int i = 0; i < 8; ++i) { const float b = XW[t * FP + d0 + i], bc = BC[d0 + i];
                qi[i] = q[i] * 0.125f * __expf(b); ki[i] = k[i] * __expf(-b); KST[SWC(d0 + i, t)] = (bf16)f2bf(k[i] * __expf(bc - b)); }
            const v4u qp = pack8(qi);
            *(v4u*)(QI + t * PITCH + d0) = qp; *(v4u*)(KI + t * PITCH + d0) = pack8(ki);
            *(v4u*)((bf16*)(a.ws + WS_QI) + (size_t)unit * 4096 + t * 64 + d0) = qp;
        }
        LBAR();
        {
            const int tt = wave >> 1; const int tcol = 16 * tt + c16;
#pragma unroll
            for (int j2 = 0; j2 < 2; ++j2) { const int jt = 2 * (wave & 1) + j2; f32x4 acc = {0.f, 0.f, 0.f, 0.f};
                if (jt <= tt) { acc = mma2(KI + (16 * jt + c16) * PITCH + 8 * g, QI + tcol * PITCH + 8 * g, acc);
#pragma unroll
                    for (int j = 0; j < 4; ++j) if (16 * jt + 4 * g + j > tcol) acc[j] = 0.f; }
                *(v2u*)(SC + tcol * PITCH + 16 * jt + 4 * g) = pack4(acc); }
            bf16* DSg = (bf16*)(a.ws + WS_DS) + (size_t)unit * 8192;
#pragma unroll
            for (int i = 0; i < 4; ++i) { const int tile = wave * 4 + i, dt = tile & 3, et = tile >> 2; f32x4 acc = {0.f, 0.f, 0.f, 0.f};
                { const int ar = 16 * dt + c16, br = 16 * et + c16; acc = mma2s(KST + ar * PITCH, SWK(ar), VT + br * PITCH, SWK(br), g, acc); }
                *(v2u*)(DSg + (16 * et + c16) * 64 + 16 * dt + 4 * g) = pack4(acc); }
            if (tid < 64) ((float*)(a.ws + WS_GDEC))[unit * 64 + tid] = __expf(BC[tid]);
        }
        LBAR();
        {
            bf16* OIg = (bf16*)(a.ws + WS_OI) + (size_t)unit * 8192;
#pragma unroll
            for (int i = 0; i < 4; ++i) { const int tile = wave * 4 + i, tt = tile & 3, et = tile >> 2; f32x4 acc = {0.f, 0.f, 0.f, 0.f};
                { const int ar = 16 * et + c16; acc = mma2s(VT + ar * PITCH, SWK(ar), SC + (16 * tt + c16) * PITCH, 0, g, acc); }
                *(v2u*)(OIg + (16 * tt + c16) * 128 + 16 * et + 4 * g) = pack4(acc); }
        }
        LBAR();
    }
}

__device__ __forceinline__ void g2_scan(CArgs& a, int wg, unsigned char* L, int tid) {
    asm volatile("" : "+v"(tid));
    const int h = wg >> 2, e = 32 * (wg & 3) + (tid >> 4), dq = tid & 15;
    const bf16* DS = (const bf16*)(a.ws + WS_DS) + (size_t)h * 8192 + e * 64 + 4 * dq; const float* GD = (const float*)(a.ws + WS_GDEC) + (size_t)(((tid >> 4) & 15) * 4 + h) * 64 + 4 * dq;
    bf16* SP = (bf16*)(a.ws + WS_SP) + (size_t)h * 8192 + e * 64 + 4 * dq;
    float* DCL = (float*)L;
    v2u dsb[2][16]; f32x4 dcr;
    f32x4 S = {0.f, 0.f, 0.f, 0.f};
#pragma unroll
    for (int i = 0; i < 16; ++i) dsb[0][i] = *(const v2u*)(DS + (size_t)i * (4 * 8192));
    dcr = *(const f32x4*)GD;
    if (tid < 256) *(f32x4*)(DCL + (tid >> 4) * 64 + 4 * dq) = dcr;
#pragma unroll 1
    for (int b2 = 0; b2 < 8; b2 += 2) {
#pragma unroll
        for (int bb = 0; bb < 2; ++bb) { const int b = b2 + bb;
            if (b + 1 < 8) {
#pragma unroll
                for (int i = 0; i < 16; ++i) dsb[(bb + 1) & 1][i] = *(const v2u*)(DS + (size_t)(16 * (b + 1) + i) * (4 * 8192));
                dcr = *(const f32x4*)(GD + (size_t)(16 * (b + 1)) * (4 * 64)); }
            LBAR();
            const float* dcl = DCL + bb * 1024 + 4 * dq;
#pragma unroll
            for (int i = 0; i < 16; ++i) { const f32x4 dc = *(const f32x4*)(dcl + i * 64); const v2u w = dsb[bb][i];
                *(v2u*)(SP + (size_t)(16 * b + i) * (4 * 8192)) = pack4(S);
                const f32x4 dv = {bf2f(w.x & 0xffffu), bf2f(w.x >> 16), bf2f(w.y & 0xffffu), bf2f(w.y >> 16)};
                S = S * dc + dv; }
            if (b + 1 < 8 && tid < 256) *(f32x4*)(DCL + ((bb + 1) & 1) * 1024 + (tid >> 4) * 64 + 4 * dq) = dcr;
        }
    }
    LBAR();
}

__device__ __forceinline__ void g3_phase(CArgs& a, size_t uo, int l, int hb, int gw, int NGW, int lane) {
    asm volatile("" : "+v"(lane));
    const int g = lane >> 4, c16 = lane & 15;
    const bf16* U = (const bf16*)(a.ws + WS_U + uo); const bf16* QI = (const bf16*)(a.ws + WS_QI); const bf16* SP = (const bf16*)(a.ws + WS_SP); const bf16* OI = (const bf16*)(a.ws + WS_OI);
    bf16* MG = (bf16*)(a.ws + WS_XN) + (size_t)hb * MH * D; const float* gnw = a.in[5] + l * 128;
    const int erow = 32 * (c16 >> 2) + (c16 & 3);
#pragma unroll 1
    for (int kk = 0; kk < 1; ++kk) {
        const int unit = (gw >> 3) + 256 * ((gw & 7) >> 2), mt = gw & 3, ch = unit >> 2, h = unit & 3;
        if (unit >= NGUNIT) break;
        const int lr = 64 * ch + 16 * mt + c16; const bf16* urow = U + (size_t)lr * NPAD + C_GG + 128 * h + 32 * g;
        const v4u gg0 = *(const v4u*)urow, gg1 = *(const v4u*)(urow + 8), gg2 = *(const v4u*)(urow + 16), gg3 = *(const v4u*)(urow + 24);
        const bf16* qr = QI + (size_t)unit * 4096 + (16 * mt + c16) * 64 + 8 * g;
        const bf16x8 B0 = *(const bf16x8*)qr, B1 = *(const bf16x8*)(qr + 32);
        f32x4 O[8]; float ss = 0.f; bf16x8 SA[8][2];
#pragma unroll
        for (int et = 0; et < 8; ++et) { const bf16* sr = SP + (size_t)unit * 8192 + (erow + 4 * et) * 64 + 8 * g; SA[et][0] = *(const bf16x8*)sr; SA[et][1] = *(const bf16x8*)(sr + 32); }
        const bf16* oip = OI + (size_t)unit * 8192 + (16 * mt + c16) * 128 + 32 * g; const v4u oi0 = *(const v4u*)oip, oi1 = *(const v4u*)(oip + 8), oi2 = *(const v4u*)(oip + 16), oi3 = *(const v4u*)(oip + 24);
        asm volatile("" ::: "memory");
        { float of[32]; unpack8(oi0, of); unpack8(oi1, of + 8); unpack8(oi2, of + 16); unpack8(oi3, of + 24);
#pragma unroll
          for (int et = 0; et < 8; ++et) O[et] = (f32x4){of[4 * et], of[4 * et + 1], of[4 * et + 2], of[4 * et + 3]}; }
#pragma unroll
        for (int et = 0; et < 8; ++et) { f32x4 acc = __builtin_amdgcn_mfma_f32_16x16x32_bf16(SA[et][0], B0, O[et], 0, 0, 0);
            acc = __builtin_amdgcn_mfma_f32_16x16x32_bf16(SA[et][1], B1, acc, 0, 0, 0);
            O[et] = acc; ss += (acc.x * acc.x + acc.y * acc.y) + (acc.z * acc.z + acc.w * acc.w); }
        ss += __shfl_xor(ss, 16); ss += __shfl_xor(ss, 32);
        const float rstd = rsqrtf(ss * (1.f / 128.f) + 1e-6f);
        float gf[32], o[32]; unpack8(gg0, gf); unpack8(gg1, gf + 8); unpack8(gg2, gf + 16); unpack8(gg3, gf + 24);
#pragma unroll
        for (int et = 0; et < 8; ++et) { const f32x4 w4 = *(const f32x4*)(gnw + 32 * g + 4 * et);
#pragma unroll
            for (int j = 0; j < 4; ++j) { const int i = 4 * et + j; o[i] = O[et][j] * rstd * w4[j] * gf[i] * sigm(gf[i]); } }
        bf16* op = MG + (size_t)lr * D + 128 * h + 32 * g;
        *(v4u*)op = pack8(o); *(v4u*)(op + 8) = pack8(o + 8); *(v4u*)(op + 16) = pack8(o + 16); *(v4u*)(op + 24) = pack8(o + 24);
    }
}

#define LAS __attribute__((address_space(3)))
#define XB_TMO      128
#define XB_XCNT(j)  (256  + 64 * (j))
#define XB_XSUB(j)  (1280 + 64 * (j))
#define XB_XGEN(j)  (2304 + 64 * (j))
#define XB_TOP      3328
#define XB_TOPGEN   3392
#define XCD_BAR_WORDS 3456
#define XB_SPIN_CAP (1u << 18)

__device__ __forceinline__ unsigned xb_ld(unsigned* p)              { return __hip_atomic_load(p, __ATOMIC_RELAXED, __HIP_MEMORY_SCOPE_AGENT); }
__device__ __forceinline__ unsigned xb_add(unsigned* p, unsigned v) { return __hip_atomic_fetch_add(p, v, __ATOMIC_RELAXED, __HIP_MEMORY_SCOPE_AGENT); }
__device__ __forceinline__ unsigned xb_xcc_id() { return (unsigned)__builtin_amdgcn_s_getreg((3 << 11) | 20) & 0xFu; }
#define XB_SPIN(cond, bar) do { unsigned _sp = 0; while (cond) { __builtin_amdgcn_s_sleep(1); \
    if ((++_sp & 255u) == 0u) { if (xb_ld(&(bar)[XB_TMO])) break; if (_sp > XB_SPIN_CAP) { atomicAdd(&(bar)[XB_TMO], 1u); break; } } } } while (0)

struct XcdBarrier {
    unsigned* bar; unsigned x;
    volatile LAS unsigned* st;
};

__device__ __forceinline__ XcdBarrier xcd_barrier_post(unsigned* bar, volatile LAS unsigned* st) {
    XcdBarrier b; b.bar = bar; b.x = xb_xcc_id(); b.st = st;
    if (threadIdx.x == 0) (void)xb_add(&bar[XB_XCNT(b.x)], 1u);
    return b;
}
__device__ __forceinline__ void xcd_barrier_complete(unsigned* bar, unsigned x, unsigned& nloc, unsigned& nx) {
    const unsigned G = gridDim.x * gridDim.y * gridDim.z;
    unsigned sum, cnt, mine, sp = 0u;
    for (;;) {
        sum = 0u; cnt = 0u; mine = 0u;
#pragma unroll
        for (unsigned j = 0; j < 16; ++j) { const unsigned c = xb_ld(&bar[XB_XCNT(j)]); sum += c; cnt += (c > 0u) ? 1u : 0u; mine = (j == x) ? c : mine; }
        if (sum == G) break;
        __builtin_amdgcn_s_sleep(1);
        if ((++sp & 255u) == 0u) { if (xb_ld(&bar[XB_TMO])) break; if (sp > XB_SPIN_CAP) { atomicAdd(&bar[XB_TMO], 1u); break; } }
    }
    nloc = mine > 0u ? mine : 1u; nx = cnt > 0u ? cnt : 1u;
}

__device__ __forceinline__ void xcd_barrier(const XcdBarrier& b) {
    asm volatile("s_waitcnt vmcnt(0)" ::: "memory");
    __syncthreads();
    if (threadIdx.x == 0) {
        unsigned* bar = b.bar;
        __builtin_amdgcn_s_waitcnt(0);
        unsigned nloc = b.st[0], nx = b.st[1];
        if (nloc == 0u) { xcd_barrier_complete(bar, b.x, nloc, nx); b.st[0] = nloc; b.st[1] = nx; }
        const unsigned old = xb_add(&bar[XB_XSUB(b.x)], 1u);
        const unsigned gen = old / nloc;
        if (old + 1u == (gen + 1u) * nloc) {
            __builtin_amdgcn_fence(__ATOMIC_RELEASE, "agent");
            asm volatile("s_waitcnt vmcnt(0)" ::: "memory");
            const unsigned og = xb_add(&bar[XB_TOP], 1u);
            const unsigned tg = og / nx;
            if (og + 1u == (tg + 1u) * nx) xb_add(&bar[XB_TOPGEN], 1u);
            else XB_SPIN(xb_ld(&bar[XB_TOPGEN]) == tg, bar);
            __builtin_amdgcn_fence(__ATOMIC_ACQUIRE, "agent");
            xb_add(&bar[XB_XGEN(b.x)], 1u);
            asm volatile("s_waitcnt vmcnt(0)" ::: "memory");
        } else {
            XB_SPIN(xb_ld(&bar[XB_XGEN(b.x)]) == gen, bar);
            __builtin_amdgcn_fence(__ATOMIC_ACQUIRE, "agent");
            asm volatile("s_waitcnt vmcnt(0)" ::: "memory");
        }
    }
    __syncthreads();
}


__global__ void __launch_bounds__(NTHR, 2) hymba_fwd(Args a_kernarg) {
    extern __shared__ __attribute__((aligned(16))) unsigned char lds[];
    cg::grid_group grid = cg::this_grid();
    const int tid = threadIdx.x, lane = tid & 63, wave = __builtin_amdgcn_readfirstlane(tid >> 6);
    const int G = gridDim.x, gw = blockIdx.x * NWAVES + wave, NGW = G * NWAVES;
    volatile LAS unsigned* xst = (volatile LAS unsigned*)(LAS unsigned char*)(lds + LDS_BYTES - 64);
    if (tid < 2) xst[tid] = 0u;
    __syncthreads();
    const XcdBarrier xbar = xcd_barrier_post((unsigned*)AA.ws, xst);
    {
        CArgs& a = AA; bf16* XN = (bf16*)(a.ws + WS_XN);
        float* scr = (float*)lds;
        constexpr int T_IN = (D / 64) * (NPAD / 64), T_OUT = (D / 64) * (D / 64);
        for (int l = 0; l < 2; ++l) {
            transpose_tiles(a.in[2] + (size_t)l * D * NIN, D, NIN, NPAD, (bf16*)(a.ws + WS_WIN + l * WIN_BYTES), scr, (int)blockIdx.x, G, T_IN, tid);
            transpose_tiles(a.in[16] + (size_t)l * D * D, D, D, D, (bf16*)(a.ws + WS_WOUT + l * WOUT_BYTES), scr, (int)blockIdx.x, G, T_OUT, tid);
        }
        for (int m = 2 * gw; m < M; m += 2 * NGW) rms_row2(a.in[0] + (size_t)m * D, a.in[0] + (size_t)(m + 1) * D, a.in[1], XN + (size_t)m * D, XN + (size_t)(m + 1) * D, lane);
        {
            bf16* UPT = (bf16*)(a.ws + WS_UPT);
            for (int e = blockIdx.x * NTHR + tid; e < 2 * 2 * 512 * 64; e += G * NTHR) { const int r = e & 63, c = (e >> 6) & 511, q = (e >> 15) & 1, ll = e >> 16;
                UPT[e] = (bf16)f2bf((q ? a.in[10] : a.in[8])[(size_t)ll * 64 * 512 + r * 512 + c]); }
        }
    }
    if (AA.ws == nullptr) grid.sync();
    xcd_barrier(xbar);
    for (int l = 0; l < 2; ++l) {
        for (int hb = 0; hb < 2; ++hb) {
            {
                CArgs& a = AA; bf16* XN = (bf16*)(a.ws + WS_XN); bf16* U = (bf16*)(a.ws + WS_U + (size_t)hb * U_STRIDE);
                pg8::Gemm g{XN + (size_t)hb * MH * D, (const bf16*)(a.ws + WS_WIN + l * WIN_BYTES), MH, NPAD, D}; pg8::RangeOrder S;
                if (hb == 0) S.init(MH, NPAD, G, (int)blockIdx.x, 0, 480); else S.init(MH, NPAD, G, (int)blockIdx.x, EARLY_TILES, 480 - EARLY_TILES);
                pg8::EpiBf16<0> E{U, NPAD, nullptr, 0, 0, 1.f};
                pg8::gemm_phase<pg8::EpiBf16<0>, pg8::RangeOrder, true, true>((PG8_LAS unsigned char*)lds, g, S, E);
            }
            xcd_barrier(xbar);
            const size_t uo = (size_t)hb * U_STRIDE;
            r1_phase(AA, uo, l, lds, tid);
            g1_phase(AA, uo, l, lds, tid, (int)blockIdx.x, G);
            xcd_barrier(xbar);
            if (blockIdx.x < 32) r2_scan(AA, blockIdx.x, lds, tid);
            else { if (blockIdx.x < 48) g2_scan(AA, blockIdx.x - 32, lds, tid);
                if (hb == 0) {
                    CArgs& a = AA; bf16* XN = (bf16*)(a.ws + WS_XN); bf16* U1 = (bf16*)(a.ws + WS_U1);
                    pg8::Gemm g{XN + (size_t)MH * D, (const bf16*)(a.ws + WS_WIN + l * WIN_BYTES), MH, NPAD, D}; pg8::RangeOrder S; S.init(MH, NPAD, G, (int)blockIdx.x - 32, 0, EARLY_TILES);
                    pg8::EpiBf16<0> E{U1, NPAD, nullptr, 0, 0, 1.f};
                    pg8::gemm_phase<pg8::EpiBf16<0>, pg8::RangeOrder, true, true>((PG8_LAS unsigned char*)lds, g, S, E); } }
            xcd_barrier(xbar);
            r3_phase(AA, uo, l, hb, gw, NGW, lane);
            g3_phase(AA, uo, l, hb, gw, NGW, lane);
            if (hb == 1) xcd_barrier(xbar);
        }
        {
            CArgs& a = AA; bf16* XN = (bf16*)(a.ws + WS_XN);
            pg8::Gemm g{XN, (const bf16*)(a.ws + WS_WOUT + l * WOUT_BYTES), M, D, D}; pg8::StaticOrder S; S.init(M, D, G, (int)blockIdx.x);
            pg8::EpiRmsRes E{l == 0 ? a.in[0] : a.out, a.out, XN, l == 0 ? a.in[1] + D : a.in[17], (float*)(a.ws + WS_SLOTS) + (size_t)l * M * 4, (unsigned*)(a.ws + 16384) + l * 64 * 64, D, l};
            pg8::gemm_phase<pg8::EpiRmsRes, pg8::StaticOrder, false, true>((PG8_LAS unsigned char*)lds, g, S, E);
        }
        if (l == 0) xcd_barrier(xbar);
    }
}

extern "C" void kernel_launch(void* const* d_in, const int* in_sizes, int n_in, void* d_out, int out_size, void* d_ws, size_t ws_size, hipStream_t stream) {
    static int grid = 0;
    if (grid == 0) {
        if (n_in != 18 || out_size != M * D || ws_size < WS_END) { fprintf(stderr, "kernel_launch: unexpected shapes n_in %d out %d ws %zu\n", n_in, out_size, ws_size); grid = -1; return; }
        int dev = 0, cus = 0, per_cu = 0;
        hipGetDevice(&dev); hipDeviceGetAttribute(&cus, hipDeviceAttributeMultiprocessorCount, dev);
        if (hipFuncSetAttribute((const void*)hymba_fwd, hipFuncAttributeMaxDynamicSharedMemorySize, LDS_BYTES) != hipSuccess) { fprintf(stderr, "kernel_launch: hipFuncSetAttribute failed\n"); grid = -1; return; }
        if (hipOccupancyMaxActiveBlocksPerMultiprocessor(&per_cu, (const void*)hymba_fwd, NTHR, LDS_BYTES) != hipSuccess || per_cu < 1) { fprintf(stderr, "kernel_launch: occupancy query failed (%d)\n", per_cu); grid = -1; return; }
        grid = cus * 1;
        fprintf(stderr, "kernel_launch: cus %d per_cu %d grid %d\n", cus, per_cu, grid);
    }
    if (grid < 0) return;
    if (hipMemsetAsync(d_ws, 0, 65536, stream) != hipSuccess) { fprintf(stderr, "kernel_launch: memset failed\n"); return; }
    Args a{};
    for (int i = 0; i < 18; ++i) a.in[i] = (const float*)d_in[i];
    a.out = (float*)d_out; a.ws = (unsigned char*)d_ws;
    void* args[] = {&a};
    hipError_t e = hipLaunchCooperativeKernel((const void*)hymba_fwd, dim3(grid), dim3(NTHR), args, LDS_BYTES, stream);
    if (e != hipSuccess) fprintf(stderr, "cooperative launch failed: %s (grid %d)\n", hipGetErrorString(e), grid);
}
```

```cpp
#include <hip/hip_runtime.h>
#include <hip/hip_cooperative_groups.h>
#include <cstdio>
#include <cstdint>
namespace cg = cooperative_groups;
namespace pg8 {
#define PG8_LAS __attribute__((address_space(3)))
typedef unsigned short bf16_t;
typedef short bf16x8 __attribute__((ext_vector_type(8)));
typedef float f32x4 __attribute__((ext_vector_type(4)));
typedef unsigned u32x4 __attribute__((ext_vector_type(4)));
constexpr int BM = 256, BK = 64, HALF = 128, HTB = HALF * BK * 2  , STAGE_BYTES = 8 * HTB, NXCD = 8, WGM = 8;

__host__ __device__ __forceinline__ int lds_byte(int r, int c) { const int st = (r >> 4) * 2 + (c >> 5), rr = r & 15, cc = c & 31, ob = rr * 64 + cc * 2; return st * 1024 + (ob ^ (((ob >> 9) & 1) << 5)); }
__host__ __device__ __forceinline__ void stage_rc(int b, int& R, int& C) { const int st = b / 1024, sb = b % 1024, swz = sb ^ (((sb >> 9) & 1) << 5); R = (st >> 1) * 16 + swz / 64; C = (st & 1) * 32 + (swz % 64) / 2; }
__host__ __device__ __forceinline__ int perm32(int rho) { const int n = rho >> 4, i = rho & 15; return 8 * (i >> 2) + 4 * n + (i & 3); }

struct Unit { int pm, pn; };
struct Gemm { const bf16_t* A; const bf16_t* Bt; int M, N, K; };

struct StaticOrder {
    int nM, nN, nwg, G, c;
    __host__ __device__ void init(int M, int N, int G_, int c_) { nM = M / BM; nN = N / BM; nwg = nM * nN; G = G_; c = c_; }
    __host__ __device__ bool next(int i, Unit& u) const {
        const long L = (long)i * G + c; if (L >= nwg) return false;
        int wgid = (int)L; { const int q = nwg / NXCD, r = nwg % NXCD, xcd = wgid % NXCD, off = wgid / NXCD; wgid = (xcd < r ? xcd * (q + 1) : r * (q + 1) + (xcd - r) * q) + off; }
        const int nig = WGM * nN, gid = wgid / nig, fm = gid * WGM, gsz = (nM - fm) < WGM ? (nM - fm) : WGM;
        u.pm = fm + ((wgid % nig) % gsz); u.pn = (wgid % nig) / gsz; return true;
    }
    __device__ __forceinline__ void a_ready(const Unit&) const {}
    __device__ __forceinline__ void done(const Unit&) const {}
};

__device__ __forceinline__ unsigned cvt_pk_bf16(float lo, float hi) { unsigned r; asm volatile("v_cvt_pk_bf16_f32 %0, %1, %2" : "=v"(r) : "v"(lo), "v"(hi)); return r; }
typedef float f32x2 __attribute__((ext_vector_type(2)));
__device__ __forceinline__ f32x2 gelu_pk(f32x2 v) {
    const f32x2 av = __builtin_elementwise_abs(v), d = av * 0.2316418882f + 1.0f;
    f32x2 t; t.x = __builtin_amdgcn_rcpf(d.x); t.y = __builtin_amdgcn_rcpf(d.y);
    f32x2 q = t * 0.5307027145f + (-0.7265760135f); q = q * t + 0.7107068705f; q = q * t + (-0.142248368f); q = q * t + 0.127414796f; q = q * t;
    const f32x2 s = (v * v) * (-0.72134752044f);
    f32x2 e; e.x = __builtin_amdgcn_exp2f(s.x); e.y = __builtin_amdgcn_exp2f(s.y);
    const f32x2 m = v * (q * e), r = v - m;
    f32x2 o; o.x = v.x < 0.f ? m.x : r.x; o.y = v.y < 0.f ? m.y : r.y; return o;
}

template <int ACT  > struct EpiBf16 {
    static constexpr bool PERM = true, AFTER_DRAIN = false; static_assert(ACT == 0 || ACT == 1, "EpiBf16: ACT is 0 (none) or 1 (gelu_pk)");
    bf16_t* O; int ldc; const float* bias; int split_cols; size_t split_stride; float scale0;
    __device__ __forceinline__ void operator()(const f32x4 (&acc)[2][2][4][2], const Unit& u, int wr, int wc, int fr, int fq) const {
        const int row0 = u.pm * BM + wr * 64 + fr; int colt = u.pn * BM; bf16_t* base = O;
        float sc = 1.f; if (split_cols) { const int t = colt / split_cols; base += (size_t)t * split_stride; colt -= t * split_cols; if (t == 0) sc = scale0; }
        const int col0 = colt + wc * 32 + 8 * fq, bcol0 = u.pn * BM + wc * 32 + 8 * fq;
        f32x4 bv[2][2];
#pragma unroll
        for (int bj = 0; bj < 2; ++bj)
#pragma unroll
            for (int n = 0; n < 2; ++n) bv[bj][n] = bias ? *(const f32x4*)(bias + bcol0 + bj * HALF + 4 * n) : (f32x4){0.f, 0.f, 0.f, 0.f};
#pragma unroll
        for (int ai = 0; ai < 2; ++ai)
#pragma unroll
            for (int m = 0; m < 4; ++m) { bf16_t* rowp = base + (size_t)(row0 + ai * HALF + m * 16) * ldc + col0;
#pragma unroll
                for (int bj = 0; bj < 2; ++bj) { f32x4 v0 = acc[ai][bj][m][0] + bv[bj][0], v1 = acc[ai][bj][m][1] + bv[bj][1];
                    if (ACT == 1) { f32x2 a = gelu_pk((f32x2){v0[0], v0[1]}), b = gelu_pk((f32x2){v0[2], v0[3]}), c = gelu_pk((f32x2){v1[0], v1[1]}), d = gelu_pk((f32x2){v1[2], v1[3]});
                        v0 = (f32x4){a.x, a.y, b.x, b.y}; v1 = (f32x4){c.x, c.y, d.x, d.y}; }
                    v0 = v0 * sc; v1 = v1 * sc; u32x4 w; w.x = cvt_pk_bf16(v0[0], v0[1]); w.y = cvt_pk_bf16(v0[2], v0[3]); w.z = cvt_pk_bf16(v1[0], v1[1]); w.w = cvt_pk_bf16(v1[2], v1[3]);
                    *(u32x4*)(rowp + bj * HALF) = w; } }
    }
};

template <class Epi, class Sched, bool ALIGN_EPI = false, bool SP2 = false>
__device__ __forceinline__ void gemm_phase(PG8_LAS unsigned char* lds, const Gemm g, const Sched& S, const Epi& E) {
    int tid_ = threadIdx.x; asm volatile("" : "+v"(tid_));
    const int tid = tid_, wid = __builtin_amdgcn_readfirstlane(tid >> 6), lane = tid & 63, wr = wid >> 2, wc = wid & 3, fr = lane & 15, fq = lane >> 4;
    const int K = g.K, nt = K / BK;
    unsigned voffA[2], voffB[2];
#pragma unroll
    for (int i = 0; i < 2; ++i) { int R, C; stage_rc(tid * 16 + i * 8192, R, C); const int Rb = Epi::PERM ? ((R & ~31) + perm32(R & 31)) : R;
        voffA[i] = (unsigned)(R * K + C) * 2u; voffB[i] = (unsigned)(Rb * K + C) * 2u; }
    const size_t kstep = (size_t)(BK * 2);
    const size_t hstep = (size_t)HALF * K * 2;
    const size_t tstep = 2 * hstep;
    const unsigned ldsw = (unsigned)wid * 1024u;
    const int aoff = lds_byte(wr * 64 + fr, fq * 8), boff = lds_byte(wc * 32 + fr, fq * 8);
#define PG8_SA(b, h) (((b) * 2 + (h)) * HTB)
#define PG8_SB(b, h) ((4 + (b) * 2 + (h)) * HTB)
#define PG8_STAGE(bufoff, gbase, voff) do { _Pragma("unroll") for (int _i = 0; _i < 2; ++_i) \
        __builtin_amdgcn_global_load_lds((const unsigned*)((const char*)(gbase) + (voff)[_i]), (PG8_LAS unsigned*)(lds + (bufoff) + ldsw + _i * 8192), 16, 0, 0); } while (0)
#define PG8_LDA(dst, b, h) do { _Pragma("unroll") for (int m = 0; m < 4; ++m) _Pragma("unroll") for (int k = 0; k < 2; ++k) dst[m][k] = *(const PG8_LAS bf16x8*)(lds + PG8_SA(b, h) + aoff + m * 2048 + k * 1024); } while (0)
#define PG8_LDB(dst, b, h) do { _Pragma("unroll") for (int n = 0; n < 2; ++n) _Pragma("unroll") for (int k = 0; k < 2; ++k) dst[n][k] = *(const PG8_LAS bf16x8*)(lds + PG8_SB(b, h) + boff + n * 2048 + k * 1024); } while (0)
#define PG8_MMA(ai, bj, At, Bt) do { __builtin_amdgcn_s_setprio(1); _Pragma("unroll") for (int m = 0; m < 4; ++m) _Pragma("unroll") for (int n = 0; n < 2; ++n) _Pragma("unroll") for (int k = 0; k < 2; ++k) \
        acc[ai][bj][m][n] = __builtin_amdgcn_mfma_f32_16x16x32_bf16(Bt[n][k], At[m][k], acc[ai][bj][m][n], 0, 0, 0); __builtin_amdgcn_s_setprio(0); } while (0)
#define PG8_WAIT_V(n) asm volatile("s_waitcnt vmcnt(" #n ")" ::: "memory")
#define PG8_WAIT_L(n) asm volatile("s_waitcnt lgkmcnt(" #n ")" ::: "memory")
#define PG8_BAR __builtin_amdgcn_s_barrier()
#define PG8_SCHED __builtin_amdgcn_sched_barrier(0)
    Unit cur, nxt; int ui = 0;
    if (!S.next(0, cur)) return;
    f32x4 acc[2][2][4][2];
#pragma unroll
    for (int a = 0; a < 2; ++a)
#pragma unroll
        for (int b = 0; b < 2; ++b)
#pragma unroll
            for (int m = 0; m < 4; ++m)
#pragma unroll
                for (int n = 0; n < 2; ++n) acc[a][b][m][n] = (f32x4){0.f, 0.f, 0.f, 0.f};
    bf16x8 At[4][2], B0[2][2], B1[2][2];
    const char* cA = (const char*)g.A + (size_t)cur.pm * tstep; const char* cB = (const char*)g.Bt + (size_t)cur.pn * tstep;
    S.a_ready(cur);
    if constexpr (SP2) {
        PG8_STAGE(PG8_SB(0, 0), cB, voffB); PG8_STAGE(PG8_SB(0, 1), cB + hstep, voffB); PG8_STAGE(PG8_SA(0, 0), cA, voffA); PG8_STAGE(PG8_SA(0, 1), cA + hstep, voffA);
        if (wr == 1) PG8_BAR;
        PG8_WAIT_V(2); PG8_BAR;
        PG8_STAGE(PG8_SB(1, 0), cB + kstep, voffB); PG8_STAGE(PG8_SA(1, 0), cA + kstep, voffA); PG8_STAGE(PG8_SB(1, 1), cB + hstep + kstep, voffB);
        PG8_WAIT_V(6); PG8_BAR;
    } else {
        PG8_STAGE(PG8_SB(0, 0), cB, voffB); PG8_STAGE(PG8_SA(0, 0), cA, voffA); PG8_STAGE(PG8_SB(0, 1), cB + hstep, voffB); PG8_STAGE(PG8_SA(0, 1), cA + hstep, voffA);
        if (wr == 1) PG8_BAR;
        PG8_WAIT_V(4); PG8_BAR;
        PG8_STAGE(PG8_SB(1, 0), cB + kstep, voffB); PG8_STAGE(PG8_SA(1, 0), cA + kstep, voffA); PG8_STAGE(PG8_SB(1, 1), cB + hstep + kstep, voffB);
        PG8_WAIT_V(6); PG8_BAR;
    }
    for (;;) {
        const bool has_next = S.next(ui + 1, nxt);
        const char* nA = has_next ? (const char*)g.A + (size_t)nxt.pm * tstep : cA; const char* nB = has_next ? (const char*)g.Bt + (size_t)nxt.pn * tstep : cB;
        for (int t = 0; t < nt; t += 2) {
            const bool last = (t == nt - 2);
            const char* a1 = cA + (size_t)(t + 1) * kstep;
            const char* a2 = last ? nA : cA + (size_t)(t + 2) * kstep; const char* b2 = last ? nB : cB + (size_t)(t + 2) * kstep;
            const char* a3 = a2 + kstep; const char* b3 = b2 + kstep;
            if (last && has_next) S.a_ready(nxt);
            if constexpr (SP2) {
            PG8_LDB(B0, 0, 0); PG8_LDB(B1, 0, 1); PG8_SCHED; PG8_LDA(At, 0, 0); PG8_STAGE(PG8_SA(1, 1), a1 + hstep, voffA);
            PG8_WAIT_V(8); PG8_WAIT_L(0); PG8_BAR; PG8_MMA(0, 0, At, B0); PG8_MMA(0, 1, At, B1); PG8_BAR; PG8_SCHED;
            PG8_LDA(At, 0, 1); PG8_STAGE(PG8_SB(0, 0), b2, voffB); PG8_STAGE(PG8_SB(0, 1), b2 + hstep, voffB); PG8_STAGE(PG8_SA(0, 0), a2, voffA);
            PG8_WAIT_V(8); PG8_WAIT_L(0); PG8_BAR; PG8_MMA(1, 0, At, B0); PG8_MMA(1, 1, At, B1); PG8_BAR; PG8_SCHED;
            PG8_LDB(B0, 1, 0); PG8_LDB(B1, 1, 1); PG8_SCHED; PG8_LDA(At, 1, 0); PG8_STAGE(PG8_SA(0, 1), a2 + hstep, voffA);
            PG8_WAIT_V(8); PG8_WAIT_L(0); PG8_BAR; PG8_MMA(0, 0, At, B0); PG8_MMA(0, 1, At, B1); PG8_BAR; PG8_SCHED;
            PG8_LDA(At, 1, 1); PG8_STAGE(PG8_SB(1, 0), b3, voffB); PG8_STAGE(PG8_SB(1, 1), b3 + hstep, voffB); PG8_STAGE(PG8_SA(1, 0), a3, voffA);
            PG8_WAIT_V(8); PG8_WAIT_L(0); PG8_BAR; PG8_MMA(1, 0, At, B0); PG8_MMA(1, 1, At, B1); PG8_BAR; PG8_SCHED;
            } else {
            PG8_LDB(B0, 0, 0); PG8_SCHED; PG8_LDA(At, 0, 0); PG8_STAGE(PG8_SA(1, 1), a1 + hstep, voffA);
            PG8_WAIT_L(8); PG8_BAR; PG8_WAIT_L(0); PG8_MMA(0, 0, At, B0); PG8_BAR; PG8_SCHED;
            PG8_LDB(B1, 0, 1); PG8_STAGE(PG8_SB(0, 0), b2, voffB);
            PG8_BAR; PG8_WAIT_L(0); PG8_MMA(0, 1, At, B1); PG8_BAR;
            PG8_LDA(At, 0, 1); PG8_STAGE(PG8_SA(0, 0), a2, voffA);
            PG8_BAR; PG8_WAIT_L(0); PG8_MMA(1, 0, At, B0); PG8_BAR; PG8_SCHED;
            PG8_STAGE(PG8_SB(0, 1), b2 + hstep, voffB);
            PG8_WAIT_V(6); PG8_BAR; PG8_MMA(1, 1, At, B1); PG8_BAR;
            PG8_LDB(B0, 1, 0); PG8_SCHED; PG8_LDA(At, 1, 0); PG8_STAGE(PG8_SA(0, 1), a2 + hstep, voffA);
            PG8_WAIT_L(8); PG8_BAR; PG8_WAIT_L(0); PG8_MMA(0, 0, At, B0); PG8_BAR; PG8_SCHED;
            PG8_LDB(B1, 1, 1); PG8_STAGE(PG8_SB(1, 0), b3, voffB);
            PG8_BAR; PG8_WAIT_L(0); PG8_MMA(0, 1, At, B1); PG8_BAR;
            PG8_LDA(At, 1, 1); PG8_STAGE(PG8_SA(1, 0), a3, voffA);
            PG8_BAR; PG8_WAIT_L(0); PG8_MMA(1, 0, At, B0); PG8_BAR; PG8_SCHED;
            PG8_STAGE(PG8_SB(1, 1), b3 + hstep, voffB);
            PG8_WAIT_V(6); PG8_BAR; PG8_MMA(1, 1, At, B1); PG8_BAR;
            }
        }
        if constexpr (ALIGN_EPI) { if (wr == 0) PG8_BAR; }
        if constexpr (!Epi::AFTER_DRAIN) { E(acc, cur, wr, wc, fr, fq); S.done(cur); }
        if (!has_next) break;
#pragma unroll
        for (int a = 0; a < 2; ++a)
#pragma unroll
            for (int b = 0; b < 2; ++b)
#pragma unroll
                for (int m = 0; m < 4; ++m)
#pragma unroll
                    for (int n = 0; n < 2; ++n) acc[a][b][m][n] = (f32x4){0.f, 0.f, 0.f, 0.f};
        cur = nxt; cA = nA; cB = nB; ++ui;
        if constexpr (ALIGN_EPI) { if (wr == 1) PG8_BAR; }
    }
    PG8_WAIT_V(0);
    if constexpr (!ALIGN_EPI) { if (wr == 0) PG8_BAR; }
    PG8_BAR;
    if constexpr (Epi::AFTER_DRAIN) { E.fused(acc, cur, wr, wc, fr, fq, lds, wid, lane); S.done(cur); }
#undef PG8_SA
#undef PG8_SB
#undef PG8_STAGE
#undef PG8_LDA
#undef PG8_LDB
#undef PG8_MMA
#undef PG8_WAIT_V
#undef PG8_WAIT_L
#undef PG8_BAR
#undef PG8_SCHED
}
}
namespace pg8 {
struct EpiResid {
    static constexpr bool PERM = false, AFTER_DRAIN = false;
    const float* base; float* out; int ldc;
    __device__ __forceinline__ void operator()(const f32x4 (&acc)[2][2][4][2], const Unit& u, int wr, int wc, int fr, int fq) const {
        const int col0 = u.pn * BM + wc * 32 + 4 * fq;
#pragma unroll
        for (int ai = 0; ai < 2; ++ai)
#pragma unroll
            for (int m = 0; m < 4; ++m) { const size_t off = (size_t)(u.pm * BM + ai * HALF + wr * 64 + m * 16 + fr) * ldc + col0;
#pragma unroll
                for (int bj = 0; bj < 2; ++bj)
#pragma unroll
                    for (int n = 0; n < 2; ++n) { const f32x4 b = *(const f32x4*)(base + off + bj * HALF + n * 16); *(f32x4*)(out + off + bj * HALF + n * 16) = b + acc[ai][bj][m][n]; } }
    }
};
struct RangeOrder {
    int nM, nN, nwg, G, c, first, last;
    __host__ __device__ void init(int M, int N, int G_, int c_, int first_, int count_) { nM = M / BM; nN = N / BM; nwg = nM * nN; G = G_; c = c_; first = first_; last = first_ + count_; }
    __host__ __device__ bool next(int i, Unit& u) const {
        const long L = (long)first + (long)i * G + c; if (c < 0 || L >= last || L >= nwg) return false;
        int wgid = (int)L; { const int q = nwg / NXCD, r = nwg % NXCD, xcd = wgid % NXCD, off = wgid / NXCD; wgid = (xcd < r ? xcd * (q + 1) : r * (q + 1) + (xcd - r) * q) + off; }
        const int nig = WGM * nN, gid = wgid / nig, fm = gid * WGM, gsz = (nM - fm) < WGM ? (nM - fm) : WGM;
        u.pm = fm + ((wgid % nig) % gsz); u.pn = (wgid % nig) / gsz; return true;
    }
    __device__ __forceinline__ void a_ready(const Unit&) const {}
    __device__ __forceinline__ void done(const Unit&) const {}
};
struct EpiRmsRes {
    static constexpr bool PERM = false, AFTER_DRAIN = true;
    const float* base; float* out; bf16_t* xn; const float* w; float* slots; unsigned* cnt; int ldc; int mode;
    __device__ __forceinline__ void fused(f32x4 (&acc)[2][2][4][2], const Unit& u, int wr, int wc, int fr, int fq, PG8_LAS unsigned char* lds, int wid, int lane) const {
        const int col0 = u.pn * BM + wc * 32 + 4 * fq;
        PG8_LAS float* P = (PG8_LAS float*)lds; PG8_LAS float* S = (PG8_LAS float*)(lds + 4096);
#pragma unroll
        for (int ai = 0; ai < 2; ++ai)
#pragma unroll
            for (int m = 0; m < 4; ++m) { const size_t off = (size_t)(u.pm * BM + ai * HALF + wr * 64 + m * 16 + fr) * ldc + col0; float s = 0.f;
#pragma unroll
                for (int bj = 0; bj < 2; ++bj)
#pragma unroll
                    for (int n = 0; n < 2; ++n) { const f32x4 v = acc[ai][bj][m][n] + *(const f32x4*)(base + off + bj * HALF + n * 16); acc[ai][bj][m][n] = v; s += (v[0] * v[0] + v[1] * v[1]) + (v[2] * v[2] + v[3] * v[3]); }
                s += __shfl_xor(s, 16); s += __shfl_xor(s, 32);
                if (fq == 0) P[(ai * HALF + wr * 64 + m * 16 + fr) * 4 + wc] = s;
                if (m & 1) asm volatile("" ::: "memory"); }
        asm volatile("s_waitcnt lgkmcnt(0)" ::: "memory"); __builtin_amdgcn_s_barrier(); asm volatile("" ::: "memory");
        const int row = wid * 32 + (lane & 31);
        if (lane < 32) { const float tot = (P[row * 4 + 0] + P[row * 4 + 1]) + (P[row * 4 + 2] + P[row * 4 + 3]);
            __hip_atomic_store(slots + ((size_t)(u.pm * BM + row) * 4 + u.pn), tot, __ATOMIC_RELAXED, __HIP_MEMORY_SCOPE_AGENT); }
        asm volatile("s_waitcnt vmcnt(0)" ::: "memory");
        if (lane == 0) __hip_atomic_fetch_add(cnt + 64 * u.pm, 1u, __ATOMIC_RELAXED, __HIP_MEMORY_SCOPE_AGENT);
        if (wid == 0) { while ((unsigned)__builtin_amdgcn_readfirstlane(__hip_atomic_load(cnt + 64 * u.pm, __ATOMIC_RELAXED, __HIP_MEMORY_SCOPE_AGENT)) < 32u) __builtin_amdgcn_s_sleep(2);
            __builtin_amdgcn_fence(__ATOMIC_ACQUIRE, "agent"); }
        asm volatile("s_waitcnt vmcnt(0) lgkmcnt(0)" ::: "memory"); __builtin_amdgcn_s_barrier(); asm volatile("" ::: "memory");
        if (lane < 32) { const float* sl = slots + (size_t)(u.pm * BM + row) * 4; float q = 0.f;
#pragma unroll
            for (int t = 0; t < 4; ++t) q += __hip_atomic_load(sl + t, __ATOMIC_RELAXED, __HIP_MEMORY_SCOPE_AGENT);
            S[row] = 1.0f / sqrtf(q * (1.f / 1024.f) + 1e-6f); }
        asm volatile("s_waitcnt lgkmcnt(0)" ::: "memory"); __builtin_amdgcn_s_barrier(); asm volatile("" ::: "memory");
        f32x4 wv[2][2];
#pragma unroll
        for (int bj = 0; bj < 2; ++bj)
#pragma unroll
            for (int n = 0; n < 2; ++n) wv[bj][n] = *(const f32x4*)(w + col0 + bj * HALF + n * 16);
#pragma unroll
        for (int ai = 0; ai < 2; ++ai)
#pragma unroll
            for (int m = 0; m < 4; ++m) { const int r = ai * HALF + wr * 64 + m * 16 + fr; const float rs = S[r]; const size_t off = (size_t)(u.pm * BM + r) * ldc + col0;
#pragma unroll
                for (int bj = 0; bj < 2; ++bj)
#pragma unroll
                    for (int n = 0; n < 2; ++n) { const f32x4 v = acc[ai][bj][m][n]; const f32x4 nv = v * rs * wv[bj][n];
                        if (mode == 0) { *(f32x4*)(out + off + bj * HALF + n * 16) = v; typedef unsigned u32x2v __attribute__((ext_vector_type(2))); u32x2v pk; pk.x = cvt_pk_bf16(nv[0], nv[1]); pk.y = cvt_pk_bf16(nv[2], nv[3]);
                            *(u32x2v*)(xn + off + bj * HALF + n * 16) = pk; }
                        else *(f32x4*)(out + off + bj * HALF + n * 16) = nv; } }
    }
};
}
constexpr int NWAVES = 8, NTHR = 512;
constexpr int BATCH = 2, T = 8192, D = 1024, M = BATCH * T, MH = T;
constexpr int NIN = 3728, NPAD = 3840;
constexpr int C_GQ = 0, C_GK = 256, C_GV = 512, C_GLR = 1024, C_GG = 1040, C_R = 1552, C_K = 2064, C_V = 2576, C_WL = 3088, C_AL = 3152, C_RG = 3216;
constexpr size_t MiB = 1u << 20;
constexpr size_t WS_WIN = 1 * MiB, WIN_BYTES = (size_t)NPAD * D * 2;
constexpr size_t WS_WOUT = 16 * MiB, WOUT_BYTES = (size_t)D * D * 2;
constexpr size_t WS_XN = 20 * MiB;
constexpr size_t WS_U = 52 * MiB, WS_U1 = 193 * MiB, U_STRIDE = WS_U1 - WS_U;
constexpr size_t WS_SLOTS = 192 * MiB;
constexpr size_t WS_END = 254 * MiB;
constexpr int LDS_BYTES = 163840;
constexpr int EARLY_TILES = 224;

typedef unsigned short bf16;
typedef unsigned v4u __attribute__((ext_vector_type(4)));
typedef float f32x4 __attribute__((ext_vector_type(4)));
#define LDS_WAIT() asm volatile("s_waitcnt lgkmcnt(0)" ::: "memory")
#define LBAR() do { asm volatile("s_waitcnt lgkmcnt(0)" ::: "memory"); __builtin_amdgcn_s_barrier(); asm volatile("" ::: "memory"); } while (0)
__device__ __forceinline__ float bf2f(unsigned h) { return __uint_as_float(h << 16); }
__device__ __forceinline__ unsigned f2bf(float f) { unsigned u = __float_as_uint(f); return (u + 0x7fffu + ((u >> 16) & 1u)) >> 16; }
typedef __bf16 bf16x2_t __attribute__((ext_vector_type(2)));
typedef float f32x2_t __attribute__((ext_vector_type(2)));
__device__ __forceinline__ unsigned pk2(float lo, float hi) { const f32x2_t v = {lo, hi}; const bf16x2_t b = __builtin_convertvector(v, bf16x2_t); return __builtin_bit_cast(unsigned, b); }
__device__ __forceinline__ float wave_sum(float v) {
#pragma unroll
    for (int o = 1; o < 64; o <<= 1) v += __shfl_xor(v, o);
    return v;
}
__device__ __forceinline__ float sigm(float x) { return __builtin_amdgcn_rcpf(1.f + __expf(-x)); }
__device__ __forceinline__ float tanh_fast(float x) { return 1.f - 2.f * __builtin_amdgcn_rcpf(1.f + __expf(2.f * x)); }
__device__ __forceinline__ float rl(float v, int l) { return __int_as_float(__builtin_amdgcn_readlane(__float_as_int(v), l)); }

typedef short bf16x8 __attribute__((ext_vector_type(8)));
typedef unsigned v2u __attribute__((ext_vector_type(2)));
__device__ __forceinline__ v2u pack4(f32x4 v) { v2u r; r.x = pk2(v.x, v.y); r.y = pk2(v.z, v.w); return r; }
__device__ __forceinline__ void unpack8(v4u w, float* o) { o[0] = bf2f(w.x & 0xffffu); o[1] = bf2f(w.x >> 16); o[2] = bf2f(w.y & 0xffffu); o[3] = bf2f(w.y >> 16);
    o[4] = bf2f(w.z & 0xffffu); o[5] = bf2f(w.z >> 16); o[6] = bf2f(w.w & 0xffffu); o[7] = bf2f(w.w >> 16); }
__device__ __forceinline__ v4u pack8(const float* v) { v4u r; r.x = pk2(v[0], v[1]); r.y = pk2(v[2], v[3]); r.z = pk2(v[4], v[5]); r.w = pk2(v[6], v[7]); return r; }
struct Args { const float* in[18]; float* out; unsigned char* ws; };
typedef const Args __attribute__((address_space(4))) CArgs;
__device__ __forceinline__ CArgs* opaque_args() { CArgs* p = (CArgs*)__builtin_amdgcn_kernarg_segment_ptr(); asm volatile("" : "+s"(p)); return p; }
#define AA (*opaque_args())

__device__ __forceinline__ void rms_row2(const float* x0, const float* x1, const float* w, bf16* o0, bf16* o1, int lane) {
    const f32x4* r0 = (const f32x4*)x0 + lane; const f32x4* r1 = (const f32x4*)x1 + lane; const f32x4* wr = (const f32x4*)w + lane;
    f32x4 a[4], b[4]; float sa = 0.f, sb = 0.f;
#pragma unroll
    for (int j = 0; j < 4; ++j) { a[j] = r0[64 * j]; b[j] = r1[64 * j]; }
#pragma unroll
    for (int j = 0; j < 4; ++j) { sa += (a[j].x * a[j].x + a[j].y * a[j].y) + (a[j].z * a[j].z + a[j].w * a[j].w); sb += (b[j].x * b[j].x + b[j].y * b[j].y) + (b[j].z * b[j].z + b[j].w * b[j].w); }
    const float ra = rsqrtf(wave_sum(sa) * (1.f / D) + 1e-6f), rb = rsqrtf(wave_sum(sb) * (1.f / D) + 1e-6f);
#pragma unroll
    for (int j = 0; j < 4; ++j) { const f32x4 ww = wr[64 * j]; const f32x4 oa = a[j] * ra * ww, ob = b[j] * rb * ww;
        ((v2u*)o0 + lane)[64 * j] = pack4(oa); ((v2u*)o1 + lane)[64 * j] = pack4(ob); }
}
__device__ __forceinline__ void transpose_item(const float* W, int K, int N, int Npad, bf16* WT, float* scr, int item, int lane) {
    const int nblk = Npad / 32, kb = item / nblk, nb = item % nblk, k0 = 64 * kb, n0 = 32 * nb;
    const int n = n0 + (lane & 31);
#pragma unroll 8
    for (int i = 0; i < 32; ++i) { const int kk = 2 * i + (lane >> 5); scr[kk * 33 + (lane & 31)] = (n < N) ? W[(size_t)(k0 + kk) * N + n] : 0.f; }
    LDS_WAIT();
    const int c = lane & 7;
#pragma unroll
    for (int j = 0; j < 4; ++j) { const int nn = (lane >> 3) + 8 * j; const float* s = scr + (8 * c) * 33 + nn;
        v4u o; o.x = pk2(s[0 * 33], s[1 * 33]); o.y = pk2(s[2 * 33], s[3 * 33]); o.z = pk2(s[4 * 33], s[5 * 33]); o.w = pk2(s[6 * 33], s[7 * 33]);
        *(v4u*)(WT + (size_t)(n0 + nn) * K + k0 + 8 * c) = o; }
    LDS_WAIT();
}
__device__ __forceinline__ void transpose_tiles(const float* W, int K, int N, int Npad, bf16* WT, float* scr  , int first, int stride, int ntiles, int tid) {
    const int nblk = Npad / 64, kr = tid >> 4, nq = tid & 15;
    f32x4 v0 = {0.f, 0.f, 0.f, 0.f}, v1 = v0;
    if (first < ntiles) { const int kb = first / nblk, nb = first % nblk, n = 64 * nb + 4 * nq; if (n < N) { v0 = *(const f32x4*)(W + (size_t)(64 * kb + kr) * N + n); v1 = *(const f32x4*)(W + (size_t)(64 * kb + 32 + kr) * N + n); } }
#pragma unroll 1
    for (int it = first; it < ntiles; it += stride) {
        const int kb = it / nblk, nb = it % nblk;
        scr[kr * 65 + 4 * nq] = v0.x; scr[kr * 65 + 4 * nq + 1] = v0.y; scr[kr * 65 + 4 * nq + 2] = v0.z; scr[kr * 65 + 4 * nq + 3] = v0.w;
        scr[(32 + kr) * 65 + 4 * nq] = v1.x; scr[(32 + kr) * 65 + 4 * nq + 1] = v1.y; scr[(32 + kr) * 65 + 4 * nq + 2] = v1.z; scr[(32 + kr) * 65 + 4 * nq + 3] = v1.w;
        const int nx = it + stride; v0 = (f32x4){0.f, 0.f, 0.f, 0.f}; v1 = v0;
        if (nx < ntiles) { const int kb2 = nx / nblk, nb2 = nx % nblk, n = 64 * nb2 + 4 * nq; if (n < N) { v0 = *(const f32x4*)(W + (size_t)(64 * kb2 + kr) * N + n); v1 = *(const f32x4*)(W + (size_t)(64 * kb2 + 32 + kr) * N + n); } }
        LBAR();
        { const int n = tid >> 3, kc = tid & 7; const float* sp = scr + (8 * kc) * 65 + n; float o[8];
#pragma unroll
          for (int j = 0; j < 8; ++j) o[j] = sp[j * 65];
          *(v4u*)(WT + (size_t)(64 * nb + n) * K + 64 * kb + 8 * kc) = pack8(o); }
        LBAR();
    }
}
__device__ __forceinline__ void rms_row(const float* xrow, const float* w, bf16* obf, float* of32, int lane) {
    const f32x4* xr = (const f32x4*)xrow + lane; const f32x4* wr = (const f32x4*)w + lane;
    f32x4 v[4]; float s = 0.f;
#pragma unroll
    for (int j = 0; j < 4; ++j) { v[j] = xr[64 * j]; s += (v[j].x * v[j].x + v[j].y * v[j].y) + (v[j].z * v[j].z + v[j].w * v[j].w); }
    const float rs = rsqrtf(wave_sum(s) * (1.f / D) + 1e-6f);
#pragma unroll
    for (int j = 0; j < 4; ++j) { const f32x4 ww = wr[64 * j]; f32x4 o = v[j] * rs * ww;
        if (of32) ((f32x4*)of32 + lane)[64 * j] = o;
        else ((unsigned long long*)obf + lane)[64 * j] = (unsigned long long)pk2(o.x, o.y) | ((unsigned long long)pk2(o.z, o.w) << 32); }
}

constexpr int PITCH = 72, FP = 68, TP = 20;
constexpr int OFF_TW = 0, OFF_AL = 9216, OFF_ARK = 18432, OFF_XA = 27648, OFF_XW = 45056, OFF_AT = 63488, OFF_RT = 72704, OFF_BH = 81920, OFF_KH = 91136,
              OFF_BBT = 100352, OFF_KBT = 109568, OFF_VT = 118784, OFF_TII = 128000, OFF_TOT = 133120, OFF_BC = 135168;
constexpr int OFF_AAK = OFF_TW, OFF_ARB = OFF_AL, OFF_AAB = OFF_XA, OFF_XT = OFF_XW;
constexpr size_t WS_MC = 112 * MiB, WS_NC = 120 * MiB, WS_PP = 136 * MiB, WS_Y0 = 144 * MiB, WS_S0 = 152 * MiB, WS_DEC = 160 * MiB, WS_BON2 = 161 * MiB, WS_UPT = 162 * MiB;
constexpr int NUNIT = 1024;

__device__ __forceinline__ f32x4 mma2s(const bf16* Ab, int ak, const bf16* Bb, int bk, int g, f32x4 acc) {
    acc = __builtin_amdgcn_mfma_f32_16x16x32_bf16(*(const bf16x8*)(Ab + ((g ^ ak) << 3)), *(const bf16x8*)(Bb + ((g ^ bk) << 3)), acc, 0, 0, 0);
    acc = __builtin_amdgcn_mfma_f32_16x16x32_bf16(*(const bf16x8*)(Ab + (((g + 4) ^ ak) << 3)), *(const bf16x8*)(Bb + (((g + 4) ^ bk) << 3)), acc, 0, 0, 0);
    return acc;
}
#define SWK(row) (((row) >> 3) & 7)
#define SWC(row, t) ((row) * PITCH + ((((t) >> 3) ^ SWK(row)) << 3) + ((t) & 7))
__device__ __forceinline__ f32x4 mma2(const bf16* Arow, const bf16* Brow, f32x4 acc) {
    acc = __builtin_amdgcn_mfma_f32_16x16x32_bf16(*(const bf16x8*)(Arow), *(const bf16x8*)(Brow), acc, 0, 0, 0);
    acc = __builtin_amdgcn_mfma_f32_16x16x32_bf16(*(const bf16x8*)(Arow + 32), *(const bf16x8*)(Brow + 32), acc, 0, 0, 0);
    return acc;
}

__device__ __forceinline__ void r1_phase(CArgs& a, size_t uo, int l, unsigned char* L, int tid0) {
    asm volatile("" : "+v"(tid0));
    const int wave = __builtin_amdgcn_readfirstlane(tid0 >> 6);
    const bf16* U = (const bf16*)(a.ws + WS_U + uo);
    bf16* TW = (bf16*)(L + 138240 + 2560); bf16* ALm = (bf16*)(L + 138240 + 2560 + 9216);
    bf16* ARK = (bf16*)(L + OFF_ARK); bf16* AAK = (bf16*)(L + OFF_AAK); bf16* ARB = (bf16*)(L + OFF_ARB);
    float* XA = (float*)(L + OFF_XA); float* XW = (float*)(L + OFF_XW); float* AAB = (float*)(L + OFF_AAB); bf16* XT = (bf16*)(L + OFF_XT);
    bf16* AT = (bf16*)(L + OFF_AT); bf16* RT = (bf16*)(L + OFF_RT); bf16* BH = (bf16*)(L + OFF_BH); bf16* KH = (bf16*)(L + OFF_KH);
    bf16* BBT = (bf16*)(L + OFF_BBT); bf16* KBT = (bf16*)(L + OFF_KBT); bf16* VT = (bf16*)(L + OFF_VT);
    float* TII = (float*)(L + OFF_TII); float* TOT = (float*)(L + OFF_TOT); float* BC = (float*)(L + OFF_BC);
    const bf16* UPT = (const bf16*)(a.ws + WS_UPT) + (size_t)l * 2 * 512 * 64;
    const float* mu = a.in[6] + l * 1664;
    float* WTS = (float*)(L + 135680);
    const int ch = (int)blockIdx.x >> 1, hbase = 4 * ((int)blockIdx.x & 1);
    v4u Lrc, Lkc, Lvc, Lrp, Lkp, Lvp; bf16x8 wfa0, wfa1; float pw[8];
#define R1_ISSUE(h_) do { const int lr_ = 64 * ch + (tid >> 3); const bf16* uq_ = U + (size_t)lr_ * NPAD + 64 * (h_) + 8 * (tid & 7); \
        Lrc = *(const v4u*)(uq_ + C_R); Lkc = *(const v4u*)(uq_ + C_K); Lvc = *(const v4u*)(uq_ + C_V); Lrp = (v4u){0u, 0u, 0u, 0u}; Lkp = Lrp; Lvp = Lrp; \
        if (lr_ > 0) { Lrp = *(const v4u*)(uq_ + C_R - NPAD); Lkp = *(const v4u*)(uq_ + C_K - NPAD); Lvp = *(const v4u*)(uq_ + C_V - NPAD); } \
        if (tid < 64) { const int c_ = l * 512 + 64 * (h_) + tid; pw[0] = a.in[7][c_]; pw[1] = a.in[9][c_]; pw[2] = a.in[11][c_]; pw[3] = a.in[12][c_]; pw[4] = a.in[13][c_]; \
            pw[5] = mu[64 * (h_) + tid]; pw[6] = mu[512 + 64 * (h_) + tid]; pw[7] = mu[1024 + 64 * (h_) + tid]; } \
        { const bf16* WT_ = UPT + (size_t)(wave >> 2) * 512 * 64 + (size_t)(64 * (h_) + 16 * (wave & 3) + (tid & 15)) * 64 + 8 * ((tid & 63) >> 4); wfa0 = *(const bf16x8*)WT_; wfa1 = *(const bf16x8*)(WT_ + 32); } } while (0)
    {
        int tid = tid0; asm volatile("" : "+v"(tid));
        R1_ISSUE(hbase);
        const int t = tid >> 3, cg = tid & 7, lr = 64 * ch + t; const bf16* up = U + (size_t)lr * NPAD + C_WL + 16 * cg;
        const v4u c0 = *(const v4u*)up, c1 = *(const v4u*)(up + 8); v4u p0 = {0u, 0u, 0u, 0u}, p1 = p0;
        if (lr > 0) { p0 = *(const v4u*)(up - NPAD); p1 = *(const v4u*)(up - NPAD + 8); }
        float cu[16], pr[16], o[16]; unpack8(c0, cu); unpack8(c1, cu + 8); unpack8(p0, pr); unpack8(p1, pr + 8);
        const float* mp = mu + 1536 + 16 * cg;
#pragma unroll
        for (int i = 0; i < 16; ++i) { float mv = cu[i] + (pr[i] - cu[i]) * mp[i]; if (cg < 4) mv = tanh_fast(mv); o[i] = mv; }
        bf16* dst = (cg < 4 ? TW : ALm) + t * PITCH + 16 * (cg & 3);
        *(v4u*)dst = pack8(o); *(v4u*)(dst + 8) = pack8(o + 8);
    }
#pragma unroll 1
    for (int hi = 0; hi < 4; ++hi) {
        int tid = tid0; asm volatile("" : "+v"(tid));
        const int lane = tid & 63, g = lane >> 4, c16 = lane & 15;
        const int h = hbase + hi, unit = ch * 8 + h;
        const int t = tid >> 3, dg = tid & 7, d0 = 8 * dg, lr = 64 * ch + t, hc = 64 * h + d0;
        if (tid < 64) {
#pragma unroll
            for (int q = 0; q < 8; ++q) WTS[64 * q + tid] = pw[q]; }
        LBAR();
        {
            const int q = wave >> 2, dt = wave & 3;
            const bf16x8 a0 = wfa0, a1 = wfa1;
            const bf16* Bm = q ? ALm : TW; float* X = q ? XA : XW;
#pragma unroll
            for (int tt = 0; tt < 4; ++tt) { const bf16* br = Bm + (16 * tt + c16) * PITCH + 8 * g; f32x4 acc = {0.f, 0.f, 0.f, 0.f};
                acc = __builtin_amdgcn_mfma_f32_16x16x32_bf16(a0, *(const bf16x8*)br, acc, 0, 0, 0);
                acc = __builtin_amdgcn_mfma_f32_16x16x32_bf16(a1, *(const bf16x8*)(br + 32), acc, 0, 0, 0);
                *(f32x4*)(X + (16 * tt + c16) * FP + 16 * dt + 4 * g) = acc; }
        }
        LBAR();
        float r[8], kq[8], v[8], al[8], be[8], lw[8];
        {
            float rc[8], rp[8], kc[8], kp[8], vc[8], vp[8];
            unpack8(Lrc, rc); unpack8(Lkc, kc); unpack8(Lvc, vc); unpack8(Lrp, rp); unpack8(Lkp, kp); unpack8(Lvp, vp);
            const float* w0p = WTS + d0; const float* a0p = WTS + 64 + d0; const float* kkp = WTS + 128 + d0;
            const float* kap = WTS + 192 + d0; const float* rkp = WTS + 256 + d0;
            float nn = 0.f, bon = 0.f, kk[8], av[8];
#pragma unroll
            for (int i = 0; i < 8; ++i) {
                const float xw = XW[t * FP + d0 + i] + w0p[i], xa = XA[t * FP + d0 + i] + a0p[i];
                lw[i] = -0.60653065971f * sigm(xw); av[i] = sigm(xa);
                r[i] = rc[i] + (rp[i] - rc[i]) * WTS[320 + d0 + i]; const float k = kc[i] + (kp[i] - kc[i]) * WTS[384 + d0 + i]; v[i] = vc[i] + (vp[i] - vc[i]) * WTS[448 + d0 + i];
                kk[i] = k * kkp[i]; nn += kk[i] * kk[i];
                kq[i] = k * (1.f + (av[i] - 1.f) * kap[i]); bon += r[i] * kq[i] * rkp[i];
            }
            nn += __shfl_xor(nn, 1); nn += __shfl_xor(nn, 2); nn += __shfl_xor(nn, 4);
            bon += __shfl_xor(bon, 1); bon += __shfl_xor(bon, 2); bon += __shfl_xor(bon, 4);
            const float inv = __builtin_amdgcn_rsqf(fmaxf(nn, 1e-24f));
#pragma unroll
            for (int i = 0; i < 8; ++i) { const float kn = kk[i] * inv; al[i] = -kn; be[i] = av[i] * kn; XW[t * FP + d0 + i] = lw[i]; }
            if (dg == 0) ((float*)(a.ws + WS_BON2))[lr * 8 + h] = bon;
        }
        LBAR();
        {
            const int d = tid & 63, tb = tid >> 6; float p[8]; float run = 0.f;
#pragma unroll
            for (int i = 0; i < 8; ++i) { run += XW[(8 * tb + i) * FP + d]; p[i] = run; }
            TOT[tb * 64 + d] = run;
            LBAR();
            float off = 0.f;
#pragma unroll
            for (int j = 0; j < 8; ++j) off += (j < tb) ? TOT[j * 64 + d] : 0.f;
#pragma unroll
            for (int i = 0; i < 8; ++i) XW[(8 * tb + i) * FP + d] = off + p[i];
            if (tb == 7) { BC[d] = off + run; BC[64 + d] = __expf(off + run); }
        }
        LBAR();
        {
            float at[8], rt[8], bh[8], kh[8];
#pragma unroll
            for (int i = 0; i < 8; ++i) { const float b = XW[t * FP + d0 + i];
                const float eb = __expf(b), enb = __builtin_amdgcn_rcpf(eb), ebp = __expf(b - lw[i]), ebc = BC[64 + d0 + i] * enb;
                at[i] = al[i] * ebp; rt[i] = r[i] * eb; bh[i] = be[i] * enb; kh[i] = kq[i] * enb;
                BBT[SWC(d0 + i, t)] = (bf16)f2bf(be[i] * ebc); KBT[SWC(d0 + i, t)] = (bf16)f2bf(kq[i] * ebc); VT[SWC(d0 + i, t)] = (bf16)f2bf(v[i]); }
            *(v4u*)(AT + t * PITCH + d0) = pack8(at); *(v4u*)(RT + t * PITCH + d0) = pack8(rt); *(v4u*)(BH + t * PITCH + d0) = pack8(bh); *(v4u*)(KH + t * PITCH + d0) = pack8(kh);
        }
        asm volatile("" ::: "memory");
        if (hi + 1 < 4) R1_ISSUE(h + 1);
        LBAR();
        {
            const int q = wave >> 1, mh = wave & 1;
            const bf16* As = (q < 2) ? AT : RT; const bf16* Bs = (q & 1) ? KH : BH;
#pragma unroll
            for (int t2 = 0; t2 < 2; ++t2) { const int tt = t2 == 0 ? mh : 3 - mh; const int tcol = 16 * tt + c16;
#pragma unroll
                for (int jt = 0; jt < 4; ++jt) {
                    f32x4 acc = {0.f, 0.f, 0.f, 0.f};
                    if (jt <= tt) { acc = mma2(Bs + (16 * jt + c16) * PITCH + 8 * g, As + tcol * PITCH + 8 * g, acc);
#pragma unroll
                        for (int j = 0; j < 4; ++j) { const int jj = 16 * jt + 4 * g + j; const bool keep = (q < 2) ? (jj < tcol) : (jj <= tcol); if (!keep) acc[j] = 0.f; } }
                    if (q == 0) *(f32x4*)(AAB + tcol * FP + 16 * jt + 4 * g) = acc;
                    else { bf16* dst = (q == 1 ? AAK : (q == 2 ? ARB : ARK)); *(v2u*)(dst + tcol * PITCH + 16 * jt + 4 * g) = pack4(acc); }
                } }
        }
        LBAR();
        f32x4 Z[4];
        {
            if (wave < 4) {
                typedef short s16x4 __attribute__((ext_vector_type(4)));
                const int i = wave; const f32x4 at4 = *(const f32x4*)(AAB + (16 * i + c16) * FP + 16 * i + 4 * g); f32x4 a4, Sp;
#pragma unroll
                for (int j = 0; j < 4; ++j) { a4[j] = AAB[(16 * i + 4 * g + j) * FP + 16 * i + c16]; Sp[j] = at4[j] + ((4 * g + j) == c16 ? 1.f : 0.f); }
                v2u pk_ = pack4(a4), pkt_ = pack4(at4); s16x4 P = __builtin_bit_cast(s16x4, pk_), PT = __builtin_bit_cast(s16x4, pkt_);
                const f32x4 zero4 = {0.f, 0.f, 0.f, 0.f};
#pragma unroll
                for (int st = 0; st < 3; ++st) { const f32x4 p2 = __builtin_amdgcn_mfma_f32_16x16x16bf16_1k(PT, P, zero4, 0, 0, 0), pt2 = __builtin_amdgcn_mfma_f32_16x16x16bf16_1k(P, PT, zero4, 0, 0, 0);
                    pk_ = pack4(p2); pkt_ = pack4(pt2); P = __builtin_bit_cast(s16x4, pk_); PT = __builtin_bit_cast(s16x4, pkt_);
                    const v2u sp_ = pack4(Sp); Sp = __builtin_amdgcn_mfma_f32_16x16x16bf16_1k(P, __builtin_bit_cast(s16x4, sp_), Sp, 0, 0, 0); }
                *(v2u*)((unsigned char*)TII + (i * 64 + lane) * 8) = pack4(Sp); }
            if (wave < 4) {
#pragma unroll
                for (int i = 0; i < 4; ++i)
#pragma unroll
                    for (int j = 0; j < 4; ++j) Z[i][j] = bf2f(AT[(16 * i + 4 * g + j) * PITCH + 16 * wave + c16]);
            } else {
#pragma unroll
                for (int i = 0; i < 4; ++i) { f32x4 acc = {0.f, 0.f, 0.f, 0.f}; const int er = 16 * (wave - 4) + c16; Z[i] = mma2s(AAK + (16 * i + c16) * PITCH, 0, VT + er * PITCH, SWK(er), g, acc); }
            }
        }
        LBAR();
        {
            typedef short s16x4 __attribute__((ext_vector_type(4)));
            f32x4 X[4]; s16x4 Xb[4];
#pragma unroll
            for (int i = 0; i < 4; ++i) { f32x4 z = Z[i];
#pragma unroll
                for (int kb = 0; kb < 4; ++kb) if (kb < i) { const f32x4 av = *(const f32x4*)(AAB + (16 * i + c16) * FP + 16 * kb + 4 * g);
                    const v2u ap = pack4(av); z = __builtin_amdgcn_mfma_f32_16x16x16bf16_1k(__builtin_bit_cast(s16x4, ap), Xb[kb], z, 0, 0, 0); }
                const v2u tp = *(const v2u*)((const unsigned char*)TII + (i * 64 + lane) * 8), zp = pack4(z);
                const f32x4 zero4 = {0.f, 0.f, 0.f, 0.f};
                X[i] = __builtin_amdgcn_mfma_f32_16x16x16bf16_1k(__builtin_bit_cast(s16x4, tp), __builtin_bit_cast(s16x4, zp), zero4, 0, 0, 0);
                const v2u xp = pack4(X[i]); Xb[i] = __builtin_bit_cast(s16x4, xp); }
#pragma unroll
            for (int i = 0; i < 4; ++i) *(v2u*)(XT + (16 * wave + c16) * PITCH + 16 * i + 4 * g) = __builtin_bit_cast(v2u, Xb[i]);
        }
        LBAR();
        {
            const int ps = wave & 1, ti = wave >> 1;
            bf16* MCg = (bf16*)(a.ws + WS_MC) + (size_t)unit * 4096; float* NCg = (float*)(a.ws + WS_NC) + (size_t)unit * 4096;
            bf16* PPg = (bf16*)(a.ws + WS_PP) + (size_t)unit * 4096; bf16* Y0g = (bf16*)(a.ws + WS_Y0) + (size_t)unit * 4096;
#pragma unroll
            for (int tj = 0; tj < 4; ++tj) { const int cc = 16 * tj + c16, rr = 16 * ti + 4 * g, ar = 16 * ti + c16; f32x4 acc = {0.f, 0.f, 0.f, 0.f}, acc2 = {0.f, 0.f, 0.f, 0.f};
                if (ps == 0) {
                    acc = mma2s(XT + ar * PITCH, 0, BBT + cc * PITCH, SWK(cc), g, acc); *(v2u*)(MCg + cc * 64 + (ti >> 1) * 32 + g * 8 + (ti & 1) * 4) = pack4(acc);
                    acc2 = mma2s(BBT + ar * PITCH, SWK(ar), XT + (64 + cc) * PITCH, 0, g, acc2); acc2 = mma2s(KBT + ar * PITCH, SWK(ar), VT + cc * PITCH, SWK(cc), g, acc2);
                    *(f32x4*)(NCg + cc * 64 + rr) = acc2;
                } else {
                    acc = mma2(XT + ar * PITCH + 8 * g, ARB + cc * PITCH + 8 * g, acc);
                    const v2u rv = *(const v2u*)(RT + cc * PITCH + rr); acc[0] += bf2f(rv.x & 0xffffu); acc[1] += bf2f(rv.x >> 16); acc[2] += bf2f(rv.y & 0xffffu); acc[3] += bf2f(rv.y >> 16);
                    *(v2u*)(PPg + cc * 64 + rr) = pack4(acc);
                    acc2 = mma2(XT + (64 + ar) * PITCH + 8 * g, ARB + cc * PITCH + 8 * g, acc2); acc2 = mma2s(VT + ar * PITCH, SWK(ar), ARK + cc * PITCH, 0, g, acc2);
                    *(v2u*)(Y0g + cc * 64 + rr) = pack4(acc2);
                } }
            if (tid < 64) ((float*)(a.ws + WS_DEC))[unit * 64 + tid] = BC[64 + tid];
        }
        LBAR();
    }
}

#define LAS3 __attribute__((address_space(3)))
constexpr int R2_SLOT = 12544, R2_NS = 10, R2_FLAGS = R2_SLOT * R2_NS;
__device__ __forceinline__ void r2_scan(CArgs& a, int chain, unsigned char* L, int tid) {
    asm volatile("" : "+v"(tid));
    const int lane = tid & 63, wave = __builtin_amdgcn_readfirstlane(tid >> 6);
    const int h = chain >> 2, e0 = 16 * (chain & 3), g = lane >> 4, c16 = lane & 15;
    volatile LAS3 unsigned* flg = (volatile LAS3 unsigned*)(LAS3 unsigned char*)(L + R2_FLAGS);
    if (tid < 32) flg[tid] = 0u;
    if (tid >= 64 && tid < 64 + R2_NS) *(volatile LAS3 unsigned*)(LAS3 unsigned char*)(L + (tid - 64) * R2_SLOT + 12288 + 252) = 0xffffffffu;
    __syncthreads();
    const bf16* MC = (const bf16*)(a.ws + WS_MC); const float* NC = (const float*)(a.ws + WS_NC); const float* DEC = (const float*)(a.ws + WS_DEC);
    if (wave != 0) {
        int mco[8], nco[4];
#pragma unroll
        for (int q = 0; q < 8; ++q) { const int pos = 64 * q + lane, row = pos >> 3, kc = (pos & 7) ^ (row & 7); mco[q] = row * 64 + kc * 8; }
#pragma unroll
        for (int q = 0; q < 4; ++q) { const int pos = 64 * q + lane, e = pos >> 4, dc = (pos & 15) ^ e; nco[q] = (e0 + e) * 64 + dc * 4; }
#pragma unroll 1
        for (int c = wave - 1; c < 128; c += 7) {
            while ((int)flg[16] < c - (R2_NS - 1)) __builtin_amdgcn_s_sleep(12);
            LAS3 unsigned char* slot = (LAS3 unsigned char*)(L + (c % R2_NS) * R2_SLOT);
            const size_t unit = (size_t)c * 8 + h;
#pragma unroll
            for (int q = 0; q < 8; ++q) __builtin_amdgcn_global_load_lds((const unsigned*)(MC + unit * 4096 + mco[q]), (LAS3 unsigned*)(slot + q * 1024), 16, 0, 0);
#pragma unroll
            for (int q = 0; q < 4; ++q) __builtin_amdgcn_global_load_lds((const unsigned*)(NC + unit * 4096 + nco[q]), (LAS3 unsigned*)(slot + 8192 + q * 1024), 16, 0, 0);
            __builtin_amdgcn_global_load_lds((const unsigned*)(DEC + unit * 64 + lane), (LAS3 unsigned*)(slot + 12288), 4, 0, 0);
        }
        asm volatile("s_waitcnt vmcnt(0)" ::: "memory");
    } else {
        bf16* S0 = (bf16*)(a.ws + WS_S0) + (size_t)h * 4096 + (e0 + c16) * 64 + 4 * g;
        f32x4 S[4];
#pragma unroll
        for (int m = 0; m < 4; ++m) S[m] = (f32x4){0.f, 0.f, 0.f, 0.f};
        int avail = 0;
        const LAS3 unsigned char* Lb = (const LAS3 unsigned char*)L;
        const int offA0 = (c16 * 8 + (g ^ (c16 & 7))) * 16, offA1 = (c16 * 8 + ((4 + g) ^ (c16 & 7))) * 16;
        int offN[4];
#pragma unroll
        for (int mt = 0; mt < 4; ++mt) offN[mt] = 8192 + (c16 * 16 + ((4 * mt + g) ^ c16)) * 16;
        const int offD = 12288 + 16 * g;
#define R2_MARKS(s_) (*(volatile LAS3 unsigned*)(LAS3 unsigned char*)(L + (s_) * R2_SLOT + 12288 + 252))
#define R2_WAITS(c_, s_) do { while (avail <= (c_)) { const unsigned f0_ = R2_MARKS(s_), f1_ = R2_MARKS(((s_) + 1) % R2_NS), f2_ = R2_MARKS(((s_) + 2) % R2_NS); \
            if (f0_ != 0xffffffffu) { avail = (c_) + 1; if (f1_ != 0xffffffffu) { avail = (c_) + 2; if (f2_ != 0xffffffffu) avail = (c_) + 3; } } \
            else __builtin_amdgcn_s_sleep(0); } asm volatile("" ::: "memory"); } while (0)
        v4u A[2][4][2]; f32x4 Nn[2][4], Dd[2][4];
#define R2_READS(s_, p_) do { _Pragma("unroll") for (int mt = 0; mt < 4; ++mt) { \
                A[p_][mt][0] = *(const LAS3 v4u*)(Lb + (s_) * R2_SLOT + mt * 2048 + offA0); A[p_][mt][1] = *(const LAS3 v4u*)(Lb + (s_) * R2_SLOT + mt * 2048 + offA1); \
                Nn[p_][mt] = *(const LAS3 f32x4*)(Lb + (s_) * R2_SLOT + offN[mt]); Dd[p_][mt] = *(const LAS3 f32x4*)(Lb + (s_) * R2_SLOT + mt * 64 + offD); } } while (0)
        R2_WAITS(0, 0); R2_READS(0, 0);
        asm volatile("s_waitcnt lgkmcnt(0)" ::: "memory");
#pragma unroll 1
        for (int c0 = 0; c0 < 128; c0 += R2_NS) {
#pragma unroll
            for (int k = 0; k < R2_NS; ++k) { const int c = c0 + k;
                if (c < 128) {
                    R2_MARKS(k) = 0xffffffffu; flg[16] = (unsigned)(c + 1);
                    if (c + 1 < 128) { R2_WAITS(c + 1, (k + 1) % R2_NS); R2_READS((k + 1) % R2_NS, (k + 1) & 1); }
                    bf16* sp = S0 + (size_t)c * (8 * 4096); v2u sb[4];
#pragma unroll
                    for (int m = 0; m < 4; ++m) { sb[m] = pack4(S[m]); *(v2u*)(sp + 16 * m) = sb[m]; }
                    const v4u b0 = {sb[0].x, sb[0].y, sb[1].x, sb[1].y}, b1 = {sb[2].x, sb[2].y, sb[3].x, sb[3].y};
                    const bf16x8 B0 = __builtin_bit_cast(bf16x8, b0), B1 = __builtin_bit_cast(bf16x8, b1);
                    f32x4 acc[4];
#pragma unroll
                    for (int mt = 0; mt < 4; ++mt) acc[mt] = __builtin_amdgcn_mfma_f32_16x16x32_bf16(__builtin_bit_cast(bf16x8, A[k & 1][mt][0]), B0, Nn[k & 1][mt] + S[mt] * Dd[k & 1][mt], 0, 0, 0);
#pragma unroll
                    for (int mt = 0; mt < 4; ++mt) S[mt] = __builtin_amdgcn_mfma_f32_16x16x32_bf16(__builtin_bit_cast(bf16x8, A[k & 1][mt][1]), B1, acc[mt], 0, 0, 0);
                    asm volatile("s_waitcnt lgkmcnt(0)" ::: "memory");
                } }
        }
#undef R2_WAITS
#undef R2_MARKS
#undef R2_READS
#define R2_READ 0
#undef R2_READ
    }
    __syncthreads();
}

__device__ __forceinline__ void r3_phase(CArgs& a, size_t uo, int l, int hb, int gw, int NGW, int lane) {
    asm volatile("" : "+v"(lane));
    const int g = lane >> 4, c16 = lane & 15;
    const bf16* U = (const bf16*)(a.ws + WS_U + uo); const bf16* PP = (const bf16*)(a.ws + WS_PP); const bf16* S0 = (const bf16*)(a.ws + WS_S0); const bf16* Y0 = (const bf16*)(a.ws + WS_Y0);
    const float* BON = (const float*)(a.ws + WS_BON2); bf16* MG = (bf16*)(a.ws + WS_XN) + (size_t)hb * MH * D;
    const float* mu_v = a.in[6] + l * 1664 + 1024; const float* lnw = a.in[14] + l * 512; const float* lnb = a.in[15] + l * 512;
    const int erow = 16 * (c16 >> 2) + (c16 & 3);
    bf16x8 SA[4][2];
    { const int unit0 = 4 * (gw >> 3) + ((gw & 7) >> 1);
#pragma unroll
      for (int et = 0; et < 4; ++et) { const bf16* sr = S0 + (size_t)unit0 * 4096 + (erow + 4 * et) * 64 + 8 * g; SA[et][0] = *(const bf16x8*)sr; SA[et][1] = *(const bf16x8*)(sr + 32); } }
#pragma unroll 1
    for (int kk = 0; kk < 2; ++kk) {
        const int unit = 4 * (gw >> 3) + ((gw & 7) >> 1), mt = 2 * (gw & 1) + kk, ch = unit >> 3, h = unit & 7; const size_t ub = (size_t)unit * 4096;
        if (unit >= NUNIT) break;
        const int lr = 64 * ch + 16 * mt + c16; const bf16* urow = U + (size_t)lr * NPAD + 64 * h + 16 * g;
        float vc[16], vp[16], rgf[16];
        unpack8(*(const v4u*)(urow + C_V), vc); unpack8(*(const v4u*)(urow + C_V + 8), vc + 8); unpack8(*(const v4u*)(urow + C_RG), rgf); unpack8(*(const v4u*)(urow + C_RG + 8), rgf + 8);
        if (lr > 0) { unpack8(*(const v4u*)(urow + C_V - NPAD), vp); unpack8(*(const v4u*)(urow + C_V + 8 - NPAD), vp + 8); }
        else {
#pragma unroll
            for (int i = 0; i < 16; ++i) vp[i] = 0.f; }
        const float bon = BON[lr * 8 + h];
        const bf16* pr = PP + ub + (16 * mt + c16) * 64 + 8 * g;
        const bf16x8 B0 = *(const bf16x8*)pr, B1 = *(const bf16x8*)(pr + 32);
        f32x4 Y[4];
        const bf16* y0p = Y0 + ub + (16 * mt + c16) * 64 + 16 * g; const v4u y0a = *(const v4u*)y0p, y0b = *(const v4u*)(y0p + 8);
        asm volatile("" ::: "memory");
        { float yf[16]; unpack8(y0a, yf); unpack8(y0b, yf + 8);
#pragma unroll
          for (int et = 0; et < 4; ++et) Y[et] = (f32x4){yf[4 * et], yf[4 * et + 1], yf[4 * et + 2], yf[4 * et + 3]}; }
#pragma unroll
        for (int et = 0; et < 4; ++et) { f32x4 acc = __builtin_amdgcn_mfma_f32_16x16x32_bf16(SA[et][0], B0, Y[et], 0, 0, 0);
            Y[et] = __builtin_amdgcn_mfma_f32_16x16x32_bf16(SA[et][1], B1, acc, 0, 0, 0); }
        const f32x4 sv = (Y[0] + Y[1]) + (Y[2] + Y[3]); float sm = (sv.x + sv.y) + (sv.z + sv.w); sm += __shfl_xor(sm, 16); sm += __shfl_xor(sm, 32);
        const float mean = sm * (1.f / 64.f); float q = 0.f;
#pragma unroll
        for (int et = 0; et < 4; ++et) { const f32x4 dd = Y[et] - mean; q += (dd.x * dd.x + dd.y * dd.y) + (dd.z * dd.z + dd.w * dd.w); }
        q += __shfl_xor(q, 16); q += __shfl_xor(q, 32);
        const float rstd = rsqrtf(q * (1.f / 64.f) + 64e-5f);
        const int cc = 64 * h + 16 * g; float o[16];
#pragma unroll
        for (int et = 0; et < 4; ++et) {
            const f32x4 w4 = *(const f32x4*)(lnw + cc + 4 * et), b4 = *(const f32x4*)(lnb + cc + 4 * et), m4 = *(const f32x4*)(mu_v + cc + 4 * et);
#pragma unroll
            for (int j = 0; j < 4; ++j) { const int i = 4 * et + j; const float vv = vc[i] + (vp[i] - vc[i]) * m4[j]; const float yn = (Y[et][j] - mean) * rstd * w4[j] + b4[j];
                o[i] = (yn + bon * vv) * rgf[i] * sigm(rgf[i]); } }
        bf16* op = MG + (size_t)lr * D + 512 + cc; *(v4u*)op = pack8(o); *(v4u*)(op + 8) = pack8(o + 8);
    }
}

constexpr int OFF_GQI = 17408, OFF_GKI = 26624, OFF_GKST = 35840, OFF_GVT = 45056, OFF_GSC = 63488, OFF_GTOT = 72704, OFF_GBC = 74752;
constexpr size_t WS_QI = 163 * MiB, WS_OI = 167 * MiB, WS_DS = 175 * MiB, WS_GDEC = 183 * MiB, WS_SP = 184 * MiB;
constexpr int NGUNIT = 512;

__device__ __forceinline__ void g1_phase(CArgs& a, size_t uo, int l, unsigned char* L, int tid0, int ufirst, int ustride) {
    asm volatile("" : "+v"(tid0));
    const int wave = __builtin_amdgcn_readfirstlane(tid0 >> 6);
    const bf16* U = (const bf16*)(a.ws + WS_U + uo);
    float* XW = (float*)L; bf16* QI = (bf16*)(L + OFF_GQI); bf16* KI = (bf16*)(L + OFF_GKI); bf16* KST = (bf16*)(L + OFF_GKST); bf16* VT = (bf16*)(L + OFF_GVT); bf16* SC = (bf16*)(L + OFF_GSC);
    float* TOT = (float*)(L + OFF_GTOT); float* BC = (float*)(L + OFF_GBC);
    float* GW = (float*)(L + OFF_GBC + 256);
    int hl = -1;
    v4u Gl0, Gl1, Gq, Gk, Gv0, Gv1;
#define G1_ISSUE(u_) do { const int lr_ = 64 * ((u_) >> 2) + (tid >> 3), h_ = (u_) & 3, dg_ = tid & 7; const bf16* ur_ = U + (size_t)lr_ * NPAD; \
        Gl0 = *(const v4u*)(ur_ + C_GLR); Gl1 = *(const v4u*)(ur_ + C_GLR + 8); Gq = *(const v4u*)(ur_ + C_GQ + 64 * h_ + 8 * dg_); Gk = *(const v4u*)(ur_ + C_GK + 64 * h_ + 8 * dg_); \
        Gv0 = *(const v4u*)(ur_ + C_GV + 128 * h_ + 16 * dg_); Gv1 = *(const v4u*)(ur_ + C_GV + 128 * h_ + 16 * dg_ + 8); } while (0)
#pragma unroll 1
    for (int unit = ufirst; unit < NGUNIT; unit += ustride) {
        int tid = tid0; asm volatile("" : "+v"(tid));
        const int lane = tid & 63, g = lane >> 4, c16 = lane & 15;
        const int ch = unit >> 2, h = unit & 3;
        if (h != hl) { hl = h; LBAR();
            for (int i = tid; i < 16 * 64; i += NTHR) GW[i] = a.in[3][l * 16 * 256 + (i >> 6) * 256 + 64 * h + (i & 63)];
            if (tid < 64) GW[1024 + tid] = a.in[4][l * 256 + 64 * h + tid];
            LBAR(); }
        const int t = tid >> 3, dg = tid & 7, d0 = 8 * dg, lr = 64 * ch + t, hc = 64 * h + d0;
        if (unit == ufirst) G1_ISSUE(unit);
        float q[8], k[8];
        {
            float glr[16]; unpack8(Gl0, glr); unpack8(Gl1, glr + 8);
            float x[8]; const float* gb = GW + 1024 + d0; const float* gu = GW + d0;
#pragma unroll
            for (int i = 0; i < 8; ++i) x[i] = gb[i];
#pragma unroll
            for (int r = 0; r < 16; ++r) { const f32x4 u0 = *(const f32x4*)(gu + r * 64), u1 = *(const f32x4*)(gu + r * 64 + 4);
                x[0] += glr[r] * u0.x; x[1] += glr[r] * u0.y; x[2] += glr[r] * u0.z; x[3] += glr[r] * u0.w; x[4] += glr[r] * u1.x; x[5] += glr[r] * u1.y; x[6] += glr[r] * u1.z; x[7] += glr[r] * u1.w; }
#pragma unroll
            for (int i = 0; i < 8; ++i) XW[t * FP + d0 + i] = (fminf(x[i], 0.f) - __logf(1.f + __expf(-fabsf(x[i])))) * (1.f / 16.f);
            unpack8(Gq, q); unpack8(Gk, k);
            float vv[16]; const int e0 = 16 * dg; unpack8(Gv0, vv); unpack8(Gv1, vv + 8);
            asm volatile("" ::: "memory");
            if (unit + ustride < NGUNIT) G1_ISSUE(unit + ustride);
#pragma unroll
            for (int i = 0; i < 16; ++i) VT[SWC(e0 + i, t)] = (bf16)f2bf(vv[i]);
        }
        LBAR();
        {
            const int d = tid & 63, tb = tid >> 6; float p[8]; float run = 0.f;
#pragma unroll
            for (int i = 0; i < 8; ++i) { run += XW[(8 * tb + i) * FP + d]; p[i] = run; }
            TOT[tb * 64 + d] = run;
            LBAR();
            float off = 0.f;
#pragma unroll
            for (int j = 0; j < 8; ++j) off += (j < tb) ? TOT[j * 64 + d] : 0.f;
#pragma unroll
            for (int i = 0; i < 8; ++i) XW[(8 * tb + i) * FP + d] = off + p[i];
            if (tb == 7) BC[d] = off + run;
        }
        LBAR();
        {
            float qi[8], ki[8];
#pragma unroll
            for (int i = 0; i < 8; ++i) { const float b = XW[t * FP + d0 + i], bc = BC[d0 + i];
                qi[i] = q[i] * 0.125f * __expf(b); ki[i] = k[i] * __expf(-b); KST[SWC(d0 + i, t)] = (bf16)f2bf(k[i] * __expf(bc - b)); }
            const v4u qp = pack8(qi);
            *(v4u*)(QI + t * PITCH + d0) = qp; *(v4u*)(KI + t * PITCH + d0) = pack8(ki);
            *(v4u*)((bf16*)(a.ws + WS_QI) + (size_t)unit * 4096 + t * 64 + d0) = qp;
        }
        LBAR();
        {
            const int tt = wave >> 1; const int tcol = 16 * tt + c16;
#pragma unroll
            for (int j2 = 0; j2 < 2; ++j2) { const int jt = 2 * (wave & 1) + j2; f32x4 acc = {0.f, 0.f, 0.f, 0.f};
                if (jt <= tt) { acc = mma2(KI + (16 * jt + c16) * PITCH + 8 * g, QI + tcol * PITCH + 8 * g, acc);
#pragma unroll
                    for (int j = 0; j < 4; ++j) if (16 * jt + 4 * g + j > tcol) acc[j] = 0.f; }
                *(v2u*)(SC + tcol * PITCH + 16 * jt + 4 * g) = pack4(acc); }
            bf16* DSg = (bf16*)(a.ws + WS_DS) + (size_t)unit * 8192;
#pragma unroll
            for (int i = 0; i < 4; ++i) { const int tile = wave * 4 + i, dt = tile & 3, et = tile >> 2; f32x4 acc = {0.f, 0.f, 0.f, 0.f};
                { const int ar = 16 * dt + c16, br = 16 * et + c16; acc = mma2s(KST + ar * PITCH, SWK(ar), VT + br * PITCH, SWK(br), g, acc); }
                *(v2u*)(DSg + (16 * et + c16) * 64 + 16 * dt + 4 * g) = pack4(acc); }
            if (tid < 64) ((float*)(a.ws + WS_GDEC))[unit * 64 + tid] = __expf(BC[tid]);
        }
        LBAR();
        {
            bf16* OIg = (bf16*)(a.ws + WS_OI) + (size_t)unit * 8192;
#pragma unroll
            for (int i = 0; i < 4; ++i) { const int tile = wave * 4 + i, tt = tile & 3, et = tile >> 2; f32x4 acc = {0.f, 0.f, 0.f, 0.f};
                { const int ar = 16 * et + c16; acc = mma2s(VT + ar * PITCH, SWK(ar), SC + (16 * tt + c16) * PITCH, 0, g, acc); }
                *(v2u*)(OIg + (16 * tt + c16) * 128 + 16 * et + 4 * g) = pack4(acc); }
        }
        LBAR();
    }
}

__device__ __forceinline__ void g2_scan(CArgs& a, int wg, unsigned char* L, int tid) {
    asm volatile("" : "+v"(tid));
    const int h = wg >> 2, e = 32 * (wg & 3) + (tid >> 4), dq = tid & 15;
    const bf16* DS = (const bf16*)(a.ws + WS_DS) + (size_t)h * 8192 + e * 64 + 4 * dq; const float* GD = (const float*)(a.ws + WS_GDEC) + (size_t)(((tid >> 4) & 15) * 4 + h) * 64 + 4 * dq;
    bf16* SP = (bf16*)(a.ws + WS_SP) + (size_t)h * 8192 + e * 64 + 4 * dq;
    float* DCL = (float*)L;
    v2u dsb[2][16]; f32x4 dcr;
    f32x4 S = {0.f, 0.f, 0.f, 0.f};
#pragma unroll
    for (int i = 0; i < 16; ++i) dsb[0][i] = *(const v2u*)(DS + (size_t)i * (4 * 8192));
    dcr = *(const f32x4*)GD;
    if (tid < 256) *(f32x4*)(DCL + (tid >> 4) * 64 + 4 * dq) = dcr;
#pragma unroll 1
    for (int b2 = 0; b2 < 8; b2 += 2) {
#pragma unroll
        for (int bb = 0; bb < 2; ++bb) { const int b = b2 + bb;
            if (b + 1 < 8) {
#pragma unroll
                for (int i = 0; i < 16; ++i) dsb[(bb + 1) & 1][i] = *(const v2u*)(DS + (size_t)(16 * (b + 1) + i) * (4 * 8192));
                dcr = *(const f32x4*)(GD + (size_t)(16 * (b + 1)) * (4 * 64)); }
            LBAR();
            const float* dcl = DCL + bb * 1024 + 4 * dq;
#pragma unroll
            for (int i = 0; i < 16; ++i) { const f32x4 dc = *(const f32x4*)(dcl + i * 64); const v2u w = dsb[bb][i];
                *(v2u*)(SP + (size_t)(16 * b + i) * (4 * 8192)) = pack4(S);
                const f32x4 dv = {bf2f(w.x & 0xffffu), bf2f(w.x >> 16), bf2f(w.y & 0xffffu), bf2f(w.y >> 16)};
                S = S * dc + dv; }
            if (b + 1 < 8 && tid < 256) *(f32x4*)(DCL + ((bb + 1) & 1) * 1024 + (tid >> 4) * 64 + 4 * dq) = dcr;
        }
    }
    LBAR();
}

__device__ __forceinline__ void g3_phase(CArgs& a, size_t uo, int l, int hb, int gw, int NGW, int lane) {
    asm volatile("" : "+v"(lane));
    const int g = lane >> 4, c16 = lane & 15;
    const bf16* U = (const bf16*)(a.ws + WS_U + uo); const bf16* QI = (const bf16*)(a.ws + WS_QI); const bf16* SP = (const bf16*)(a.ws + WS_SP); const bf16* OI = (const bf16*)(a.ws + WS_OI);
    bf16* MG = (bf16*)(a.ws + WS_XN) + (size_t)hb * MH * D; const float* gnw = a.in[5] + l * 128;
    const int erow = 32 * (c16 >> 2) + (c16 & 3);
#pragma unroll 1
    for (int kk = 0; kk < 1; ++kk) {
        const int unit = (gw >> 3) + 256 * ((gw & 7) >> 2), mt = gw & 3, ch = unit >> 2, h = unit & 3;
        if (unit >= NGUNIT) break;
        const int lr = 64 * ch + 16 * mt + c16; const bf16* urow = U + (size_t)lr * NPAD + C_GG + 128 * h + 32 * g;
        const v4u gg0 = *(const v4u*)urow, gg1 = *(const v4u*)(urow + 8), gg2 = *(const v4u*)(urow + 16), gg3 = *(const v4u*)(urow + 24);
        const bf16* qr = QI + (size_t)unit * 4096 + (16 * mt + c16) * 64 + 8 * g;
        const bf16x8 B0 = *(const bf16x8*)qr, B1 = *(const bf16x8*)(qr + 32);
        f32x4 O[8]; float ss = 0.f; bf16x8 SA[8][2];
#pragma unroll
        for (int et = 0; et < 8; ++et) { const bf16* sr = SP + (size_t)unit * 8192 + (erow + 4 * et) * 64 + 8 * g; SA[et][0] = *(const bf16x8*)sr; SA[et][1] = *(const bf16x8*)(sr + 32); }
        const bf16* oip = OI + (size_t)unit * 8192 + (16 * mt + c16) * 128 + 32 * g; const v4u oi0 = *(const v4u*)oip, oi1 = *(const v4u*)(oip + 8), oi2 = *(const v4u*)(oip + 16), oi3 = *(const v4u*)(oip + 24);
        asm volatile("" ::: "memory");
        { float of[32]; unpack8(oi0, of); unpack8(oi1, of + 8); unpack8(oi2, of + 16); unpack8(oi3, of + 24);
#pragma unroll
          for (int et = 0; et < 8; ++et) O[et] = (f32x4){of[4 * et], of[4 * et + 1], of[4 * et + 2], of[4 * et + 3]}; }
#pragma unroll
        for (int et = 0; et < 8; ++et) { f32x4 acc = __builtin_amdgcn_mfma_f32_16x16x32_bf16(SA[et][0], B0, O[et], 0, 0, 0);
            acc = __builtin_amdgcn_mfma_f32_16x16x32_bf16(SA[et][1], B1, acc, 0, 0, 0);
            O[et] = acc; ss += (acc.x * acc.x + acc.y * acc.y) + (acc.z * acc.z + acc.w * acc.w); }
        ss += __shfl_xor(ss, 16); ss += __shfl_xor(ss, 32);
        const float rstd = rsqrtf(ss * (1.f / 128.f) + 1e-6f);
        float gf[32], o[32]; unpack8(gg0, gf); unpack8(gg1, gf + 8); unpack8(gg2, gf + 16); unpack8(gg3, gf + 24);
#pragma unroll
        for (int et = 0; et < 8; ++et) { const f32x4 w4 = *(const f32x4*)(gnw + 32 * g + 4 * et);
#pragma unroll
            for (int j = 0; j < 4; ++j) { const int i = 4 * et + j; o[i] = O[et][j] * rstd * w4[j] * gf[i] * sigm(gf[i]); } }
        bf16* op = MG + (size_t)lr * D + 128 * h + 32 * g;
        *(v4u*)op = pack8(o); *(v4u*)(op + 8) = pack8(o + 8); *(v4u*)(op + 16) = pack8(o + 16); *(v4u*)(op + 24) = pack8(o + 24);
    }
}

#define LAS __attribute__((address_space(3)))
#define XB_TMO      128
#define XB_XCNT(j)  (256  + 64 * (j))
#define XB_XSUB(j)  (1280 + 64 * (j))
#define XB_XGEN(j)  (2304 + 64 * (j))
#define XB_TOP      3328
#define XB_TOPGEN   3392
#define XCD_BAR_WORDS 3456
#define XB_SPIN_CAP (1u << 18)

__device__ __forceinline__ unsigned xb_ld(unsigned* p)              { return __hip_atomic_load(p, __ATOMIC_RELAXED, __HIP_MEMORY_SCOPE_AGENT); }
__device__ __forceinline__ unsigned xb_add(unsigned* p, unsigned v) { return __hip_atomic_fetch_add(p, v, __ATOMIC_RELAXED, __HIP_MEMORY_SCOPE_AGENT); }
__device__ __forceinline__ unsigned xb_xcc_id() { return (unsigned)__builtin_amdgcn_s_getreg((3 << 11) | 20) & 0xFu; }
#define XB_SPIN(cond, bar) do { unsigned _sp = 0; while (cond) { __builtin_amdgcn_s_sleep(1); \
    if ((++_sp & 255u) == 0u) { if (xb_ld(&(bar)[XB_TMO])) break; if (_sp > XB_SPIN_CAP) { atomicAdd(&(bar)[XB_TMO], 1u); break; } } } } while (0)

struct XcdBarrier {
    unsigned* bar; unsigned x;
    volatile LAS unsigned* st;
};

__device__ __forceinline__ XcdBarrier xcd_barrier_post(unsigned* bar, volatile LAS unsigned* st) {
    XcdBarrier b; b.bar = bar; b.x = xb_xcc_id(); b.st = st;
    if (threadIdx.x == 0) (void)xb_add(&bar[XB_XCNT(b.x)], 1u);
    return b;
}
__device__ __forceinline__ void xcd_barrier_complete(unsigned* bar, unsigned x, unsigned& nloc, unsigned& nx) {
    const unsigned G = gridDim.x * gridDim.y * gridDim.z;
    unsigned sum, cnt, mine, sp = 0u;
    for (;;) {
        sum = 0u; cnt = 0u; mine = 0u;
#pragma unroll
        for (unsigned j = 0; j < 16; ++j) { const unsigned c = xb_ld(&bar[XB_XCNT(j)]); sum += c; cnt += (c > 0u) ? 1u : 0u; mine = (j == x) ? c : mine; }
        if (sum == G) break;
        __builtin_amdgcn_s_sleep(1);
        if ((++sp & 255u) == 0u) { if (xb_ld(&bar[XB_TMO])) break; if (sp > XB_SPIN_CAP) { atomicAdd(&bar[XB_TMO], 1u); break; } }
    }
    nloc = mine > 0u ? mine : 1u; nx = cnt > 0u ? cnt : 1u;
}

__device__ __forceinline__ void xcd_barrier(const XcdBarrier& b) {
    asm volatile("s_waitcnt vmcnt(0)" ::: "memory");
    __syncthreads();
    if (threadIdx.x == 0) {
        unsigned* bar = b.bar;
        __builtin_amdgcn_s_waitcnt(0);
        unsigned nloc = b.st[0], nx = b.st[1];
        if (nloc == 0u) { xcd_barrier_complete(bar, b.x, nloc, nx); b.st[0] = nloc; b.st[1] = nx; }
        const unsigned old = xb_add(&bar[XB_XSUB(b.x)], 1u);
        const unsigned gen = old / nloc;
        if (old + 1u == (gen + 1u) * nloc) {
            __builtin_amdgcn_fence(__ATOMIC_RELEASE, "agent");
            asm volatile("s_waitcnt vmcnt(0)" ::: "memory");
            const unsigned og = xb_add(&bar[XB_TOP], 1u);
            const unsigned tg = og / nx;
            if (og + 1u == (tg + 1u) * nx) xb_add(&bar[XB_TOPGEN], 1u);
            else XB_SPIN(xb_ld(&bar[XB_TOPGEN]) == tg, bar);
            __builtin_amdgcn_fence(__ATOMIC_ACQUIRE, "agent");
            xb_add(&bar[XB_XGEN(b.x)], 1u);
            asm volatile("s_waitcnt vmcnt(0)" ::: "memory");
        } else {
            XB_SPIN(xb_ld(&bar[XB_XGEN(b.x)]) == gen, bar);
            __builtin_amdgcn_fence(__ATOMIC_ACQUIRE, "agent");
            asm volatile("s_waitcnt vmcnt(0)" ::: "memory");
        }
    }
    __syncthreads();
}


__global__ void __launch_bounds__(NTHR, 2) hymba_fwd(Args a_kernarg) {
    extern __shared__ __attribute__((aligned(16))) unsigned char lds[];
    cg::grid_group grid = cg::this_grid();
    const int tid = threadIdx.x, lane = tid & 63, wave = __builtin_amdgcn_readfirstlane(tid >> 6);
    const int G = gridDim.x, gw = blockIdx.x * NWAVES + wave, NGW = G * NWAVES;
    volatile LAS unsigned* xst = (volatile LAS unsigned*)(LAS unsigned char*)(lds + LDS_BYTES - 64);
    if (tid < 2) xst[tid] = 0u;
    __syncthreads();
    const XcdBarrier xbar = xcd_barrier_post((unsigned*)AA.ws, xst);
    {
        CArgs& a = AA; bf16* XN = (bf16*)(a.ws + WS_XN);
        float* scr = (float*)lds;
        constexpr int T_IN = (D / 64) * (NPAD / 64), T_OUT = (D / 64) * (D / 64);
        for (int l = 0; l < 2; ++l) {
            transpose_tiles(a.in[2] + (size_t)l * D * NIN, D, NIN, NPAD, (bf16*)(a.ws + WS_WIN + l * WIN_BYTES), scr, (int)blockIdx.x, G, T_IN, tid);
            transpose_tiles(a.in[16] + (size_t)l * D * D, D, D, D, (bf16*)(a.ws + WS_WOUT + l * WOUT_BYTES), scr, (int)blockIdx.x, G, T_OUT, tid);
        }
        for (int m = 2 * gw; m < M; m += 2 * NGW) rms_row2(a.in[0] + (size_t)m * D, a.in[0] + (size_t)(m + 1) * D, a.in[1], XN + (size_t)m * D, XN + (size_t)(m + 1) * D, lane);
        {
            bf16* UPT = (bf16*)(a.ws + WS_UPT);
            for (int e = blockIdx.x * NTHR + tid; e < 2 * 2 * 512 * 64; e += G * NTHR) { const int r = e & 63, c = (e >> 6) & 511, q = (e >> 15) & 1, ll = e >> 16;
                UPT[e] = (bf16)f2bf((q ? a.in[10] : a.in[8])[(size_t)ll * 64 * 512 + r * 512 + c]); }
        }
    }
    if (AA.ws == nullptr) grid.sync();
    xcd_barrier(xbar);
    for (int l = 0; l < 2; ++l) {
        for (int hb = 0; hb < 2; ++hb) {
            {
                CArgs& a = AA; bf16* XN = (bf16*)(a.ws + WS_XN); bf16* U = (bf16*)(a.ws + WS_U + (size_t)hb * U_STRIDE);
                pg8::Gemm g{XN + (size_t)hb * MH * D, (const bf16*)(a.ws + WS_WIN + l * WIN_BYTES), MH, NPAD, D}; pg8::RangeOrder S;
                if (hb == 0) S.init(MH, NPAD, G, (int)blockIdx.x, 0, 480); else S.init(MH, NPAD, G, (int)blockIdx.x, EARLY_TILES, 480 - EARLY_TILES);
                pg8::EpiBf16<0> E{U, NPAD, nullptr, 0, 0, 1.f};
                pg8::gemm_phase<pg8::EpiBf16<0>, pg8::RangeOrder, true, true>((PG8_LAS unsigned char*)lds, g, S, E);
            }
            xcd_barrier(xbar);
            const size_t uo = (size_t)hb * U_STRIDE;
            r1_phase(AA, uo, l, lds, tid);
            g1_phase(AA, uo, l, lds, tid, (int)blockIdx.x, G);
            xcd_barrier(xbar);
            if (blockIdx.x < 32) r2_scan(AA, blockIdx.x, lds, tid);
            else { if (blockIdx.x < 48) g2_scan(AA, blockIdx.x - 32, lds, tid);
                if (hb == 0) {
                    CArgs& a = AA; bf16* XN = (bf16*)(a.ws + WS_XN); bf16* U1 = (bf16*)(a.ws + WS_U1);
                    pg8::Gemm g{XN + (size_t)MH * D, (const bf16*)(a.ws + WS_WIN + l * WIN_BYTES), MH, NPAD, D}; pg8::RangeOrder S; S.init(MH, NPAD, G, (int)blockIdx.x - 32, 0, EARLY_TILES);
                    pg8::EpiBf16<0> E{U1, NPAD, nullptr, 0, 0, 1.f};
                    pg8::gemm_phase<pg8::EpiBf16<0>, pg8::RangeOrder, true, true>((PG8_LAS unsigned char*)lds, g, S, E); } }
            xcd_barrier(xbar);
            r3_phase(AA, uo, l, hb, gw, NGW, lane);
            g3_phase(AA, uo, l, hb, gw, NGW, lane);
            if (hb == 1) xcd_barrier(xbar);
        }
        {
            CArgs& a = AA; bf16* XN = (bf16*)(a.ws + WS_XN);
            pg8::Gemm g{XN, (const bf16*)(a.ws + WS_WOUT + l * WOUT_BYTES), M, D, D}; pg8::StaticOrder S; S.init(M, D, G, (int)blockIdx.x);
            pg8::EpiRmsRes E{l == 0 ? a.in[0] : a.out, a.out, XN, l == 0 ? a.in[1] + D : a.in[17], (float*)(a.ws + WS_SLOTS) + (size_t)l * M * 4, (unsigned*)(a.ws + 16384) + l * 64 * 64, D, l};
            pg8::gemm_phase<pg8::EpiRmsRes, pg8::StaticOrder, false, true>((PG8_LAS unsigned char*)lds, g, S, E);
        }
        if (l == 0) xcd_barrier(xbar);
    }
}

extern "C" void kernel_launch(void* const* d_in, const int* in_sizes, int n_in, void* d_out, int out_size, void* d_ws, size_t ws_size, hipStream_t stream) {
    static int grid = 0;
    if (grid == 0) {
        if (n_in != 18 || out_size != M * D || ws_size < WS_END) { fprintf(stderr, "kernel_launch: unexpected shapes n_in %d out %d ws %zu\n", n_in, out_size, ws_size); grid = -1; return; }
        int dev = 0, cus = 0, per_cu = 0;
        hipGetDevice(&dev); hipDeviceGetAttribute(&cus, hipDeviceAttributeMultiprocessorCount, dev);
        if (hipFuncSetAttribute((const void*)hymba_fwd, hipFuncAttributeMaxDynamicSharedMemorySize, LDS_BYTES) != hipSuccess) { fprintf(stderr, "kernel_launch: hipFuncSetAttribute failed\n"); grid = -1; return; }
        if (hipOccupancyMaxActiveBlocksPerMultiprocessor(&per_cu, (const void*)hymba_fwd, NTHR, LDS_BYTES) != hipSuccess || per_cu < 1) { fprintf(stderr, "kernel_launch: occupancy query failed (%d)\n", per_cu); grid = -1; return; }
        grid = cus * 1;
        fprintf(stderr, "kernel_launch: cus %d per_cu %d grid %d\n", cus, per_cu, grid);
    }
    if (grid < 0) return;
    if (hipMemsetAsync(d_ws, 0, 65536, stream) != hipSuccess) { fprintf(stderr, "kernel_launch: memset failed\n"); return; }
    Args a{};
    for (int i = 0; i < 18; ++i) a.in[i] = (const float*)d_in[i];
    a.out = (float*)d_out; a.ws = (unsigned char*)d_ws;
    void* args[] = {&a};
    hipError_t e = hipLaunchCooperativeKernel((const void*)hymba_fwd, dim3(grid), dim3(NTHR), args, LDS_BYTES, stream);
    if (e != hipSuccess) fprintf(stderr, "cooperative launch failed: %s (grid %d)\n", hipGetErrorString(e), grid);
}
```

```cpp
#include <hip/hip_runtime.h>
#include <hip/hip_cooperative_groups.h>
#include <cstdio>
#include <cstdint>
namespace cg = cooperative_groups;
namespace pg8 {
#define PG8_LAS __attribute__((address_space(3)))
typedef unsigned short bf16_t;
typedef short bf16x8 __attribute__((ext_vector_type(8)));
typedef float f32x4 __attribute__((ext_vector_type(4)));
typedef unsigned u32x4 __attribute__((ext_vector_type(4)));
constexpr int BM = 256, BK = 64, HALF = 128, HTB = HALF * BK * 2  , STAGE_BYTES = 8 * HTB, NXCD = 8, WGM = 8;

__host__ __device__ __forceinline__ int lds_byte(int r, int c) { const int st = (r >> 4) * 2 + (c >> 5), rr = r & 15, cc = c & 31, ob = rr * 64 + cc * 2; return st * 1024 + (ob ^ (((ob >> 9) & 1) << 5)); }
__host__ __device__ __forceinline__ void stage_rc(int b, int& R, int& C) { const int st = b / 1024, sb = b % 1024, swz = sb ^ (((sb >> 9) & 1) << 5); R = (st >> 1) * 16 + swz / 64; C = (st & 1) * 32 + (swz % 64) / 2; }
__host__ __device__ __forceinline__ int perm32(int rho) { const int n = rho >> 4, i = rho & 15; return 8 * (i >> 2) + 4 * n + (i & 3); }

struct Unit { int pm, pn; };
struct Gemm { const bf16_t* A; const bf16_t* Bt; int M, N, K; };

struct StaticOrder {
    int nM, nN, nwg, G, c;
    __host__ __device__ void init(int M, int N, int G_, int c_) { nM = M / BM; nN = N / BM; nwg = nM * nN; G = G_; c = c_; }
    __host__ __device__ bool next(int i, Unit& u) const {
        const long L = (long)i * G + c; if (L >= nwg) return false;
        int wgid = (int)L; { const int q = nwg / NXCD, r = nwg % NXCD, xcd = wgid % NXCD, off = wgid / NXCD; wgid = (xcd < r ? xcd * (q + 1) : r * (q + 1) + (xcd - r) * q) + off; }
        const int nig = WGM * nN, gid = wgid / nig, fm = gid * WGM, gsz = (nM - fm) < WGM ? (nM - fm) : WGM;
        u.pm = fm + ((wgid % nig) % gsz); u.pn = (wgid % nig) / gsz; return true;
    }
    __device__ __forceinline__ void a_ready(const Unit&) const {}
    __device__ __forceinline__ void done(const Unit&) const {}
};

__device__ __forceinline__ unsigned cvt_pk_bf16(float lo, float hi) { unsigned r; asm volatile("v_cvt_pk_bf16_f32 %0, %1, %2" : "=v"(r) : "v"(lo), "v"(hi)); return r; }
typedef float f32x2 __attribute__((ext_vector_type(2)));
__device__ __forceinline__ f32x2 gelu_pk(f32x2 v) {
    const f32x2 av = __builtin_elementwise_abs(v), d = av * 0.2316418882f + 1.0f;
    f32x2 t; t.x = __builtin_amdgcn_rcpf(d.x); t.y = __builtin_amdgcn_rcpf(d.y);
    f32x2 q = t * 0.5307027145f + (-0.7265760135f); q = q * t + 0.7107068705f; q = q * t + (-0.142248368f); q = q * t + 0.127414796f; q = q * t;
    const f32x2 s = (v * v) * (-0.72134752044f);
    f32x2 e; e.x = __builtin_amdgcn_exp2f(s.x); e.y = __builtin_amdgcn_exp2f(s.y);
    const f32x2 m = v * (q * e), r = v - m;
    f32x2 o; o.x = v.x < 0.f ? m.x : r.x; o.y = v.y < 0.f ? m.y : r.y; return o;
}

template <int ACT  > struct EpiBf16 {
    static constexpr bool PERM = true, AFTER_DRAIN = false; static_assert(ACT == 0 || ACT == 1, "EpiBf16: ACT is 0 (none) or 1 (gelu_pk)");
    bf16_t* O; int ldc; const float* bias; int split_cols; size_t split_stride; float scale0;
    __device__ __forceinline__ void operator()(const f32x4 (&acc)[2][2][4][2], const Unit& u, int wr, int wc, int fr, int fq) const {
        const int row0 = u.pm * BM + wr * 64 + fr; int colt = u.pn * BM; bf16_t* base = O;
        float sc = 1.f; if (split_cols) { const int t = colt / split_cols; base += (size_t)t * split_stride; colt -= t * split_cols; if (t == 0) sc = scale0; }
        const int col0 = colt + wc * 32 + 8 * fq, bcol0 = u.pn * BM + wc * 32 + 8 * fq;
        f32x4 bv[2][2];
#pragma unroll
        for (int bj = 0; bj < 2; ++bj)
#pragma unroll
            for (int n = 0; n < 2; ++n) bv[bj][n] = bias ? *(const f32x4*)(bias + bcol0 + bj * HALF + 4 * n) : (f32x4){0.f, 0.f, 0.f, 0.f};
#pragma unroll
        for (int ai = 0; ai < 2; ++ai)
#pragma unroll
            for (int m = 0; m < 4; ++m) { bf16_t* rowp = base + (size_t)(row0 + ai * HALF + m * 16) * ldc + col0;
#pragma unroll
                for (int bj = 0; bj < 2; ++bj) { f32x4 v0 = acc[ai][bj][m][0] + bv[bj][0], v1 = acc[ai][bj][m][1] + bv[bj][1];
                    if (ACT == 1) { f32x2 a = gelu_pk((f32x2){v0[0], v0[1]}), b = gelu_pk((f32x2){v0[2], v0[3]}), c = gelu_pk((f32x2){v1[0], v1[1]}), d = gelu_pk((f32x2){v1[2], v1[3]});
                        v0 = (f32x4){a.x, a.y, b.x, b.y}; v1 = (f32x4){c.x, c.y, d.x, d.y}; }
                    v0 = v0 * sc; v1 = v1 * sc; u32x4 w; w.x = cvt_pk_bf16(v0[0], v0[1]); w.y = cvt_pk_bf16(v0[2], v0[3]); w.z = cvt_pk_bf16(v1[0], v1[1]); w.w = cvt_pk_bf16(v1[2], v1[3]);
                    *(u32x4*)(rowp + bj * HALF) = w; } }
    }
};

template <class Epi, class Sched, bool ALIGN_EPI = false, bool SP2 = false>
__device__ __forceinline__ void gemm_phase(PG8_LAS unsigned char* lds, const Gemm g, const Sched& S, const Epi& E) {
    int tid_ = threadIdx.x; asm volatile("" : "+v"(tid_));
    const int tid = tid_, wid = __builtin_amdgcn_readfirstlane(tid >> 6), lane = tid & 63, wr = wid >> 2, wc = wid & 3, fr = lane & 15, fq = lane >> 4;
    const int K = g.K, nt = K / BK;
    unsigned voffA[2], voffB[2];
#pragma unroll
    for (int i = 0; i < 2; ++i) { int R, C; stage_rc(tid * 16 + i * 8192, R, C); const int Rb = Epi::PERM ? ((R & ~31) + perm32(R & 31)) : R;
        voffA[i] = (unsigned)(R * K + C) * 2u; voffB[i] = (unsigned)(Rb * K + C) * 2u; }
    const size_t kstep = (size_t)(BK * 2);
    const size_t hstep = (size_t)HALF * K * 2;
    const size_t tstep = 2 * hstep;
    const unsigned ldsw = (unsigned)wid * 1024u;
    const int aoff = lds_byte(wr * 64 + fr, fq * 8), boff = lds_byte(wc * 32 + fr, fq * 8);
#define PG8_SA(b, h) (((b) * 2 + (h)) * HTB)
#define PG8_SB(b, h) ((4 + (b) * 2 + (h)) * HTB)
#define PG8_STAGE(bufoff, gbase, voff) do { _Pragma("unroll") for (int _i = 0; _i < 2; ++_i) \
        __builtin_amdgcn_global_load_lds((const unsigned*)((const char*)(gbase) + (voff)[_i]), (PG8_LAS unsigned*)(lds + (bufoff) + ldsw + _i * 8192), 16, 0, 0); } while (0)
#define PG8_LDA(dst, b, h) do { _Pragma("unroll") for (int m = 0; m < 4; ++m) _Pragma("unroll") for (int k = 0; k < 2; ++k) dst[m][k] = *(const PG8_LAS bf16x8*)(lds + PG8_SA(b, h) + aoff + m * 2048 + k * 1024); } while (0)
#define PG8_LDB(dst, b, h) do { _Pragma("unroll") for (int n = 0; n < 2; ++n) _Pragma("unroll") for (int k = 0; k < 2; ++k) dst[n][k] = *(const PG8_LAS bf16x8*)(lds + PG8_SB(b, h) + boff + n * 2048 + k * 1024); } while (0)
#define PG8_MMA(ai, bj, At, Bt) do { __builtin_amdgcn_s_setprio(1); _Pragma("unroll") for (int m = 0; m < 4; ++m) _Pragma("unroll") for (int n = 0; n < 2; ++n) _Pragma("unroll") for (int k = 0; k < 2; ++k) \
        acc[ai][bj][m][n] = __builtin_amdgcn_mfma_f32_16x16x32_bf16(Bt[n][k], At[m][k], acc[ai][bj][m][n], 0, 0, 0); __builtin_amdgcn_s_setprio(0); } while (0)
#define PG8_WAIT_V(n) asm volatile("s_waitcnt vmcnt(" #n ")" ::: "memory")
#define PG8_WAIT_L(n) asm volatile("s_waitcnt lgkmcnt(" #n ")" ::: "memory")
#define PG8_BAR __builtin_amdgcn_s_barrier()
#define PG8_SCHED __builtin_amdgcn_sched_barrier(0)
    Unit cur, nxt; int ui = 0;
    if (!S.next(0, cur)) return;
    f32x4 acc[2][2][4][2];
#pragma unroll
    for (int a = 0; a < 2; ++a)
#pragma unroll
        for (int b = 0; b < 2; ++b)
#pragma unroll
            for (int m = 0; m < 4; ++m)
#pragma unroll
                for (int n = 0; n < 2; ++n) acc[a][b][m][n] = (f32x4){0.f, 0.f, 0.f, 0.f};
    bf16x8 At[4][2], B0[2][2], B1[2][2];
    const char* cA = (const char*)g.A + (size_t)cur.pm * tstep; const char* cB = (const char*)g.Bt + (size_t)cur.pn * tstep;
    S.a_ready(cur);
    if constexpr (SP2) {
        PG8_STAGE(PG8_SB(0, 0), cB, voffB); PG8_STAGE(PG8_SB(0, 1), cB + hstep, voffB); PG8_STAGE(PG8_SA(0, 0), cA, voffA); PG8_STAGE(PG8_SA(0, 1), cA + hstep, voffA);
        if (wr == 1) PG8_BAR;
        PG8_WAIT_V(2); PG8_BAR;
        PG8_STAGE(PG8_SB(1, 0), cB + kstep, voffB); PG8_STAGE(PG8_SA(1, 0), cA + kstep, voffA); PG8_STAGE(PG8_SB(1, 1), cB + hstep + kstep, voffB);
        PG8_WAIT_V(6); PG8_BAR;
    } else {
        PG8_STAGE(PG8_SB(0, 0), cB, voffB); PG8_STAGE(PG8_SA(0, 0), cA, voffA); PG8_STAGE(PG8_SB(0, 1), cB + hstep, voffB); PG8_STAGE(PG8_SA(0, 1), cA + hstep, voffA);
        if (wr == 1) PG8_BAR;
        PG8_WAIT_V(4); PG8_BAR;
        PG8_STAGE(PG8_SB(1, 0), cB + kstep, voffB); PG8_STAGE(PG8_SA(1, 0), cA + kstep, voffA); PG8_STAGE(PG8_SB(1, 1), cB + hstep + kstep, voffB);
        PG8_WAIT_V(6); PG8_BAR;
    }
    for (;;) {
        const bool has_next = S.next(ui + 1, nxt);
        const char* nA = has_next ? (const char*)g.A + (size_t)nxt.pm * tstep : cA; const char* nB = has_next ? (const char*)g.Bt + (size_t)nxt.pn * tstep : cB;
        for (int t = 0; t < nt; t += 2) {
            const bool last = (t == nt - 2);
            const char* a1 = cA + (size_t)(t + 1) * kstep;
            const char* a2 = last ? nA : cA + (size_t)(t + 2) * kstep; const char* b2 = last ? nB : cB + (size_t)(t + 2) * kstep;
            const char* a3 = a2 + kstep; const char* b3 = b2 + kstep;
            if (last && has_next) S.a_ready(nxt);
            if constexpr (SP2) {
            PG8_LDB(B0, 0, 0); PG8_LDB(B1, 0, 1); PG8_SCHED; PG8_LDA(At, 0, 0); PG8_STAGE(PG8_SA(1, 1), a1 + hstep, voffA);
            PG8_WAIT_V(8); PG8_WAIT_L(0); PG8_BAR; PG8_MMA(0, 0, At, B0); PG8_MMA(0, 1, At, B1); PG8_BAR; PG8_SCHED;
            PG8_LDA(At, 0, 1); PG8_STAGE(PG8_SB(0, 0), b2, voffB); PG8_STAGE(PG8_SB(0, 1), b2 + hstep, voffB); PG8_STAGE(PG8_SA(0, 0), a2, voffA);
            PG8_WAIT_V(8); PG8_WAIT_L(0); PG8_BAR; PG8_MMA(1, 0, At, B0); PG8_MMA(1, 1, At, B1); PG8_BAR; PG8_SCHED;
            PG8_LDB(B0, 1, 0); PG8_LDB(B1, 1, 1); PG8_SCHED; PG8_LDA(At, 1, 0); PG8_STAGE(PG8_SA(0, 1), a2 + hstep, voffA);
            PG8_WAIT_V(8); PG8_WAIT_L(0); PG8_BAR; PG8_MMA(0, 0, At, B0); PG8_MMA(0, 1, At, B1); PG8_BAR; PG8_SCHED;
            PG8_LDA(At, 1, 1); PG8_STAGE(PG8_SB(1, 0), b3, voffB); PG8_STAGE(PG8_SB(1, 1), b3 + hstep, voffB); PG8_STAGE(PG8_SA(1, 0), a3, voffA);
            PG8_WAIT_V(8); PG8_WAIT_L(0); PG8_BAR; PG8_MMA(1, 0, At, B0); PG8_MMA(1, 1, At, B1); PG8_BAR; PG8_SCHED;
            } else {
            PG8_LDB(B0, 0, 0); PG8_SCHED; PG8_LDA(At, 0, 0); PG8_STAGE(PG8_SA(1, 1), a1 + hstep, voffA);
            PG8_WAIT_L(8); PG8_BAR; PG8_WAIT_L(0); PG8_MMA(0, 0, At, B0); PG8_BAR; PG8_SCHED;
            PG8_LDB(B1, 0, 1); PG8_STAGE(PG8_SB(0, 0), b2, voffB);
            PG8_BAR; PG8_WAIT_L(0); PG8_MMA(0, 1, At, B1); PG8_BAR;
            PG8_LDA(At, 0, 1); PG8_STAGE(PG8_SA(0, 0), a2, voffA);
            PG8_BAR; PG8_WAIT_L(0); PG8_MMA(1, 0, At, B0); PG8_BAR; PG8_SCHED;
            PG8_STAGE(PG8_SB(0, 1), b2 + hstep, voffB);
            PG8_WAIT_V(6); PG8_BAR; PG8_MMA(1, 1, At, B1); PG8_BAR;
            PG8_LDB(B0, 1, 0); PG8_SCHED; PG8_LDA(At, 1, 0); PG8_STAGE(PG8_SA(0, 1), a2 + hstep, voffA);
            PG8_WAIT_L(8); PG8_BAR; PG8_WAIT_L(0); PG8_MMA(0, 0, At, B0); PG8_BAR; PG8_SCHED;
            PG8_LDB(B1, 1, 1); PG8_STAGE(PG8_SB(1, 0), b3, voffB);
            PG8_BAR; PG8_WAIT_L(0); PG8_MMA(0, 1, At, B1); PG8_BAR;
            PG8_LDA(At, 1, 1); PG8_STAGE(PG8_SA(1, 0), a3, voffA);
            PG8_BAR; PG8_WAIT_L(0); PG8_MMA(1, 0, At, B0); PG8_BAR; PG8_SCHED;
            PG8_STAGE(PG8_SB(1, 1), b3 + hstep, voffB);
            PG8_WAIT_V(6); PG8_BAR; PG8_MMA(1, 1, At, B1); PG8_BAR;
            }
        }
        if constexpr (ALIGN_EPI) { if (wr == 0) PG8_BAR; }
        if constexpr (!Epi::AFTER_DRAIN) { E(acc, cur, wr, wc, fr, fq); S.done(cur); }
        if (!has_next) break;
#pragma unroll
        for (int a = 0; a < 2; ++a)
#pragma unroll
            for (int b = 0; b < 2; ++b)
#pragma unroll
                for (int m = 0; m < 4; ++m)
#pragma unroll
                    for (int n = 0; n < 2; ++n) acc[a][b][m][n] = (f32x4){0.f, 0.f, 0.f, 0.f};
        cur = nxt; cA = nA; cB = nB; ++ui;
        if constexpr (ALIGN_EPI) { if (wr == 1) PG8_BAR; }
    }
    PG8_WAIT_V(0);
    if constexpr (!ALIGN_EPI) { if (wr == 0) PG8_BAR; }
    PG8_BAR;
    if constexpr (Epi::AFTER_DRAIN) { E.fused(acc, cur, wr, wc, fr, fq, lds, wid, lane); S.done(cur); }
#undef PG8_SA
#undef PG8_SB
#undef PG8_STAGE
#undef PG8_LDA
#undef PG8_LDB
#undef PG8_MMA
#undef PG8_WAIT_V
#undef PG8_WAIT_L
#undef PG8_BAR
#undef PG8_SCHED
}
}
namespace pg8 {
struct EpiResid {
    static constexpr bool PERM = false, AFTER_DRAIN = false;
    const float* base; float* out; int ldc;
    __device__ __forceinline__ void operator()(const f32x4 (&acc)[2][2][4][2], const Unit& u, int wr, int wc, int fr, int fq) const {
        const int col0 = u.pn * BM + wc * 32 + 4 * fq;
#pragma unroll
        for (int ai = 0; ai < 2; ++ai)
#pragma unroll
            for (int m = 0; m < 4; ++m) { const size_t off = (size_t)(u.pm * BM + ai * HALF + wr * 64 + m * 16 + fr) * ldc + col0;
#pragma unroll
                for (int bj = 0; bj < 2; ++bj)
#pragma unroll
                    for (int n = 0; n < 2; ++n) { const f32x4 b = *(const f32x4*)(base + off + bj * HALF + n * 16); *(f32x4*)(out + off + bj * HALF + n * 16) = b + acc[ai][bj][m][n]; } }
    }
};
struct RangeOrder {
    int nM, nN, nwg, G, c, first, last;
    __host__ __device__ void init(int M, int N, int G_, int c_, int first_, int count_) { nM = M / BM; nN = N / BM; nwg = nM * nN; G = G_; c = c_; first = first_; last = first_ + count_; }
    __host__ __device__ bool next(int i, Unit& u) const {
        const long L = (long)first + (long)i * G + c; if (c < 0 || L >= last || L >= nwg) return false;
        int wgid = (int)L; { const int q = nwg / NXCD, r = nwg % NXCD, xcd = wgid % NXCD, off = wgid / NXCD; wgid = (xcd < r ? xcd * (q + 1) : r * (q + 1) + (xcd - r) * q) + off; }
        const int nig = WGM * nN, gid = wgid / nig, fm = gid * WGM, gsz = (nM - fm) < WGM ? (nM - fm) : WGM;
        u.pm = fm + ((wgid % nig) % gsz); u.pn = (wgid % nig) / gsz; return true;
    }
    __device__ __forceinline__ void a_ready(const Unit&) const {}
    __device__ __forceinline__ void done(const Unit&) const {}
};
struct EpiRmsRes {
    static constexpr bool PERM = false, AFTER_DRAIN = true;
    const float* base; float* out; bf16_t* xn; const float* w; float* slots; unsigned* cnt; int ldc; int mode;
    __device__ __forceinline__ void fused(f32x4 (&acc)[2][2][4][2], const Unit& u, int wr, int wc, int fr, int fq, PG8_LAS unsigned char* lds, int wid, int lane) const {
        const int col0 = u.pn * BM + wc * 32 + 4 * fq;
        PG8_LAS float* P = (PG8_LAS float*)lds; PG8_LAS float* S = (PG8_LAS float*)(lds + 4096);
#pragma unroll
        for (int ai = 0; ai < 2; ++ai)
#pragma unroll
            for (int m = 0; m < 4; ++m) { const size_t off = (size_t)(u.pm * BM + ai * HALF + wr * 64 + m * 16 + fr) * ldc + col0; float s = 0.f;
#pragma unroll
                for (int bj = 0; bj < 2; ++bj)
#pragma unroll
                    for (int n = 0; n < 2; ++n) { const f32x4 v = acc[ai][bj][m][n] + *(const f32x4*)(base + off + bj * HALF + n * 16); acc[ai][bj][m][n] = v; s += (v[0] * v[0] + v[1] * v[1]) + (v[2] * v[2] + v[3] * v[3]); }
                s += __shfl_xor(s, 16); s += __shfl_xor(s, 32);
                if (fq == 0) P[(ai * HALF + wr * 64 + m * 16 + fr) * 4 + wc] = s;
                if (m & 1) asm volatile("" ::: "memory"); }
        asm volatile("s_waitcnt lgkmcnt(0)" ::: "memory"); __builtin_amdgcn_s_barrier(); asm volatile("" ::: "memory");
        const int row = wid * 32 + (lane & 31);
        if (lane < 32) { const float tot = (P[row * 4 + 0] + P[row * 4 + 1]) + (P[row * 4 + 2] + P[row * 4 + 3]);
            __hip_atomic_store(slots + ((size_t)(u.pm * BM + row) * 4 + u.pn), tot, __ATOMIC_RELAXED, __HIP_MEMORY_SCOPE_AGENT); }
        asm volatile("s_waitcnt vmcnt(0)" ::: "memory");
        if (lane == 0) __hip_atomic_fetch_add(cnt + 64 * u.pm, 1u, __ATOMIC_RELAXED, __HIP_MEMORY_SCOPE_AGENT);
        if (wid == 0) { while ((unsigned)__builtin_amdgcn_readfirstlane(__hip_atomic_load(cnt + 64 * u.pm, __ATOMIC_RELAXED, __HIP_MEMORY_SCOPE_AGENT)) < 32u) __builtin_amdgcn_s_sleep(2);
            __builtin_amdgcn_fence(__ATOMIC_ACQUIRE, "agent"); }
        asm volatile("s_waitcnt vmcnt(0) lgkmcnt(0)" ::: "memory"); __builtin_amdgcn_s_barrier(); asm volatile("" ::: "memory");
        if (lane < 32) { const float* sl = slots + (size_t)(u.pm * BM + row) * 4; float q = 0.f;
#pragma unroll
            for (int t = 0; t < 4; ++t) q += __hip_atomic_load(sl + t, __ATOMIC_RELAXED, __HIP_MEMORY_SCOPE_AGENT);
            S[row] = 1.0f / sqrtf(q * (1.f / 1024.f) + 1e-6f); }
        asm volatile("s_waitcnt lgkmcnt(0)" ::: "memory"); __builtin_amdgcn_s_barrier(); asm volatile("" ::: "memory");
        f32x4 wv[2][2];
#pragma unroll
        for (int bj = 0; bj < 2; ++bj)
#pragma unroll
            for (int n = 0; n < 2; ++n) wv[bj][n] = *(const f32x4*)(w + col0 + bj * HALF + n * 16);
#pragma unroll
        for (int ai = 0; ai < 2; ++ai)
#pragma unroll
            for (int m = 0; m < 4; ++m) { const int r = ai * HALF + wr * 64 + m * 16 + fr; const float rs = S[r]; const size_t off = (size_t)(u.pm * BM + r) * ldc + col0;
#pragma unroll
                for (int bj = 0; bj < 2; ++bj)
#pragma unroll
                    for (int n = 0; n < 2; ++n) { const f32x4 v = acc[ai][bj][m][n]; const f32x4 nv = v * rs * wv[bj][n];
                        if (mode == 0) { *(f32x4*)(out + off + bj * HALF + n * 16) = v; typedef unsigned u32x2v __attribute__((ext_vector_type(2))); u32x2v pk; pk.x = cvt_pk_bf16(nv[0], nv[1]); pk.y = cvt_pk_bf16(nv[2], nv[3]);
                            *(u32x2v*)(xn + off + bj * HALF + n * 16) = pk; }
                        else *(f32x4*)(out + off + bj * HALF + n * 16) = nv; } }
    }
};
}
constexpr int NWAVES = 8, NTHR = 512;
constexpr int BATCH = 2, T = 8192, D = 1024, M = BATCH * T, MH = T;
constexpr int NIN = 3728, NPAD = 3840;
constexpr int C_GQ = 0, C_GK = 256, C_GV = 512, C_GLR = 1024, C_GG = 1040, C_R = 1552, C_K = 2064, C_V = 2576, C_WL = 3088, C_AL = 3152, C_RG = 3216;
constexpr size_t MiB = 1u << 20;
constexpr size_t WS_WIN = 1 * MiB, WIN_BYTES = (size_t)NPAD * D * 2;
constexpr size_t WS_WOUT = 16 * MiB, WOUT_BYTES = (size_t)D * D * 2;
constexpr size_t WS_XN = 20 * MiB;
constexpr size_t WS_U = 52 * MiB, WS_U1 = 193 * MiB, U_STRIDE = WS_U1 - WS_U;
constexpr size_t WS_SLOTS = 192 * MiB;
constexpr size_t WS_END = 254 * MiB;
constexpr int LDS_BYTES = 163840;
constexpr int EARLY_TILES = 224;

typedef unsigned short bf16;
typedef unsigned v4u __attribute__((ext_vector_type(4)));
typedef float f32x4 __attribute__((ext_vector_type(4)));
#define LDS_WAIT() asm volatile("s_waitcnt lgkmcnt(0)" ::: "memory")
#define LBAR() do { asm volatile("s_waitcnt lgkmcnt(0)" ::: "memory"); __builtin_amdgcn_s_barrier(); asm volatile("" ::: "memory"); } while (0)
__device__ __forceinline__ float bf2f(unsigned h) { return __uint_as_float(h << 16); }
__device__ __forceinline__ unsigned f2bf(float f) { unsigned u = __float_as_uint(f); return (u + 0x7fffu + ((u >> 16) & 1u)) >> 16; }
typedef __bf16 bf16x2_t __attribute__((ext_vector_type(2)));
typedef float f32x2_t __attribute__((ext_vector_type(2)));
__device__ __forceinline__ unsigned pk2(float lo, float hi) { const f32x2_t v = {lo, hi}; const bf16x2_t b = __builtin_convertvector(v, bf16x2_t); return __builtin_bit_cast(unsigned, b); }
__device__ __forceinline__ float wave_sum(float v) {
#pragma unroll
    for (int o = 1; o < 64; o <<= 1) v += __shfl_xor(v, o);
    return v;
}
__device__ __forceinline__ float sigm(float x) { return __builtin_amdgcn_rcpf(1.f + __expf(-x)); }
__device__ __forceinline__ float tanh_fast(float x) { return 1.f - 2.f * __builtin_amdgcn_rcpf(1.f + __expf(2.f * x)); }
__device__ __forceinline__ float rl(float v, int l) { return __int_as_float(__builtin_amdgcn_readlane(__float_as_int(v), l)); }

typedef short bf16x8 __attribute__((ext_vector_type(8)));
typedef unsigned v2u __attribute__((ext_vector_type(2)));
__device__ __forceinline__ v2u pack4(f32x4 v) { v2u r; r.x = pk2(v.x, v.y); r.y = pk2(v.z, v.w); return r; }
__device__ __forceinline__ void unpack8(v4u w, float* o) { o[0] = bf2f(w.x & 0xffffu); o[1] = bf2f(w.x >> 16); o[2] = bf2f(w.y & 0xffffu); o[3] = bf2f(w.y >> 16);
    o[4] = bf2f(w.z & 0xffffu); o[5] = bf2f(w.z >> 16); o[6] = bf2f(w.w & 0xffffu); o[7] = bf2f(w.w >> 16); }
__device__ __forceinline__ v4u pack8(const float* v) { v4u r; r.x = pk2(v[0], v[1]); r.y = pk2(v[2], v[3]); r.z = pk2(v[4], v[5]); r.w = pk2(v[6], v[7]); return r; }
struct Args { const float* in[18]; float* out; unsigned char* ws; };
typedef const Args __attribute__((address_space(4))) CArgs;
__device__ __forceinline__ CArgs* opaque_args() { CArgs* p = (CArgs*)__builtin_amdgcn_kernarg_segment_ptr(); asm volatile("" : "+s"(p)); return p; }
#define AA (*opaque_args())

__device__ __forceinline__ void rms_row2(const float* x0, const float* x1, const float* w, bf16* o0, bf16* o1, int lane) {
    const f32x4* r0 = (const f32x4*)x0 + lane; const f32x4* r1 = (const f32x4*)x1 + lane; const f32x4* wr = (const f32x4*)w + lane;
    f32x4 a[4], b[4]; float sa = 0.f, sb = 0.f;
#pragma unroll
    for (int j = 0; j < 4; ++j) { a[j] = r0[64 * j]; b[j] = r1[64 * j]; }
#pragma unroll
    for (int j = 0; j < 4; ++j) { sa += (a[j].x * a[j].x + a[j].y * a[j].y) + (a[j].z * a[j].z + a[j].w * a[j].w); sb += (b[j].x * b[j].x + b[j].y * b[j].y) + (b[j].z * b[j].z + b[j].w * b[j].w); }
    const float ra = rsqrtf(wave_sum(sa) * (1.f / D) + 1e-6f), rb = rsqrtf(wave_sum(sb) * (1.f / D) + 1e-6f);
#pragma unroll
    for (int j = 0; j < 4; ++j) { const f32x4 ww = wr[64 * j]; const f32x4 oa = a[j] * ra * ww, ob = b[j] * rb * ww;
        ((v2u*)o0 + lane)[64 * j] = pack4(oa); ((v2u*)o1 + lane)[64 * j] = pack4(ob); }
}
__device__ __forceinline__ void transpose_item(const float* W, int K, int N, int Npad, bf16* WT, float* scr, int item, int lane) {
    const int nblk = Npad / 32, kb = item / nblk, nb = item % nblk, k0 = 64 * kb, n0 = 32 * nb;
    const int n = n0 + (lane & 31);
#pragma unroll 8
    for (int i = 0; i < 32; ++i) { const int kk = 2 * i + (lane >> 5); scr[kk * 33 + (lane & 31)] = (n < N) ? W[(size_t)(k0 + kk) * N + n] : 0.f; }
    LDS_WAIT();
    const int c = lane & 7;
#pragma unroll
    for (int j = 0; j < 4; ++j) { const int nn = (lane >> 3) + 8 * j; const float* s = scr + (8 * c) * 33 + nn;
        v4u o; o.x = pk2(s[0 * 33], s[1 * 33]); o.y = pk2(s[2 * 33], s[3 * 33]); o.z = pk2(s[4 * 33], s[5 * 33]); o.w = pk2(s[6 * 33], s[7 * 33]);
        *(v4u*)(WT + (size_t)(n0 + nn) * K + k0 + 8 * c) = o; }
    LDS_WAIT();
}
__device__ __forceinline__ void transpose_tiles(const float* W, int K, int N, int Npad, bf16* WT, float* scr  , int first, int stride, int ntiles, int tid) {
    const int nblk = Npad / 64, kr = tid >> 4, nq = tid & 15;
    f32x4 v0 = {0.f, 0.f, 0.f, 0.f}, v1 = v0;
    if (first < ntiles) { const int kb = first / nblk, nb = first % nblk, n = 64 * nb + 4 * nq; if (n < N) { v0 = *(const f32x4*)(W + (size_t)(64 * kb + kr) * N + n); v1 = *(const f32x4*)(W + (size_t)(64 * kb + 32 + kr) * N + n); } }
#pragma unroll 1
    for (int it = first; it < ntiles; it += stride) {
        const int kb = it / nblk, nb = it % nblk;
        scr[kr * 65 + 4 * nq] = v0.x; scr[kr * 65 + 4 * nq + 1] = v0.y; scr[kr * 65 + 4 * nq + 2] = v0.z; scr[kr * 65 + 4 * nq + 3] = v0.w;
        scr[(32 + kr) * 65 + 4 * nq] = v1.x; scr[(32 + kr) * 65 + 4 * nq + 1] = v1.y; scr[(32 + kr) * 65 + 4 * nq + 2] = v1.z; scr[(32 + kr) * 65 + 4 * nq + 3] = v1.w;
        const int nx = it + stride; v0 = (f32x4){0.f, 0.f, 0.f, 0.f}; v1 = v0;
        if (nx < ntiles) { const int kb2 = nx / nblk, nb2 = nx % nblk, n = 64 * nb2 + 4 * nq; if (n < N) { v0 = *(const f32x4*)(W + (size_t)(64 * kb2 + kr) * N + n); v1 = *(const f32x4*)(W + (size_t)(64 * kb2 + 32 + kr) * N + n); } }
        LBAR();
        { const int n = tid >> 3, kc = tid & 7; const float* sp = scr + (8 * kc) * 65 + n; float o[8];
#pragma unroll
          for (int j = 0; j < 8; ++j) o[j] = sp[j * 65];
          *(v4u*)(WT + (size_t)(64 * nb + n) * K + 64 * kb + 8 * kc) = pack8(o); }
        LBAR();
    }
}
__device__ __forceinline__ void rms_row(const float* xrow, const float* w, bf16* obf, float* of32, int lane) {
    const f32x4* xr = (const f32x4*)xrow + lane; const f32x4* wr = (const f32x4*)w + lane;
    f32x4 v[4]; float s = 0.f;
#pragma unroll
    for (int j = 0; j < 4; ++j) { v[j] = xr[64 * j]; s += (v[j].x * v[j].x + v[j].y * v[j].y) + (v[j].z * v[j].z + v[j].w * v[j].w); }
    const float rs = rsqrtf(wave_sum(s) * (1.f / D) + 1e-6f);
#pragma unroll
    for (int j = 0; j < 4; ++j) { const f32x4 ww = wr[64 * j]; f32x4 o = v[j] * rs * ww;
        if (of32) ((f32x4*)of32 + lane)[64 * j] = o;
        else ((unsigned long long*)obf + lane)[64 * j] = (unsigned long long)pk2(o.x, o.y) | ((unsigned long long)pk2(o.z, o.w) << 32); }
}

constexpr int PITCH = 72, FP = 68, TP = 20;
constexpr int OFF_TW = 0, OFF_AL = 9216, OFF_ARK = 18432, OFF_XA = 27648, OFF_XW = 45056, OFF_AT = 63488, OFF_RT = 72704, OFF_BH = 81920, OFF_KH = 91136,
              OFF_BBT = 100352, OFF_KBT = 109568, OFF_VT = 118784, OFF_TII = 128000, OFF_TOT = 133120, OFF_BC = 135168;
constexpr int OFF_AAK = OFF_TW, OFF_ARB = OFF_AL, OFF_AAB = OFF_XA, OFF_XT = OFF_XW;
constexpr size_t WS_MC = 112 * MiB, WS_NC = 120 * MiB, WS_PP = 136 * MiB, WS_Y0 = 144 * MiB, WS_S0 = 152 * MiB, WS_DEC = 160 * MiB, WS_BON2 = 161 * MiB, WS_UPT = 162 * MiB;
constexpr int NUNIT = 1024;

__device__ __forceinline__ f32x4 mma2s(const bf16* Ab, int ak, const bf16* Bb, int bk, int g, f32x4 acc) {
    acc = __builtin_amdgcn_mfma_f32_16x16x32_bf16(*(const bf16x8*)(Ab + ((g ^ ak) << 3)), *(const bf16x8*)(Bb + ((g ^ bk) << 3)), acc, 0, 0, 0);
    acc = __builtin_amdgcn_mfma_f32_16x16x32_bf16(*(const bf16x8*)(Ab + (((g + 4) ^ ak) << 3)), *(const bf16x8*)(Bb + (((g + 4) ^ bk) << 3)), acc, 0, 0, 0);
    return acc;
}
#define SWK(row) (((row) >> 3) & 7)
#define SWC(row, t) ((row) * PITCH + ((((t) >> 3) ^ SWK(row)) << 3) + ((t) & 7))
__device__ __forceinline__ f32x4 mma2(const bf16* Arow, const bf16* Brow, f32x4 acc) {
    acc = __builtin_amdgcn_mfma_f32_16x16x32_bf16(*(const bf16x8*)(Arow), *(const bf16x8*)(Brow), acc, 0, 0, 0);
    acc = __builtin_amdgcn_mfma_f32_16x16x32_bf16(*(const bf16x8*)(Arow + 32), *(const bf16x8*)(Brow + 32), acc, 0, 0, 0);
    return acc;
}

__device__ __forceinline__ void r1_phase(CArgs& a, size_t uo, int l, unsigned char* L, int tid0, v4u (&GP)[2]) {
    asm volatile("" : "+v"(tid0));
    const int wave = __builtin_amdgcn_readfirstlane(tid0 >> 6);
    const bf16* U = (const bf16*)(a.ws + WS_U + uo);
    bf16* TW = (bf16*)(L + 138240 + 2560); bf16* ALm = (bf16*)(L + 138240 + 2560 + 9216);
    bf16* ARK = (bf16*)(L + OFF_ARK); bf16* AAK = (bf16*)(L + OFF_AAK); bf16* ARB = (bf16*)(L + OFF_ARB);
    float* XA = (float*)(L + OFF_XA); float* XW = (float*)(L + OFF_XW); float* AAB = (float*)(L + OFF_AAB); bf16* XT = (bf16*)(L + OFF_XT);
    bf16* AT = (bf16*)(L + OFF_AT); bf16* RT = (bf16*)(L + OFF_RT); bf16* BH = (bf16*)(L + OFF_BH); bf16* KH = (bf16*)(L + OFF_KH);
    bf16* BBT = (bf16*)(L + OFF_BBT); bf16* KBT = (bf16*)(L + OFF_KBT); bf16* VT = (bf16*)(L + OFF_VT);
    float* TII = (float*)(L + OFF_TII); float* TOT = (float*)(L + OFF_TOT); float* BC = (float*)(L + OFF_BC);
    const bf16* UPT = (const bf16*)(a.ws + WS_UPT) + (size_t)l * 2 * 512 * 64;
    const float* mu = a.in[6] + l * 1664;
    float* WTS = (float*)(L + 135680);
    const int ch = (int)blockIdx.x >> 1, hbase = 4 * ((int)blockIdx.x & 1);
    v4u Lrc, Lkc, Lvc, Lrp, Lkp, Lvp; bf16x8 wfa0, wfa1; float pw[8];
#define R1_ISSUE(h_) do { const int lr_ = 64 * ch + (tid >> 3); const bf16* uq_ = U + (size_t)lr_ * NPAD + 64 * (h_) + 8 * (tid & 7); \
        Lrc = *(const v4u*)(uq_ + C_R); Lkc = *(const v4u*)(uq_ + C_K); Lvc = *(const v4u*)(uq_ + C_V); Lrp = (v4u){0u, 0u, 0u, 0u}; Lkp = Lrp; Lvp = Lrp; \
        if (lr_ > 0) { Lrp = *(const v4u*)(uq_ + C_R - NPAD); Lkp = *(const v4u*)(uq_ + C_K - NPAD); Lvp = *(const v4u*)(uq_ + C_V - NPAD); } \
        if (tid < 64) { const int c_ = l * 512 + 64 * (h_) + tid; pw[0] = a.in[7][c_]; pw[1] = a.in[9][c_]; pw[2] = a.in[11][c_]; pw[3] = a.in[12][c_]; pw[4] = a.in[13][c_]; \
            pw[5] = mu[64 * (h_) + tid]; pw[6] = mu[512 + 64 * (h_) + tid]; pw[7] = mu[1024 + 64 * (h_) + tid]; } \
        { const bf16* WT_ = UPT + (size_t)(wave >> 2) * 512 * 64 + (size_t)(64 * (h_) + 16 * (wave & 3) + (tid & 15)) * 64 + 8 * ((tid & 63) >> 4); wfa0 = *(const bf16x8*)WT_; wfa1 = *(const bf16x8*)(WT_ + 32); } } while (0)
    {
        int tid = tid0; asm volatile("" : "+v"(tid));
        R1_ISSUE(hbase);
        const int t = tid >> 3, cg = tid & 7, lr = 64 * ch + t; const bf16* up = U + (size_t)lr * NPAD + C_WL + 16 * cg;
        const v4u c0 = *(const v4u*)up, c1 = *(const v4u*)(up + 8); v4u p0 = {0u, 0u, 0u, 0u}, p1 = p0;
        if (lr > 0) { p0 = *(const v4u*)(up - NPAD); p1 = *(const v4u*)(up - NPAD + 8); }
        float cu[16], pr[16], o[16]; unpack8(c0, cu); unpack8(c1, cu + 8); unpack8(p0, pr); unpack8(p1, pr + 8);
        const float* mp = mu + 1536 + 16 * cg;
#pragma unroll
        for (int i = 0; i < 16; ++i) { float mv = cu[i] + (pr[i] - cu[i]) * mp[i]; if (cg < 4) mv = tanh_fast(mv); o[i] = mv; }
        bf16* dst = (cg < 4 ? TW : ALm) + t * PITCH + 16 * (cg & 3);
        *(v4u*)dst = pack8(o); *(v4u*)(dst + 8) = pack8(o + 8);
    }
#pragma unroll 1
    for (int hi = 0; hi < 4; ++hi) {
        int tid = tid0; asm volatile("" : "+v"(tid));
        const int lane = tid & 63, g = lane >> 4, c16 = lane & 15;
        const int h = hbase + hi, unit = ch * 8 + h;
        const int t = tid >> 3, dg = tid & 7, d0 = 8 * dg, lr = 64 * ch + t, hc = 64 * h + d0;
        if (tid < 64) {
#pragma unroll
            for (int q = 0; q < 8; ++q) WTS[64 * q + tid] = pw[q]; }
        LBAR();
        {
            const int q = wave >> 2, dt = wave & 3;
            const bf16x8 a0 = wfa0, a1 = wfa1;
            const bf16* Bm = q ? ALm : TW; float* X = q ? XA : XW;
#pragma unroll
            for (int tt = 0; tt < 4; ++tt) { const bf16* br = Bm + (16 * tt + c16) * PITCH + 8 * g; f32x4 acc = {0.f, 0.f, 0.f, 0.f};
                acc = __builtin_amdgcn_mfma_f32_16x16x32_bf16(a0, *(const bf16x8*)br, acc, 0, 0, 0);
                acc = __builtin_amdgcn_mfma_f32_16x16x32_bf16(a1, *(const bf16x8*)(br + 32), acc, 0, 0, 0);
                *(f32x4*)(X + (16 * tt + c16) * FP + 16 * dt + 4 * g) = acc; }
        }
        LBAR();
        float r[8], kq[8], v[8], al[8], be[8], lw[8];
        {
            float rc[8], rp[8], kc[8], kp[8], vc[8], vp[8];
            unpack8(Lrc, rc); unpack8(Lkc, kc); unpack8(Lvc, vc); unpack8(Lrp, rp); unpack8(Lkp, kp); unpack8(Lvp, vp);
            const float* w0p = WTS + d0; const float* a0p = WTS + 64 + d0; const float* kkp = WTS + 128 + d0;
            const float* kap = WTS + 192 + d0; const float* rkp = WTS + 256 + d0;
            float nn = 0.f, bon = 0.f, kk[8], av[8];
#pragma unroll
            for (int i = 0; i < 8; ++i) {
                const float xw = XW[t * FP + d0 + i] + w0p[i], xa = XA[t * FP + d0 + i] + a0p[i];
                lw[i] = -0.60653065971f * sigm(xw); av[i] = sigm(xa);
                r[i] = rc[i] + (rp[i] - rc[i]) * WTS[320 + d0 + i]; const float k = kc[i] + (kp[i] - kc[i]) * WTS[384 + d0 + i]; v[i] = vc[i] + (vp[i] - vc[i]) * WTS[448 + d0 + i];
                kk[i] = k * kkp[i]; nn += kk[i] * kk[i];
                kq[i] = k * (1.f + (av[i] - 1.f) * kap[i]); bon += r[i] * kq[i] * rkp[i];
            }
            nn += __shfl_xor(nn, 1); nn += __shfl_xor(nn, 2); nn += __shfl_xor(nn, 4);
            bon += __shfl_xor(bon, 1); bon += __shfl_xor(bon, 2); bon += __shfl_xor(bon, 4);
            const float inv = __builtin_amdgcn_rsqf(fmaxf(nn, 1e-24f));
#pragma unroll
            for (int i = 0; i < 8; ++i) { const float kn = kk[i] * inv; al[i] = -kn; be[i] = av[i] * kn; XW[t * FP + d0 + i] = lw[i]; }
            if (dg == 0) ((float*)(a.ws + WS_BON2))[lr * 8 + h] = bon;
        }
        LBAR();
        {
            const int d = tid & 63, tb = tid >> 6; float p[8]; float run = 0.f;
#pragma unroll
            for (int i = 0; i < 8; ++i) { run += XW[(8 * tb + i) * FP + d]; p[i] = run; }
            TOT[tb * 64 + d] = run;
            LBAR();
            float off = 0.f;
#pragma unroll
            for (int j = 0; j < 8; ++j) off += (j < tb) ? TOT[j * 64 + d] : 0.f;
#pragma unroll
            for (int i = 0; i < 8; ++i) XW[(8 * tb + i) * FP + d] = off + p[i];
            if (tb == 7) { BC[d] = off + run; BC[64 + d] = __expf(off + run); }
        }
        LBAR();
        {
            float at[8], rt[8], bh[8], kh[8];
#pragma unroll
            for (int i = 0; i < 8; ++i) { const float b = XW[t * FP + d0 + i];
                const float eb = __expf(b), enb = __builtin_amdgcn_rcpf(eb), ebp = __expf(b - lw[i]), ebc = BC[64 + d0 + i] * enb;
                at[i] = al[i] * ebp; rt[i] = r[i] * eb; bh[i] = be[i] * enb; kh[i] = kq[i] * enb;
                BBT[SWC(d0 + i, t)] = (bf16)f2bf(be[i] * ebc); KBT[SWC(d0 + i, t)] = (bf16)f2bf(kq[i] * ebc); VT[SWC(d0 + i, t)] = (bf16)f2bf(v[i]); }
            *(v4u*)(AT + t * PITCH + d0) = pack8(at); *(v4u*)(RT + t * PITCH + d0) = pack8(rt); *(v4u*)(BH + t * PITCH + d0) = pack8(bh); *(v4u*)(KH + t * PITCH + d0) = pack8(kh);
        }
        asm volatile("" ::: "memory");
        if (hi + 1 < 4) R1_ISSUE(h + 1);
        else { const bf16* ur_ = U + (size_t)(64 * ((int)blockIdx.x >> 2) + (tid >> 3)) * NPAD;
            GP[0] = *(const v4u*)(ur_ + C_GLR); GP[1] = *(const v4u*)(ur_ + C_GLR + 8); }
        LBAR();
        {
            const int q = wave >> 1, mh = wave & 1;
            const bf16* As = (q < 2) ? AT : RT; const bf16* Bs = (q & 1) ? KH : BH;
#pragma unroll
            for (int t2 = 0; t2 < 2; ++t2) { const int tt = t2 == 0 ? mh : 3 - mh; const int tcol = 16 * tt + c16;
#pragma unroll
                for (int jt = 0; jt < 4; ++jt) {
                    f32x4 acc = {0.f, 0.f, 0.f, 0.f};
                    if (jt <= tt) { acc = mma2(Bs + (16 * jt + c16) * PITCH + 8 * g, As + tcol * PITCH + 8 * g, acc);
#pragma unroll
                        for (int j = 0; j < 4; ++j) { const int jj = 16 * jt + 4 * g + j; const bool keep = (q < 2) ? (jj < tcol) : (jj <= tcol); if (!keep) acc[j] = 0.f; } }
                    if (q == 0) *(f32x4*)(AAB + tcol * FP + 16 * jt + 4 * g) = acc;
                    else { bf16* dst = (q == 1 ? AAK : (q == 2 ? ARB : ARK)); *(v2u*)(dst + tcol * PITCH + 16 * jt + 4 * g) = pack4(acc); }
                } }
        }
        LBAR();
        f32x4 Z[4];
        {
            if (wave < 4) {
                typedef short s16x4 __attribute__((ext_vector_type(4)));
                const int i = wave; const f32x4 at4 = *(const f32x4*)(AAB + (16 * i + c16) * FP + 16 * i + 4 * g); f32x4 a4, Sp;
#pragma unroll
                for (int j = 0; j < 4; ++j) { a4[j] = AAB[(16 * i + 4 * g + j) * FP + 16 * i + c16]; Sp[j] = at4[j] + ((4 * g + j) == c16 ? 1.f : 0.f); }
                v2u pk_ = pack4(a4), pkt_ = pack4(at4); s16x4 P = __builtin_bit_cast(s16x4, pk_), PT = __builtin_bit_cast(s16x4, pkt_);
                const f32x4 zero4 = {0.f, 0.f, 0.f, 0.f};
#pragma unroll
                for (int st = 0; st < 3; ++st) { const f32x4 p2 = __builtin_amdgcn_mfma_f32_16x16x16bf16_1k(PT, P, zero4, 0, 0, 0), pt2 = __builtin_amdgcn_mfma_f32_16x16x16bf16_1k(P, PT, zero4, 0, 0, 0);
                    pk_ = pack4(p2); pkt_ = pack4(pt2); P = __builtin_bit_cast(s16x4, pk_); PT = __builtin_bit_cast(s16x4, pkt_);
                    const v2u sp_ = pack4(Sp); Sp = __builtin_amdgcn_mfma_f32_16x16x16bf16_1k(P, __builtin_bit_cast(s16x4, sp_), Sp, 0, 0, 0); }
                *(v2u*)((unsigned char*)TII + (i * 64 + lane) * 8) = pack4(Sp); }
            if (wave < 4) {
#pragma unroll
                for (int i = 0; i < 4; ++i)
#pragma unroll
                    for (int j = 0; j < 4; ++j) Z[i][j] = bf2f(AT[(16 * i + 4 * g + j) * PITCH + 16 * wave + c16]);
            } else {
#pragma unroll
                for (int i = 0; i < 4; ++i) { f32x4 acc = {0.f, 0.f, 0.f, 0.f}; const int er = 16 * (wave - 4) + c16; Z[i] = mma2s(AAK + (16 * i + c16) * PITCH, 0, VT + er * PITCH, SWK(er), g, acc); }
            }
        }
        LBAR();
        {
            typedef short s16x4 __attribute__((ext_vector_type(4)));
            f32x4 X[4]; s16x4 Xb[4];
#pragma unroll
            for (int i = 0; i < 4; ++i) { f32x4 z = Z[i];
#pragma unroll
                for (int kb = 0; kb < 4; ++kb) if (kb < i) { const f32x4 av = *(const f32x4*)(AAB + (16 * i + c16) * FP + 16 * kb + 4 * g);
                    const v2u ap = pack4(av); z = __builtin_amdgcn_mfma_f32_16x16x16bf16_1k(__builtin_bit_cast(s16x4, ap), Xb[kb], z, 0, 0, 0); }
                const v2u tp = *(const v2u*)((const unsigned char*)TII + (i * 64 + lane) * 8), zp = pack4(z);
                const f32x4 zero4 = {0.f, 0.f, 0.f, 0.f};
                X[i] = __builtin_amdgcn_mfma_f32_16x16x16bf16_1k(__builtin_bit_cast(s16x4, tp), __builtin_bit_cast(s16x4, zp), zero4, 0, 0, 0);
                const v2u xp = pack4(X[i]); Xb[i] = __builtin_bit_cast(s16x4, xp); }
#pragma unroll
            for (int i = 0; i < 4; ++i) *(v2u*)(XT + (16 * wave + c16) * PITCH + 16 * i + 4 * g) = __builtin_bit_cast(v2u, Xb[i]);
        }
        LBAR();
        {
            const int ps = wave & 1, ti = wave >> 1;
            bf16* MCg = (bf16*)(a.ws + WS_MC) + (size_t)unit * 4096; float* NCg = (float*)(a.ws + WS_NC) + (size_t)unit * 4096;
            bf16* PPg = (bf16*)(a.ws + WS_PP) + (size_t)unit * 4096; bf16* Y0g = (bf16*)(a.ws + WS_Y0) + (size_t)unit * 4096;
#pragma unroll
            for (int tj = 0; tj < 4; ++tj) { const int cc = 16 * tj + c16, rr = 16 * ti + 4 * g, ar = 16 * ti + c16; f32x4 acc = {0.f, 0.f, 0.f, 0.f}, acc2 = {0.f, 0.f, 0.f, 0.f};
                if (ps == 0) {
                    acc = mma2s(XT + ar * PITCH, 0, BBT + cc * PITCH, SWK(cc), g, acc); *(v2u*)(MCg + cc * 64 + (ti >> 1) * 32 + g * 8 + (ti & 1) * 4) = pack4(acc);
                    acc2 = mma2s(BBT + ar * PITCH, SWK(ar), XT + (64 + cc) * PITCH, 0, g, acc2); acc2 = mma2s(KBT + ar * PITCH, SWK(ar), VT + cc * PITCH, SWK(cc), g, acc2);
                    *(f32x4*)(NCg + cc * 64 + rr) = acc2;
                } else {
                    acc = mma2(XT + ar * PITCH + 8 * g, ARB + cc * PITCH + 8 * g, acc);
                    const v2u rv = *(const v2u*)(RT + cc * PITCH + rr); acc[0] += bf2f(rv.x & 0xffffu); acc[1] += bf2f(rv.x >> 16); acc[2] += bf2f(rv.y & 0xffffu); acc[3] += bf2f(rv.y >> 16);
                    *(v2u*)(PPg + cc * 64 + rr) = pack4(acc);
                    acc2 = mma2(XT + (64 + ar) * PITCH + 8 * g, ARB + cc * PITCH + 8 * g, acc2); acc2 = mma2s(VT + ar * PITCH, SWK(ar), ARK + cc * PITCH, 0, g, acc2);
                    *(v2u*)(Y0g + cc * 64 + rr) = pack4(acc2);
                } }
            if (tid < 64) ((float*)(a.ws + WS_DEC))[unit * 64 + tid] = BC[64 + tid];
        }
        LBAR();
    }
}

#define LAS3 __attribute__((address_space(3)))
constexpr int R2_SLOT = 12544, R2_NS = 10, R2_FLAGS = R2_SLOT * R2_NS;
__device__ __forceinline__ void r2_scan(CArgs& a, int chain, unsigned char* L, int tid) {
    asm volatile("" : "+v"(tid));
    const int lane = tid & 63, wave = __builtin_amdgcn_readfirstlane(tid >> 6);
    const int h = chain >> 2, e0 = 16 * (chain & 3), g = lane >> 4, c16 = lane & 15;
    volatile LAS3 unsigned* flg = (volatile LAS3 unsigned*)(LAS3 unsigned char*)(L + R2_FLAGS);
    if (tid < 32) flg[tid] = 0u;
    if (tid >= 64 && tid < 64 + R2_NS) *(volatile LAS3 unsigned*)(LAS3 unsigned char*)(L + (tid - 64) * R2_SLOT + 12288 + 252) = 0xffffffffu;
    __syncthreads();
    const bf16* MC = (const bf16*)(a.ws + WS_MC); const float* NC = (const float*)(a.ws + WS_NC); const float* DEC = (const float*)(a.ws + WS_DEC);
    if (wave != 0) {
        int mco[8], nco[4];
#pragma unroll
        for (int q = 0; q < 8; ++q) { const int pos = 64 * q + lane, row = pos >> 3, kc = (pos & 7) ^ (row & 7); mco[q] = row * 64 + kc * 8; }
#pragma unroll
        for (int q = 0; q < 4; ++q) { const int pos = 64 * q + lane, e = pos >> 4, dc = (pos & 15) ^ e; nco[q] = (e0 + e) * 64 + dc * 4; }
#pragma unroll 1
        for (int c = wave - 1; c < 128; c += 7) {
            while ((int)flg[16] < c - (R2_NS - 1)) __builtin_amdgcn_s_sleep(12);
            LAS3 unsigned char* slot = (LAS3 unsigned char*)(L + (c % R2_NS) * R2_SLOT);
            const size_t unit = (size_t)c * 8 + h;
#pragma unroll
            for (int q = 0; q < 8; ++q) __builtin_amdgcn_global_load_lds((const unsigned*)(MC + unit * 4096 + mco[q]), (LAS3 unsigned*)(slot + q * 1024), 16, 0, 0);
#pragma unroll
            for (int q = 0; q < 4; ++q) __builtin_amdgcn_global_load_lds((const unsigned*)(NC + unit * 4096 + nco[q]), (LAS3 unsigned*)(slot + 8192 + q * 1024), 16, 0, 0);
            __builtin_amdgcn_global_load_lds((const unsigned*)(DEC + unit * 64 + lane), (LAS3 unsigned*)(slot + 12288), 4, 0, 0);
        }
        asm volatile("s_waitcnt vmcnt(0)" ::: "memory");
    } else {
        bf16* S0 = (bf16*)(a.ws + WS_S0) + (size_t)h * 4096 + (e0 + c16) * 64 + 4 * g;
        f32x4 S[4];
#pragma unroll
        for (int m = 0; m < 4; ++m) S[m] = (f32x4){0.f, 0.f, 0.f, 0.f};
        int avail = 0;
        const LAS3 unsigned char* Lb = (const LAS3 unsigned char*)L;
        const int offA0 = (c16 * 8 + (g ^ (c16 & 7))) * 16, offA1 = (c16 * 8 + ((4 + g) ^ (c16 & 7))) * 16;
        int offN[4];
#pragma unroll
        for (int mt = 0; mt < 4; ++mt) offN[mt] = 8192 + (c16 * 16 + ((4 * mt + g) ^ c16)) * 16;
        const int offD = 12288 + 16 * g;
#define R2_MARKS(s_) (*(volatile LAS3 unsigned*)(LAS3 unsigned char*)(L + (s_) * R2_SLOT + 12288 + 252))
#define R2_WAITS(c_, s_) do { while (avail <= (c_)) { const unsigned f0_ = R2_MARKS(s_), f1_ = R2_MARKS(((s_) + 1) % R2_NS), f2_ = R2_MARKS(((s_) + 2) % R2_NS); \
            if (f0_ != 0xffffffffu) { avail = (c_) + 1; if (f1_ != 0xffffffffu) { avail = (c_) + 2; if (f2_ != 0xffffffffu) avail = (c_) + 3; } } \
            else __builtin_amdgcn_s_sleep(0); } asm volatile("" ::: "memory"); } while (0)
        v4u A[2][4][2]; f32x4 Nn[2][4], Dd[2][4];
#define R2_READS(s_, p_) do { _Pragma("unroll") for (int mt = 0; mt < 4; ++mt) { \
                A[p_][mt][0] = *(const LAS3 v4u*)(Lb + (s_) * R2_SLOT + mt * 2048 + offA0); A[p_][mt][1] = *(const LAS3 v4u*)(Lb + (s_) * R2_SLOT + mt * 2048 + offA1); \
                Nn[p_][mt] = *(const LAS3 f32x4*)(Lb + (s_) * R2_SLOT + offN[mt]); Dd[p_][mt] = *(const LAS3 f32x4*)(Lb + (s_) * R2_SLOT + mt * 64 + offD); } } while (0)
        R2_WAITS(0, 0); R2_READS(0, 0);
        asm volatile("s_waitcnt lgkmcnt(0)" ::: "memory");
#pragma unroll 1
        for (int c0 = 0; c0 < 128; c0 += R2_NS) {
#pragma unroll
            for (int k = 0; k < R2_NS; ++k) { const int c = c0 + k;
                if (c < 128) {
                    R2_MARKS(k) = 0xffffffffu; flg[16] = (unsigned)(c + 1);
                    if (c + 1 < 128) { R2_WAITS(c + 1, (k + 1) % R2_NS); R2_READS((k + 1) % R2_NS, (k + 1) & 1); }
                    bf16* sp = S0 + (size_t)c * (8 * 4096); v2u sb[4];
#pragma unroll
                    for (int m = 0; m < 4; ++m) { sb[m] = pack4(S[m]); *(v2u*)(sp + 16 * m) = sb[m]; }
                    const v4u b0 = {sb[0].x, sb[0].y, sb[1].x, sb[1].y}, b1 = {sb[2].x, sb[2].y, sb[3].x, sb[3].y};
                    const bf16x8 B0 = __builtin_bit_cast(bf16x8, b0), B1 = __builtin_bit_cast(bf16x8, b1);
                    f32x4 acc[4];
#pragma unroll
                    for (int mt = 0; mt < 4; ++mt) acc[mt] = __builtin_amdgcn_mfma_f32_16x16x32_bf16(__builtin_bit_cast(bf16x8, A[k & 1][mt][0]), B0, Nn[k & 1][mt] + S[mt] * Dd[k & 1][mt], 0, 0, 0);
#pragma unroll
                    for (int mt = 0; mt < 4; ++mt) S[mt] = __builtin_amdgcn_mfma_f32_16x16x32_bf16(__builtin_bit_cast(bf16x8, A[k & 1][mt][1]), B1, acc[mt], 0, 0, 0);
                    asm volatile("s_waitcnt lgkmcnt(0)" ::: "memory");
                } }
        }
#undef R2_WAITS
#undef R2_MARKS
#undef R2_READS
#define R2_READ 0
#undef R2_READ
    }
    __syncthreads();
}

__device__ __forceinline__ void r3_phase(CArgs& a, size_t uo, int l, int hb, int gw, int NGW, int lane) {
    asm volatile("" : "+v"(lane));
    const int g = lane >> 4, c16 = lane & 15;
    const bf16* U = (const bf16*)(a.ws + WS_U + uo); const bf16* PP = (const bf16*)(a.ws + WS_PP); const bf16* S0 = (const bf16*)(a.ws + WS_S0); const bf16* Y0 = (const bf16*)(a.ws + WS_Y0);
    const float* BON = (const float*)(a.ws + WS_BON2); bf16* MG = (bf16*)(a.ws + WS_XN) + (size_t)hb * MH * D;
    const float* mu_v = a.in[6] + l * 1664 + 1024; const float* lnw = a.in[14] + l * 512; const float* lnb = a.in[15] + l * 512;
    const int erow = 16 * (c16 >> 2) + (c16 & 3);
    bf16x8 SA[4][2];
    { const int unit0 = 4 * (gw >> 3) + ((gw & 7) >> 1);
#pragma unroll
      for (int et = 0; et < 4; ++et) { const bf16* sr = S0 + (size_t)unit0 * 4096 + (erow + 4 * et) * 64 + 8 * g; SA[et][0] = *(const bf16x8*)sr; SA[et][1] = *(const bf16x8*)(sr + 32); } }
#pragma unroll 1
    for (int kk = 0; kk < 2; ++kk) {
        const int unit = 4 * (gw >> 3) + ((gw & 7) >> 1), mt = 2 * (gw & 1) + kk, ch = unit >> 3, h = unit & 7; const size_t ub = (size_t)unit * 4096;
        if (unit >= NUNIT) break;
        const int lr = 64 * ch + 16 * mt + c16; const bf16* urow = U + (size_t)lr * NPAD + 64 * h + 16 * g;
        float vc[16], vp[16], rgf[16];
        unpack8(*(const v4u*)(urow + C_V), vc); unpack8(*(const v4u*)(urow + C_V + 8), vc + 8); unpack8(*(const v4u*)(urow + C_RG), rgf); unpack8(*(const v4u*)(urow + C_RG + 8), rgf + 8);
        if (lr > 0) { unpack8(*(const v4u*)(urow + C_V - NPAD), vp); unpack8(*(const v4u*)(urow + C_V + 8 - NPAD), vp + 8); }
        else {
#pragma unroll
            for (int i = 0; i < 16; ++i) vp[i] = 0.f; }
        const float bon = BON[lr * 8 + h];
        const bf16* pr = PP + ub + (16 * mt + c16) * 64 + 8 * g;
        const bf16x8 B0 = *(const bf16x8*)pr, B1 = *(const bf16x8*)(pr + 32);
        f32x4 Y[4];
        const bf16* y0p = Y0 + ub + (16 * mt + c16) * 64 + 16 * g; const v4u y0a = *(const v4u*)y0p, y0b = *(const v4u*)(y0p + 8);
        asm volatile("" ::: "memory");
        { float yf[16]; unpack8(y0a, yf); unpack8(y0b, yf + 8);
#pragma unroll
          for (int et = 0; et < 4; ++et) Y[et] = (f32x4){yf[4 * et], yf[4 * et + 1], yf[4 * et + 2], yf[4 * et + 3]}; }
#pragma unroll
        for (int et = 0; et < 4; ++et) { f32x4 acc = __builtin_amdgcn_mfma_f32_16x16x32_bf16(SA[et][0], B0, Y[et], 0, 0, 0);
            Y[et] = __builtin_amdgcn_mfma_f32_16x16x32_bf16(SA[et][1], B1, acc, 0, 0, 0); }
        const f32x4 sv = (Y[0] + Y[1]) + (Y[2] + Y[3]); float sm = (sv.x + sv.y) + (sv.z + sv.w); sm += __shfl_xor(sm, 16); sm += __shfl_xor(sm, 32);
        const float mean = sm * (1.f / 64.f); float q = 0.f;
#pragma unroll
        for (int et = 0; et < 4; ++et) { const f32x4 dd = Y[et] - mean; q += (dd.x * dd.x + dd.y * dd.y) + (dd.z * dd.z + dd.w * dd.w); }
        q += __shfl_xor(q, 16); q += __shfl_xor(q, 32);
        const float rstd = rsqrtf(q * (1.f / 64.f) + 64e-5f);
        const int cc = 64 * h + 16 * g; float o[16];
#pragma unroll
        for (int et = 0; et < 4; ++et) {
            const f32x4 w4 = *(const f32x4*)(lnw + cc + 4 * et), b4 = *(const f32x4*)(lnb + cc + 4 * et), m4 = *(const f32x4*)(mu_v + cc + 4 * et);
#pragma unroll
            for (int j = 0; j < 4; ++j) { const int i = 4 * et + j; const float vv = vc[i] + (vp[i] - vc[i]) * m4[j]; const float yn = (Y[et][j] - mean) * rstd * w4[j] + b4[j];
                o[i] = (yn + bon * vv) * rgf[i] * sigm(rgf[i]); } }
        bf16* op = MG + (size_t)lr * D + 512 + cc; *(v4u*)op = pack8(o); *(v4u*)(op + 8) = pack8(o + 8);
    }
}

constexpr int OFF_GQI = 17408, OFF_GKI = 26624, OFF_GKST = 35840, OFF_GVT = 45056, OFF_GSC = 63488, OFF_GTOT = 72704, OFF_GBC = 74752;
constexpr size_t WS_QI = 163 * MiB, WS_OI = 167 * MiB, WS_DS = 175 * MiB, WS_GDEC = 183 * MiB, WS_SP = 184 * MiB;
constexpr int NGUNIT = 512;

__device__ __forceinline__ void g1_phase(CArgs& a, size_t uo, int l, unsigned char* L, int tid0, int ufirst, int ustride, const v4u (&GP)[2]) {
    asm volatile("" : "+v"(tid0));
    const int wave = __builtin_amdgcn_readfirstlane(tid0 >> 6);
    const bf16* U = (const bf16*)(a.ws + WS_U + uo);
    float* XW = (float*)L; bf16* QI = (bf16*)(L + OFF_GQI); bf16* KI = (bf16*)(L + OFF_GKI); bf16* KST = (bf16*)(L + OFF_GKST); bf16* VT = (bf16*)(L + OFF_GVT); bf16* SC = (bf16*)(L + OFF_GSC);
    float* TOT = (float*)(L + OFF_GTOT); float* BC = (float*)(L + OFF_GBC);
    float* GW = (float*)(L + OFF_GBC + 256);
    int hl = -1;
    v4u Gl0, Gl1, Gq, Gk, Gv0, Gv1;
#define G1_ISSUE(u_) do { const int lr_ = 64 * ((u_) >> 2) + (tid >> 3), h_ = (u_) & 3, dg_ = tid & 7; const bf16* ur_ = U + (size_t)lr_ * NPAD; \
        Gl0 = *(const v4u*)(ur_ + C_GLR); Gl1 = *(const v4u*)(ur_ + C_GLR + 8); Gq = *(const v4u*)(ur_ + C_GQ + 64 * h_ + 8 * dg_); Gk = *(const v4u*)(ur_ + C_GK + 64 * h_ + 8 * dg_); \
        Gv0 = *(const v4u*)(ur_ + C_GV + 128 * h_ + 16 * dg_); Gv1 = *(const v4u*)(ur_ + C_GV + 128 * h_ + 16 * dg_ + 8); } while (0)
#pragma unroll 1
    for (int unit = ufirst; unit < NGUNIT; unit += ustride) {
        int tid = tid0; asm volatile("" : "+v"(tid));
        const int lane = tid & 63, g = lane >> 4, c16 = lane & 15;
        const int ch = unit >> 2, h = unit & 3;
        if (h != hl) { hl = h; LBAR();
            for (int i = tid; i < 16 * 64; i += NTHR) GW[i] = a.in[3][l * 16 * 256 + (i >> 6) * 256 + 64 * h + (i & 63)];
            if (tid < 64) GW[1024 + tid] = a.in[4][l * 256 + 64 * h + tid];
            LBAR(); }
        const int t = tid >> 3, dg = tid & 7, d0 = 8 * dg, lr = 64 * ch + t, hc = 64 * h + d0;
        if (unit == ufirst) { G1_ISSUE(unit); Gl0 = GP[0]; Gl1 = GP[1]; }
        float q[8], k[8];
        {
            float glr[16]; unpack8(Gl0, glr); unpack8(Gl1, glr + 8);
            float x[8]; const float* gb = GW + 1024 + d0; const float* gu = GW + d0;
#pragma unroll
            for (int i = 0; i < 8; ++i) x[i] = gb[i];
#pragma unroll
            for (int r = 0; r < 16; ++r) { const f32x4 u0 = *(const f32x4*)(gu + r * 64), u1 = *(const f32x4*)(gu + r * 64 + 4);
                x[0] += glr[r] * u0.x; x[1] += glr[r] * u0.y; x[2] += glr[r] * u0.z; x[3] += glr[r] * u0.w; x[4] += glr[r] * u1.x; x[5] += glr[r] * u1.y; x[6] += glr[r] * u1.z; x[7] += glr[r] * u1.w; }
#pragma unroll
            for (int i = 0; i < 8; ++i) XW[t * FP + d0 + i] = (fminf(x[i], 0.f) - __logf(1.f + __expf(-fabsf(x[i])))) * (1.f / 16.f);
            unpack8(Gq, q); unpack8(Gk, k);
            float vv[16]; const int e0 = 16 * dg; unpack8(Gv0, vv); unpack8(Gv1, vv + 8);
            asm volatile("" ::: "memory");
            if (unit + ustride < NGUNIT) G1_ISSUE(unit + ustride);
#pragma unroll
            for (int i = 0; i < 16; ++i) VT[SWC(e0 + i, t)] = (bf16)f2bf(vv[i]);
        }
        LBAR();
        {
            const int d = tid & 63, tb = tid >> 6; float p[8]; float run = 0.f;
#pragma unroll
            for (int i = 0; i < 8; ++i) { run += XW[(8 * tb + i) * FP + d]; p[i] = run; }
            TOT[tb * 64 + d] = run;
            LBAR();
            float off = 0.f;
#pragma unroll
            for (int j = 0; j < 8; ++j) off += (j < tb) ? TOT[j * 64 + d] : 0.f;
#pragma unroll
            for (int i = 0; i < 8; ++i) XW[(8 * tb + i) * FP + d] = off + p[i];
            if (tb == 7) BC[d] = off + run;
        }
        LBAR();
        {
            float qi[8], ki[8];
#pragma unroll
            for (int i = 0; i < 8; ++i) { const float b = XW[t * FP + d0 + i], bc = BC[d0 + i];
                qi[i] = q[i] * 0.125f * __expf(b); ki[i] = k[i] * __expf(-b); KST[SWC(d0 + i, t)] = (bf16)f2bf(k[i] * __expf(bc - b)); }
            const v4u qp = pack8(qi);
            *(v4u*)(QI + t * PITCH + d0) = qp; *(v4u*)(KI + t * PITCH + d0) = pack8(ki);
            *(v4u*)((bf16*)(a.ws + WS_QI) + (size_t)unit * 4096 + t * 64 + d0) = qp;
        }
        LBAR();
        {
            const int tt = wave >> 1; const int tcol = 16 * tt + c16;
#pragma unroll
            for (int j2 = 0; j2 < 2; ++j2) { const int jt = 2 * (wave & 1) + j2; f32x4 acc = {0.f, 0.f, 0.f, 0.f};
                if (jt <= tt) { acc = mma2(KI + (16 * jt + c16) * PITCH + 8 * g, QI + tcol * PITCH + 8 * g, acc);
#pragma unroll
                    for (int j = 0; j < 4; ++j) if (16 * jt + 4 * g + j > tcol) acc[j] = 0.f; }
                *(v2u*)(SC + tcol * PITCH + 16 * jt + 4 * g) = pack4(acc); }
            bf16* DSg = (bf16*)(a.ws + WS_DS) + (size_t)unit * 8192;
#pragma unroll
            for (int i = 0; i < 4; ++i) { const int tile = wave * 4 + i, dt = tile & 3, et = tile >> 2; f32x4 acc = {0.f, 0.f, 0.f, 0.f};
                { const int ar = 16 * dt + c16, br = 16 * et + c16; acc = mma2s(KST + ar * PITCH, SWK(ar), VT + br * PITCH, SWK(br), g, acc); }
                *(v2u*)(DSg + (16 * et + c16) * 64 + 16 * dt + 4 * g) = pack4(acc); }
            if (tid < 64) ((float*)(a.ws + WS_GDEC))[unit * 64 + tid] = __expf(BC[tid]);
        }
        LBAR();
        {
            bf16* OIg = (bf16*)(a.ws + WS_OI) + (size_t)unit * 8192;
#pragma unroll
            for (int i = 0; i < 4; ++i) { const int tile = wave * 4 + i, tt = tile & 3, et = tile >> 2; f32x4 acc = {0.f, 0.f, 0.f, 0.f};
                { const int ar = 16 * et + c16; acc = mma2s(VT + ar * PITCH, SWK(ar), SC + (16 * tt + c16) * PITCH, 0, g, acc); }
                *(v2u*)(OIg + (16 * tt + c16) * 128 + 16 * et + 4 * g) = pack4(acc); }
        }
        LBAR();
    }
}

__device__ __forceinline__ void g2_scan(CArgs& a, int wg, unsigned char* L, int tid) {
    asm volatile("" : "+v"(tid));
    const int h = wg >> 2, e = 32 * (wg & 3) + (tid >> 4), dq = tid & 15;
    const bf16* DS = (const bf16*)(a.ws + WS_DS) + (size_t)h * 8192 + e * 64 + 4 * dq; const float* GD = (const float*)(a.ws + WS_GDEC) + (size_t)(((tid >> 4) & 15) * 4 + h) * 64 + 4 * dq;
    bf16* SP = (bf16*)(a.ws + WS_SP) + (size_t)h * 8192 + e * 64 + 4 * dq;
    float* DCL = (float*)L;
    v2u dsb[2][16]; f32x4 dcr;
    f32x4 S = {0.f, 0.f, 0.f, 0.f};
#pragma unroll
    for (int i = 0; i < 16; ++i) dsb[0][i] = *(const v2u*)(DS + (size_t)i * (4 * 8192));
    dcr = *(const f32x4*)GD;
    if (tid < 256) *(f32x4*)(DCL + (tid >> 4) * 64 + 4 * dq) = dcr;
#pragma unroll 1
    for (int b2 = 0; b2 < 8; b2 += 2) {
#pragma unroll
        for (int bb = 0; bb < 2; ++bb) { const int b = b2 + bb;
            if (b + 1 < 8) {
#pragma unroll
                for (int i = 0; i < 16; ++i) dsb[(bb + 1) & 1][i] = *(const v2u*)(DS + (size_t)(16 * (b + 1) + i) * (4 * 8192));
                dcr = *(const f32x4*)(GD + (size_t)(16 * (b + 1)) * (4 * 64)); }
            LBAR();
            const float* dcl = DCL + bb * 1024 + 4 * dq;
#pragma unroll
            for (int i = 0; i < 16; ++i) { const f32x4 dc = *(const f32x4*)(dcl + i * 64); const v2u w = dsb[bb][i];
                *(v2u*)(SP + (size_t)(16 * b + i) * (4 * 8192)) = pack4(S);
                const f32x4 dv = {bf2f(w.x & 0xffffu), bf2f(w.x >> 16), bf2f(w.y & 0xffffu), bf2f(w.y >> 16)};
                S = S * dc + dv; }
            if (b + 1 < 8 && tid < 256) *(f32x4*)(DCL + ((bb + 1) & 1) * 1024 + (tid >> 4) * 64 + 4 * dq) = dcr;
        }
    }
    LBAR();
}

__device__ __forceinline__ void g3_phase(CArgs& a, size_t uo, int l, int hb, int gw, int NGW, int lane) {
    asm volatile("" : "+v"(lane));
    const int g = lane >> 4, c16 = lane & 15;
    const bf16* U = (const bf16*)(a.ws + WS_U + uo); const bf16* QI = (const bf16*)(a.ws + WS_QI); const bf16* SP = (const bf16*)(a.ws + WS_SP); const bf16* OI = (const bf16*)(a.ws + WS_OI);
    bf16* MG = (bf16*)(a.ws + WS_XN) + (size_t)hb * MH * D; const float* gnw = a.in[5] + l * 128;
    const int erow = 32 * (c16 >> 2) + (c16 & 3);
#pragma unroll 1
    for (int kk = 0; kk < 1; ++kk) {
        const int unit = (gw >> 3) + 256 * ((gw & 7) >> 2), mt = gw & 3, ch = unit >> 2, h = unit & 3;
        if (unit >= NGUNIT) break;
        const int lr = 64 * ch + 16 * mt + c16; const bf16* urow = U + (size_t)lr * NPAD + C_GG + 128 * h + 32 * g;
        const v4u gg0 = *(const v4u*)urow, gg1 = *(const v4u*)(urow + 8), gg2 = *(const v4u*)(urow + 16), gg3 = *(const v4u*)(urow + 24);
        const bf16* qr = QI + (size_t)unit * 4096 + (16 * mt + c16) * 64 + 8 * g;
        const bf16x8 B0 = *(const bf16x8*)qr, B1 = *(const bf16x8*)(qr + 32);
        f32x4 O[8]; float ss = 0.f; bf16x8 SA[8][2];
#pragma unroll
        for (int et = 0; et < 8; ++et) { const bf16* sr = SP + (size_t)unit * 8192 + (erow + 4 * et) * 64 + 8 * g; SA[et][0] = *(const bf16x8*)sr; SA[et][1] = *(const bf16x8*)(sr + 32); }
        const bf16* oip = OI + (size_t)unit * 8192 + (16 * mt + c16) * 128 + 32 * g; const v4u oi0 = *(const v4u*)oip, oi1 = *(const v4u*)(oip + 8), oi2 = *(const v4u*)(oip + 16), oi3 = *(const v4u*)(oip + 24);
        asm volatile("" ::: "memory");
        { float of[32]; unpack8(oi0, of); unpack8(oi1, of + 8); unpack8(oi2, of + 16); unpack8(oi3, of + 24);
#pragma unroll
          for (int et = 0; et < 8; ++et) O[et] = (f32x4){of[4 * et], of[4 * et + 1], of[4 * et + 2], of[4 * et + 3]}; }
#pragma unroll
        for (int et = 0; et < 8; ++et) { f32x4 acc = __builtin_amdgcn_mfma_f32_16x16x32_bf16(SA[et][0], B0, O[et], 0, 0, 0);
            acc = __builtin_amdgcn_mfma_f32_16x16x32_bf16(SA[et][1], B1, acc, 0, 0, 0);
            O[et] = acc; ss += (acc.x * acc.x + acc.y * acc.y) + (acc.z * acc.z + acc.w * acc.w); }
        ss += __shfl_xor(ss, 16); ss += __shfl_xor(ss, 32);
        const float rstd = rsqrtf(ss * (1.f / 128.f) + 1e-6f);
        float gf[32], o[32]; unpack8(gg0, gf); unpack8(gg1, gf + 8); unpack8(gg2, gf + 16); unpack8(gg3, gf + 24);
#pragma unroll
        for (int et = 0; et < 8; ++et) { const f32x4 w4 = *(const f32x4*)(gnw + 32 * g + 4 * et);
#pragma unroll
            for (int j = 0; j < 4; ++j) { const int i = 4 * et + j; o[i] = O[et][j] * rstd * w4[j] * gf[i] * sigm(gf[i]); } }
        bf16* op = MG + (size_t)lr * D + 128 * h + 32 * g;
        *(v4u*)op = pack8(o); *(v4u*)(op + 8) = pack8(o + 8); *(v4u*)(op + 16) = pack8(o + 16); *(v4u*)(op + 24) = pack8(o + 24);
    }
}

#define LAS __attribute__((address_space(3)))
#define XB_TMO      128
#define XB_XCNT(j)  (256  + 64 * (j))
#define XB_XSUB(j)  (1280 + 64 * (j))
#define XB_XGEN(j)  (2304 + 64 * (j))
#define XB_TOP      3328
#define XB_TOPGEN   3392
#define XCD_BAR_WORDS 3456
#define XB_SPIN_CAP (1u << 18)

__device__ __forceinline__ unsigned xb_ld(unsigned* p)              { return __hip_atomic_load(p, __ATOMIC_RELAXED, __HIP_MEMORY_SCOPE_AGENT); }
__device__ __forceinline__ unsigned xb_add(unsigned* p, unsigned v) { return __hip_atomic_fetch_add(p, v, __ATOMIC_RELAXED, __HIP_MEMORY_SCOPE_AGENT); }
__device__ __forceinline__ unsigned xb_xcc_id() { return (unsigned)__builtin_amdgcn_s_getreg((3 << 11) | 20) & 0xFu; }
#define XB_SPIN(cond, bar) do { unsigned _sp = 0; while (cond) { __builtin_amdgcn_s_sleep(1); \
    if ((++_sp & 255u) == 0u) { if (xb_ld(&(bar)[XB_TMO])) break; if (_sp > XB_SPIN_CAP) { atomicAdd(&(bar)[XB_TMO], 1u); break; } } } } while (0)

struct XcdBarrier {
    unsigned* bar; unsigned x;
    volatile LAS unsigned* st;
};

__device__ __forceinline__ XcdBarrier xcd_barrier_post(unsigned* bar, volatile LAS unsigned* st) {
    XcdBarrier b; b.bar = bar; b.x = xb_xcc_id(); b.st = st;
    if (threadIdx.x == 0) (void)xb_add(&bar[XB_XCNT(b.x)], 1u);
    return b;
}
__device__ __forceinline__ void xcd_barrier_complete(unsigned* bar, unsigned x, unsigned& nloc, unsigned& nx) {
    const unsigned G = gridDim.x * gridDim.y * gridDim.z;
    unsigned sum, cnt, mine, sp = 0u;
    for (;;) {
        sum = 0u; cnt = 0u; mine = 0u;
#pragma unroll
        for (unsigned j = 0; j < 16; ++j) { const unsigned c = xb_ld(&bar[XB_XCNT(j)]); sum += c; cnt += (c > 0u) ? 1u : 0u; mine = (j == x) ? c : mine; }
        if (sum == G) break;
        __builtin_amdgcn_s_sleep(1);
        if ((++sp & 255u) == 0u) { if (xb_ld(&bar[XB_TMO])) break; if (sp > XB_SPIN_CAP) { atomicAdd(&bar[XB_TMO], 1u); break; } }
    }
    nloc = mine > 0u ? mine : 1u; nx = cnt > 0u ? cnt : 1u;
}

__device__ __forceinline__ void xcd_barrier(const XcdBarrier& b) {
    asm volatile("s_waitcnt vmcnt(0)" ::: "memory");
    __syncthreads();
    if (threadIdx.x == 0) {
        unsigned* bar = b.bar;
        __builtin_amdgcn_s_waitcnt(0);
        unsigned nloc = b.st[0], nx = b.st[1];
        if (nloc == 0u) { xcd_barrier_complete(bar, b.x, nloc, nx); b.st[0] = nloc; b.st[1] = nx; }
        const unsigned old = xb_add(&bar[XB_XSUB(b.x)], 1u);
        const unsigned gen = old / nloc;
        if (old + 1u == (gen + 1u) * nloc) {
            __builtin_amdgcn_fence(__ATOMIC_RELEASE, "agent");
            asm volatile("s_waitcnt vmcnt(0)" ::: "memory");
            const unsigned og = xb_add(&bar[XB_TOP], 1u);
            const unsigned tg = og / nx;
            if (og + 1u == (tg + 1u) * nx) xb_add(&bar[XB_TOPGEN], 1u);
            else XB_SPIN(xb_ld(&bar[XB_TOPGEN]) == tg, bar);
            __builtin_amdgcn_fence(__ATOMIC_ACQUIRE, "agent");
            xb_add(&bar[XB_XGEN(b.x)], 1u);
            asm volatile("s_waitcnt vmcnt(0)" ::: "memory");
        } else {
            XB_SPIN(xb_ld(&bar[XB_XGEN(b.x)]) == gen, bar);
            __builtin_amdgcn_fence(__ATOMIC_ACQUIRE, "agent");
            asm volatile("s_waitcnt vmcnt(0)" ::: "memory");
        }
    }
    __syncthreads();
}


__global__ void __launch_bounds__(NTHR, 2) hymba_fwd(Args a_kernarg) {
    extern __shared__ __attribute__((aligned(16))) unsigned char lds[];
    cg::grid_group grid = cg::this_grid();
    const int tid = threadIdx.x, lane = tid & 63, wave = __builtin_amdgcn_readfirstlane(tid >> 6);
    const int G = gridDim.x, gw = blockIdx.x * NWAVES + wave, NGW = G * NWAVES;
    volatile LAS unsigned* xst = (volatile LAS unsigned*)(LAS unsigned char*)(lds + LDS_BYTES - 64);
    if (tid < 2) xst[tid] = 0u;
    __syncthreads();
    const XcdBarrier xbar = xcd_barrier_post((unsigned*)AA.ws, xst);
    {
        CArgs& a = AA; bf16* XN = (bf16*)(a.ws + WS_XN);
        float* scr = (float*)lds;
        constexpr int T_IN = (D / 64) * (NPAD / 64), T_OUT = (D / 64) * (D / 64);
        for (int l = 0; l < 2; ++l) {
            transpose_tiles(a.in[2] + (size_t)l * D * NIN, D, NIN, NPAD, (bf16*)(a.ws + WS_WIN + l * WIN_BYTES), scr, (int)blockIdx.x, G, T_IN, tid);
            transpose_tiles(a.in[16] + (size_t)l * D * D, D, D, D, (bf16*)(a.ws + WS_WOUT + l * WOUT_BYTES), scr, (int)blockIdx.x, G, T_OUT, tid);
        }
        for (int m = 2 * gw; m < M; m += 2 * NGW) rms_row2(a.in[0] + (size_t)m * D, a.in[0] + (size_t)(m + 1) * D, a.in[1], XN + (size_t)m * D, XN + (size_t)(m + 1) * D, lane);
        {
            bf16* UPT = (bf16*)(a.ws + WS_UPT);
            for (int e = blockIdx.x * NTHR + tid; e < 2 * 2 * 512 * 64; e += G * NTHR) { const int r = e & 63, c = (e >> 6) & 511, q = (e >> 15) & 1, ll = e >> 16;
                UPT[e] = (bf16)f2bf((q ? a.in[10] : a.in[8])[(size_t)ll * 64 * 512 + r * 512 + c]); }
        }
    }
    if (AA.ws == nullptr) grid.sync();
    xcd_barrier(xbar);
    for (int l = 0; l < 2; ++l) {
        for (int hb = 0; hb < 2; ++hb) {
            {
                CArgs& a = AA; bf16* XN = (bf16*)(a.ws + WS_XN); bf16* U = (bf16*)(a.ws + WS_U + (size_t)hb * U_STRIDE);
                pg8::Gemm g{XN + (size_t)hb * MH * D, (const bf16*)(a.ws + WS_WIN + l * WIN_BYTES), MH, NPAD, D}; pg8::RangeOrder S;
                if (hb == 0) S.init(MH, NPAD, G, (int)blockIdx.x, 0, 480); else S.init(MH, NPAD, G, (int)blockIdx.x, EARLY_TILES, 480 - EARLY_TILES);
                pg8::EpiBf16<0> E{U, NPAD, nullptr, 0, 0, 1.f};
                pg8::gemm_phase<pg8::EpiBf16<0>, pg8::RangeOrder, true, true>((PG8_LAS unsigned char*)lds, g, S, E);
            }
            xcd_barrier(xbar);
            const size_t uo = (size_t)hb * U_STRIDE;
            v4u GP[2];
            r1_phase(AA, uo, l, lds, tid, GP);
            g1_phase(AA, uo, l, lds, tid, (int)blockIdx.x, G, GP);
            xcd_barrier(xbar);
            if (blockIdx.x < 32) r2_scan(AA, blockIdx.x, lds, tid);
            else { if (blockIdx.x < 48) g2_scan(AA, blockIdx.x - 32, lds, tid);
                if (hb == 0) {
                    CArgs& a = AA; bf16* XN = (bf16*)(a.ws + WS_XN); bf16* U1 = (bf16*)(a.ws + WS_U1);
                    pg8::Gemm g{XN + (size_t)MH * D, (const bf16*)(a.ws + WS_WIN + l * WIN_BYTES), MH, NPAD, D}; pg8::RangeOrder S; S.init(MH, NPAD, G, (int)blockIdx.x - 32, 0, EARLY_TILES);
                    pg8::EpiBf16<0> E{U1, NPAD, nullptr, 0, 0, 1.f};
                    pg8::gemm_phase<pg8::EpiBf16<0>, pg8::RangeOrder, true, true>((PG8_LAS unsigned char*)lds, g, S, E); } }
            xcd_barrier(xbar);
            r3_phase(AA, uo, l, hb, gw, NGW, lane);
            g3_phase(AA, uo, l, hb, gw, NGW, lane);
            if (hb == 1) xcd_barrier(xbar);
        }
        {
            CArgs& a = AA; bf16* XN = (bf16*)(a.ws + WS_XN);
            pg8::Gemm g{XN, (const bf16*)(a.ws + WS_WOUT + l * WOUT_BYTES), M, D, D}; pg8::StaticOrder S; S.init(M, D, G, (int)blockIdx.x);
            pg8::EpiRmsRes E{l == 0 ? a.in[0] : a.out, a.out, XN, l == 0 ? a.in[1] + D : a.in[17], (float*)(a.ws + WS_SLOTS) + (size_t)l * M * 4, (unsigned*)(a.ws + 16384) + l * 64 * 64, D, l};
            pg8::gemm_phase<pg8::EpiRmsRes, pg8::StaticOrder, false, true>((PG8_LAS unsigned char*)lds, g, S, E);
        }
        if (l == 0) xcd_barrier(xbar);
    }
}

extern "C" void kernel_launch(void* const* d_in, const int* in_sizes, int n_in, void* d_out, int out_size, void* d_ws, size_t ws_size, hipStream_t stream) {
    static int grid = 0;
    if (grid == 0) {
        if (n_in != 18 || out_size != M * D || ws_size < WS_END) { fprintf(stderr, "kernel_launch: unexpected shapes n_in %d out %d ws %zu\n", n_in, out_size, ws_size); grid = -1; return; }
        int dev = 0, cus = 0, per_cu = 0;
        hipGetDevice(&dev); hipDeviceGetAttribute(&cus, hipDeviceAttributeMultiprocessorCount, dev);
        if (hipFuncSetAttribute((const void*)hymba_fwd, hipFuncAttributeMaxDynamicSharedMemorySize, LDS_BYTES) != hipSuccess) { fprintf(stderr, "kernel_launch: hipFuncSetAttribute failed\n"); grid = -1; return; }
        if (hipOccupancyMaxActiveBlocksPerMultiprocessor(&per_cu, (const void*)hymba_fwd, NTHR, LDS_BYTES) != hipSuccess || per_cu < 1) { fprintf(stderr, "kernel_launch: occupancy query failed (%d)\n", per_cu); grid = -1; return; }
        grid = cus * 1;
        fprintf(stderr, "kernel_launch: cus %d per_cu %d grid %d\n", cus, per_cu, grid);
    }
    if (grid < 0) return;
    if (hipMemsetAsync(d_ws, 0, 65536, stream) != hipSuccess) { fprintf(stderr, "kernel_launch: memset failed\n"); return; }
    Args a{};
    for (int i = 0; i < 18; ++i) a.in[i] = (const float*)d_in[i];
    a.out = (float*)d_out; a.ws = (unsigned char*)d_ws;
    void* args[] = {&a};
    hipError_t e = hipLaunchCooperativeKernel((const void*)hymba_fwd, dim3(grid), dim3(NTHR), args, LDS_BYTES, stream);
    if (e != hipSuccess) fprintf(stderr, "cooperative launch failed: %s (grid %d)\n", hipGetErrorString(e), grid);
}
```
